# Optimizing an MI355X kernel written in HIP

```python
import math
import jax
import jax.numpy as jnp
from jax import lax
import numpy as np

D_MODEL = 1024
BATCH = 8
SEQ = 4096
DEPTH = 4

GRID_W = 64
CTX_LEN = 256
F32 = jnp.float32
ALPHA = (2.0 * DEPTH) ** 0.25
BETA = (8.0 * DEPTH) ** -0.25
LN_EPS = 1e-5
NORM_EPS = 1e-6
NEG = -1e30
GLA_HEADS = 4
GLA_DK = 64
GLA_DV = 128
GLA_RANK = 16
GLA_TAU = 16.0
GLA_CHUNK = 64
NA_HEADS = 8
NA_DH = 64
NA_KH = 8
NA_KW = 16
ML_HEADS = 4
ML_DQK = 64
ML_DV = 128
ML_CHUNK = 64
SW_HEADS = 8
SW_KV_HEADS = 2
SW_DH = 64
SW_WINDOW = 128
SW_BLOCK = 128
ROPE_BASE = 10000.0

GLA_W = GLA_HEADS * GLA_DV
NA_W = NA_HEADS * NA_DH
ML_W = ML_HEADS * ML_DV
SW_W = SW_HEADS * SW_DH
EVEN_SPLITS = (GLA_HEADS * GLA_DK, GLA_HEADS * GLA_DK, GLA_W, GLA_W, 2 * GLA_RANK, NA_W, NA_W, NA_W, NA_W)
ODD_SPLITS = (ML_HEADS * ML_DQK, ML_HEADS * ML_DQK, ML_W, ML_W, 4 * ML_HEADS, SW_W, SW_KV_HEADS * SW_DH, SW_KV_HEADS * SW_DH, SW_W)
EVEN_IN = sum(EVEN_SPLITS)
ODD_IN = sum(ODD_SPLITS)
EVEN_OUT = GLA_W + NA_W
ODD_OUT = ML_W + SW_W
N_EVEN = (DEPTH + 1) // 2
N_ODD = DEPTH // 2

kernel_name = 'hybrid_gla_natten_mlstm_swa_block'


def split_cols(a, sizes):
    idx = [int(i) for i in np.cumsum(sizes)[:-1]]
    return jnp.split(a, idx, axis=-1)


def heads(a, h):
    b, t, _ = a.shape
    return a.reshape(b, t, h, -1).transpose(0, 2, 1, 3)


def merge(a):
    b, h, t, d = a.shape
    return a.transpose(0, 2, 1, 3).reshape(b, t, h * d)


def layer_norm(x, g, b):
    xf = x.astype(F32)
    mu = jnp.mean(xf, axis=-1, keepdims=True)
    var = jnp.mean(jnp.square(xf - mu), axis=-1, keepdims=True)
    return ((xf - mu) * lax.rsqrt(var + LN_EPS)).astype(x.dtype) * g + b


def head_rmsnorm(o, g):
    of = o.astype(F32)
    of = of * lax.rsqrt(jnp.mean(jnp.square(of), axis=-1, keepdims=True) + NORM_EPS)
    return merge(of.astype(o.dtype)) * g


def to_chunks(a, c):
    s = a.shape
    return jnp.moveaxis(a.reshape(s[:2] + (s[2] // c, c) + s[3:]), 2, 0)


def from_chunks(a):
    a = jnp.moveaxis(a, 0, 2)
    s = a.shape
    return a.reshape(s[:2] + (s[2] * s[3],) + s[4:])


def flip_t(args):
    return tuple(jnp.flip(a, axis=2) for a in args)


def prefix_scan(scan_fn, lat, ctx, state0):
    o_ctx, st = scan_fn(*ctx, state0)
    o_lat, _ = scan_fn(*lat, st)
    return o_lat, o_ctx


def bidir_prefix(scan_fn, lat_f, ctx_f, lat_b, ctx_b, state0):
    lf, cf = prefix_scan(scan_fn, lat_f, ctx_f, state0)
    lb, cb = prefix_scan(scan_fn, flip_t(lat_b), flip_t(ctx_b), state0)
    return lf + jnp.flip(lb, axis=2), cf + jnp.flip(cb, axis=2)


def gla_scan(q, k, v, g, s0):
    out_dtype = v.dtype
    qs, ks, vs, gs = [to_chunks(a.astype(F32), GLA_CHUNK) for a in (q, k, v, g)]
    tril = jnp.tril(jnp.ones((GLA_CHUNK, GLA_CHUNK), bool))

    def body(S, inp):
        qc, kc, vc, gc = inp
        b = jnp.cumsum(gc, axis=2)
        b_last = b[:, :, -1:, :]
        q_in = qc * jnp.exp(b)
        k_in = kc * jnp.exp(-b)
        a = jnp.where(tril, jnp.einsum('bhtd,bhsd->bhts', q_in, k_in), 0.0)
        o = jnp.einsum('bhts,bhsv->bhtv', a, vc) + jnp.einsum('bhtd,bhdv->bhtv', q_in, S)
        S = jnp.exp(b_last)[:, :, 0, :, None] * S + jnp.einsum('bhsd,bhsv->bhdv', kc * jnp.exp(b_last - b), vc)
        return S, o

    S, o = lax.scan(body, s0, (qs, ks, vs, gs))
    return from_chunks(o).astype(out_dtype), S


def mlstm_scan(q, k, v, ig, lf, state):
    out_dtype = v.dtype
    qs, ks, vs, is_, fs = [to_chunks(a.astype(F32), ML_CHUNK) for a in (q, k, v, ig, lf)]
    tril = jnp.tril(jnp.ones((ML_CHUNK, ML_CHUNK), bool))

    def body(st, inp):
        cm, n, m = st
        qc, kc, vc, ic, fc = inp
        b = jnp.cumsum(fc, axis=-1)
        dmat = jnp.where(tril, b[..., :, None] - b[..., None, :] + ic[..., None, :], NEG)
        inter = b + m[..., None]
        m_t = jnp.maximum(jnp.max(dmat, axis=-1), inter)
        w = jnp.exp(dmat - m_t[..., None])
        w_int = jnp.exp(inter - m_t)
        s = jnp.einsum('bhtd,bhsd->bhts', qc, kc) * w
        num = s @ vc + w_int[..., None] * jnp.einsum('bhtd,bhdv->bhtv', qc, cm)
        den = jnp.sum(s, axis=-1) + w_int * jnp.einsum('bhtd,bhd->bht', qc, n)
        h = num / jnp.maximum(jnp.abs(den), jnp.exp(-m_t))[..., None]
        b_last = b[..., -1]
        ws_log = b_last[..., None] - b + ic
        m_new = jnp.maximum(b_last + m, jnp.max(ws_log, axis=-1))
        dec = jnp.exp(b_last + m - m_new)
        ws = jnp.exp(ws_log - m_new[..., None])
        cm = dec[..., None, None] * cm + jnp.einsum('bhs,bhsd,bhsv->bhdv', ws, kc, vc)
        n = dec[..., None] * n + jnp.einsum('bhs,bhsd->bhd', ws, kc)
        return (cm, n, m_new), h

    st, h = lax.scan(body, state, (qs, ks, vs, is_, fs))
    return from_chunks(h).astype(out_dtype), st


def axial_rope(x, rows, cols):
    half = x.shape[-1] // 2
    nf = half // 2
    freqs = ROPE_BASE ** (-jnp.arange(nf, dtype=F32) / nf)

    def rot(xp, pos):
        ang = pos[:, None] * freqs[None, :]
        cos = jnp.cos(ang).astype(x.dtype)
        sin = jnp.sin(ang).astype(x.dtype)
        x1, x2 = xp[..., :nf], xp[..., nf:]
        return jnp.concatenate([x1 * cos - x2 * sin, x1 * sin + x2 * cos], axis=-1)

    return jnp.concatenate([rot(x[..., :half], rows), rot(x[..., half:], cols)], axis=-1)


def dense_attn(q, k, v, sink=None):
    scale = q.shape[-1] ** -0.5
    s = jnp.einsum('bkgld,bksd->bkgls', q, k).astype(F32) * scale
    if sink is None:
        p = jax.nn.softmax(s, axis=-1)
    else:
        s_sink = jnp.broadcast_to(sink.astype(F32)[None, :, :, None, None], s.shape[:-1] + (1,))
        p = jax.nn.softmax(jnp.concatenate([s, s_sink], axis=-1), axis=-1)[..., :-1]
    return jnp.einsum('bkgls,bksd->bkgld', p.astype(v.dtype), v)


def neighbourhood_attn(q, k, v, kc, vc, rpb):
    b, h, t, dh = q.shape
    rows_n = t // GRID_W
    kh = min(NA_KH, rows_n)
    qg, kg, vg = [a.reshape(b, h, rows_n, GRID_W, dh) for a in (q, k, v)]
    cols = jnp.arange(GRID_W)
    cs = jnp.clip(cols - NA_KW // 2, 0, GRID_W - NA_KW)
    col_ok = (cols[None, :] >= cs[:, None]) & (cols[None, :] < cs[:, None] + NA_KW)
    dc_idx = jnp.clip(cols[None, :] - cols[:, None] + NA_KW - 1, 0, 2 * NA_KW - 2)
    scale = dh ** -0.5
    n_lat = kh * GRID_W

    def row(r):
        rs = jnp.clip(r - kh // 2, 0, rows_n - kh)
        q_r = lax.dynamic_index_in_dim(qg, r, axis=2, keepdims=False)
        k_blk = lax.dynamic_slice_in_dim(kg, rs, kh, axis=2)
        v_blk = lax.dynamic_slice_in_dim(vg, rs, kh, axis=2)
        dr_idx = rs + jnp.arange(kh) - r + NA_KH - 1
        bias = rpb[:, dr_idx[:, None, None], dc_idx[None, :, :]].transpose(0, 2, 1, 3)
        s_lat = jnp.einsum('bhqd,bhiwd->bhqiw', q_r, k_blk).astype(F32) * scale + bias.astype(F32)[None]
        s_lat = jnp.where(col_ok[:, None, :], s_lat, NEG).reshape(b, h, GRID_W, n_lat)
        s_ctx = jnp.einsum('bhqd,bhcd->bhqc', q_r, kc).astype(F32) * scale
        p = jax.nn.softmax(jnp.concatenate([s_lat, s_ctx], axis=-1), axis=-1)
        p_lat = p[..., :n_lat].reshape(b, h, GRID_W, kh, GRID_W).astype(v.dtype)
        p_ctx = p[..., n_lat:].astype(v.dtype)
        return jnp.einsum('bhqiw,bhiwd->bhqd', p_lat, v_blk) + jnp.einsum('bhqc,bhcd->bhqd', p_ctx, vc)

    o = lax.map(row, jnp.arange(rows_n))
    return jnp.moveaxis(o, 0, 2).reshape(b, h, t, dh)


def swa_attn(q, k, v, kc, vc, sink):
    b, h, t, dh = q.shape
    kv = k.shape[1]
    g = h // kv
    n_ctx = kc.shape[2]
    qg = q.reshape(b, kv, g, t, dh)
    nb = t // SW_BLOCK
    span = SW_BLOCK + 2 * SW_WINDOW
    pad = ((0, 0), (0, 0), (SW_WINDOW, SW_WINDOW), (0, 0))
    k_pad = jnp.pad(k, pad)
    v_pad = jnp.pad(v, pad)
    sink_f = sink.reshape(kv, g).astype(F32)
    scale = dh ** -0.5

    def block(n):
        start = n * SW_BLOCK
        q_b = lax.dynamic_slice_in_dim(qg, start, SW_BLOCK, axis=3)
        k_w = lax.dynamic_slice_in_dim(k_pad, start, span, axis=2)
        v_w = lax.dynamic_slice_in_dim(v_pad, start, span, axis=2)
        qpos = start + jnp.arange(SW_BLOCK)
        kpos = start - SW_WINDOW + jnp.arange(span)
        ok = (jnp.abs(qpos[:, None] - kpos[None, :]) <= SW_WINDOW) & (kpos[None, :] >= 0) & (kpos[None, :] < t)
        s_lat = jnp.where(ok, jnp.einsum('bkgqd,bksd->bkgqs', q_b, k_w).astype(F32) * scale, NEG)
        s_ctx = jnp.einsum('bkgqd,bkcd->bkgqc', q_b, kc).astype(F32) * scale
        s_sink = jnp.broadcast_to(sink_f[None, :, :, None, None], s_ctx.shape[:-1] + (1,))
        p = jax.nn.softmax(jnp.concatenate([s_lat, s_ctx, s_sink], axis=-1), axis=-1).astype(v.dtype)
        return (jnp.einsum('bkgqs,bksd->bkgqd', p[..., :span], v_w)
                + jnp.einsum('bkgqc,bkcd->bkgqd', p[..., span:span + n_ctx], vc))

    o = lax.map(block, jnp.arange(nb))
    return jnp.moveaxis(o, 0, 3).reshape(b, h, t, dh)


def mixer_even(h, hc, w_in, w_out, gla_gate_w, gla_gate_b, gla_norm_g, na_rpb, need_ctx):
    pl = split_cols(h @ w_in, EVEN_SPLITS)
    pc = split_cols(hc @ w_in, EVEN_SPLITS)
    bsz = h.shape[0]

    def gla_inputs(parts):
        qa, ka, va, _, lra = parts[:5]
        q = heads(qa, GLA_HEADS) * (GLA_DK ** -0.5)
        k = heads(ka, GLA_HEADS)
        v = heads(va, GLA_HEADS)
        lr = lra.reshape(lra.shape[:-1] + (2, GLA_RANK))
        z = jnp.einsum('btdr,drk->btdk', lr, gla_gate_w) + gla_gate_b
        g = jax.nn.log_sigmoid(z.astype(F32)) / GLA_TAU
        return (q, k, v, heads(g[:, :, 0], GLA_HEADS)), (q, k, v, heads(g[:, :, 1], GLA_HEADS))

    lat_f, lat_b = gla_inputs(pl)
    ctx_f, ctx_b = gla_inputs(pc)
    s0 = jnp.zeros((bsz, GLA_HEADS, GLA_DK, GLA_DV), F32)
    oa_lat, oa_ctx = bidir_prefix(gla_scan, lat_f, ctx_f, lat_b, ctx_b, s0)
    ya = head_rmsnorm(oa_lat, gla_norm_g) * jax.nn.silu(pl[3])

    kbc = heads(pc[6], NA_HEADS)
    vbc = heads(pc[7], NA_HEADS)
    ob = neighbourhood_attn(heads(pl[5], NA_HEADS), heads(pl[6], NA_HEADS), heads(pl[7], NA_HEADS), kbc, vbc, na_rpb)
    yb = merge(ob) * jax.nn.silu(pl[8])
    y_lat = jnp.concatenate([ya, yb], axis=-1) @ w_out
    if not need_ctx:
        return y_lat, None
    ya_c = head_rmsnorm(oa_ctx, gla_norm_g) * jax.nn.silu(pc[3])
    ob_c = dense_attn(heads(pc[5], NA_HEADS)[:, :, None], kbc, vbc)[:, :, 0]
    yb_c = merge(ob_c) * jax.nn.silu(pc[8])
    y_ctx = jnp.concatenate([ya_c, yb_c], axis=-1) @ w_out
    return y_lat, y_ctx


def mixer_odd(h, hc, w_in, w_out, ml_gate_b, ml_norm_g, sw_sink, need_ctx):
    pl = split_cols(h @ w_in, ODD_SPLITS)
    pc = split_cols(hc @ w_in, ODD_SPLITS)
    bsz, t, _ = h.shape

    def mlstm_inputs(parts):
        qm, km, vm, _, gates = parts[:5]
        q = heads(qm, ML_HEADS)
        k = heads(km, ML_HEADS) * (ML_DQK ** -0.5)
        v = heads(vm, ML_HEADS)
        gp = gates.reshape(gates.shape[:2] + (2, 2, ML_HEADS)).astype(F32) + ml_gate_b.astype(F32)
        gp = gp.transpose(2, 3, 0, 4, 1)
        return ((q, k, v, gp[0, 0], jax.nn.log_sigmoid(gp[0, 1])),
                (q, k, v, gp[1, 0], jax.nn.log_sigmoid(gp[1, 1])))

    lat_f, lat_b = mlstm_inputs(pl)
    ctx_f, ctx_b = mlstm_inputs(pc)
    st0 = (jnp.zeros((bsz, ML_HEADS, ML_DQK, ML_DV), F32), jnp.zeros((bsz, ML_HEADS, ML_DQK), F32),
           jnp.zeros((bsz, ML_HEADS), F32))
    oc_lat, oc_ctx = bidir_prefix(mlstm_scan, lat_f, ctx_f, lat_b, ctx_b, st0)
    yc = head_rmsnorm(oc_lat, ml_norm_g) * jax.nn.silu(pl[3])

    pos = jnp.arange(t)
    rows = (pos // GRID_W).astype(F32)
    cols = (pos % GRID_W).astype(F32)
    qd = axial_rope(heads(pl[5], SW_HEADS), rows, cols)
    kd = axial_rope(heads(pl[6], SW_KV_HEADS), rows, cols)
    vd = heads(pl[7], SW_KV_HEADS)
    kdc = heads(pc[6], SW_KV_HEADS)
    vdc = heads(pc[7], SW_KV_HEADS)
    od = swa_attn(qd, kd, vd, kdc, vdc, sw_sink)
    yd = merge(od) * jax.nn.silu(pl[8])
    y_lat = jnp.concatenate([yc, yd], axis=-1) @ w_out
    if not need_ctx:
        return y_lat, None
    yc_c = head_rmsnorm(oc_ctx, ml_norm_g) * jax.nn.silu(pc[3])
    n_ctx = hc.shape[1]
    qdc = heads(pc[5], SW_HEADS).reshape(bsz, SW_KV_HEADS, SW_HEADS // SW_KV_HEADS, n_ctx, SW_DH)
    od_c = dense_attn(qdc, kdc, vdc, sw_sink.reshape(SW_KV_HEADS, SW_HEADS // SW_KV_HEADS))
    yd_c = merge(od_c.reshape(bsz, SW_HEADS, n_ctx, SW_DH)) * jax.nn.silu(pc[8])
    y_ctx = jnp.concatenate([yc_c, yd_c], axis=-1) @ w_out
    return y_lat, y_ctx


def setup_inputs(seed: int = 0) -> dict:
    key = jax.random.key(seed)
    ks = jax.random.split(key, 20)

    def nrm(k, shape, scale):
        return jax.random.normal(k, shape, F32) * scale

    ml_base = jnp.stack([jnp.full((ML_HEADS,), -1.0, F32), jnp.linspace(3.0, 6.0, ML_HEADS, dtype=F32)])
    return {
        'x': nrm(ks[0], (BATCH, SEQ, D_MODEL), 1.0),
        'c': nrm(ks[1], (BATCH, D_MODEL), 1.0),
        'ctx': nrm(ks[2], (BATCH, CTX_LEN, D_MODEL), 1.0),
        'c_ctx': nrm(ks[3], (D_MODEL,), 1.0),
        'w_ada': nrm(ks[4], (DEPTH, D_MODEL, 3 * D_MODEL), 0.5 * D_MODEL ** -0.5),
        'b_ada': nrm(ks[5], (DEPTH, 3 * D_MODEL), 0.02),
        'ln_g': 1.0 + nrm(ks[6], (DEPTH, D_MODEL), 0.02),
        'ln_b': nrm(ks[7], (DEPTH, D_MODEL), 0.02),
        'w_in_even': nrm(ks[8], (N_EVEN, D_MODEL, EVEN_IN), D_MODEL ** -0.5),
        'w_out_even': nrm(ks[9], (N_EVEN, EVEN_OUT, D_MODEL), BETA * EVEN_OUT ** -0.5),
        'gla_gate_w': nrm(ks[10], (N_EVEN, 2, GLA_RANK, GLA_HEADS * GLA_DK), GLA_RANK ** -0.5),
        'gla_gate_b': 2.0 + nrm(ks[11], (N_EVEN, 2, GLA_HEADS * GLA_DK), 0.1),
        'gla_norm_g': 1.0 + nrm(ks[12], (N_EVEN, GLA_W), 0.02),
        'na_rpb': nrm(ks[13], (N_EVEN, NA_HEADS, 2 * NA_KH - 1, 2 * NA_KW - 1), 0.1),
        'w_in_odd': nrm(ks[14], (N_ODD, D_MODEL, ODD_IN), D_MODEL ** -0.5),
        'w_out_odd': nrm(ks[15], (N_ODD, ODD_OUT, D_MODEL), BETA * ODD_OUT ** -0.5),
        'ml_gate_b': ml_base[None, None] + nrm(ks[16], (N_ODD, 2, 2, ML_HEADS), 0.1),
        'ml_norm_g': 1.0 + nrm(ks[17], (N_ODD, ML_W), 0.02),
        'sw_sink': nrm(ks[18], (N_ODD, SW_HEADS), 0.5),
    }


def reference(x, c, ctx, c_ctx, w_ada, b_ada, ln_g, ln_b, w_in_even, w_out_even, gla_gate_w, gla_gate_b,
              gla_norm_g, na_rpb, w_in_odd, w_out_odd, ml_gate_b, ml_norm_g, sw_sink):
    cond = jax.nn.silu(c)
    cond_ctx = jax.nn.silu(c_ctx)
    cx = ctx
    for l in range(DEPTH):
        need_ctx = l < DEPTH - 1
        shift, scale, gate = jnp.split(cond @ w_ada[l] + b_ada[l], 3, axis=-1)
        shift_c, scale_c, gate_c = jnp.split(cond_ctx @ w_ada[l] + b_ada[l], 3, axis=-1)
        h = x * (1.0 + scale[:, None]) + shift[:, None]
        hc = cx * (1.0 + scale_c) + shift_c
        i = l // 2
        if l % 2 == 0:
            y, yc = mixer_even(h, hc, w_in_even[i], w_out_even[i], gla_gate_w[i], gla_gate_b[i],
                               gla_norm_g[i], na_rpb[i], need_ctx)
        else:
            y, yc = mixer_odd(h, hc, w_in_odd[i], w_out_odd[i], ml_gate_b[i], ml_norm_g[i], sw_sink[i], need_ctx)
        x = layer_norm(ALPHA * x + gate[:, None] * y, ln_g[l], ln_b[l])
        if need_ctx:
            cx = layer_norm(ALPHA * cx + gate_c * yc, ln_g[l], ln_b[l])
    return x
```

```cpp
#include <hip/hip_runtime.h>
#include <hip/hip_cooperative_groups.h>
#include <cstdio>
#include <cstdint>
namespace cg = cooperative_groups;
__device__ __forceinline__ int otid() { int t = threadIdx.x; asm volatile("" : "+v"(t)); return t; }
namespace pg8 {
#define PG8_LAS __attribute__((address_space(3)))
typedef unsigned short bf16_t;
typedef short bf16x8 __attribute__((ext_vector_type(8)));
typedef float f32x4 __attribute__((ext_vector_type(4)));
typedef unsigned u32x4 __attribute__((ext_vector_type(4)));
constexpr int BM = 256, BK = 64, HALF = 128, HTB = HALF * BK * 2  , STAGE_BYTES = 8 * HTB, NXCD = 8, WGM = 8;

__host__ __device__ __forceinline__ int lds_byte(int r, int c) { const int st = (r >> 4) * 2 + (c >> 5), rr = r & 15, cc = c & 31, ob = rr * 64 + cc * 2; return st * 1024 + (ob ^ (((ob >> 9) & 1) << 5)); }
__host__ __device__ __forceinline__ void stage_rc(int b, int& R, int& C) { const int st = b / 1024, sb = b % 1024, swz = sb ^ (((sb >> 9) & 1) << 5); R = (st >> 1) * 16 + swz / 64; C = (st & 1) * 32 + (swz % 64) / 2; }
__host__ __device__ __forceinline__ int perm32(int rho) { const int n = rho >> 4, i = rho & 15; return 8 * (i >> 2) + 4 * n + (i & 3); }

struct Unit { int pm, pn; };
struct Gemm { const bf16_t* A; const bf16_t* Bt; int M, N, K; };

struct StaticOrder {
    int nM, nN, nwg, G, c;
    __host__ __device__ void init(int M, int N, int G_, int c_) { nM = M / BM; nN = N / BM; nwg = nM * nN; G = G_; c = c_; }
    __host__ __device__ bool next(int i, Unit& u) const {
        const long L = (long)i * G + c; if (L >= nwg) return false;
        int wgid = (int)L; { const int q = nwg / NXCD, r = nwg % NXCD, xcd = wgid % NXCD, off = wgid / NXCD; wgid = (xcd < r ? xcd * (q + 1) : r * (q + 1) + (xcd - r) * q) + off; }
        const int nig = WGM * nN, gid = wgid / nig, fm = gid * WGM, gsz = (nM - fm) < WGM ? (nM - fm) : WGM;
        u.pm = fm + ((wgid % nig) % gsz); u.pn = (wgid % nig) / gsz; return true;
    }
    __device__ __forceinline__ void a_ready(const Unit&) const {}
    __device__ __forceinline__ void done(const Unit&) const {}
};

__device__ __forceinline__ unsigned cvt_pk_bf16(float lo, float hi) { unsigned r; asm volatile("v_cvt_pk_bf16_f32 %0, %1, %2" : "=v"(r) : "v"(lo), "v"(hi)); return r; }
struct EpiProj {
    static constexpr bool PERM = true, AFTER_DRAIN = false;
    bf16_t* P; int ldp; float* SM; int nsm; int last_pn; int rope; const float* cosT; const float* sinT;
    __device__ __forceinline__ void operator()(const f32x4 (&acc)[2][2][4][2], const Unit& u, int wr, int wc, int fr, int fq) const {
        const int row0 = u.pm * BM + wr * 64 + fr;
        if (u.pn == last_pn) {
            if (wc == 0) {
#pragma unroll
                for (int ai = 0; ai < 2; ++ai)
#pragma unroll
                    for (int m = 0; m < 4; ++m) { const int row = row0 + ai * HALF + m * 16;
#pragma unroll
                        for (int n = 0; n < 2; ++n) { const int col = 8 * fq + 4 * n; if (col < nsm) *(f32x4*)(SM + (size_t)row * 32 + col) = acc[ai][0][m][n]; } }
            }
            return;
        }
        const bool do_rope_tile = rope && (u.pn == 6 || u.pn == 7 || u.pn == 8) && (u.pm * BM < 32768);
#pragma unroll
        for (int ai = 0; ai < 2; ++ai)
#pragma unroll
            for (int m = 0; m < 4; ++m) { const int row = row0 + ai * HALF + m * 16; bf16_t* rowp = P + (size_t)row * ldp + u.pn * BM + wc * 32 + 8 * fq;
#pragma unroll
                for (int bj = 0; bj < 2; ++bj) { f32x4 v0 = acc[ai][bj][m][0], v1 = acc[ai][bj][m][1];
                    if (do_rope_tile && (u.pn != 8 || bj == 0)) {
                        const int t = row & 4095; const int pos = (wc & 1) ? (t & 63) : (t >> 6); const int i0 = pos * 16 + 8 * (fq & 1);
                        const f32x4 c0 = *(const f32x4*)(cosT + i0), c1 = *(const f32x4*)(cosT + i0 + 4), s0 = *(const f32x4*)(sinT + i0), s1 = *(const f32x4*)(sinT + i0 + 4);
                        f32x4 p0, p1;
#pragma unroll
                        for (int e = 0; e < 4; ++e) { p0[e] = __shfl_xor(v0[e], 32); p1[e] = __shfl_xor(v1[e], 32); }
                        if (fq < 2) { v0 = v0 * c0 - p0 * s0; v1 = v1 * c1 - p1 * s1; } else { v0 = p0 * s0 + v0 * c0; v1 = p1 * s1 + v1 * c1; }
                    }
                    u32x4 w; w.x = cvt_pk_bf16(v0[0], v0[1]); w.y = cvt_pk_bf16(v0[2], v0[3]); w.z = cvt_pk_bf16(v1[0], v1[1]); w.w = cvt_pk_bf16(v1[2], v1[3]);
                    *(u32x4*)(rowp + bj * HALF) = w; } }
    }
};
template <class Epi, class Sched, bool ALIGN_EPI = false, bool SP2 = false>
__device__ __forceinline__ void gemm_phase(PG8_LAS unsigned char* lds, const Gemm g, const Sched& S, const Epi& E) {
    const int tid = otid(), wid = __builtin_amdgcn_readfirstlane(tid >> 6), lane = tid & 63, wr = wid >> 2, wc = wid & 3, fr = lane & 15, fq = lane >> 4;
    const int K = g.K, nt = K / BK;
    unsigned voffA[2], voffB[2];
#pragma unroll
    for (int i = 0; i < 2; ++i) { int R, C; stage_rc(tid * 16 + i * 8192, R, C); const int Rb = Epi::PERM ? ((R & ~31) + perm32(R & 31)) : R;
        voffA[i] = (unsigned)(R * K + C) * 2u; voffB[i] = (unsigned)(Rb * K + C) * 2u; }
    const size_t kstep = (size_t)(BK * 2);
    const size_t hstep = (size_t)HALF * K * 2;
    const size_t tstep = 2 * hstep;
    const unsigned ldsw = (unsigned)wid * 1024u;
    const int aoff = lds_byte(wr * 64 + fr, fq * 8), boff = lds_byte(wc * 32 + fr, fq * 8);
#define PG8_SA(b, h) (((b) * 2 + (h)) * HTB)
#define PG8_SB(b, h) ((4 + (b) * 2 + (h)) * HTB)
#define PG8_STAGE(bufoff, gbase, voff) do { _Pragma("unroll") for (int _i = 0; _i < 2; ++_i) \
        __builtin_amdgcn_global_load_lds((const unsigned*)((const char*)(gbase) + (voff)[_i]), (PG8_LAS unsigned*)(lds + (bufoff) + ldsw + _i * 8192), 16, 0, 0); } while (0)
#define PG8_LDA(dst, b, h) do { _Pragma("unroll") for (int m = 0; m < 4; ++m) _Pragma("unroll") for (int k = 0; k < 2; ++k) dst[m][k] = *(const PG8_LAS bf16x8*)(lds + PG8_SA(b, h) + aoff + m * 2048 + k * 1024); } while (0)
#define PG8_LDB(dst, b, h) do { _Pragma("unroll") for (int n = 0; n < 2; ++n) _Pragma("unroll") for (int k = 0; k < 2; ++k) dst[n][k] = *(const PG8_LAS bf16x8*)(lds + PG8_SB(b, h) + boff + n * 2048 + k * 1024); } while (0)
#define PG8_MMA(ai, bj, At, Bt) do { __builtin_amdgcn_s_setprio(1); _Pragma("unroll") for (int m = 0; m < 4; ++m) _Pragma("unroll") for (int n = 0; n < 2; ++n) _Pragma("unroll") for (int k = 0; k < 2; ++k) \
        acc[ai][bj][m][n] = __builtin_amdgcn_mfma_f32_16x16x32_bf16(Bt[n][k], At[m][k], acc[ai][bj][m][n], 0, 0, 0); __builtin_amdgcn_s_setprio(0); } while (0)
#define PG8_WAIT_V(n) asm volatile("s_waitcnt vmcnt(" #n ")" ::: "memory")
#define PG8_WAIT_L(n) asm volatile("s_waitcnt lgkmcnt(" #n ")" ::: "memory")
#define PG8_BAR __builtin_amdgcn_s_barrier()
#define PG8_SCHED __builtin_amdgcn_sched_barrier(0)
    Unit cur, nxt; int ui = 0;
    if (!S.next(0, cur)) return;
    f32x4 acc[2][2][4][2];
#pragma unroll
    for (int a = 0; a < 2; ++a)
#pragma unroll
        for (int b = 0; b < 2; ++b)
#pragma unroll
            for (int m = 0; m < 4; ++m)
#pragma unroll
                for (int n = 0; n < 2; ++n) acc[a][b][m][n] = (f32x4){0.f, 0.f, 0.f, 0.f};
    bf16x8 At[4][2], B0[2][2], B1[2][2];
    const char* cA = (const char*)g.A + (size_t)cur.pm * tstep; const char* cB = (const char*)g.Bt + (size_t)cur.pn * tstep;
    S.a_ready(cur);
    if constexpr (SP2) {
        PG8_STAGE(PG8_SB(0, 0), cB, voffB); PG8_STAGE(PG8_SB(0, 1), cB + hstep, voffB); PG8_STAGE(PG8_SA(0, 0), cA, voffA); PG8_STAGE(PG8_SA(0, 1), cA + hstep, voffA);
        if (wr == 1) PG8_BAR;
        PG8_WAIT_V(2); PG8_BAR;
        PG8_STAGE(PG8_SB(1, 0), cB + kstep, voffB); PG8_STAGE(PG8_SA(1, 0), cA + kstep, voffA); PG8_STAGE(PG8_SB(1, 1), cB + hstep + kstep, voffB);
        PG8_WAIT_V(6); PG8_BAR;
    } else {
        PG8_STAGE(PG8_SB(0, 0), cB, voffB); PG8_STAGE(PG8_SA(0, 0), cA, voffA); PG8_STAGE(PG8_SB(0, 1), cB + hstep, voffB); PG8_STAGE(PG8_SA(0, 1), cA + hstep, voffA);
        if (wr == 1) PG8_BAR;
        PG8_WAIT_V(4); PG8_BAR;
        PG8_STAGE(PG8_SB(1, 0), cB + kstep, voffB); PG8_STAGE(PG8_SA(1, 0), cA + kstep, voffA); PG8_STAGE(PG8_SB(1, 1), cB + hstep + kstep, voffB);
        PG8_WAIT_V(6); PG8_BAR;
    }
    for (;;) {
        const bool has_next = S.next(ui + 1, nxt);
        const char* nA = has_next ? (const char*)g.A + (size_t)nxt.pm * tstep : cA; const char* nB = has_next ? (const char*)g.Bt + (size_t)nxt.pn * tstep : cB;
        for (int t = 0; t < nt; t += 2) {
            const bool last = (t == nt - 2);
            const char* a1 = cA + (size_t)(t + 1) * kstep;
            const char* a2 = last ? nA : cA + (size_t)(t + 2) * kstep; const char* b2 = last ? nB : cB + (size_t)(t + 2) * kstep;
            const char* a3 = a2 + kstep; const char* b3 = b2 + kstep;
            if (last && has_next) S.a_ready(nxt);
            if constexpr (SP2) {
            PG8_LDB(B0, 0, 0); PG8_LDB(B1, 0, 1); PG8_SCHED; PG8_LDA(At, 0, 0); PG8_STAGE(PG8_SA(1, 1), a1 + hstep, voffA);
            PG8_WAIT_V(8); PG8_WAIT_L(0); PG8_BAR; PG8_MMA(0, 0, At, B0); PG8_MMA(0, 1, At, B1); PG8_BAR; PG8_SCHED;
            PG8_LDA(At, 0, 1); PG8_STAGE(PG8_SB(0, 0), b2, voffB); PG8_STAGE(PG8_SB(0, 1), b2 + hstep, voffB); PG8_STAGE(PG8_SA(0, 0), a2, voffA);
            PG8_WAIT_V(8); PG8_WAIT_L(0); PG8_BAR; PG8_MMA(1, 0, At, B0); PG8_MMA(1, 1, At, B1); PG8_BAR; PG8_SCHED;
            PG8_LDB(B0, 1, 0); PG8_LDB(B1, 1, 1); PG8_SCHED; PG8_LDA(At, 1, 0); PG8_STAGE(PG8_SA(0, 1), a2 + hstep, voffA);
            PG8_WAIT_V(8); PG8_WAIT_L(0); PG8_BAR; PG8_MMA(0, 0, At, B0); PG8_MMA(0, 1, At, B1); PG8_BAR; PG8_SCHED;
            PG8_LDA(At, 1, 1); PG8_STAGE(PG8_SB(1, 0), b3, voffB); PG8_STAGE(PG8_SB(1, 1), b3 + hstep, voffB); PG8_STAGE(PG8_SA(1, 0), a3, voffA);
            PG8_WAIT_V(8); PG8_WAIT_L(0); PG8_BAR; PG8_MMA(1, 0, At, B0); PG8_MMA(1, 1, At, B1); PG8_BAR; PG8_SCHED;
            } else {
            PG8_LDB(B0, 0, 0); PG8_SCHED; PG8_LDA(At, 0, 0); PG8_STAGE(PG8_SA(1, 1), a1 + hstep, voffA);
            PG8_WAIT_L(8); PG8_BAR; PG8_WAIT_L(0); PG8_MMA(0, 0, At, B0); PG8_BAR; PG8_SCHED;
            PG8_LDB(B1, 0, 1); PG8_STAGE(PG8_SB(0, 0), b2, voffB);
            PG8_BAR; PG8_WAIT_L(0); PG8_MMA(0, 1, At, B1); PG8_BAR;
            PG8_LDA(At, 0, 1); PG8_STAGE(PG8_SA(0, 0), a2, voffA);
            PG8_BAR; PG8_WAIT_L(0); PG8_MMA(1, 0, At, B0); PG8_BAR; PG8_SCHED;
            PG8_STAGE(PG8_SB(0, 1), b2 + hstep, voffB);
            PG8_WAIT_V(6); PG8_BAR; PG8_MMA(1, 1, At, B1); PG8_BAR;
            PG8_LDB(B0, 1, 0); PG8_SCHED; PG8_LDA(At, 1, 0); PG8_STAGE(PG8_SA(0, 1), a2 + hstep, voffA);
            PG8_WAIT_L(8); PG8_BAR; PG8_WAIT_L(0); PG8_MMA(0, 0, At, B0); PG8_BAR; PG8_SCHED;
            PG8_LDB(B1, 1, 1); PG8_STAGE(PG8_SB(1, 0), b3, voffB);
            PG8_BAR; PG8_WAIT_L(0); PG8_MMA(0, 1, At, B1); PG8_BAR;
            PG8_LDA(At, 1, 1); PG8_STAGE(PG8_SA(1, 0), a3, voffA);
            PG8_BAR; PG8_WAIT_L(0); PG8_MMA(1, 0, At, B0); PG8_BAR; PG8_SCHED;
            PG8_STAGE(PG8_SB(1, 1), b3 + hstep, voffB);
            PG8_WAIT_V(6); PG8_BAR; PG8_MMA(1, 1, At, B1); PG8_BAR;
            }
        }
        if constexpr (ALIGN_EPI) { if (wr == 0) PG8_BAR; }
        if constexpr (!Epi::AFTER_DRAIN) { E(acc, cur, wr, wc, fr, fq); S.done(cur); }
        if (!has_next) break;
#pragma unroll
        for (int a = 0; a < 2; ++a)
#pragma unroll
            for (int b = 0; b < 2; ++b)
#pragma unroll
                for (int m = 0; m < 4; ++m)
#pragma unroll
                    for (int n = 0; n < 2; ++n) acc[a][b][m][n] = (f32x4){0.f, 0.f, 0.f, 0.f};
        cur = nxt; cA = nA; cB = nB; ++ui;
        if constexpr (ALIGN_EPI) { if (wr == 1) PG8_BAR; }
    }
    PG8_WAIT_V(0);
    if constexpr (!ALIGN_EPI) { if (wr == 0) PG8_BAR; }
    PG8_BAR;
    if constexpr (Epi::AFTER_DRAIN) { E.fused(acc, cur, wr, wc, fr, fq, lds, wid, lane); S.done(cur); }
#undef PG8_SA
#undef PG8_SB
#undef PG8_STAGE
#undef PG8_LDA
#undef PG8_LDB
#undef PG8_MMA
#undef PG8_WAIT_V
#undef PG8_WAIT_L
#undef PG8_BAR
#undef PG8_SCHED
}
}
constexpr int NWAVES = 8, NTHR = 512;
constexpr int BATCH = 8, SEQ = 4096, DM = 1024, CTXL = 256, DEPTH = 4;
constexpr int MLAT = BATCH * SEQ, MCTX = BATCH * CTXL, MTOT = MLAT + MCTX;
constexpr int NP_EVEN = 3584, NPAD_EVEN = 3840, NORIG_EVEN = 3616;
constexpr int NP_ODD = 2816, NPAD_ODD = 3072, NORIG_ODD = 2832;
constexpr int NCHUNK = 68;
constexpr int NSLOT = BATCH * 4 * 2 * NCHUNK;
constexpr float ALPHA_DN = 1.681792830507429f;
constexpr size_t MiB = 1u << 20;
constexpr size_t WS_MOD = 0;
constexpr size_t WS_ROPE = 1 * MiB;
constexpr size_t WS_SC = WS_ROPE + 65536;
constexpr size_t WS_GAM = 2 * MiB;
constexpr size_t WS_SM = 4 * MiB;
constexpr size_t WS_WIE = 9 * MiB;
constexpr size_t WS_WIO = 24 * MiB;
constexpr size_t WS_WO = 36 * MiB;
constexpr size_t WS_XC = 44 * MiB;
constexpr size_t WS_H = 52 * MiB;
constexpr size_t WS_P = 120 * MiB;
constexpr size_t WS_S = 359 * MiB;
constexpr size_t WS_END = WS_S + (size_t)NSLOT * 8192 * 4;
static_assert(WS_SC + (size_t)NSLOT * 16 <= WS_GAM && WS_GAM + (size_t)NSLOT * 256 <= WS_SM && WS_SM + (size_t)MTOT * 128 <= WS_WIE, "ws map 1");
static_assert(WS_WIE + (size_t)2 * NPAD_EVEN * 1024 * 2 <= WS_WIO && WS_WIO + (size_t)2 * NPAD_ODD * 1024 * 2 <= WS_WO && WS_WO + (size_t)4 * 1024 * 1024 * 2 <= WS_XC, "ws map 2");
static_assert(WS_XC + (size_t)MCTX * 1024 * 4 <= WS_H && WS_H + (size_t)MTOT * 1024 * 2 <= WS_P && WS_P + (size_t)MTOT * NP_EVEN * 2 <= WS_S && WS_END <= 512 * MiB, "ws map 3");
constexpr int LDS_BYTES = 147456;

#define LAS __attribute__((address_space(3)))
typedef unsigned short bf16;
typedef float f32x4 __attribute__((ext_vector_type(4)));
typedef short bf16x8 __attribute__((ext_vector_type(8)));
typedef short s16x4 __attribute__((ext_vector_type(4)));
typedef unsigned u32x4 __attribute__((ext_vector_type(4)));
typedef unsigned u32x2 __attribute__((ext_vector_type(2)));
#define LDS_WAIT() asm volatile("s_waitcnt lgkmcnt(0)" ::: "memory")

__device__ __forceinline__ unsigned f2bf(float f) { unsigned u = __builtin_bit_cast(unsigned, f); return (u + 0x7fffu + ((u >> 16) & 1u)) >> 16; }
__device__ __forceinline__ unsigned pk2(float lo, float hi) { return f2bf(lo) | (f2bf(hi) << 16); }
__device__ __forceinline__ float bf2f(unsigned short v) { return __builtin_bit_cast(float, (unsigned)v << 16); }
__device__ __forceinline__ float bflo(unsigned w) { return __builtin_bit_cast(float, w << 16); }
__device__ __forceinline__ float bfhi(unsigned w) { return __builtin_bit_cast(float, w & 0xffff0000u); }
__device__ __forceinline__ float siluf(float x) { return x / (1.f + __expf(-x)); }
__device__ __forceinline__ float logsigf(float z) { return fminf(z, 0.f) - log1pf(__expf(-fabsf(z))); }
__device__ __forceinline__ float red16_max(float v) { v = fmaxf(v, __shfl_xor(v, 1)); v = fmaxf(v, __shfl_xor(v, 2)); v = fmaxf(v, __shfl_xor(v, 4)); v = fmaxf(v, __shfl_xor(v, 8)); return v; }
__device__ __forceinline__ float red16_sum(float v) { v += __shfl_xor(v, 1); v += __shfl_xor(v, 2); v += __shfl_xor(v, 4); v += __shfl_xor(v, 8); return v; }
__device__ __forceinline__ float wave_sum(float v) {
#pragma unroll
    for (int o = 1; o < 64; o <<= 1) v += __shfl_xor(v, o);
    return v;
}
__device__ __forceinline__ float wave_max(float v) {
#pragma unroll
    for (int o = 1; o < 64; o <<= 1) v = fmaxf(v, __shfl_xor(v, o));
    return v;
}
#define MFMA(a, b, c) __builtin_amdgcn_mfma_f32_16x16x32_bf16((a), (b), (c), 0, 0, 0)
__device__ __forceinline__ bf16x8 frag_rm(const LAS bf16* X, int ld, int row0, int k0, int lane) {
    return *(const LAS bf16x8*)(X + (row0 + (lane & 15)) * ld + k0 + 8 * (lane >> 4));
}
__device__ __forceinline__ bf16x8 frag_tr(const LAS bf16* X, int ld, int k0, int n0, int lane) {
    const int g = lane >> 4, m = lane & 15, q = m >> 2, p = m & 3;
    const LAS bf16* a0 = X + (k0 + 8 * g + q) * ld + n0 + 4 * p;
    const s16x4 lo = __builtin_amdgcn_ds_read_tr16_b64_v4i16((LAS s16x4*)a0);
    const s16x4 hi = __builtin_amdgcn_ds_read_tr16_b64_v4i16((LAS s16x4*)(a0 + 4 * ld));
    bf16x8 r; r[0] = lo[0]; r[1] = lo[1]; r[2] = lo[2]; r[3] = lo[3]; r[4] = hi[0]; r[5] = hi[1]; r[6] = hi[2]; r[7] = hi[3]; return r;
}

struct Params {
    const float *x, *c, *ctx, *c_ctx, *w_ada, *b_ada, *ln_g, *ln_b, *w_in_even, *w_out_even, *gla_gate_w, *gla_gate_b, *gla_norm_g, *na_rpb, *w_in_odd, *w_out_odd, *ml_gate_b, *ml_norm_g, *sw_sink;
    float* out; unsigned char* ws; long long ph_lo, ph_hi;
};
typedef const __attribute__((address_space(4))) Params* KP;
__device__ __forceinline__ KP kparams() { unsigned long long v = (unsigned long long)__builtin_amdgcn_kernarg_segment_ptr(); asm volatile("" : "+s"(v)); return (KP)v; }

__device__ __forceinline__ int orig_col(int type, int n) {
    if (type == 0) { if (n < 1536) return n; if (n < 3584) return n + 32; if (n < 3616) return n - 3584 + 1536; return -1; }
    if (type == 1) { if (n < 1536) return n; if (n < 2816) return n + 16; if (n < 2832) return n - 2816 + 1536; return -1; }
    return n;
}
__device__ __forceinline__ float col_scale(int type, int n) {
    if (type == 0) return (n < 256 || (n >= 1536 && n < 2048)) ? 0.125f : 1.f;
    if (type == 1) return ((n >= 256 && n < 512) || (n >= 1536 && n < 2048)) ? 0.125f : 1.f;
    return 1.f;
}
__device__ __forceinline__ void p0_transpose_item(const float* __restrict__ W, int K, int Norig, int type, bf16* __restrict__ WT, LAS float* scr, int nblk, int item, int lane) {
    const int kb = item / nblk, nb = item % nblk, k0 = 64 * kb, n0 = 32 * nb;
    const int oc = orig_col(type, n0 + (lane & 31)); const float sc = col_scale(type, n0 + (lane & 31));
#pragma unroll 8
    for (int i = 0; i < 32; ++i) { const int kk = 2 * i + (lane >> 5); scr[kk * 33 + (lane & 31)] = oc >= 0 ? W[(size_t)(k0 + kk) * Norig + oc] * sc : 0.f; }
    LDS_WAIT();
    const int c = lane & 7;
#pragma unroll
    for (int j = 0; j < 4; ++j) { const int n = (lane >> 3) + 8 * j; const LAS float* s = scr + (8 * c) * 33 + n;
        u32x4 o; o.x = pk2(s[0 * 33], s[1 * 33]); o.y = pk2(s[2 * 33], s[3 * 33]); o.z = pk2(s[4 * 33], s[5 * 33]); o.w = pk2(s[6 * 33], s[7 * 33]);
        *(u32x4*)(WT + (size_t)(n0 + n) * K + k0 + 8 * c) = o; }
    LDS_WAIT();
}
__device__ __forceinline__ void phase_prologue(KP p, LAS unsigned char* lds) {
    const int tid = otid(), lane = tid & 63, wave = tid >> 6;
    unsigned char* ws = p->ws;
    float* MOD = (float*)(ws + WS_MOD);
    if ((int)blockIdx.x < 192) {
        LAS float* cond = (LAS float*)lds;
        LAS float* red = (LAS float*)(lds + 36864);
        for (int e = tid; e < 9 * 1024; e += NTHR) { const int j = e >> 10, k = e & 1023; const float v = j < 8 ? p->c[j * 1024 + k] : p->c_ctx[k]; cond[e] = siluf(v); }
        __syncthreads();
        for (int it = blockIdx.x; it < 192; it += gridDim.x) {
            const int l = it / 48, n0 = (it % 48) * 64, cq = tid & 15, ks = tid >> 4;
            float acc[9][4];
#pragma unroll
            for (int j = 0; j < 9; ++j) { acc[j][0] = 0.f; acc[j][1] = 0.f; acc[j][2] = 0.f; acc[j][3] = 0.f; }
            const float* wp = p->w_ada + (size_t)l * 1024 * 3072 + (size_t)(ks * 32) * 3072 + n0 + 4 * cq;
#pragma unroll 4
            for (int kk = 0; kk < 32; ++kk) { const f32x4 w = *(const f32x4*)(wp + (size_t)kk * 3072);
#pragma unroll
                for (int j = 0; j < 9; ++j) { const float cv = cond[j * 1024 + ks * 32 + kk]; acc[j][0] += cv * w[0]; acc[j][1] += cv * w[1]; acc[j][2] += cv * w[2]; acc[j][3] += cv * w[3]; } }
#pragma unroll
            for (int j = 0; j < 9; ++j)
#pragma unroll
                for (int i = 0; i < 4; ++i) red[ks * 576 + j * 64 + 4 * cq + i] = acc[j][i];
            __syncthreads();
            for (int o = tid; o < 576; o += NTHR) { float s = 0.f; for (int q = 0; q < 32; ++q) s += red[q * 576 + o]; const int j = o >> 6, n = n0 + (o & 63);
                MOD[(size_t)(l * 9 + j) * 3072 + n] = s + p->b_ada[l * 3072 + n]; }
            __syncthreads();
        }
    }
    if (blockIdx.x == gridDim.x - 1) {
        float* cosT = (float*)(ws + WS_ROPE); float* sinT = cosT + 1024;
        for (int e = tid; e < 1024; e += NTHR) { const int pos = e >> 4, i = e & 15;
            double f = 1.0; for (int q = 0; q < i; ++q) f *= 0.5623413251903491;
            const double f2 = f * f; double sn = 1.0, cs = 1.0;
            for (int q = 12; q >= 1; --q) { sn = 1.0 - f2 / ((2.0 * q) * (2.0 * q + 1.0)) * sn; cs = 1.0 - f2 / ((2.0 * q - 1.0) * (2.0 * q)) * cs; }
            sn *= f;
            double c = 1.0, s = 0.0; for (int q = 0; q < pos; ++q) { const double c2 = c * cs - s * sn, s2 = s * cs + c * sn; c = c2; s = s2; }
            cosT[e] = (float)c; sinT[e] = (float)s; }
    }
    __syncthreads();
    {
        LAS float* scr = (LAS float*)(lds + wave * 16384);
        const int gw = blockIdx.x * NWAVES + wave, NGW = gridDim.x * NWAVES;
        constexpr int I_E = 16 * (NPAD_EVEN / 32), I_O = 16 * (NPAD_ODD / 32), I_W = 16 * 32;
        constexpr int NIT = 2 * I_E + 2 * I_O + 4 * I_W;
        for (int it = gw; it < NIT; it += NGW) {
            int r = it;
            if (r < 2 * I_E) { const int i = r / I_E; r -= i * I_E; p0_transpose_item(p->w_in_even + (size_t)i * 1024 * NORIG_EVEN, 1024, NORIG_EVEN, 0, (bf16*)(ws + WS_WIE) + (size_t)i * NPAD_EVEN * 1024, scr, NPAD_EVEN / 32, r, lane); continue; }
            r -= 2 * I_E;
            if (r < 2 * I_O) { const int i = r / I_O; r -= i * I_O; p0_transpose_item(p->w_in_odd + (size_t)i * 1024 * NORIG_ODD, 1024, NORIG_ODD, 1, (bf16*)(ws + WS_WIO) + (size_t)i * NPAD_ODD * 1024, scr, NPAD_ODD / 32, r, lane); continue; }
            r -= 2 * I_O;
            { const int l = r / I_W; r -= l * I_W; const float* W = (l & 1) ? p->w_out_odd + (size_t)(l >> 1) * 1024 * 1024 : p->w_out_even + (size_t)(l >> 1) * 1024 * 1024;
              p0_transpose_item(W, 1024, 1024, 2, (bf16*)(ws + WS_WO) + (size_t)l * 1024 * 1024, scr, 32, r, lane); }
        }
    }
}
__device__ __forceinline__ void phase_h0(KP p) {
    const int lane = otid() & 63, gw = blockIdx.x * NWAVES + (otid() >> 6), NGW = gridDim.x * NWAVES;
    const float* MOD = (const float*)(p->ws + WS_MOD); bf16* H = (bf16*)(p->ws + WS_H);
    for (int m = gw; m < MTOT; m += NGW) {
        const int jb = m < MLAT ? (m >> 12) : 8;
        const float* src = m < MLAT ? p->x + (size_t)m * DM : p->ctx + (size_t)(m - MLAT) * DM;
        const float* md = MOD + (size_t)jb * 3072;
#pragma unroll
        for (int j = 0; j < 4; ++j) { const int k = 4 * lane + 256 * j; const f32x4 v = *(const f32x4*)(src + k), sh = *(const f32x4*)(md + k), sc = *(const f32x4*)(md + 1024 + k);
            const f32x4 h = v * (sc + 1.0f) + sh; u32x2 o; o.x = pk2(h[0], h[1]); o.y = pk2(h[2], h[3]); *(u32x2*)(H + (size_t)m * DM + k) = o; }
    }
}
__device__ __forceinline__ void phase_ln(KP p, int l) {
    const int lane = otid() & 63, gw = blockIdx.x * NWAVES + (otid() >> 6), NGW = gridDim.x * NWAVES;
    const float* MOD = (const float*)(p->ws + WS_MOD); bf16* H = (bf16*)(p->ws + WS_H); const bf16* Y = (const bf16*)(p->ws + WS_P); float* XC = (float*)(p->ws + WS_XC);
    const int mrows = l < DEPTH - 1 ? MTOT : MLAT;
    const float* lg = p->ln_g + l * DM; const float* lb = p->ln_b + l * DM;
    for (int m = gw; m < mrows; m += NGW) {
        const int jb = m < MLAT ? (m >> 12) : 8;
        const float* src = l == 0 ? (m < MLAT ? p->x + (size_t)m * DM : p->ctx + (size_t)(m - MLAT) * DM) : (m < MLAT ? p->out + (size_t)m * DM : XC + (size_t)(m - MLAT) * DM);
        float* dst = m < MLAT ? p->out + (size_t)m * DM : XC + (size_t)(m - MLAT) * DM;
        const float* md = MOD + (size_t)(l * 9 + jb) * 3072;
        f32x4 v[4]; float s = 0.f;
#pragma unroll
        for (int j = 0; j < 4; ++j) { const int k = 4 * lane + 256 * j; const f32x4 xv = *(const f32x4*)(src + k), g = *(const f32x4*)(md + 2048 + k); const u32x2 yw = *(const u32x2*)(Y + (size_t)m * DM + k);
            f32x4 y; y[0] = bflo(yw.x); y[1] = bfhi(yw.x); y[2] = bflo(yw.y); y[3] = bfhi(yw.y);
            v[j] = xv * ALPHA_DN + g * y; s += (v[j][0] + v[j][1]) + (v[j][2] + v[j][3]); }
        const float mean = wave_sum(s) * (1.f / DM); float s2 = 0.f;
#pragma unroll
        for (int j = 0; j < 4; ++j) { v[j] = v[j] - mean; s2 += (v[j][0] * v[j][0] + v[j][1] * v[j][1]) + (v[j][2] * v[j][2] + v[j][3] * v[j][3]); }
        const float rstd = 1.f / sqrtf(wave_sum(s2) * (1.f / DM) + 1e-5f);
        const float* md2 = MOD + (size_t)((l + 1) * 9 + jb) * 3072;
#pragma unroll
        for (int j = 0; j < 4; ++j) { const int k = 4 * lane + 256 * j; const f32x4 o = v[j] * rstd * *(const f32x4*)(lg + k) + *(const f32x4*)(lb + k);
            *(f32x4*)(dst + k) = o;
            if (l < DEPTH - 1) { const f32x4 sh = *(const f32x4*)(md2 + k), sc = *(const f32x4*)(md2 + 1024 + k); const f32x4 h = o * (sc + 1.0f) + sh;
                u32x2 w; w.x = pk2(h[0], h[1]); w.y = pk2(h[2], h[3]); *(u32x2*)(H + (size_t)m * DM + k) = w; } }
    }
}
constexpr int AT_KS = 0, AT_VS = 9216, AT_PS = 18432, AT_RPB = AT_PS + 8 * 2304;
__device__ __forceinline__ void attn_item(LAS unsigned char* lds, const bf16* __restrict__ P, int ldp, bf16* __restrict__ Z, int mode,
                                          int qrow0, int qcol, int kcol, int vcol, int gcol, int zcol,
                                          int nlat, int lat_row0, int ctx_row0, int qa_, int qb_, int ka_, const float* __restrict__ rpb_g, float sink) {
    const int tid = otid(), lane = tid & 63, wave = tid >> 6, fq = lane >> 4, fr = lane & 15;
    LAS bf16* Ks = (LAS bf16*)(lds + AT_KS); LAS bf16* Vs = (LAS bf16*)(lds + AT_VS); LAS bf16* Ps = (LAS bf16*)(lds + AT_PS + wave * 2304); LAS float* rpb = (LAS float*)(lds + AT_RPB);
    __syncthreads();
    if (mode == 0) { for (int e = tid; e < 465; e += NTHR) rpb[e] = rpb_g[e]; }
    bf16x8 qa[2];
#pragma unroll
    for (int ks = 0; ks < 2; ++ks) qa[ks] = *(const bf16x8*)(P + (size_t)(qrow0 + fr) * ldp + qcol + 32 * ks + 8 * fq);
    float mrow[4], lsum[4]; f32x4 oacc[4];
#pragma unroll
    for (int r = 0; r < 4; ++r) { mrow[r] = -1e30f; lsum[r] = 0.f; oacc[r] = (f32x4){0.f, 0.f, 0.f, 0.f}; }
    const int ntile = nlat + 4, srow = tid >> 3, sch = tid & 7;
    u32x4 kreg, vreg;
    { const int rb = nlat > 0 ? lat_row0 : ctx_row0; kreg = *(const u32x4*)(P + (size_t)(rb + srow) * ldp + kcol + 8 * sch); vreg = *(const u32x4*)(P + (size_t)(rb + srow) * ldp + vcol + 8 * sch); }
    for (int i = 0; i < ntile; ++i) {
        __syncthreads();
        *(LAS u32x4*)(Ks + srow * 72 + 8 * sch) = kreg; *(LAS u32x4*)(Vs + srow * 72 + 8 * sch) = vreg;
        __syncthreads();
        if (i + 1 < ntile) { const int rb = (i + 1 < nlat) ? lat_row0 + 64 * (i + 1) : ctx_row0 + 64 * (i + 1 - nlat);
            kreg = *(const u32x4*)(P + (size_t)(rb + srow) * ldp + kcol + 8 * sch); vreg = *(const u32x4*)(P + (size_t)(rb + srow) * ldp + vcol + 8 * sch); }
        const bool islat = i < nlat;
        bool active = true; int kt0 = 0;
        if (islat) {
            if (mode == 0) { kt0 = ka_ + i; const int rs = min(max(qa_ - 4, 0), 56); active = (kt0 >= rs) && (kt0 < rs + 8); }
            else { kt0 = ka_ + 64 * i; active = !(kt0 > qa_ + 15 + 128 || kt0 + 63 < qa_ - 128); }
        }
        if (active) {
            f32x4 s[4];
#pragma unroll
            for (int nt = 0; nt < 4; ++nt) { s[nt] = (f32x4){0.f, 0.f, 0.f, 0.f};
#pragma unroll
                for (int ks = 0; ks < 2; ++ks) s[nt] = MFMA(qa[ks], frag_rm(Ks, 72, 16 * nt, 32 * ks, lane), s[nt]); }
            float tmax[4] = {-3e38f, -3e38f, -3e38f, -3e38f};
#pragma unroll
            for (int nt = 0; nt < 4; ++nt)
#pragma unroll
                for (int r = 0; r < 4; ++r) { float v = s[nt][r];
                    if (islat) {
                        if (mode == 0) { const int qc = qb_ + 4 * fq + r, kc = 16 * nt + fr, cs = min(max(qc - 8, 0), 48); const bool ok = (kc >= cs) && (kc < cs + 16);
                            const int bi = (kt0 - qa_ + 7) * 31 + (kc - qc + 15); v = ok ? v + rpb[ok ? bi : 0] : -3e38f; }
                        else { const int qt = qa_ + 4 * fq + r, kt = kt0 + 16 * nt + fr; const int d = qt - kt; v = (d <= 128 && d >= -128) ? v : -3e38f; }
                    }
                    s[nt][r] = v; tmax[r] = fmaxf(tmax[r], v); }
#pragma unroll
            for (int r = 0; r < 4; ++r) { const float tm = red16_max(tmax[r]); const float mnew = fmaxf(mrow[r], tm); const float alpha = __expf(mrow[r] - mnew); mrow[r] = mnew;
                float ps = 0.f;
#pragma unroll
                for (int nt = 0; nt < 4; ++nt) { const float pv = __expf(s[nt][r] - mnew); ps += pv; Ps[(4 * fq + r) * 72 + 16 * nt + fr] = (bf16)f2bf(pv); oacc[nt][r] *= alpha; }
                lsum[r] = lsum[r] * alpha + ps; }
            LDS_WAIT();
#pragma unroll
            for (int ks = 0; ks < 2; ++ks) { const bf16x8 pa = frag_rm(Ps, 72, 0, 32 * ks, lane);
#pragma unroll
                for (int nt = 0; nt < 4; ++nt) oacc[nt] = MFMA(pa, frag_tr(Vs, 72, 32 * ks, 16 * nt, lane), oacc[nt]); }
            LDS_WAIT();
        }
    }
#pragma unroll
    for (int r = 0; r < 4; ++r) { float lt = red16_sum(lsum[r]); float sc;
        if (mode == 1 || mode == 3) { const float mf = fmaxf(mrow[r], sink); const float al = __expf(mrow[r] - mf); lt = lt * al + __expf(sink - mf); sc = al / lt; } else sc = 1.f / lt;
#pragma unroll
        for (int nt = 0; nt < 4; ++nt) Ps[(4 * fq + r) * 72 + 16 * nt + fr] = (bf16)f2bf(oacc[nt][r] * sc); }
    LDS_WAIT();
#pragma unroll
    for (int c2 = 0; c2 < 2; ++c2) { const int idx = lane + 64 * c2, q = idx >> 3, ch = idx & 7;
        const u32x4 ov = *(const LAS u32x4*)(Ps + q * 72 + 8 * ch); const u32x4 gv = *(const u32x4*)(P + (size_t)(qrow0 + q) * ldp + gcol + 8 * ch);
        u32x4 w;
        w.x = pk2(bflo(ov.x) * siluf(bflo(gv.x)), bfhi(ov.x) * siluf(bfhi(gv.x))); w.y = pk2(bflo(ov.y) * siluf(bflo(gv.y)), bfhi(ov.y) * siluf(bfhi(gv.y)));
        w.z = pk2(bflo(ov.z) * siluf(bflo(gv.z)), bfhi(ov.z) * siluf(bfhi(gv.z))); w.w = pk2(bflo(ov.w) * siluf(bflo(gv.w)), bfhi(ov.w) * siluf(bfhi(gv.w)));
        *(u32x4*)(Z + (size_t)(qrow0 + q) * DM + zcol + 8 * ch) = w; }
    LDS_WAIT();
}
__device__ __forceinline__ void phase_attn(KP p, LAS unsigned char* lds, int l, bool need_ctx) {
    const int wave = otid() >> 6; const bool odd = l & 1; const int li = l >> 1;
    const bf16* P = (const bf16*)(p->ws + WS_P); bf16* Z = (bf16*)(p->ws + WS_H); const int ldp = odd ? NP_ODD : NP_EVEN;
    const int nmain = BATCH * 8 * 32, nctx = need_ctx ? BATCH * 8 * 2 : 0;
    for (int it = blockIdx.x; it < nmain + nctx; it += gridDim.x) {
        if (it < nmain) {
            const int b = it >> 8, h = (it >> 5) & 7, qb = it & 31;
            if (!odd) { const int r0 = 2 * qb, rw = r0 + (wave >> 2); const int rs0 = min(max(r0 - 4, 0), 56), rs1 = min(max(r0 + 1 - 4, 0), 56);
                attn_item(lds, P, ldp, Z, 0, b * SEQ + rw * 64 + 16 * (wave & 3), 1536 + h * 64, 2048 + h * 64, 2560 + h * 64, 3072 + h * 64, 512 + h * 64,
                          rs1 + 8 - rs0, b * SEQ + rs0 * 64, MLAT + b * CTXL, rw, 16 * (wave & 3), rs0, p->na_rpb + (size_t)(li * 8 + h) * 465, 0.f); }
            else { const int kv = h >> 2, t0 = 128 * qb, lt0 = max(0, 2 * qb - 2), lt1 = min(63, 2 * qb + 3);
                attn_item(lds, P, ldp, Z, 1, b * SEQ + t0 + 16 * wave, 1536 + h * 64, 2048 + kv * 64, 2176 + kv * 64, 2304 + h * 64, 512 + h * 64,
                          lt1 - lt0 + 1, b * SEQ + lt0 * 64, MLAT + b * CTXL, t0 + 16 * wave, 0, lt0 * 64, nullptr, p->sw_sink[li * 8 + h]); }
        } else {
            const int j = it - nmain, b = j >> 4, h = (j >> 1) & 7, half = j & 1; const int q0 = MLAT + b * CTXL + 128 * half + 16 * wave;
            if (!odd) attn_item(lds, P, ldp, Z, 2, q0, 1536 + h * 64, 2048 + h * 64, 2560 + h * 64, 3072 + h * 64, 512 + h * 64, 0, 0, MLAT + b * CTXL, 0, 0, 0, nullptr, 0.f);
            else { const int kv = h >> 2; attn_item(lds, P, ldp, Z, 3, q0, 1536 + h * 64, 2048 + kv * 64, 2176 + kv * 64, 2304 + h * 64, 512 + h * 64, 0, 0, MLAT + b * CTXL, 0, 0, 0, nullptr, p->sw_sink[li * 8 + h]); }
        }
    }
}
__device__ __forceinline__ int chunk_row0(int b, int cp) { return cp < 4 ? MLAT + b * CTXL + cp * 64 : b * SEQ + (cp - 4) * 64; }
constexpr int SL_KDF = 0, SL_KDB = 9216, SL_VS = 18432, SL_SEG = 35840, SL_MISC = 39936;
__device__ __forceinline__ void phase_scan_local(KP p, LAS unsigned char* lds, int l) {
    const int tid = otid(), lane = tid & 63, wave = tid >> 6, fq = lane >> 4, fr = lane & 15; const bool odd = l & 1; const int li = l >> 1;
    const bf16* P = (const bf16*)(p->ws + WS_P); const int ldp = odd ? NP_ODD : NP_EVEN; const float* SM = (const float*)(p->ws + WS_SM);
    float* S = (float*)(p->ws + WS_S); float* GAM = (float*)(p->ws + WS_GAM); float* SC = (float*)(p->ws + WS_SC);
    LAS bf16* kdf = (LAS bf16*)(lds + SL_KDF); LAS bf16* kdb = (LAS bf16*)(lds + SL_KDB); LAS bf16* vs = (LAS bf16*)(lds + SL_VS);
    LAS float* seg = (LAS float*)(lds + SL_SEG); LAS float* misc = (LAS float*)(lds + SL_MISC);
    const int dk = tid & 63, sg = tid >> 6;
    for (int it = blockIdx.x; it < BATCH * 4 * NCHUNK; it += gridDim.x) {
        const int b = it / (4 * NCHUNK), h = (it / NCHUNK) & 3, cp = it % NCHUNK; const int row0 = chunk_row0(b, cp);
        const int slf = ((b * 4 + h) * 2 + 0) * NCHUNK + cp, slb = slf + NCHUNK;
        __syncthreads();
#pragma unroll
        for (int c2 = 0; c2 < 2; ++c2) { const int idx = tid + NTHR * c2, t = idx >> 4, ch = idx & 15; *(LAS u32x4*)(vs + t * 136 + 8 * ch) = *(const u32x4*)(P + (size_t)(row0 + t) * ldp + 512 + h * 128 + 8 * ch); }
        float kv[8];
#pragma unroll
        for (int tt = 0; tt < 8; ++tt) kv[tt] = bf2f(P[(size_t)(row0 + sg * 8 + tt) * ldp + 256 + h * 64 + dk]);
        if (!odd) {
            float gwf[16], gwb[16];
            const float* gw = p->gla_gate_w + (size_t)li * 2 * 16 * 256; const float* gb = p->gla_gate_b + (size_t)li * 2 * 256;
#pragma unroll
            for (int r = 0; r < 16; ++r) { gwf[r] = gw[r * 256 + h * 64 + dk]; gwb[r] = gw[(16 + r) * 256 + h * 64 + dk]; }
            const float gbf = gb[h * 64 + dk], gbb = gb[256 + h * 64 + dk];
            float pf[8], sb[8];
#pragma unroll
            for (int tt = 0; tt < 8; ++tt) { const float* lr = SM + (size_t)(row0 + sg * 8 + tt) * 32; float zf = gbf, zb = gbb;
#pragma unroll
                for (int r = 0; r < 16; ++r) { zf += lr[r] * gwf[r]; zb += lr[16 + r] * gwb[r]; }
                pf[tt] = logsigf(zf) * 0.0625f; sb[tt] = logsigf(zb) * 0.0625f; }
#pragma unroll
            for (int tt = 1; tt < 8; ++tt) pf[tt] += pf[tt - 1];
#pragma unroll
            for (int tt = 6; tt >= 0; --tt) sb[tt] += sb[tt + 1];
            seg[(0 * 8 + sg) * 64 + dk] = pf[7]; seg[(1 * 8 + sg) * 64 + dk] = sb[0];
            __syncthreads();
            float offf = 0.f, totf = 0.f, offb = 0.f, totb = 0.f;
#pragma unroll
            for (int q = 0; q < 8; ++q) { const float a = seg[q * 64 + dk], c = seg[(8 + q) * 64 + dk]; totf += a; totb += c; if (q < sg) offf += a; if (q > sg) offb += c; }
#pragma unroll
            for (int tt = 0; tt < 8; ++tt) { const int t = sg * 8 + tt;
                kdf[t * 72 + dk] = (bf16)f2bf(kv[tt] * __expf(totf - (offf + pf[tt]))); kdb[t * 72 + dk] = (bf16)f2bf(kv[tt] * __expf(totb - (offb + sb[tt]))); }
            if (sg == 0) { GAM[(size_t)slf * 64 + dk] = __expf(totf); GAM[(size_t)slb * 64 + dk] = __expf(totb); }
        } else {
            const float* mb = p->ml_gate_b + li * 16;
            if (tid < 128) { const int d = tid >> 6, t = tid & 63; const float* gp = SM + (size_t)(row0 + t) * 32 + d * 8;
                misc[d * 128 + t] = gp[h] + mb[d * 8 + h]; misc[d * 128 + 64 + t] = logsigf(gp[4 + h] + mb[d * 8 + 4 + h]); }
            __syncthreads();
            if (tid < 128) { const int d = tid >> 6, t = tid & 63; float run = 0.f;
                if (d == 0) { for (int s2 = 0; s2 <= t; ++s2) run += misc[64 + s2]; } else { for (int s2 = 63; s2 >= t; --s2) run += misc[128 + 64 + s2]; }
                const float tot = d == 0 ? __shfl(run, 63) : __shfl(run, 0);
                const float wl = tot - run + misc[d * 128 + t]; const float ml = wave_max(wl);
                misc[256 + d * 64 + t] = __expf(wl - ml);
                if (t == 0) { const int sl = d == 0 ? slf : slb; SC[(size_t)sl * 4 + 0] = tot; SC[(size_t)sl * 4 + 1] = ml; } }
            __syncthreads();
            float nf = 0.f, nb = 0.f;
#pragma unroll
            for (int tt = 0; tt < 8; ++tt) { const int t = sg * 8 + tt; const float a = kv[tt] * misc[256 + t], c = kv[tt] * misc[256 + 64 + t]; nf += a; nb += c;
                kdf[t * 72 + dk] = (bf16)f2bf(a); kdb[t * 72 + dk] = (bf16)f2bf(c); }
            seg[(0 * 8 + sg) * 64 + dk] = nf; seg[(1 * 8 + sg) * 64 + dk] = nb;
            __syncthreads();
            if (sg < 2) { float s2 = 0.f;
#pragma unroll
                for (int q = 0; q < 8; ++q) s2 += seg[(sg * 8 + q) * 64 + dk];
                GAM[(size_t)(sg == 0 ? slf : slb) * 64 + dk] = s2; }
        }
        __syncthreads();
#pragma unroll
        for (int d = 0; d < 2; ++d) { const LAS bf16* kd = d ? kdb : kdf; f32x4 acc[4];
#pragma unroll
            for (int mt = 0; mt < 4; ++mt) acc[mt] = (f32x4){0.f, 0.f, 0.f, 0.f};
#pragma unroll
            for (int ks = 0; ks < 2; ++ks) { const bf16x8 bv = frag_tr(vs, 136, 32 * ks, 16 * wave, lane);
#pragma unroll
                for (int mt = 0; mt < 4; ++mt) acc[mt] = MFMA(frag_tr(kd, 72, 32 * ks, 16 * mt, lane), bv, acc[mt]); }
            float* dst = S + (size_t)(d ? slb : slf) * 8192;
#pragma unroll
            for (int mt = 0; mt < 4; ++mt)
#pragma unroll
                for (int r = 0; r < 4; ++r) dst[(16 * mt + 4 * fq + r) * 128 + 16 * wave + fr] = acc[mt][r]; }
    }
}
__device__ __forceinline__ void phase_scan_seq(KP p, int l) {
    const bool odd = l & 1;
    f32x4* S4 = (f32x4*)(p->ws + WS_S); float* GAM = (float*)(p->ws + WS_GAM); f32x4* GAM4 = (f32x4*)(p->ws + WS_GAM); float* SC = (float*)(p->ws + WS_SC);
    const int nthreads = gridDim.x * NTHR;
    for (int gid = blockIdx.x * NTHR + otid(); gid < 64 * 2048; gid += nthreads) {
        const int chain = gid >> 11, e4 = gid & 2047, dir = chain & 1, dkk = e4 >> 5; const int base = chain * NCHUNK;
        f32x4 st = (f32x4){0.f, 0.f, 0.f, 0.f}, nst = (f32x4){0.f, 0.f, 0.f, 0.f}; float m = 0.f; const bool hasn = odd && e4 < 16;
        for (int s0 = 0; s0 < NCHUNK; s0 += 4) {
            f32x4 d[4], dn[4]; float g0[4], g1[4]; int idx[4];
#pragma unroll
            for (int u = 0; u < 4; ++u) { const int step = s0 + u; const int cp = dir == 0 ? step : (step < 4 ? 3 - step : 71 - step); idx[u] = base + cp;
                d[u] = S4[(size_t)idx[u] * 2048 + e4];
                if (!odd) { g0[u] = GAM[(size_t)idx[u] * 64 + dkk]; g1[u] = 0.f; } else { g0[u] = SC[(size_t)idx[u] * 4 + 0]; g1[u] = SC[(size_t)idx[u] * 4 + 1]; if (hasn) dn[u] = GAM4[(size_t)idx[u] * 16 + e4]; } }
#pragma unroll
            for (int u = 0; u < 4; ++u) {
                S4[(size_t)idx[u] * 2048 + e4] = st;
                if (!odd) { st = st * g0[u] + d[u]; }
                else { if (hasn) GAM4[(size_t)idx[u] * 16 + e4] = nst; if (e4 == 0) SC[(size_t)idx[u] * 4 + 2] = m;
                    const float mn = fmaxf(g0[u] + m, g1[u]); const float dec = __expf(g0[u] + m - mn), sc = __expf(g1[u] - mn);
                    st = st * dec + d[u] * sc; if (hasn) nst = nst * dec + dn[u] * sc; m = mn; }
            }
        }
    }
}
constexpr int SO_QF = 0, SO_KF = 9216, SO_QB = 18432, SO_KB = 27648, SO_VS = 36864, SO_AF = 54272, SO_AB = 63488, SO_SF = 72704, SO_SB = 90112, SO_SEG = 107520, SO_SSQ = 111616, SO_MISC = 113664;
constexpr int SO_OST = 0;
__device__ __forceinline__ void scan_out_tail(LAS unsigned char* lds, f32x4 (&o)[4], const bf16* __restrict__ P, int ldp, bf16* __restrict__ Z, int row0, int h, const float* __restrict__ ng) {
    const int tid = otid(), lane = tid & 63, wave = tid >> 6, fq = lane >> 4, fr = lane & 15;
    LAS float* ssq = (LAS float*)(lds + SO_SSQ); LAS float* ost = (LAS float*)(lds + SO_OST);
#pragma unroll
    for (int mt = 0; mt < 4; ++mt)
#pragma unroll
        for (int r = 0; r < 4; ++r) { const float q = red16_sum(o[mt][r] * o[mt][r]); if (fr == 0) ssq[wave * 64 + 16 * mt + 4 * fq + r] = q; }
    __syncthreads();
#pragma unroll
    for (int mt = 0; mt < 4; ++mt)
#pragma unroll
        for (int r = 0; r < 4; ++r) { const int t = 16 * mt + 4 * fq + r; float q = 0.f;
#pragma unroll
            for (int w = 0; w < 8; ++w) q += ssq[w * 64 + t];
            ost[t * 132 + 16 * wave + fr] = o[mt][r] * rsqrtf(q * (1.f / 128.f) + 1e-6f); }
    __syncthreads();
#pragma unroll
    for (int c2 = 0; c2 < 2; ++c2) { const int idx = tid + NTHR * c2, t = idx >> 4, ch = idx & 15;
        const f32x4 o0 = *(const LAS f32x4*)(ost + t * 132 + 8 * ch), o1 = *(const LAS f32x4*)(ost + t * 132 + 8 * ch + 4);
        const f32x4 g0 = *(const f32x4*)(ng + h * 128 + 8 * ch), g1 = *(const f32x4*)(ng + h * 128 + 8 * ch + 4);
        const u32x4 gv = *(const u32x4*)(P + (size_t)(row0 + t) * ldp + 1024 + h * 128 + 8 * ch);
        u32x4 w;
        w.x = pk2(o0[0] * g0[0] * siluf(bflo(gv.x)), o0[1] * g0[1] * siluf(bfhi(gv.x))); w.y = pk2(o0[2] * g0[2] * siluf(bflo(gv.y)), o0[3] * g0[3] * siluf(bfhi(gv.y)));
        w.z = pk2(o1[0] * g1[0] * siluf(bflo(gv.z)), o1[1] * g1[1] * siluf(bfhi(gv.z))); w.w = pk2(o1[2] * g1[2] * siluf(bflo(gv.w)), o1[3] * g1[3] * siluf(bfhi(gv.w)));
        *(u32x4*)(Z + (size_t)(row0 + t) * DM + h * 128 + 8 * ch) = w; }
}
__device__ __forceinline__ void stage_state(LAS bf16* dst, const float* __restrict__ src) {
    const int tid = otid();
#pragma unroll
    for (int c4 = 0; c4 < 4; ++c4) { const int idx = tid + NTHR * c4, r = idx >> 5, c = (idx & 31) * 4; const f32x4 v = *(const f32x4*)(src + r * 128 + c);
        u32x2 w; w.x = pk2(v[0], v[1]); w.y = pk2(v[2], v[3]); *(LAS u32x2*)(dst + r * 136 + c) = w; }
}
__device__ __forceinline__ void phase_scan_out_gla(KP p, LAS unsigned char* lds, int l, bool need_ctx) {
    const int tid = otid(), lane = tid & 63, wave = tid >> 6, fq = lane >> 4, fr = lane & 15; const int li = l >> 1;
    const bf16* P = (const bf16*)(p->ws + WS_P); const int ldp = NP_EVEN; const float* SM = (const float*)(p->ws + WS_SM); bf16* Z = (bf16*)(p->ws + WS_H);
    const float* S = (const float*)(p->ws + WS_S);
    LAS bf16* qf = (LAS bf16*)(lds + SO_QF); LAS bf16* kf = (LAS bf16*)(lds + SO_KF); LAS bf16* qb = (LAS bf16*)(lds + SO_QB); LAS bf16* kb = (LAS bf16*)(lds + SO_KB);
    LAS bf16* vs = (LAS bf16*)(lds + SO_VS); LAS bf16* Af = (LAS bf16*)(lds + SO_AF); LAS bf16* Ab = (LAS bf16*)(lds + SO_AB); LAS bf16* Sf = (LAS bf16*)(lds + SO_SF); LAS bf16* Sb = (LAS bf16*)(lds + SO_SB);
    LAS float* seg = (LAS float*)(lds + SO_SEG);
    const int dk = tid & 63, sg = tid >> 6;
    for (int it = blockIdx.x; it < BATCH * 4 * NCHUNK; it += gridDim.x) {
        const int b = it / (4 * NCHUNK), h = (it / NCHUNK) & 3, cp = it % NCHUNK; if (cp < 4 && !need_ctx) continue;
        const int row0 = chunk_row0(b, cp); const int slf = ((b * 4 + h) * 2 + 0) * NCHUNK + cp, slb = slf + NCHUNK;
        __syncthreads();
#pragma unroll
        for (int c2 = 0; c2 < 2; ++c2) { const int idx = tid + NTHR * c2, t = idx >> 4, ch = idx & 15; *(LAS u32x4*)(vs + t * 136 + 8 * ch) = *(const u32x4*)(P + (size_t)(row0 + t) * ldp + 512 + h * 128 + 8 * ch); }
        stage_state(Sf, S + (size_t)slf * 8192); stage_state(Sb, S + (size_t)slb * 8192);
        float qv[8], kv[8];
#pragma unroll
        for (int tt = 0; tt < 8; ++tt) { const size_t ro = (size_t)(row0 + sg * 8 + tt) * ldp + h * 64 + dk; qv[tt] = bf2f(P[ro]); kv[tt] = bf2f(P[ro + 256]); }
        float gwf[16], gwb[16];
        const float* gw = p->gla_gate_w + (size_t)li * 2 * 16 * 256; const float* gb = p->gla_gate_b + (size_t)li * 2 * 256;
#pragma unroll
        for (int r = 0; r < 16; ++r) { gwf[r] = gw[r * 256 + h * 64 + dk]; gwb[r] = gw[(16 + r) * 256 + h * 64 + dk]; }
        const float gbf = gb[h * 64 + dk], gbb = gb[256 + h * 64 + dk];
        float pf[8], sb[8];
#pragma unroll
        for (int tt = 0; tt < 8; ++tt) { const float* lr = SM + (size_t)(row0 + sg * 8 + tt) * 32; float zf = gbf, zb = gbb;
#pragma unroll
            for (int r = 0; r < 16; ++r) { zf += lr[r] * gwf[r]; zb += lr[16 + r] * gwb[r]; }
            pf[tt] = logsigf(zf) * 0.0625f; sb[tt] = logsigf(zb) * 0.0625f; }
#pragma unroll
        for (int tt = 1; tt < 8; ++tt) pf[tt] += pf[tt - 1];
#pragma unroll
        for (int tt = 6; tt >= 0; --tt) sb[tt] += sb[tt + 1];
        seg[(0 * 8 + sg) * 64 + dk] = pf[7]; seg[(1 * 8 + sg) * 64 + dk] = sb[0];
        __syncthreads();
        float offf = 0.f, offb = 0.f;
#pragma unroll
        for (int q = 0; q < 8; ++q) { const float a = seg[q * 64 + dk], c = seg[(8 + q) * 64 + dk]; if (q < sg) offf += a; if (q > sg) offb += c; }
#pragma unroll
        for (int tt = 0; tt < 8; ++tt) { const int t = sg * 8 + tt; const float bf_ = offf + pf[tt], bb_ = offb + sb[tt];
            qf[t * 72 + dk] = (bf16)f2bf(qv[tt] * __expf(bf_)); kf[t * 72 + dk] = (bf16)f2bf(kv[tt] * __expf(-bf_));
            qb[t * 72 + dk] = (bf16)f2bf(qv[tt] * __expf(bb_)); kb[t * 72 + dk] = (bf16)f2bf(kv[tt] * __expf(-bb_)); }
        __syncthreads();
        { const int mt = wave >> 1;
#pragma unroll
          for (int n2 = 0; n2 < 2; ++n2) { const int nt = 2 * (wave & 1) + n2; f32x4 af = (f32x4){0.f, 0.f, 0.f, 0.f}, ab = (f32x4){0.f, 0.f, 0.f, 0.f};
#pragma unroll
              for (int ks = 0; ks < 2; ++ks) { af = MFMA(frag_rm(qf, 72, 16 * mt, 32 * ks, lane), frag_rm(kf, 72, 16 * nt, 32 * ks, lane), af);
                                               ab = MFMA(frag_rm(qb, 72, 16 * mt, 32 * ks, lane), frag_rm(kb, 72, 16 * nt, 32 * ks, lane), ab); }
#pragma unroll
              for (int r = 0; r < 4; ++r) { const int t = 16 * mt + 4 * fq + r, s = 16 * nt + fr;
                  Af[t * 72 + s] = (bf16)f2bf(s <= t ? af[r] : 0.f); Ab[t * 72 + s] = (bf16)f2bf(s >= t ? ab[r] : 0.f); } } }
        __syncthreads();
        f32x4 o[4];
#pragma unroll
        for (int mt = 0; mt < 4; ++mt) o[mt] = (f32x4){0.f, 0.f, 0.f, 0.f};
#pragma unroll
        for (int ks = 0; ks < 2; ++ks) { const bf16x8 bv = frag_tr(vs, 136, 32 * ks, 16 * wave, lane), bsf = frag_tr(Sf, 136, 32 * ks, 16 * wave, lane), bsb = frag_tr(Sb, 136, 32 * ks, 16 * wave, lane);
#pragma unroll
            for (int mt = 0; mt < 4; ++mt) { o[mt] = MFMA(frag_rm(Af, 72, 16 * mt, 32 * ks, lane), bv, o[mt]); o[mt] = MFMA(frag_rm(Ab, 72, 16 * mt, 32 * ks, lane), bv, o[mt]);
                o[mt] = MFMA(frag_rm(qf, 72, 16 * mt, 32 * ks, lane), bsf, o[mt]); o[mt] = MFMA(frag_rm(qb, 72, 16 * mt, 32 * ks, lane), bsb, o[mt]); } }
        scan_out_tail(lds, o, P, ldp, Z, row0, h, p->gla_norm_g + (size_t)li * 512);
    }
}
constexpr int MO_QS = 0, MO_KS = 9216, MO_QWF = 18432, MO_QWB = 27648;
__device__ __forceinline__ void phase_scan_out_mlstm(KP p, LAS unsigned char* lds, int l, bool need_ctx) {
    const int tid = otid(), lane = tid & 63, wave = tid >> 6, fq = lane >> 4, fr = lane & 15; const int li = l >> 1;
    const bf16* P = (const bf16*)(p->ws + WS_P); const int ldp = NP_ODD; const float* SM = (const float*)(p->ws + WS_SM); bf16* Z = (bf16*)(p->ws + WS_H);
    const float* S = (const float*)(p->ws + WS_S); const float* GAM = (const float*)(p->ws + WS_GAM); const float* SC = (const float*)(p->ws + WS_SC);
    LAS bf16* qs = (LAS bf16*)(lds + MO_QS); LAS bf16* ks_ = (LAS bf16*)(lds + MO_KS); LAS bf16* qwf = (LAS bf16*)(lds + MO_QWF); LAS bf16* qwb = (LAS bf16*)(lds + MO_QWB);
    LAS bf16* vs = (LAS bf16*)(lds + SO_VS); LAS bf16* Af = (LAS bf16*)(lds + SO_AF); LAS bf16* Ab = (LAS bf16*)(lds + SO_AB); LAS bf16* Cf = (LAS bf16*)(lds + SO_SF); LAS bf16* Cb = (LAS bf16*)(lds + SO_SB);
    LAS float* part = (LAS float*)(lds + SO_SEG);
    LAS float* misc = (LAS float*)(lds + SO_MISC);
    const float* mb = p->ml_gate_b + li * 16;
    for (int it = blockIdx.x; it < BATCH * 4 * NCHUNK; it += gridDim.x) {
        const int b = it / (4 * NCHUNK), h = (it / NCHUNK) & 3, cp = it % NCHUNK; if (cp < 4 && !need_ctx) continue;
        const int row0 = chunk_row0(b, cp); const int slf = ((b * 4 + h) * 2 + 0) * NCHUNK + cp, slb = slf + NCHUNK;
        __syncthreads();
#pragma unroll
        for (int c2 = 0; c2 < 2; ++c2) { const int idx = tid + NTHR * c2, t = idx >> 4, ch = idx & 15; *(LAS u32x4*)(vs + t * 136 + 8 * ch) = *(const u32x4*)(P + (size_t)(row0 + t) * ldp + 512 + h * 128 + 8 * ch); }
        stage_state(Cf, S + (size_t)slf * 8192); stage_state(Cb, S + (size_t)slb * 8192);
        { const int t = tid >> 3, ch = tid & 7; const size_t ro = (size_t)(row0 + t) * ldp + h * 64 + 8 * ch;
          *(LAS u32x4*)(qs + t * 72 + 8 * ch) = *(const u32x4*)(P + ro); *(LAS u32x4*)(ks_ + t * 72 + 8 * ch) = *(const u32x4*)(P + ro + 256); }
        if (tid < 128) { const int d = tid >> 6, t = tid & 63; const float* gp = SM + (size_t)(row0 + t) * 32 + d * 8;
            misc[d * 512 + t] = gp[h] + mb[d * 8 + h]; misc[d * 512 + 64 + t] = logsigf(gp[4 + h] + mb[d * 8 + 4 + h]);
            misc[1024 + d * 64 + t] = GAM[(size_t)(d ? slb : slf) * 64 + t]; }
        __syncthreads();
        if (tid < 128) { const int d = tid >> 6, t = tid & 63; LAS float* md = misc + d * 512; float run = 0.f, pm = -3e38f;
            if (d == 0) { for (int s2 = 0; s2 <= t; ++s2) { run += md[64 + s2]; pm = fmaxf(pm, md[s2] - run); } }
            else { for (int s2 = 63; s2 >= t; --s2) { run += md[64 + s2]; pm = fmaxf(pm, md[s2] - run); } }
            const float mprev = SC[(size_t)(d ? slb : slf) * 4 + 2];
            const float mt_ = fmaxf(run + pm, run + mprev);
            md[128 + t] = run; md[192 + t] = mt_; md[256 + t] = __expf(run + mprev - mt_); }
        __syncthreads();
        { const int t = tid >> 3, ch = tid & 7; const u32x4 qv = *(const LAS u32x4*)(qs + t * 72 + 8 * ch); const float wf = misc[256 + t], wb = misc[512 + 256 + t];
          u32x4 a, c;
          a.x = pk2(bflo(qv.x) * wf, bfhi(qv.x) * wf); a.y = pk2(bflo(qv.y) * wf, bfhi(qv.y) * wf); a.z = pk2(bflo(qv.z) * wf, bfhi(qv.z) * wf); a.w = pk2(bflo(qv.w) * wf, bfhi(qv.w) * wf);
          c.x = pk2(bflo(qv.x) * wb, bfhi(qv.x) * wb); c.y = pk2(bflo(qv.y) * wb, bfhi(qv.y) * wb); c.z = pk2(bflo(qv.z) * wb, bfhi(qv.z) * wb); c.w = pk2(bflo(qv.w) * wb, bfhi(qv.w) * wb);
          *(LAS u32x4*)(qwf + t * 72 + 8 * ch) = a; *(LAS u32x4*)(qwb + t * 72 + 8 * ch) = c;
          const float q0 = bflo(qv.x), q1 = bfhi(qv.x), q2 = bflo(qv.y), q3 = bfhi(qv.y), q4 = bflo(qv.z), q5 = bfhi(qv.z), q6 = bflo(qv.w), q7 = bfhi(qv.w);
#pragma unroll
          for (int d = 0; d < 2; ++d) { const LAS float* nv = misc + 1024 + d * 64 + 8 * ch;
              part[(d * 8 + ch) * 64 + t] = q0 * nv[0] + q1 * nv[1] + q2 * nv[2] + q3 * nv[3] + q4 * nv[4] + q5 * nv[5] + q6 * nv[6] + q7 * nv[7]; } }
        { const int mt = wave >> 1; float rsf[4] = {0.f, 0.f, 0.f, 0.f}, rsb[4] = {0.f, 0.f, 0.f, 0.f};
#pragma unroll
          for (int n2 = 0; n2 < 2; ++n2) { const int nt = 2 * (wave & 1) + n2; f32x4 a = (f32x4){0.f, 0.f, 0.f, 0.f};
#pragma unroll
              for (int ks = 0; ks < 2; ++ks) a = MFMA(frag_rm(qs, 72, 16 * mt, 32 * ks, lane), frag_rm(ks_, 72, 16 * nt, 32 * ks, lane), a);
#pragma unroll
              for (int r = 0; r < 4; ++r) { const int t = 16 * mt + 4 * fq + r, s = 16 * nt + fr;
                  const float wf = s <= t ? __expf(misc[128 + t] - misc[128 + s] + misc[s] - misc[192 + t]) : 0.f;
                  const float wb = s >= t ? __expf(misc[512 + 128 + t] - misc[512 + 128 + s] + misc[512 + s] - misc[512 + 192 + t]) : 0.f;
                  const float vf = a[r] * wf, vb = a[r] * wb; rsf[r] += vf; rsb[r] += vb;
                  Af[t * 72 + s] = (bf16)f2bf(vf); Ab[t * 72 + s] = (bf16)f2bf(vb); } }
#pragma unroll
          for (int r = 0; r < 4; ++r) { const float a = red16_sum(rsf[r]), c = red16_sum(rsb[r]);
              if (fr == 0) { misc[1152 + (0 * 2 + (wave & 1)) * 64 + 16 * mt + 4 * fq + r] = a; misc[1152 + (1 * 2 + (wave & 1)) * 64 + 16 * mt + 4 * fq + r] = c; } } }
        __syncthreads();
        if (tid < 128) { const int d = tid >> 6, t = tid & 63; float qn = 0.f;
#pragma unroll
            for (int q = 0; q < 8; ++q) qn += part[(d * 8 + q) * 64 + t];
            const float den = misc[1152 + (d * 2 + 0) * 64 + t] + misc[1152 + (d * 2 + 1) * 64 + t] + misc[d * 512 + 256 + t] * qn;
            misc[d * 512 + 320 + t] = 1.f / fmaxf(fabsf(den), __expf(-misc[d * 512 + 192 + t])); }
        f32x4 of[4], ob[4];
#pragma unroll
        for (int mt = 0; mt < 4; ++mt) { of[mt] = (f32x4){0.f, 0.f, 0.f, 0.f}; ob[mt] = (f32x4){0.f, 0.f, 0.f, 0.f}; }
#pragma unroll
        for (int ks = 0; ks < 2; ++ks) { const bf16x8 bv = frag_tr(vs, 136, 32 * ks, 16 * wave, lane), bcf = frag_tr(Cf, 136, 32 * ks, 16 * wave, lane), bcb = frag_tr(Cb, 136, 32 * ks, 16 * wave, lane);
#pragma unroll
            for (int mt = 0; mt < 4; ++mt) { of[mt] = MFMA(frag_rm(Af, 72, 16 * mt, 32 * ks, lane), bv, of[mt]); of[mt] = MFMA(frag_rm(qwf, 72, 16 * mt, 32 * ks, lane), bcf, of[mt]);
                ob[mt] = MFMA(frag_rm(Ab, 72, 16 * mt, 32 * ks, lane), bv, ob[mt]); ob[mt] = MFMA(frag_rm(qwb, 72, 16 * mt, 32 * ks, lane), bcb, ob[mt]); } }
        __syncthreads();
        f32x4 o[4];
#pragma unroll
        for (int mt = 0; mt < 4; ++mt)
#pragma unroll
            for (int r = 0; r < 4; ++r) { const int t = 16 * mt + 4 * fq + r; o[mt][r] = of[mt][r] * misc[320 + t] + ob[mt][r] * misc[512 + 320 + t]; }
        scan_out_tail(lds, o, P, ldp, Z, row0, h, p->ml_norm_g + (size_t)li * 512);
    }
}
#ifndef MK_N_LAUNCHES
#define MK_N_LAUNCHES 1
#endif
constexpr int N_PHASES = 2 + 6 * DEPTH;
__global__ void __launch_bounds__(NTHR, 2) fwd_megakernel(Params p_unused) {
    extern __shared__ __attribute__((aligned(16))) unsigned char lds_raw[];
    LAS unsigned char* lds = (LAS unsigned char*)lds_raw;
    cg::grid_group grid = cg::this_grid();
    const int lo = (int)kparams()->ph_lo, hi = (int)kparams()->ph_hi;
#define IN(k) (lo <= (k) && (k) < hi)
#define SEAM(k) do { if (IN(k) && IN((k) + 1)) grid.sync(); } while (0)
    if (IN(0)) { phase_prologue(kparams(), lds); } SEAM(0);
    if (IN(1)) { phase_h0(kparams()); } SEAM(1);
#pragma unroll 1
    for (int l = 0; l < DEPTH; ++l) {
        const int pb = 2 + 6 * l; const bool odd = l & 1; const int li = l >> 1; const bool need_ctx = l < DEPTH - 1;
        if (IN(pb + 0)) {
            const int npad = odd ? NPAD_ODD : NPAD_EVEN; unsigned char* ws = kparams()->ws;
            pg8::Gemm g{(const pg8::bf16_t*)(ws + WS_H), (const pg8::bf16_t*)(ws + (odd ? WS_WIO : WS_WIE)) + (size_t)li * npad * 1024, MTOT, npad, 1024};
            pg8::StaticOrder S; S.init(MTOT, npad, (int)gridDim.x, (int)blockIdx.x);
            pg8::EpiProj E{(pg8::bf16_t*)(ws + WS_P), odd ? NP_ODD : NP_EVEN, (float*)(ws + WS_SM), odd ? 16 : 32, npad / 256 - 1, odd ? 1 : 0, (const float*)(ws + WS_ROPE), (const float*)(ws + WS_ROPE) + 1024};
            pg8::gemm_phase<pg8::EpiProj, pg8::StaticOrder, true, true>(lds, g, S, E);
        }
        SEAM(pb + 0);
        if (IN(pb + 1)) { phase_attn(kparams(), lds, l, need_ctx); phase_scan_local(kparams(), lds, l); }
        SEAM(pb + 1);
        if (IN(pb + 2)) { phase_scan_seq(kparams(), l); }
        SEAM(pb + 2);
        if (IN(pb + 3)) { if (odd) phase_scan_out_mlstm(kparams(), lds, l, need_ctx); else phase_scan_out_gla(kparams(), lds, l, need_ctx); }
        SEAM(pb + 3);
        if (IN(pb + 4)) {
            const int mrows = need_ctx ? MTOT : MLAT; unsigned char* ws = kparams()->ws;
            pg8::Gemm g{(const pg8::bf16_t*)(ws + WS_H), (const pg8::bf16_t*)(ws + WS_WO) + (size_t)l * 1024 * 1024, mrows, 1024, 1024};
            pg8::StaticOrder S; S.init(mrows, 1024, (int)gridDim.x, (int)blockIdx.x);
            pg8::EpiProj E{(pg8::bf16_t*)(ws + WS_P), 1024, nullptr, 0, -1, 0, nullptr, nullptr};
            pg8::gemm_phase<pg8::EpiProj, pg8::StaticOrder, true, true>(lds, g, S, E);
        }
        SEAM(pb + 4);
        if (IN(pb + 5)) { phase_ln(kparams(), l); }
        SEAM(pb + 5);
    }
}
extern "C" void kernel_launch(void* const* d_in, const int* in_sizes, int n_in, void* d_out, int out_size, void* d_ws, size_t ws_size, hipStream_t stream) {
    static int grid = 0;
    if (grid == 0) {
        if (n_in != 19 || ws_size < WS_END) { fprintf(stderr, "kernel_launch: need 19 inputs and %zu bytes of workspace; got %d, %zu\n", (size_t)WS_END, n_in, ws_size); grid = -1; return; }
        int dev = 0, cus = 0, per_cu = 0;
        if (hipGetDevice(&dev) != hipSuccess || hipDeviceGetAttribute(&cus, hipDeviceAttributeMultiprocessorCount, dev) != hipSuccess) { grid = -1; return; }
        if (hipFuncSetAttribute((const void*)fwd_megakernel, hipFuncAttributeMaxDynamicSharedMemorySize, LDS_BYTES) != hipSuccess) { fprintf(stderr, "kernel_launch: hipFuncSetAttribute failed\n"); grid = -1; return; }
        if (hipOccupancyMaxActiveBlocksPerMultiprocessor(&per_cu, (const void*)fwd_megakernel, NTHR, LDS_BYTES) != hipSuccess || per_cu < 1) per_cu = 1;
        grid = cus * per_cu;
    }
    if (grid < 0) return;
    Params p{};
    p.x = (const float*)d_in[0]; p.c = (const float*)d_in[1]; p.ctx = (const float*)d_in[2]; p.c_ctx = (const float*)d_in[3]; p.w_ada = (const float*)d_in[4]; p.b_ada = (const float*)d_in[5];
    p.ln_g = (const float*)d_in[6]; p.ln_b = (const float*)d_in[7]; p.w_in_even = (const float*)d_in[8]; p.w_out_even = (const float*)d_in[9]; p.gla_gate_w = (const float*)d_in[10]; p.gla_gate_b = (const float*)d_in[11];
    p.gla_norm_g = (const float*)d_in[12]; p.na_rpb = (const float*)d_in[13]; p.w_in_odd = (const float*)d_in[14]; p.w_out_odd = (const float*)d_in[15]; p.ml_gate_b = (const float*)d_in[16]; p.ml_norm_g = (const float*)d_in[17];
    p.sw_sink = (const float*)d_in[18]; p.out = (float*)d_out; p.ws = (unsigned char*)d_ws;
#if MK_N_LAUNCHES == 1
    p.ph_lo = 0; p.ph_hi = N_PHASES;
    void* args[] = {&p};
    hipError_t e = hipLaunchCooperativeKernel((const void*)fwd_megakernel, dim3(grid), dim3(NTHR), args, LDS_BYTES, stream);
    if (e != hipSuccess) fprintf(stderr, "kernel_launch: cooperative launch failed: %s (grid %d)\n", hipGetErrorString(e), grid);
#else
    for (int k = 0; k < N_PHASES; ++k) { p.ph_lo = k; p.ph_hi = k + 1; hipLaunchKernelGGL(fwd_megakernel, dim3(grid), dim3(NTHR), LDS_BYTES, stream, p); }
#endif
}
```

```cpp
#include <hip/hip_runtime.h>
#include <hip/hip_cooperative_groups.h>
#include <cstdio>
#include <cstdint>
namespace cg = cooperative_groups;
__device__ __forceinline__ int otid() { int t = threadIdx.x; asm volatile("" : "+v"(t)); return t; }
namespace pg8 {
#define PG8_LAS __attribute__((address_space(3)))
typedef unsigned short bf16_t;
typedef short bf16x8 __attribute__((ext_vector_type(8)));
typedef float f32x4 __attribute__((ext_vector_type(4)));
typedef unsigned u32x4 __attribute__((ext_vector_type(4)));
constexpr int BM = 256, BK = 64, HALF = 128, HTB = HALF * BK * 2  , STAGE_BYTES = 8 * HTB, NXCD = 8, WGM = 8;

__host__ __device__ __forceinline__ int lds_byte(int r, int c) { const int st = (r >> 4) * 2 + (c >> 5), rr = r & 15, cc = c & 31, ob = rr * 64 + cc * 2; return st * 1024 + (ob ^ (((ob >> 9) & 1) << 5)); }
__host__ __device__ __forceinline__ void stage_rc(int b, int& R, int& C) { const int st = b / 1024, sb = b % 1024, swz = sb ^ (((sb >> 9) & 1) << 5); R = (st >> 1) * 16 + swz / 64; C = (st & 1) * 32 + (swz % 64) / 2; }
__host__ __device__ __forceinline__ int perm32(int rho) { const int n = rho >> 4, i = rho & 15; return 8 * (i >> 2) + 4 * n + (i & 3); }

struct Unit { int pm, pn; };
struct Gemm { const bf16_t* A; const bf16_t* Bt; int M, N, K; };

struct StaticOrder {
    int nM, nN, nwg, G, c;
    __host__ __device__ void init(int M, int N, int G_, int c_) { nM = M / BM; nN = N / BM; nwg = nM * nN; G = G_; c = c_; }
    __host__ __device__ bool next(int i, Unit& u) const {
        const long L = (long)i * G + c; if (L >= nwg) return false;
        int wgid = (int)L; { const int q = nwg / NXCD, r = nwg % NXCD, xcd = wgid % NXCD, off = wgid / NXCD; wgid = (xcd < r ? xcd * (q + 1) : r * (q + 1) + (xcd - r) * q) + off; }
        const int nig = WGM * nN, gid = wgid / nig, fm = gid * WGM, gsz = (nM - fm) < WGM ? (nM - fm) : WGM;
        u.pm = fm + ((wgid % nig) % gsz); u.pn = (wgid % nig) / gsz; return true;
    }
    __device__ __forceinline__ void a_ready(const Unit&) const {}
    __device__ __forceinline__ void done(const Unit&) const {}
};

__device__ __forceinline__ unsigned cvt_pk_bf16(float lo, float hi) { unsigned r; asm volatile("v_cvt_pk_bf16_f32 %0, %1, %2" : "=v"(r) : "v"(lo), "v"(hi)); return r; }
struct EpiProj {
    static constexpr bool PERM = true, AFTER_DRAIN = false;
    bf16_t* P; int ldp; float* SM; int nsm; int last_pn; int rope; const float* cosT; const float* sinT;
    __device__ __forceinline__ void operator()(const f32x4 (&acc)[2][2][4][2], const Unit& u, int wr, int wc, int fr, int fq) const {
        const int row0 = u.pm * BM + wr * 64 + fr;
        if (u.pn == last_pn) {
            if (wc == 0) {
#pragma unroll
                for (int ai = 0; ai < 2; ++ai)
#pragma unroll
                    for (int m = 0; m < 4; ++m) { const int row = row0 + ai * HALF + m * 16;
#pragma unroll
                        for (int n = 0; n < 2; ++n) { const int col = 8 * fq + 4 * n; if (col < nsm) *(f32x4*)(SM + (size_t)row * 32 + col) = acc[ai][0][m][n]; } }
            }
            return;
        }
        const bool do_rope_tile = rope && (u.pn == 6 || u.pn == 7 || u.pn == 8) && (u.pm * BM < 32768);
#pragma unroll
        for (int ai = 0; ai < 2; ++ai)
#pragma unroll
            for (int m = 0; m < 4; ++m) { const int row = row0 + ai * HALF + m * 16; bf16_t* rowp = P + (size_t)row * ldp + u.pn * BM + wc * 32 + 8 * fq;
#pragma unroll
                for (int bj = 0; bj < 2; ++bj) { f32x4 v0 = acc[ai][bj][m][0], v1 = acc[ai][bj][m][1];
                    if (do_rope_tile && (u.pn != 8 || bj == 0)) {
                        const int t = row & 4095; const int pos = (wc & 1) ? (t & 63) : (t >> 6); const int i0 = pos * 16 + 8 * (fq & 1);
                        const f32x4 c0 = *(const f32x4*)(cosT + i0), c1 = *(const f32x4*)(cosT + i0 + 4), s0 = *(const f32x4*)(sinT + i0), s1 = *(const f32x4*)(sinT + i0 + 4);
                        f32x4 p0, p1;
#pragma unroll
                        for (int e = 0; e < 4; ++e) { p0[e] = __shfl_xor(v0[e], 32); p1[e] = __shfl_xor(v1[e], 32); }
                        if (fq < 2) { v0 = v0 * c0 - p0 * s0; v1 = v1 * c1 - p1 * s1; } else { v0 = p0 * s0 + v0 * c0; v1 = p1 * s1 + v1 * c1; }
                    }
                    u32x4 w; w.x = cvt_pk_bf16(v0[0], v0[1]); w.y = cvt_pk_bf16(v0[2], v0[3]); w.z = cvt_pk_bf16(v1[0], v1[1]); w.w = cvt_pk_bf16(v1[2], v1[3]);
                    *(u32x4*)(rowp + bj * HALF) = w; } }
    }
};
template <class Epi, class Sched, bool ALIGN_EPI = false, bool SP2 = false>
__device__ __forceinline__ void gemm_phase(PG8_LAS unsigned char* lds, const Gemm g, const Sched& S, const Epi& E) {
    const int tid = otid(), wid = __builtin_amdgcn_readfirstlane(tid >> 6), lane = tid & 63, wr = wid >> 2, wc = wid & 3, fr = lane & 15, fq = lane >> 4;
    const int K = g.K, nt = K / BK;
    unsigned voffA[2], voffB[2];
#pragma unroll
    for (int i = 0; i < 2; ++i) { int R, C; stage_rc(tid * 16 + i * 8192, R, C); const int Rb = Epi::PERM ? ((R & ~31) + perm32(R & 31)) : R;
        voffA[i] = (unsigned)(R * K + C) * 2u; voffB[i] = (unsigned)(Rb * K + C) * 2u; }
    const size_t kstep = (size_t)(BK * 2);
    const size_t hstep = (size_t)HALF * K * 2;
    const size_t tstep = 2 * hstep;
    const unsigned ldsw = (unsigned)wid * 1024u;
    const int aoff = lds_byte(wr * 64 + fr, fq * 8), boff = lds_byte(wc * 32 + fr, fq * 8);
#define PG8_SA(b, h) (((b) * 2 + (h)) * HTB)
#define PG8_SB(b, h) ((4 + (b) * 2 + (h)) * HTB)
#define PG8_STAGE(bufoff, gbase, voff) do { _Pragma("unroll") for (int _i = 0; _i < 2; ++_i) \
        __builtin_amdgcn_global_load_lds((const unsigned*)((const char*)(gbase) + (voff)[_i]), (PG8_LAS unsigned*)(lds + (bufoff) + ldsw + _i * 8192), 16, 0, 0); } while (0)
#define PG8_LDA(dst, b, h) do { _Pragma("unroll") for (int m = 0; m < 4; ++m) _Pragma("unroll") for (int k = 0; k < 2; ++k) dst[m][k] = *(const PG8_LAS bf16x8*)(lds + PG8_SA(b, h) + aoff + m * 2048 + k * 1024); } while (0)
#define PG8_LDB(dst, b, h) do { _Pragma("unroll") for (int n = 0; n < 2; ++n) _Pragma("unroll") for (int k = 0; k < 2; ++k) dst[n][k] = *(const PG8_LAS bf16x8*)(lds + PG8_SB(b, h) + boff + n * 2048 + k * 1024); } while (0)
#define PG8_MMA(ai, bj, At, Bt) do { __builtin_amdgcn_s_setprio(1); _Pragma("unroll") for (int m = 0; m < 4; ++m) _Pragma("unroll") for (int n = 0; n < 2; ++n) _Pragma("unroll") for (int k = 0; k < 2; ++k) \
        acc[ai][bj][m][n] = __builtin_amdgcn_mfma_f32_16x16x32_bf16(Bt[n][k], At[m][k], acc[ai][bj][m][n], 0, 0, 0); __builtin_amdgcn_s_setprio(0); } while (0)
#define PG8_WAIT_V(n) asm volatile("s_waitcnt vmcnt(" #n ")" ::: "memory")
#define PG8_WAIT_L(n) asm volatile("s_waitcnt lgkmcnt(" #n ")" ::: "memory")
#define PG8_BAR __builtin_amdgcn_s_barrier()
#define PG8_SCHED __builtin_amdgcn_sched_barrier(0)
    Unit cur, nxt; int ui = 0;
    if (!S.next(0, cur)) return;
    f32x4 acc[2][2][4][2];
#pragma unroll
    for (int a = 0; a < 2; ++a)
#pragma unroll
        for (int b = 0; b < 2; ++b)
#pragma unroll
            for (int m = 0; m < 4; ++m)
#pragma unroll
                for (int n = 0; n < 2; ++n) acc[a][b][m][n] = (f32x4){0.f, 0.f, 0.f, 0.f};
    bf16x8 At[4][2], B0[2][2], B1[2][2];
    const char* cA = (const char*)g.A + (size_t)cur.pm * tstep; const char* cB = (const char*)g.Bt + (size_t)cur.pn * tstep;
    S.a_ready(cur);
    if constexpr (SP2) {
        PG8_STAGE(PG8_SB(0, 0), cB, voffB); PG8_STAGE(PG8_SB(0, 1), cB + hstep, voffB); PG8_STAGE(PG8_SA(0, 0), cA, voffA); PG8_STAGE(PG8_SA(0, 1), cA + hstep, voffA);
        if (wr == 1) PG8_BAR;
        PG8_WAIT_V(2); PG8_BAR;
        PG8_STAGE(PG8_SB(1, 0), cB + kstep, voffB); PG8_STAGE(PG8_SA(1, 0), cA + kstep, voffA); PG8_STAGE(PG8_SB(1, 1), cB + hstep + kstep, voffB);
        PG8_WAIT_V(6); PG8_BAR;
    } else {
        PG8_STAGE(PG8_SB(0, 0), cB, voffB); PG8_STAGE(PG8_SA(0, 0), cA, voffA); PG8_STAGE(PG8_SB(0, 1), cB + hstep, voffB); PG8_STAGE(PG8_SA(0, 1), cA + hstep, voffA);
        if (wr == 1) PG8_BAR;
        PG8_WAIT_V(4); PG8_BAR;
        PG8_STAGE(PG8_SB(1, 0), cB + kstep, voffB); PG8_STAGE(PG8_SA(1, 0), cA + kstep, voffA); PG8_STAGE(PG8_SB(1, 1), cB + hstep + kstep, voffB);
        PG8_WAIT_V(6); PG8_BAR;
    }
    for (;;) {
        const bool has_next = S.next(ui + 1, nxt);
        const char* nA = has_next ? (const char*)g.A + (size_t)nxt.pm * tstep : cA; const char* nB = has_next ? (const char*)g.Bt + (size_t)nxt.pn * tstep : cB;
        for (int t = 0; t < nt; t += 2) {
            const bool last = (t == nt - 2);
            const char* a1 = cA + (size_t)(t + 1) * kstep;
            const char* a2 = last ? nA : cA + (size_t)(t + 2) * kstep; const char* b2 = last ? nB : cB + (size_t)(t + 2) * kstep;
            const char* a3 = a2 + kstep; const char* b3 = b2 + kstep;
            if (last && has_next) S.a_ready(nxt);
            if constexpr (SP2) {
            PG8_LDB(B0, 0, 0); PG8_LDB(B1, 0, 1); PG8_SCHED; PG8_LDA(At, 0, 0); PG8_STAGE(PG8_SA(1, 1), a1 + hstep, voffA);
            PG8_WAIT_V(8); PG8_WAIT_L(0); PG8_BAR; PG8_MMA(0, 0, At, B0); PG8_MMA(0, 1, At, B1); PG8_BAR; PG8_SCHED;
            PG8_LDA(At, 0, 1); PG8_STAGE(PG8_SB(0, 0), b2, voffB); PG8_STAGE(PG8_SB(0, 1), b2 + hstep, voffB); PG8_STAGE(PG8_SA(0, 0), a2, voffA);
            PG8_WAIT_V(8); PG8_WAIT_L(0); PG8_BAR; PG8_MMA(1, 0, At, B0); PG8_MMA(1, 1, At, B1); PG8_BAR; PG8_SCHED;
            PG8_LDB(B0, 1, 0); PG8_LDB(B1, 1, 1); PG8_SCHED; PG8_LDA(At, 1, 0); PG8_STAGE(PG8_SA(0, 1), a2 + hstep, voffA);
            PG8_WAIT_V(8); PG8_WAIT_L(0); PG8_BAR; PG8_MMA(0, 0, At, B0); PG8_MMA(0, 1, At, B1); PG8_BAR; PG8_SCHED;
            PG8_LDA(At, 1, 1); PG8_STAGE(PG8_SB(1, 0), b3, voffB); PG8_STAGE(PG8_SB(1, 1), b3 + hstep, voffB); PG8_STAGE(PG8_SA(1, 0), a3, voffA);
            PG8_WAIT_V(8); PG8_WAIT_L(0); PG8_BAR; PG8_MMA(1, 0, At, B0); PG8_MMA(1, 1, At, B1); PG8_BAR; PG8_SCHED;
            } else {
            PG8_LDB(B0, 0, 0); PG8_SCHED; PG8_LDA(At, 0, 0); PG8_STAGE(PG8_SA(1, 1), a1 + hstep, voffA);
            PG8_WAIT_L(8); PG8_BAR; PG8_WAIT_L(0); PG8_MMA(0, 0, At, B0); PG8_BAR; PG8_SCHED;
            PG8_LDB(B1, 0, 1); PG8_STAGE(PG8_SB(0, 0), b2, voffB);
            PG8_BAR; PG8_WAIT_L(0); PG8_MMA(0, 1, At, B1); PG8_BAR;
            PG8_LDA(At, 0, 1); PG8_STAGE(PG8_SA(0, 0), a2, voffA);
            PG8_BAR; PG8_WAIT_L(0); PG8_MMA(1, 0, At, B0); PG8_BAR; PG8_SCHED;
            PG8_STAGE(PG8_SB(0, 1), b2 + hstep, voffB);
            PG8_WAIT_V(6); PG8_BAR; PG8_MMA(1, 1, At, B1); PG8_BAR;
            PG8_LDB(B0, 1, 0); PG8_SCHED; PG8_LDA(At, 1, 0); PG8_STAGE(PG8_SA(0, 1), a2 + hstep, voffA);
            PG8_WAIT_L(8); PG8_BAR; PG8_WAIT_L(0); PG8_MMA(0, 0, At, B0); PG8_BAR; PG8_SCHED;
            PG8_LDB(B1, 1, 1); PG8_STAGE(PG8_SB(1, 0), b3, voffB);
            PG8_BAR; PG8_WAIT_L(0); PG8_MMA(0, 1, At, B1); PG8_BAR;
            PG8_LDA(At, 1, 1); PG8_STAGE(PG8_SA(1, 0), a3, voffA);
            PG8_BAR; PG8_WAIT_L(0); PG8_MMA(1, 0, At, B0); PG8_BAR; PG8_SCHED;
            PG8_STAGE(PG8_SB(1, 1), b3 + hstep, voffB);
            PG8_WAIT_V(6); PG8_BAR; PG8_MMA(1, 1, At, B1); PG8_BAR;
            }
        }
        if constexpr (ALIGN_EPI) { if (wr == 0) PG8_BAR; }
        if constexpr (!Epi::AFTER_DRAIN) { E(acc, cur, wr, wc, fr, fq); S.done(cur); }
        if (!has_next) break;
#pragma unroll
        for (int a = 0; a < 2; ++a)
#pragma unroll
            for (int b = 0; b < 2; ++b)
#pragma unroll
                for (int m = 0; m < 4; ++m)
#pragma unroll
                    for (int n = 0; n < 2; ++n) acc[a][b][m][n] = (f32x4){0.f, 0.f, 0.f, 0.f};
        cur = nxt; cA = nA; cB = nB; ++ui;
        if constexpr (ALIGN_EPI) { if (wr == 1) PG8_BAR; }
    }
    PG8_WAIT_V(0);
    if constexpr (!ALIGN_EPI) { if (wr == 0) PG8_BAR; }
    PG8_BAR;
    if constexpr (Epi::AFTER_DRAIN) { E.fused(acc, cur, wr, wc, fr, fq, lds, wid, lane); S.done(cur); }
#undef PG8_SA
#undef PG8_SB
#undef PG8_STAGE
#undef PG8_LDA
#undef PG8_LDB
#undef PG8_MMA
#undef PG8_WAIT_V
#undef PG8_WAIT_L
#undef PG8_BAR
#undef PG8_SCHED
}
}
constexpr int NWAVES = 8, NTHR = 512;
constexpr int BATCH = 8, SEQ = 4096, DM = 1024, CTXL = 256, DEPTH = 4;
constexpr int MLAT = BATCH * SEQ, MCTX = BATCH * CTXL, MTOT = MLAT + MCTX;
constexpr int NP_EVEN = 3584, NPAD_EVEN = 3840, NORIG_EVEN = 3616;
constexpr int NP_ODD = 2816, NPAD_ODD = 3072, NORIG_ODD = 2832;
constexpr int NCHUNK = 68;
constexpr int NSLOT = BATCH * 4 * 2 * NCHUNK;
constexpr float ALPHA_DN = 1.681792830507429f;
constexpr size_t MiB = 1u << 20;
constexpr size_t WS_MOD = 0;
constexpr size_t WS_BAR = 512 * 1024;
constexpr size_t WS_ROPE = 1 * MiB;
constexpr size_t WS_SC = WS_ROPE + 65536;
constexpr size_t WS_GAM = 2 * MiB;
constexpr size_t WS_SM = 4 * MiB;
constexpr size_t WS_WIE = 9 * MiB;
constexpr size_t WS_WIO = 24 * MiB;
constexpr size_t WS_WO = 36 * MiB;
constexpr size_t WS_XC = 44 * MiB;
constexpr size_t WS_H = 52 * MiB;
constexpr size_t WS_P = 120 * MiB;
constexpr size_t WS_S = 359 * MiB;
constexpr size_t WS_END = WS_S + (size_t)NSLOT * 8192 * 4;
static_assert(WS_SC + (size_t)NSLOT * 16 <= WS_GAM && WS_GAM + (size_t)NSLOT * 256 <= WS_SM && WS_SM + (size_t)MTOT * 128 <= WS_WIE, "ws map 1");
static_assert(WS_WIE + (size_t)2 * NPAD_EVEN * 1024 * 2 <= WS_WIO && WS_WIO + (size_t)2 * NPAD_ODD * 1024 * 2 <= WS_WO && WS_WO + (size_t)4 * 1024 * 1024 * 2 <= WS_XC, "ws map 2");
static_assert(WS_XC + (size_t)MCTX * 1024 * 4 <= WS_H && WS_H + (size_t)MTOT * 1024 * 2 <= WS_P && WS_P + (size_t)MTOT * NP_EVEN * 2 <= WS_S && WS_END <= 512 * MiB, "ws map 3");
constexpr int LDS_BYTES = 147456;

#define LAS __attribute__((address_space(3)))
typedef unsigned short bf16;
typedef float f32x4 __attribute__((ext_vector_type(4)));
typedef short bf16x8 __attribute__((ext_vector_type(8)));
typedef short s16x4 __attribute__((ext_vector_type(4)));
typedef unsigned u32x4 __attribute__((ext_vector_type(4)));
typedef unsigned u32x2 __attribute__((ext_vector_type(2)));
#define LDS_WAIT() asm volatile("s_waitcnt lgkmcnt(0)" ::: "memory")

__device__ __forceinline__ unsigned f2bf(float f) { unsigned u = __builtin_bit_cast(unsigned, f); return (u + 0x7fffu + ((u >> 16) & 1u)) >> 16; }
__device__ __forceinline__ unsigned pk2(float lo, float hi) { return f2bf(lo) | (f2bf(hi) << 16); }
__device__ __forceinline__ float bf2f(unsigned short v) { return __builtin_bit_cast(float, (unsigned)v << 16); }
__device__ __forceinline__ float bflo(unsigned w) { return __builtin_bit_cast(float, w << 16); }
__device__ __forceinline__ float bfhi(unsigned w) { return __builtin_bit_cast(float, w & 0xffff0000u); }
__device__ __forceinline__ float siluf(float x) { return x / (1.f + __expf(-x)); }
__device__ __forceinline__ float logsigf(float z) { return fminf(z, 0.f) - log1pf(__expf(-fabsf(z))); }
__device__ __forceinline__ float red16_max(float v) { v = fmaxf(v, __shfl_xor(v, 1)); v = fmaxf(v, __shfl_xor(v, 2)); v = fmaxf(v, __shfl_xor(v, 4)); v = fmaxf(v, __shfl_xor(v, 8)); return v; }
__device__ __forceinline__ float red16_sum(float v) { v += __shfl_xor(v, 1); v += __shfl_xor(v, 2); v += __shfl_xor(v, 4); v += __shfl_xor(v, 8); return v; }
__device__ __forceinline__ float wave_sum(float v) {
#pragma unroll
    for (int o = 1; o < 64; o <<= 1) v += __shfl_xor(v, o);
    return v;
}
__device__ __forceinline__ float wave_max(float v) {
#pragma unroll
    for (int o = 1; o < 64; o <<= 1) v = fmaxf(v, __shfl_xor(v, o));
    return v;
}
__device__ __forceinline__ float wave_scan_sum(float v, int lane, bool rev) {
#pragma unroll
    for (int o = 1; o < 64; o <<= 1) { const float t = rev ? __shfl_down(v, o) : __shfl_up(v, o); if (rev ? (lane + o < 64) : (lane >= o)) v += t; }
    return v;
}
__device__ __forceinline__ float wave_scan_max(float v, int lane, bool rev) {
#pragma unroll
    for (int o = 1; o < 64; o <<= 1) { const float t = rev ? __shfl_down(v, o) : __shfl_up(v, o); if (rev ? (lane + o < 64) : (lane >= o)) v = fmaxf(v, t); }
    return v;
}
#define MFMA(a, b, c) __builtin_amdgcn_mfma_f32_16x16x32_bf16((a), (b), (c), 0, 0, 0)
__device__ __forceinline__ bf16x8 frag_rm(const LAS bf16* X, int ld, int row0, int k0, int lane) {
    return *(const LAS bf16x8*)(X + (row0 + (lane & 15)) * ld + k0 + 8 * (lane >> 4));
}
__device__ __forceinline__ bf16x8 frag_tr(const LAS bf16* X, int ld, int k0, int n0, int lane) {
    const int g = lane >> 4, m = lane & 15, q = m >> 2, p = m & 3;
    const LAS bf16* a0 = X + (k0 + 8 * g + q) * ld + n0 + 4 * p;
    const s16x4 lo = __builtin_amdgcn_ds_read_tr16_b64_v4i16((LAS s16x4*)a0);
    const s16x4 hi = __builtin_amdgcn_ds_read_tr16_b64_v4i16((LAS s16x4*)(a0 + 4 * ld));
    bf16x8 r; r[0] = lo[0]; r[1] = lo[1]; r[2] = lo[2]; r[3] = lo[3]; r[4] = hi[0]; r[5] = hi[1]; r[6] = hi[2]; r[7] = hi[3]; return r;
}

struct Params {
    const float *x, *c, *ctx, *c_ctx, *w_ada, *b_ada, *ln_g, *ln_b, *w_in_even, *w_out_even, *gla_gate_w, *gla_gate_b, *gla_norm_g, *na_rpb, *w_in_odd, *w_out_odd, *ml_gate_b, *ml_norm_g, *sw_sink;
    float* out; unsigned char* ws; long long ph_lo, ph_hi;
};
typedef const __attribute__((address_space(4))) Params* KP;
__device__ __forceinline__ KP kparams() { unsigned long long v = (unsigned long long)__builtin_amdgcn_kernarg_segment_ptr(); asm volatile("" : "+s"(v)); return (KP)v; }

__device__ __forceinline__ int orig_col(int type, int n) {
    if (type == 0) { if (n < 1536) return n; if (n < 3584) return n + 32; if (n < 3616) return n - 3584 + 1536; return -1; }
    if (type == 1) { if (n < 1536) return n; if (n < 2816) return n + 16; if (n < 2832) return n - 2816 + 1536; return -1; }
    return n;
}
__device__ __forceinline__ float col_scale(int type, int n) {
    if (type == 0) return (n < 256 || (n >= 1536 && n < 2048)) ? 0.125f : 1.f;
    if (type == 1) return ((n >= 256 && n < 512) || (n >= 1536 && n < 2048)) ? 0.125f : 1.f;
    return 1.f;
}
__device__ __forceinline__ void p0_transpose_item(const float* __restrict__ W, int K, int Norig, int type, bf16* __restrict__ WT, LAS float* scr, int nblk, int item, int lane) {
    const int kb = item / nblk, nb = item % nblk, k0 = 64 * kb, n0 = 32 * nb;
    const int oc = orig_col(type, n0 + (lane & 31)); const float sc = col_scale(type, n0 + (lane & 31));
#pragma unroll 8
    for (int i = 0; i < 32; ++i) { const int kk = 2 * i + (lane >> 5); scr[kk * 33 + (lane & 31)] = oc >= 0 ? W[(size_t)(k0 + kk) * Norig + oc] * sc : 0.f; }
    LDS_WAIT();
    const int c = lane & 7;
#pragma unroll
    for (int j = 0; j < 4; ++j) { const int n = (lane >> 3) + 8 * j; const LAS float* s = scr + (8 * c) * 33 + n;
        u32x4 o; o.x = pk2(s[0 * 33], s[1 * 33]); o.y = pk2(s[2 * 33], s[3 * 33]); o.z = pk2(s[4 * 33], s[5 * 33]); o.w = pk2(s[6 * 33], s[7 * 33]);
        *(u32x4*)(WT + (size_t)(n0 + n) * K + k0 + 8 * c) = o; }
    LDS_WAIT();
}
__device__ __forceinline__ void phase_prologue(KP p, LAS unsigned char* lds) {
    const int tid = otid(), lane = tid & 63, wave = tid >> 6;
    unsigned char* ws = p->ws;
    float* MOD = (float*)(ws + WS_MOD);
    if ((int)blockIdx.x < 192) {
        LAS float* cond = (LAS float*)lds;
        LAS float* red = (LAS float*)(lds + 36864);
        for (int e = tid; e < 9 * 1024; e += NTHR) { const int j = e >> 10, k = e & 1023; const float v = j < 8 ? p->c[j * 1024 + k] : p->c_ctx[k]; cond[e] = siluf(v); }
        __syncthreads();
        for (int it = blockIdx.x; it < 192; it += gridDim.x) {
            const int l = it / 48, n0 = (it % 48) * 64, cq = tid & 15, ks = tid >> 4;
            float acc[9][4];
#pragma unroll
            for (int j = 0; j < 9; ++j) { acc[j][0] = 0.f; acc[j][1] = 0.f; acc[j][2] = 0.f; acc[j][3] = 0.f; }
            const float* wp = p->w_ada + (size_t)l * 1024 * 3072 + (size_t)(ks * 32) * 3072 + n0 + 4 * cq;
#pragma unroll 4
            for (int kk = 0; kk < 32; ++kk) { const f32x4 w = *(const f32x4*)(wp + (size_t)kk * 3072);
#pragma unroll
                for (int j = 0; j < 9; ++j) { const float cv = cond[j * 1024 + ks * 32 + kk]; acc[j][0] += cv * w[0]; acc[j][1] += cv * w[1]; acc[j][2] += cv * w[2]; acc[j][3] += cv * w[3]; } }
#pragma unroll
            for (int j = 0; j < 9; ++j)
#pragma unroll
                for (int i = 0; i < 4; ++i) red[ks * 576 + j * 64 + 4 * cq + i] = acc[j][i];
            __syncthreads();
            for (int o = tid; o < 576; o += NTHR) { float s = 0.f; for (int q = 0; q < 32; ++q) s += red[q * 576 + o]; const int j = o >> 6, n = n0 + (o & 63);
                MOD[(size_t)(l * 9 + j) * 3072 + n] = s + p->b_ada[l * 3072 + n]; }
            __syncthreads();
        }
    }
    if (blockIdx.x == gridDim.x - 1) {
        float* cosT = (float*)(ws + WS_ROPE); float* sinT = cosT + 1024;
        for (int e = tid; e < 1024; e += NTHR) { const int pos = e >> 4, i = e & 15;
            double f = 1.0; for (int q = 0; q < i; ++q) f *= 0.5623413251903491;
            const double f2 = f * f; double sn = 1.0, cs = 1.0;
            for (int q = 12; q >= 1; --q) { sn = 1.0 - f2 / ((2.0 * q) * (2.0 * q + 1.0)) * sn; cs = 1.0 - f2 / ((2.0 * q - 1.0) * (2.0 * q)) * cs; }
            sn *= f;
            double c = 1.0, s = 0.0; for (int q = 0; q < pos; ++q) { const double c2 = c * cs - s * sn, s2 = s * cs + c * sn; c = c2; s = s2; }
            cosT[e] = (float)c; sinT[e] = (float)s; }
    }
    __syncthreads();
    {
        LAS float* scr = (LAS float*)(lds + wave * 16384);
        const int gw = blockIdx.x * NWAVES + wave, NGW = gridDim.x * NWAVES;
        constexpr int I_E = 16 * (NPAD_EVEN / 32), I_O = 16 * (NPAD_ODD / 32), I_W = 16 * 32;
        constexpr int NIT = 2 * I_E + 2 * I_O + 4 * I_W;
        for (int it = gw; it < NIT; it += NGW) {
            int r = it;
            if (r < 2 * I_E) { const int i = r / I_E; r -= i * I_E; p0_transpose_item(p->w_in_even + (size_t)i * 1024 * NORIG_EVEN, 1024, NORIG_EVEN, 0, (bf16*)(ws + WS_WIE) + (size_t)i * NPAD_EVEN * 1024, scr, NPAD_EVEN / 32, r, lane); continue; }
            r -= 2 * I_E;
            if (r < 2 * I_O) { const int i = r / I_O; r -= i * I_O; p0_transpose_item(p->w_in_odd + (size_t)i * 1024 * NORIG_ODD, 1024, NORIG_ODD, 1, (bf16*)(ws + WS_WIO) + (size_t)i * NPAD_ODD * 1024, scr, NPAD_ODD / 32, r, lane); continue; }
            r -= 2 * I_O;
            { const int l = r / I_W; r -= l * I_W; const float* W = (l & 1) ? p->w_out_odd + (size_t)(l >> 1) * 1024 * 1024 : p->w_out_even + (size_t)(l >> 1) * 1024 * 1024;
              p0_transpose_item(W, 1024, 1024, 2, (bf16*)(ws + WS_WO) + (size_t)l * 1024 * 1024, scr, 32, r, lane); }
        }
    }
}
__device__ __forceinline__ void phase_h0(KP p) {
    const int lane = otid() & 63, gw = blockIdx.x * NWAVES + (otid() >> 6), NGW = gridDim.x * NWAVES;
    const float* MOD = (const float*)(p->ws + WS_MOD); bf16* H = (bf16*)(p->ws + WS_H);
    for (int m = gw; m < MTOT; m += NGW) {
        const int jb = m < MLAT ? (m >> 12) : 8;
        const float* src = m < MLAT ? p->x + (size_t)m * DM : p->ctx + (size_t)(m - MLAT) * DM;
        const float* md = MOD + (size_t)jb * 3072;
#pragma unroll
        for (int j = 0; j < 4; ++j) { const int k = 4 * lane + 256 * j; const f32x4 v = *(const f32x4*)(src + k), sh = *(const f32x4*)(md + k), sc = *(const f32x4*)(md + 1024 + k);
            const f32x4 h = v * (sc + 1.0f) + sh; u32x2 o; o.x = pk2(h[0], h[1]); o.y = pk2(h[2], h[3]); *(u32x2*)(H + (size_t)m * DM + k) = o; }
    }
}
__device__ __forceinline__ void phase_ln(KP p, int l) {
    const int lane = otid() & 63, gw = blockIdx.x * NWAVES + (otid() >> 6), NGW = gridDim.x * NWAVES;
    const float* MOD = (const float*)(p->ws + WS_MOD); bf16* H = (bf16*)(p->ws + WS_H); const bf16* Y = (const bf16*)(p->ws + WS_P); float* XC = (float*)(p->ws + WS_XC);
    const int mrows = l < DEPTH - 1 ? MTOT : MLAT;
    const float* lg = p->ln_g + l * DM; const float* lb = p->ln_b + l * DM;
    for (int m = gw; m < mrows; m += NGW) {
        const int jb = m < MLAT ? (m >> 12) : 8;
        const float* src = l == 0 ? (m < MLAT ? p->x + (size_t)m * DM : p->ctx + (size_t)(m - MLAT) * DM) : (m < MLAT ? p->out + (size_t)m * DM : XC + (size_t)(m - MLAT) * DM);
        float* dst = m < MLAT ? p->out + (size_t)m * DM : XC + (size_t)(m - MLAT) * DM;
        const float* md = MOD + (size_t)(l * 9 + jb) * 3072;
        f32x4 v[4]; float s = 0.f;
#pragma unroll
        for (int j = 0; j < 4; ++j) { const int k = 4 * lane + 256 * j; const f32x4 xv = *(const f32x4*)(src + k), g = *(const f32x4*)(md + 2048 + k); const u32x2 yw = *(const u32x2*)(Y + (size_t)m * DM + k);
            f32x4 y; y[0] = bflo(yw.x); y[1] = bfhi(yw.x); y[2] = bflo(yw.y); y[3] = bfhi(yw.y);
            v[j] = xv * ALPHA_DN + g * y; s += (v[j][0] + v[j][1]) + (v[j][2] + v[j][3]); }
        const float mean = wave_sum(s) * (1.f / DM); float s2 = 0.f;
#pragma unroll
        for (int j = 0; j < 4; ++j) { v[j] = v[j] - mean; s2 += (v[j][0] * v[j][0] + v[j][1] * v[j][1]) + (v[j][2] * v[j][2] + v[j][3] * v[j][3]); }
        const float rstd = 1.f / sqrtf(wave_sum(s2) * (1.f / DM) + 1e-5f);
        const float* md2 = MOD + (size_t)((l + 1) * 9 + jb) * 3072;
#pragma unroll
        for (int j = 0; j < 4; ++j) { const int k = 4 * lane + 256 * j; const f32x4 o = v[j] * rstd * *(const f32x4*)(lg + k) + *(const f32x4*)(lb + k);
            *(f32x4*)(dst + k) = o;
            if (l < DEPTH - 1) { const f32x4 sh = *(const f32x4*)(md2 + k), sc = *(const f32x4*)(md2 + 1024 + k); const f32x4 h = o * (sc + 1.0f) + sh;
                u32x2 w; w.x = pk2(h[0], h[1]); w.y = pk2(h[2], h[3]); *(u32x2*)(H + (size_t)m * DM + k) = w; } }
    }
}
constexpr int AT_KS = 0, AT_VS = 9216, AT_PS = 18432, AT_RPB = AT_PS + 8 * 2304;
__device__ __forceinline__ void attn_item(LAS unsigned char* lds, const bf16* __restrict__ P, int ldp, bf16* __restrict__ Z, int mode,
                                          int qrow0, int qcol, int kcol, int vcol, int gcol, int zcol,
                                          int nlat, int lat_row0, int ctx_row0, int qa_, int qb_, int ka_, const float* __restrict__ rpb_g, float sink) {
    const int tid = otid(), lane = tid & 63, wave = tid >> 6, fq = lane >> 4, fr = lane & 15;
    LAS bf16* Ks = (LAS bf16*)(lds + AT_KS); LAS bf16* Vs = (LAS bf16*)(lds + AT_VS); LAS bf16* Ps = (LAS bf16*)(lds + AT_PS + wave * 2304); LAS float* rpb = (LAS float*)(lds + AT_RPB);
    __syncthreads();
    if (mode == 0) { for (int e = tid; e < 465; e += NTHR) rpb[e] = rpb_g[e]; }
    bf16x8 qa[2];
#pragma unroll
    for (int ks = 0; ks < 2; ++ks) qa[ks] = *(const bf16x8*)(P + (size_t)(qrow0 + fr) * ldp + qcol + 32 * ks + 8 * fq);
    float mrow[4], lsum[4]; f32x4 oacc[4];
#pragma unroll
    for (int r = 0; r < 4; ++r) { mrow[r] = -1e30f; lsum[r] = 0.f; oacc[r] = (f32x4){0.f, 0.f, 0.f, 0.f}; }
    const int ntile = nlat + 4, srow = tid >> 3, sch = tid & 7;
    u32x4 kreg, vreg;
    { const int rb = nlat > 0 ? lat_row0 : ctx_row0; kreg = *(const u32x4*)(P + (size_t)(rb + srow) * ldp + kcol + 8 * sch); vreg = *(const u32x4*)(P + (size_t)(rb + srow) * ldp + vcol + 8 * sch); }
    for (int i = 0; i < ntile; ++i) {
        __syncthreads();
        *(LAS u32x4*)(Ks + srow * 72 + 8 * sch) = kreg; *(LAS u32x4*)(Vs + srow * 72 + 8 * sch) = vreg;
        __syncthreads();
        if (i + 1 < ntile) { const int rb = (i + 1 < nlat) ? lat_row0 + 64 * (i + 1) : ctx_row0 + 64 * (i + 1 - nlat);
            kreg = *(const u32x4*)(P + (size_t)(rb + srow) * ldp + kcol + 8 * sch); vreg = *(const u32x4*)(P + (size_t)(rb + srow) * ldp + vcol + 8 * sch); }
        const bool islat = i < nlat;
        bool active = true; int kt0 = 0;
        if (islat) {
            if (mode == 0) { kt0 = ka_ + i; const int rs = min(max(qa_ - 4, 0), 56); active = (kt0 >= rs) && (kt0 < rs + 8); }
            else { kt0 = ka_ + 64 * i; active = !(kt0 > qa_ + 15 + 128 || kt0 + 63 < qa_ - 128); }
        }
        if (active) {
            f32x4 s[4];
#pragma unroll
            for (int nt = 0; nt < 4; ++nt) { s[nt] = (f32x4){0.f, 0.f, 0.f, 0.f};
#pragma unroll
                for (int ks = 0; ks < 2; ++ks) s[nt] = MFMA(qa[ks], frag_rm(Ks, 72, 16 * nt, 32 * ks, lane), s[nt]); }
            float tmax[4] = {-3e38f, -3e38f, -3e38f, -3e38f};
#pragma unroll
            for (int nt = 0; nt < 4; ++nt)
#pragma unroll
                for (int r = 0; r < 4; ++r) { float v = s[nt][r];
                    if (islat) {
                        if (mode == 0) { const int qc = qb_ + 4 * fq + r, kc = 16 * nt + fr, cs = min(max(qc - 8, 0), 48); const bool ok = (kc >= cs) && (kc < cs + 16);
                            const int bi = (kt0 - qa_ + 7) * 31 + (kc - qc + 15); v = ok ? v + rpb[ok ? bi : 0] : -3e38f; }
                        else { const int qt = qa_ + 4 * fq + r, kt = kt0 + 16 * nt + fr; const int d = qt - kt; v = (d <= 128 && d >= -128) ? v : -3e38f; }
                    }
                    s[nt][r] = v; tmax[r] = fmaxf(tmax[r], v); }
#pragma unroll
            for (int r = 0; r < 4; ++r) { const float tm = red16_max(tmax[r]); const float mnew = fmaxf(mrow[r], tm); const float alpha = __expf(mrow[r] - mnew); mrow[r] = mnew;
                float ps = 0.f;
#pragma unroll
                for (int nt = 0; nt < 4; ++nt) { const float pv = __expf(s[nt][r] - mnew); ps += pv; Ps[(4 * fq + r) * 72 + 16 * nt + fr] = (bf16)f2bf(pv); oacc[nt][r] *= alpha; }
                lsum[r] = lsum[r] * alpha + ps; }
            LDS_WAIT();
#pragma unroll
            for (int ks = 0; ks < 2; ++ks) { const bf16x8 pa = frag_rm(Ps, 72, 0, 32 * ks, lane);
#pragma unroll
                for (int nt = 0; nt < 4; ++nt) oacc[nt] = MFMA(pa, frag_tr(Vs, 72, 32 * ks, 16 * nt, lane), oacc[nt]); }
            LDS_WAIT();
        }
    }
#pragma unroll
    for (int r = 0; r < 4; ++r) { float lt = red16_sum(lsum[r]); float sc;
        if (mode == 1 || mode == 3) { const float mf = fmaxf(mrow[r], sink); const float al = __expf(mrow[r] - mf); lt = lt * al + __expf(sink - mf); sc = al / lt; } else sc = 1.f / lt;
#pragma unroll
        for (int nt = 0; nt < 4; ++nt) Ps[(4 * fq + r) * 72 + 16 * nt + fr] = (bf16)f2bf(oacc[nt][r] * sc); }
    LDS_WAIT();
#pragma unroll
    for (int c2 = 0; c2 < 2; ++c2) { const int idx = lane + 64 * c2, q = idx >> 3, ch = idx & 7;
        const u32x4 ov = *(const LAS u32x4*)(Ps + q * 72 + 8 * ch); const u32x4 gv = *(const u32x4*)(P + (size_t)(qrow0 + q) * ldp + gcol + 8 * ch);
        u32x4 w;
        w.x = pk2(bflo(ov.x) * siluf(bflo(gv.x)), bfhi(ov.x) * siluf(bfhi(gv.x))); w.y = pk2(bflo(ov.y) * siluf(bflo(gv.y)), bfhi(ov.y) * siluf(bfhi(gv.y)));
        w.z = pk2(bflo(ov.z) * siluf(bflo(gv.z)), bfhi(ov.z) * siluf(bfhi(gv.z))); w.w = pk2(bflo(ov.w) * siluf(bflo(gv.w)), bfhi(ov.w) * siluf(bfhi(gv.w)));
        *(u32x4*)(Z + (size_t)(qrow0 + q) * DM + zcol + 8 * ch) = w; }
    LDS_WAIT();
}
__device__ __forceinline__ void phase_attn(KP p, LAS unsigned char* lds, int l, bool need_ctx) {
    const int wave = otid() >> 6; const bool odd = l & 1; const int li = l >> 1;
    const bf16* P = (const bf16*)(p->ws + WS_P); bf16* Z = (bf16*)(p->ws + WS_H); const int ldp = odd ? NP_ODD : NP_EVEN;
    const int nmain = BATCH * 8 * 32, nctx = need_ctx ? BATCH * 8 * 2 : 0;
    for (int it = blockIdx.x; it < nmain + nctx; it += gridDim.x) {
        if (it < nmain) {
            const int b = it >> 8, h = (it >> 5) & 7, qb = it & 31;
            if (!odd) { const int r0 = 2 * qb, rw = r0 + (wave >> 2); const int rs0 = min(max(r0 - 4, 0), 56), rs1 = min(max(r0 + 1 - 4, 0), 56);
                attn_item(lds, P, ldp, Z, 0, b * SEQ + rw * 64 + 16 * (wave & 3), 1536 + h * 64, 2048 + h * 64, 2560 + h * 64, 3072 + h * 64, 512 + h * 64,
                          rs1 + 8 - rs0, b * SEQ + rs0 * 64, MLAT + b * CTXL, rw, 16 * (wave & 3), rs0, p->na_rpb + (size_t)(li * 8 + h) * 465, 0.f); }
            else { const int kv = h >> 2, t0 = 128 * qb, lt0 = max(0, 2 * qb - 2), lt1 = min(63, 2 * qb + 3);
                attn_item(lds, P, ldp, Z, 1, b * SEQ + t0 + 16 * wave, 1536 + h * 64, 2048 + kv * 64, 2176 + kv * 64, 2304 + h * 64, 512 + h * 64,
                          lt1 - lt0 + 1, b * SEQ + lt0 * 64, MLAT + b * CTXL, t0 + 16 * wave, 0, lt0 * 64, nullptr, p->sw_sink[li * 8 + h]); }
        } else {
            const int j = it - nmain, b = j >> 4, h = (j >> 1) & 7, half = j & 1; const int q0 = MLAT + b * CTXL + 128 * half + 16 * wave;
            if (!odd) attn_item(lds, P, ldp, Z, 2, q0, 1536 + h * 64, 2048 + h * 64, 2560 + h * 64, 3072 + h * 64, 512 + h * 64, 0, 0, MLAT + b * CTXL, 0, 0, 0, nullptr, 0.f);
            else { const int kv = h >> 2; attn_item(lds, P, ldp, Z, 3, q0, 1536 + h * 64, 2048 + kv * 64, 2176 + kv * 64, 2304 + h * 64, 512 + h * 64, 0, 0, MLAT + b * CTXL, 0, 0, 0, nullptr, p->sw_sink[li * 8 + h]); }
        }
    }
}
__device__ __forceinline__ int chunk_row0(int b, int cp) { return cp < 4 ? MLAT + b * CTXL + cp * 64 : b * SEQ + (cp - 4) * 64; }
constexpr int SL_KDF = 0, SL_KDB = 9216, SL_VS = 18432, SL_SEG = 35840, SL_MISC = 39936;
__device__ __forceinline__ void phase_scan_local(KP p, LAS unsigned char* lds, int l) {
    const int tid = otid(), lane = tid & 63, wave = tid >> 6, fq = lane >> 4, fr = lane & 15; const bool odd = l & 1; const int li = l >> 1;
    const bf16* P = (const bf16*)(p->ws + WS_P); const int ldp = odd ? NP_ODD : NP_EVEN; const float* SM = (const float*)(p->ws + WS_SM);
    float* S = (float*)(p->ws + WS_S); float* GAM = (float*)(p->ws + WS_GAM); float* SC = (float*)(p->ws + WS_SC);
    LAS bf16* kdf = (LAS bf16*)(lds + SL_KDF); LAS bf16* kdb = (LAS bf16*)(lds + SL_KDB); LAS bf16* vs = (LAS bf16*)(lds + SL_VS);
    LAS float* seg = (LAS float*)(lds + SL_SEG); LAS float* misc = (LAS float*)(lds + SL_MISC);
    const int dk = tid & 63, sg = tid >> 6;
    for (int it = blockIdx.x; it < BATCH * 4 * NCHUNK; it += gridDim.x) {
        const int b = it / (4 * NCHUNK), h = (it / NCHUNK) & 3, cp = it % NCHUNK; const int row0 = chunk_row0(b, cp);
        const int slf = ((b * 4 + h) * 2 + 0) * NCHUNK + cp, slb = slf + NCHUNK;
        __syncthreads();
#pragma unroll
        for (int c2 = 0; c2 < 2; ++c2) { const int idx = tid + NTHR * c2, t = idx >> 4, ch = idx & 15; *(LAS u32x4*)(vs + t * 136 + 8 * ch) = *(const u32x4*)(P + (size_t)(row0 + t) * ldp + 512 + h * 128 + 8 * ch); }
        float kv[8];
#pragma unroll
        for (int tt = 0; tt < 8; ++tt) kv[tt] = bf2f(P[(size_t)(row0 + sg * 8 + tt) * ldp + 256 + h * 64 + dk]);
        if (!odd) {
            float gwf[16], gwb[16];
            const float* gw = p->gla_gate_w + (size_t)li * 2 * 16 * 256; const float* gb = p->gla_gate_b + (size_t)li * 2 * 256;
#pragma unroll
            for (int r = 0; r < 16; ++r) { gwf[r] = gw[r * 256 + h * 64 + dk]; gwb[r] = gw[(16 + r) * 256 + h * 64 + dk]; }
            const float gbf = gb[h * 64 + dk], gbb = gb[256 + h * 64 + dk];
            { const int t = tid >> 3, c4 = (tid & 7) * 4; *(LAS f32x4*)(misc + t * 32 + c4) = *(const f32x4*)(SM + (size_t)(row0 + t) * 32 + c4); }
            __syncthreads();
            float pf[8], sb[8];
#pragma unroll
            for (int tt = 0; tt < 8; ++tt) { const LAS float* lr = misc + (sg * 8 + tt) * 32; float zf = gbf, zb = gbb;
#pragma unroll
                for (int r = 0; r < 16; ++r) { zf += lr[r] * gwf[r]; zb += lr[16 + r] * gwb[r]; }
                pf[tt] = logsigf(zf) * 0.0625f; sb[tt] = logsigf(zb) * 0.0625f; }
#pragma unroll
            for (int tt = 1; tt < 8; ++tt) pf[tt] += pf[tt - 1];
#pragma unroll
            for (int tt = 6; tt >= 0; --tt) sb[tt] += sb[tt + 1];
            seg[(0 * 8 + sg) * 64 + dk] = pf[7]; seg[(1 * 8 + sg) * 64 + dk] = sb[0];
            __syncthreads();
            float offf = 0.f, totf = 0.f, offb = 0.f, totb = 0.f;
#pragma unroll
            for (int q = 0; q < 8; ++q) { const float a = seg[q * 64 + dk], c = seg[(8 + q) * 64 + dk]; totf += a; totb += c; if (q < sg) offf += a; if (q > sg) offb += c; }
#pragma unroll
            for (int tt = 0; tt < 8; ++tt) { const int t = sg * 8 + tt;
                kdf[t * 72 + dk] = (bf16)f2bf(kv[tt] * __expf(totf - (offf + pf[tt]))); kdb[t * 72 + dk] = (bf16)f2bf(kv[tt] * __expf(totb - (offb + sb[tt]))); }
            if (sg == 0) { GAM[(size_t)slf * 64 + dk] = __expf(totf); GAM[(size_t)slb * 64 + dk] = __expf(totb); }
        } else {
            const float* mb = p->ml_gate_b + li * 16;
            if (tid < 128) { const int d = tid >> 6, t = tid & 63; const float* gp = SM + (size_t)(row0 + t) * 32 + d * 8;
                misc[d * 128 + t] = gp[h] + mb[d * 8 + h]; misc[d * 128 + 64 + t] = logsigf(gp[4 + h] + mb[d * 8 + 4 + h]); }
            __syncthreads();
            if (tid < 128) { const int d = tid >> 6, t = tid & 63; const float run = wave_scan_sum(misc[d * 128 + 64 + t], t, d == 1);
                const float tot = d == 0 ? __shfl(run, 63) : __shfl(run, 0);
                const float wl = tot - run + misc[d * 128 + t]; const float ml = wave_max(wl);
                misc[256 + d * 64 + t] = __expf(wl - ml);
                if (t == 0) { const int sl = d == 0 ? slf : slb; SC[(size_t)sl * 4 + 0] = tot; SC[(size_t)sl * 4 + 1] = ml; } }
            __syncthreads();
            float nf = 0.f, nb = 0.f;
#pragma unroll
            for (int tt = 0; tt < 8; ++tt) { const int t = sg * 8 + tt; const float a = kv[tt] * misc[256 + t], c = kv[tt] * misc[256 + 64 + t]; nf += a; nb += c;
                kdf[t * 72 + dk] = (bf16)f2bf(a); kdb[t * 72 + dk] = (bf16)f2bf(c); }
            seg[(0 * 8 + sg) * 64 + dk] = nf; seg[(1 * 8 + sg) * 64 + dk] = nb;
            __syncthreads();
            if (sg < 2) { float s2 = 0.f;
#pragma unroll
                for (int q = 0; q < 8; ++q) s2 += seg[(sg * 8 + q) * 64 + dk];
                GAM[(size_t)(sg == 0 ? slf : slb) * 64 + dk] = s2; }
        }
        __syncthreads();
#pragma unroll
        for (int d = 0; d < 2; ++d) { const LAS bf16* kd = d ? kdb : kdf; f32x4 acc[4];
#pragma unroll
            for (int mt = 0; mt < 4; ++mt) acc[mt] = (f32x4){0.f, 0.f, 0.f, 0.f};
#pragma unroll
            for (int ks = 0; ks < 2; ++ks) { const bf16x8 bv = frag_tr(vs, 136, 32 * ks, 16 * wave, lane);
#pragma unroll
                for (int mt = 0; mt < 4; ++mt) acc[mt] = MFMA(frag_tr(kd, 72, 32 * ks, 16 * mt, lane), bv, acc[mt]); }
            float* dst = S + (size_t)(d ? slb : slf) * 8192;
#pragma unroll
            for (int mt = 0; mt < 4; ++mt)
#pragma unroll
                for (int r = 0; r < 4; ++r) dst[(16 * mt + 4 * fq + r) * 128 + 16 * wave + fr] = acc[mt][r]; }
    }
}
__device__ __forceinline__ void phase_scan_seq(KP p, int l) {
    const bool odd = l & 1;
    f32x4* S4 = (f32x4*)(p->ws + WS_S); float* GAM = (float*)(p->ws + WS_GAM); f32x4* GAM4 = (f32x4*)(p->ws + WS_GAM); float* SC = (float*)(p->ws + WS_SC);
    const int nthreads = gridDim.x * NTHR;
    for (int gid = blockIdx.x * NTHR + otid(); gid < 64 * 2048; gid += nthreads) {
        const int chain = gid >> 11, e4 = gid & 2047, dir = chain & 1, dkk = e4 >> 5; const int base = chain * NCHUNK;
        f32x4 st = (f32x4){0.f, 0.f, 0.f, 0.f}, nst = (f32x4){0.f, 0.f, 0.f, 0.f}; float m = 0.f; const bool hasn = odd && e4 < 16;
        for (int s0 = 0; s0 < NCHUNK; s0 += 4) {
            f32x4 d[4], dn[4]; float g0[4], g1[4]; int idx[4];
#pragma unroll
            for (int u = 0; u < 4; ++u) { const int step = s0 + u; const int cp = dir == 0 ? step : (step < 4 ? 3 - step : 71 - step); idx[u] = base + cp;
                d[u] = S4[(size_t)idx[u] * 2048 + e4];
                if (!odd) { g0[u] = GAM[(size_t)idx[u] * 64 + dkk]; g1[u] = 0.f; } else { g0[u] = SC[(size_t)idx[u] * 4 + 0]; g1[u] = SC[(size_t)idx[u] * 4 + 1]; if (hasn) dn[u] = GAM4[(size_t)idx[u] * 16 + e4]; } }
#pragma unroll
            for (int u = 0; u < 4; ++u) {
                S4[(size_t)idx[u] * 2048 + e4] = st;
                if (!odd) { st = st * g0[u] + d[u]; }
                else { if (hasn) GAM4[(size_t)idx[u] * 16 + e4] = nst; if (e4 == 0) SC[(size_t)idx[u] * 4 + 2] = m;
                    const float mn = fmaxf(g0[u] + m, g1[u]); const float dec = __expf(g0[u] + m - mn), sc = __expf(g1[u] - mn);
                    st = st * dec + d[u] * sc; if (hasn) nst = nst * dec + dn[u] * sc; m = mn; }
            }
        }
    }
}
constexpr int SO_QF = 0, SO_KF = 9216, SO_QB = 18432, SO_KB = 27648, SO_VS = 36864, SO_AF = 54272, SO_AB = 63488, SO_SF = 72704, SO_SB = 90112, SO_SEG = 107520, SO_SSQ = 111616, SO_MISC = 113664;
constexpr int SO_OST = 0;
__device__ __forceinline__ void scan_out_tail(LAS unsigned char* lds, f32x4 (&o)[4], const bf16* __restrict__ P, int ldp, bf16* __restrict__ Z, int row0, int h, const float* __restrict__ ng) {
    const int tid = otid(), lane = tid & 63, wave = tid >> 6, fq = lane >> 4, fr = lane & 15;
    LAS float* ssq = (LAS float*)(lds + SO_SSQ); LAS float* ost = (LAS float*)(lds + SO_OST);
#pragma unroll
    for (int mt = 0; mt < 4; ++mt)
#pragma unroll
        for (int r = 0; r < 4; ++r) { const float q = red16_sum(o[mt][r] * o[mt][r]); if (fr == 0) ssq[wave * 64 + 16 * mt + 4 * fq + r] = q; }
    __syncthreads();
#pragma unroll
    for (int mt = 0; mt < 4; ++mt)
#pragma unroll
        for (int r = 0; r < 4; ++r) { const int t = 16 * mt + 4 * fq + r; float q = 0.f;
#pragma unroll
            for (int w = 0; w < 8; ++w) q += ssq[w * 64 + t];
            ost[t * 132 + 16 * wave + fr] = o[mt][r] * rsqrtf(q * (1.f / 128.f) + 1e-6f); }
    __syncthreads();
#pragma unroll
    for (int c2 = 0; c2 < 2; ++c2) { const int idx = tid + NTHR * c2, t = idx >> 4, ch = idx & 15;
        const f32x4 o0 = *(const LAS f32x4*)(ost + t * 132 + 8 * ch), o1 = *(const LAS f32x4*)(ost + t * 132 + 8 * ch + 4);
        const f32x4 g0 = *(const f32x4*)(ng + h * 128 + 8 * ch), g1 = *(const f32x4*)(ng + h * 128 + 8 * ch + 4);
        const u32x4 gv = *(const u32x4*)(P + (size_t)(row0 + t) * ldp + 1024 + h * 128 + 8 * ch);
        u32x4 w;
        w.x = pk2(o0[0] * g0[0] * siluf(bflo(gv.x)), o0[1] * g0[1] * siluf(bfhi(gv.x))); w.y = pk2(o0[2] * g0[2] * siluf(bflo(gv.y)), o0[3] * g0[3] * siluf(bfhi(gv.y)));
        w.z = pk2(o1[0] * g1[0] * siluf(bflo(gv.z)), o1[1] * g1[1] * siluf(bfhi(gv.z))); w.w = pk2(o1[2] * g1[2] * siluf(bflo(gv.w)), o1[3] * g1[3] * siluf(bfhi(gv.w)));
        *(u32x4*)(Z + (size_t)(row0 + t) * DM + h * 128 + 8 * ch) = w; }
}
__device__ __forceinline__ void stage_state(LAS bf16* dst, const float* __restrict__ src) {
    const int tid = otid();
#pragma unroll
    for (int c4 = 0; c4 < 4; ++c4) { const int idx = tid + NTHR * c4, r = idx >> 5, c = (idx & 31) * 4; const f32x4 v = *(const f32x4*)(src + r * 128 + c);
        u32x2 w; w.x = pk2(v[0], v[1]); w.y = pk2(v[2], v[3]); *(LAS u32x2*)(dst + r * 136 + c) = w; }
}
__device__ __forceinline__ void phase_scan_out_gla(KP p, LAS unsigned char* lds, int l, bool need_ctx) {
    const int tid = otid(), lane = tid & 63, wave = tid >> 6, fq = lane >> 4, fr = lane & 15; const int li = l >> 1;
    const bf16* P = (const bf16*)(p->ws + WS_P); const int ldp = NP_EVEN; const float* SM = (const float*)(p->ws + WS_SM); bf16* Z = (bf16*)(p->ws + WS_H);
    const float* S = (const float*)(p->ws + WS_S);
    LAS bf16* qf = (LAS bf16*)(lds + SO_QF); LAS bf16* kf = (LAS bf16*)(lds + SO_KF); LAS bf16* qb = (LAS bf16*)(lds + SO_QB); LAS bf16* kb = (LAS bf16*)(lds + SO_KB);
    LAS bf16* vs = (LAS bf16*)(lds + SO_VS); LAS bf16* Af = (LAS bf16*)(lds + SO_AF); LAS bf16* Ab = (LAS bf16*)(lds + SO_AB); LAS bf16* Sf = (LAS bf16*)(lds + SO_SF); LAS bf16* Sb = (LAS bf16*)(lds + SO_SB);
    LAS float* seg = (LAS float*)(lds + SO_SEG); LAS float* lrs = (LAS float*)(lds + SO_MISC);
    const int dk = tid & 63, sg = tid >> 6;
    for (int it = blockIdx.x; it < BATCH * 4 * NCHUNK; it += gridDim.x) {
        const int b = it / (4 * NCHUNK), h = (it / NCHUNK) & 3, cp = it % NCHUNK; if (cp < 4 && !need_ctx) continue;
        const int row0 = chunk_row0(b, cp); const int slf = ((b * 4 + h) * 2 + 0) * NCHUNK + cp, slb = slf + NCHUNK;
        __syncthreads();
#pragma unroll
        for (int c2 = 0; c2 < 2; ++c2) { const int idx = tid + NTHR * c2, t = idx >> 4, ch = idx & 15; *(LAS u32x4*)(vs + t * 136 + 8 * ch) = *(const u32x4*)(P + (size_t)(row0 + t) * ldp + 512 + h * 128 + 8 * ch); }
        stage_state(Sf, S + (size_t)slf * 8192); stage_state(Sb, S + (size_t)slb * 8192);
        float qv[8], kv[8];
#pragma unroll
        for (int tt = 0; tt < 8; ++tt) { const size_t ro = (size_t)(row0 + sg * 8 + tt) * ldp + h * 64 + dk; qv[tt] = bf2f(P[ro]); kv[tt] = bf2f(P[ro + 256]); }
        float gwf[16], gwb[16];
        const float* gw = p->gla_gate_w + (size_t)li * 2 * 16 * 256; const float* gb = p->gla_gate_b + (size_t)li * 2 * 256;
#pragma unroll
        for (int r = 0; r < 16; ++r) { gwf[r] = gw[r * 256 + h * 64 + dk]; gwb[r] = gw[(16 + r) * 256 + h * 64 + dk]; }
        const float gbf = gb[h * 64 + dk], gbb = gb[256 + h * 64 + dk];
        { const int t = tid >> 3, c4 = (tid & 7) * 4; *(LAS f32x4*)(lrs + t * 32 + c4) = *(const f32x4*)(SM + (size_t)(row0 + t) * 32 + c4); }
        __syncthreads();
        float pf[8], sb[8];
#pragma unroll
        for (int tt = 0; tt < 8; ++tt) { const LAS float* lr = lrs + (sg * 8 + tt) * 32; float zf = gbf, zb = gbb;
#pragma unroll
            for (int r = 0; r < 16; ++r) { zf += lr[r] * gwf[r]; zb += lr[16 + r] * gwb[r]; }
            pf[tt] = logsigf(zf) * 0.0625f; sb[tt] = logsigf(zb) * 0.0625f; }
#pragma unroll
        for (int tt = 1; tt < 8; ++tt) pf[tt] += pf[tt - 1];
#pragma unroll
        for (int tt = 6; tt >= 0; --tt) sb[tt] += sb[tt + 1];
        seg[(0 * 8 + sg) * 64 + dk] = pf[7]; seg[(1 * 8 + sg) * 64 + dk] = sb[0];
        __syncthreads();
        float offf = 0.f, offb = 0.f;
#pragma unroll
        for (int q = 0; q < 8; ++q) { const float a = seg[q * 64 + dk], c = seg[(8 + q) * 64 + dk]; if (q < sg) offf += a; if (q > sg) offb += c; }
#pragma unroll
        for (int tt = 0; tt < 8; ++tt) { const int t = sg * 8 + tt; const float bf_ = offf + pf[tt], bb_ = offb + sb[tt];
            qf[t * 72 + dk] = (bf16)f2bf(qv[tt] * __expf(bf_)); kf[t * 72 + dk] = (bf16)f2bf(kv[tt] * __expf(-bf_));
            qb[t * 72 + dk] = (bf16)f2bf(qv[tt] * __expf(bb_)); kb[t * 72 + dk] = (bf16)f2bf(kv[tt] * __expf(-bb_)); }
        __syncthreads();
        { const int mt = wave >> 1;
#pragma unroll
          for (int n2 = 0; n2 < 2; ++n2) { const int nt = 2 * (wave & 1) + n2; f32x4 af = (f32x4){0.f, 0.f, 0.f, 0.f}, ab = (f32x4){0.f, 0.f, 0.f, 0.f};
#pragma unroll
              for (int ks = 0; ks < 2; ++ks) { af = MFMA(frag_rm(qf, 72, 16 * mt, 32 * ks, lane), frag_rm(kf, 72, 16 * nt, 32 * ks, lane), af);
                                               ab = MFMA(frag_rm(qb, 72, 16 * mt, 32 * ks, lane), frag_rm(kb, 72, 16 * nt, 32 * ks, lane), ab); }
#pragma unroll
              for (int r = 0; r < 4; ++r) { const int t = 16 * mt + 4 * fq + r, s = 16 * nt + fr;
                  Af[t * 72 + s] = (bf16)f2bf(s <= t ? af[r] : 0.f); Ab[t * 72 + s] = (bf16)f2bf(s >= t ? ab[r] : 0.f); } } }
        __syncthreads();
        f32x4 o[4];
#pragma unroll
        for (int mt = 0; mt < 4; ++mt) o[mt] = (f32x4){0.f, 0.f, 0.f, 0.f};
#pragma unroll
        for (int ks = 0; ks < 2; ++ks) { const bf16x8 bv = frag_tr(vs, 136, 32 * ks, 16 * wave, lane), bsf = frag_tr(Sf, 136, 32 * ks, 16 * wave, lane), bsb = frag_tr(Sb, 136, 32 * ks, 16 * wave, lane);
#pragma unroll
            for (int mt = 0; mt < 4; ++mt) { o[mt] = MFMA(frag_rm(Af, 72, 16 * mt, 32 * ks, lane), bv, o[mt]); o[mt] = MFMA(frag_rm(Ab, 72, 16 * mt, 32 * ks, lane), bv, o[mt]);
                o[mt] = MFMA(frag_rm(qf, 72, 16 * mt, 32 * ks, lane), bsf, o[mt]); o[mt] = MFMA(frag_rm(qb, 72, 16 * mt, 32 * ks, lane), bsb, o[mt]); } }
        scan_out_tail(lds, o, P, ldp, Z, row0, h, p->gla_norm_g + (size_t)li * 512);
    }
}
constexpr int MO_QS = 0, MO_KS = 9216, MO_QWF = 18432, MO_QWB = 27648;
__device__ __forceinline__ void phase_scan_out_mlstm(KP p, LAS unsigned char* lds, int l, bool need_ctx) {
    const int tid = otid(), lane = tid & 63, wave = tid >> 6, fq = lane >> 4, fr = lane & 15; const int li = l >> 1;
    const bf16* P = (const bf16*)(p->ws + WS_P); const int ldp = NP_ODD; const float* SM = (const float*)(p->ws + WS_SM); bf16* Z = (bf16*)(p->ws + WS_H);
    const float* S = (const float*)(p->ws + WS_S); const float* GAM = (const float*)(p->ws + WS_GAM); const float* SC = (const float*)(p->ws + WS_SC);
    LAS bf16* qs = (LAS bf16*)(lds + MO_QS); LAS bf16* ks_ = (LAS bf16*)(lds + MO_KS); LAS bf16* qwf = (LAS bf16*)(lds + MO_QWF); LAS bf16* qwb = (LAS bf16*)(lds + MO_QWB);
    LAS bf16* vs = (LAS bf16*)(lds + SO_VS); LAS bf16* Af = (LAS bf16*)(lds + SO_AF); LAS bf16* Ab = (LAS bf16*)(lds + SO_AB); LAS bf16* Cf = (LAS bf16*)(lds + SO_SF); LAS bf16* Cb = (LAS bf16*)(lds + SO_SB);
    LAS float* part = (LAS float*)(lds + SO_SEG);
    LAS float* misc = (LAS float*)(lds + SO_MISC);
    const float* mb = p->ml_gate_b + li * 16;
    for (int it = blockIdx.x; it < BATCH * 4 * NCHUNK; it += gridDim.x) {
        const int b = it / (4 * NCHUNK), h = (it / NCHUNK) & 3, cp = it % NCHUNK; if (cp < 4 && !need_ctx) continue;
        const int row0 = chunk_row0(b, cp); const int slf = ((b * 4 + h) * 2 + 0) * NCHUNK + cp, slb = slf + NCHUNK;
        __syncthreads();
#pragma unroll
        for (int c2 = 0; c2 < 2; ++c2) { const int idx = tid + NTHR * c2, t = idx >> 4, ch = idx & 15; *(LAS u32x4*)(vs + t * 136 + 8 * ch) = *(const u32x4*)(P + (size_t)(row0 + t) * ldp + 512 + h * 128 + 8 * ch); }
        stage_state(Cf, S + (size_t)slf * 8192); stage_state(Cb, S + (size_t)slb * 8192);
        { const int t = tid >> 3, ch = tid & 7; const size_t ro = (size_t)(row0 + t) * ldp + h * 64 + 8 * ch;
          *(LAS u32x4*)(qs + t * 72 + 8 * ch) = *(const u32x4*)(P + ro); *(LAS u32x4*)(ks_ + t * 72 + 8 * ch) = *(const u32x4*)(P + ro + 256); }
        if (tid < 128) { const int d = tid >> 6, t = tid & 63; const float* gp = SM + (size_t)(row0 + t) * 32 + d * 8;
            misc[d * 512 + t] = gp[h] + mb[d * 8 + h]; misc[d * 512 + 64 + t] = logsigf(gp[4 + h] + mb[d * 8 + 4 + h]);
            misc[1024 + d * 64 + t] = GAM[(size_t)(d ? slb : slf) * 64 + t]; }
        __syncthreads();
        if (tid < 128) { const int d = tid >> 6, t = tid & 63; LAS float* md = misc + d * 512; const float run = wave_scan_sum(md[64 + t], t, d == 1); const float pm = wave_scan_max(md[t] - run, t, d == 1);
            const float mprev = SC[(size_t)(d ? slb : slf) * 4 + 2];
            const float mt_ = fmaxf(run + pm, run + mprev);
            md[128 + t] = run; md[192 + t] = mt_; md[256 + t] = __expf(run + mprev - mt_); }
        __syncthreads();
        { const int t = tid >> 3, ch = tid & 7; const u32x4 qv = *(const LAS u32x4*)(qs + t * 72 + 8 * ch); const float wf = misc[256 + t], wb = misc[512 + 256 + t];
          u32x4 a, c;
          a.x = pk2(bflo(qv.x) * wf, bfhi(qv.x) * wf); a.y = pk2(bflo(qv.y) * wf, bfhi(qv.y) * wf); a.z = pk2(bflo(qv.z) * wf, bfhi(qv.z) * wf); a.w = pk2(bflo(qv.w) * wf, bfhi(qv.w) * wf);
          c.x = pk2(bflo(qv.x) * wb, bfhi(qv.x) * wb); c.y = pk2(bflo(qv.y) * wb, bfhi(qv.y) * wb); c.z = pk2(bflo(qv.z) * wb, bfhi(qv.z) * wb); c.w = pk2(bflo(qv.w) * wb, bfhi(qv.w) * wb);
          *(LAS u32x4*)(qwf + t * 72 + 8 * ch) = a; *(LAS u32x4*)(qwb + t * 72 + 8 * ch) = c;
          const float q0 = bflo(qv.x), q1 = bfhi(qv.x), q2 = bflo(qv.y), q3 = bfhi(qv.y), q4 = bflo(qv.z), q5 = bfhi(qv.z), q6 = bflo(qv.w), q7 = bfhi(qv.w);
#pragma unroll
          for (int d = 0; d < 2; ++d) { const LAS float* nv = misc + 1024 + d * 64 + 8 * ch;
              part[(d * 8 + ch) * 64 + t] = q0 * nv[0] + q1 * nv[1] + q2 * nv[2] + q3 * nv[3] + q4 * nv[4] + q5 * nv[5] + q6 * nv[6] + q7 * nv[7]; } }
        { const int mt = wave >> 1; float rsf[4] = {0.f, 0.f, 0.f, 0.f}, rsb[4] = {0.f, 0.f, 0.f, 0.f};
#pragma unroll
          for (int n2 = 0; n2 < 2; ++n2) { const int nt = 2 * (wave & 1) + n2; f32x4 a = (f32x4){0.f, 0.f, 0.f, 0.f};
#pragma unroll
              for (int ks = 0; ks < 2; ++ks) a = MFMA(frag_rm(qs, 72, 16 * mt, 32 * ks, lane), frag_rm(ks_, 72, 16 * nt, 32 * ks, lane), a);
#pragma unroll
              for (int r = 0; r < 4; ++r) { const int t = 16 * mt + 4 * fq + r, s = 16 * nt + fr;
                  const float wf = s <= t ? __expf(misc[128 + t] - misc[128 + s] + misc[s] - misc[192 + t]) : 0.f;
                  const float wb = s >= t ? __expf(misc[512 + 128 + t] - misc[512 + 128 + s] + misc[512 + s] - misc[512 + 192 + t]) : 0.f;
                  const float vf = a[r] * wf, vb = a[r] * wb; rsf[r] += vf; rsb[r] += vb;
                  Af[t * 72 + s] = (bf16)f2bf(vf); Ab[t * 72 + s] = (bf16)f2bf(vb); } }
#pragma unroll
          for (int r = 0; r < 4; ++r) { const float a = red16_sum(rsf[r]), c = red16_sum(rsb[r]);
              if (fr == 0) { misc[1152 + (0 * 2 + (wave & 1)) * 64 + 16 * mt + 4 * fq + r] = a; misc[1152 + (1 * 2 + (wave & 1)) * 64 + 16 * mt + 4 * fq + r] = c; } } }
        __syncthreads();
        if (tid < 128) { const int d = tid >> 6, t = tid & 63; float qn = 0.f;
#pragma unroll
            for (int q = 0; q < 8; ++q) qn += part[(d * 8 + q) * 64 + t];
            const float den = misc[1152 + (d * 2 + 0) * 64 + t] + misc[1152 + (d * 2 + 1) * 64 + t] + misc[d * 512 + 256 + t] * qn;
            misc[d * 512 + 320 + t] = 1.f / fmaxf(fabsf(den), __expf(-misc[d * 512 + 192 + t])); }
        f32x4 of[4], ob[4];
#pragma unroll
        for (int mt = 0; mt < 4; ++mt) { of[mt] = (f32x4){0.f, 0.f, 0.f, 0.f}; ob[mt] = (f32x4){0.f, 0.f, 0.f, 0.f}; }
#pragma unroll
        for (int ks = 0; ks < 2; ++ks) { const bf16x8 bv = frag_tr(vs, 136, 32 * ks, 16 * wave, lane), bcf = frag_tr(Cf, 136, 32 * ks, 16 * wave, lane), bcb = frag_tr(Cb, 136, 32 * ks, 16 * wave, lane);
#pragma unroll
            for (int mt = 0; mt < 4; ++mt) { of[mt] = MFMA(frag_rm(Af, 72, 16 * mt, 32 * ks, lane), bv, of[mt]); of[mt] = MFMA(frag_rm(qwf, 72, 16 * mt, 32 * ks, lane), bcf, of[mt]);
                ob[mt] = MFMA(frag_rm(Ab, 72, 16 * mt, 32 * ks, lane), bv, ob[mt]); ob[mt] = MFMA(frag_rm(qwb, 72, 16 * mt, 32 * ks, lane), bcb, ob[mt]); } }
        __syncthreads();
        f32x4 o[4];
#pragma unroll
        for (int mt = 0; mt < 4; ++mt)
#pragma unroll
            for (int r = 0; r < 4; ++r) { const int t = 16 * mt + 4 * fq + r; o[mt][r] = of[mt][r] * misc[320 + t] + ob[mt][r] * misc[512 + 320 + t]; }
        scan_out_tail(lds, o, P, ldp, Z, row0, h, p->ml_norm_g + (size_t)li * 512);
    }
}
#define XB_TMO      128
#define XB_XCNT(j)  (256  + 64 * (j))
#define XB_XSUB(j)  (1280 + 64 * (j))
#define XB_XGEN(j)  (2304 + 64 * (j))
#define XB_TOP      3328
#define XB_TOPGEN   3392
#define XCD_BAR_WORDS 3456
#define XB_SPIN_CAP (1u << 18)

__device__ __forceinline__ unsigned xb_ld(unsigned* p)              { return __hip_atomic_load(p, __ATOMIC_RELAXED, __HIP_MEMORY_SCOPE_AGENT); }
__device__ __forceinline__ unsigned xb_add(unsigned* p, unsigned v) { return __hip_atomic_fetch_add(p, v, __ATOMIC_RELAXED, __HIP_MEMORY_SCOPE_AGENT); }
__device__ __forceinline__ unsigned xb_xcc_id() { return (unsigned)__builtin_amdgcn_s_getreg((3 << 11) | 20) & 0xFu; }
#define XB_SPIN(cond, bar) do { unsigned _sp = 0; while (cond) { __builtin_amdgcn_s_sleep(1); \
    if ((++_sp & 255u) == 0u) { if (xb_ld(&(bar)[XB_TMO])) break; if (_sp > XB_SPIN_CAP) { atomicAdd(&(bar)[XB_TMO], 1u); break; } } } } while (0)

struct XcdBarrier {
    unsigned* bar; unsigned x;
    volatile LAS unsigned* st;
};

__device__ __forceinline__ XcdBarrier xcd_barrier_post(unsigned* bar, volatile LAS unsigned* st) {
    XcdBarrier b; b.bar = bar; b.x = xb_xcc_id(); b.st = st;
    if (otid() == 0) (void)xb_add(&bar[XB_XCNT(b.x)], 1u);
    return b;
}
__device__ __forceinline__ void xcd_barrier_complete(unsigned* bar, unsigned x, unsigned& nloc, unsigned& nx) {
    const unsigned G = gridDim.x * gridDim.y * gridDim.z;
    unsigned sum, cnt, mine, sp = 0u;
    for (;;) {
        sum = 0u; cnt = 0u; mine = 0u;
#pragma unroll
        for (unsigned j = 0; j < 16; ++j) { const unsigned c = xb_ld(&bar[XB_XCNT(j)]); sum += c; cnt += (c > 0u) ? 1u : 0u; mine = (j == x) ? c : mine; }
        if (sum == G) break;
        __builtin_amdgcn_s_sleep(1);
        if ((++sp & 255u) == 0u) { if (xb_ld(&bar[XB_TMO])) break; if (sp > XB_SPIN_CAP) { atomicAdd(&bar[XB_TMO], 1u); break; } }
    }
    nloc = mine > 0u ? mine : 1u; nx = cnt > 0u ? cnt : 1u;
}

__device__ __forceinline__ void xcd_barrier(const XcdBarrier& b) {
    asm volatile("s_waitcnt vmcnt(0)" ::: "memory");
    __syncthreads();
    if (otid() == 0) {
        unsigned* bar = b.bar;
        __builtin_amdgcn_s_waitcnt(0);
        unsigned nloc = b.st[0], nx = b.st[1];
        if (nloc == 0u) { xcd_barrier_complete(bar, b.x, nloc, nx); b.st[0] = nloc; b.st[1] = nx; }
        const unsigned old = xb_add(&bar[XB_XSUB(b.x)], 1u);
        const unsigned gen = old / nloc;
        if (old + 1u == (gen + 1u) * nloc) {
            __builtin_amdgcn_fence(__ATOMIC_RELEASE, "agent");
            asm volatile("s_waitcnt vmcnt(0)" ::: "memory");
            const unsigned og = xb_add(&bar[XB_TOP], 1u);
            const unsigned tg = og / nx;
            if (og + 1u == (tg + 1u) * nx) xb_add(&bar[XB_TOPGEN], 1u);
            else XB_SPIN(xb_ld(&bar[XB_TOPGEN]) == tg, bar);
            __builtin_amdgcn_fence(__ATOMIC_ACQUIRE, "agent");
            xb_add(&bar[XB_XGEN(b.x)], 1u);
            asm volatile("s_waitcnt vmcnt(0)" ::: "memory");
        } else {
            XB_SPIN(xb_ld(&bar[XB_XGEN(b.x)]) == gen, bar);
            __builtin_amdgcn_fence(__ATOMIC_ACQUIRE, "agent");
            asm volatile("s_waitcnt vmcnt(0)" ::: "memory");
        }
    }
    __syncthreads();
}

#define REP_GEMM 1
#define REP_ATT 1
#define REP_LOC 1
#define REP_OUT 1
#define REP_PRO 1
#ifndef MK_N_LAUNCHES
#define MK_N_LAUNCHES 1
#endif
constexpr int N_PHASES = 2 + 6 * DEPTH;
__global__ void __launch_bounds__(NTHR, 2) fwd_megakernel(Params p_unused) {
    extern __shared__ __attribute__((aligned(16))) unsigned char lds_raw[];
    LAS unsigned char* lds = (LAS unsigned char*)lds_raw;
    cg::grid_group grid = cg::this_grid();
    const int lo = (int)kparams()->ph_lo, hi = (int)kparams()->ph_hi;
#define IN(k) (lo <= (k) && (k) < hi)
    volatile LAS unsigned* bst = (volatile LAS unsigned*)(lds + LDS_BYTES - 64);
    if (otid() < 16) bst[otid()] = 0u;
    __syncthreads();
    XcdBarrier bar = xcd_barrier_post((unsigned*)(kparams()->ws + WS_BAR), bst);
#define SEAM(k) do { if (IN(k) && IN((k) + 1)) { if ((k) == 0) grid.sync(); else xcd_barrier(bar); } } while (0)
    if (IN(0)) { for (int rep = 0; rep < REP_PRO; ++rep) { phase_prologue(kparams(), lds); __syncthreads(); } } SEAM(0);
    if (IN(1)) { for (int rep = 0; rep < REP_PRO; ++rep) phase_h0(kparams()); } SEAM(1);
#pragma unroll 1
    for (int l = 0; l < DEPTH; ++l) {
        const int pb = 2 + 6 * l; const bool odd = l & 1; const int li = l >> 1; const bool need_ctx = l < DEPTH - 1;
        if (IN(pb + 0)) {
            const int npad = odd ? NPAD_ODD : NPAD_EVEN; unsigned char* ws = kparams()->ws;
            pg8::Gemm g{(const pg8::bf16_t*)(ws + WS_H), (const pg8::bf16_t*)(ws + (odd ? WS_WIO : WS_WIE)) + (size_t)li * npad * 1024, MTOT, npad, 1024};
            pg8::StaticOrder S; S.init(MTOT, npad, (int)gridDim.x, (int)blockIdx.x);
            pg8::EpiProj E{(pg8::bf16_t*)(ws + WS_P), odd ? NP_ODD : NP_EVEN, (float*)(ws + WS_SM), odd ? 16 : 32, npad / 256 - 1, odd ? 1 : 0, (const float*)(ws + WS_ROPE), (const float*)(ws + WS_ROPE) + 1024};
            for (int rep = 0; rep < REP_GEMM; ++rep) pg8::gemm_phase<pg8::EpiProj, pg8::StaticOrder, true, true>(lds, g, S, E);
        }
        SEAM(pb + 0);
        if (IN(pb + 1)) { for (int rep = 0; rep < REP_ATT; ++rep) phase_attn(kparams(), lds, l, need_ctx); for (int rep = 0; rep < REP_LOC; ++rep) phase_scan_local(kparams(), lds, l); }
        SEAM(pb + 1);
        if (IN(pb + 2)) { phase_scan_seq(kparams(), l); }
        SEAM(pb + 2);
        if (IN(pb + 3)) { for (int rep = 0; rep < REP_OUT; ++rep) { if (odd) phase_scan_out_mlstm(kparams(), lds, l, need_ctx); else phase_scan_out_gla(kparams(), lds, l, need_ctx); } }
        SEAM(pb + 3);
        if (IN(pb + 4)) {
            const int mrows = need_ctx ? MTOT : MLAT; unsigned char* ws = kparams()->ws;
            pg8::Gemm g{(const pg8::bf16_t*)(ws + WS_H), (const pg8::bf16_t*)(ws + WS_WO) + (size_t)l * 1024 * 1024, mrows, 1024, 1024};
            pg8::StaticOrder S; S.init(mrows, 1024, (int)gridDim.x, (int)blockIdx.x);
            pg8::EpiProj E{(pg8::bf16_t*)(ws + WS_P), 1024, nullptr, 0, -1, 0, nullptr, nullptr};
            for (int rep = 0; rep < REP_GEMM; ++rep) pg8::gemm_phase<pg8::EpiProj, pg8::StaticOrder, true, true>(lds, g, S, E);
        }
        SEAM(pb + 4);
        if (IN(pb + 5)) { phase_ln(kparams(), l); }
        SEAM(pb + 5);
    }
}
extern "C" void kernel_launch(void* const* d_in, const int* in_sizes, int n_in, void* d_out, int out_size, void* d_ws, size_t ws_size, hipStream_t stream) {
    static int grid = 0;
    if (grid == 0) {
        if (n_in != 19 || ws_size < WS_END) { fprintf(stderr, "kernel_launch: need 19 inputs and %zu bytes of workspace; got %d, %zu\n", (size_t)WS_END, n_in, ws_size); grid = -1; return; }
        int dev = 0, cus = 0, per_cu = 0;
        if (hipGetDevice(&dev) != hipSuccess || hipDeviceGetAttribute(&cus, hipDeviceAttributeMultiprocessorCount, dev) != hipSuccess) { grid = -1; return; }
        if (hipFuncSetAttribute((const void*)fwd_megakernel, hipFuncAttributeMaxDynamicSharedMemorySize, LDS_BYTES) != hipSuccess) { fprintf(stderr, "kernel_launch: hipFuncSetAttribute failed\n"); grid = -1; return; }
        if (hipOccupancyMaxActiveBlocksPerMultiprocessor(&per_cu, (const void*)fwd_megakernel, NTHR, LDS_BYTES) != hipSuccess || per_cu < 1) per_cu = 1;
        grid = cus * per_cu;
    }
    if (grid < 0) return;
    Params p{};
    p.x = (const float*)d_in[0]; p.c = (const float*)d_in[1]; p.ctx = (const float*)d_in[2]; p.c_ctx = (const float*)d_in[3]; p.w_ada = (const float*)d_in[4]; p.b_ada = (const float*)d_in[5];
    p.ln_g = (const float*)d_in[6]; p.ln_b = (const float*)d_in[7]; p.w_in_even = (const float*)d_in[8]; p.w_out_even = (const float*)d_in[9]; p.gla_gate_w = (const float*)d_in[10]; p.gla_gate_b = (const float*)d_in[11];
    p.gla_norm_g = (const float*)d_in[12]; p.na_rpb = (const float*)d_in[13]; p.w_in_odd = (const float*)d_in[14]; p.w_out_odd = (const float*)d_in[15]; p.ml_gate_b = (const float*)d_in[16]; p.ml_norm_g = (const float*)d_in[17];
    p.sw_sink = (const float*)d_in[18]; p.out = (float*)d_out; p.ws = (unsigned char*)d_ws;
    if (hipMemsetAsync((char*)d_ws + WS_BAR, 0, XCD_BAR_WORDS * 4, stream) != hipSuccess) { fprintf(stderr, "kernel_launch: memset failed\n"); return; }
#if MK_N_LAUNCHES == 1
    p.ph_lo = 0; p.ph_hi = N_PHASES;
    void* args[] = {&p};
    hipError_t e = hipLaunchCooperativeKernel((const void*)fwd_megakernel, dim3(grid), dim3(NTHR), args, LDS_BYTES, stream);
    if (e != hipSuccess) fprintf(stderr, "kernel_launch: cooperative launch failed: %s (grid %d)\n", hipGetErrorString(e), grid);
#else
    for (int k = 0; k < N_PHASES; ++k) { p.ph_lo = k; p.ph_hi = k + 1; hipLaunchKernelGGL(fwd_megakernel, dim3(grid), dim3(NTHR), LDS_BYTES, stream, p); }
#endif
}
```

```cpp
#include <hip/hip_runtime.h>
#include <hip/hip_cooperative_groups.h>
#include <cstdio>
#include <cstdint>
namespace cg = cooperative_groups;
__device__ __forceinline__ int otid() { int t = threadIdx.x; asm volatile("" : "+v"(t)); return t; }
namespace pg8 {
#define PG8_LAS __attribute__((address_space(3)))
typedef unsigned short bf16_t;
typedef short bf16x8 __attribute__((ext_vector_type(8)));
typedef float f32x4 __attribute__((ext_vector_type(4)));
typedef unsigned u32x4 __attribute__((ext_vector_type(4)));
constexpr int BM = 256, BK = 64, HALF = 128, HTB = HALF * BK * 2  , STAGE_BYTES = 8 * HTB, NXCD = 8, WGM = 8;

__host__ __device__ __forceinline__ int lds_byte(int r, int c) { const int st = (r >> 4) * 2 + (c >> 5), rr = r & 15, cc = c & 31, ob = rr * 64 + cc * 2; return st * 1024 + (ob ^ (((ob >> 9) & 1) << 5)); }
__host__ __device__ __forceinline__ void stage_rc(int b, int& R, int& C) { const int st = b / 1024, sb = b % 1024, swz = sb ^ (((sb >> 9) & 1) << 5); R = (st >> 1) * 16 + swz / 64; C = (st & 1) * 32 + (swz % 64) / 2; }
__host__ __device__ __forceinline__ int perm32(int rho) { const int n = rho >> 4, i = rho & 15; return 8 * (i >> 2) + 4 * n + (i & 3); }

struct Unit { int pm, pn; };
struct Gemm { const bf16_t* A; const bf16_t* Bt; int M, N, K; };

struct StaticOrder {
    int nM, nN, nwg, G, c;
    __host__ __device__ void init(int M, int N, int G_, int c_) { nM = M / BM; nN = N / BM; nwg = nM * nN; G = G_; c = c_; }
    __host__ __device__ bool next(int i, Unit& u) const {
        const long L = (long)i * G + c; if (L >= nwg) return false;
        int wgid = (int)L; { const int q = nwg / NXCD, r = nwg % NXCD, xcd = wgid % NXCD, off = wgid / NXCD; wgid = (xcd < r ? xcd * (q + 1) : r * (q + 1) + (xcd - r) * q) + off; }
        const int nig = WGM * nN, gid = wgid / nig, fm = gid * WGM, gsz = (nM - fm) < WGM ? (nM - fm) : WGM;
        u.pm = fm + ((wgid % nig) % gsz); u.pn = (wgid % nig) / gsz; return true;
    }
    __device__ __forceinline__ void a_ready(const Unit&) const {}
    __device__ __forceinline__ void done(const Unit&) const {}
};

__device__ __forceinline__ unsigned cvt_pk_bf16(float lo, float hi) { unsigned r; asm volatile("v_cvt_pk_bf16_f32 %0, %1, %2" : "=v"(r) : "v"(lo), "v"(hi)); return r; }
struct EpiProj {
    static constexpr bool PERM = true, AFTER_DRAIN = false;
    bf16_t* P; int ldp; float* SM; int nsm; int last_pn; int rope; const float* cosT; const float* sinT;
    __device__ __forceinline__ void operator()(const f32x4 (&acc)[2][2][4][2], const Unit& u, int wr, int wc, int fr, int fq) const {
        const int row0 = u.pm * BM + wr * 64 + fr;
        if (u.pn == last_pn) {
            if (wc == 0) {
#pragma unroll
                for (int ai = 0; ai < 2; ++ai)
#pragma unroll
                    for (int m = 0; m < 4; ++m) { const int row = row0 + ai * HALF + m * 16;
#pragma unroll
                        for (int n = 0; n < 2; ++n) { const int col = 8 * fq + 4 * n; if (col < nsm) *(f32x4*)(SM + (size_t)row * 32 + col) = acc[ai][0][m][n]; } }
            }
            return;
        }
        const bool do_rope_tile = rope && (u.pn == 6 || u.pn == 7 || u.pn == 8) && (u.pm * BM < 32768);
#pragma unroll
        for (int ai = 0; ai < 2; ++ai)
#pragma unroll
            for (int m = 0; m < 4; ++m) { const int row = row0 + ai * HALF + m * 16; bf16_t* rowp = P + (size_t)row * ldp + u.pn * BM + wc * 32 + 8 * fq;
#pragma unroll
                for (int bj = 0; bj < 2; ++bj) { f32x4 v0 = acc[ai][bj][m][0], v1 = acc[ai][bj][m][1];
                    if (do_rope_tile && (u.pn != 8 || bj == 0)) {
                        const int t = row & 4095; const int pos = (wc & 1) ? (t & 63) : (t >> 6); const int i0 = pos * 16 + 8 * (fq & 1);
                        const f32x4 c0 = *(const f32x4*)(cosT + i0), c1 = *(const f32x4*)(cosT + i0 + 4), s0 = *(const f32x4*)(sinT + i0), s1 = *(const f32x4*)(sinT + i0 + 4);
                        f32x4 p0, p1;
#pragma unroll
                        for (int e = 0; e < 4; ++e) { p0[e] = __shfl_xor(v0[e], 32); p1[e] = __shfl_xor(v1[e], 32); }
                        if (fq < 2) { v0 = v0 * c0 - p0 * s0; v1 = v1 * c1 - p1 * s1; } else { v0 = p0 * s0 + v0 * c0; v1 = p1 * s1 + v1 * c1; }
                    }
                    u32x4 w; w.x = cvt_pk_bf16(v0[0], v0[1]); w.y = cvt_pk_bf16(v0[2], v0[3]); w.z = cvt_pk_bf16(v1[0], v1[1]); w.w = cvt_pk_bf16(v1[2], v1[3]);
                    *(u32x4*)(rowp + bj * HALF) = w; } }
    }
};
template <class Epi, class Sched, bool ALIGN_EPI = false, bool SP2 = false>
__device__ __forceinline__ void gemm_phase(PG8_LAS unsigned char* lds, const Gemm g, const Sched& S, const Epi& E) {
    const int tid = otid(), wid = __builtin_amdgcn_readfirstlane(tid >> 6), lane = tid & 63, wr = wid >> 2, wc = wid & 3, fr = lane & 15, fq = lane >> 4;
    const int K = g.K, nt = K / BK;
    unsigned voffA[2], voffB[2];
#pragma unroll
    for (int i = 0; i < 2; ++i) { int R, C; stage_rc(tid * 16 + i * 8192, R, C); const int Rb = Epi::PERM ? ((R & ~31) + perm32(R & 31)) : R;
        voffA[i] = (unsigned)(R * K + C) * 2u; voffB[i] = (unsigned)(Rb * K + C) * 2u; }
    const size_t kstep = (size_t)(BK * 2);
    const size_t hstep = (size_t)HALF * K * 2;
    const size_t tstep = 2 * hstep;
    const unsigned ldsw = (unsigned)wid * 1024u;
    const int aoff = lds_byte(wr * 64 + fr, fq * 8), boff = lds_byte(wc * 32 + fr, fq * 8);
#define PG8_SA(b, h) (((b) * 2 + (h)) * HTB)
#define PG8_SB(b, h) ((4 + (b) * 2 + (h)) * HTB)
#define PG8_STAGE(bufoff, gbase, voff) do { _Pragma("unroll") for (int _i = 0; _i < 2; ++_i) \
        __builtin_amdgcn_global_load_lds((const unsigned*)((const char*)(gbase) + (voff)[_i]), (PG8_LAS unsigned*)(lds + (bufoff) + ldsw + _i * 8192), 16, 0, 0); } while (0)
#define PG8_LDA(dst, b, h) do { _Pragma("unroll") for (int m = 0; m < 4; ++m) _Pragma("unroll") for (int k = 0; k < 2; ++k) dst[m][k] = *(const PG8_LAS bf16x8*)(lds + PG8_SA(b, h) + aoff + m * 2048 + k * 1024); } while (0)
#define PG8_LDB(dst, b, h) do { _Pragma("unroll") for (int n = 0; n < 2; ++n) _Pragma("unroll") for (int k = 0; k < 2; ++k) dst[n][k] = *(const PG8_LAS bf16x8*)(lds + PG8_SB(b, h) + boff + n * 2048 + k * 1024); } while (0)
#define PG8_MMA(ai, bj, At, Bt) do { __builtin_amdgcn_s_setprio(1); _Pragma("unroll") for (int m = 0; m < 4; ++m) _Pragma("unroll") for (int n = 0; n < 2; ++n) _Pragma("unroll") for (int k = 0; k < 2; ++k) \
        acc[ai][bj][m][n] = __builtin_amdgcn_mfma_f32_16x16x32_bf16(Bt[n][k], At[m][k], acc[ai][bj][m][n], 0, 0, 0); __builtin_amdgcn_s_setprio(0); } while (0)
#define PG8_WAIT_V(n) asm volatile("s_waitcnt vmcnt(" #n ")" ::: "memory")
#define PG8_WAIT_L(n) asm volatile("s_waitcnt lgkmcnt(" #n ")" ::: "memory")
#define PG8_BAR __builtin_amdgcn_s_barrier()
#define PG8_SCHED __builtin_amdgcn_sched_barrier(0)
    Unit cur, nxt; int ui = 0;
    if (!S.next(0, cur)) return;
    f32x4 acc[2][2][4][2];
#pragma unroll
    for (int a = 0; a < 2; ++a)
#pragma unroll
        for (int b = 0; b < 2; ++b)
#pragma unroll
            for (int m = 0; m < 4; ++m)
#pragma unroll
                for (int n = 0; n < 2; ++n) acc[a][b][m][n] = (f32x4){0.f, 0.f, 0.f, 0.f};
    bf16x8 At[4][2], B0[2][2], B1[2][2];
    const char* cA = (const char*)g.A + (size_t)cur.pm * tstep; const char* cB = (const char*)g.Bt + (size_t)cur.pn * tstep;
    S.a_ready(cur);
    if constexpr (SP2) {
        PG8_STAGE(PG8_SB(0, 0), cB, voffB); PG8_STAGE(PG8_SB(0, 1), cB + hstep, voffB); PG8_STAGE(PG8_SA(0, 0), cA, voffA); PG8_STAGE(PG8_SA(0, 1), cA + hstep, voffA);
        if (wr == 1) PG8_BAR;
        PG8_WAIT_V(2); PG8_BAR;
        PG8_STAGE(PG8_SB(1, 0), cB + kstep, voffB); PG8_STAGE(PG8_SA(1, 0), cA + kstep, voffA); PG8_STAGE(PG8_SB(1, 1), cB + hstep + kstep, voffB);
        PG8_WAIT_V(6); PG8_BAR;
    } else {
        PG8_STAGE(PG8_SB(0, 0), cB, voffB); PG8_STAGE(PG8_SA(0, 0), cA, voffA); PG8_STAGE(PG8_SB(0, 1), cB + hstep, voffB); PG8_STAGE(PG8_SA(0, 1), cA + hstep, voffA);
        if (wr == 1) PG8_BAR;
        PG8_WAIT_V(4); PG8_BAR;
        PG8_STAGE(PG8_SB(1, 0), cB + kstep, voffB); PG8_STAGE(PG8_SA(1, 0), cA + kstep, voffA); PG8_STAGE(PG8_SB(1, 1), cB + hstep + kstep, voffB);
        PG8_WAIT_V(6); PG8_BAR;
    }
    for (;;) {
        const bool has_next = S.next(ui + 1, nxt);
        const char* nA = has_next ? (const char*)g.A + (size_t)nxt.pm * tstep : cA; const char* nB = has_next ? (const char*)g.Bt + (size_t)nxt.pn * tstep : cB;
        for (int t = 0; t < nt; t += 2) {
            const bool last = (t == nt - 2);
            const char* a1 = cA + (size_t)(t + 1) * kstep;
            const char* a2 = last ? nA : cA + (size_t)(t + 2) * kstep; const char* b2 = last ? nB : cB + (size_t)(t + 2) * kstep;
            const char* a3 = a2 + kstep; const char* b3 = b2 + kstep;
            if (last && has_next) S.a_ready(nxt);
            if constexpr (SP2) {
            PG8_LDB(B0, 0, 0); PG8_LDB(B1, 0, 1); PG8_SCHED; PG8_LDA(At, 0, 0); PG8_STAGE(PG8_SA(1, 1), a1 + hstep, voffA);
            PG8_WAIT_V(8); PG8_WAIT_L(0); PG8_BAR; PG8_MMA(0, 0, At, B0); PG8_MMA(0, 1, At, B1); PG8_BAR; PG8_SCHED;
            PG8_LDA(At, 0, 1); PG8_STAGE(PG8_SB(0, 0), b2, voffB); PG8_STAGE(PG8_SB(0, 1), b2 + hstep, voffB); PG8_STAGE(PG8_SA(0, 0), a2, voffA);
            PG8_WAIT_V(8); PG8_WAIT_L(0); PG8_BAR; PG8_MMA(1, 0, At, B0); PG8_MMA(1, 1, At, B1); PG8_BAR; PG8_SCHED;
            PG8_LDB(B0, 1, 0); PG8_LDB(B1, 1, 1); PG8_SCHED; PG8_LDA(At, 1, 0); PG8_STAGE(PG8_SA(0, 1), a2 + hstep, voffA);
            PG8_WAIT_V(8); PG8_WAIT_L(0); PG8_BAR; PG8_MMA(0, 0, At, B0); PG8_MMA(0, 1, At, B1); PG8_BAR; PG8_SCHED;
            PG8_LDA(At, 1, 1); PG8_STAGE(PG8_SB(1, 0), b3, voffB); PG8_STAGE(PG8_SB(1, 1), b3 + hstep, voffB); PG8_STAGE(PG8_SA(1, 0), a3, voffA);
            PG8_WAIT_V(8); PG8_WAIT_L(0); PG8_BAR; PG8_MMA(1, 0, At, B0); PG8_MMA(1, 1, At, B1); PG8_BAR; PG8_SCHED;
            } else {
            PG8_LDB(B0, 0, 0); PG8_SCHED; PG8_LDA(At, 0, 0); PG8_STAGE(PG8_SA(1, 1), a1 + hstep, voffA);
            PG8_WAIT_L(8); PG8_BAR; PG8_WAIT_L(0); PG8_MMA(0, 0, At, B0); PG8_BAR; PG8_SCHED;
            PG8_LDB(B1, 0, 1); PG8_STAGE(PG8_SB(0, 0), b2, voffB);
            PG8_BAR; PG8_WAIT_L(0); PG8_MMA(0, 1, At, B1); PG8_BAR;
            PG8_LDA(At, 0, 1); PG8_STAGE(PG8_SA(0, 0), a2, voffA);
            PG8_BAR; PG8_WAIT_L(0); PG8_MMA(1, 0, At, B0); PG8_BAR; PG8_SCHED;
            PG8_STAGE(PG8_SB(0, 1), b2 + hstep, voffB);
            PG8_WAIT_V(6); PG8_BAR; PG8_MMA(1, 1, At, B1); PG8_BAR;
            PG8_LDB(B0, 1, 0); PG8_SCHED; PG8_LDA(At, 1, 0); PG8_STAGE(PG8_SA(0, 1), a2 + hstep, voffA);
            PG8_WAIT_L(8); PG8_BAR; PG8_WAIT_L(0); PG8_MMA(0, 0, At, B0); PG8_BAR; PG8_SCHED;
            PG8_LDB(B1, 1, 1); PG8_STAGE(PG8_SB(1, 0), b3, voffB);
            PG8_BAR; PG8_WAIT_L(0); PG8_MMA(0, 1, At, B1); PG8_BAR;
            PG8_LDA(At, 1, 1); PG8_STAGE(PG8_SA(1, 0), a3, voffA);
            PG8_BAR; PG8_WAIT_L(0); PG8_MMA(1, 0, At, B0); PG8_BAR; PG8_SCHED;
            PG8_STAGE(PG8_SB(1, 1), b3 + hstep, voffB);
            PG8_WAIT_V(6); PG8_BAR; PG8_MMA(1, 1, At, B1); PG8_BAR;
            }
        }
        if constexpr (ALIGN_EPI) { if (wr == 0) PG8_BAR; }
        if constexpr (!Epi::AFTER_DRAIN) { E(acc, cur, wr, wc, fr, fq); S.done(cur); }
        if (!has_next) break;
#pragma unroll
        for (int a = 0; a < 2; ++a)
#pragma unroll
            for (int b = 0; b < 2; ++b)
#pragma unroll
                for (int m = 0; m < 4; ++m)
#pragma unroll
                    for (int n = 0; n < 2; ++n) acc[a][b][m][n] = (f32x4){0.f, 0.f, 0.f, 0.f};
        cur = nxt; cA = nA; cB = nB; ++ui;
        if constexpr (ALIGN_EPI) { if (wr == 1) PG8_BAR; }
    }
    PG8_WAIT_V(0);
    if constexpr (!ALIGN_EPI) { if (wr == 0) PG8_BAR; }
    PG8_BAR;
    if constexpr (Epi::AFTER_DRAIN) { E.fused(acc, cur, wr, wc, fr, fq, lds, wid, lane); S.done(cur); }
#undef PG8_SA
#undef PG8_SB
#undef PG8_STAGE
#undef PG8_LDA
#undef PG8_LDB
#undef PG8_MMA
#undef PG8_WAIT_V
#undef PG8_WAIT_L
#undef PG8_BAR
#undef PG8_SCHED
}
}
constexpr int NWAVES = 8, NTHR = 512;
constexpr int BATCH = 8, SEQ = 4096, DM = 1024, CTXL = 256, DEPTH = 4;
constexpr int MLAT = BATCH * SEQ, MCTX = BATCH * CTXL, MTOT = MLAT + MCTX;
constexpr int NP_EVEN = 3584, NPAD_EVEN = 3840, NORIG_EVEN = 3616;
constexpr int NP_ODD = 2816, NPAD_ODD = 3072, NORIG_ODD = 2832;
constexpr int NCHUNK = 68;
constexpr int NSLOT = BATCH * 4 * 2 * NCHUNK;
constexpr float ALPHA_DN = 1.681792830507429f;
constexpr size_t MiB = 1u << 20;
constexpr size_t WS_MOD = 0;
constexpr size_t WS_BAR = 512 * 1024;
constexpr size_t WS_ROPE = 1 * MiB;
constexpr size_t WS_SC = WS_ROPE + 65536;
constexpr size_t WS_GAM = 2 * MiB;
constexpr size_t WS_SM = 4 * MiB;
constexpr size_t WS_WIE = 9 * MiB;
constexpr size_t WS_WIO = 24 * MiB;
constexpr size_t WS_WO = 36 * MiB;
constexpr size_t WS_XC = 44 * MiB;
constexpr size_t WS_H = 52 * MiB;
constexpr size_t WS_P = 120 * MiB;
constexpr size_t WS_S = 359 * MiB;
constexpr size_t WS_END = WS_S + (size_t)NSLOT * 8192 * 4;
static_assert(WS_SC + (size_t)NSLOT * 16 <= WS_GAM && WS_GAM + (size_t)NSLOT * 256 <= WS_SM && WS_SM + (size_t)MTOT * 128 <= WS_WIE, "ws map 1");
static_assert(WS_WIE + (size_t)2 * NPAD_EVEN * 1024 * 2 <= WS_WIO && WS_WIO + (size_t)2 * NPAD_ODD * 1024 * 2 <= WS_WO && WS_WO + (size_t)4 * 1024 * 1024 * 2 <= WS_XC, "ws map 2");
static_assert(WS_XC + (size_t)MCTX * 1024 * 4 <= WS_H && WS_H + (size_t)MTOT * 1024 * 2 <= WS_P && WS_P + (size_t)MTOT * NP_EVEN * 2 <= WS_S && WS_END <= 512 * MiB, "ws map 3");
constexpr int LDS_BYTES = 147456;

#define LAS __attribute__((address_space(3)))
typedef unsigned short bf16;
typedef float f32x4 __attribute__((ext_vector_type(4)));
typedef short bf16x8 __attribute__((ext_vector_type(8)));
typedef short s16x4 __attribute__((ext_vector_type(4)));
typedef unsigned u32x4 __attribute__((ext_vector_type(4)));
typedef unsigned u32x2 __attribute__((ext_vector_type(2)));
#define LDS_WAIT() asm volatile("s_waitcnt lgkmcnt(0)" ::: "memory")

typedef __bf16 hbf2 __attribute__((ext_vector_type(2)));
typedef float f32x2_ __attribute__((ext_vector_type(2)));
__device__ __forceinline__ unsigned f2bf(float f) { const __bf16 b = (__bf16)f; return (unsigned)__builtin_bit_cast(unsigned short, b); }
__device__ __forceinline__ unsigned pk2(float lo, float hi) { const f32x2_ v = {lo, hi}; const hbf2 b = __builtin_convertvector(v, hbf2); return __builtin_bit_cast(unsigned, b); }
__device__ __forceinline__ float bf2f(unsigned short v) { return __builtin_bit_cast(float, (unsigned)v << 16); }
__device__ __forceinline__ float bflo(unsigned w) { return __builtin_bit_cast(float, w << 16); }
__device__ __forceinline__ float bfhi(unsigned w) { return __builtin_bit_cast(float, w & 0xffff0000u); }
__device__ __forceinline__ float siluf(float x) { return x / (1.f + __expf(-x)); }
__device__ __forceinline__ float logsigf(float z) { return fminf(z, 0.f) - __logf(1.f + __expf(-fabsf(z))); }
__device__ __forceinline__ float red16_max(float v) { v = fmaxf(v, __shfl_xor(v, 1)); v = fmaxf(v, __shfl_xor(v, 2)); v = fmaxf(v, __shfl_xor(v, 4)); v = fmaxf(v, __shfl_xor(v, 8)); return v; }
__device__ __forceinline__ float red16_sum(float v) { v += __shfl_xor(v, 1); v += __shfl_xor(v, 2); v += __shfl_xor(v, 4); v += __shfl_xor(v, 8); return v; }
__device__ __forceinline__ float wave_sum(float v) {
#pragma unroll
    for (int o = 1; o < 64; o <<= 1) v += __shfl_xor(v, o);
    return v;
}
__device__ __forceinline__ float wave_max(float v) {
#pragma unroll
    for (int o = 1; o < 64; o <<= 1) v = fmaxf(v, __shfl_xor(v, o));
    return v;
}
__device__ __forceinline__ float wave_scan_sum(float v, int lane, bool rev) {
#pragma unroll
    for (int o = 1; o < 64; o <<= 1) { const float t = rev ? __shfl_down(v, o) : __shfl_up(v, o); if (rev ? (lane + o < 64) : (lane >= o)) v += t; }
    return v;
}
__device__ __forceinline__ float wave_scan_max(float v, int lane, bool rev) {
#pragma unroll
    for (int o = 1; o < 64; o <<= 1) { const float t = rev ? __shfl_down(v, o) : __shfl_up(v, o); if (rev ? (lane + o < 64) : (lane >= o)) v = fmaxf(v, t); }
    return v;
}
#define MFMA(a, b, c) __builtin_amdgcn_mfma_f32_16x16x32_bf16((a), (b), (c), 0, 0, 0)
__device__ __forceinline__ bf16x8 frag_rm(const LAS bf16* X, int ld, int row0, int k0, int lane) {
    return *(const LAS bf16x8*)(X + (row0 + (lane & 15)) * ld + k0 + 8 * (lane >> 4));
}
__device__ __forceinline__ bf16x8 frag_tr(const LAS bf16* X, int ld, int k0, int n0, int lane) {
    const int g = lane >> 4, m = lane & 15, q = m >> 2, p = m & 3;
    const LAS bf16* a0 = X + (k0 + 8 * g + q) * ld + n0 + 4 * p;
    const s16x4 lo = __builtin_amdgcn_ds_read_tr16_b64_v4i16((LAS s16x4*)a0);
    const s16x4 hi = __builtin_amdgcn_ds_read_tr16_b64_v4i16((LAS s16x4*)(a0 + 4 * ld));
    bf16x8 r; r[0] = lo[0]; r[1] = lo[1]; r[2] = lo[2]; r[3] = lo[3]; r[4] = hi[0]; r[5] = hi[1]; r[6] = hi[2]; r[7] = hi[3]; return r;
}

struct Params {
    const float *x, *c, *ctx, *c_ctx, *w_ada, *b_ada, *ln_g, *ln_b, *w_in_even, *w_out_even, *gla_gate_w, *gla_gate_b, *gla_norm_g, *na_rpb, *w_in_odd, *w_out_odd, *ml_gate_b, *ml_norm_g, *sw_sink;
    float* out; unsigned char* ws; long long ph_lo, ph_hi;
};
typedef const __attribute__((address_space(4))) Params* KP;
__device__ __forceinline__ KP kparams() { unsigned long long v = (unsigned long long)__builtin_amdgcn_kernarg_segment_ptr(); asm volatile("" : "+s"(v)); return (KP)v; }

__device__ __forceinline__ int orig_col(int type, int n) {
    if (type == 0) { if (n < 1536) return n; if (n < 3584) return n + 32; if (n < 3616) return n - 3584 + 1536; return -1; }
    if (type == 1) { if (n < 1536) return n; if (n < 2816) return n + 16; if (n < 2832) return n - 2816 + 1536; return -1; }
    return n;
}
__device__ __forceinline__ float col_scale(int type, int n) {
    if (type == 0) return (n < 256 || (n >= 1536 && n < 2048)) ? 0.125f : 1.f;
    if (type == 1) return ((n >= 256 && n < 512) || (n >= 1536 && n < 2048)) ? 0.125f : 1.f;
    return 1.f;
}
__device__ __forceinline__ void p0_transpose_item(const float* __restrict__ W, int K, int Norig, int type, bf16* __restrict__ WT, LAS float* scr, int nblk, int item, int lane) {
    const int kb = item / nblk, nb = item % nblk, k0 = 64 * kb, n0 = 32 * nb;
    const int oc = orig_col(type, n0 + (lane & 31)); const float sc = col_scale(type, n0 + (lane & 31));
#pragma unroll 8
    for (int i = 0; i < 32; ++i) { const int kk = 2 * i + (lane >> 5); scr[kk * 33 + (lane & 31)] = oc >= 0 ? W[(size_t)(k0 + kk) * Norig + oc] * sc : 0.f; }
    LDS_WAIT();
    const int c = lane & 7;
#pragma unroll
    for (int j = 0; j < 4; ++j) { const int n = (lane >> 3) + 8 * j; const LAS float* s = scr + (8 * c) * 33 + n;
        u32x4 o; o.x = pk2(s[0 * 33], s[1 * 33]); o.y = pk2(s[2 * 33], s[3 * 33]); o.z = pk2(s[4 * 33], s[5 * 33]); o.w = pk2(s[6 * 33], s[7 * 33]);
        *(u32x4*)(WT + (size_t)(n0 + n) * K + k0 + 8 * c) = o; }
    LDS_WAIT();
}
__device__ __forceinline__ void phase_prologue(KP p, LAS unsigned char* lds) {
    const int tid = otid(), lane = tid & 63, wave = tid >> 6;
    unsigned char* ws = p->ws;
    float* MOD = (float*)(ws + WS_MOD);
    if ((int)blockIdx.x < 192) {
        LAS float* cond = (LAS float*)lds;
        LAS float* red = (LAS float*)(lds + 36864);
        for (int e = tid; e < 9 * 1024; e += NTHR) { const int j = e >> 10, k = e & 1023; const float v = j < 8 ? p->c[j * 1024 + k] : p->c_ctx[k]; cond[e] = siluf(v); }
        __syncthreads();
        for (int it = blockIdx.x; it < 192; it += gridDim.x) {
            const int l = it / 48, n0 = (it % 48) * 64, cq = tid & 15, ks = tid >> 4;
            float acc[9][4];
#pragma unroll
            for (int j = 0; j < 9; ++j) { acc[j][0] = 0.f; acc[j][1] = 0.f; acc[j][2] = 0.f; acc[j][3] = 0.f; }
            const float* wp = p->w_ada + (size_t)l * 1024 * 3072 + (size_t)(ks * 32) * 3072 + n0 + 4 * cq;
#pragma unroll 4
            for (int kk = 0; kk < 32; ++kk) { const f32x4 w = *(const f32x4*)(wp + (size_t)kk * 3072);
#pragma unroll
                for (int j = 0; j < 9; ++j) { const float cv = cond[j * 1024 + ks * 32 + kk]; acc[j][0] += cv * w[0]; acc[j][1] += cv * w[1]; acc[j][2] += cv * w[2]; acc[j][3] += cv * w[3]; } }
#pragma unroll
            for (int j = 0; j < 9; ++j)
#pragma unroll
                for (int i = 0; i < 4; ++i) red[ks * 576 + j * 64 + 4 * cq + i] = acc[j][i];
            __syncthreads();
            for (int o = tid; o < 576; o += NTHR) { float s = 0.f; for (int q = 0; q < 32; ++q) s += red[q * 576 + o]; const int j = o >> 6, n = n0 + (o & 63);
                MOD[(size_t)(l * 9 + j) * 3072 + n] = s + p->b_ada[l * 3072 + n]; }
            __syncthreads();
        }
    }
    if (blockIdx.x == gridDim.x - 1) {
        float* cosT = (float*)(ws + WS_ROPE); float* sinT = cosT + 1024;
        for (int e = tid; e < 1024; e += NTHR) { const int pos = e >> 4, i = e & 15;
            double f = 1.0; for (int q = 0; q < i; ++q) f *= 0.5623413251903491;
            const double f2 = f * f; double sn = 1.0, cs = 1.0;
            for (int q = 12; q >= 1; --q) { sn = 1.0 - f2 / ((2.0 * q) * (2.0 * q + 1.0)) * sn; cs = 1.0 - f2 / ((2.0 * q - 1.0) * (2.0 * q)) * cs; }
            sn *= f;
            double c = 1.0, s = 0.0; for (int q = 0; q < pos; ++q) { const double c2 = c * cs - s * sn, s2 = s * cs + c * sn; c = c2; s = s2; }
            cosT[e] = (float)c; sinT[e] = (float)s; }
    }
    __syncthreads();
    {
        LAS float* scr = (LAS float*)(lds + wave * 16384);
        const int gw = blockIdx.x * NWAVES + wave, NGW = gridDim.x * NWAVES;
        constexpr int I_E = 16 * (NPAD_EVEN / 32), I_O = 16 * (NPAD_ODD / 32), I_W = 16 * 32;
        constexpr int NIT = 2 * I_E + 2 * I_O + 4 * I_W;
        for (int it = gw; it < NIT; it += NGW) {
            int r = it;
            if (r < 2 * I_E) { const int i = r / I_E; r -= i * I_E; p0_transpose_item(p->w_in_even + (size_t)i * 1024 * NORIG_EVEN, 1024, NORIG_EVEN, 0, (bf16*)(ws + WS_WIE) + (size_t)i * NPAD_EVEN * 1024, scr, NPAD_EVEN / 32, r, lane); continue; }
            r -= 2 * I_E;
            if (r < 2 * I_O) { const int i = r / I_O; r -= i * I_O; p0_transpose_item(p->w_in_odd + (size_t)i * 1024 * NORIG_ODD, 1024, NORIG_ODD, 1, (bf16*)(ws + WS_WIO) + (size_t)i * NPAD_ODD * 1024, scr, NPAD_ODD / 32, r, lane); continue; }
            r -= 2 * I_O;
            { const int l = r / I_W; r -= l * I_W; const float* W = (l & 1) ? p->w_out_odd + (size_t)(l >> 1) * 1024 * 1024 : p->w_out_even + (size_t)(l >> 1) * 1024 * 1024;
              p0_transpose_item(W, 1024, 1024, 2, (bf16*)(ws + WS_WO) + (size_t)l * 1024 * 1024, scr, 32, r, lane); }
        }
    }
}
__device__ __forceinline__ void phase_h0(KP p) {
    const int lane = otid() & 63, gw = blockIdx.x * NWAVES + (otid() >> 6), NGW = gridDim.x * NWAVES;
    const float* MOD = (const float*)(p->ws + WS_MOD); bf16* H = (bf16*)(p->ws + WS_H);
    for (int m = gw; m < MTOT; m += NGW) {
        const int jb = m < MLAT ? (m >> 12) : 8;
        const float* src = m < MLAT ? p->x + (size_t)m * DM : p->ctx + (size_t)(m - MLAT) * DM;
        const float* md = MOD + (size_t)jb * 3072;
#pragma unroll
        for (int j = 0; j < 4; ++j) { const int k = 4 * lane + 256 * j; const f32x4 v = *(const f32x4*)(src + k), sh = *(const f32x4*)(md + k), sc = *(const f32x4*)(md + 1024 + k);
            const f32x4 h = v * (sc + 1.0f) + sh; u32x2 o; o.x = pk2(h[0], h[1]); o.y = pk2(h[2], h[3]); *(u32x2*)(H + (size_t)m * DM + k) = o; }
    }
}
__device__ __forceinline__ void phase_ln(KP p, int l, bool dummy = false) {
    const int lane = otid() & 63, gw = blockIdx.x * NWAVES + (otid() >> 6), NGW = gridDim.x * NWAVES;
    const float* MOD = (const float*)(p->ws + WS_MOD); bf16* H = (bf16*)(p->ws + WS_H); const bf16* Y = (const bf16*)(p->ws + WS_P); float* XC = (float*)(p->ws + WS_XC);
    const int mrows = l < DEPTH - 1 ? MTOT : MLAT;
    const float* lg = p->ln_g + l * DM; const float* lb = p->ln_b + l * DM;
    const float* xin = p->x; const float* cin = p->ctx; float* outp = p->out;
    for (int m0 = 2 * gw; m0 < mrows; m0 += 2 * NGW) {
        const int jb = m0 < MLAT ? (m0 >> 12) : 8;
        const float* md = MOD + (size_t)(l * 9 + jb) * 3072;
        const float* src[2]; float* dst[2]; f32x4 v[2][4]; float s[2] = {0.f, 0.f};
#pragma unroll
        for (int q = 0; q < 2; ++q) { const int m = m0 + q;
            src[q] = l == 0 ? (m < MLAT ? xin + (size_t)m * DM : cin + (size_t)(m - MLAT) * DM) : (m < MLAT ? outp + (size_t)m * DM : XC + (size_t)(m - MLAT) * DM);
            dst[q] = m < MLAT ? outp + (size_t)m * DM : XC + (size_t)(m - MLAT) * DM; }
#pragma unroll
        for (int j = 0; j < 4; ++j) { const int k = 4 * lane + 256 * j; const f32x4 g = *(const f32x4*)(md + 2048 + k);
#pragma unroll
            for (int q = 0; q < 2; ++q) { const f32x4 xv = *(const f32x4*)(src[q] + k); const u32x2 yw = *(const u32x2*)(Y + (size_t)(m0 + q) * DM + k);
                f32x4 y; y[0] = bflo(yw.x); y[1] = bfhi(yw.x); y[2] = bflo(yw.y); y[3] = bfhi(yw.y);
                v[q][j] = xv * ALPHA_DN + g * y; s[q] += (v[q][j][0] + v[q][j][1]) + (v[q][j][2] + v[q][j][3]); } }
        float rstd[2];
#pragma unroll
        for (int q = 0; q < 2; ++q) { const float mean = wave_sum(s[q]) * (1.f / DM); float s2 = 0.f;
#pragma unroll
            for (int j = 0; j < 4; ++j) { v[q][j] = v[q][j] - mean; s2 += (v[q][j][0] * v[q][j][0] + v[q][j][1] * v[q][j][1]) + (v[q][j][2] * v[q][j][2] + v[q][j][3] * v[q][j][3]); }
            rstd[q] = 1.f / sqrtf(wave_sum(s2) * (1.f / DM) + 1e-5f); }
        const float* md2 = MOD + (size_t)((l + 1) * 9 + jb) * 3072;
#pragma unroll
        for (int j = 0; j < 4; ++j) { const int k = 4 * lane + 256 * j; const f32x4 gg = *(const f32x4*)(lg + k), bb = *(const f32x4*)(lb + k);
            f32x4 sh = (f32x4){0.f, 0.f, 0.f, 0.f}, sc = sh; if (l < DEPTH - 1) { sh = *(const f32x4*)(md2 + k); sc = *(const f32x4*)(md2 + 1024 + k); }
#pragma unroll
            for (int q = 0; q < 2; ++q) { const f32x4 o = v[q][j] * rstd[q] * gg + bb;
                *(f32x4*)(dst[q] + k) = dummy ? *(const f32x4*)(src[q] + k) : o;
                if (l < DEPTH - 1) { const f32x4 h = o * (sc + 1.0f) + sh; u32x2 w; w.x = pk2(h[0], h[1]); w.y = pk2(h[2], h[3]); *(u32x2*)(H + (size_t)(m0 + q) * DM + k) = w; } } }
    }
}
constexpr int AT_KS = 0, AT_VS = 9216, AT_PS = 18432, AT_RPB = AT_PS + 8 * 2304;
__device__ __forceinline__ void attn_item(LAS unsigned char* lds, const bf16* __restrict__ P, int ldp, bf16* __restrict__ Z, int mode,
                                          int qrow0, int qcol, int kcol, int vcol, int gcol, int zcol,
                                          int nlat, int lat_row0, int ctx_row0, int qa_, int qb_, int ka_, const float* __restrict__ rpb_g, float sink) {
    const int tid = otid(), lane = tid & 63, wave = tid >> 6, fq = lane >> 4, fr = lane & 15;
    LAS bf16* Ks = (LAS bf16*)(lds + AT_KS); LAS bf16* Vs = (LAS bf16*)(lds + AT_VS); LAS bf16* Ps = (LAS bf16*)(lds + AT_PS + wave * 2304); LAS float* rpb = (LAS float*)(lds + AT_RPB);
    __syncthreads();
    if (mode == 0) { for (int e = tid; e < 465; e += NTHR) rpb[e] = rpb_g[e]; }
    bf16x8 qa[2];
#pragma unroll
    for (int ks = 0; ks < 2; ++ks) qa[ks] = *(const bf16x8*)(P + (size_t)(qrow0 + fr) * ldp + qcol + 32 * ks + 8 * fq);
    float mrow[4], lsum[4]; f32x4 oacc[4];
#pragma unroll
    for (int r = 0; r < 4; ++r) { mrow[r] = -1e30f; lsum[r] = 0.f; oacc[r] = (f32x4){0.f, 0.f, 0.f, 0.f}; }
    const int ntile = nlat + 4, srow = tid >> 3, sch = tid & 7;
    u32x4 kreg, vreg;
    { const int rb = nlat > 0 ? lat_row0 : ctx_row0; kreg = *(const u32x4*)(P + (size_t)(rb + srow) * ldp + kcol + 8 * sch); vreg = *(const u32x4*)(P + (size_t)(rb + srow) * ldp + vcol + 8 * sch); }
    for (int i = 0; i < ntile; ++i) {
        __syncthreads();
        *(LAS u32x4*)(Ks + srow * 72 + 8 * sch) = kreg; *(LAS u32x4*)(Vs + srow * 72 + 8 * sch) = vreg;
        __syncthreads();
        if (i + 1 < ntile) { const int rb = (i + 1 < nlat) ? lat_row0 + 64 * (i + 1) : ctx_row0 + 64 * (i + 1 - nlat);
            kreg = *(const u32x4*)(P + (size_t)(rb + srow) * ldp + kcol + 8 * sch); vreg = *(const u32x4*)(P + (size_t)(rb + srow) * ldp + vcol + 8 * sch); }
        const bool islat = i < nlat;
        bool active = true; int kt0 = 0;
        if (islat) {
            if (mode == 0) { kt0 = ka_ + i; const int rs = min(max(qa_ - 4, 0), 56); active = (kt0 >= rs) && (kt0 < rs + 8); }
            else { kt0 = ka_ + 64 * i; active = !(kt0 > qa_ + 15 + 128 || kt0 + 63 < qa_ - 128); }
        }
        if (active) {
            const bool nar = islat && mode == 0;
            const int w4 = wave & 3, ntlo = nar ? (w4 < 2 ? 0 : w4 - 1) : 0, nthi = nar ? (w4 > 1 ? 3 : w4 + 1) : 3;
            f32x4 s[4];
#pragma unroll
            for (int nt = 0; nt < 4; ++nt) { s[nt] = (f32x4){0.f, 0.f, 0.f, 0.f};
                if (nt >= ntlo && nt <= nthi) {
#pragma unroll
                for (int ks = 0; ks < 2; ++ks) s[nt] = MFMA(qa[ks], frag_rm(Ks, 72, 16 * nt, 32 * ks, lane), s[nt]); } }
            float tmax[4] = {-3e38f, -3e38f, -3e38f, -3e38f};
#pragma unroll
            for (int nt = 0; nt < 4; ++nt) { if (nt >= ntlo && nt <= nthi) {
#pragma unroll
                for (int r = 0; r < 4; ++r) { float v = s[nt][r];
                    if (islat) {
                        if (mode == 0) { const int qc = qb_ + 4 * fq + r, kc = 16 * nt + fr, cs = min(max(qc - 8, 0), 48); const bool ok = (kc >= cs) && (kc < cs + 16);
                            const int bi = (kt0 - qa_ + 7) * 31 + (kc - qc + 15); v = ok ? v + rpb[ok ? bi : 0] : -3e38f; }
                        else { const int qt = qa_ + 4 * fq + r, kt = kt0 + 16 * nt + fr; const int d = qt - kt; v = (d <= 128 && d >= -128) ? v : -3e38f; }
                    }
                    s[nt][r] = v; tmax[r] = fmaxf(tmax[r], v); } } }
#pragma unroll
            for (int r = 0; r < 4; ++r) { const float tm = red16_max(tmax[r]); const float mnew = fmaxf(mrow[r], tm); const float alpha = __expf(mrow[r] - mnew); mrow[r] = mnew;
                float ps = 0.f;
#pragma unroll
                for (int nt = 0; nt < 4; ++nt) { float pv = 0.f; if (nt >= ntlo && nt <= nthi) { pv = __expf(s[nt][r] - mnew); ps += pv; } Ps[(4 * fq + r) * 72 + 16 * nt + fr] = (bf16)f2bf(pv); oacc[nt][r] *= alpha; }
                lsum[r] = lsum[r] * alpha + ps; }
            LDS_WAIT();
#pragma unroll
            for (int ks = 0; ks < 2; ++ks) { if (ks == 0 ? (ntlo < 2) : (nthi > 1)) { const bf16x8 pa = frag_rm(Ps, 72, 0, 32 * ks, lane);
#pragma unroll
                for (int nt = 0; nt < 4; ++nt) oacc[nt] = MFMA(pa, frag_tr(Vs, 72, 32 * ks, 16 * nt, lane), oacc[nt]); } }
            LDS_WAIT();
        }
    }
#pragma unroll
    for (int r = 0; r < 4; ++r) { float lt = red16_sum(lsum[r]); float sc;
        if (mode == 1 || mode == 3) { const float mf = fmaxf(mrow[r], sink); const float al = __expf(mrow[r] - mf); lt = lt * al + __expf(sink - mf); sc = al / lt; } else sc = 1.f / lt;
#pragma unroll
        for (int nt = 0; nt < 4; ++nt) Ps[(4 * fq + r) * 72 + 16 * nt + fr] = (bf16)f2bf(oacc[nt][r] * sc); }
    LDS_WAIT();
#pragma unroll
    for (int c2 = 0; c2 < 2; ++c2) { const int idx = lane + 64 * c2, q = idx >> 3, ch = idx & 7;
        const u32x4 ov = *(const LAS u32x4*)(Ps + q * 72 + 8 * ch); const u32x4 gv = *(const u32x4*)(P + (size_t)(qrow0 + q) * ldp + gcol + 8 * ch);
        u32x4 w;
        w.x = pk2(bflo(ov.x) * siluf(bflo(gv.x)), bfhi(ov.x) * siluf(bfhi(gv.x))); w.y = pk2(bflo(ov.y) * siluf(bflo(gv.y)), bfhi(ov.y) * siluf(bfhi(gv.y)));
        w.z = pk2(bflo(ov.z) * siluf(bflo(gv.z)), bfhi(ov.z) * siluf(bfhi(gv.z))); w.w = pk2(bflo(ov.w) * siluf(bflo(gv.w)), bfhi(ov.w) * siluf(bfhi(gv.w)));
        *(u32x4*)(Z + (size_t)(qrow0 + q) * DM + zcol + 8 * ch) = w; }
    LDS_WAIT();
}
__device__ __forceinline__ void phase_attn(KP p, LAS unsigned char* lds, int l, bool need_ctx) {
    const int wave = otid() >> 6; const bool odd = l & 1; const int li = l >> 1;
    const bf16* P = (const bf16*)(p->ws + WS_P); bf16* Z = (bf16*)(p->ws + WS_H); const int ldp = odd ? NP_ODD : NP_EVEN;
    const int nmain = BATCH * 8 * 32, nctx = need_ctx ? BATCH * 8 * 2 : 0;
    for (int it = blockIdx.x; it < nmain + nctx; it += gridDim.x) {
        if (it < nmain) {
            const int b = it >> 8, h = (it >> 5) & 7, qb = it & 31;
            if (!odd) { const int r0 = 2 * qb, rw = r0 + (wave >> 2); const int rs0 = min(max(r0 - 4, 0), 56), rs1 = min(max(r0 + 1 - 4, 0), 56);
                attn_item(lds, P, ldp, Z, 0, b * SEQ + rw * 64 + 16 * (wave & 3), 1536 + h * 64, 2048 + h * 64, 2560 + h * 64, 3072 + h * 64, 512 + h * 64,
                          rs1 + 8 - rs0, b * SEQ + rs0 * 64, MLAT + b * CTXL, rw, 16 * (wave & 3), rs0, p->na_rpb + (size_t)(li * 8 + h) * 465, 0.f); }
            else { const int kv = h >> 2, t0 = 128 * qb, lt0 = max(0, 2 * qb - 2), lt1 = min(63, 2 * qb + 3);
                attn_item(lds, P, ldp, Z, 1, b * SEQ + t0 + 16 * wave, 1536 + h * 64, 2048 + kv * 64, 2176 + kv * 64, 2304 + h * 64, 512 + h * 64,
                          lt1 - lt0 + 1, b * SEQ + lt0 * 64, MLAT + b * CTXL, t0 + 16 * wave, 0, lt0 * 64, nullptr, p->sw_sink[li * 8 + h]); }
        } else {
            const int j = it - nmain, b = j >> 4, h = (j >> 1) & 7, half = j & 1; const int q0 = MLAT + b * CTXL + 128 * half + 16 * wave;
            if (!odd) attn_item(lds, P, ldp, Z, 2, q0, 1536 + h * 64, 2048 + h * 64, 2560 + h * 64, 3072 + h * 64, 512 + h * 64, 0, 0, MLAT + b * CTXL, 0, 0, 0, nullptr, 0.f);
            else { const int kv = h >> 2; attn_item(lds, P, ldp, Z, 3, q0, 1536 + h * 64, 2048 + kv * 64, 2176 + kv * 64, 2304 + h * 64, 512 + h * 64, 0, 0, MLAT + b * CTXL, 0, 0, 0, nullptr, p->sw_sink[li * 8 + h]); }
        }
    }
}
__device__ __forceinline__ int chunk_row0(int b, int cp) { return cp < 4 ? MLAT + b * CTXL + cp * 64 : b * SEQ + (cp - 4) * 64; }
constexpr int SL_KDF = 0, SL_KDB = 9216, SL_VS = 18432, SL_SEG = 35840, SL_MISC = 39936;
__device__ __forceinline__ void phase_scan_local(KP p, LAS unsigned char* lds, int l) {
    const int tid = otid(), lane = tid & 63, wave = tid >> 6, fq = lane >> 4, fr = lane & 15; const bool odd = l & 1; const int li = l >> 1;
    const bf16* P = (const bf16*)(p->ws + WS_P); const int ldp = odd ? NP_ODD : NP_EVEN; const float* SM = (const float*)(p->ws + WS_SM);
    float* S = (float*)(p->ws + WS_S); float* GAM = (float*)(p->ws + WS_GAM); float* SC = (float*)(p->ws + WS_SC);
    LAS bf16* kdf = (LAS bf16*)(lds + SL_KDF); LAS bf16* kdb = (LAS bf16*)(lds + SL_KDB); LAS bf16* vs = (LAS bf16*)(lds + SL_VS);
    LAS float* seg = (LAS float*)(lds + SL_SEG); LAS float* misc = (LAS float*)(lds + SL_MISC);
    const int dk = tid & 63, sg = tid >> 6;
    for (int it = blockIdx.x; it < BATCH * 4 * NCHUNK; it += gridDim.x) {
        const int b = it / (4 * NCHUNK), h = (it / NCHUNK) & 3, cp = it % NCHUNK; const int row0 = chunk_row0(b, cp);
        const int slf = ((b * 4 + h) * 2 + 0) * NCHUNK + cp, slb = slf + NCHUNK;
        __syncthreads();
#pragma unroll
        for (int c2 = 0; c2 < 2; ++c2) { const int idx = tid + NTHR * c2, t = idx >> 4, ch = idx & 15; *(LAS u32x4*)(vs + t * 136 + 8 * ch) = *(const u32x4*)(P + (size_t)(row0 + t) * ldp + 512 + h * 128 + 8 * ch); }
        float kv[8];
#pragma unroll
        for (int tt = 0; tt < 8; ++tt) kv[tt] = bf2f(P[(size_t)(row0 + sg * 8 + tt) * ldp + 256 + h * 64 + dk]);
        if (!odd) {
            float gwf[16], gwb[16];
            const float* gw = p->gla_gate_w + (size_t)li * 2 * 16 * 256; const float* gb = p->gla_gate_b + (size_t)li * 2 * 256;
#pragma unroll
            for (int r = 0; r < 16; ++r) { gwf[r] = gw[r * 256 + h * 64 + dk]; gwb[r] = gw[(16 + r) * 256 + h * 64 + dk]; }
            const float gbf = gb[h * 64 + dk], gbb = gb[256 + h * 64 + dk];
            { const int t = tid >> 3, c4 = (tid & 7) * 4; *(LAS f32x4*)(misc + t * 32 + c4) = *(const f32x4*)(SM + (size_t)(row0 + t) * 32 + c4); }
            __syncthreads();
            float pf[8], sb[8];
#pragma unroll
            for (int tt = 0; tt < 8; ++tt) { const LAS float* lr = misc + (sg * 8 + tt) * 32; float zf = gbf, zb = gbb;
#pragma unroll
                for (int r = 0; r < 16; ++r) { zf += lr[r] * gwf[r]; zb += lr[16 + r] * gwb[r]; }
                pf[tt] = logsigf(zf) * 0.0625f; sb[tt] = logsigf(zb) * 0.0625f; }
#pragma unroll
            for (int tt = 1; tt < 8; ++tt) pf[tt] += pf[tt - 1];
#pragma unroll
            for (int tt = 6; tt >= 0; --tt) sb[tt] += sb[tt + 1];
            seg[(0 * 8 + sg) * 64 + dk] = pf[7]; seg[(1 * 8 + sg) * 64 + dk] = sb[0];
            __syncthreads();
            float offf = 0.f, totf = 0.f, offb = 0.f, totb = 0.f;
#pragma unroll
            for (int q = 0; q < 8; ++q) { const float a = seg[q * 64 + dk], c = seg[(8 + q) * 64 + dk]; totf += a; totb += c; if (q < sg) offf += a; if (q > sg) offb += c; }
#pragma unroll
            for (int tt = 0; tt < 8; ++tt) { const int t = sg * 8 + tt;
                kdf[t * 72 + dk] = (bf16)f2bf(kv[tt] * __expf(totf - (offf + pf[tt]))); kdb[t * 72 + dk] = (bf16)f2bf(kv[tt] * __expf(totb - (offb + sb[tt]))); }
            if (sg == 0) { GAM[(size_t)slf * 64 + dk] = __expf(totf); GAM[(size_t)slb * 64 + dk] = __expf(totb); }
        } else {
            const float* mb = p->ml_gate_b + li * 16;
            if (tid < 128) { const int d = tid >> 6, t = tid & 63; const float* gp = SM + (size_t)(row0 + t) * 32 + d * 8;
                misc[d * 128 + t] = gp[h] + mb[d * 8 + h]; misc[d * 128 + 64 + t] = logsigf(gp[4 + h] + mb[d * 8 + 4 + h]); }
            __syncthreads();
            if (tid < 128) { const int d = tid >> 6, t = tid & 63; const float run = wave_scan_sum(misc[d * 128 + 64 + t], t, d == 1);
                const float tot = d == 0 ? __shfl(run, 63) : __shfl(run, 0);
                const float wl = tot - run + misc[d * 128 + t]; const float ml = wave_max(wl);
                misc[256 + d * 64 + t] = __expf(wl - ml);
                if (t == 0) { const int sl = d == 0 ? slf : slb; SC[(size_t)sl * 4 + 0] = tot; SC[(size_t)sl * 4 + 1] = ml; } }
            __syncthreads();
            float nf = 0.f, nb = 0.f;
#pragma unroll
            for (int tt = 0; tt < 8; ++tt) { const int t = sg * 8 + tt; const float a = kv[tt] * misc[256 + t], c = kv[tt] * misc[256 + 64 + t]; nf += a; nb += c;
                kdf[t * 72 + dk] = (bf16)f2bf(a); kdb[t * 72 + dk] = (bf16)f2bf(c); }
            seg[(0 * 8 + sg) * 64 + dk] = nf; seg[(1 * 8 + sg) * 64 + dk] = nb;
            __syncthreads();
            if (sg < 2) { float s2 = 0.f;
#pragma unroll
                for (int q = 0; q < 8; ++q) s2 += seg[(sg * 8 + q) * 64 + dk];
                GAM[(size_t)(sg == 0 ? slf : slb) * 64 + dk] = s2; }
        }
        __syncthreads();
#pragma unroll
        for (int d = 0; d < 2; ++d) { const LAS bf16* kd = d ? kdb : kdf; f32x4 acc[4];
#pragma unroll
            for (int mt = 0; mt < 4; ++mt) acc[mt] = (f32x4){0.f, 0.f, 0.f, 0.f};
#pragma unroll
            for (int ks = 0; ks < 2; ++ks) { const bf16x8 bv = frag_tr(vs, 136, 32 * ks, 16 * wave, lane);
#pragma unroll
                for (int mt = 0; mt < 4; ++mt) acc[mt] = MFMA(frag_tr(kd, 72, 32 * ks, 16 * mt, lane), bv, acc[mt]); }
            float* dst = S + (size_t)(d ? slb : slf) * 8192;
#pragma unroll
            for (int mt = 0; mt < 4; ++mt)
#pragma unroll
                for (int r = 0; r < 4; ++r) dst[(16 * mt + 4 * fq + r) * 128 + 16 * wave + fr] = acc[mt][r]; }
    }
}
__device__ __forceinline__ void phase_scan_seq(KP p, int l, bool dummy = false) {
    const bool odd = l & 1;
    f32x4* S4 = (f32x4*)(p->ws + WS_S); float* GAM = (float*)(p->ws + WS_GAM); f32x4* GAM4 = (f32x4*)(p->ws + WS_GAM); float* SC = (float*)(p->ws + WS_SC);
    const int nthreads = gridDim.x * NTHR;
    for (int gid = blockIdx.x * NTHR + otid(); gid < 64 * 2048; gid += nthreads) {
        const int chain = gid >> 11, e4 = gid & 2047, dir = chain & 1, dkk = e4 >> 5; const int base = chain * NCHUNK;
        f32x4 st = (f32x4){0.f, 0.f, 0.f, 0.f}, nst = (f32x4){0.f, 0.f, 0.f, 0.f}; float m = 0.f; const bool hasn = odd && e4 < 16;
        for (int s0 = 0; s0 < NCHUNK; s0 += 4) {
            f32x4 d[4], dn[4]; float g0[4], g1[4]; int idx[4];
#pragma unroll
            for (int u = 0; u < 4; ++u) { const int step = s0 + u; const int cp = dir == 0 ? step : (step < 4 ? 3 - step : 71 - step); idx[u] = base + cp;
                d[u] = S4[(size_t)idx[u] * 2048 + e4];
                if (!odd) { g0[u] = GAM[(size_t)idx[u] * 64 + dkk]; g1[u] = 0.f; } else { g0[u] = SC[(size_t)idx[u] * 4 + 0]; g1[u] = SC[(size_t)idx[u] * 4 + 1]; if (hasn) dn[u] = GAM4[(size_t)idx[u] * 16 + e4]; } }
#pragma unroll
            for (int u = 0; u < 4; ++u) {
                S4[(size_t)idx[u] * 2048 + e4] = dummy ? d[u] : st;
                if (!odd) { st = st * g0[u] + d[u]; }
                else { if (hasn) GAM4[(size_t)idx[u] * 16 + e4] = dummy ? dn[u] : nst; if (e4 == 0 && !dummy) SC[(size_t)idx[u] * 4 + 2] = m;
                    const float mn = fmaxf(g0[u] + m, g1[u]); const float dec = __expf(g0[u] + m - mn), sc = __expf(g1[u] - mn);
                    st = st * dec + d[u] * sc; if (hasn) nst = nst * dec + dn[u] * sc; m = mn; }
            }
        }
    }
}
constexpr int SO_QF = 0, SO_KF = 9216, SO_QB = 18432, SO_KB = 27648, SO_VS = 36864, SO_AF = 54272, SO_AB = 63488, SO_SF = 72704, SO_SB = 90112, SO_SEG = 107520, SO_SSQ = 111616, SO_MISC = 113664;
constexpr int SO_OST = 0;
__device__ __forceinline__ void scan_out_tail(LAS unsigned char* lds, f32x4 (&o)[4], const bf16* __restrict__ P, int ldp, bf16* __restrict__ Z, int row0, int h, const float* __restrict__ ng) {
    const int tid = otid(), lane = tid & 63, wave = tid >> 6, fq = lane >> 4, fr = lane & 15;
    LAS float* ssq = (LAS float*)(lds + SO_SSQ); LAS float* ost = (LAS float*)(lds + SO_OST);
#pragma unroll
    for (int mt = 0; mt < 4; ++mt)
#pragma unroll
        for (int r = 0; r < 4; ++r) { const float q = red16_sum(o[mt][r] * o[mt][r]); if (fr == 0) ssq[wave * 64 + 16 * mt + 4 * fq + r] = q; }
    __syncthreads();
#pragma unroll
    for (int mt = 0; mt < 4; ++mt)
#pragma unroll
        for (int r = 0; r < 4; ++r) { const int t = 16 * mt + 4 * fq + r; float q = 0.f;
#pragma unroll
            for (int w = 0; w < 8; ++w) q += ssq[w * 64 + t];
            ost[t * 132 + 16 * wave + fr] = o[mt][r] * rsqrtf(q * (1.f / 128.f) + 1e-6f); }
    __syncthreads();
#pragma unroll
    for (int c2 = 0; c2 < 2; ++c2) { const int idx = tid + NTHR * c2, t = idx >> 4, ch = idx & 15;
        const f32x4 o0 = *(const LAS f32x4*)(ost + t * 132 + 8 * ch), o1 = *(const LAS f32x4*)(ost + t * 132 + 8 * ch + 4);
        const f32x4 g0 = *(const f32x4*)(ng + h * 128 + 8 * ch), g1 = *(const f32x4*)(ng + h * 128 + 8 * ch + 4);
        const u32x4 gv = *(const u32x4*)(P + (size_t)(row0 + t) * ldp + 1024 + h * 128 + 8 * ch);
        u32x4 w;
        w.x = pk2(o0[0] * g0[0] * siluf(bflo(gv.x)), o0[1] * g0[1] * siluf(bfhi(gv.x))); w.y = pk2(o0[2] * g0[2] * siluf(bflo(gv.y)), o0[3] * g0[3] * siluf(bfhi(gv.y)));
        w.z = pk2(o1[0] * g1[0] * siluf(bflo(gv.z)), o1[1] * g1[1] * siluf(bfhi(gv.z))); w.w = pk2(o1[2] * g1[2] * siluf(bflo(gv.w)), o1[3] * g1[3] * siluf(bfhi(gv.w)));
        *(u32x4*)(Z + (size_t)(row0 + t) * DM + h * 128 + 8 * ch) = w; }
}
__device__ __forceinline__ void stage_state(LAS bf16* dst, const float* __restrict__ src) {
    const int tid = otid();
#pragma unroll
    for (int c4 = 0; c4 < 4; ++c4) { const int idx = tid + NTHR * c4, r = idx >> 5, c = (idx & 31) * 4; const f32x4 v = *(const f32x4*)(src + r * 128 + c);
        u32x2 w; w.x = pk2(v[0], v[1]); w.y = pk2(v[2], v[3]); *(LAS u32x2*)(dst + r * 136 + c) = w; }
}
__device__ __forceinline__ void phase_scan_out_gla(KP p, LAS unsigned char* lds, int l, bool need_ctx) {
    const int tid = otid(), lane = tid & 63, wave = tid >> 6, fq = lane >> 4, fr = lane & 15; const int li = l >> 1;
    const bf16* P = (const bf16*)(p->ws + WS_P); const int ldp = NP_EVEN; const float* SM = (const float*)(p->ws + WS_SM); bf16* Z = (bf16*)(p->ws + WS_H);
    const float* S = (const float*)(p->ws + WS_S);
    LAS bf16* qf = (LAS bf16*)(lds + SO_QF); LAS bf16* kf = (LAS bf16*)(lds + SO_KF); LAS bf16* qb = (LAS bf16*)(lds + SO_QB); LAS bf16* kb = (LAS bf16*)(lds + SO_KB);
    LAS bf16* vs = (LAS bf16*)(lds + SO_VS); LAS bf16* Af = (LAS bf16*)(lds + SO_AF); LAS bf16* Ab = (LAS bf16*)(lds + SO_AB); LAS bf16* Sf = (LAS bf16*)(lds + SO_SF); LAS bf16* Sb = (LAS bf16*)(lds + SO_SB);
    LAS float* seg = (LAS float*)(lds + SO_SEG); LAS float* lrs = (LAS float*)(lds + SO_MISC);
    const int dk = tid & 63, sg = tid >> 6;
    for (int it = blockIdx.x; it < BATCH * 4 * NCHUNK; it += gridDim.x) {
        const int b = it / (4 * NCHUNK), h = (it / NCHUNK) & 3, cp = it % NCHUNK; if (cp < 4 && !need_ctx) continue;
        const int row0 = chunk_row0(b, cp); const int slf = ((b * 4 + h) * 2 + 0) * NCHUNK + cp, slb = slf + NCHUNK;
        __syncthreads();
#pragma unroll
        for (int c2 = 0; c2 < 2; ++c2) { const int idx = tid + NTHR * c2, t = idx >> 4, ch = idx & 15; *(LAS u32x4*)(vs + t * 136 + 8 * ch) = *(const u32x4*)(P + (size_t)(row0 + t) * ldp + 512 + h * 128 + 8 * ch); }
        stage_state(Sf, S + (size_t)slf * 8192); stage_state(Sb, S + (size_t)slb * 8192);
        float qv[8], kv[8];
#pragma unroll
        for (int tt = 0; tt < 8; ++tt) { const size_t ro = (size_t)(row0 + sg * 8 + tt) * ldp + h * 64 + dk; qv[tt] = bf2f(P[ro]); kv[tt] = bf2f(P[ro + 256]); }
        float gwf[16], gwb[16];
        const float* gw = p->gla_gate_w + (size_t)li * 2 * 16 * 256; const float* gb = p->gla_gate_b + (size_t)li * 2 * 256;
#pragma unroll
        for (int r = 0; r < 16; ++r) { gwf[r] = gw[r * 256 + h * 64 + dk]; gwb[r] = gw[(16 + r) * 256 + h * 64 + dk]; }
        const float gbf = gb[h * 64 + dk], gbb = gb[256 + h * 64 + dk];
        { const int t = tid >> 3, c4 = (tid & 7) * 4; *(LAS f32x4*)(lrs + t * 32 + c4) = *(const f32x4*)(SM + (size_t)(row0 + t) * 32 + c4); }
        __syncthreads();
        float pf[8], sb[8];
#pragma unroll
        for (int tt = 0; tt < 8; ++tt) { const LAS float* lr = lrs + (sg * 8 + tt) * 32; float zf = gbf, zb = gbb;
#pragma unroll
            for (int r = 0; r < 16; ++r) { zf += lr[r] * gwf[r]; zb += lr[16 + r] * gwb[r]; }
            pf[tt] = logsigf(zf) * 0.0625f; sb[tt] = logsigf(zb) * 0.0625f; }
#pragma unroll
        for (int tt = 1; tt < 8; ++tt) pf[tt] += pf[tt - 1];
#pragma unroll
        for (int tt = 6; tt >= 0; --tt) sb[tt] += sb[tt + 1];
        seg[(0 * 8 + sg) * 64 + dk] = pf[7]; seg[(1 * 8 + sg) * 64 + dk] = sb[0];
        __syncthreads();
        float offf = 0.f, offb = 0.f;
#pragma unroll
        for (int q = 0; q < 8; ++q) { const float a = seg[q * 64 + dk], c = seg[(8 + q) * 64 + dk]; if (q < sg) offf += a; if (q > sg) offb += c; }
#pragma unroll
        for (int tt = 0; tt < 8; ++tt) { const int t = sg * 8 + tt; const float bf_ = offf + pf[tt], bb_ = offb + sb[tt];
            qf[t * 72 + dk] = (bf16)f2bf(qv[tt] * __expf(bf_)); kf[t * 72 + dk] = (bf16)f2bf(kv[tt] * __expf(-bf_));
            qb[t * 72 + dk] = (bf16)f2bf(qv[tt] * __expf(bb_)); kb[t * 72 + dk] = (bf16)f2bf(kv[tt] * __expf(-bb_)); }
        __syncthreads();
        { const int mt = wave >> 1;
#pragma unroll
          for (int n2 = 0; n2 < 2; ++n2) { const int nt = 2 * (wave & 1) + n2; f32x4 af = (f32x4){0.f, 0.f, 0.f, 0.f}, ab = (f32x4){0.f, 0.f, 0.f, 0.f};
#pragma unroll
              for (int ks = 0; ks < 2; ++ks) { af = MFMA(frag_rm(qf, 72, 16 * mt, 32 * ks, lane), frag_rm(kf, 72, 16 * nt, 32 * ks, lane), af);
                                               ab = MFMA(frag_rm(qb, 72, 16 * mt, 32 * ks, lane), frag_rm(kb, 72, 16 * nt, 32 * ks, lane), ab); }
#pragma unroll
              for (int r = 0; r < 4; ++r) { const int t = 16 * mt + 4 * fq + r, s = 16 * nt + fr;
                  Af[t * 72 + s] = (bf16)f2bf(s <= t ? af[r] : 0.f); Ab[t * 72 + s] = (bf16)f2bf(s >= t ? ab[r] : 0.f); } } }
        __syncthreads();
        f32x4 o[4];
#pragma unroll
        for (int mt = 0; mt < 4; ++mt) o[mt] = (f32x4){0.f, 0.f, 0.f, 0.f};
#pragma unroll
        for (int ks = 0; ks < 2; ++ks) { const bf16x8 bv = frag_tr(vs, 136, 32 * ks, 16 * wave, lane), bsf = frag_tr(Sf, 136, 32 * ks, 16 * wave, lane), bsb = frag_tr(Sb, 136, 32 * ks, 16 * wave, lane);
#pragma unroll
            for (int mt = 0; mt < 4; ++mt) { o[mt] = MFMA(frag_rm(Af, 72, 16 * mt, 32 * ks, lane), bv, o[mt]); o[mt] = MFMA(frag_rm(Ab, 72, 16 * mt, 32 * ks, lane), bv, o[mt]);
                o[mt] = MFMA(frag_rm(qf, 72, 16 * mt, 32 * ks, lane), bsf, o[mt]); o[mt] = MFMA(frag_rm(qb, 72, 16 * mt, 32 * ks, lane), bsb, o[mt]); } }
        scan_out_tail(lds, o, P, ldp, Z, row0, h, p->gla_norm_g + (size_t)li * 512);
    }
}
constexpr int MO_QS = 0, MO_KS = 9216, MO_QWF = 18432, MO_QWB = 27648;
__device__ __forceinline__ void phase_scan_out_mlstm(KP p, LAS unsigned char* lds, int l, bool need_ctx) {
    const int tid = otid(), lane = tid & 63, wave = tid >> 6, fq = lane >> 4, fr = lane & 15; const int li = l >> 1;
    const bf16* P = (const bf16*)(p->ws + WS_P); const int ldp = NP_ODD; const float* SM = (const float*)(p->ws + WS_SM); bf16* Z = (bf16*)(p->ws + WS_H);
    const float* S = (const float*)(p->ws + WS_S); const float* GAM = (const float*)(p->ws + WS_GAM); const float* SC = (const float*)(p->ws + WS_SC);
    LAS bf16* qs = (LAS bf16*)(lds + MO_QS); LAS bf16* ks_ = (LAS bf16*)(lds + MO_KS); LAS bf16* qwf = (LAS bf16*)(lds + MO_QWF); LAS bf16* qwb = (LAS bf16*)(lds + MO_QWB);
    LAS bf16* vs = (LAS bf16*)(lds + SO_VS); LAS bf16* Af = (LAS bf16*)(lds + SO_AF); LAS bf16* Ab = (LAS bf16*)(lds + SO_AB); LAS bf16* Cf = (LAS bf16*)(lds + SO_SF); LAS bf16* Cb = (LAS bf16*)(lds + SO_SB);
    LAS float* part = (LAS float*)(lds + SO_SEG);
    LAS float* misc = (LAS float*)(lds + SO_MISC);
    const float* mb = p->ml_gate_b + li * 16;
    for (int it = blockIdx.x; it < BATCH * 4 * NCHUNK; it += gridDim.x) {
        const int b = it / (4 * NCHUNK), h = (it / NCHUNK) & 3, cp = it % NCHUNK; if (cp < 4 && !need_ctx) continue;
        const int row0 = chunk_row0(b, cp); const int slf = ((b * 4 + h) * 2 + 0) * NCHUNK + cp, slb = slf + NCHUNK;
        __syncthreads();
#pragma unroll
        for (int c2 = 0; c2 < 2; ++c2) { const int idx = tid + NTHR * c2, t = idx >> 4, ch = idx & 15; *(LAS u32x4*)(vs + t * 136 + 8 * ch) = *(const u32x4*)(P + (size_t)(row0 + t) * ldp + 512 + h * 128 + 8 * ch); }
        stage_state(Cf, S + (size_t)slf * 8192); stage_state(Cb, S + (size_t)slb * 8192);
        { const int t = tid >> 3, ch = tid & 7; const size_t ro = (size_t)(row0 + t) * ldp + h * 64 + 8 * ch;
          *(LAS u32x4*)(qs + t * 72 + 8 * ch) = *(const u32x4*)(P + ro); *(LAS u32x4*)(ks_ + t * 72 + 8 * ch) = *(const u32x4*)(P + ro + 256); }
        if (tid < 128) { const int d = tid >> 6, t = tid & 63; const float* gp = SM + (size_t)(row0 + t) * 32 + d * 8;
            misc[d * 512 + t] = gp[h] + mb[d * 8 + h]; misc[d * 512 + 64 + t] = logsigf(gp[4 + h] + mb[d * 8 + 4 + h]);
            misc[1024 + d * 64 + t] = GAM[(size_t)(d ? slb : slf) * 64 + t]; }
        __syncthreads();
        if (tid < 128) { const int d = tid >> 6, t = tid & 63; LAS float* md = misc + d * 512; const float run = wave_scan_sum(md[64 + t], t, d == 1); const float pm = wave_scan_max(md[t] - run, t, d == 1);
            const float mprev = SC[(size_t)(d ? slb : slf) * 4 + 2];
            const float mt_ = fmaxf(run + pm, run + mprev);
            md[128 + t] = run; md[192 + t] = mt_; md[256 + t] = __expf(run + mprev - mt_); }
        __syncthreads();
        { const int t = tid >> 3, ch = tid & 7; const u32x4 qv = *(const LAS u32x4*)(qs + t * 72 + 8 * ch); const float wf = misc[256 + t], wb = misc[512 + 256 + t];
          u32x4 a, c;
          a.x = pk2(bflo(qv.x) * wf, bfhi(qv.x) * wf); a.y = pk2(bflo(qv.y) * wf, bfhi(qv.y) * wf); a.z = pk2(bflo(qv.z) * wf, bfhi(qv.z) * wf); a.w = pk2(bflo(qv.w) * wf, bfhi(qv.w) * wf);
          c.x = pk2(bflo(qv.x) * wb, bfhi(qv.x) * wb); c.y = pk2(bflo(qv.y) * wb, bfhi(qv.y) * wb); c.z = pk2(bflo(qv.z) * wb, bfhi(qv.z) * wb); c.w = pk2(bflo(qv.w) * wb, bfhi(qv.w) * wb);
          *(LAS u32x4*)(qwf + t * 72 + 8 * ch) = a; *(LAS u32x4*)(qwb + t * 72 + 8 * ch) = c;
          const float q0 = bflo(qv.x), q1 = bfhi(qv.x), q2 = bflo(qv.y), q3 = bfhi(qv.y), q4 = bflo(qv.z), q5 = bfhi(qv.z), q6 = bflo(qv.w), q7 = bfhi(qv.w);
#pragma unroll
          for (int d = 0; d < 2; ++d) { const LAS float* nv = misc + 1024 + d * 64 + 8 * ch;
              part[(d * 8 + ch) * 64 + t] = q0 * nv[0] + q1 * nv[1] + q2 * nv[2] + q3 * nv[3] + q4 * nv[4] + q5 * nv[5] + q6 * nv[6] + q7 * nv[7]; } }
        { const int mt = wave >> 1; float rsf[4] = {0.f, 0.f, 0.f, 0.f}, rsb[4] = {0.f, 0.f, 0.f, 0.f};
#pragma unroll
          for (int n2 = 0; n2 < 2; ++n2) { const int nt = 2 * (wave & 1) + n2; f32x4 a = (f32x4){0.f, 0.f, 0.f, 0.f};
#pragma unroll
              for (int ks = 0; ks < 2; ++ks) a = MFMA(frag_rm(qs, 72, 16 * mt, 32 * ks, lane), frag_rm(ks_, 72, 16 * nt, 32 * ks, lane), a);
#pragma unroll
              for (int r = 0; r < 4; ++r) { const int t = 16 * mt + 4 * fq + r, s = 16 * nt + fr;
                  const float wf = s <= t ? __expf(misc[128 + t] - misc[128 + s] + misc[s] - misc[192 + t]) : 0.f;
                  const float wb = s >= t ? __expf(misc[512 + 128 + t] - misc[512 + 128 + s] + misc[512 + s] - misc[512 + 192 + t]) : 0.f;
                  const float vf = a[r] * wf, vb = a[r] * wb; rsf[r] += vf; rsb[r] += vb;
                  Af[t * 72 + s] = (bf16)f2bf(vf); Ab[t * 72 + s] = (bf16)f2bf(vb); } }
#pragma unroll
          for (int r = 0; r < 4; ++r) { const float a = red16_sum(rsf[r]), c = red16_sum(rsb[r]);
              if (fr == 0) { misc[1152 + (0 * 2 + (wave & 1)) * 64 + 16 * mt + 4 * fq + r] = a; misc[1152 + (1 * 2 + (wave & 1)) * 64 + 16 * mt + 4 * fq + r] = c; } } }
        __syncthreads();
        if (tid < 128) { const int d = tid >> 6, t = tid & 63; float qn = 0.f;
#pragma unroll
            for (int q = 0; q < 8; ++q) qn += part[(d * 8 + q) * 64 + t];
            const float den = misc[1152 + (d * 2 + 0) * 64 + t] + misc[1152 + (d * 2 + 1) * 64 + t] + misc[d * 512 + 256 + t] * qn;
            misc[d * 512 + 320 + t] = 1.f / fmaxf(fabsf(den), __expf(-misc[d * 512 + 192 + t])); }
        f32x4 of[4], ob[4];
#pragma unroll
        for (int mt = 0; mt < 4; ++mt) { of[mt] = (f32x4){0.f, 0.f, 0.f, 0.f}; ob[mt] = (f32x4){0.f, 0.f, 0.f, 0.f}; }
#pragma unroll
        for (int ks = 0; ks < 2; ++ks) { const bf16x8 bv = frag_tr(vs, 136, 32 * ks, 16 * wave, lane), bcf = frag_tr(Cf, 136, 32 * ks, 16 * wave, lane), bcb = frag_tr(Cb, 136, 32 * ks, 16 * wave, lane);
#pragma unroll
            for (int mt = 0; mt < 4; ++mt) { of[mt] = MFMA(frag_rm(Af, 72, 16 * mt, 32 * ks, lane), bv, of[mt]); of[mt] = MFMA(frag_rm(qwf, 72, 16 * mt, 32 * ks, lane), bcf, of[mt]);
                ob[mt] = MFMA(frag_rm(Ab, 72, 16 * mt, 32 * ks, lane), bv, ob[mt]); ob[mt] = MFMA(frag_rm(qwb, 72, 16 * mt, 32 * ks, lane), bcb, ob[mt]); } }
        __syncthreads();
        f32x4 o[4];
#pragma unroll
        for (int mt = 0; mt < 4; ++mt)
#pragma unroll
            for (int r = 0; r < 4; ++r) { const int t = 16 * mt + 4 * fq + r; o[mt][r] = of[mt][r] * misc[320 + t] + ob[mt][r] * misc[512 + 320 + t]; }
        scan_out_tail(lds, o, P, ldp, Z, row0, h, p->ml_norm_g + (size_t)li * 512);
    }
}
#define XB_TMO      128
#define XB_XCNT(j)  (256  + 64 * (j))
#define XB_XSUB(j)  (1280 + 64 * (j))
#define XB_XGEN(j)  (2304 + 64 * (j))
#define XB_TOP      3328
#define XB_TOPGEN   3392
#define XCD_BAR_WORDS 3456
#define XB_SPIN_CAP (1u << 18)

__device__ __forceinline__ unsigned xb_ld(unsigned* p)              { return __hip_atomic_load(p, __ATOMIC_RELAXED, __HIP_MEMORY_SCOPE_AGENT); }
__device__ __forceinline__ unsigned xb_add(unsigned* p, unsigned v) { return __hip_atomic_fetch_add(p, v, __ATOMIC_RELAXED, __HIP_MEMORY_SCOPE_AGENT); }
__device__ __forceinline__ unsigned xb_xcc_id() { return (unsigned)__builtin_amdgcn_s_getreg((3 << 11) | 20) & 0xFu; }
#define XB_SPIN(cond, bar) do { unsigned _sp = 0; while (cond) { __builtin_amdgcn_s_sleep(1); \
    if ((++_sp & 255u) == 0u) { if (xb_ld(&(bar)[XB_TMO])) break; if (_sp > XB_SPIN_CAP) { atomicAdd(&(bar)[XB_TMO], 1u); break; } } } } while (0)

struct XcdBarrier {
    unsigned* bar; unsigned x;
    volatile LAS unsigned* st;
};

__device__ __forceinline__ XcdBarrier xcd_barrier_post(unsigned* bar, volatile LAS unsigned* st) {
    XcdBarrier b; b.bar = bar; b.x = xb_xcc_id(); b.st = st;
    if (otid() == 0) (void)xb_add(&bar[XB_XCNT(b.x)], 1u);
    return b;
}
__device__ __forceinline__ void xcd_barrier_complete(unsigned* bar, unsigned x, unsigned& nloc, unsigned& nx) {
    const unsigned G = gridDim.x * gridDim.y * gridDim.z;
    unsigned sum, cnt, mine, sp = 0u;
    for (;;) {
        sum = 0u; cnt = 0u; mine = 0u;
#pragma unroll
        for (unsigned j = 0; j < 16; ++j) { const unsigned c = xb_ld(&bar[XB_XCNT(j)]); sum += c; cnt += (c > 0u) ? 1u : 0u; mine = (j == x) ? c : mine; }
        if (sum == G) break;
        __builtin_amdgcn_s_sleep(1);
        if ((++sp & 255u) == 0u) { if (xb_ld(&bar[XB_TMO])) break; if (sp > XB_SPIN_CAP) { atomicAdd(&bar[XB_TMO], 1u); break; } }
    }
    nloc = mine > 0u ? mine : 1u; nx = cnt > 0u ? cnt : 1u;
}

__device__ __forceinline__ void xcd_barrier(const XcdBarrier& b) {
    asm volatile("s_waitcnt vmcnt(0)" ::: "memory");
    __syncthreads();
    if (otid() == 0) {
        unsigned* bar = b.bar;
        __builtin_amdgcn_s_waitcnt(0);
        unsigned nloc = b.st[0], nx = b.st[1];
        if (nloc == 0u) { xcd_barrier_complete(bar, b.x, nloc, nx); b.st[0] = nloc; b.st[1] = nx; }
        const unsigned old = xb_add(&bar[XB_XSUB(b.x)], 1u);
        const unsigned gen = old / nloc;
        if (old + 1u == (gen + 1u) * nloc) {
            __builtin_amdgcn_fence(__ATOMIC_RELEASE, "agent");
            asm volatile("s_waitcnt vmcnt(0)" ::: "memory");
            const unsigned og = xb_add(&bar[XB_TOP], 1u);
            const unsigned tg = og / nx;
            if (og + 1u == (tg + 1u) * nx) xb_add(&bar[XB_TOPGEN], 1u);
            else XB_SPIN(xb_ld(&bar[XB_TOPGEN]) == tg, bar);
            __builtin_amdgcn_fence(__ATOMIC_ACQUIRE, "agent");
            xb_add(&bar[XB_XGEN(b.x)], 1u);
            asm volatile("s_waitcnt vmcnt(0)" ::: "memory");
        } else {
            XB_SPIN(xb_ld(&bar[XB_XGEN(b.x)]) == gen, bar);
            __builtin_amdgcn_fence(__ATOMIC_ACQUIRE, "agent");
            asm volatile("s_waitcnt vmcnt(0)" ::: "memory");
        }
    }
    __syncthreads();
}

#define REP_GEMM 1
#define REP_ATT 1
#define REP_LOC 1
#define REP_OUT 1
#define REP_PRO 1
#define REP_SEQ 1
#define REP_LN 1
#ifndef MK_N_LAUNCHES
#define MK_N_LAUNCHES 1
#endif
constexpr int N_PHASES = 2 + 6 * DEPTH;
__global__ void __launch_bounds__(NTHR, 2) fwd_megakernel(Params p_unused) {
    extern __shared__ __attribute__((aligned(16))) unsigned char lds_raw[];
    LAS unsigned char* lds = (LAS unsigned char*)lds_raw;
    cg::grid_group grid = cg::this_grid();
    const int lo = (int)kparams()->ph_lo, hi = (int)kparams()->ph_hi;
#define IN(k) (lo <= (k) && (k) < hi)
    volatile LAS unsigned* bst = (volatile LAS unsigned*)(lds + LDS_BYTES - 64);
    if (otid() < 16) bst[otid()] = 0u;
    __syncthreads();
    XcdBarrier bar = xcd_barrier_post((unsigned*)(kparams()->ws + WS_BAR), bst);
#define SEAM(k) do { if (IN(k) && IN((k) + 1)) { if ((k) == 0) grid.sync(); else xcd_barrier(bar); } } while (0)
    if (IN(0)) { for (int rep = 0; rep < REP_PRO; ++rep) { phase_prologue(kparams(), lds); __syncthreads(); } } SEAM(0);
    if (IN(1)) { for (int rep = 0; rep < REP_PRO; ++rep) phase_h0(kparams()); } SEAM(1);
#pragma unroll 1
    for (int l = 0; l < DEPTH; ++l) {
        const int pb = 2 + 6 * l; const bool odd = l & 1; const int li = l >> 1; const bool need_ctx = l < DEPTH - 1;
        if (IN(pb + 0)) {
            const int npad = odd ? NPAD_ODD : NPAD_EVEN; unsigned char* ws = kparams()->ws;
            pg8::Gemm g{(const pg8::bf16_t*)(ws + WS_H), (const pg8::bf16_t*)(ws + (odd ? WS_WIO : WS_WIE)) + (size_t)li * npad * 1024, MTOT, npad, 1024};
            pg8::StaticOrder S; S.init(MTOT, npad, (int)gridDim.x, (int)blockIdx.x);
            pg8::EpiProj E{(pg8::bf16_t*)(ws + WS_P), odd ? NP_ODD : NP_EVEN, (float*)(ws + WS_SM), odd ? 16 : 32, npad / 256 - 1, odd ? 1 : 0, (const float*)(ws + WS_ROPE), (const float*)(ws + WS_ROPE) + 1024};
            for (int rep = 0; rep < REP_GEMM; ++rep) pg8::gemm_phase<pg8::EpiProj, pg8::StaticOrder, true, true>(lds, g, S, E);
        }
        SEAM(pb + 0);
        if (IN(pb + 1)) { for (int rep = 0; rep < REP_ATT; ++rep) phase_attn(kparams(), lds, l, need_ctx); for (int rep = 0; rep < REP_LOC; ++rep) phase_scan_local(kparams(), lds, l); }
        SEAM(pb + 1);
        if (IN(pb + 2)) { for (int rep = 1; rep < REP_SEQ; ++rep) { phase_scan_seq(kparams(), l, true); __syncthreads(); } phase_scan_seq(kparams(), l); }
        SEAM(pb + 2);
        if (IN(pb + 3)) { for (int rep = 0; rep < REP_OUT; ++rep) { if (odd) phase_scan_out_mlstm(kparams(), lds, l, need_ctx); else phase_scan_out_gla(kparams(), lds, l, need_ctx); } }
        SEAM(pb + 3);
        if (IN(pb + 4)) {
            const int mrows = need_ctx ? MTOT : MLAT; unsigned char* ws = kparams()->ws;
            pg8::Gemm g{(const pg8::bf16_t*)(ws + WS_H), (const pg8::bf16_t*)(ws + WS_WO) + (size_t)l * 1024 * 1024, mrows, 1024, 1024};
            pg8::StaticOrder S; S.init(mrows, 1024, (int)gridDim.x, (int)blockIdx.x);
            pg8::EpiProj E{(pg8::bf16_t*)(ws + WS_P), 1024, nullptr, 0, -1, 0, nullptr, nullptr};
            for (int rep = 0; rep < REP_GEMM; ++rep) pg8::gemm_phase<pg8::EpiProj, pg8::StaticOrder, true, true>(lds, g, S, E);
        }
        SEAM(pb + 4);
        if (IN(pb + 5)) { for (int rep = 1; rep < REP_LN; ++rep) { phase_ln(kparams(), l, true); } phase_ln(kparams(), l); }
        SEAM(pb + 5);
    }
}
extern "C" void kernel_launch(void* const* d_in, const int* in_sizes, int n_in, void* d_out, int out_size, void* d_ws, size_t ws_size, hipStream_t stream) {
    static int grid = 0;
    if (grid == 0) {
        if (n_in != 19 || ws_size < WS_END) { fprintf(stderr, "kernel_launch: need 19 inputs and %zu bytes of workspace; got %d, %zu\n", (size_t)WS_END, n_in, ws_size); grid = -1; return; }
        int dev = 0, cus = 0, per_cu = 0;
        if (hipGetDevice(&dev) != hipSuccess || hipDeviceGetAttribute(&cus, hipDeviceAttributeMultiprocessorCount, dev) != hipSuccess) { grid = -1; return; }
        if (hipFuncSetAttribute((const void*)fwd_megakernel, hipFuncAttributeMaxDynamicSharedMemorySize, LDS_BYTES) != hipSuccess) { fprintf(stderr, "kernel_launch: hipFuncSetAttribute failed\n"); grid = -1; return; }
        if (hipOccupancyMaxActiveBlocksPerMultiprocessor(&per_cu, (const void*)fwd_megakernel, NTHR, LDS_BYTES) != hipSuccess || per_cu < 1) per_cu = 1;
        grid = cus * per_cu;
    }
    if (grid < 0) return;
    Params p{};
    p.x = (const float*)d_in[0]; p.c = (const float*)d_in[1]; p.ctx = (const float*)d_in[2]; p.c_ctx = (const float*)d_in[3]; p.w_ada = (const float*)d_in[4]; p.b_ada = (const float*)d_in[5];
    p.ln_g = (const float*)d_in[6]; p.ln_b = (const float*)d_in[7]; p.w_in_even = (const float*)d_in[8]; p.w_out_even = (const float*)d_in[9]; p.gla_gate_w = (const float*)d_in[10]; p.gla_gate_b = (const float*)d_in[11];
    p.gla_norm_g = (const float*)d_in[12]; p.na_rpb = (const float*)d_in[13]; p.w_in_odd = (const float*)d_in[14]; p.w_out_odd = (const float*)d_in[15]; p.ml_gate_b = (const float*)d_in[16]; p.ml_norm_g = (const float*)d_in[17];
    p.sw_sink = (const float*)d_in[18]; p.out = (float*)d_out; p.ws = (unsigned char*)d_ws;
    if (hipMemsetAsync((char*)d_ws + WS_BAR, 0, XCD_BAR_WORDS * 4, stream) != hipSuccess) { fprintf(stderr, "kernel_launch: memset failed\n"); return; }
#if MK_N_LAUNCHES == 1
    p.ph_lo = 0; p.ph_hi = N_PHASES;
    void* args[] = {&p};
    hipError_t e = hipLaunchCooperativeKernel((const void*)fwd_megakernel, dim3(grid), dim3(NTHR), args, LDS_BYTES, stream);
    if (e != hipSuccess) fprintf(stderr, "kernel_launch: cooperative launch failed: %s (grid %d)\n", hipGetErrorString(e), grid);
#else
    for (int k = 0; k < N_PHASES; ++k) { p.ph_lo = k; p.ph_hi = k + 1; hipLaunchKernelGGL(fwd_megakernel, dim3(grid), dim3(NTHR), LDS_BYTES, stream, p); }
#endif
}
```

```cpp
#include <hip/hip_runtime.h>
#include <hip/hip_cooperative_groups.h>
#include <cstdio>
#include <cstdint>
namespace cg = cooperative_groups;
__device__ __forceinline__ int otid() { int t = threadIdx.x; asm volatile("" : "+v"(t)); return t; }
namespace pg8 {
#define PG8_LAS __attribute__((address_space(3)))
typedef unsigned short bf16_t;
typedef short bf16x8 __attribute__((ext_vector_type(8)));
typedef float f32x4 __attribute__((ext_vector_type(4)));
typedef unsigned u32x4 __attribute__((ext_vector_type(4)));
constexpr int BM = 256, BK = 64, HALF = 128, HTB = HALF * BK * 2  , STAGE_BYTES = 8 * HTB, NXCD = 8, WGM = 8;

__host__ __device__ __forceinline__ int lds_byte(int r, int c) { const int st = (r >> 4) * 2 + (c >> 5), rr = r & 15, cc = c & 31, ob = rr * 64 + cc * 2; return st * 1024 + (ob ^ (((ob >> 9) & 1) << 5)); }
__host__ __device__ __forceinline__ void stage_rc(int b, int& R, int& C) { const int st = b / 1024, sb = b % 1024, swz = sb ^ (((sb >> 9) & 1) << 5); R = (st >> 1) * 16 + swz / 64; C = (st & 1) * 32 + (swz % 64) / 2; }
__host__ __device__ __forceinline__ int perm32(int rho) { const int n = rho >> 4, i = rho & 15; return 8 * (i >> 2) + 4 * n + (i & 3); }

struct Unit { int pm, pn; };
struct Gemm { const bf16_t* A; const bf16_t* Bt; int M, N, K; };

struct StaticOrder {
    int nM, nN, nwg, G, c;
    __host__ __device__ void init(int M, int N, int G_, int c_) { nM = M / BM; nN = N / BM; nwg = nM * nN; G = G_; c = c_; }
    __host__ __device__ bool next(int i, Unit& u) const {
        const long L = (long)i * G + c; if (L >= nwg) return false;
        int wgid = (int)L; { const int q = nwg / NXCD, r = nwg % NXCD, xcd = wgid % NXCD, off = wgid / NXCD; wgid = (xcd < r ? xcd * (q + 1) : r * (q + 1) + (xcd - r) * q) + off; }
        const int nig = WGM * nN, gid = wgid / nig, fm = gid * WGM, gsz = (nM - fm) < WGM ? (nM - fm) : WGM;
        u.pm = fm + ((wgid % nig) % gsz); u.pn = (wgid % nig) / gsz; return true;
    }
    __device__ __forceinline__ void a_ready(const Unit&) const {}
    __device__ __forceinline__ void done(const Unit&) const {}
};

__device__ __forceinline__ unsigned cvt_pk_bf16(float lo, float hi) { unsigned r; asm volatile("v_cvt_pk_bf16_f32 %0, %1, %2" : "=v"(r) : "v"(lo), "v"(hi)); return r; }
struct EpiProj {
    static constexpr bool PERM = true, AFTER_DRAIN = false;
    bf16_t* P; int ldp; float* SM; int nsm; int last_pn; int rope; const float* cosT; const float* sinT;
    __device__ __forceinline__ void operator()(const f32x4 (&acc)[2][2][4][2], const Unit& u, int wr, int wc, int fr, int fq) const {
        const int row0 = u.pm * BM + wr * 64 + fr;
        if (u.pn == last_pn) {
            if (wc == 0) {
#pragma unroll
                for (int ai = 0; ai < 2; ++ai)
#pragma unroll
                    for (int m = 0; m < 4; ++m) { const int row = row0 + ai * HALF + m * 16;
#pragma unroll
                        for (int n = 0; n < 2; ++n) { const int col = 8 * fq + 4 * n; if (col < nsm) *(f32x4*)(SM + (size_t)row * 32 + col) = acc[ai][0][m][n]; } }
            }
            return;
        }
        const bool do_rope_tile = rope && (u.pn == 6 || u.pn == 7 || u.pn == 8) && (u.pm * BM < 32768);
#pragma unroll
        for (int ai = 0; ai < 2; ++ai)
#pragma unroll
            for (int m = 0; m < 4; ++m) { const int row = row0 + ai * HALF + m * 16; bf16_t* rowp = P + (size_t)row * ldp + u.pn * BM + wc * 32 + 8 * fq;
#pragma unroll
                for (int bj = 0; bj < 2; ++bj) { f32x4 v0 = acc[ai][bj][m][0], v1 = acc[ai][bj][m][1];
                    if (do_rope_tile && (u.pn != 8 || bj == 0)) {
                        const int t = row & 4095; const int pos = (wc & 1) ? (t & 63) : (t >> 6); const int i0 = pos * 16 + 8 * (fq & 1);
                        const f32x4 c0 = *(const f32x4*)(cosT + i0), c1 = *(const f32x4*)(cosT + i0 + 4), s0 = *(const f32x4*)(sinT + i0), s1 = *(const f32x4*)(sinT + i0 + 4);
                        f32x4 p0, p1;
#pragma unroll
                        for (int e = 0; e < 4; ++e) { p0[e] = __shfl_xor(v0[e], 32); p1[e] = __shfl_xor(v1[e], 32); }
                        if (fq < 2) { v0 = v0 * c0 - p0 * s0; v1 = v1 * c1 - p1 * s1; } else { v0 = p0 * s0 + v0 * c0; v1 = p1 * s1 + v1 * c1; }
                    }
                    u32x4 w; w.x = cvt_pk_bf16(v0[0], v0[1]); w.y = cvt_pk_bf16(v0[2], v0[3]); w.z = cvt_pk_bf16(v1[0], v1[1]); w.w = cvt_pk_bf16(v1[2], v1[3]);
                    *(u32x4*)(rowp + bj * HALF) = w; } }
    }
};
template <class Epi, class Sched, bool ALIGN_EPI = false, bool SP2 = false>
__device__ __forceinline__ void gemm_phase(PG8_LAS unsigned char* lds, const Gemm g, const Sched& S, const Epi& E) {
    const int tid = otid(), wid = __builtin_amdgcn_readfirstlane(tid >> 6), lane = tid & 63, wr = wid >> 2, wc = wid & 3, fr = lane & 15, fq = lane >> 4;
    const int K = g.K, nt = K / BK;
    unsigned voffA[2], voffB[2];
#pragma unroll
    for (int i = 0; i < 2; ++i) { int R, C; stage_rc(tid * 16 + i * 8192, R, C); const int Rb = Epi::PERM ? ((R & ~31) + perm32(R & 31)) : R;
        voffA[i] = (unsigned)(R * K + C) * 2u; voffB[i] = (unsigned)(Rb * K + C) * 2u; }
    const size_t kstep = (size_t)(BK * 2);
    const size_t hstep = (size_t)HALF * K * 2;
    const size_t tstep = 2 * hstep;
    const unsigned ldsw = (unsigned)wid * 1024u;
    const int aoff = lds_byte(wr * 64 + fr, fq * 8), boff = lds_byte(wc * 32 + fr, fq * 8);
#define PG8_SA(b, h) (((b) * 2 + (h)) * HTB)
#define PG8_SB(b, h) ((4 + (b) * 2 + (h)) * HTB)
#define PG8_STAGE(bufoff, gbase, voff) do { _Pragma("unroll") for (int _i = 0; _i < 2; ++_i) \
        __builtin_amdgcn_global_load_lds((const unsigned*)((const char*)(gbase) + (voff)[_i]), (PG8_LAS unsigned*)(lds + (bufoff) + ldsw + _i * 8192), 16, 0, 0); } while (0)
#define PG8_LDA(dst, b, h) do { _Pragma("unroll") for (int m = 0; m < 4; ++m) _Pragma("unroll") for (int k = 0; k < 2; ++k) dst[m][k] = *(const PG8_LAS bf16x8*)(lds + PG8_SA(b, h) + aoff + m * 2048 + k * 1024); } while (0)
#define PG8_LDB(dst, b, h) do { _Pragma("unroll") for (int n = 0; n < 2; ++n) _Pragma("unroll") for (int k = 0; k < 2; ++k) dst[n][k] = *(const PG8_LAS bf16x8*)(lds + PG8_SB(b, h) + boff + n * 2048 + k * 1024); } while (0)
#define PG8_MMA(ai, bj, At, Bt) do { __builtin_amdgcn_s_setprio(1); _Pragma("unroll") for (int m = 0; m < 4; ++m) _Pragma("unroll") for (int n = 0; n < 2; ++n) _Pragma("unroll") for (int k = 0; k < 2; ++k) \
        acc[ai][bj][m][n] = __builtin_amdgcn_mfma_f32_16x16x32_bf16(Bt[n][k], At[m][k], acc[ai][bj][m][n], 0, 0, 0); __builtin_amdgcn_s_setprio(0); } while (0)
#define PG8_WAIT_V(n) asm volatile("s_waitcnt vmcnt(" #n ")" ::: "memory")
#define PG8_WAIT_L(n) asm volatile("s_waitcnt lgkmcnt(" #n ")" ::: "memory")
#define PG8_BAR __builtin_amdgcn_s_barrier()
#define PG8_SCHED __builtin_amdgcn_sched_barrier(0)
    Unit cur, nxt; int ui = 0;
    if (!S.next(0, cur)) return;
    f32x4 acc[2][2][4][2];
#pragma unroll
    for (int a = 0; a < 2; ++a)
#pragma unroll
        for (int b = 0; b < 2; ++b)
#pragma unroll
            for (int m = 0; m < 4; ++m)
#pragma unroll
                for (int n = 0; n < 2; ++n) acc[a][b][m][n] = (f32x4){0.f, 0.f, 0.f, 0.f};
    bf16x8 At[4][2], B0[2][2], B1[2][2];
    const char* cA = (const char*)g.A + (size_t)cur.pm * tstep; const char* cB = (const char*)g.Bt + (size_t)cur.pn * tstep;
    S.a_ready(cur);
    if constexpr (SP2) {
        PG8_STAGE(PG8_SB(0, 0), cB, voffB); PG8_STAGE(PG8_SB(0, 1), cB + hstep, voffB); PG8_STAGE(PG8_SA(0, 0), cA, voffA); PG8_STAGE(PG8_SA(0, 1), cA + hstep, voffA);
        if (wr == 1) PG8_BAR;
        PG8_WAIT_V(2); PG8_BAR;
        PG8_STAGE(PG8_SB(1, 0), cB + kstep, voffB); PG8_STAGE(PG8_SA(1, 0), cA + kstep, voffA); PG8_STAGE(PG8_SB(1, 1), cB + hstep + kstep, voffB);
        PG8_WAIT_V(6); PG8_BAR;
    } else {
        PG8_STAGE(PG8_SB(0, 0), cB, voffB); PG8_STAGE(PG8_SA(0, 0), cA, voffA); PG8_STAGE(PG8_SB(0, 1), cB + hstep, voffB); PG8_STAGE(PG8_SA(0, 1), cA + hstep, voffA);
        if (wr == 1) PG8_BAR;
        PG8_WAIT_V(4); PG8_BAR;
        PG8_STAGE(PG8_SB(1, 0), cB + kstep, voffB); PG8_STAGE(PG8_SA(1, 0), cA + kstep, voffA); PG8_STAGE(PG8_SB(1, 1), cB + hstep + kstep, voffB);
        PG8_WAIT_V(6); PG8_BAR;
    }
    for (;;) {
        const bool has_next = S.next(ui + 1, nxt);
        const char* nA = has_next ? (const char*)g.A + (size_t)nxt.pm * tstep : cA; const char* nB = has_next ? (const char*)g.Bt + (size_t)nxt.pn * tstep : cB;
        for (int t = 0; t < nt; t += 2) {
            const bool last = (t == nt - 2);
            const char* a1 = cA + (size_t)(t + 1) * kstep;
            const char* a2 = last ? nA : cA + (size_t)(t + 2) * kstep; const char* b2 = last ? nB : cB + (size_t)(t + 2) * kstep;
            const char* a3 = a2 + kstep; const char* b3 = b2 + kstep;
            if (last && has_next) S.a_ready(nxt);
            if constexpr (SP2) {
            PG8_LDB(B0, 0, 0); PG8_LDB(B1, 0, 1); PG8_SCHED; PG8_LDA(At, 0, 0); PG8_STAGE(PG8_SA(1, 1), a1 + hstep, voffA);
            PG8_WAIT_V(8); PG8_WAIT_L(0); PG8_BAR; PG8_MMA(0, 0, At, B0); PG8_MMA(0, 1, At, B1); PG8_BAR; PG8_SCHED;
            PG8_LDA(At, 0, 1); PG8_STAGE(PG8_SB(0, 0), b2, voffB); PG8_STAGE(PG8_SB(0, 1), b2 + hstep, voffB); PG8_STAGE(PG8_SA(0, 0), a2, voffA);
            PG8_WAIT_V(8); PG8_WAIT_L(0); PG8_BAR; PG8_MMA(1, 0, At, B0); PG8_MMA(1, 1, At, B1); PG8_BAR; PG8_SCHED;
            PG8_LDB(B0, 1, 0); PG8_LDB(B1, 1, 1); PG8_SCHED; PG8_LDA(At, 1, 0); PG8_STAGE(PG8_SA(0, 1), a2 + hstep, voffA);
            PG8_WAIT_V(8); PG8_WAIT_L(0); PG8_BAR; PG8_MMA(0, 0, At, B0); PG8_MMA(0, 1, At, B1); PG8_BAR; PG8_SCHED;
            PG8_LDA(At, 1, 1); PG8_STAGE(PG8_SB(1, 0), b3, voffB); PG8_STAGE(PG8_SB(1, 1), b3 + hstep, voffB); PG8_STAGE(PG8_SA(1, 0), a3, voffA);
            PG8_WAIT_V(8); PG8_WAIT_L(0); PG8_BAR; PG8_MMA(1, 0, At, B0); PG8_MMA(1, 1, At, B1); PG8_BAR; PG8_SCHED;
            } else {
            PG8_LDB(B0, 0, 0); PG8_SCHED; PG8_LDA(At, 0, 0); PG8_STAGE(PG8_SA(1, 1), a1 + hstep, voffA);
            PG8_WAIT_L(8); PG8_BAR; PG8_WAIT_L(0); PG8_MMA(0, 0, At, B0); PG8_BAR; PG8_SCHED;
            PG8_LDB(B1, 0, 1); PG8_STAGE(PG8_SB(0, 0), b2, voffB);
            PG8_BAR; PG8_WAIT_L(0); PG8_MMA(0, 1, At, B1); PG8_BAR;
            PG8_LDA(At, 0, 1); PG8_STAGE(PG8_SA(0, 0), a2, voffA);
            PG8_BAR; PG8_WAIT_L(0); PG8_MMA(1, 0, At, B0); PG8_BAR; PG8_SCHED;
            PG8_STAGE(PG8_SB(0, 1), b2 + hstep, voffB);
            PG8_WAIT_V(6); PG8_BAR; PG8_MMA(1, 1, At, B1); PG8_BAR;
            PG8_LDB(B0, 1, 0); PG8_SCHED; PG8_LDA(At, 1, 0); PG8_STAGE(PG8_SA(0, 1), a2 + hstep, voffA);
            PG8_WAIT_L(8); PG8_BAR; PG8_WAIT_L(0); PG8_MMA(0, 0, At, B0); PG8_BAR; PG8_SCHED;
            PG8_LDB(B1, 1, 1); PG8_STAGE(PG8_SB(1, 0), b3, voffB);
            PG8_BAR; PG8_WAIT_L(0); PG8_MMA(0, 1, At, B1); PG8_BAR;
            PG8_LDA(At, 1, 1); PG8_STAGE(PG8_SA(1, 0), a3, voffA);
            PG8_BAR; PG8_WAIT_L(0); PG8_MMA(1, 0, At, B0); PG8_BAR; PG8_SCHED;
            PG8_STAGE(PG8_SB(1, 1), b3 + hstep, voffB);
            PG8_WAIT_V(6); PG8_BAR; PG8_MMA(1, 1, At, B1); PG8_BAR;
            }
        }
        if constexpr (ALIGN_EPI) { if (wr == 0) PG8_BAR; }
        if constexpr (!Epi::AFTER_DRAIN) { E(acc, cur, wr, wc, fr, fq); S.done(cur); }
        if (!has_next) break;
#pragma unroll
        for (int a = 0; a < 2; ++a)
#pragma unroll
            for (int b = 0; b < 2; ++b)
#pragma unroll
                for (int m = 0; m < 4; ++m)
#pragma unroll
                    for (int n = 0; n < 2; ++n) acc[a][b][m][n] = (f32x4){0.f, 0.f, 0.f, 0.f};
        cur = nxt; cA = nA; cB = nB; ++ui;
        if constexpr (ALIGN_EPI) { if (wr == 1) PG8_BAR; }
    }
    PG8_WAIT_V(0);
    if constexpr (!ALIGN_EPI) { if (wr == 0) PG8_BAR; }
    PG8_BAR;
    if constexpr (Epi::AFTER_DRAIN) { E.fused(acc, cur, wr, wc, fr, fq, lds, wid, lane); S.done(cur); }
#undef PG8_SA
#undef PG8_SB
#undef PG8_STAGE
#undef PG8_LDA
#undef PG8_LDB
#undef PG8_MMA
#undef PG8_WAIT_V
#undef PG8_WAIT_L
#undef PG8_BAR
#undef PG8_SCHED
}
}
constexpr int NWAVES = 8, NTHR = 512;
constexpr int BATCH = 8, SEQ = 4096, DM = 1024, CTXL = 256, DEPTH = 4;
constexpr int MLAT = BATCH * SEQ, MCTX = BATCH * CTXL, MTOT = MLAT + MCTX;
constexpr int NP_EVEN = 3584, NPAD_EVEN = 3840, NORIG_EVEN = 3616;
constexpr int NP_ODD = 2816, NPAD_ODD = 3072, NORIG_ODD = 2832;
constexpr int NCHUNK = 68;
constexpr int NSLOT = BATCH * 4 * 2 * NCHUNK;
constexpr float ALPHA_DN = 1.681792830507429f;
constexpr size_t MiB = 1u << 20;
constexpr size_t WS_MOD = 0;
constexpr size_t WS_BAR = 512 * 1024;
constexpr size_t WS_ROPE = 1 * MiB;
constexpr size_t WS_SC = WS_ROPE + 65536;
constexpr size_t WS_GAM = 2 * MiB;
constexpr size_t WS_SM = 4 * MiB;
constexpr size_t WS_WIE = 9 * MiB;
constexpr size_t WS_WIO = 24 * MiB;
constexpr size_t WS_WO = 36 * MiB;
constexpr size_t WS_XC = 44 * MiB;
constexpr size_t WS_H = 52 * MiB;
constexpr size_t WS_P = 120 * MiB;
constexpr size_t WS_S = 359 * MiB;
constexpr size_t WS_END = WS_S + (size_t)NSLOT * 8192 * 4;
static_assert(WS_SC + (size_t)NSLOT * 16 <= WS_GAM && WS_GAM + (size_t)NSLOT * 256 <= WS_SM && WS_SM + (size_t)MTOT * 128 <= WS_WIE, "ws map 1");
static_assert(WS_WIE + (size_t)2 * NPAD_EVEN * 1024 * 2 <= WS_WIO && WS_WIO + (size_t)2 * NPAD_ODD * 1024 * 2 <= WS_WO && WS_WO + (size_t)4 * 1024 * 1024 * 2 <= WS_XC, "ws map 2");
static_assert(WS_XC + (size_t)MCTX * 1024 * 4 <= WS_H && WS_H + (size_t)MTOT * 1024 * 2 <= WS_P && WS_P + (size_t)MTOT * NP_EVEN * 2 <= WS_S && WS_END <= 512 * MiB, "ws map 3");
constexpr int LDS_BYTES = 147456;

#define LAS __attribute__((address_space(3)))
typedef unsigned short bf16;
typedef float f32x4 __attribute__((ext_vector_type(4)));
typedef short bf16x8 __attribute__((ext_vector_type(8)));
typedef short s16x4 __attribute__((ext_vector_type(4)));
typedef unsigned u32x4 __attribute__((ext_vector_type(4)));
typedef unsigned u32x2 __attribute__((ext_vector_type(2)));
#define LDS_WAIT() asm volatile("s_waitcnt lgkmcnt(0)" ::: "memory")

typedef __bf16 hbf2 __attribute__((ext_vector_type(2)));
typedef float f32x2_ __attribute__((ext_vector_type(2)));
__device__ __forceinline__ unsigned f2bf(float f) { const __bf16 b = (__bf16)f; return (unsigned)__builtin_bit_cast(unsigned short, b); }
__device__ __forceinline__ unsigned pk2(float lo, float hi) { const f32x2_ v = {lo, hi}; const hbf2 b = __builtin_convertvector(v, hbf2); return __builtin_bit_cast(unsigned, b); }
__device__ __forceinline__ float bf2f(unsigned short v) { return __builtin_bit_cast(float, (unsigned)v << 16); }
__device__ __forceinline__ float bflo(unsigned w) { return __builtin_bit_cast(float, w << 16); }
__device__ __forceinline__ float bfhi(unsigned w) { return __builtin_bit_cast(float, w & 0xffff0000u); }
__device__ __forceinline__ float siluf(float x) { return x * __builtin_amdgcn_rcpf(1.f + __expf(-x)); }
__device__ __forceinline__ float logsigf(float z) { return fminf(z, 0.f) - __logf(1.f + __expf(-fabsf(z))); }
template <int N> __device__ __forceinline__ float dpp_ror(float v) { return __builtin_bit_cast(float, __builtin_amdgcn_update_dpp(0, __builtin_bit_cast(int, v), 0x120 + N, 0xf, 0xf, false)); }
__device__ __forceinline__ float red16_max(float v) { v = fmaxf(v, dpp_ror<1>(v)); v = fmaxf(v, dpp_ror<2>(v)); v = fmaxf(v, dpp_ror<4>(v)); v = fmaxf(v, dpp_ror<8>(v)); return v; }
__device__ __forceinline__ float red16_sum(float v) { v += dpp_ror<1>(v); v += dpp_ror<2>(v); v += dpp_ror<4>(v); v += dpp_ror<8>(v); return v; }
__device__ __forceinline__ float wave_sum(float v) {
#pragma unroll
    for (int o = 1; o < 64; o <<= 1) v += __shfl_xor(v, o);
    return v;
}
__device__ __forceinline__ float wave_max(float v) {
#pragma unroll
    for (int o = 1; o < 64; o <<= 1) v = fmaxf(v, __shfl_xor(v, o));
    return v;
}
__device__ __forceinline__ float wave_scan_sum(float v, int lane, bool rev) {
#pragma unroll
    for (int o = 1; o < 64; o <<= 1) { const float t = rev ? __shfl_down(v, o) : __shfl_up(v, o); if (rev ? (lane + o < 64) : (lane >= o)) v += t; }
    return v;
}
__device__ __forceinline__ float wave_scan_max(float v, int lane, bool rev) {
#pragma unroll
    for (int o = 1; o < 64; o <<= 1) { const float t = rev ? __shfl_down(v, o) : __shfl_up(v, o); if (rev ? (lane + o < 64) : (lane >= o)) v = fmaxf(v, t); }
    return v;
}
#define MFMA(a, b, c) __builtin_amdgcn_mfma_f32_16x16x32_bf16((a), (b), (c), 0, 0, 0)
__device__ __forceinline__ bf16x8 frag_rm(const LAS bf16* X, int ld, int row0, int k0, int lane) {
    return *(const LAS bf16x8*)(X + (row0 + (lane & 15)) * ld + k0 + 8 * (lane >> 4));
}
__device__ __forceinline__ bf16x8 frag_tr(const LAS bf16* X, int ld, int k0, int n0, int lane) {
    const int g = lane >> 4, m = lane & 15, q = m >> 2, p = m & 3;
    const LAS bf16* a0 = X + (k0 + 8 * g + q) * ld + n0 + 4 * p;
    const s16x4 lo = __builtin_amdgcn_ds_read_tr16_b64_v4i16((LAS s16x4*)a0);
    const s16x4 hi = __builtin_amdgcn_ds_read_tr16_b64_v4i16((LAS s16x4*)(a0 + 4 * ld));
    bf16x8 r; r[0] = lo[0]; r[1] = lo[1]; r[2] = lo[2]; r[3] = lo[3]; r[4] = hi[0]; r[5] = hi[1]; r[6] = hi[2]; r[7] = hi[3]; return r;
}

struct Params {
    const float *x, *c, *ctx, *c_ctx, *w_ada, *b_ada, *ln_g, *ln_b, *w_in_even, *w_out_even, *gla_gate_w, *gla_gate_b, *gla_norm_g, *na_rpb, *w_in_odd, *w_out_odd, *ml_gate_b, *ml_norm_g, *sw_sink;
    float* out; unsigned char* ws; long long ph_lo, ph_hi;
};
typedef const __attribute__((address_space(4))) Params* KP;
__device__ __forceinline__ KP kparams() { unsigned long long v = (unsigned long long)__builtin_amdgcn_kernarg_segment_ptr(); asm volatile("" : "+s"(v)); return (KP)v; }

__device__ __forceinline__ int orig_col(int type, int n) {
    if (type == 0) { if (n < 1536) return n; if (n < 3584) return n + 32; if (n < 3616) return n - 3584 + 1536; return -1; }
    if (type == 1) { if (n < 1536) return n; if (n < 2816) return n + 16; if (n < 2832) return n - 2816 + 1536; return -1; }
    return n;
}
__device__ __forceinline__ float col_scale(int type, int n) {
    if (type == 0) return (n < 256 || (n >= 1536 && n < 2048)) ? 0.125f : 1.f;
    if (type == 1) return ((n >= 256 && n < 512) || (n >= 1536 && n < 2048)) ? 0.125f : 1.f;
    return 1.f;
}
__device__ __forceinline__ void p0_transpose_item(const float* __restrict__ W, int K, int Norig, int type, bf16* __restrict__ WT, LAS float* scr, int nblk, int item, int lane) {
    const int kb = item / nblk, nb = item % nblk, k0 = 64 * kb, n0 = 32 * nb;
    const int oc = orig_col(type, n0 + (lane & 31)); const float sc = col_scale(type, n0 + (lane & 31));
#pragma unroll 8
    for (int i = 0; i < 32; ++i) { const int kk = 2 * i + (lane >> 5); scr[kk * 33 + (lane & 31)] = oc >= 0 ? W[(size_t)(k0 + kk) * Norig + oc] * sc : 0.f; }
    LDS_WAIT();
    const int c = lane & 7;
#pragma unroll
    for (int j = 0; j < 4; ++j) { const int n = (lane >> 3) + 8 * j; const LAS float* s = scr + (8 * c) * 33 + n;
        u32x4 o; o.x = pk2(s[0 * 33], s[1 * 33]); o.y = pk2(s[2 * 33], s[3 * 33]); o.z = pk2(s[4 * 33], s[5 * 33]); o.w = pk2(s[6 * 33], s[7 * 33]);
        *(u32x4*)(WT + (size_t)(n0 + n) * K + k0 + 8 * c) = o; }
    LDS_WAIT();
}
__device__ __forceinline__ void phase_prologue(KP p, LAS unsigned char* lds) {
    const int tid = otid(), lane = tid & 63, wave = tid >> 6;
    unsigned char* ws = p->ws;
    float* MOD = (float*)(ws + WS_MOD);
    if ((int)blockIdx.x < 192) {
        LAS float* cond = (LAS float*)lds;
        LAS float* red = (LAS float*)(lds + 36864);
        for (int e = tid; e < 9 * 1024; e += NTHR) { const int j = e >> 10, k = e & 1023; const float v = j < 8 ? p->c[j * 1024 + k] : p->c_ctx[k]; cond[e] = siluf(v); }
        __syncthreads();
        for (int it = blockIdx.x; it < 192; it += gridDim.x) {
            const int l = it / 48, n0 = (it % 48) * 64, cq = tid & 15, ks = tid >> 4;
            float acc[9][4];
#pragma unroll
            for (int j = 0; j < 9; ++j) { acc[j][0] = 0.f; acc[j][1] = 0.f; acc[j][2] = 0.f; acc[j][3] = 0.f; }
            const float* wp = p->w_ada + (size_t)l * 1024 * 3072 + (size_t)(ks * 32) * 3072 + n0 + 4 * cq;
#pragma unroll 4
            for (int kk = 0; kk < 32; ++kk) { const f32x4 w = *(const f32x4*)(wp + (size_t)kk * 3072);
#pragma unroll
                for (int j = 0; j < 9; ++j) { const float cv = cond[j * 1024 + ks * 32 + kk]; acc[j][0] += cv * w[0]; acc[j][1] += cv * w[1]; acc[j][2] += cv * w[2]; acc[j][3] += cv * w[3]; } }
#pragma unroll
            for (int j = 0; j < 9; ++j)
#pragma unroll
                for (int i = 0; i < 4; ++i) red[ks * 576 + j * 64 + 4 * cq + i] = acc[j][i];
            __syncthreads();
            for (int o = tid; o < 576; o += NTHR) { float s = 0.f; for (int q = 0; q < 32; ++q) s += red[q * 576 + o]; const int j = o >> 6, n = n0 + (o & 63);
                MOD[(size_t)(l * 9 + j) * 3072 + n] = s + p->b_ada[l * 3072 + n]; }
            __syncthreads();
        }
    }
    if (blockIdx.x == gridDim.x - 1) {
        float* cosT = (float*)(ws + WS_ROPE); float* sinT = cosT + 1024;
        for (int e = tid; e < 1024; e += NTHR) { const int pos = e >> 4, i = e & 15;
            double f = 1.0; for (int q = 0; q < i; ++q) f *= 0.5623413251903491;
            const double f2 = f * f; double sn = 1.0, cs = 1.0;
            for (int q = 12; q >= 1; --q) { sn = 1.0 - f2 / ((2.0 * q) * (2.0 * q + 1.0)) * sn; cs = 1.0 - f2 / ((2.0 * q - 1.0) * (2.0 * q)) * cs; }
            sn *= f;
            double c = 1.0, s = 0.0; for (int q = 0; q < pos; ++q) { const double c2 = c * cs - s * sn, s2 = s * cs + c * sn; c = c2; s = s2; }
            cosT[e] = (float)c; sinT[e] = (float)s; }
    }
    __syncthreads();
    {
        LAS float* scr = (LAS float*)(lds + wave * 16384);
        const int gw = blockIdx.x * NWAVES + wave, NGW = gridDim.x * NWAVES;
        constexpr int I_E = 16 * (NPAD_EVEN / 32), I_O = 16 * (NPAD_ODD / 32), I_W = 16 * 32;
        constexpr int NIT = 2 * I_E + 2 * I_O + 4 * I_W;
        for (int it = gw; it < NIT; it += NGW) {
            int r = it;
            if (r < 2 * I_E) { const int i = r / I_E; r -= i * I_E; p0_transpose_item(p->w_in_even + (size_t)i * 1024 * NORIG_EVEN, 1024, NORIG_EVEN, 0, (bf16*)(ws + WS_WIE) + (size_t)i * NPAD_EVEN * 1024, scr, NPAD_EVEN / 32, r, lane); continue; }
            r -= 2 * I_E;
            if (r < 2 * I_O) { const int i = r / I_O; r -= i * I_O; p0_transpose_item(p->w_in_odd + (size_t)i * 1024 * NORIG_ODD, 1024, NORIG_ODD, 1, (bf16*)(ws + WS_WIO) + (size_t)i * NPAD_ODD * 1024, scr, NPAD_ODD / 32, r, lane); continue; }
            r -= 2 * I_O;
            { const int l = r / I_W; r -= l * I_W; const float* W = (l & 1) ? p->w_out_odd + (size_t)(l >> 1) * 1024 * 1024 : p->w_out_even + (size_t)(l >> 1) * 1024 * 1024;
              p0_transpose_item(W, 1024, 1024, 2, (bf16*)(ws + WS_WO) + (size_t)l * 1024 * 1024, scr, 32, r, lane); }
        }
    }
}
__device__ __forceinline__ void phase_h0(KP p) {
    const int lane = otid() & 63, gw = blockIdx.x * NWAVES + (otid() >> 6), NGW = gridDim.x * NWAVES;
    const float* MOD = (const float*)(p->ws + WS_MOD); bf16* H = (bf16*)(p->ws + WS_H);
    for (int m = gw; m < MTOT; m += NGW) {
        const int jb = m < MLAT ? (m >> 12) : 8;
        const float* src = m < MLAT ? p->x + (size_t)m * DM : p->ctx + (size_t)(m - MLAT) * DM;
        const float* md = MOD + (size_t)jb * 3072;
#pragma unroll
        for (int j = 0; j < 4; ++j) { const int k = 4 * lane + 256 * j; const f32x4 v = *(const f32x4*)(src + k), sh = *(const f32x4*)(md + k), sc = *(const f32x4*)(md + 1024 + k);
            const f32x4 h = v * (sc + 1.0f) + sh; u32x2 o; o.x = pk2(h[0], h[1]); o.y = pk2(h[2], h[3]); *(u32x2*)(H + (size_t)m * DM + k) = o; }
    }
}
__device__ __forceinline__ void phase_ln(KP p, int l, bool dummy = false) {
    const int lane = otid() & 63, gw = blockIdx.x * NWAVES + (otid() >> 6), NGW = gridDim.x * NWAVES;
    const float* MOD = (const float*)(p->ws + WS_MOD); bf16* H = (bf16*)(p->ws + WS_H); const bf16* Y = (const bf16*)(p->ws + WS_P); float* XC = (float*)(p->ws + WS_XC);
    const int mrows = l < DEPTH - 1 ? MTOT : MLAT;
    const float* lg = p->ln_g + l * DM; const float* lb = p->ln_b + l * DM;
    const float* xin = p->x; const float* cin = p->ctx; float* outp = p->out;
    for (int m0 = 2 * gw; m0 < mrows; m0 += 2 * NGW) {
        const int jb = m0 < MLAT ? (m0 >> 12) : 8;
        const float* md = MOD + (size_t)(l * 9 + jb) * 3072;
        const float* src[2]; float* dst[2]; f32x4 v[2][4]; float s[2] = {0.f, 0.f};
#pragma unroll
        for (int q = 0; q < 2; ++q) { const int m = m0 + q;
            src[q] = l == 0 ? (m < MLAT ? xin + (size_t)m * DM : cin + (size_t)(m - MLAT) * DM) : (m < MLAT ? outp + (size_t)m * DM : XC + (size_t)(m - MLAT) * DM);
            dst[q] = m < MLAT ? outp + (size_t)m * DM : XC + (size_t)(m - MLAT) * DM; }
#pragma unroll
        for (int j = 0; j < 4; ++j) { const int k = 4 * lane + 256 * j; const f32x4 g = *(const f32x4*)(md + 2048 + k);
#pragma unroll
            for (int q = 0; q < 2; ++q) { const f32x4 xv = *(const f32x4*)(src[q] + k); const u32x2 yw = *(const u32x2*)(Y + (size_t)(m0 + q) * DM + k);
                f32x4 y; y[0] = bflo(yw.x); y[1] = bfhi(yw.x); y[2] = bflo(yw.y); y[3] = bfhi(yw.y);
                v[q][j] = xv * ALPHA_DN + g * y; s[q] += (v[q][j][0] + v[q][j][1]) + (v[q][j][2] + v[q][j][3]); } }
        float rstd[2];
#pragma unroll
        for (int q = 0; q < 2; ++q) { const float mean = wave_sum(s[q]) * (1.f / DM); float s2 = 0.f;
#pragma unroll
            for (int j = 0; j < 4; ++j) { v[q][j] = v[q][j] - mean; s2 += (v[q][j][0] * v[q][j][0] + v[q][j][1] * v[q][j][1]) + (v[q][j][2] * v[q][j][2] + v[q][j][3] * v[q][j][3]); }
            rstd[q] = 1.f / sqrtf(wave_sum(s2) * (1.f / DM) + 1e-5f); }
        const float* md2 = MOD + (size_t)((l + 1) * 9 + jb) * 3072;
#pragma unroll
        for (int j = 0; j < 4; ++j) { const int k = 4 * lane + 256 * j; const f32x4 gg = *(const f32x4*)(lg + k), bb = *(const f32x4*)(lb + k);
            f32x4 sh = (f32x4){0.f, 0.f, 0.f, 0.f}, sc = sh; if (l < DEPTH - 1) { sh = *(const f32x4*)(md2 + k); sc = *(const f32x4*)(md2 + 1024 + k); }
#pragma unroll
            for (int q = 0; q < 2; ++q) { const f32x4 o = v[q][j] * rstd[q] * gg + bb;
                *(f32x4*)(dst[q] + k) = dummy ? *(const f32x4*)(src[q] + k) : o;
                if (l < DEPTH - 1) { const f32x4 h = o * (sc + 1.0f) + sh; u32x2 w; w.x = pk2(h[0], h[1]); w.y = pk2(h[2], h[3]); *(u32x2*)(H + (size_t)(m0 + q) * DM + k) = w; } } }
    }
}
constexpr int AT_KS = 0, AT_VS = 9216, AT_PS = 18432, AT_RPB = AT_PS + 8 * 2304;
__device__ __forceinline__ void attn_item(LAS unsigned char* lds, const bf16* __restrict__ P, int ldp, bf16* __restrict__ Z, int mode,
                                          int qrow0, int qcol, int kcol, int vcol, int gcol, int zcol,
                                          int nlat, int lat_row0, int ctx_row0, int qa_, int qb_, int ka_, const float* __restrict__ rpb_g, float sink) {
    const int tid = otid(), lane = tid & 63, wave = tid >> 6, fq = lane >> 4, fr = lane & 15;
    LAS bf16* Ks = (LAS bf16*)(lds + AT_KS); LAS bf16* Vs = (LAS bf16*)(lds + AT_VS); LAS bf16* Ps = (LAS bf16*)(lds + AT_PS + wave * 2304); LAS float* rpb = (LAS float*)(lds + AT_RPB);
    __syncthreads();
    if (mode == 0) { for (int e = tid; e < 465; e += NTHR) rpb[e] = rpb_g[e]; }
    bf16x8 qa[2];
#pragma unroll
    for (int ks = 0; ks < 2; ++ks) qa[ks] = *(const bf16x8*)(P + (size_t)(qrow0 + fr) * ldp + qcol + 32 * ks + 8 * fq);
    float mrow[4], lsum[4]; f32x4 oacc[4];
#pragma unroll
    for (int r = 0; r < 4; ++r) { mrow[r] = -1e30f; lsum[r] = 0.f; oacc[r] = (f32x4){0.f, 0.f, 0.f, 0.f}; }
    const int ntile = nlat + 4, srow = tid >> 3, sch = tid & 7;
    u32x4 kreg, vreg;
    { const int rb = nlat > 0 ? lat_row0 : ctx_row0; kreg = *(const u32x4*)(P + (size_t)(rb + srow) * ldp + kcol + 8 * sch); vreg = *(const u32x4*)(P + (size_t)(rb + srow) * ldp + vcol + 8 * sch); }
    for (int i = 0; i < ntile; ++i) {
        __syncthreads();
        *(LAS u32x4*)(Ks + srow * 72 + 8 * sch) = kreg; *(LAS u32x4*)(Vs + srow * 72 + 8 * sch) = vreg;
        __syncthreads();
        if (i + 1 < ntile) { const int rb = (i + 1 < nlat) ? lat_row0 + 64 * (i + 1) : ctx_row0 + 64 * (i + 1 - nlat);
            kreg = *(const u32x4*)(P + (size_t)(rb + srow) * ldp + kcol + 8 * sch); vreg = *(const u32x4*)(P + (size_t)(rb + srow) * ldp + vcol + 8 * sch); }
        const bool islat = i < nlat;
        bool active = true; int kt0 = 0;
        if (islat) {
            if (mode == 0) { kt0 = ka_ + i; const int rs = min(max(qa_ - 4, 0), 56); active = (kt0 >= rs) && (kt0 < rs + 8); }
            else { kt0 = ka_ + 64 * i; active = !(kt0 > qa_ + 15 + 128 || kt0 + 63 < qa_ - 128); }
        }
        if (active) {
            const bool nar = islat && mode == 0;
            const int w4 = wave & 3, ntlo = nar ? (w4 < 2 ? 0 : w4 - 1) : 0, nthi = nar ? (w4 > 1 ? 3 : w4 + 1) : 3;
            f32x4 s[4];
#pragma unroll
            for (int nt = 0; nt < 4; ++nt) { s[nt] = (f32x4){0.f, 0.f, 0.f, 0.f};
                if (nt >= ntlo && nt <= nthi) {
#pragma unroll
                for (int ks = 0; ks < 2; ++ks) s[nt] = MFMA(qa[ks], frag_rm(Ks, 72, 16 * nt, 32 * ks, lane), s[nt]); } }
            float tmax[4] = {-3e38f, -3e38f, -3e38f, -3e38f};
#pragma unroll
            for (int nt = 0; nt < 4; ++nt) { if (nt >= ntlo && nt <= nthi) {
#pragma unroll
                for (int r = 0; r < 4; ++r) { float v = s[nt][r];
                    if (islat) {
                        if (mode == 0) { const int qc = qb_ + 4 * fq + r, kc = 16 * nt + fr, cs = min(max(qc - 8, 0), 48); const bool ok = (kc >= cs) && (kc < cs + 16);
                            const int bi = (kt0 - qa_ + 7) * 31 + (kc - qc + 15); v = ok ? v + rpb[ok ? bi : 0] : -3e38f; }
                        else { const int qt = qa_ + 4 * fq + r, kt = kt0 + 16 * nt + fr; const int d = qt - kt; v = (d <= 128 && d >= -128) ? v : -3e38f; }
                    }
                    s[nt][r] = v; tmax[r] = fmaxf(tmax[r], v); } } }
#pragma unroll
            for (int r = 0; r < 4; ++r) { const float tm = red16_max(tmax[r]); const float mnew = fmaxf(mrow[r], tm); const float alpha = __expf(mrow[r] - mnew); mrow[r] = mnew;
                float ps = 0.f;
#pragma unroll
                for (int nt = 0; nt < 4; ++nt) { float pv = 0.f; if (nt >= ntlo && nt <= nthi) { pv = __expf(s[nt][r] - mnew); ps += pv; } Ps[(4 * fq + r) * 72 + 16 * nt + fr] = (bf16)f2bf(pv); oacc[nt][r] *= alpha; }
                lsum[r] = lsum[r] * alpha + ps; }
            LDS_WAIT();
#pragma unroll
            for (int ks = 0; ks < 2; ++ks) { if (ks == 0 ? (ntlo < 2) : (nthi > 1)) { const bf16x8 pa = frag_rm(Ps, 72, 0, 32 * ks, lane);
#pragma unroll
                for (int nt = 0; nt < 4; ++nt) oacc[nt] = MFMA(pa, frag_tr(Vs, 72, 32 * ks, 16 * nt, lane), oacc[nt]); } }
            LDS_WAIT();
        }
    }
#pragma unroll
    for (int r = 0; r < 4; ++r) { float lt = red16_sum(lsum[r]); float sc;
        if (mode == 1 || mode == 3) { const float mf = fmaxf(mrow[r], sink); const float al = __expf(mrow[r] - mf); lt = lt * al + __expf(sink - mf); sc = al / lt; } else sc = 1.f / lt;
#pragma unroll
        for (int nt = 0; nt < 4; ++nt) Ps[(4 * fq + r) * 72 + 16 * nt + fr] = (bf16)f2bf(oacc[nt][r] * sc); }
    LDS_WAIT();
#pragma unroll
    for (int c2 = 0; c2 < 2; ++c2) { const int idx = lane + 64 * c2, q = idx >> 3, ch = idx & 7;
        const u32x4 ov = *(const LAS u32x4*)(Ps + q * 72 + 8 * ch); const u32x4 gv = *(const u32x4*)(P + (size_t)(qrow0 + q) * ldp + gcol + 8 * ch);
        u32x4 w;
        w.x = pk2(bflo(ov.x) * siluf(bflo(gv.x)), bfhi(ov.x) * siluf(bfhi(gv.x))); w.y = pk2(bflo(ov.y) * siluf(bflo(gv.y)), bfhi(ov.y) * siluf(bfhi(gv.y)));
        w.z = pk2(bflo(ov.z) * siluf(bflo(gv.z)), bfhi(ov.z) * siluf(bfhi(gv.z))); w.w = pk2(bflo(ov.w) * siluf(bflo(gv.w)), bfhi(ov.w) * siluf(bfhi(gv.w)));
        *(u32x4*)(Z + (size_t)(qrow0 + q) * DM + zcol + 8 * ch) = w; }
    LDS_WAIT();
}
__device__ __forceinline__ void phase_attn(KP p, LAS unsigned char* lds, int l, bool need_ctx) {
    const int wave = otid() >> 6; const bool odd = l & 1; const int li = l >> 1;
    const bf16* P = (const bf16*)(p->ws + WS_P); bf16* Z = (bf16*)(p->ws + WS_H); const int ldp = odd ? NP_ODD : NP_EVEN;
    const int nmain = BATCH * 8 * 32, nctx = need_ctx ? BATCH * 8 * 2 : 0;
    for (int it = blockIdx.x; it < nmain + nctx; it += gridDim.x) {
        if (it < nmain) {
            const int b = it >> 8, h = (it >> 5) & 7, qb = it & 31;
            if (!odd) { const int r0 = 2 * qb, rw = r0 + (wave >> 2); const int rs0 = min(max(r0 - 4, 0), 56), rs1 = min(max(r0 + 1 - 4, 0), 56);
                attn_item(lds, P, ldp, Z, 0, b * SEQ + rw * 64 + 16 * (wave & 3), 1536 + h * 64, 2048 + h * 64, 2560 + h * 64, 3072 + h * 64, 512 + h * 64,
                          rs1 + 8 - rs0, b * SEQ + rs0 * 64, MLAT + b * CTXL, rw, 16 * (wave & 3), rs0, p->na_rpb + (size_t)(li * 8 + h) * 465, 0.f); }
            else { const int kv = h >> 2, t0 = 128 * qb, lt0 = max(0, 2 * qb - 2), lt1 = min(63, 2 * qb + 3);
                attn_item(lds, P, ldp, Z, 1, b * SEQ + t0 + 16 * wave, 1536 + h * 64, 2048 + kv * 64, 2176 + kv * 64, 2304 + h * 64, 512 + h * 64,
                          lt1 - lt0 + 1, b * SEQ + lt0 * 64, MLAT + b * CTXL, t0 + 16 * wave, 0, lt0 * 64, nullptr, p->sw_sink[li * 8 + h]); }
        } else {
            const int j = it - nmain, b = j >> 4, h = (j >> 1) & 7, half = j & 1; const int q0 = MLAT + b * CTXL + 128 * half + 16 * wave;
            if (!odd) attn_item(lds, P, ldp, Z, 2, q0, 1536 + h * 64, 2048 + h * 64, 2560 + h * 64, 3072 + h * 64, 512 + h * 64, 0, 0, MLAT + b * CTXL, 0, 0, 0, nullptr, 0.f);
            else { const int kv = h >> 2; attn_item(lds, P, ldp, Z, 3, q0, 1536 + h * 64, 2048 + kv * 64, 2176 + kv * 64, 2304 + h * 64, 512 + h * 64, 0, 0, MLAT + b * CTXL, 0, 0, 0, nullptr, p->sw_sink[li * 8 + h]); }
        }
    }
}
__device__ __forceinline__ int chunk_row0(int b, int cp) { return cp < 4 ? MLAT + b * CTXL + cp * 64 : b * SEQ + (cp - 4) * 64; }
constexpr int SL_KDF = 0, SL_KDB = 9216, SL_VS = 18432, SL_SEG = 35840, SL_MISC = 39936;
__device__ __forceinline__ void phase_scan_local(KP p, LAS unsigned char* lds, int l) {
    const int tid = otid(), lane = tid & 63, wave = tid >> 6, fq = lane >> 4, fr = lane & 15; const bool odd = l & 1; const int li = l >> 1;
    const bf16* P = (const bf16*)(p->ws + WS_P); const int ldp = odd ? NP_ODD : NP_EVEN; const float* SM = (const float*)(p->ws + WS_SM);
    float* S = (float*)(p->ws + WS_S); float* GAM = (float*)(p->ws + WS_GAM); float* SC = (float*)(p->ws + WS_SC);
    LAS bf16* kdf = (LAS bf16*)(lds + SL_KDF); LAS bf16* kdb = (LAS bf16*)(lds + SL_KDB); LAS bf16* vs = (LAS bf16*)(lds + SL_VS);
    LAS float* seg = (LAS float*)(lds + SL_SEG); LAS float* misc = (LAS float*)(lds + SL_MISC);
    const int dk = tid & 63, sg = tid >> 6;
    for (int it = blockIdx.x; it < BATCH * 4 * NCHUNK; it += gridDim.x) {
        const int b = it / (4 * NCHUNK), h = (it / NCHUNK) & 3, cp = it % NCHUNK; const int row0 = chunk_row0(b, cp);
        const int slf = ((b * 4 + h) * 2 + 0) * NCHUNK + cp, slb = slf + NCHUNK;
        __syncthreads();
#pragma unroll
        for (int c2 = 0; c2 < 2; ++c2) { const int idx = tid + NTHR * c2, t = idx >> 4, ch = idx & 15; *(LAS u32x4*)(vs + t * 136 + 8 * ch) = *(const u32x4*)(P + (size_t)(row0 + t) * ldp + 512 + h * 128 + 8 * ch); }
        float kv[8];
#pragma unroll
        for (int tt = 0; tt < 8; ++tt) kv[tt] = bf2f(P[(size_t)(row0 + sg * 8 + tt) * ldp + 256 + h * 64 + dk]);
        if (!odd) {
            float gwf[16], gwb[16];
            const float* gw = p->gla_gate_w + (size_t)li * 2 * 16 * 256; const float* gb = p->gla_gate_b + (size_t)li * 2 * 256;
#pragma unroll
            for (int r = 0; r < 16; ++r) { gwf[r] = gw[r * 256 + h * 64 + dk]; gwb[r] = gw[(16 + r) * 256 + h * 64 + dk]; }
            const float gbf = gb[h * 64 + dk], gbb = gb[256 + h * 64 + dk];
            { const int t = tid >> 3, c4 = (tid & 7) * 4; *(LAS f32x4*)(misc + t * 32 + c4) = *(const f32x4*)(SM + (size_t)(row0 + t) * 32 + c4); }
            __syncthreads();
            float pf[8], sb[8];
#pragma unroll
            for (int tt = 0; tt < 8; ++tt) { const LAS float* lr = misc + (sg * 8 + tt) * 32; float zf = gbf, zb = gbb;
#pragma unroll
                for (int r = 0; r < 16; ++r) { zf += lr[r] * gwf[r]; zb += lr[16 + r] * gwb[r]; }
                pf[tt] = logsigf(zf) * 0.0625f; sb[tt] = logsigf(zb) * 0.0625f; }
#pragma unroll
            for (int tt = 1; tt < 8; ++tt) pf[tt] += pf[tt - 1];
#pragma unroll
            for (int tt = 6; tt >= 0; --tt) sb[tt] += sb[tt + 1];
            seg[(0 * 8 + sg) * 64 + dk] = pf[7]; seg[(1 * 8 + sg) * 64 + dk] = sb[0];
            __syncthreads();
            float offf = 0.f, totf = 0.f, offb = 0.f, totb = 0.f;
#pragma unroll
            for (int q = 0; q < 8; ++q) { const float a = seg[q * 64 + dk], c = seg[(8 + q) * 64 + dk]; totf += a; totb += c; if (q < sg) offf += a; if (q > sg) offb += c; }
#pragma unroll
            for (int tt = 0; tt < 8; ++tt) { const int t = sg * 8 + tt;
                kdf[t * 72 + dk] = (bf16)f2bf(kv[tt] * __expf(totf - (offf + pf[tt]))); kdb[t * 72 + dk] = (bf16)f2bf(kv[tt] * __expf(totb - (offb + sb[tt]))); }
            if (sg == 0) { GAM[(size_t)slf * 64 + dk] = __expf(totf); GAM[(size_t)slb * 64 + dk] = __expf(totb); }
        } else {
            const float* mb = p->ml_gate_b + li * 16;
            if (tid < 128) { const int d = tid >> 6, t = tid & 63; const float* gp = SM + (size_t)(row0 + t) * 32 + d * 8;
                misc[d * 128 + t] = gp[h] + mb[d * 8 + h]; misc[d * 128 + 64 + t] = logsigf(gp[4 + h] + mb[d * 8 + 4 + h]); }
            __syncthreads();
            if (tid < 128) { const int d = tid >> 6, t = tid & 63; const float run = wave_scan_sum(misc[d * 128 + 64 + t], t, d == 1);
                const float tot = d == 0 ? __shfl(run, 63) : __shfl(run, 0);
                const float wl = tot - run + misc[d * 128 + t]; const float ml = wave_max(wl);
                misc[256 + d * 64 + t] = __expf(wl - ml);
                if (t == 0) { const int sl = d == 0 ? slf : slb; SC[(size_t)sl * 4 + 0] = tot; SC[(size_t)sl * 4 + 1] = ml; } }
            __syncthreads();
            float nf = 0.f, nb = 0.f;
#pragma unroll
            for (int tt = 0; tt < 8; ++tt) { const int t = sg * 8 + tt; const float a = kv[tt] * misc[256 + t], c = kv[tt] * misc[256 + 64 + t]; nf += a; nb += c;
                kdf[t * 72 + dk] = (bf16)f2bf(a); kdb[t * 72 + dk] = (bf16)f2bf(c); }
            seg[(0 * 8 + sg) * 64 + dk] = nf; seg[(1 * 8 + sg) * 64 + dk] = nb;
            __syncthreads();
            if (sg < 2) { float s2 = 0.f;
#pragma unroll
                for (int q = 0; q < 8; ++q) s2 += seg[(sg * 8 + q) * 64 + dk];
                GAM[(size_t)(sg == 0 ? slf : slb) * 64 + dk] = s2; }
        }
        __syncthreads();
#pragma unroll
        for (int d = 0; d < 2; ++d) { const LAS bf16* kd = d ? kdb : kdf; f32x4 acc[4];
#pragma unroll
            for (int mt = 0; mt < 4; ++mt) acc[mt] = (f32x4){0.f, 0.f, 0.f, 0.f};
#pragma unroll
            for (int ks = 0; ks < 2; ++ks) { const bf16x8 bv = frag_tr(vs, 136, 32 * ks, 16 * wave, lane);
#pragma unroll
                for (int mt = 0; mt < 4; ++mt) acc[mt] = MFMA(frag_tr(kd, 72, 32 * ks, 16 * mt, lane), bv, acc[mt]); }
            float* dst = S + (size_t)(d ? slb : slf) * 8192;
#pragma unroll
            for (int mt = 0; mt < 4; ++mt)
#pragma unroll
                for (int r = 0; r < 4; ++r) dst[(16 * mt + 4 * fq + r) * 128 + 16 * wave + fr] = acc[mt][r]; }
    }
}
__device__ __forceinline__ void phase_scan_seq(KP p, int l, bool dummy = false) {
    const bool odd = l & 1;
    f32x4* S4 = (f32x4*)(p->ws + WS_S); float* GAM = (float*)(p->ws + WS_GAM); f32x4* GAM4 = (f32x4*)(p->ws + WS_GAM); float* SC = (float*)(p->ws + WS_SC);
    const int nthreads = gridDim.x * NTHR;
    for (int gid = blockIdx.x * NTHR + otid(); gid < 64 * 2048; gid += nthreads) {
        const int chain = gid >> 11, e4 = gid & 2047, dir = chain & 1, dkk = e4 >> 5; const int base = chain * NCHUNK;
        f32x4 st = (f32x4){0.f, 0.f, 0.f, 0.f}, nst = (f32x4){0.f, 0.f, 0.f, 0.f}; float m = 0.f; const bool hasn = odd && e4 < 16;
        for (int s0 = 0; s0 < NCHUNK; s0 += 4) {
            f32x4 d[4], dn[4]; float g0[4], g1[4]; int idx[4];
#pragma unroll
            for (int u = 0; u < 4; ++u) { const int step = s0 + u; const int cp = dir == 0 ? step : (step < 4 ? 3 - step : 71 - step); idx[u] = base + cp;
                d[u] = S4[(size_t)idx[u] * 2048 + e4];
                if (!odd) { g0[u] = GAM[(size_t)idx[u] * 64 + dkk]; g1[u] = 0.f; } else { g0[u] = SC[(size_t)idx[u] * 4 + 0]; g1[u] = SC[(size_t)idx[u] * 4 + 1]; if (hasn) dn[u] = GAM4[(size_t)idx[u] * 16 + e4]; } }
#pragma unroll
            for (int u = 0; u < 4; ++u) {
                S4[(size_t)idx[u] * 2048 + e4] = dummy ? d[u] : st;
                if (!odd) { st = st * g0[u] + d[u]; }
                else { if (hasn) GAM4[(size_t)idx[u] * 16 + e4] = dummy ? dn[u] : nst; if (e4 == 0 && !dummy) SC[(size_t)idx[u] * 4 + 2] = m;
                    const float mn = fmaxf(g0[u] + m, g1[u]); const float dec = __expf(g0[u] + m - mn), sc = __expf(g1[u] - mn);
                    st = st * dec + d[u] * sc; if (hasn) nst = nst * dec + dn[u] * sc; m = mn; }
            }
        }
    }
}
constexpr int SO_QF = 0, SO_KF = 9216, SO_QB = 18432, SO_KB = 27648, SO_VS = 36864, SO_AF = 54272, SO_AB = 63488, SO_SF = 72704, SO_SB = 90112, SO_SEG = 107520, SO_SSQ = 111616, SO_MISC = 113664;
constexpr int SO_OST = 0;
__device__ __forceinline__ void scan_out_tail(LAS unsigned char* lds, f32x4 (&o)[4], const bf16* __restrict__ P, int ldp, bf16* __restrict__ Z, int row0, int h, const float* __restrict__ ng) {
    const int tid = otid(), lane = tid & 63, wave = tid >> 6, fq = lane >> 4, fr = lane & 15;
    LAS float* ost = (LAS float*)(lds + SO_OST);
    u32x4 gv[2]; f32x4 g0[2], g1[2];
#pragma unroll
    for (int c2 = 0; c2 < 2; ++c2) { const int idx = tid + NTHR * c2, t = idx >> 4, ch = idx & 15;
        gv[c2] = *(const u32x4*)(P + (size_t)(row0 + t) * ldp + 1024 + h * 128 + 8 * ch); g0[c2] = *(const f32x4*)(ng + h * 128 + 8 * ch); g1[c2] = *(const f32x4*)(ng + h * 128 + 8 * ch + 4); }
    __syncthreads();
#pragma unroll
    for (int mt = 0; mt < 4; ++mt)
#pragma unroll
        for (int r = 0; r < 4; ++r) ost[(16 * mt + 4 * fq + r) * 132 + 16 * wave + fr] = o[mt][r];
    __syncthreads();
#pragma unroll
    for (int c2 = 0; c2 < 2; ++c2) { const int idx = tid + NTHR * c2, t = idx >> 4, ch = idx & 15;
        f32x4 o0 = *(const LAS f32x4*)(ost + t * 132 + 8 * ch), o1 = *(const LAS f32x4*)(ost + t * 132 + 8 * ch + 4);
        const float q = red16_sum((o0[0] * o0[0] + o0[1] * o0[1]) + (o0[2] * o0[2] + o0[3] * o0[3]) + (o1[0] * o1[0] + o1[1] * o1[1]) + (o1[2] * o1[2] + o1[3] * o1[3]));
        const float rs = rsqrtf(q * (1.f / 128.f) + 1e-6f); o0 = o0 * rs * g0[c2]; o1 = o1 * rs * g1[c2];
        u32x4 w;
        w.x = pk2(o0[0] * siluf(bflo(gv[c2].x)), o0[1] * siluf(bfhi(gv[c2].x))); w.y = pk2(o0[2] * siluf(bflo(gv[c2].y)), o0[3] * siluf(bfhi(gv[c2].y)));
        w.z = pk2(o1[0] * siluf(bflo(gv[c2].z)), o1[1] * siluf(bfhi(gv[c2].z))); w.w = pk2(o1[2] * siluf(bflo(gv[c2].w)), o1[3] * siluf(bfhi(gv[c2].w)));
        *(u32x4*)(Z + (size_t)(row0 + t) * DM + h * 128 + 8 * ch) = w; }
}
__device__ __forceinline__ void stage_state(LAS bf16* dst, const float* __restrict__ src) {
    const int tid = otid();
#pragma unroll
    for (int c4 = 0; c4 < 4; ++c4) { const int idx = tid + NTHR * c4, r = idx >> 5, c = (idx & 31) * 4; const f32x4 v = *(const f32x4*)(src + r * 128 + c);
        u32x2 w; w.x = pk2(v[0], v[1]); w.y = pk2(v[2], v[3]); *(LAS u32x2*)(dst + r * 136 + c) = w; }
}
__device__ __forceinline__ void phase_scan_out_gla(KP p, LAS unsigned char* lds, int l, bool need_ctx) {
    const int tid = otid(), lane = tid & 63, wave = tid >> 6, fq = lane >> 4, fr = lane & 15; const int li = l >> 1;
    const bf16* P = (const bf16*)(p->ws + WS_P); const int ldp = NP_EVEN; const float* SM = (const float*)(p->ws + WS_SM); bf16* Z = (bf16*)(p->ws + WS_H);
    const float* S = (const float*)(p->ws + WS_S);
    LAS bf16* qf = (LAS bf16*)(lds + SO_QF); LAS bf16* kf = (LAS bf16*)(lds + SO_KF); LAS bf16* qb = (LAS bf16*)(lds + SO_QB); LAS bf16* kb = (LAS bf16*)(lds + SO_KB);
    LAS bf16* vs = (LAS bf16*)(lds + SO_VS); LAS bf16* Af = (LAS bf16*)(lds + SO_AF); LAS bf16* Ab = (LAS bf16*)(lds + SO_AB); LAS bf16* Sf = (LAS bf16*)(lds + SO_SF); LAS bf16* Sb = (LAS bf16*)(lds + SO_SB);
    LAS float* seg = (LAS float*)(lds + SO_SEG); LAS float* lrs = (LAS float*)(lds + SO_MISC);
    const int dk = tid & 63, sg = tid >> 6;
    for (int it = blockIdx.x; it < BATCH * 4 * NCHUNK; it += gridDim.x) {
        const int b = it / (4 * NCHUNK), h = (it / NCHUNK) & 3, cp = it % NCHUNK; if (cp < 4 && !need_ctx) continue;
        const int row0 = chunk_row0(b, cp); const int slf = ((b * 4 + h) * 2 + 0) * NCHUNK + cp, slb = slf + NCHUNK;
        __syncthreads();
#pragma unroll
        for (int c2 = 0; c2 < 2; ++c2) { const int idx = tid + NTHR * c2, t = idx >> 4, ch = idx & 15; *(LAS u32x4*)(vs + t * 136 + 8 * ch) = *(const u32x4*)(P + (size_t)(row0 + t) * ldp + 512 + h * 128 + 8 * ch); }
        stage_state(Sf, S + (size_t)slf * 8192); stage_state(Sb, S + (size_t)slb * 8192);
        float qv[8], kv[8];
#pragma unroll
        for (int tt = 0; tt < 8; ++tt) { const size_t ro = (size_t)(row0 + sg * 8 + tt) * ldp + h * 64 + dk; qv[tt] = bf2f(P[ro]); kv[tt] = bf2f(P[ro + 256]); }
        float gwf[16], gwb[16];
        const float* gw = p->gla_gate_w + (size_t)li * 2 * 16 * 256; const float* gb = p->gla_gate_b + (size_t)li * 2 * 256;
#pragma unroll
        for (int r = 0; r < 16; ++r) { gwf[r] = gw[r * 256 + h * 64 + dk]; gwb[r] = gw[(16 + r) * 256 + h * 64 + dk]; }
        const float gbf = gb[h * 64 + dk], gbb = gb[256 + h * 64 + dk];
        { const int t = tid >> 3, c4 = (tid & 7) * 4; *(LAS f32x4*)(lrs + t * 32 + c4) = *(const f32x4*)(SM + (size_t)(row0 + t) * 32 + c4); }
        __syncthreads();
        float pf[8], sb[8];
#pragma unroll
        for (int tt = 0; tt < 8; ++tt) { const LAS float* lr = lrs + (sg * 8 + tt) * 32; float zf = gbf, zb = gbb;
#pragma unroll
            for (int r = 0; r < 16; ++r) { zf += lr[r] * gwf[r]; zb += lr[16 + r] * gwb[r]; }
            pf[tt] = logsigf(zf) * 0.0625f; sb[tt] = logsigf(zb) * 0.0625f; }
#pragma unroll
        for (int tt = 1; tt < 8; ++tt) pf[tt] += pf[tt - 1];
#pragma unroll
        for (int tt = 6; tt >= 0; --tt) sb[tt] += sb[tt + 1];
        seg[(0 * 8 + sg) * 64 + dk] = pf[7]; seg[(1 * 8 + sg) * 64 + dk] = sb[0];
        __syncthreads();
        float offf = 0.f, offb = 0.f;
#pragma unroll
        for (int q = 0; q < 8; ++q) { const float a = seg[q * 64 + dk], c = seg[(8 + q) * 64 + dk]; if (q < sg) offf += a; if (q > sg) offb += c; }
#pragma unroll
        for (int tt = 0; tt < 8; ++tt) { const int t = sg * 8 + tt; const float bf_ = offf + pf[tt], bb_ = offb + sb[tt];
            qf[t * 72 + dk] = (bf16)f2bf(qv[tt] * __expf(bf_)); kf[t * 72 + dk] = (bf16)f2bf(kv[tt] * __expf(-bf_));
            qb[t * 72 + dk] = (bf16)f2bf(qv[tt] * __expf(bb_)); kb[t * 72 + dk] = (bf16)f2bf(kv[tt] * __expf(-bb_)); }
        __syncthreads();
        { const int mt = wave >> 1;
#pragma unroll
          for (int n2 = 0; n2 < 2; ++n2) { const int nt = 2 * (wave & 1) + n2; f32x4 af = (f32x4){0.f, 0.f, 0.f, 0.f}, ab = (f32x4){0.f, 0.f, 0.f, 0.f};
#pragma unroll
              for (int ks = 0; ks < 2; ++ks) { af = MFMA(frag_rm(qf, 72, 16 * mt, 32 * ks, lane), frag_rm(kf, 72, 16 * nt, 32 * ks, lane), af);
                                               ab = MFMA(frag_rm(qb, 72, 16 * mt, 32 * ks, lane), frag_rm(kb, 72, 16 * nt, 32 * ks, lane), ab); }
#pragma unroll
              for (int r = 0; r < 4; ++r) { const int t = 16 * mt + 4 * fq + r, s = 16 * nt + fr;
                  Af[t * 72 + s] = (bf16)f2bf(s <= t ? af[r] : 0.f); Ab[t * 72 + s] = (bf16)f2bf(s >= t ? ab[r] : 0.f); } } }
        __syncthreads();
        f32x4 o[4];
#pragma unroll
        for (int mt = 0; mt < 4; ++mt) o[mt] = (f32x4){0.f, 0.f, 0.f, 0.f};
#pragma unroll
        for (int ks = 0; ks < 2; ++ks) { const bf16x8 bv = frag_tr(vs, 136, 32 * ks, 16 * wave, lane), bsf = frag_tr(Sf, 136, 32 * ks, 16 * wave, lane), bsb = frag_tr(Sb, 136, 32 * ks, 16 * wave, lane);
#pragma unroll
            for (int mt = 0; mt < 4; ++mt) { o[mt] = MFMA(frag_rm(Af, 72, 16 * mt, 32 * ks, lane), bv, o[mt]); o[mt] = MFMA(frag_rm(Ab, 72, 16 * mt, 32 * ks, lane), bv, o[mt]);
                o[mt] = MFMA(frag_rm(qf, 72, 16 * mt, 32 * ks, lane), bsf, o[mt]); o[mt] = MFMA(frag_rm(qb, 72, 16 * mt, 32 * ks, lane), bsb, o[mt]); } }
        scan_out_tail(lds, o, P, ldp, Z, row0, h, p->gla_norm_g + (size_t)li * 512);
    }
}
constexpr int MO_QS = 0, MO_KS = 9216, MO_QWF = 18432, MO_QWB = 27648;
__device__ __forceinline__ void phase_scan_out_mlstm(KP p, LAS unsigned char* lds, int l, bool need_ctx) {
    const int tid = otid(), lane = tid & 63, wave = tid >> 6, fq = lane >> 4, fr = lane & 15; const int li = l >> 1;
    const bf16* P = (const bf16*)(p->ws + WS_P); const int ldp = NP_ODD; const float* SM = (const float*)(p->ws + WS_SM); bf16* Z = (bf16*)(p->ws + WS_H);
    const float* S = (const float*)(p->ws + WS_S); const float* GAM = (const float*)(p->ws + WS_GAM); const float* SC = (const float*)(p->ws + WS_SC);
    LAS bf16* qs = (LAS bf16*)(lds + MO_QS); LAS bf16* ks_ = (LAS bf16*)(lds + MO_KS); LAS bf16* qwf = (LAS bf16*)(lds + MO_QWF); LAS bf16* qwb = (LAS bf16*)(lds + MO_QWB);
    LAS bf16* vs = (LAS bf16*)(lds + SO_VS); LAS bf16* Af = (LAS bf16*)(lds + SO_AF); LAS bf16* Ab = (LAS bf16*)(lds + SO_AB); LAS bf16* Cf = (LAS bf16*)(lds + SO_SF); LAS bf16* Cb = (LAS bf16*)(lds + SO_SB);
    LAS float* part = (LAS float*)(lds + SO_SEG);
    LAS float* misc = (LAS float*)(lds + SO_MISC);
    const float* mb = p->ml_gate_b + li * 16;
    for (int it = blockIdx.x; it < BATCH * 4 * NCHUNK; it += gridDim.x) {
        const int b = it / (4 * NCHUNK), h = (it / NCHUNK) & 3, cp = it % NCHUNK; if (cp < 4 && !need_ctx) continue;
        const int row0 = chunk_row0(b, cp); const int slf = ((b * 4 + h) * 2 + 0) * NCHUNK + cp, slb = slf + NCHUNK;
        __syncthreads();
#pragma unroll
        for (int c2 = 0; c2 < 2; ++c2) { const int idx = tid + NTHR * c2, t = idx >> 4, ch = idx & 15; *(LAS u32x4*)(vs + t * 136 + 8 * ch) = *(const u32x4*)(P + (size_t)(row0 + t) * ldp + 512 + h * 128 + 8 * ch); }
        stage_state(Cf, S + (size_t)slf * 8192); stage_state(Cb, S + (size_t)slb * 8192);
        { const int t = tid >> 3, ch = tid & 7; const size_t ro = (size_t)(row0 + t) * ldp + h * 64 + 8 * ch;
          *(LAS u32x4*)(qs + t * 72 + 8 * ch) = *(const u32x4*)(P + ro); *(LAS u32x4*)(ks_ + t * 72 + 8 * ch) = *(const u32x4*)(P + ro + 256); }
        if (tid < 128) { const int d = tid >> 6, t = tid & 63; const float* gp = SM + (size_t)(row0 + t) * 32 + d * 8;
            misc[d * 512 + t] = gp[h] + mb[d * 8 + h]; misc[d * 512 + 64 + t] = logsigf(gp[4 + h] + mb[d * 8 + 4 + h]);
            misc[1024 + d * 64 + t] = GAM[(size_t)(d ? slb : slf) * 64 + t]; }
        __syncthreads();
        if (tid < 128) { const int d = tid >> 6, t = tid & 63; LAS float* md = misc + d * 512; const float run = wave_scan_sum(md[64 + t], t, d == 1); const float pm = wave_scan_max(md[t] - run, t, d == 1);
            const float mprev = SC[(size_t)(d ? slb : slf) * 4 + 2];
            const float mt_ = fmaxf(run + pm, run + mprev);
            md[128 + t] = run; md[192 + t] = mt_; md[256 + t] = __expf(run + mprev - mt_); }
        __syncthreads();
        { const int t = tid >> 3, ch = tid & 7; const u32x4 qv = *(const LAS u32x4*)(qs + t * 72 + 8 * ch); const float wf = misc[256 + t], wb = misc[512 + 256 + t];
          u32x4 a, c;
          a.x = pk2(bflo(qv.x) * wf, bfhi(qv.x) * wf); a.y = pk2(bflo(qv.y) * wf, bfhi(qv.y) * wf); a.z = pk2(bflo(qv.z) * wf, bfhi(qv.z) * wf); a.w = pk2(bflo(qv.w) * wf, bfhi(qv.w) * wf);
          c.x = pk2(bflo(qv.x) * wb, bfhi(qv.x) * wb); c.y = pk2(bflo(qv.y) * wb, bfhi(qv.y) * wb); c.z = pk2(bflo(qv.z) * wb, bfhi(qv.z) * wb); c.w = pk2(bflo(qv.w) * wb, bfhi(qv.w) * wb);
          *(LAS u32x4*)(qwf + t * 72 + 8 * ch) = a; *(LAS u32x4*)(qwb + t * 72 + 8 * ch) = c;
          const float q0 = bflo(qv.x), q1 = bfhi(qv.x), q2 = bflo(qv.y), q3 = bfhi(qv.y), q4 = bflo(qv.z), q5 = bfhi(qv.z), q6 = bflo(qv.w), q7 = bfhi(qv.w);
#pragma unroll
          for (int d = 0; d < 2; ++d) { const LAS float* nv = misc + 1024 + d * 64 + 8 * ch;
              part[(d * 8 + ch) * 64 + t] = q0 * nv[0] + q1 * nv[1] + q2 * nv[2] + q3 * nv[3] + q4 * nv[4] + q5 * nv[5] + q6 * nv[6] + q7 * nv[7]; } }
        { const int mt = wave >> 1; float rsf[4] = {0.f, 0.f, 0.f, 0.f}, rsb[4] = {0.f, 0.f, 0.f, 0.f};
#pragma unroll
          for (int n2 = 0; n2 < 2; ++n2) { const int nt = 2 * (wave & 1) + n2; f32x4 a = (f32x4){0.f, 0.f, 0.f, 0.f};
#pragma unroll
              for (int ks = 0; ks < 2; ++ks) a = MFMA(frag_rm(qs, 72, 16 * mt, 32 * ks, lane), frag_rm(ks_, 72, 16 * nt, 32 * ks, lane), a);
#pragma unroll
              for (int r = 0; r < 4; ++r) { const int t = 16 * mt + 4 * fq + r, s = 16 * nt + fr;
                  const float wf = s <= t ? __expf(misc[128 + t] - misc[128 + s] + misc[s] - misc[192 + t]) : 0.f;
                  const float wb = s >= t ? __expf(misc[512 + 128 + t] - misc[512 + 128 + s] + misc[512 + s] - misc[512 + 192 + t]) : 0.f;
                  const float vf = a[r] * wf, vb = a[r] * wb; rsf[r] += vf; rsb[r] += vb;
                  Af[t * 72 + s] = (bf16)f2bf(vf); Ab[t * 72 + s] = (bf16)f2bf(vb); } }
#pragma unroll
          for (int r = 0; r < 4; ++r) { const float a = red16_sum(rsf[r]), c = red16_sum(rsb[r]);
              if (fr == 0) { misc[1152 + (0 * 2 + (wave & 1)) * 64 + 16 * mt + 4 * fq + r] = a; misc[1152 + (1 * 2 + (wave & 1)) * 64 + 16 * mt + 4 * fq + r] = c; } } }
        __syncthreads();
        if (tid < 128) { const int d = tid >> 6, t = tid & 63; float qn = 0.f;
#pragma unroll
            for (int q = 0; q < 8; ++q) qn += part[(d * 8 + q) * 64 + t];
            const float den = misc[1152 + (d * 2 + 0) * 64 + t] + misc[1152 + (d * 2 + 1) * 64 + t] + misc[d * 512 + 256 + t] * qn;
            misc[d * 512 + 320 + t] = 1.f / fmaxf(fabsf(den), __expf(-misc[d * 512 + 192 + t])); }
        f32x4 of[4], ob[4];
#pragma unroll
        for (int mt = 0; mt < 4; ++mt) { of[mt] = (f32x4){0.f, 0.f, 0.f, 0.f}; ob[mt] = (f32x4){0.f, 0.f, 0.f, 0.f}; }
#pragma unroll
        for (int ks = 0; ks < 2; ++ks) { const bf16x8 bv = frag_tr(vs, 136, 32 * ks, 16 * wave, lane), bcf = frag_tr(Cf, 136, 32 * ks, 16 * wave, lane), bcb = frag_tr(Cb, 136, 32 * ks, 16 * wave, lane);
#pragma unroll
            for (int mt = 0; mt < 4; ++mt) { of[mt] = MFMA(frag_rm(Af, 72, 16 * mt, 32 * ks, lane), bv, of[mt]); of[mt] = MFMA(frag_rm(qwf, 72, 16 * mt, 32 * ks, lane), bcf, of[mt]);
                ob[mt] = MFMA(frag_rm(Ab, 72, 16 * mt, 32 * ks, lane), bv, ob[mt]); ob[mt] = MFMA(frag_rm(qwb, 72, 16 * mt, 32 * ks, lane), bcb, ob[mt]); } }
        __syncthreads();
        f32x4 o[4];
#pragma unroll
        for (int mt = 0; mt < 4; ++mt)
#pragma unroll
            for (int r = 0; r < 4; ++r) { const int t = 16 * mt + 4 * fq + r; o[mt][r] = of[mt][r] * misc[320 + t] + ob[mt][r] * misc[512 + 320 + t]; }
        scan_out_tail(lds, o, P, ldp, Z, row0, h, p->ml_norm_g + (size_t)li * 512);
    }
}
#define XB_TMO      128
#define XB_XCNT(j)  (256  + 64 * (j))
#define XB_XSUB(j)  (1280 + 64 * (j))
#define XB_XGEN(j)  (2304 + 64 * (j))
#define XB_TOP      3328
#define XB_TOPGEN   3392
#define XCD_BAR_WORDS 3456
#define XB_SPIN_CAP (1u << 18)

__device__ __forceinline__ unsigned xb_ld(unsigned* p)              { return __hip_atomic_load(p, __ATOMIC_RELAXED, __HIP_MEMORY_SCOPE_AGENT); }
__device__ __forceinline__ unsigned xb_add(unsigned* p, unsigned v) { return __hip_atomic_fetch_add(p, v, __ATOMIC_RELAXED, __HIP_MEMORY_SCOPE_AGENT); }
__device__ __forceinline__ unsigned xb_xcc_id() { return (unsigned)__builtin_amdgcn_s_getreg((3 << 11) | 20) & 0xFu; }
#define XB_SPIN(cond, bar) do { unsigned _sp = 0; while (cond) { __builtin_amdgcn_s_sleep(1); \
    if ((++_sp & 255u) == 0u) { if (xb_ld(&(bar)[XB_TMO])) break; if (_sp > XB_SPIN_CAP) { atomicAdd(&(bar)[XB_TMO], 1u); break; } } } } while (0)

struct XcdBarrier {
    unsigned* bar; unsigned x;
    volatile LAS unsigned* st;
};

__device__ __forceinline__ XcdBarrier xcd_barrier_post(unsigned* bar, volatile LAS unsigned* st) {
    XcdBarrier b; b.bar = bar; b.x = xb_xcc_id(); b.st = st;
    if (otid() == 0) (void)xb_add(&bar[XB_XCNT(b.x)], 1u);
    return b;
}
__device__ __forceinline__ void xcd_barrier_complete(unsigned* bar, unsigned x, unsigned& nloc, unsigned& nx) {
    const unsigned G = gridDim.x * gridDim.y * gridDim.z;
    unsigned sum, cnt, mine, sp = 0u;
    for (;;) {
        sum = 0u; cnt = 0u; mine = 0u;
#pragma unroll
        for (unsigned j = 0; j < 16; ++j) { const unsigned c = xb_ld(&bar[XB_XCNT(j)]); sum += c; cnt += (c > 0u) ? 1u : 0u; mine = (j == x) ? c : mine; }
        if (sum == G) break;
        __builtin_amdgcn_s_sleep(1);
        if ((++sp & 255u) == 0u) { if (xb_ld(&bar[XB_TMO])) break; if (sp > XB_SPIN_CAP) { atomicAdd(&bar[XB_TMO], 1u); break; } }
    }
    nloc = mine > 0u ? mine : 1u; nx = cnt > 0u ? cnt : 1u;
}

__device__ __forceinline__ void xcd_barrier(const XcdBarrier& b) {
    asm volatile("s_waitcnt vmcnt(0)" ::: "memory");
    __syncthreads();
    if (otid() == 0) {
        unsigned* bar = b.bar;
        __builtin_amdgcn_s_waitcnt(0);
        unsigned nloc = b.st[0], nx = b.st[1];
        if (nloc == 0u) { xcd_barrier_complete(bar, b.x, nloc, nx); b.st[0] = nloc; b.st[1] = nx; }
        const unsigned old = xb_add(&bar[XB_XSUB(b.x)], 1u);
        const unsigned gen = old / nloc;
        if (old + 1u == (gen + 1u) * nloc) {
            __builtin_amdgcn_fence(__ATOMIC_RELEASE, "agent");
            asm volatile("s_waitcnt vmcnt(0)" ::: "memory");
            const unsigned og = xb_add(&bar[XB_TOP], 1u);
            const unsigned tg = og / nx;
            if (og + 1u == (tg + 1u) * nx) xb_add(&bar[XB_TOPGEN], 1u);
            else XB_SPIN(xb_ld(&bar[XB_TOPGEN]) == tg, bar);
            __builtin_amdgcn_fence(__ATOMIC_ACQUIRE, "agent");
            xb_add(&bar[XB_XGEN(b.x)], 1u);
            asm volatile("s_waitcnt vmcnt(0)" ::: "memory");
        } else {
            XB_SPIN(xb_ld(&bar[XB_XGEN(b.x)]) == gen, bar);
            __builtin_amdgcn_fence(__ATOMIC_ACQUIRE, "agent");
            asm volatile("s_waitcnt vmcnt(0)" ::: "memory");
        }
    }
    __syncthreads();
}

#define REP_GEMM 1
#define REP_ATT 1
#define REP_LOC 1
#define REP_OUT 1
#define REP_PRO 1
#define REP_SEQ 1
#define REP_LN 1
#ifndef MK_N_LAUNCHES
#define MK_N_LAUNCHES 1
#endif
constexpr int N_PHASES = 2 + 6 * DEPTH;
__global__ void __launch_bounds__(NTHR, 2) fwd_megakernel(Params p_unused) {
    extern __shared__ __attribute__((aligned(16))) unsigned char lds_raw[];
    LAS unsigned char* lds = (LAS unsigned char*)lds_raw;
    cg::grid_group grid = cg::this_grid();
    const int lo = (int)kparams()->ph_lo, hi = (int)kparams()->ph_hi;
#define IN(k) (lo <= (k) && (k) < hi)
    volatile LAS unsigned* bst = (volatile LAS unsigned*)(lds + LDS_BYTES - 64);
    if (otid() < 16) bst[otid()] = 0u;
    __syncthreads();
    XcdBarrier bar = xcd_barrier_post((unsigned*)(kparams()->ws + WS_BAR), bst);
#define SEAM(k) do { if (IN(k) && IN((k) + 1)) { if ((k) == 0) grid.sync(); else xcd_barrier(bar); } } while (0)
    if (IN(0)) { for (int rep = 0; rep < REP_PRO; ++rep) { phase_prologue(kparams(), lds); __syncthreads(); } } SEAM(0);
    if (IN(1)) { for (int rep = 0; rep < REP_PRO; ++rep) phase_h0(kparams()); } SEAM(1);
#pragma unroll 1
    for (int l = 0; l < DEPTH; ++l) {
        const int pb = 2 + 6 * l; const bool odd = l & 1; const int li = l >> 1; const bool need_ctx = l < DEPTH - 1;
        if (IN(pb + 0)) {
            const int npad = odd ? NPAD_ODD : NPAD_EVEN; unsigned char* ws = kparams()->ws;
            pg8::Gemm g{(const pg8::bf16_t*)(ws + WS_H), (const pg8::bf16_t*)(ws + (odd ? WS_WIO : WS_WIE)) + (size_t)li * npad * 1024, MTOT, npad, 1024};
            pg8::StaticOrder S; S.init(MTOT, npad, (int)gridDim.x, (int)blockIdx.x);
            pg8::EpiProj E{(pg8::bf16_t*)(ws + WS_P), odd ? NP_ODD : NP_EVEN, (float*)(ws + WS_SM), odd ? 16 : 32, npad / 256 - 1, odd ? 1 : 0, (const float*)(ws + WS_ROPE), (const float*)(ws + WS_ROPE) + 1024};
            for (int rep = 0; rep < REP_GEMM; ++rep) pg8::gemm_phase<pg8::EpiProj, pg8::StaticOrder, true, true>(lds, g, S, E);
        }
        SEAM(pb + 0);
        if (IN(pb + 1)) { for (int rep = 0; rep < REP_ATT; ++rep) phase_attn(kparams(), lds, l, need_ctx); for (int rep = 0; rep < REP_LOC; ++rep) phase_scan_local(kparams(), lds, l); }
        SEAM(pb + 1);
        if (IN(pb + 2)) { for (int rep = 1; rep < REP_SEQ; ++rep) { phase_scan_seq(kparams(), l, true); __syncthreads(); } phase_scan_seq(kparams(), l); }
        SEAM(pb + 2);
        if (IN(pb + 3)) { for (int rep = 0; rep < REP_OUT; ++rep) { if (odd) phase_scan_out_mlstm(kparams(), lds, l, need_ctx); else phase_scan_out_gla(kparams(), lds, l, need_ctx); } }
        SEAM(pb + 3);
        if (IN(pb + 4)) {
            const int mrows = need_ctx ? MTOT : MLAT; unsigned char* ws = kparams()->ws;
            pg8::Gemm g{(const pg8::bf16_t*)(ws + WS_H), (const pg8::bf16_t*)(ws + WS_WO) + (size_t)l * 1024 * 1024, mrows, 1024, 1024};
            pg8::StaticOrder S; S.init(mrows, 1024, (int)gridDim.x, (int)blockIdx.x);
            pg8::EpiProj E{(pg8::bf16_t*)(ws + WS_P), 1024, nullptr, 0, -1, 0, nullptr, nullptr};
            for (int rep = 0; rep < REP_GEMM; ++rep) pg8::gemm_phase<pg8::EpiProj, pg8::StaticOrder, true, true>(lds, g, S, E);
        }
        SEAM(pb + 4);
        if (IN(pb + 5)) { for (int rep = 1; rep < REP_LN; ++rep) { phase_ln(kparams(), l, true); } phase_ln(kparams(), l); }
        SEAM(pb + 5);
    }
}
extern "C" void kernel_launch(void* const* d_in, const int* in_sizes, int n_in, void* d_out, int out_size, void* d_ws, size_t ws_size, hipStream_t stream) {
    static int grid = 0;
    if (grid == 0) {
        if (n_in != 19 || ws_size < WS_END) { fprintf(stderr, "kernel_launch: need 19 inputs and %zu bytes of workspace; got %d, %zu\n", (size_t)WS_END, n_in, ws_size); grid = -1; return; }
        int dev = 0, cus = 0, per_cu = 0;
        if (hipGetDevice(&dev) != hipSuccess || hipDeviceGetAttribute(&cus, hipDeviceAttributeMultiprocessorCount, dev) != hipSuccess) { grid = -1; return; }
        if (hipFuncSetAttribute((const void*)fwd_megakernel, hipFuncAttributeMaxDynamicSharedMemorySize, LDS_BYTES) != hipSuccess) { fprintf(stderr, "kernel_launch: hipFuncSetAttribute failed\n"); grid = -1; return; }
        if (hipOccupancyMaxActiveBlocksPerMultiprocessor(&per_cu, (const void*)fwd_megakernel, NTHR, LDS_BYTES) != hipSuccess || per_cu < 1) per_cu = 1;
        grid = cus * per_cu;
    }
    if (grid < 0) return;
    Params p{};
    p.x = (const float*)d_in[0]; p.c = (const float*)d_in[1]; p.ctx = (const float*)d_in[2]; p.c_ctx = (const float*)d_in[3]; p.w_ada = (const float*)d_in[4]; p.b_ada = (const float*)d_in[5];
    p.ln_g = (const float*)d_in[6]; p.ln_b = (const float*)d_in[7]; p.w_in_even = (const float*)d_in[8]; p.w_out_even = (const float*)d_in[9]; p.gla_gate_w = (const float*)d_in[10]; p.gla_gate_b = (const float*)d_in[11];
    p.gla_norm_g = (const float*)d_in[12]; p.na_rpb = (const float*)d_in[13]; p.w_in_odd = (const float*)d_in[14]; p.w_out_odd = (const float*)d_in[15]; p.ml_gate_b = (const float*)d_in[16]; p.ml_norm_g = (const float*)d_in[17];
    p.sw_sink = (const float*)d_in[18]; p.out = (float*)d_out; p.ws = (unsigned char*)d_ws;
    if (hipMemsetAsync((char*)d_ws + WS_BAR, 0, XCD_BAR_WORDS * 4, stream) != hipSuccess) { fprintf(stderr, "kernel_launch: memset failed\n"); return; }
#if MK_N_LAUNCHES == 1
    p.ph_lo = 0; p.ph_hi = N_PHASES;
    void* args[] = {&p};
    hipError_t e = hipLaunchCooperativeKernel((const void*)fwd_megakernel, dim3(grid), dim3(NTHR), args, LDS_BYTES, stream);
    if (e != hipSuccess) fprintf(stderr, "kernel_launch: cooperative launch failed: %s (grid %d)\n", hipGetErrorString(e), grid);
#else
    for (int k = 0; k < N_PHASES; ++k) { p.ph_lo = k; p.ph_hi = k + 1; hipLaunchKernelGGL(fwd_megakernel, dim3(grid), dim3(NTHR), LDS_BYTES, stream, p); }
#endif
}
```

```cpp
#include <hip/hip_runtime.h>
#include <hip/hip_cooperative_groups.h>
#include <cstdio>
#include <cstdint>
namespace cg = cooperative_groups;
__device__ __forceinline__ int otid() { int t = threadIdx.x; asm volatile("" : "+v"(t)); return t; }
namespace pg8 {
#define PG8_LAS __attribute__((address_space(3)))
typedef unsigned short bf16_t;
typedef short bf16x8 __attribute__((ext_vector_type(8)));
typedef float f32x4 __attribute__((ext_vector_type(4)));
typedef unsigned u32x4 __attribute__((ext_vector_type(4)));
constexpr int BM = 256, BK = 64, HALF = 128, HTB = HALF * BK * 2  , STAGE_BYTES = 8 * HTB, NXCD = 8, WGM = 8;

__host__ __device__ __forceinline__ int lds_byte(int r, int c) { const int st = (r >> 4) * 2 + (c >> 5), rr = r & 15, cc = c & 31, ob = rr * 64 + cc * 2; return st * 1024 + (ob ^ (((ob >> 9) & 1) << 5)); }
__host__ __device__ __forceinline__ void stage_rc(int b, int& R, int& C) { const int st = b / 1024, sb = b % 1024, swz = sb ^ (((sb >> 9) & 1) << 5); R = (st >> 1) * 16 + swz / 64; C = (st & 1) * 32 + (swz % 64) / 2; }
__host__ __device__ __forceinline__ int perm32(int rho) { const int n = rho >> 4, i = rho & 15; return 8 * (i >> 2) + 4 * n + (i & 3); }

struct Unit { int pm, pn; };
struct Gemm { const bf16_t* A; const bf16_t* Bt; int M, N, K; };

struct StaticOrder {
    int nM, nN, nwg, G, c;
    __host__ __device__ void init(int M, int N, int G_, int c_) { nM = M / BM; nN = N / BM; nwg = nM * nN; G = G_; c = c_; }
    __host__ __device__ bool next(int i, Unit& u) const {
        const long L = (long)i * G + c; if (L >= nwg) return false;
        int wgid = (int)L; { const int q = nwg / NXCD, r = nwg % NXCD, xcd = wgid % NXCD, off = wgid / NXCD; wgid = (xcd < r ? xcd * (q + 1) : r * (q + 1) + (xcd - r) * q) + off; }
        const int nig = WGM * nN, gid = wgid / nig, fm = gid * WGM, gsz = (nM - fm) < WGM ? (nM - fm) : WGM;
        u.pm = fm + ((wgid % nig) % gsz); u.pn = (wgid % nig) / gsz; return true;
    }
    __device__ __forceinline__ void a_ready(const Unit&) const {}
    __device__ __forceinline__ void done(const Unit&) const {}
};

__device__ __forceinline__ unsigned cvt_pk_bf16(float lo, float hi) { unsigned r; asm volatile("v_cvt_pk_bf16_f32 %0, %1, %2" : "=v"(r) : "v"(lo), "v"(hi)); return r; }
struct EpiProj {
    static constexpr bool PERM = true, AFTER_DRAIN = false;
    bf16_t* P; int ldp; float* SM; int nsm; int last_pn; int rope; const float* cosT; const float* sinT;
    __device__ __forceinline__ void operator()(const f32x4 (&acc)[2][2][4][2], const Unit& u, int wr, int wc, int fr, int fq) const {
        const int row0 = u.pm * BM + wr * 64 + fr;
        if (u.pn == last_pn) {
            if (wc == 0) {
#pragma unroll
                for (int ai = 0; ai < 2; ++ai)
#pragma unroll
                    for (int m = 0; m < 4; ++m) { const int row = row0 + ai * HALF + m * 16;
#pragma unroll
                        for (int n = 0; n < 2; ++n) { const int col = 8 * fq + 4 * n; if (col < nsm) *(f32x4*)(SM + (size_t)row * 32 + col) = acc[ai][0][m][n]; } }
            }
            return;
        }
        const bool do_rope_tile = rope && (u.pn == 6 || u.pn == 7 || u.pn == 8) && (u.pm * BM < 32768);
#pragma unroll
        for (int ai = 0; ai < 2; ++ai)
#pragma unroll
            for (int m = 0; m < 4; ++m) { const int row = row0 + ai * HALF + m * 16; bf16_t* rowp = P + (size_t)row * ldp + u.pn * BM + wc * 32 + 8 * fq;
#pragma unroll
                for (int bj = 0; bj < 2; ++bj) { f32x4 v0 = acc[ai][bj][m][0], v1 = acc[ai][bj][m][1];
                    if (do_rope_tile && (u.pn != 8 || bj == 0)) {
                        const int t = row & 4095; const int pos = (wc & 1) ? (t & 63) : (t >> 6); const int i0 = pos * 16 + 8 * (fq & 1);
                        const f32x4 c0 = *(const f32x4*)(cosT + i0), c1 = *(const f32x4*)(cosT + i0 + 4), s0 = *(const f32x4*)(sinT + i0), s1 = *(const f32x4*)(sinT + i0 + 4);
                        f32x4 p0, p1;
#pragma unroll
                        for (int e = 0; e < 4; ++e) { p0[e] = __shfl_xor(v0[e], 32); p1[e] = __shfl_xor(v1[e], 32); }
                        if (fq < 2) { v0 = v0 * c0 - p0 * s0; v1 = v1 * c1 - p1 * s1; } else { v0 = p0 * s0 + v0 * c0; v1 = p1 * s1 + v1 * c1; }
                    }
                    u32x4 w; w.x = cvt_pk_bf16(v0[0], v0[1]); w.y = cvt_pk_bf16(v0[2], v0[3]); w.z = cvt_pk_bf16(v1[0], v1[1]); w.w = cvt_pk_bf16(v1[2], v1[3]);
                    *(u32x4*)(rowp + bj * HALF) = w; } }
    }
};
template <class Epi, class Sched, bool ALIGN_EPI = false, bool SP2 = false>
__device__ __forceinline__ void gemm_phase(PG8_LAS unsigned char* lds, const Gemm g, const Sched& S, const Epi& E) {
    const int tid = otid(), wid = __builtin_amdgcn_readfirstlane(tid >> 6), lane = tid & 63, wr = wid >> 2, wc = wid & 3, fr = lane & 15, fq = lane >> 4;
    const int K = g.K, nt = K / BK;
    unsigned voffA[2], voffB[2];
#pragma unroll
    for (int i = 0; i < 2; ++i) { int R, C; stage_rc(tid * 16 + i * 8192, R, C); const int Rb = Epi::PERM ? ((R & ~31) + perm32(R & 31)) : R;
        voffA[i] = (unsigned)(R * K + C) * 2u; voffB[i] = (unsigned)(Rb * K + C) * 2u; }
    const size_t kstep = (size_t)(BK * 2);
    const size_t hstep = (size_t)HALF * K * 2;
    const size_t tstep = 2 * hstep;
    const unsigned ldsw = (unsigned)wid * 1024u;
    const int aoff = lds_byte(wr * 64 + fr, fq * 8), boff = lds_byte(wc * 32 + fr, fq * 8);
#define PG8_SA(b, h) (((b) * 2 + (h)) * HTB)
#define PG8_SB(b, h) ((4 + (b) * 2 + (h)) * HTB)
#define PG8_STAGE(bufoff, gbase, voff) do { _Pragma("unroll") for (int _i = 0; _i < 2; ++_i) \
        __builtin_amdgcn_global_load_lds((const unsigned*)((const char*)(gbase) + (voff)[_i]), (PG8_LAS unsigned*)(lds + (bufoff) + ldsw + _i * 8192), 16, 0, 0); } while (0)
#define PG8_LDA(dst, b, h) do { _Pragma("unroll") for (int m = 0; m < 4; ++m) _Pragma("unroll") for (int k = 0; k < 2; ++k) dst[m][k] = *(const PG8_LAS bf16x8*)(lds + PG8_SA(b, h) + aoff + m * 2048 + k * 1024); } while (0)
#define PG8_LDB(dst, b, h) do { _Pragma("unroll") for (int n = 0; n < 2; ++n) _Pragma("unroll") for (int k = 0; k < 2; ++k) dst[n][k] = *(const PG8_LAS bf16x8*)(lds + PG8_SB(b, h) + boff + n * 2048 + k * 1024); } while (0)
#define PG8_MMA(ai, bj, At, Bt) do { __builtin_amdgcn_s_setprio(1); _Pragma("unroll") for (int m = 0; m < 4; ++m) _Pragma("unroll") for (int n = 0; n < 2; ++n) _Pragma("unroll") for (int k = 0; k < 2; ++k) \
        acc[ai][bj][m][n] = __builtin_amdgcn_mfma_f32_16x16x32_bf16(Bt[n][k], At[m][k], acc[ai][bj][m][n], 0, 0, 0); __builtin_amdgcn_s_setprio(0); } while (0)
#define PG8_WAIT_V(n) asm volatile("s_waitcnt vmcnt(" #n ")" ::: "memory")
#define PG8_WAIT_L(n) asm volatile("s_waitcnt lgkmcnt(" #n ")" ::: "memory")
#define PG8_BAR __builtin_amdgcn_s_barrier()
#define PG8_SCHED __builtin_amdgcn_sched_barrier(0)
    Unit cur, nxt; int ui = 0;
    if (!S.next(0, cur)) return;
    f32x4 acc[2][2][4][2];
#pragma unroll
    for (int a = 0; a < 2; ++a)
#pragma unroll
        for (int b = 0; b < 2; ++b)
#pragma unroll
            for (int m = 0; m < 4; ++m)
#pragma unroll
                for (int n = 0; n < 2; ++n) acc[a][b][m][n] = (f32x4){0.f, 0.f, 0.f, 0.f};
    bf16x8 At[4][2], B0[2][2], B1[2][2];
    const char* cA = (const char*)g.A + (size_t)cur.pm * tstep; const char* cB = (const char*)g.Bt + (size_t)cur.pn * tstep;
    S.a_ready(cur);
    if constexpr (SP2) {
        PG8_STAGE(PG8_SB(0, 0), cB, voffB); PG8_STAGE(PG8_SB(0, 1), cB + hstep, voffB); PG8_STAGE(PG8_SA(0, 0), cA, voffA); PG8_STAGE(PG8_SA(0, 1), cA + hstep, voffA);
        if (wr == 1) PG8_BAR;
        PG8_WAIT_V(2); PG8_BAR;
        PG8_STAGE(PG8_SB(1, 0), cB + kstep, voffB); PG8_STAGE(PG8_SA(1, 0), cA + kstep, voffA); PG8_STAGE(PG8_SB(1, 1), cB + hstep + kstep, voffB);
        PG8_WAIT_V(6); PG8_BAR;
    } else {
        PG8_STAGE(PG8_SB(0, 0), cB, voffB); PG8_STAGE(PG8_SA(0, 0), cA, voffA); PG8_STAGE(PG8_SB(0, 1), cB + hstep, voffB); PG8_STAGE(PG8_SA(0, 1), cA + hstep, voffA);
        if (wr == 1) PG8_BAR;
        PG8_WAIT_V(4); PG8_BAR;
        PG8_STAGE(PG8_SB(1, 0), cB + kstep, voffB); PG8_STAGE(PG8_SA(1, 0), cA + kstep, voffA); PG8_STAGE(PG8_SB(1, 1), cB + hstep + kstep, voffB);
        PG8_WAIT_V(6); PG8_BAR;
    }
    for (;;) {
        const bool has_next = S.next(ui + 1, nxt);
        const char* nA = has_next ? (const char*)g.A + (size_t)nxt.pm * tstep : cA; const char* nB = has_next ? (const char*)g.Bt + (size_t)nxt.pn * tstep : cB;
        for (int t = 0; t < nt; t += 2) {
            const bool last = (t == nt - 2);
            const char* a1 = cA + (size_t)(t + 1) * kstep;
            const char* a2 = last ? nA : cA + (size_t)(t + 2) * kstep; const char* b2 = last ? nB : cB + (size_t)(t + 2) * kstep;
            const char* a3 = a2 + kstep; const char* b3 = b2 + kstep;
            if (last && has_next) S.a_ready(nxt);
            if constexpr (SP2) {
            PG8_LDB(B0, 0, 0); PG8_LDB(B1, 0, 1); PG8_SCHED; PG8_LDA(At, 0, 0); PG8_STAGE(PG8_SA(1, 1), a1 + hstep, voffA);
            PG8_WAIT_V(8); PG8_WAIT_L(0); PG8_BAR; PG8_MMA(0, 0, At, B0); PG8_MMA(0, 1, At, B1); PG8_BAR; PG8_SCHED;
            PG8_LDA(At, 0, 1); PG8_STAGE(PG8_SB(0, 0), b2, voffB); PG8_STAGE(PG8_SB(0, 1), b2 + hstep, voffB); PG8_STAGE(PG8_SA(0, 0), a2, voffA);
            PG8_WAIT_V(8); PG8_WAIT_L(0); PG8_BAR; PG8_MMA(1, 0, At, B0); PG8_MMA(1, 1, At, B1); PG8_BAR; PG8_SCHED;
            PG8_LDB(B0, 1, 0); PG8_LDB(B1, 1, 1); PG8_SCHED; PG8_LDA(At, 1, 0); PG8_STAGE(PG8_SA(0, 1), a2 + hstep, voffA);
            PG8_WAIT_V(8); PG8_WAIT_L(0); PG8_BAR; PG8_MMA(0, 0, At, B0); PG8_MMA(0, 1, At, B1); PG8_BAR; PG8_SCHED;
            PG8_LDA(At, 1, 1); PG8_STAGE(PG8_SB(1, 0), b3, voffB); PG8_STAGE(PG8_SB(1, 1), b3 + hstep, voffB); PG8_STAGE(PG8_SA(1, 0), a3, voffA);
            PG8_WAIT_V(8); PG8_WAIT_L(0); PG8_BAR; PG8_MMA(1, 0, At, B0); PG8_MMA(1, 1, At, B1); PG8_BAR; PG8_SCHED;
            } else {
            PG8_LDB(B0, 0, 0); PG8_SCHED; PG8_LDA(At, 0, 0); PG8_STAGE(PG8_SA(1, 1), a1 + hstep, voffA);
            PG8_WAIT_L(8); PG8_BAR; PG8_WAIT_L(0); PG8_MMA(0, 0, At, B0); PG8_BAR; PG8_SCHED;
            PG8_LDB(B1, 0, 1); PG8_STAGE(PG8_SB(0, 0), b2, voffB);
            PG8_BAR; PG8_WAIT_L(0); PG8_MMA(0, 1, At, B1); PG8_BAR;
            PG8_LDA(At, 0, 1); PG8_STAGE(PG8_SA(0, 0), a2, voffA);
            PG8_BAR; PG8_WAIT_L(0); PG8_MMA(1, 0, At, B0); PG8_BAR; PG8_SCHED;
            PG8_STAGE(PG8_SB(0, 1), b2 + hstep, voffB);
            PG8_WAIT_V(6); PG8_BAR; PG8_MMA(1, 1, At, B1); PG8_BAR;
            PG8_LDB(B0, 1, 0); PG8_SCHED; PG8_LDA(At, 1, 0); PG8_STAGE(PG8_SA(0, 1), a2 + hstep, voffA);
            PG8_WAIT_L(8); PG8_BAR; PG8_WAIT_L(0); PG8_MMA(0, 0, At, B0); PG8_BAR; PG8_SCHED;
            PG8_LDB(B1, 1, 1); PG8_STAGE(PG8_SB(1, 0), b3, voffB);
            PG8_BAR; PG8_WAIT_L(0); PG8_MMA(0, 1, At, B1); PG8_BAR;
            PG8_LDA(At, 1, 1); PG8_STAGE(PG8_SA(1, 0), a3, voffA);
            PG8_BAR; PG8_WAIT_L(0); PG8_MMA(1, 0, At, B0); PG8_BAR; PG8_SCHED;
            PG8_STAGE(PG8_SB(1, 1), b3 + hstep, voffB);
            PG8_WAIT_V(6); PG8_BAR; PG8_MMA(1, 1, At, B1); PG8_BAR;
            }
        }
        if constexpr (ALIGN_EPI) { if (wr == 0) PG8_BAR; }
        if constexpr (!Epi::AFTER_DRAIN) { E(acc, cur, wr, wc, fr, fq); S.done(cur); }
        if (!has_next) break;
#pragma unroll
        for (int a = 0; a < 2; ++a)
#pragma unroll
            for (int b = 0; b < 2; ++b)
#pragma unroll
                for (int m = 0; m < 4; ++m)
#pragma unroll
                    for (int n = 0; n < 2; ++n) acc[a][b][m][n] = (f32x4){0.f, 0.f, 0.f, 0.f};
        cur = nxt; cA = nA; cB = nB; ++ui;
        if constexpr (ALIGN_EPI) { if (wr == 1) PG8_BAR; }
    }
    PG8_WAIT_V(0);
    if constexpr (!ALIGN_EPI) { if (wr == 0) PG8_BAR; }
    PG8_BAR;
    if constexpr (Epi::AFTER_DRAIN) { E.fused(acc, cur, wr, wc, fr, fq, lds, wid, lane); S.done(cur); }
#undef PG8_SA
#undef PG8_SB
#undef PG8_STAGE
#undef PG8_LDA
#undef PG8_LDB
#undef PG8_MMA
#undef PG8_WAIT_V
#undef PG8_WAIT_L
#undef PG8_BAR
#undef PG8_SCHED
}
}
constexpr int NWAVES = 8, NTHR = 512;
constexpr int BATCH = 8, SEQ = 4096, DM = 1024, CTXL = 256, DEPTH = 4;
constexpr int MLAT = BATCH * SEQ, MCTX = BATCH * CTXL, MTOT = MLAT + MCTX;
constexpr int NP_EVEN = 3584, NPAD_EVEN = 3840, NORIG_EVEN = 3616;
constexpr int NP_ODD = 2816, NPAD_ODD = 3072, NORIG_ODD = 2832;
constexpr int NCHUNK = 68;
constexpr int NSLOT = BATCH * 4 * 2 * NCHUNK;
constexpr float ALPHA_DN = 1.681792830507429f;
constexpr size_t MiB = 1u << 20;
constexpr size_t WS_MOD = 0;
constexpr size_t WS_BAR = 512 * 1024;
constexpr size_t WS_ROPE = 1 * MiB;
constexpr size_t WS_SC = WS_ROPE + 65536;
constexpr size_t WS_GAM = 2 * MiB;
constexpr size_t WS_SM = 4 * MiB;
constexpr size_t WS_WIE = 9 * MiB;
constexpr size_t WS_WIO = 24 * MiB;
constexpr size_t WS_WO = 36 * MiB;
constexpr size_t WS_XC = 44 * MiB;
constexpr size_t WS_H = 52 * MiB;
constexpr size_t WS_P = 120 * MiB;
constexpr size_t WS_S = 359 * MiB;
constexpr size_t WS_END = WS_S + (size_t)NSLOT * 8192 * 4;
static_assert(WS_SC + (size_t)NSLOT * 16 <= WS_GAM && WS_GAM + (size_t)NSLOT * 256 <= WS_SM && WS_SM + (size_t)MTOT * 128 <= WS_WIE, "ws map 1");
static_assert(WS_WIE + (size_t)2 * NPAD_EVEN * 1024 * 2 <= WS_WIO && WS_WIO + (size_t)2 * NPAD_ODD * 1024 * 2 <= WS_WO && WS_WO + (size_t)4 * 1024 * 1024 * 2 <= WS_XC, "ws map 2");
static_assert(WS_XC + (size_t)MCTX * 1024 * 4 <= WS_H && WS_H + (size_t)MTOT * 1024 * 2 <= WS_P && WS_P + (size_t)MTOT * NP_EVEN * 2 <= WS_S && WS_END <= 512 * MiB, "ws map 3");
constexpr int LDS_BYTES = 147456;

#define LAS __attribute__((address_space(3)))
typedef unsigned short bf16;
typedef float f32x4 __attribute__((ext_vector_type(4)));
typedef short bf16x8 __attribute__((ext_vector_type(8)));
typedef short s16x4 __attribute__((ext_vector_type(4)));
typedef unsigned u32x4 __attribute__((ext_vector_type(4)));
typedef unsigned u32x2 __attribute__((ext_vector_type(2)));
#define LDS_WAIT() asm volatile("s_waitcnt lgkmcnt(0)" ::: "memory")

typedef __bf16 hbf2 __attribute__((ext_vector_type(2)));
typedef float f32x2_ __attribute__((ext_vector_type(2)));
__device__ __forceinline__ unsigned f2bf(float f) { const __bf16 b = (__bf16)f; return (unsigned)__builtin_bit_cast(unsigned short, b); }
__device__ __forceinline__ unsigned pk2(float lo, float hi) { const f32x2_ v = {lo, hi}; const hbf2 b = __builtin_convertvector(v, hbf2); return __builtin_bit_cast(unsigned, b); }
__device__ __forceinline__ float bf2f(unsigned short v) { return __builtin_bit_cast(float, (unsigned)v << 16); }
__device__ __forceinline__ float bflo(unsigned w) { return __builtin_bit_cast(float, w << 16); }
__device__ __forceinline__ float bfhi(unsigned w) { return __builtin_bit_cast(float, w & 0xffff0000u); }
__device__ __forceinline__ float siluf(float x) { return x * __builtin_amdgcn_rcpf(1.f + __expf(-x)); }
__device__ __forceinline__ float logsigf(float z) { return fminf(z, 0.f) - __logf(1.f + __expf(-fabsf(z))); }
template <int N> __device__ __forceinline__ float dpp_ror(float v) { return __builtin_bit_cast(float, __builtin_amdgcn_update_dpp(0, __builtin_bit_cast(int, v), 0x120 + N, 0xf, 0xf, false)); }
__device__ __forceinline__ float red16_max(float v) { v = fmaxf(v, dpp_ror<1>(v)); v = fmaxf(v, dpp_ror<2>(v)); v = fmaxf(v, dpp_ror<4>(v)); v = fmaxf(v, dpp_ror<8>(v)); return v; }
__device__ __forceinline__ float red16_sum(float v) { v += dpp_ror<1>(v); v += dpp_ror<2>(v); v += dpp_ror<4>(v); v += dpp_ror<8>(v); return v; }
__device__ __forceinline__ float wave_sum(float v) {
#pragma unroll
    for (int o = 1; o < 64; o <<= 1) v += __shfl_xor(v, o);
    return v;
}
__device__ __forceinline__ float wave_max(float v) {
#pragma unroll
    for (int o = 1; o < 64; o <<= 1) v = fmaxf(v, __shfl_xor(v, o));
    return v;
}
__device__ __forceinline__ float wave_scan_sum(float v, int lane, bool rev) {
#pragma unroll
    for (int o = 1; o < 64; o <<= 1) { const float t = rev ? __shfl_down(v, o) : __shfl_up(v, o); if (rev ? (lane + o < 64) : (lane >= o)) v += t; }
    return v;
}
__device__ __forceinline__ float wave_scan_max(float v, int lane, bool rev) {
#pragma unroll
    for (int o = 1; o < 64; o <<= 1) { const float t = rev ? __shfl_down(v, o) : __shfl_up(v, o); if (rev ? (lane + o < 64) : (lane >= o)) v = fmaxf(v, t); }
    return v;
}
#define MFMA(a, b, c) __builtin_amdgcn_mfma_f32_16x16x32_bf16((a), (b), (c), 0, 0, 0)
__device__ __forceinline__ bf16x8 frag_rm(const LAS bf16* X, int ld, int row0, int k0, int lane) {
    return *(const LAS bf16x8*)(X + (row0 + (lane & 15)) * ld + k0 + 8 * (lane >> 4));
}
__device__ __forceinline__ bf16x8 frag_tr(const LAS bf16* X, int ld, int k0, int n0, int lane) {
    const int g = lane >> 4, m = lane & 15, q = m >> 2, p = m & 3;
    const LAS bf16* a0 = X + (k0 + 8 * g + q) * ld + n0 + 4 * p;
    const s16x4 lo = __builtin_amdgcn_ds_read_tr16_b64_v4i16((LAS s16x4*)a0);
    const s16x4 hi = __builtin_amdgcn_ds_read_tr16_b64_v4i16((LAS s16x4*)(a0 + 4 * ld));
    bf16x8 r; r[0] = lo[0]; r[1] = lo[1]; r[2] = lo[2]; r[3] = lo[3]; r[4] = hi[0]; r[5] = hi[1]; r[6] = hi[2]; r[7] = hi[3]; return r;
}

struct Params {
    const float *x, *c, *ctx, *c_ctx, *w_ada, *b_ada, *ln_g, *ln_b, *w_in_even, *w_out_even, *gla_gate_w, *gla_gate_b, *gla_norm_g, *na_rpb, *w_in_odd, *w_out_odd, *ml_gate_b, *ml_norm_g, *sw_sink;
    float* out; unsigned char* ws; long long ph_lo, ph_hi;
};
typedef const __attribute__((address_space(4))) Params* KP;
__device__ __forceinline__ KP kparams() { unsigned long long v = (unsigned long long)__builtin_amdgcn_kernarg_segment_ptr(); asm volatile("" : "+s"(v)); return (KP)v; }

__device__ __forceinline__ int orig_col(int type, int n) {
    if (type == 0) { if (n < 1536) return n; if (n < 3584) return n + 32; if (n < 3616) return n - 3584 + 1536; return -1; }
    if (type == 1) { if (n < 1536) return n; if (n < 2816) return n + 16; if (n < 2832) return n - 2816 + 1536; return -1; }
    return n;
}
__device__ __forceinline__ float col_scale(int type, int n) {
    if (type == 0) return (n < 256 || (n >= 1536 && n < 2048)) ? 0.125f : 1.f;
    if (type == 1) return ((n >= 256 && n < 512) || (n >= 1536 && n < 2048)) ? 0.125f : 1.f;
    return 1.f;
}
__device__ __forceinline__ void p0_transpose_item(const float* __restrict__ W, int K, int Norig, int type, bf16* __restrict__ WT, LAS float* scr, int nblk, int item, int lane) {
    const int kb = item / nblk, nb = item % nblk, k0 = 64 * kb, n0 = 32 * nb;
    const int oc = orig_col(type, n0 + (lane & 31)); const float sc = col_scale(type, n0 + (lane & 31));
#pragma unroll 8
    for (int i = 0; i < 32; ++i) { const int kk = 2 * i + (lane >> 5); scr[kk * 33 + (lane & 31)] = oc >= 0 ? W[(size_t)(k0 + kk) * Norig + oc] * sc : 0.f; }
    LDS_WAIT();
    const int c = lane & 7;
#pragma unroll
    for (int j = 0; j < 4; ++j) { const int n = (lane >> 3) + 8 * j; const LAS float* s = scr + (8 * c) * 33 + n;
        u32x4 o; o.x = pk2(s[0 * 33], s[1 * 33]); o.y = pk2(s[2 * 33], s[3 * 33]); o.z = pk2(s[4 * 33], s[5 * 33]); o.w = pk2(s[6 * 33], s[7 * 33]);
        *(u32x4*)(WT + (size_t)(n0 + n) * K + k0 + 8 * c) = o; }
    LDS_WAIT();
}
__device__ __forceinline__ void phase_prologue(KP p, LAS unsigned char* lds) {
    const int tid = otid(), lane = tid & 63, wave = tid >> 6;
    unsigned char* ws = p->ws;
    float* MOD = (float*)(ws + WS_MOD);
    if ((int)blockIdx.x < 192) {
        LAS float* cond = (LAS float*)lds;
        LAS float* red = (LAS float*)(lds + 36864);
        for (int e = tid; e < 9 * 1024; e += NTHR) { const int j = e >> 10, k = e & 1023; const float v = j < 8 ? p->c[j * 1024 + k] : p->c_ctx[k]; cond[e] = siluf(v); }
        __syncthreads();
        for (int it = blockIdx.x; it < 192; it += gridDim.x) {
            const int l = it / 48, n0 = (it % 48) * 64, cq = tid & 15, ks = tid >> 4;
            float acc[9][4];
#pragma unroll
            for (int j = 0; j < 9; ++j) { acc[j][0] = 0.f; acc[j][1] = 0.f; acc[j][2] = 0.f; acc[j][3] = 0.f; }
            const float* wp = p->w_ada + (size_t)l * 1024 * 3072 + (size_t)(ks * 32) * 3072 + n0 + 4 * cq;
#pragma unroll 4
            for (int kk = 0; kk < 32; ++kk) { const f32x4 w = *(const f32x4*)(wp + (size_t)kk * 3072);
#pragma unroll
                for (int j = 0; j < 9; ++j) { const float cv = cond[j * 1024 + ks * 32 + kk]; acc[j][0] += cv * w[0]; acc[j][1] += cv * w[1]; acc[j][2] += cv * w[2]; acc[j][3] += cv * w[3]; } }
#pragma unroll
            for (int j = 0; j < 9; ++j)
#pragma unroll
                for (int i = 0; i < 4; ++i) red[ks * 576 + j * 64 + 4 * cq + i] = acc[j][i];
            __syncthreads();
            for (int o = tid; o < 576; o += NTHR) { float s = 0.f; for (int q = 0; q < 32; ++q) s += red[q * 576 + o]; const int j = o >> 6, n = n0 + (o & 63);
                MOD[(size_t)(l * 9 + j) * 3072 + n] = s + p->b_ada[l * 3072 + n]; }
            __syncthreads();
        }
    }
    if (blockIdx.x == gridDim.x - 1) {
        float* cosT = (float*)(ws + WS_ROPE); float* sinT = cosT + 1024;
        for (int e = tid; e < 1024; e += NTHR) { const int pos = e >> 4, i = e & 15;
            double f = 1.0; for (int q = 0; q < i; ++q) f *= 0.5623413251903491;
            const double f2 = f * f; double sn = 1.0, cs = 1.0;
            for (int q = 12; q >= 1; --q) { sn = 1.0 - f2 / ((2.0 * q) * (2.0 * q + 1.0)) * sn; cs = 1.0 - f2 / ((2.0 * q - 1.0) * (2.0 * q)) * cs; }
            sn *= f;
            double c = 1.0, s = 0.0; for (int q = 0; q < pos; ++q) { const double c2 = c * cs - s * sn, s2 = s * cs + c * sn; c = c2; s = s2; }
            cosT[e] = (float)c; sinT[e] = (float)s; }
    }
    __syncthreads();
    {
        LAS float* scr = (LAS float*)(lds + wave * 16384);
        const int gw = blockIdx.x * NWAVES + wave, NGW = gridDim.x * NWAVES;
        constexpr int I_E = 16 * (NPAD_EVEN / 32), I_O = 16 * (NPAD_ODD / 32), I_W = 16 * 32;
        constexpr int NIT = 2 * I_E + 2 * I_O + 4 * I_W;
        for (int it = gw; it < NIT; it += NGW) {
            int r = it;
            if (r < 2 * I_E) { const int i = r / I_E; r -= i * I_E; p0_transpose_item(p->w_in_even + (size_t)i * 1024 * NORIG_EVEN, 1024, NORIG_EVEN, 0, (bf16*)(ws + WS_WIE) + (size_t)i * NPAD_EVEN * 1024, scr, NPAD_EVEN / 32, r, lane); continue; }
            r -= 2 * I_E;
            if (r < 2 * I_O) { const int i = r / I_O; r -= i * I_O; p0_transpose_item(p->w_in_odd + (size_t)i * 1024 * NORIG_ODD, 1024, NORIG_ODD, 1, (bf16*)(ws + WS_WIO) + (size_t)i * NPAD_ODD * 1024, scr, NPAD_ODD / 32, r, lane); continue; }
            r -= 2 * I_O;
            { const int l = r / I_W; r -= l * I_W; const float* W = (l & 1) ? p->w_out_odd + (size_t)(l >> 1) * 1024 * 1024 : p->w_out_even + (size_t)(l >> 1) * 1024 * 1024;
              p0_transpose_item(W, 1024, 1024, 2, (bf16*)(ws + WS_WO) + (size_t)l * 1024 * 1024, scr, 32, r, lane); }
        }
    }
}
__device__ __forceinline__ void phase_h0(KP p) {
    const int lane = otid() & 63, gw = blockIdx.x * NWAVES + (otid() >> 6), NGW = gridDim.x * NWAVES;
    const float* MOD = (const float*)(p->ws + WS_MOD); bf16* H = (bf16*)(p->ws + WS_H);
    for (int m = gw; m < MTOT; m += NGW) {
        const int jb = m < MLAT ? (m >> 12) : 8;
        const float* src = m < MLAT ? p->x + (size_t)m * DM : p->ctx + (size_t)(m - MLAT) * DM;
        const float* md = MOD + (size_t)jb * 3072;
#pragma unroll
        for (int j = 0; j < 4; ++j) { const int k = 4 * lane + 256 * j; const f32x4 v = *(const f32x4*)(src + k), sh = *(const f32x4*)(md + k), sc = *(const f32x4*)(md + 1024 + k);
            const f32x4 h = v * (sc + 1.0f) + sh; u32x2 o; o.x = pk2(h[0], h[1]); o.y = pk2(h[2], h[3]); *(u32x2*)(H + (size_t)m * DM + k) = o; }
    }
}
__device__ __forceinline__ void phase_ln(KP p, int l, bool dummy = false) {
    const int lane = otid() & 63, gw = blockIdx.x * NWAVES + (otid() >> 6), NGW = gridDim.x * NWAVES;
    const float* MOD = (const float*)(p->ws + WS_MOD); bf16* H = (bf16*)(p->ws + WS_H); const bf16* Y = (const bf16*)(p->ws + WS_P); float* XC = (float*)(p->ws + WS_XC);
    const int mrows = l < DEPTH - 1 ? MTOT : MLAT;
    const float* lg = p->ln_g + l * DM; const float* lb = p->ln_b + l * DM;
    const float* xin = p->x; const float* cin = p->ctx; float* outp = p->out;
    for (int m0 = 2 * gw; m0 < mrows; m0 += 2 * NGW) {
        const int jb = m0 < MLAT ? (m0 >> 12) : 8;
        const float* md = MOD + (size_t)(l * 9 + jb) * 3072;
        const float* src[2]; float* dst[2]; f32x4 v[2][4]; float s[2] = {0.f, 0.f};
#pragma unroll
        for (int q = 0; q < 2; ++q) { const int m = m0 + q;
            src[q] = l == 0 ? (m < MLAT ? xin + (size_t)m * DM : cin + (size_t)(m - MLAT) * DM) : (m < MLAT ? outp + (size_t)m * DM : XC + (size_t)(m - MLAT) * DM);
            dst[q] = m < MLAT ? outp + (size_t)m * DM : XC + (size_t)(m - MLAT) * DM; }
#pragma unroll
        for (int j = 0; j < 4; ++j) { const int k = 4 * lane + 256 * j; const f32x4 g = *(const f32x4*)(md + 2048 + k);
#pragma unroll
            for (int q = 0; q < 2; ++q) { const f32x4 xv = *(const f32x4*)(src[q] + k); const u32x2 yw = *(const u32x2*)(Y + (size_t)(m0 + q) * DM + k);
                f32x4 y; y[0] = bflo(yw.x); y[1] = bfhi(yw.x); y[2] = bflo(yw.y); y[3] = bfhi(yw.y);
                v[q][j] = xv * ALPHA_DN + g * y; s[q] += (v[q][j][0] + v[q][j][1]) + (v[q][j][2] + v[q][j][3]); } }
        float rstd[2];
#pragma unroll
        for (int q = 0; q < 2; ++q) { const float mean = wave_sum(s[q]) * (1.f / DM); float s2 = 0.f;
#pragma unroll
            for (int j = 0; j < 4; ++j) { v[q][j] = v[q][j] - mean; s2 += (v[q][j][0] * v[q][j][0] + v[q][j][1] * v[q][j][1]) + (v[q][j][2] * v[q][j][2] + v[q][j][3] * v[q][j][3]); }
            rstd[q] = 1.f / sqrtf(wave_sum(s2) * (1.f / DM) + 1e-5f); }
        const float* md2 = MOD + (size_t)((l + 1) * 9 + jb) * 3072;
#pragma unroll
        for (int j = 0; j < 4; ++j) { const int k = 4 * lane + 256 * j; const f32x4 gg = *(const f32x4*)(lg + k), bb = *(const f32x4*)(lb + k);
            f32x4 sh = (f32x4){0.f, 0.f, 0.f, 0.f}, sc = sh; if (l < DEPTH - 1) { sh = *(const f32x4*)(md2 + k); sc = *(const f32x4*)(md2 + 1024 + k); }
#pragma unroll
            for (int q = 0; q < 2; ++q) { const f32x4 o = v[q][j] * rstd[q] * gg + bb;
                *(f32x4*)(dst[q] + k) = dummy ? *(const f32x4*)(src[q] + k) : o;
                if (l < DEPTH - 1) { const f32x4 h = o * (sc + 1.0f) + sh; u32x2 w; w.x = pk2(h[0], h[1]); w.y = pk2(h[2], h[3]); *(u32x2*)(H + (size_t)(m0 + q) * DM + k) = w; } } }
    }
}
constexpr int AT_KS = 0, AT_VS = 9216, AT_BUF = 18432, AT_PS = 36864, AT_RPB = AT_PS + 8 * 2304;
__device__ __forceinline__ bf16x8 frag_tr_perm(const LAS bf16* X, int ld, int k0, int n0, int lane) {
    const int g = lane >> 4, m = lane & 15, q = m >> 2, p = m & 3;
    const LAS bf16* a0 = X + (k0 + 4 * g + q) * ld + n0 + 4 * p;
    const s16x4 lo = __builtin_amdgcn_ds_read_tr16_b64_v4i16((LAS s16x4*)a0);
    const s16x4 hi = __builtin_amdgcn_ds_read_tr16_b64_v4i16((LAS s16x4*)(a0 + 16 * ld));
    bf16x8 r; r[0] = lo[0]; r[1] = lo[1]; r[2] = lo[2]; r[3] = lo[3]; r[4] = hi[0]; r[5] = hi[1]; r[6] = hi[2]; r[7] = hi[3]; return r;
}
__device__ __forceinline__ void attn_tile(const LAS bf16* Ks, const LAS bf16* Vs, const LAS float* rpb, const bf16x8 (&qa)[2], float& mrow, float& lsum, f32x4 (&oacc)[4],
                                          int mode, int i, int nlat, int qa_, int qb_, int ka_, int lane, int wave) {
    const int fq = lane >> 4, fr = lane & 15;
    const bool islat = i < nlat;
    bool active = true; int kt0 = 0;
    if (islat) {
        if (mode == 0) { kt0 = ka_ + i; const int rs = min(max(qa_ - 4, 0), 56); active = (kt0 >= rs) && (kt0 < rs + 8); }
        else { kt0 = ka_ + 64 * i; active = !(kt0 > qa_ + 15 + 128 || kt0 + 63 < qa_ - 128); }
    }
    if (!active) return;
    const bool nar = islat && mode == 0;
    const int w4 = wave & 3, ntlo = nar ? (w4 < 2 ? 0 : w4 - 1) : 0, nthi = nar ? (w4 > 1 ? 3 : w4 + 1) : 3;
    f32x4 s[4];
#pragma unroll
    for (int mt = 0; mt < 4; ++mt) { s[mt] = (f32x4){0.f, 0.f, 0.f, 0.f};
        if (mt >= ntlo && mt <= nthi) {
#pragma unroll
            for (int ks = 0; ks < 2; ++ks) s[mt] = MFMA(frag_rm(Ks, 72, 16 * mt, 32 * ks, lane), qa[ks], s[mt]); } }
    float tmax = -3e38f;
#pragma unroll
    for (int mt = 0; mt < 4; ++mt) { if (mt >= ntlo && mt <= nthi) {
#pragma unroll
        for (int r = 0; r < 4; ++r) { float v = s[mt][r]; const int kk = 16 * mt + 4 * fq + r;
            if (islat) {
                if (mode == 0) { const int qc = qb_ + fr, cs = min(max(qc - 8, 0), 48); const bool ok = (kk >= cs) && (kk < cs + 16);
                    const int bi = (kt0 - qa_ + 7) * 31 + (kk - qc + 15); v = ok ? v + rpb[ok ? bi : 0] : -3e38f; }
                else { const int d = (qa_ + fr) - (kt0 + kk); v = (d <= 128 && d >= -128) ? v : -3e38f; }
            }
            s[mt][r] = v; tmax = fmaxf(tmax, v); } } }
    tmax = fmaxf(tmax, __shfl_xor(tmax, 16)); tmax = fmaxf(tmax, __shfl_xor(tmax, 32));
    const float mnew = fmaxf(mrow, tmax); const float alpha = __expf(mrow - mnew); mrow = mnew;
    float ps = 0.f; unsigned pw[8];
#pragma unroll
    for (int mt = 0; mt < 4; ++mt) { float p0 = 0.f, p1 = 0.f, p2 = 0.f, p3 = 0.f;
        if (mt >= ntlo && mt <= nthi) { p0 = __expf(s[mt][0] - mnew); p1 = __expf(s[mt][1] - mnew); p2 = __expf(s[mt][2] - mnew); p3 = __expf(s[mt][3] - mnew); ps += (p0 + p1) + (p2 + p3); }
        pw[2 * mt] = pk2(p0, p1); pw[2 * mt + 1] = pk2(p2, p3); oacc[mt] = oacc[mt] * alpha; }
    lsum = lsum * alpha + ps;
#pragma unroll
    for (int ks = 0; ks < 2; ++ks) { if (ks == 0 ? (ntlo < 2) : (nthi > 1)) {
        const u32x4 pu = (u32x4){pw[4 * ks], pw[4 * ks + 1], pw[4 * ks + 2], pw[4 * ks + 3]}; const bf16x8 pb = __builtin_bit_cast(bf16x8, pu);
#pragma unroll
        for (int mt = 0; mt < 4; ++mt) oacc[mt] = MFMA(frag_tr_perm(Vs, 72, 32 * ks, 16 * mt, lane), pb, oacc[mt]); } }
}
__device__ __forceinline__ void attn_item(LAS unsigned char* lds, const bf16* __restrict__ P, int ldp, bf16* __restrict__ Z, int mode,
                                          int qrow0, int qcol, int kcol, int vcol, int gcol, int zcol,
                                          int nlat, int lat_row0, int ctx_row0, int qa_, int qb_, int ka_, const float* __restrict__ rpb_g, float sink) {
    const int tid = otid(), lane = tid & 63, wave = tid >> 6, fq = lane >> 4, fr = lane & 15;
    LAS bf16* Ks0 = (LAS bf16*)(lds + AT_KS); LAS bf16* Vs0 = (LAS bf16*)(lds + AT_VS); LAS bf16* Ks1 = (LAS bf16*)(lds + AT_KS + AT_BUF); LAS bf16* Vs1 = (LAS bf16*)(lds + AT_VS + AT_BUF);
    LAS bf16* Ps = (LAS bf16*)(lds + AT_PS + wave * 2304); LAS float* rpb = (LAS float*)(lds + AT_RPB);
    const int ntile = nlat + 4, srow = tid >> 3, sch = tid & 7, soff = srow * 72 + 8 * sch;
#define AT_ROWB(j) (((j) < nlat) ? lat_row0 + 64 * (j) : ctx_row0 + 64 * ((j) - nlat))
#define AT_LOAD(kr, vr, j) do { const size_t ro_ = (size_t)(AT_ROWB(j) + srow) * ldp + 8 * sch; kr = *(const u32x4*)(P + ro_ + kcol); vr = *(const u32x4*)(P + ro_ + vcol); } while (0)
    u32x4 k0, v0, k1, v1;
    AT_LOAD(k0, v0, 0);
    bf16x8 qa[2];
#pragma unroll
    for (int ks = 0; ks < 2; ++ks) qa[ks] = *(const bf16x8*)(P + (size_t)(qrow0 + fr) * ldp + qcol + 32 * ks + 8 * fq);
    __syncthreads();
    if (mode == 0) { for (int e = tid; e < 465; e += NTHR) rpb[e] = rpb_g[e]; }
    *(LAS u32x4*)(Ks0 + soff) = k0; *(LAS u32x4*)(Vs0 + soff) = v0;
    AT_LOAD(k0, v0, 1);
    AT_LOAD(k1, v1, 2);
    float mrow = -1e30f, lsum = 0.f; f32x4 oacc[4];
#pragma unroll
    for (int r = 0; r < 4; ++r) oacc[r] = (f32x4){0.f, 0.f, 0.f, 0.f};
    __syncthreads();
    for (int i = 0; i < ntile; i += 2) {
        attn_tile(Ks0, Vs0, rpb, qa, mrow, lsum, oacc, mode, i, nlat, qa_, qb_, ka_, lane, wave);
        if (i + 1 < ntile) { *(LAS u32x4*)(Ks1 + soff) = k0; *(LAS u32x4*)(Vs1 + soff) = v0; }
        if (i + 3 < ntile) AT_LOAD(k0, v0, i + 3);
        __syncthreads();
        if (i + 1 >= ntile) break;
        attn_tile(Ks1, Vs1, rpb, qa, mrow, lsum, oacc, mode, i + 1, nlat, qa_, qb_, ka_, lane, wave);
        if (i + 2 < ntile) { *(LAS u32x4*)(Ks0 + soff) = k1; *(LAS u32x4*)(Vs0 + soff) = v1; }
        if (i + 4 < ntile) AT_LOAD(k1, v1, i + 4);
        __syncthreads();
    }
#undef AT_LOAD
#undef AT_ROWB
    u32x4 gvv[2];
#pragma unroll
    for (int c2 = 0; c2 < 2; ++c2) { const int idx = lane + 64 * c2, q = idx >> 3, ch = idx & 7; gvv[c2] = *(const u32x4*)(P + (size_t)(qrow0 + q) * ldp + gcol + 8 * ch); }
    { float lt = lsum; lt += __shfl_xor(lt, 16); lt += __shfl_xor(lt, 32); float sc;
      if (mode == 1 || mode == 3) { const float mf = fmaxf(mrow, sink); const float al = __expf(mrow - mf); lt = lt * al + __expf(sink - mf); sc = al / lt; } else sc = 1.f / lt;
#pragma unroll
      for (int mt = 0; mt < 4; ++mt) { u32x2 w; w.x = pk2(oacc[mt][0] * sc, oacc[mt][1] * sc); w.y = pk2(oacc[mt][2] * sc, oacc[mt][3] * sc); *(LAS u32x2*)(Ps + fr * 72 + 16 * mt + 4 * fq) = w; } }
    LDS_WAIT();
#pragma unroll
    for (int c2 = 0; c2 < 2; ++c2) { const int idx = lane + 64 * c2, q = idx >> 3, ch = idx & 7;
        const u32x4 ov = *(const LAS u32x4*)(Ps + q * 72 + 8 * ch); const u32x4 gv = gvv[c2];
        u32x4 w;
        w.x = pk2(bflo(ov.x) * siluf(bflo(gv.x)), bfhi(ov.x) * siluf(bfhi(gv.x))); w.y = pk2(bflo(ov.y) * siluf(bflo(gv.y)), bfhi(ov.y) * siluf(bfhi(gv.y)));
        w.z = pk2(bflo(ov.z) * siluf(bflo(gv.z)), bfhi(ov.z) * siluf(bfhi(gv.z))); w.w = pk2(bflo(ov.w) * siluf(bflo(gv.w)), bfhi(ov.w) * siluf(bfhi(gv.w)));
        *(u32x4*)(Z + (size_t)(qrow0 + q) * DM + zcol + 8 * ch) = w; }
    LDS_WAIT();
}
__device__ __forceinline__ void phase_attn(KP p, LAS unsigned char* lds, int l, bool need_ctx) {
    const int wave = otid() >> 6; const bool odd = l & 1; const int li = l >> 1;
    const bf16* P = (const bf16*)(p->ws + WS_P); bf16* Z = (bf16*)(p->ws + WS_H); const int ldp = odd ? NP_ODD : NP_EVEN;
    const int nmain = BATCH * 8 * 32, nctx = need_ctx ? BATCH * 8 * 2 : 0;
    for (int it = blockIdx.x; it < nmain + nctx; it += gridDim.x) {
        if (it < nmain) {
            const int b = it >> 8, h = (it >> 5) & 7, qb = it & 31;
            if (!odd) { const int r0 = 2 * qb, rw = r0 + (wave >> 2); const int rs0 = min(max(r0 - 4, 0), 56), rs1 = min(max(r0 + 1 - 4, 0), 56);
                attn_item(lds, P, ldp, Z, 0, b * SEQ + rw * 64 + 16 * (wave & 3), 1536 + h * 64, 2048 + h * 64, 2560 + h * 64, 3072 + h * 64, 512 + h * 64,
                          rs1 + 8 - rs0, b * SEQ + rs0 * 64, MLAT + b * CTXL, rw, 16 * (wave & 3), rs0, p->na_rpb + (size_t)(li * 8 + h) * 465, 0.f); }
            else { const int kv = h >> 2, t0 = 128 * qb, lt0 = max(0, 2 * qb - 2), lt1 = min(63, 2 * qb + 3);
                attn_item(lds, P, ldp, Z, 1, b * SEQ + t0 + 16 * wave, 1536 + h * 64, 2048 + kv * 64, 2176 + kv * 64, 2304 + h * 64, 512 + h * 64,
                          lt1 - lt0 + 1, b * SEQ + lt0 * 64, MLAT + b * CTXL, t0 + 16 * wave, 0, lt0 * 64, nullptr, p->sw_sink[li * 8 + h]); }
        } else {
            const int j = it - nmain, b = j >> 4, h = (j >> 1) & 7, half = j & 1; const int q0 = MLAT + b * CTXL + 128 * half + 16 * wave;
            if (!odd) attn_item(lds, P, ldp, Z, 2, q0, 1536 + h * 64, 2048 + h * 64, 2560 + h * 64, 3072 + h * 64, 512 + h * 64, 0, 0, MLAT + b * CTXL, 0, 0, 0, nullptr, 0.f);
            else { const int kv = h >> 2; attn_item(lds, P, ldp, Z, 3, q0, 1536 + h * 64, 2048 + kv * 64, 2176 + kv * 64, 2304 + h * 64, 512 + h * 64, 0, 0, MLAT + b * CTXL, 0, 0, 0, nullptr, p->sw_sink[li * 8 + h]); }
        }
    }
}
__device__ __forceinline__ int chunk_row0(int b, int cp) { return cp < 4 ? MLAT + b * CTXL + cp * 64 : b * SEQ + (cp - 4) * 64; }
constexpr int SL_KDF = 0, SL_KDB = 9216, SL_VS = 18432, SL_SEG = 35840, SL_MISC = 39936;
__device__ __forceinline__ void phase_scan_local(KP p, LAS unsigned char* lds, int l) {
    const int tid = otid(), lane = tid & 63, wave = tid >> 6, fq = lane >> 4, fr = lane & 15; const bool odd = l & 1; const int li = l >> 1;
    const bf16* P = (const bf16*)(p->ws + WS_P); const int ldp = odd ? NP_ODD : NP_EVEN; const float* SM = (const float*)(p->ws + WS_SM);
    float* S = (float*)(p->ws + WS_S); float* GAM = (float*)(p->ws + WS_GAM); float* SC = (float*)(p->ws + WS_SC);
    LAS bf16* kdf = (LAS bf16*)(lds + SL_KDF); LAS bf16* kdb = (LAS bf16*)(lds + SL_KDB); LAS bf16* vs = (LAS bf16*)(lds + SL_VS);
    LAS float* seg = (LAS float*)(lds + SL_SEG); LAS float* misc = (LAS float*)(lds + SL_MISC);
    const int dk = tid & 63, sg = tid >> 6;
    for (int it = blockIdx.x; it < BATCH * 4 * NCHUNK; it += gridDim.x) {
        const int b = it / (4 * NCHUNK), h = (it / NCHUNK) & 3, cp = it % NCHUNK; const int row0 = chunk_row0(b, cp);
        const int slf = ((b * 4 + h) * 2 + 0) * NCHUNK + cp, slb = slf + NCHUNK;
        __syncthreads();
#pragma unroll
        for (int c2 = 0; c2 < 2; ++c2) { const int idx = tid + NTHR * c2, t = idx >> 4, ch = idx & 15; *(LAS u32x4*)(vs + t * 136 + 8 * ch) = *(const u32x4*)(P + (size_t)(row0 + t) * ldp + 512 + h * 128 + 8 * ch); }
        float kv[8];
#pragma unroll
        for (int tt = 0; tt < 8; ++tt) kv[tt] = bf2f(P[(size_t)(row0 + sg * 8 + tt) * ldp + 256 + h * 64 + dk]);
        if (!odd) {
            float gwf[16], gwb[16];
            const float* gw = p->gla_gate_w + (size_t)li * 2 * 16 * 256; const float* gb = p->gla_gate_b + (size_t)li * 2 * 256;
#pragma unroll
            for (int r = 0; r < 16; ++r) { gwf[r] = gw[r * 256 + h * 64 + dk]; gwb[r] = gw[(16 + r) * 256 + h * 64 + dk]; }
            const float gbf = gb[h * 64 + dk], gbb = gb[256 + h * 64 + dk];
            { const int t = tid >> 3, c4 = (tid & 7) * 4; *(LAS f32x4*)(misc + t * 32 + c4) = *(const f32x4*)(SM + (size_t)(row0 + t) * 32 + c4); }
            __syncthreads();
            float pf[8], sb[8];
#pragma unroll
            for (int tt = 0; tt < 8; ++tt) { const LAS float* lr = misc + (sg * 8 + tt) * 32; float zf = gbf, zb = gbb;
#pragma unroll
                for (int r = 0; r < 16; ++r) { zf += lr[r] * gwf[r]; zb += lr[16 + r] * gwb[r]; }
                pf[tt] = logsigf(zf) * 0.0625f; sb[tt] = logsigf(zb) * 0.0625f; }
#pragma unroll
            for (int tt = 1; tt < 8; ++tt) pf[tt] += pf[tt - 1];
#pragma unroll
            for (int tt = 6; tt >= 0; --tt) sb[tt] += sb[tt + 1];
            seg[(0 * 8 + sg) * 64 + dk] = pf[7]; seg[(1 * 8 + sg) * 64 + dk] = sb[0];
            __syncthreads();
            float offf = 0.f, totf = 0.f, offb = 0.f, totb = 0.f;
#pragma unroll
            for (int q = 0; q < 8; ++q) { const float a = seg[q * 64 + dk], c = seg[(8 + q) * 64 + dk]; totf += a; totb += c; if (q < sg) offf += a; if (q > sg) offb += c; }
#pragma unroll
            for (int tt = 0; tt < 8; ++tt) { const int t = sg * 8 + tt;
                kdf[t * 72 + dk] = (bf16)f2bf(kv[tt] * __expf(totf - (offf + pf[tt]))); kdb[t * 72 + dk] = (bf16)f2bf(kv[tt] * __expf(totb - (offb + sb[tt]))); }
            if (sg == 0) { GAM[(size_t)slf * 64 + dk] = __expf(totf); GAM[(size_t)slb * 64 + dk] = __expf(totb); }
        } else {
            const float* mb = p->ml_gate_b + li * 16;
            if (tid < 128) { const int d = tid >> 6, t = tid & 63; const float* gp = SM + (size_t)(row0 + t) * 32 + d * 8;
                misc[d * 128 + t] = gp[h] + mb[d * 8 + h]; misc[d * 128 + 64 + t] = logsigf(gp[4 + h] + mb[d * 8 + 4 + h]); }
            __syncthreads();
            if (tid < 128) { const int d = tid >> 6, t = tid & 63; const float run = wave_scan_sum(misc[d * 128 + 64 + t], t, d == 1);
                const float tot = d == 0 ? __shfl(run, 63) : __shfl(run, 0);
                const float wl = tot - run + misc[d * 128 + t]; const float ml = wave_max(wl);
                misc[256 + d * 64 + t] = __expf(wl - ml);
                if (t == 0) { const int sl = d == 0 ? slf : slb; SC[(size_t)sl * 4 + 0] = tot; SC[(size_t)sl * 4 + 1] = ml; } }
            __syncthreads();
            float nf = 0.f, nb = 0.f;
#pragma unroll
            for (int tt = 0; tt < 8; ++tt) { const int t = sg * 8 + tt; const float a = kv[tt] * misc[256 + t], c = kv[tt] * misc[256 + 64 + t]; nf += a; nb += c;
                kdf[t * 72 + dk] = (bf16)f2bf(a); kdb[t * 72 + dk] = (bf16)f2bf(c); }
            seg[(0 * 8 + sg) * 64 + dk] = nf; seg[(1 * 8 + sg) * 64 + dk] = nb;
            __syncthreads();
            if (sg < 2) { float s2 = 0.f;
#pragma unroll
                for (int q = 0; q < 8; ++q) s2 += seg[(sg * 8 + q) * 64 + dk];
                GAM[(size_t)(sg == 0 ? slf : slb) * 64 + dk] = s2; }
        }
        __syncthreads();
#pragma unroll
        for (int d = 0; d < 2; ++d) { const LAS bf16* kd = d ? kdb : kdf; f32x4 acc[4];
#pragma unroll
            for (int mt = 0; mt < 4; ++mt) acc[mt] = (f32x4){0.f, 0.f, 0.f, 0.f};
#pragma unroll
            for (int ks = 0; ks < 2; ++ks) { const bf16x8 bv = frag_tr(vs, 136, 32 * ks, 16 * wave, lane);
#pragma unroll
                for (int mt = 0; mt < 4; ++mt) acc[mt] = MFMA(frag_tr(kd, 72, 32 * ks, 16 * mt, lane), bv, acc[mt]); }
            float* dst = S + (size_t)(d ? slb : slf) * 8192;
#pragma unroll
            for (int mt = 0; mt < 4; ++mt)
#pragma unroll
                for (int r = 0; r < 4; ++r) dst[(16 * mt + 4 * fq + r) * 128 + 16 * wave + fr] = acc[mt][r]; }
    }
}
__device__ __forceinline__ void phase_scan_seq(KP p, int l, bool dummy = false) {
    const bool odd = l & 1;
    f32x4* S4 = (f32x4*)(p->ws + WS_S); float* GAM = (float*)(p->ws + WS_GAM); f32x4* GAM4 = (f32x4*)(p->ws + WS_GAM); float* SC = (float*)(p->ws + WS_SC);
    const int nthreads = gridDim.x * NTHR;
    for (int gid = blockIdx.x * NTHR + otid(); gid < 64 * 2048; gid += nthreads) {
        const int chain = gid >> 11, e4 = gid & 2047, dir = chain & 1, dkk = e4 >> 5; const int base = chain * NCHUNK;
        f32x4 st = (f32x4){0.f, 0.f, 0.f, 0.f}, nst = (f32x4){0.f, 0.f, 0.f, 0.f}; float m = 0.f; const bool hasn = odd && e4 < 16;
        for (int s0 = 0; s0 < NCHUNK; s0 += 4) {
            f32x4 d[4], dn[4]; float g0[4], g1[4]; int idx[4];
#pragma unroll
            for (int u = 0; u < 4; ++u) { const int step = s0 + u; const int cp = dir == 0 ? step : (step < 4 ? 3 - step : 71 - step); idx[u] = base + cp;
                d[u] = S4[(size_t)idx[u] * 2048 + e4];
                if (!odd) { g0[u] = GAM[(size_t)idx[u] * 64 + dkk]; g1[u] = 0.f; } else { g0[u] = SC[(size_t)idx[u] * 4 + 0]; g1[u] = SC[(size_t)idx[u] * 4 + 1]; if (hasn) dn[u] = GAM4[(size_t)idx[u] * 16 + e4]; } }
#pragma unroll
            for (int u = 0; u < 4; ++u) {
                S4[(size_t)idx[u] * 2048 + e4] = dummy ? d[u] : st;
                if (!odd) { st = st * g0[u] + d[u]; }
                else { if (hasn) GAM4[(size_t)idx[u] * 16 + e4] = dummy ? dn[u] : nst; if (e4 == 0 && !dummy) SC[(size_t)idx[u] * 4 + 2] = m;
                    const float mn = fmaxf(g0[u] + m, g1[u]); const float dec = __expf(g0[u] + m - mn), sc = __expf(g1[u] - mn);
                    st = st * dec + d[u] * sc; if (hasn) nst = nst * dec + dn[u] * sc; m = mn; }
            }
        }
    }
}
constexpr int SO_QF = 0, SO_KF = 9216, SO_QB = 18432, SO_KB = 27648, SO_VS = 36864, SO_AF = 54272, SO_AB = 63488, SO_SF = 72704, SO_SB = 90112, SO_SEG = 107520, SO_SSQ = 111616, SO_MISC = 113664;
constexpr int SO_OST = 0;
__device__ __forceinline__ void scan_out_tail(LAS unsigned char* lds, f32x4 (&o)[4], const bf16* __restrict__ P, int ldp, bf16* __restrict__ Z, int row0, int h, const float* __restrict__ ng) {
    const int tid = otid(), lane = tid & 63, wave = tid >> 6, fq = lane >> 4, fr = lane & 15;
    LAS float* ost = (LAS float*)(lds + SO_OST);
    u32x4 gv[2]; f32x4 g0[2], g1[2];
#pragma unroll
    for (int c2 = 0; c2 < 2; ++c2) { const int idx = tid + NTHR * c2, t = idx >> 4, ch = idx & 15;
        gv[c2] = *(const u32x4*)(P + (size_t)(row0 + t) * ldp + 1024 + h * 128 + 8 * ch); g0[c2] = *(const f32x4*)(ng + h * 128 + 8 * ch); g1[c2] = *(const f32x4*)(ng + h * 128 + 8 * ch + 4); }
    __syncthreads();
#pragma unroll
    for (int mt = 0; mt < 4; ++mt)
#pragma unroll
        for (int r = 0; r < 4; ++r) ost[(16 * mt + 4 * fq + r) * 132 + 16 * wave + fr] = o[mt][r];
    __syncthreads();
#pragma unroll
    for (int c2 = 0; c2 < 2; ++c2) { const int idx = tid + NTHR * c2, t = idx >> 4, ch = idx & 15;
        f32x4 o0 = *(const LAS f32x4*)(ost + t * 132 + 8 * ch), o1 = *(const LAS f32x4*)(ost + t * 132 + 8 * ch + 4);
        const float q = red16_sum((o0[0] * o0[0] + o0[1] * o0[1]) + (o0[2] * o0[2] + o0[3] * o0[3]) + (o1[0] * o1[0] + o1[1] * o1[1]) + (o1[2] * o1[2] + o1[3] * o1[3]));
        const float rs = rsqrtf(q * (1.f / 128.f) + 1e-6f); o0 = o0 * rs * g0[c2]; o1 = o1 * rs * g1[c2];
        u32x4 w;
        w.x = pk2(o0[0] * siluf(bflo(gv[c2].x)), o0[1] * siluf(bfhi(gv[c2].x))); w.y = pk2(o0[2] * siluf(bflo(gv[c2].y)), o0[3] * siluf(bfhi(gv[c2].y)));
        w.z = pk2(o1[0] * siluf(bflo(gv[c2].z)), o1[1] * siluf(bfhi(gv[c2].z))); w.w = pk2(o1[2] * siluf(bflo(gv[c2].w)), o1[3] * siluf(bfhi(gv[c2].w)));
        *(u32x4*)(Z + (size_t)(row0 + t) * DM + h * 128 + 8 * ch) = w; }
}
__device__ __forceinline__ void stage_state(LAS bf16* dst, const float* __restrict__ src) {
    const int tid = otid();
#pragma unroll
    for (int c4 = 0; c4 < 4; ++c4) { const int idx = tid + NTHR * c4, r = idx >> 5, c = (idx & 31) * 4; const f32x4 v = *(const f32x4*)(src + r * 128 + c);
        u32x2 w; w.x = pk2(v[0], v[1]); w.y = pk2(v[2], v[3]); *(LAS u32x2*)(dst + r * 136 + c) = w; }
}
__device__ __forceinline__ void phase_scan_out_gla(KP p, LAS unsigned char* lds, int l, bool need_ctx) {
    const int tid = otid(), lane = tid & 63, wave = tid >> 6, fq = lane >> 4, fr = lane & 15; const int li = l >> 1;
    const bf16* P = (const bf16*)(p->ws + WS_P); const int ldp = NP_EVEN; const float* SM = (const float*)(p->ws + WS_SM); bf16* Z = (bf16*)(p->ws + WS_H);
    const float* S = (const float*)(p->ws + WS_S);
    LAS bf16* qf = (LAS bf16*)(lds + SO_QF); LAS bf16* kf = (LAS bf16*)(lds + SO_KF); LAS bf16* qb = (LAS bf16*)(lds + SO_QB); LAS bf16* kb = (LAS bf16*)(lds + SO_KB);
    LAS bf16* vs = (LAS bf16*)(lds + SO_VS); LAS bf16* Af = (LAS bf16*)(lds + SO_AF); LAS bf16* Ab = (LAS bf16*)(lds + SO_AB); LAS bf16* Sf = (LAS bf16*)(lds + SO_SF); LAS bf16* Sb = (LAS bf16*)(lds + SO_SB);
    LAS float* seg = (LAS float*)(lds + SO_SEG); LAS float* lrs = (LAS float*)(lds + SO_MISC);
    const int dk = tid & 63, sg = tid >> 6;
    for (int it = blockIdx.x; it < BATCH * 4 * NCHUNK; it += gridDim.x) {
        const int b = it / (4 * NCHUNK), h = (it / NCHUNK) & 3, cp = it % NCHUNK; if (cp < 4 && !need_ctx) continue;
        const int row0 = chunk_row0(b, cp); const int slf = ((b * 4 + h) * 2 + 0) * NCHUNK + cp, slb = slf + NCHUNK;
        __syncthreads();
#pragma unroll
        for (int c2 = 0; c2 < 2; ++c2) { const int idx = tid + NTHR * c2, t = idx >> 4, ch = idx & 15; *(LAS u32x4*)(vs + t * 136 + 8 * ch) = *(const u32x4*)(P + (size_t)(row0 + t) * ldp + 512 + h * 128 + 8 * ch); }
        stage_state(Sf, S + (size_t)slf * 8192); stage_state(Sb, S + (size_t)slb * 8192);
        float qv[8], kv[8];
#pragma unroll
        for (int tt = 0; tt < 8; ++tt) { const size_t ro = (size_t)(row0 + sg * 8 + tt) * ldp + h * 64 + dk; qv[tt] = bf2f(P[ro]); kv[tt] = bf2f(P[ro + 256]); }
        float gwf[16], gwb[16];
        const float* gw = p->gla_gate_w + (size_t)li * 2 * 16 * 256; const float* gb = p->gla_gate_b + (size_t)li * 2 * 256;
#pragma unroll
        for (int r = 0; r < 16; ++r) { gwf[r] = gw[r * 256 + h * 64 + dk]; gwb[r] = gw[(16 + r) * 256 + h * 64 + dk]; }
        const float gbf = gb[h * 64 + dk], gbb = gb[256 + h * 64 + dk];
        { const int t = tid >> 3, c4 = (tid & 7) * 4; *(LAS f32x4*)(lrs + t * 32 + c4) = *(const f32x4*)(SM + (size_t)(row0 + t) * 32 + c4); }
        __syncthreads();
        float pf[8], sb[8];
#pragma unroll
        for (int tt = 0; tt < 8; ++tt) { const LAS float* lr = lrs + (sg * 8 + tt) * 32; float zf = gbf, zb = gbb;
#pragma unroll
            for (int r = 0; r < 16; ++r) { zf += lr[r] * gwf[r]; zb += lr[16 + r] * gwb[r]; }
            pf[tt] = logsigf(zf) * 0.0625f; sb[tt] = logsigf(zb) * 0.0625f; }
#pragma unroll
        for (int tt = 1; tt < 8; ++tt) pf[tt] += pf[tt - 1];
#pragma unroll
        for (int tt = 6; tt >= 0; --tt) sb[tt] += sb[tt + 1];
        seg[(0 * 8 + sg) * 64 + dk] = pf[7]; seg[(1 * 8 + sg) * 64 + dk] = sb[0];
        __syncthreads();
        float offf = 0.f, offb = 0.f;
#pragma unroll
        for (int q = 0; q < 8; ++q) { const float a = seg[q * 64 + dk], c = seg[(8 + q) * 64 + dk]; if (q < sg) offf += a; if (q > sg) offb += c; }
#pragma unroll
        for (int tt = 0; tt < 8; ++tt) { const int t = sg * 8 + tt; const float bf_ = offf + pf[tt], bb_ = offb + sb[tt];
            qf[t * 72 + dk] = (bf16)f2bf(qv[tt] * __expf(bf_)); kf[t * 72 + dk] = (bf16)f2bf(kv[tt] * __expf(-bf_));
            qb[t * 72 + dk] = (bf16)f2bf(qv[tt] * __expf(bb_)); kb[t * 72 + dk] = (bf16)f2bf(kv[tt] * __expf(-bb_)); }
        __syncthreads();
        { const int mt = wave >> 1;
#pragma unroll
          for (int n2 = 0; n2 < 2; ++n2) { const int nt = 2 * (wave & 1) + n2; f32x4 af = (f32x4){0.f, 0.f, 0.f, 0.f}, ab = (f32x4){0.f, 0.f, 0.f, 0.f};
#pragma unroll
              for (int ks = 0; ks < 2; ++ks) { af = MFMA(frag_rm(qf, 72, 16 * mt, 32 * ks, lane), frag_rm(kf, 72, 16 * nt, 32 * ks, lane), af);
                                               ab = MFMA(frag_rm(qb, 72, 16 * mt, 32 * ks, lane), frag_rm(kb, 72, 16 * nt, 32 * ks, lane), ab); }
#pragma unroll
              for (int r = 0; r < 4; ++r) { const int t = 16 * mt + 4 * fq + r, s = 16 * nt + fr;
                  Af[t * 72 + s] = (bf16)f2bf(s <= t ? af[r] : 0.f); Ab[t * 72 + s] = (bf16)f2bf(s >= t ? ab[r] : 0.f); } } }
        __syncthreads();
        f32x4 o[4];
#pragma unroll
        for (int mt = 0; mt < 4; ++mt) o[mt] = (f32x4){0.f, 0.f, 0.f, 0.f};
#pragma unroll
        for (int ks = 0; ks < 2; ++ks) { const bf16x8 bv = frag_tr(vs, 136, 32 * ks, 16 * wave, lane), bsf = frag_tr(Sf, 136, 32 * ks, 16 * wave, lane), bsb = frag_tr(Sb, 136, 32 * ks, 16 * wave, lane);
#pragma unroll
            for (int mt = 0; mt < 4; ++mt) { o[mt] = MFMA(frag_rm(Af, 72, 16 * mt, 32 * ks, lane), bv, o[mt]); o[mt] = MFMA(frag_rm(Ab, 72, 16 * mt, 32 * ks, lane), bv, o[mt]);
                o[mt] = MFMA(frag_rm(qf, 72, 16 * mt, 32 * ks, lane), bsf, o[mt]); o[mt] = MFMA(frag_rm(qb, 72, 16 * mt, 32 * ks, lane), bsb, o[mt]); } }
        scan_out_tail(lds, o, P, ldp, Z, row0, h, p->gla_norm_g + (size_t)li * 512);
    }
}
constexpr int MO_QS = 0, MO_KS = 9216, MO_QWF = 18432, MO_QWB = 27648;
__device__ __forceinline__ void phase_scan_out_mlstm(KP p, LAS unsigned char* lds, int l, bool need_ctx) {
    const int tid = otid(), lane = tid & 63, wave = tid >> 6, fq = lane >> 4, fr = lane & 15; const int li = l >> 1;
    const bf16* P = (const bf16*)(p->ws + WS_P); const int ldp = NP_ODD; const float* SM = (const float*)(p->ws + WS_SM); bf16* Z = (bf16*)(p->ws + WS_H);
    const float* S = (const float*)(p->ws + WS_S); const float* GAM = (const float*)(p->ws + WS_GAM); const float* SC = (const float*)(p->ws + WS_SC);
    LAS bf16* qs = (LAS bf16*)(lds + MO_QS); LAS bf16* ks_ = (LAS bf16*)(lds + MO_KS); LAS bf16* qwf = (LAS bf16*)(lds + MO_QWF); LAS bf16* qwb = (LAS bf16*)(lds + MO_QWB);
    LAS bf16* vs = (LAS bf16*)(lds + SO_VS); LAS bf16* Af = (LAS bf16*)(lds + SO_AF); LAS bf16* Ab = (LAS bf16*)(lds + SO_AB); LAS bf16* Cf = (LAS bf16*)(lds + SO_SF); LAS bf16* Cb = (LAS bf16*)(lds + SO_SB);
    LAS float* part = (LAS float*)(lds + SO_SEG);
    LAS float* misc = (LAS float*)(lds + SO_MISC);
    const float* mb = p->ml_gate_b + li * 16;
    for (int it = blockIdx.x; it < BATCH * 4 * NCHUNK; it += gridDim.x) {
        const int b = it / (4 * NCHUNK), h = (it / NCHUNK) & 3, cp = it % NCHUNK; if (cp < 4 && !need_ctx) continue;
        const int row0 = chunk_row0(b, cp); const int slf = ((b * 4 + h) * 2 + 0) * NCHUNK + cp, slb = slf + NCHUNK;
        __syncthreads();
#pragma unroll
        for (int c2 = 0; c2 < 2; ++c2) { const int idx = tid + NTHR * c2, t = idx >> 4, ch = idx & 15; *(LAS u32x4*)(vs + t * 136 + 8 * ch) = *(const u32x4*)(P + (size_t)(row0 + t) * ldp + 512 + h * 128 + 8 * ch); }
        stage_state(Cf, S + (size_t)slf * 8192); stage_state(Cb, S + (size_t)slb * 8192);
        { const int t = tid >> 3, ch = tid & 7; const size_t ro = (size_t)(row0 + t) * ldp + h * 64 + 8 * ch;
          *(LAS u32x4*)(qs + t * 72 + 8 * ch) = *(const u32x4*)(P + ro); *(LAS u32x4*)(ks_ + t * 72 + 8 * ch) = *(const u32x4*)(P + ro + 256); }
        if (tid < 128) { const int d = tid >> 6, t = tid & 63; const float* gp = SM + (size_t)(row0 + t) * 32 + d * 8;
            misc[d * 512 + t] = gp[h] + mb[d * 8 + h]; misc[d * 512 + 64 + t] = logsigf(gp[4 + h] + mb[d * 8 + 4 + h]);
            misc[1024 + d * 64 + t] = GAM[(size_t)(d ? slb : slf) * 64 + t]; }
        __syncthreads();
        if (tid < 128) { const int d = tid >> 6, t = tid & 63; LAS float* md = misc + d * 512; const float run = wave_scan_sum(md[64 + t], t, d == 1); const float pm = wave_scan_max(md[t] - run, t, d == 1);
            const float mprev = SC[(size_t)(d ? slb : slf) * 4 + 2];
            const float mt_ = fmaxf(run + pm, run + mprev);
            md[128 + t] = run; md[192 + t] = mt_; md[256 + t] = __expf(run + mprev - mt_); }
        __syncthreads();
        { const int t = tid >> 3, ch = tid & 7; const u32x4 qv = *(const LAS u32x4*)(qs + t * 72 + 8 * ch); const float wf = misc[256 + t], wb = misc[512 + 256 + t];
          u32x4 a, c;
          a.x = pk2(bflo(qv.x) * wf, bfhi(qv.x) * wf); a.y = pk2(bflo(qv.y) * wf, bfhi(qv.y) * wf); a.z = pk2(bflo(qv.z) * wf, bfhi(qv.z) * wf); a.w = pk2(bflo(qv.w) * wf, bfhi(qv.w) * wf);
          c.x = pk2(bflo(qv.x) * wb, bfhi(qv.x) * wb); c.y = pk2(bflo(qv.y) * wb, bfhi(qv.y) * wb); c.z = pk2(bflo(qv.z) * wb, bfhi(qv.z) * wb); c.w = pk2(bflo(qv.w) * wb, bfhi(qv.w) * wb);
          *(LAS u32x4*)(qwf + t * 72 + 8 * ch) = a; *(LAS u32x4*)(qwb + t * 72 + 8 * ch) = c;
          const float q0 = bflo(qv.x), q1 = bfhi(qv.x), q2 = bflo(qv.y), q3 = bfhi(qv.y), q4 = bflo(qv.z), q5 = bfhi(qv.z), q6 = bflo(qv.w), q7 = bfhi(qv.w);
#pragma unroll
          for (int d = 0; d < 2; ++d) { const LAS float* nv = misc + 1024 + d * 64 + 8 * ch;
              part[(d * 8 + ch) * 64 + t] = q0 * nv[0] + q1 * nv[1] + q2 * nv[2] + q3 * nv[3] + q4 * nv[4] + q5 * nv[5] + q6 * nv[6] + q7 * nv[7]; } }
        { const int mt = wave >> 1; float rsf[4] = {0.f, 0.f, 0.f, 0.f}, rsb[4] = {0.f, 0.f, 0.f, 0.f};
#pragma unroll
          for (int n2 = 0; n2 < 2; ++n2) { const int nt = 2 * (wave & 1) + n2; f32x4 a = (f32x4){0.f, 0.f, 0.f, 0.f};
#pragma unroll
              for (int ks = 0; ks < 2; ++ks) a = MFMA(frag_rm(qs, 72, 16 * mt, 32 * ks, lane), frag_rm(ks_, 72, 16 * nt, 32 * ks, lane), a);
#pragma unroll
              for (int r = 0; r < 4; ++r) { const int t = 16 * mt + 4 * fq + r, s = 16 * nt + fr;
                  const float wf = s <= t ? __expf(misc[128 + t] - misc[128 + s] + misc[s] - misc[192 + t]) : 0.f;
                  const float wb = s >= t ? __expf(misc[512 + 128 + t] - misc[512 + 128 + s] + misc[512 + s] - misc[512 + 192 + t]) : 0.f;
                  const float vf = a[r] * wf, vb = a[r] * wb; rsf[r] += vf; rsb[r] += vb;
                  Af[t * 72 + s] = (bf16)f2bf(vf); Ab[t * 72 + s] = (bf16)f2bf(vb); } }
#pragma unroll
          for (int r = 0; r < 4; ++r) { const float a = red16_sum(rsf[r]), c = red16_sum(rsb[r]);
              if (fr == 0) { misc[1152 + (0 * 2 + (wave & 1)) * 64 + 16 * mt + 4 * fq + r] = a; misc[1152 + (1 * 2 + (wave & 1)) * 64 + 16 * mt + 4 * fq + r] = c; } } }
        __syncthreads();
        if (tid < 128) { const int d = tid >> 6, t = tid & 63; float qn = 0.f;
#pragma unroll
            for (int q = 0; q < 8; ++q) qn += part[(d * 8 + q) * 64 + t];
            const float den = misc[1152 + (d * 2 + 0) * 64 + t] + misc[1152 + (d * 2 + 1) * 64 + t] + misc[d * 512 + 256 + t] * qn;
            misc[d * 512 + 320 + t] = 1.f / fmaxf(fabsf(den), __expf(-misc[d * 512 + 192 + t])); }
        f32x4 of[4], ob[4];
#pragma unroll
        for (int mt = 0; mt < 4; ++mt) { of[mt] = (f32x4){0.f, 0.f, 0.f, 0.f}; ob[mt] = (f32x4){0.f, 0.f, 0.f, 0.f}; }
#pragma unroll
        for (int ks = 0; ks < 2; ++ks) { const bf16x8 bv = frag_tr(vs, 136, 32 * ks, 16 * wave, lane), bcf = frag_tr(Cf, 136, 32 * ks, 16 * wave, lane), bcb = frag_tr(Cb, 136, 32 * ks, 16 * wave, lane);
#pragma unroll
            for (int mt = 0; mt < 4; ++mt) { of[mt] = MFMA(frag_rm(Af, 72, 16 * mt, 32 * ks, lane), bv, of[mt]); of[mt] = MFMA(frag_rm(qwf, 72, 16 * mt, 32 * ks, lane), bcf, of[mt]);
                ob[mt] = MFMA(frag_rm(Ab, 72, 16 * mt, 32 * ks, lane), bv, ob[mt]); ob[mt] = MFMA(frag_rm(qwb, 72, 16 * mt, 32 * ks, lane), bcb, ob[mt]); } }
        __syncthreads();
        f32x4 o[4];
#pragma unroll
        for (int mt = 0; mt < 4; ++mt)
#pragma unroll
            for (int r = 0; r < 4; ++r) { const int t = 16 * mt + 4 * fq + r; o[mt][r] = of[mt][r] * misc[320 + t] + ob[mt][r] * misc[512 + 320 + t]; }
        scan_out_tail(lds, o, P, ldp, Z, row0, h, p->ml_norm_g + (size_t)li * 512);
    }
}
#define XB_TMO      128
#define XB_XCNT(j)  (256  + 64 * (j))
#define XB_XSUB(j)  (1280 + 64 * (j))
#define XB_XGEN(j)  (2304 + 64 * (j))
#define XB_TOP      3328
#define XB_TOPGEN   3392
#define XCD_BAR_WORDS 3456
#define XB_SPIN_CAP (1u << 18)

__device__ __forceinline__ unsigned xb_ld(unsigned* p)              { return __hip_atomic_load(p, __ATOMIC_RELAXED, __HIP_MEMORY_SCOPE_AGENT); }
__device__ __forceinline__ unsigned xb_add(unsigned* p, unsigned v) { return __hip_atomic_fetch_add(p, v, __ATOMIC_RELAXED, __HIP_MEMORY_SCOPE_AGENT); }
__device__ __forceinline__ unsigned xb_xcc_id() { return (unsigned)__builtin_amdgcn_s_getreg((3 << 11) | 20) & 0xFu; }
#define XB_SPIN(cond, bar) do { unsigned _sp = 0; while (cond) { __builtin_amdgcn_s_sleep(1); \
    if ((++_sp & 255u) == 0u) { if (xb_ld(&(bar)[XB_TMO])) break; if (_sp > XB_SPIN_CAP) { atomicAdd(&(bar)[XB_TMO], 1u); break; } } } } while (0)

struct XcdBarrier {
    unsigned* bar; unsigned x;
    volatile LAS unsigned* st;
};

__device__ __forceinline__ XcdBarrier xcd_barrier_post(unsigned* bar, volatile LAS unsigned* st) {
    XcdBarrier b; b.bar = bar; b.x = xb_xcc_id(); b.st = st;
    if (otid() == 0) (void)xb_add(&bar[XB_XCNT(b.x)], 1u);
    return b;
}
__device__ __forceinline__ void xcd_barrier_complete(unsigned* bar, unsigned x, unsigned& nloc, unsigned& nx) {
    const unsigned G = gridDim.x * gridDim.y * gridDim.z;
    unsigned sum, cnt, mine, sp = 0u;
    for (;;) {
        sum = 0u; cnt = 0u; mine = 0u;
#pragma unroll
        for (unsigned j = 0; j < 16; ++j) { const unsigned c = xb_ld(&bar[XB_XCNT(j)]); sum += c; cnt += (c > 0u) ? 1u : 0u; mine = (j == x) ? c : mine; }
        if (sum == G) break;
        __builtin_amdgcn_s_sleep(1);
        if ((++sp & 255u) == 0u) { if (xb_ld(&bar[XB_TMO])) break; if (sp > XB_SPIN_CAP) { atomicAdd(&bar[XB_TMO], 1u); break; } }
    }
    nloc = mine > 0u ? mine : 1u; nx = cnt > 0u ? cnt : 1u;
}

__device__ __forceinline__ void xcd_barrier(const XcdBarrier& b) {
    asm volatile("s_waitcnt vmcnt(0)" ::: "memory");
    __syncthreads();
    if (otid() == 0) {
        unsigned* bar = b.bar;
        __builtin_amdgcn_s_waitcnt(0);
        unsigned nloc = b.st[0], nx = b.st[1];
        if (nloc == 0u) { xcd_barrier_complete(bar, b.x, nloc, nx); b.st[0] = nloc; b.st[1] = nx; }
        const unsigned old = xb_add(&bar[XB_XSUB(b.x)], 1u);
        const unsigned gen = old / nloc;
        if (old + 1u == (gen + 1u) * nloc) {
            __builtin_amdgcn_fence(__ATOMIC_RELEASE, "agent");
            asm volatile("s_waitcnt vmcnt(0)" ::: "memory");
            const unsigned og = xb_add(&bar[XB_TOP], 1u);
            const unsigned tg = og / nx;
            if (og + 1u == (tg + 1u) * nx) xb_add(&bar[XB_TOPGEN], 1u);
            else XB_SPIN(xb_ld(&bar[XB_TOPGEN]) == tg, bar);
            __builtin_amdgcn_fence(__ATOMIC_ACQUIRE, "agent");
            xb_add(&bar[XB_XGEN(b.x)], 1u);
            asm volatile("s_waitcnt vmcnt(0)" ::: "memory");
        } else {
            XB_SPIN(xb_ld(&bar[XB_XGEN(b.x)]) == gen, bar);
            __builtin_amdgcn_fence(__ATOMIC_ACQUIRE, "agent");
            asm volatile("s_waitcnt vmcnt(0)" ::: "memory");
        }
    }
    __syncthreads();
}

#define REP_GEMM 1
#define REP_ATT 1
#define REP_LOC 1
#define REP_OUT 1
#define REP_PRO 1
#define REP_SEQ 1
#define REP_LN 1
#ifndef MK_N_LAUNCHES
#define MK_N_LAUNCHES 1
#endif
constexpr int N_PHASES = 2 + 6 * DEPTH;
__global__ void __launch_bounds__(NTHR, 2) fwd_megakernel(Params p_unused) {
    extern __shared__ __attribute__((aligned(16))) unsigned char lds_raw[];
    LAS unsigned char* lds = (LAS unsigned char*)lds_raw;
    cg::grid_group grid = cg::this_grid();
    const int lo = (int)kparams()->ph_lo, hi = (int)kparams()->ph_hi;
#define IN(k) (lo <= (k) && (k) < hi)
    volatile LAS unsigned* bst = (volatile LAS unsigned*)(lds + LDS_BYTES - 64);
    if (otid() < 16) bst[otid()] = 0u;
    __syncthreads();
    XcdBarrier bar = xcd_barrier_post((unsigned*)(kparams()->ws + WS_BAR), bst);
#define SEAM(k) do { if (IN(k) && IN((k) + 1)) { if ((k) == 0) grid.sync(); else xcd_barrier(bar); } } while (0)
    if (IN(0)) { for (int rep = 0; rep < REP_PRO; ++rep) { phase_prologue(kparams(), lds); __syncthreads(); } } SEAM(0);
    if (IN(1)) { for (int rep = 0; rep < REP_PRO; ++rep) phase_h0(kparams()); } SEAM(1);
#pragma unroll 1
    for (int l = 0; l < DEPTH; ++l) {
        const int pb = 2 + 6 * l; const bool odd = l & 1; const int li = l >> 1; const bool need_ctx = l < DEPTH - 1;
        if (IN(pb + 0)) {
            const int npad = odd ? NPAD_ODD : NPAD_EVEN; unsigned char* ws = kparams()->ws;
            pg8::Gemm g{(const pg8::bf16_t*)(ws + WS_H), (const pg8::bf16_t*)(ws + (odd ? WS_WIO : WS_WIE)) + (size_t)li * npad * 1024, MTOT, npad, 1024};
            pg8::StaticOrder S; S.init(MTOT, npad, (int)gridDim.x, (int)blockIdx.x);
            pg8::EpiProj E{(pg8::bf16_t*)(ws + WS_P), odd ? NP_ODD : NP_EVEN, (float*)(ws + WS_SM), odd ? 16 : 32, npad / 256 - 1, odd ? 1 : 0, (const float*)(ws + WS_ROPE), (const float*)(ws + WS_ROPE) + 1024};
            for (int rep = 0; rep < REP_GEMM; ++rep) pg8::gemm_phase<pg8::EpiProj, pg8::StaticOrder, true, true>(lds, g, S, E);
        }
        SEAM(pb + 0);
        if (IN(pb + 1)) { for (int rep = 0; rep < REP_ATT; ++rep) phase_attn(kparams(), lds, l, need_ctx); for (int rep = 0; rep < REP_LOC; ++rep) phase_scan_local(kparams(), lds, l); }
        SEAM(pb + 1);
        if (IN(pb + 2)) { for (int rep = 1; rep < REP_SEQ; ++rep) { phase_scan_seq(kparams(), l, true); __syncthreads(); } phase_scan_seq(kparams(), l); }
        SEAM(pb + 2);
        if (IN(pb + 3)) { for (int rep = 0; rep < REP_OUT; ++rep) { if (odd) phase_scan_out_mlstm(kparams(), lds, l, need_ctx); else phase_scan_out_gla(kparams(), lds, l, need_ctx); } }
        SEAM(pb + 3);
        if (IN(pb + 4)) {
            const int mrows = need_ctx ? MTOT : MLAT; unsigned char* ws = kparams()->ws;
            pg8::Gemm g{(const pg8::bf16_t*)(ws + WS_H), (const pg8::bf16_t*)(ws + WS_WO) + (size_t)l * 1024 * 1024, mrows, 1024, 1024};
            pg8::StaticOrder S; S.init(mrows, 1024, (int)gridDim.x, (int)blockIdx.x);
            pg8::EpiProj E{(pg8::bf16_t*)(ws + WS_P), 1024, nullptr, 0, -1, 0, nullptr, nullptr};
            for (int rep = 0; rep < REP_GEMM; ++rep) pg8::gemm_phase<pg8::EpiProj, pg8::StaticOrder, true, true>(lds, g, S, E);
        }
        SEAM(pb + 4);
        if (IN(pb + 5)) { for (int rep = 1; rep < REP_LN; ++rep) { phase_ln(kparams(), l, true); } phase_ln(kparams(), l); }
        SEAM(pb + 5);
    }
}
extern "C" void kernel_launch(void* const* d_in, const int* in_sizes, int n_in, void* d_out, int out_size, void* d_ws, size_t ws_size, hipStream_t stream) {
    static int grid = 0;
    if (grid == 0) {
        if (n_in != 19 || ws_size < WS_END) { fprintf(stderr, "kernel_launch: need 19 inputs and %zu bytes of workspace; got %d, %zu\n", (size_t)WS_END, n_in, ws_size); grid = -1; return; }
        int dev = 0, cus = 0, per_cu = 0;
        if (hipGetDevice(&dev) != hipSuccess || hipDeviceGetAttribute(&cus, hipDeviceAttributeMultiprocessorCount, dev) != hipSuccess) { grid = -1; return; }
        if (hipFuncSetAttribute((const void*)fwd_megakernel, hipFuncAttributeMaxDynamicSharedMemorySize, LDS_BYTES) != hipSuccess) { fprintf(stderr, "kernel_launch: hipFuncSetAttribute failed\n"); grid = -1; return; }
        if (hipOccupancyMaxActiveBlocksPerMultiprocessor(&per_cu, (const void*)fwd_megakernel, NTHR, LDS_BYTES) != hipSuccess || per_cu < 1) per_cu = 1;
        grid = cus * per_cu;
    }
    if (grid < 0) return;
    Params p{};
    p.x = (const float*)d_in[0]; p.c = (const float*)d_in[1]; p.ctx = (const float*)d_in[2]; p.c_ctx = (const float*)d_in[3]; p.w_ada = (const float*)d_in[4]; p.b_ada = (const float*)d_in[5];
    p.ln_g = (const float*)d_in[6]; p.ln_b = (const float*)d_in[7]; p.w_in_even = (const float*)d_in[8]; p.w_out_even = (const float*)d_in[9]; p.gla_gate_w = (const float*)d_in[10]; p.gla_gate_b = (const float*)d_in[11];
    p.gla_norm_g = (const float*)d_in[12]; p.na_rpb = (const float*)d_in[13]; p.w_in_odd = (const float*)d_in[14]; p.w_out_odd = (const float*)d_in[15]; p.ml_gate_b = (const float*)d_in[16]; p.ml_norm_g = (const float*)d_in[17];
    p.sw_sink = (const float*)d_in[18]; p.out = (float*)d_out; p.ws = (unsigned char*)d_ws;
    if (hipMemsetAsync((char*)d_ws + WS_BAR, 0, XCD_BAR_WORDS * 4, stream) != hipSuccess) { fprintf(stderr, "kernel_launch: memset failed\n"); return; }
#if MK_N_LAUNCHES == 1
    p.ph_lo = 0; p.ph_hi = N_PHASES;
    void* args[] = {&p};
    hipError_t e = hipLaunchCooperativeKernel((const void*)fwd_megakernel, dim3(grid), dim3(NTHR), args, LDS_BYTES, stream);
    if (e != hipSuccess) fprintf(stderr, "kernel_launch: cooperative launch failed: %s (grid %d)\n", hipGetErrorString(e), grid);
#else
    for (int k = 0; k < N_PHASES; ++k) { p.ph_lo = k; p.ph_hi = k + 1; hipLaunchKernelGGL(fwd_megakernel, dim3(grid), dim3(NTHR), LDS_BYTES, stream, p); }
#endif
}
```

```cpp
#include <hip/hip_runtime.h>
#include <hip/hip_cooperative_groups.h>
#include <cstdio>
#include <cstdint>
namespace cg = cooperative_groups;
__device__ __forceinline__ int otid() { int t = threadIdx.x; asm volatile("" : "+v"(t)); return t; }
namespace pg8 {
#define PG8_LAS __attribute__((address_space(3)))
typedef unsigned short bf16_t;
typedef short bf16x8 __attribute__((ext_vector_type(8)));
typedef float f32x4 __attribute__((ext_vector_type(4)));
typedef unsigned u32x4 __attribute__((ext_vector_type(4)));
constexpr int BM = 256, BK = 64, HALF = 128, HTB = HALF * BK * 2  , STAGE_BYTES = 8 * HTB, NXCD = 8, WGM = 8;

__host__ __device__ __forceinline__ int lds_byte(int r, int c) { const int st = (r >> 4) * 2 + (c >> 5), rr = r & 15, cc = c & 31, ob = rr * 64 + cc * 2; return st * 1024 + (ob ^ (((ob >> 9) & 1) << 5)); }
__host__ __device__ __forceinline__ void stage_rc(int b, int& R, int& C) { const int st = b / 1024, sb = b % 1024, swz = sb ^ (((sb >> 9) & 1) << 5); R = (st >> 1) * 16 + swz / 64; C = (st & 1) * 32 + (swz % 64) / 2; }
__host__ __device__ __forceinline__ int perm32(int rho) { const int n = rho >> 4, i = rho & 15; return 8 * (i >> 2) + 4 * n + (i & 3); }

struct Unit { int pm, pn; };
struct Gemm { const bf16_t* A; const bf16_t* Bt; int M, N, K; };

struct StaticOrder {
    int nM, nN, nwg, G, c;
    __host__ __device__ void init(int M, int N, int G_, int c_) { nM = M / BM; nN = N / BM; nwg = nM * nN; G = G_; c = c_; }
    __host__ __device__ bool next(int i, Unit& u) const {
        const long L = (long)i * G + c; if (L >= nwg) return false;
        int wgid = (int)L; { const int q = nwg / NXCD, r = nwg % NXCD, xcd = wgid % NXCD, off = wgid / NXCD; wgid = (xcd < r ? xcd * (q + 1) : r * (q + 1) + (xcd - r) * q) + off; }
        const int nig = WGM * nN, gid = wgid / nig, fm = gid * WGM, gsz = (nM - fm) < WGM ? (nM - fm) : WGM;
        u.pm = fm + ((wgid % nig) % gsz); u.pn = (wgid % nig) / gsz; return true;
    }
    __device__ __forceinline__ void a_ready(const Unit&) const {}
    __device__ __forceinline__ void done(const Unit&) const {}
};

__device__ __forceinline__ unsigned cvt_pk_bf16(float lo, float hi) { unsigned r; asm volatile("v_cvt_pk_bf16_f32 %0, %1, %2" : "=v"(r) : "v"(lo), "v"(hi)); return r; }
struct EpiProj {
    static constexpr bool PERM = true, AFTER_DRAIN = false;
    bf16_t* P; int ldp; float* SM; int nsm; int last_pn; int rope; const float* cosT; const float* sinT;
    __device__ __forceinline__ void operator()(const f32x4 (&acc)[2][2][4][2], const Unit& u, int wr, int wc, int fr, int fq) const {
        const int row0 = u.pm * BM + wr * 64 + fr;
        if (u.pn == last_pn) {
            if (wc == 0) {
#pragma unroll
                for (int ai = 0; ai < 2; ++ai)
#pragma unroll
                    for (int m = 0; m < 4; ++m) { const int row = row0 + ai * HALF + m * 16;
#pragma unroll
                        for (int n = 0; n < 2; ++n) { const int col = 8 * fq + 4 * n; if (col < nsm) *(f32x4*)(SM + (size_t)row * 32 + col) = acc[ai][0][m][n]; } }
            }
            return;
        }
        const bool do_rope_tile = rope && (u.pn == 6 || u.pn == 7 || u.pn == 8) && (u.pm * BM < 32768);
#pragma unroll
        for (int ai = 0; ai < 2; ++ai)
#pragma unroll
            for (int m = 0; m < 4; ++m) { const int row = row0 + ai * HALF + m * 16; bf16_t* rowp = P + (size_t)row * ldp + u.pn * BM + wc * 32 + 8 * fq;
#pragma unroll
                for (int bj = 0; bj < 2; ++bj) { f32x4 v0 = acc[ai][bj][m][0], v1 = acc[ai][bj][m][1];
                    if (do_rope_tile && (u.pn != 8 || bj == 0)) {
                        const int t = row & 4095; const int pos = (wc & 1) ? (t & 63) : (t >> 6); const int i0 = pos * 16 + 8 * (fq & 1);
                        const f32x4 c0 = *(const f32x4*)(cosT + i0), c1 = *(const f32x4*)(cosT + i0 + 4), s0 = *(const f32x4*)(sinT + i0), s1 = *(const f32x4*)(sinT + i0 + 4);
                        f32x4 p0, p1;
#pragma unroll
                        for (int e = 0; e < 4; ++e) { p0[e] = __shfl_xor(v0[e], 32); p1[e] = __shfl_xor(v1[e], 32); }
                        if (fq < 2) { v0 = v0 * c0 - p0 * s0; v1 = v1 * c1 - p1 * s1; } else { v0 = p0 * s0 + v0 * c0; v1 = p1 * s1 + v1 * c1; }
                    }
                    u32x4 w; w.x = cvt_pk_bf16(v0[0], v0[1]); w.y = cvt_pk_bf16(v0[2], v0[3]); w.z = cvt_pk_bf16(v1[0], v1[1]); w.w = cvt_pk_bf16(v1[2], v1[3]);
                    *(u32x4*)(rowp + bj * HALF) = w; } }
    }
};
template <class Epi, class Sched, bool ALIGN_EPI = false, bool SP2 = false>
__device__ __forceinline__ void gemm_phase(PG8_LAS unsigned char* lds, const Gemm g, const Sched& S, const Epi& E) {
    const int tid = otid(), wid = __builtin_amdgcn_readfirstlane(tid >> 6), lane = tid & 63, wr = wid >> 2, wc = wid & 3, fr = lane & 15, fq = lane >> 4;
    const int K = g.K, nt = K / BK;
    unsigned voffA[2], voffB[2];
#pragma unroll
    for (int i = 0; i < 2; ++i) { int R, C; stage_rc(tid * 16 + i * 8192, R, C); const int Rb = Epi::PERM ? ((R & ~31) + perm32(R & 31)) : R;
        voffA[i] = (unsigned)(R * K + C) * 2u; voffB[i] = (unsigned)(Rb * K + C) * 2u; }
    const size_t kstep = (size_t)(BK * 2);
    const size_t hstep = (size_t)HALF * K * 2;
    const size_t tstep = 2 * hstep;
    const unsigned ldsw = (unsigned)wid * 1024u;
    const int aoff = lds_byte(wr * 64 + fr, fq * 8), boff = lds_byte(wc * 32 + fr, fq * 8);
#define PG8_SA(b, h) (((b) * 2 + (h)) * HTB)
#define PG8_SB(b, h) ((4 + (b) * 2 + (h)) * HTB)
#define PG8_STAGE(bufoff, gbase, voff) do { _Pragma("unroll") for (int _i = 0; _i < 2; ++_i) \
        __builtin_amdgcn_global_load_lds((const unsigned*)((const char*)(gbase) + (voff)[_i]), (PG8_LAS unsigned*)(lds + (bufoff) + ldsw + _i * 8192), 16, 0, 0); } while (0)
#define PG8_LDA(dst, b, h) do { _Pragma("unroll") for (int m = 0; m < 4; ++m) _Pragma("unroll") for (int k = 0; k < 2; ++k) dst[m][k] = *(const PG8_LAS bf16x8*)(lds + PG8_SA(b, h) + aoff + m * 2048 + k * 1024); } while (0)
#define PG8_LDB(dst, b, h) do { _Pragma("unroll") for (int n = 0; n < 2; ++n) _Pragma("unroll") for (int k = 0; k < 2; ++k) dst[n][k] = *(const PG8_LAS bf16x8*)(lds + PG8_SB(b, h) + boff + n * 2048 + k * 1024); } while (0)
#define PG8_MMA(ai, bj, At, Bt) do { __builtin_amdgcn_s_setprio(1); _Pragma("unroll") for (int m = 0; m < 4; ++m) _Pragma("unroll") for (int n = 0; n < 2; ++n) _Pragma("unroll") for (int k = 0; k < 2; ++k) \
        acc[ai][bj][m][n] = __builtin_amdgcn_mfma_f32_16x16x32_bf16(Bt[n][k], At[m][k], acc[ai][bj][m][n], 0, 0, 0); __builtin_amdgcn_s_setprio(0); } while (0)
#define PG8_WAIT_V(n) asm volatile("s_waitcnt vmcnt(" #n ")" ::: "memory")
#define PG8_WAIT_L(n) asm volatile("s_waitcnt lgkmcnt(" #n ")" ::: "memory")
#define PG8_BAR __builtin_amdgcn_s_barrier()
#define PG8_SCHED __builtin_amdgcn_sched_barrier(0)
    Unit cur, nxt; int ui = 0;
    if (!S.next(0, cur)) return;
    f32x4 acc[2][2][4][2];
#pragma unroll
    for (int a = 0; a < 2; ++a)
#pragma unroll
        for (int b = 0; b < 2; ++b)
#pragma unroll
            for (int m = 0; m < 4; ++m)
#pragma unroll
                for (int n = 0; n < 2; ++n) acc[a][b][m][n] = (f32x4){0.f, 0.f, 0.f, 0.f};
    bf16x8 At[4][2], B0[2][2], B1[2][2];
    const char* cA = (const char*)g.A + (size_t)cur.pm * tstep; const char* cB = (const char*)g.Bt + (size_t)cur.pn * tstep;
    S.a_ready(cur);
    if constexpr (SP2) {
        PG8_STAGE(PG8_SB(0, 0), cB, voffB); PG8_STAGE(PG8_SB(0, 1), cB + hstep, voffB); PG8_STAGE(PG8_SA(0, 0), cA, voffA); PG8_STAGE(PG8_SA(0, 1), cA + hstep, voffA);
        if (wr == 1) PG8_BAR;
        PG8_WAIT_V(2); PG8_BAR;
        PG8_STAGE(PG8_SB(1, 0), cB + kstep, voffB); PG8_STAGE(PG8_SA(1, 0), cA + kstep, voffA); PG8_STAGE(PG8_SB(1, 1), cB + hstep + kstep, voffB);
        PG8_WAIT_V(6); PG8_BAR;
    } else {
        PG8_STAGE(PG8_SB(0, 0), cB, voffB); PG8_STAGE(PG8_SA(0, 0), cA, voffA); PG8_STAGE(PG8_SB(0, 1), cB + hstep, voffB); PG8_STAGE(PG8_SA(0, 1), cA + hstep, voffA);
        if (wr == 1) PG8_BAR;
        PG8_WAIT_V(4); PG8_BAR;
        PG8_STAGE(PG8_SB(1, 0), cB + kstep, voffB); PG8_STAGE(PG8_SA(1, 0), cA + kstep, voffA); PG8_STAGE(PG8_SB(1, 1), cB + hstep + kstep, voffB);
        PG8_WAIT_V(6); PG8_BAR;
    }
    for (;;) {
        const bool has_next = S.next(ui + 1, nxt);
        const char* nA = has_next ? (const char*)g.A + (size_t)nxt.pm * tstep : cA; const char* nB = has_next ? (const char*)g.Bt + (size_t)nxt.pn * tstep : cB;
        for (int t = 0; t < nt; t += 2) {
            const bool last = (t == nt - 2);
            const char* a1 = cA + (size_t)(t + 1) * kstep;
            const char* a2 = last ? nA : cA + (size_t)(t + 2) * kstep; const char* b2 = last ? nB : cB + (size_t)(t + 2) * kstep;
            const char* a3 = a2 + kstep; const char* b3 = b2 + kstep;
            if (last && has_next) S.a_ready(nxt);
            if constexpr (SP2) {
            PG8_LDB(B0, 0, 0); PG8_LDB(B1, 0, 1); PG8_SCHED; PG8_LDA(At, 0, 0); PG8_STAGE(PG8_SA(1, 1), a1 + hstep, voffA);
            PG8_WAIT_V(8); PG8_WAIT_L(0); PG8_BAR; PG8_MMA(0, 0, At, B0); PG8_MMA(0, 1, At, B1); PG8_BAR; PG8_SCHED;
            PG8_LDA(At, 0, 1); PG8_STAGE(PG8_SB(0, 0), b2, voffB); PG8_STAGE(PG8_SB(0, 1), b2 + hstep, voffB); PG8_STAGE(PG8_SA(0, 0), a2, voffA);
            PG8_WAIT_V(8); PG8_WAIT_L(0); PG8_BAR; PG8_MMA(1, 0, At, B0); PG8_MMA(1, 1, At, B1); PG8_BAR; PG8_SCHED;
            PG8_LDB(B0, 1, 0); PG8_LDB(B1, 1, 1); PG8_SCHED; PG8_LDA(At, 1, 0); PG8_STAGE(PG8_SA(0, 1), a2 + hstep, voffA);
            PG8_WAIT_V(8); PG8_WAIT_L(0); PG8_BAR; PG8_MMA(0, 0, At, B0); PG8_MMA(0, 1, At, B1); PG8_BAR; PG8_SCHED;
            PG8_LDA(At, 1, 1); PG8_STAGE(PG8_SB(1, 0), b3, voffB); PG8_STAGE(PG8_SB(1, 1), b3 + hstep, voffB); PG8_STAGE(PG8_SA(1, 0), a3, voffA);
            PG8_WAIT_V(8); PG8_WAIT_L(0); PG8_BAR; PG8_MMA(1, 0, At, B0); PG8_MMA(1, 1, At, B1); PG8_BAR; PG8_SCHED;
            } else {
            PG8_LDB(B0, 0, 0); PG8_SCHED; PG8_LDA(At, 0, 0); PG8_STAGE(PG8_SA(1, 1), a1 + hstep, voffA);
            PG8_WAIT_L(8); PG8_BAR; PG8_WAIT_L(0); PG8_MMA(0, 0, At, B0); PG8_BAR; PG8_SCHED;
            PG8_LDB(B1, 0, 1); PG8_STAGE(PG8_SB(0, 0), b2, voffB);
            PG8_BAR; PG8_WAIT_L(0); PG8_MMA(0, 1, At, B1); PG8_BAR;
            PG8_LDA(At, 0, 1); PG8_STAGE(PG8_SA(0, 0), a2, voffA);
            PG8_BAR; PG8_WAIT_L(0); PG8_MMA(1, 0, At, B0); PG8_BAR; PG8_SCHED;
            PG8_STAGE(PG8_SB(0, 1), b2 + hstep, voffB);
            PG8_WAIT_V(6); PG8_BAR; PG8_MMA(1, 1, At, B1); PG8_BAR;
            PG8_LDB(B0, 1, 0); PG8_SCHED; PG8_LDA(At, 1, 0); PG8_STAGE(PG8_SA(0, 1), a2 + hstep, voffA);
            PG8_WAIT_L(8); PG8_BAR; PG8_WAIT_L(0); PG8_MMA(0, 0, At, B0); PG8_BAR; PG8_SCHED;
            PG8_LDB(B1, 1, 1); PG8_STAGE(PG8_SB(1, 0), b3, voffB);
            PG8_BAR; PG8_WAIT_L(0); PG8_MMA(0, 1, At, B1); PG8_BAR;
            PG8_LDA(At, 1, 1); PG8_STAGE(PG8_SA(1, 0), a3, voffA);
            PG8_BAR; PG8_WAIT_L(0); PG8_MMA(1, 0, At, B0); PG8_BAR; PG8_SCHED;
            PG8_STAGE(PG8_SB(1, 1), b3 + hstep, voffB);
            PG8_WAIT_V(6); PG8_BAR; PG8_MMA(1, 1, At, B1); PG8_BAR;
            }
        }
        if constexpr (ALIGN_EPI) { if (wr == 0) PG8_BAR; }
        if constexpr (!Epi::AFTER_DRAIN) { E(acc, cur, wr, wc, fr, fq); S.done(cur); }
        if (!has_next) break;
#pragma unroll
        for (int a = 0; a < 2; ++a)
#pragma unroll
            for (int b = 0; b < 2; ++b)
#pragma unroll
                for (int m = 0; m < 4; ++m)
#pragma unroll
                    for (int n = 0; n < 2; ++n) acc[a][b][m][n] = (f32x4){0.f, 0.f, 0.f, 0.f};
        cur = nxt; cA = nA; cB = nB; ++ui;
        if constexpr (ALIGN_EPI) { if (wr == 1) PG8_BAR; }
    }
    PG8_WAIT_V(0);
    if constexpr (!ALIGN_EPI) { if (wr == 0) PG8_BAR; }
    PG8_BAR;
    if constexpr (Epi::AFTER_DRAIN) { E.fused(acc, cur, wr, wc, fr, fq, lds, wid, lane); S.done(cur); }
#undef PG8_SA
#undef PG8_SB
#undef PG8_STAGE
#undef PG8_LDA
#undef PG8_LDB
#undef PG8_MMA
#undef PG8_WAIT_V
#undef PG8_WAIT_L
#undef PG8_BAR
#undef PG8_SCHED
}
}
constexpr int NWAVES = 8, NTHR = 512;
constexpr int BATCH = 8, SEQ = 4096, DM = 1024, CTXL = 256, DEPTH = 4;
constexpr int MLAT = BATCH * SEQ, MCTX = BATCH * CTXL, MTOT = MLAT + MCTX;
constexpr int NP_EVEN = 3584, NPAD_EVEN = 3840, NORIG_EVEN = 3616;
constexpr int NP_ODD = 2816, NPAD_ODD = 3072, NORIG_ODD = 2832;
constexpr int NCHUNK = 68;
constexpr int NSLOT = BATCH * 4 * 2 * NCHUNK;
constexpr float ALPHA_DN = 1.681792830507429f;
constexpr size_t MiB = 1u << 20;
constexpr size_t WS_MOD = 0;
constexpr size_t WS_BAR = 512 * 1024;
constexpr size_t WS_ROPE = 1 * MiB;
constexpr size_t WS_SC = WS_ROPE + 65536;
constexpr size_t WS_GAM = 2 * MiB;
constexpr size_t WS_SM = 4 * MiB;
constexpr size_t WS_WIE = 9 * MiB;
constexpr size_t WS_WIO = 24 * MiB;
constexpr size_t WS_WO = 36 * MiB;
constexpr size_t WS_XC = 44 * MiB;
constexpr size_t WS_H = 52 * MiB;
constexpr size_t WS_P = 120 * MiB;
constexpr size_t WS_S = 359 * MiB;
constexpr size_t WS_END = WS_S + (size_t)NSLOT * 8192 * 2;
static_assert(WS_SC + (size_t)NSLOT * 16 <= WS_GAM && WS_GAM + (size_t)NSLOT * 256 <= WS_SM && WS_SM + (size_t)MTOT * 128 <= WS_WIE, "ws map 1");
static_assert(WS_WIE + (size_t)2 * NPAD_EVEN * 1024 * 2 <= WS_WIO && WS_WIO + (size_t)2 * NPAD_ODD * 1024 * 2 <= WS_WO && WS_WO + (size_t)4 * 1024 * 1024 * 2 <= WS_XC, "ws map 2");
static_assert(WS_XC + (size_t)MCTX * 1024 * 4 <= WS_H && WS_H + (size_t)MTOT * 1024 * 2 <= WS_P && WS_P + (size_t)MTOT * NP_EVEN * 2 <= WS_S && WS_END <= 512 * MiB, "ws map 3");
constexpr int LDS_BYTES = 147456;

#define LAS __attribute__((address_space(3)))
typedef unsigned short bf16;
typedef float f32x4 __attribute__((ext_vector_type(4)));
typedef short bf16x8 __attribute__((ext_vector_type(8)));
typedef short s16x4 __attribute__((ext_vector_type(4)));
typedef unsigned u32x4 __attribute__((ext_vector_type(4)));
typedef unsigned u32x2 __attribute__((ext_vector_type(2)));
#define LDS_WAIT() asm volatile("s_waitcnt lgkmcnt(0)" ::: "memory")

typedef __bf16 hbf2 __attribute__((ext_vector_type(2)));
typedef float f32x2_ __attribute__((ext_vector_type(2)));
__device__ __forceinline__ unsigned f2bf(float f) { const __bf16 b = (__bf16)f; return (unsigned)__builtin_bit_cast(unsigned short, b); }
__device__ __forceinline__ unsigned pk2(float lo, float hi) { const f32x2_ v = {lo, hi}; const hbf2 b = __builtin_convertvector(v, hbf2); return __builtin_bit_cast(unsigned, b); }
__device__ __forceinline__ float bf2f(unsigned short v) { return __builtin_bit_cast(float, (unsigned)v << 16); }
__device__ __forceinline__ float bflo(unsigned w) { return __builtin_bit_cast(float, w << 16); }
__device__ __forceinline__ float bfhi(unsigned w) { return __builtin_bit_cast(float, w & 0xffff0000u); }
__device__ __forceinline__ float siluf(float x) { return x * __builtin_amdgcn_rcpf(1.f + __expf(-x)); }
__device__ __forceinline__ float logsigf(float z) { return fminf(z, 0.f) - __logf(1.f + __expf(-fabsf(z))); }
template <int N> __device__ __forceinline__ float dpp_ror(float v) { return __builtin_bit_cast(float, __builtin_amdgcn_update_dpp(0, __builtin_bit_cast(int, v), 0x120 + N, 0xf, 0xf, false)); }
__device__ __forceinline__ float red16_max(float v) { v = fmaxf(v, dpp_ror<1>(v)); v = fmaxf(v, dpp_ror<2>(v)); v = fmaxf(v, dpp_ror<4>(v)); v = fmaxf(v, dpp_ror<8>(v)); return v; }
__device__ __forceinline__ float red16_sum(float v) { v += dpp_ror<1>(v); v += dpp_ror<2>(v); v += dpp_ror<4>(v); v += dpp_ror<8>(v); return v; }
__device__ __forceinline__ float wave_sum(float v) {
#pragma unroll
    for (int o = 1; o < 64; o <<= 1) v += __shfl_xor(v, o);
    return v;
}
__device__ __forceinline__ float wave_max(float v) {
#pragma unroll
    for (int o = 1; o < 64; o <<= 1) v = fmaxf(v, __shfl_xor(v, o));
    return v;
}
__device__ __forceinline__ float wave_scan_sum(float v, int lane, bool rev) {
#pragma unroll
    for (int o = 1; o < 64; o <<= 1) { const float t = rev ? __shfl_down(v, o) : __shfl_up(v, o); if (rev ? (lane + o < 64) : (lane >= o)) v += t; }
    return v;
}
__device__ __forceinline__ float wave_scan_max(float v, int lane, bool rev) {
#pragma unroll
    for (int o = 1; o < 64; o <<= 1) { const float t = rev ? __shfl_down(v, o) : __shfl_up(v, o); if (rev ? (lane + o < 64) : (lane >= o)) v = fmaxf(v, t); }
    return v;
}
#define MFMA(a, b, c) __builtin_amdgcn_mfma_f32_16x16x32_bf16((a), (b), (c), 0, 0, 0)
__device__ __forceinline__ bf16x8 frag_rm(const LAS bf16* X, int ld, int row0, int k0, int lane) {
    return *(const LAS bf16x8*)(X + (row0 + (lane & 15)) * ld + k0 + 8 * (lane >> 4));
}
__device__ __forceinline__ bf16x8 frag_tr(const LAS bf16* X, int ld, int k0, int n0, int lane) {
    const int g = lane >> 4, m = lane & 15, q = m >> 2, p = m & 3;
    const LAS bf16* a0 = X + (k0 + 8 * g + q) * ld + n0 + 4 * p;
    const s16x4 lo = __builtin_amdgcn_ds_read_tr16_b64_v4i16((LAS s16x4*)a0);
    const s16x4 hi = __builtin_amdgcn_ds_read_tr16_b64_v4i16((LAS s16x4*)(a0 + 4 * ld));
    bf16x8 r; r[0] = lo[0]; r[1] = lo[1]; r[2] = lo[2]; r[3] = lo[3]; r[4] = hi[0]; r[5] = hi[1]; r[6] = hi[2]; r[7] = hi[3]; return r;
}

struct Params {
    const float *x, *c, *ctx, *c_ctx, *w_ada, *b_ada, *ln_g, *ln_b, *w_in_even, *w_out_even, *gla_gate_w, *gla_gate_b, *gla_norm_g, *na_rpb, *w_in_odd, *w_out_odd, *ml_gate_b, *ml_norm_g, *sw_sink;
    float* out; unsigned char* ws; long long ph_lo, ph_hi;
};
typedef const __attribute__((address_space(4))) Params* KP;
__device__ __forceinline__ KP kparams() { unsigned long long v = (unsigned long long)__builtin_amdgcn_kernarg_segment_ptr(); asm volatile("" : "+s"(v)); return (KP)v; }

__device__ __forceinline__ int orig_col(int type, int n) {
    if (type == 0) { if (n < 1536) return n; if (n < 3584) return n + 32; if (n < 3616) return n - 3584 + 1536; return -1; }
    if (type == 1) { if (n < 1536) return n; if (n < 2816) return n + 16; if (n < 2832) return n - 2816 + 1536; return -1; }
    return n;
}
__device__ __forceinline__ float col_scale(int type, int n) {
    if (type == 0) return (n < 256 || (n >= 1536 && n < 2048)) ? 0.125f : 1.f;
    if (type == 1) return ((n >= 256 && n < 512) || (n >= 1536 && n < 2048)) ? 0.125f : 1.f;
    return 1.f;
}
__device__ __forceinline__ void p0_transpose_item(const float* __restrict__ W, int K, int Norig, int type, bf16* __restrict__ WT, LAS float* scr, int nblk, int item, int lane) {
    const int kb = item / nblk, nb = item % nblk, k0 = 64 * kb, n0 = 32 * nb;
    const int oc = orig_col(type, n0 + (lane & 31)); const float sc = col_scale(type, n0 + (lane & 31));
#pragma unroll 8
    for (int i = 0; i < 32; ++i) { const int kk = 2 * i + (lane >> 5); scr[kk * 33 + (lane & 31)] = oc >= 0 ? W[(size_t)(k0 + kk) * Norig + oc] * sc : 0.f; }
    LDS_WAIT();
    const int c = lane & 7;
#pragma unroll
    for (int j = 0; j < 4; ++j) { const int n = (lane >> 3) + 8 * j; const LAS float* s = scr + (8 * c) * 33 + n;
        u32x4 o; o.x = pk2(s[0 * 33], s[1 * 33]); o.y = pk2(s[2 * 33], s[3 * 33]); o.z = pk2(s[4 * 33], s[5 * 33]); o.w = pk2(s[6 * 33], s[7 * 33]);
        *(u32x4*)(WT + (size_t)(n0 + n) * K + k0 + 8 * c) = o; }
    LDS_WAIT();
}
__device__ __forceinline__ void phase_prologue(KP p, LAS unsigned char* lds) {
    const int tid = otid(), lane = tid & 63, wave = tid >> 6;
    unsigned char* ws = p->ws;
    float* MOD = (float*)(ws + WS_MOD);
    if ((int)blockIdx.x < 192) {
        LAS float* cond = (LAS float*)lds;
        LAS float* red = (LAS float*)(lds + 36864);
        for (int e = tid; e < 9 * 1024; e += NTHR) { const int j = e >> 10, k = e & 1023; const float v = j < 8 ? p->c[j * 1024 + k] : p->c_ctx[k]; cond[e] = siluf(v); }
        __syncthreads();
        for (int it = blockIdx.x; it < 192; it += gridDim.x) {
            const int l = it / 48, n0 = (it % 48) * 64, cq = tid & 15, ks = tid >> 4;
            float acc[9][4];
#pragma unroll
            for (int j = 0; j < 9; ++j) { acc[j][0] = 0.f; acc[j][1] = 0.f; acc[j][2] = 0.f; acc[j][3] = 0.f; }
            const float* wp = p->w_ada + (size_t)l * 1024 * 3072 + (size_t)(ks * 32) * 3072 + n0 + 4 * cq;
#pragma unroll 4
            for (int kk = 0; kk < 32; ++kk) { const f32x4 w = *(const f32x4*)(wp + (size_t)kk * 3072);
#pragma unroll
                for (int j = 0; j < 9; ++j) { const float cv = cond[j * 1024 + ks * 32 + kk]; acc[j][0] += cv * w[0]; acc[j][1] += cv * w[1]; acc[j][2] += cv * w[2]; acc[j][3] += cv * w[3]; } }
#pragma unroll
            for (int j = 0; j < 9; ++j)
#pragma unroll
                for (int i = 0; i < 4; ++i) red[ks * 576 + j * 64 + 4 * cq + i] = acc[j][i];
            __syncthreads();
            for (int o = tid; o < 576; o += NTHR) { float s = 0.f; for (int q = 0; q < 32; ++q) s += red[q * 576 + o]; const int j = o >> 6, n = n0 + (o & 63);
                MOD[(size_t)(l * 9 + j) * 3072 + n] = s + p->b_ada[l * 3072 + n]; }
            __syncthreads();
        }
    }
    if (blockIdx.x == gridDim.x - 1) {
        float* cosT = (float*)(ws + WS_ROPE); float* sinT = cosT + 1024;
        for (int e = tid; e < 1024; e += NTHR) { const int pos = e >> 4, i = e & 15;
            double f = 1.0; for (int q = 0; q < i; ++q) f *= 0.5623413251903491;
            const double f2 = f * f; double sn = 1.0, cs = 1.0;
            for (int q = 12; q >= 1; --q) { sn = 1.0 - f2 / ((2.0 * q) * (2.0 * q + 1.0)) * sn; cs = 1.0 - f2 / ((2.0 * q - 1.0) * (2.0 * q)) * cs; }
            sn *= f;
            double c = 1.0, s = 0.0; for (int q = 0; q < pos; ++q) { const double c2 = c * cs - s * sn, s2 = s * cs + c * sn; c = c2; s = s2; }
            cosT[e] = (float)c; sinT[e] = (float)s; }
    }
    __syncthreads();
    {
        LAS float* scr = (LAS float*)(lds + wave * 16384);
        const int gw = blockIdx.x * NWAVES + wave, NGW = gridDim.x * NWAVES;
        constexpr int I_E = 16 * (NPAD_EVEN / 32), I_O = 16 * (NPAD_ODD / 32), I_W = 16 * 32;
        constexpr int NIT = 2 * I_E + 2 * I_O + 4 * I_W;
        for (int it = gw; it < NIT; it += NGW) {
            int r = it;
            if (r < 2 * I_E) { const int i = r / I_E; r -= i * I_E; p0_transpose_item(p->w_in_even + (size_t)i * 1024 * NORIG_EVEN, 1024, NORIG_EVEN, 0, (bf16*)(ws + WS_WIE) + (size_t)i * NPAD_EVEN * 1024, scr, NPAD_EVEN / 32, r, lane); continue; }
            r -= 2 * I_E;
            if (r < 2 * I_O) { const int i = r / I_O; r -= i * I_O; p0_transpose_item(p->w_in_odd + (size_t)i * 1024 * NORIG_ODD, 1024, NORIG_ODD, 1, (bf16*)(ws + WS_WIO) + (size_t)i * NPAD_ODD * 1024, scr, NPAD_ODD / 32, r, lane); continue; }
            r -= 2 * I_O;
            { const int l = r / I_W; r -= l * I_W; const float* W = (l & 1) ? p->w_out_odd + (size_t)(l >> 1) * 1024 * 1024 : p->w_out_even + (size_t)(l >> 1) * 1024 * 1024;
              p0_transpose_item(W, 1024, 1024, 2, (bf16*)(ws + WS_WO) + (size_t)l * 1024 * 1024, scr, 32, r, lane); }
        }
    }
}
__device__ __forceinline__ void phase_h0(KP p) {
    const int lane = otid() & 63, gw = blockIdx.x * NWAVES + (otid() >> 6), NGW = gridDim.x * NWAVES;
    const float* MOD = (const float*)(p->ws + WS_MOD); bf16* H = (bf16*)(p->ws + WS_H);
    for (int m = gw; m < MTOT; m += NGW) {
        const int jb = m < MLAT ? (m >> 12) : 8;
        const float* src = m < MLAT ? p->x + (size_t)m * DM : p->ctx + (size_t)(m - MLAT) * DM;
        const float* md = MOD + (size_t)jb * 3072;
#pragma unroll
        for (int j = 0; j < 4; ++j) { const int k = 4 * lane + 256 * j; const f32x4 v = *(const f32x4*)(src + k), sh = *(const f32x4*)(md + k), sc = *(const f32x4*)(md + 1024 + k);
            const f32x4 h = v * (sc + 1.0f) + sh; u32x2 o; o.x = pk2(h[0], h[1]); o.y = pk2(h[2], h[3]); *(u32x2*)(H + (size_t)m * DM + k) = o; }
    }
}
__device__ __forceinline__ void phase_ln(KP p, int l, bool dummy = false) {
    const int lane = otid() & 63, gw = blockIdx.x * NWAVES + (otid() >> 6), NGW = gridDim.x * NWAVES;
    const float* MOD = (const float*)(p->ws + WS_MOD); bf16* H = (bf16*)(p->ws + WS_H); const bf16* Y = (const bf16*)(p->ws + WS_P); float* XC = (float*)(p->ws + WS_XC);
    const int mrows = l < DEPTH - 1 ? MTOT : MLAT;
    const float* lg = p->ln_g + l * DM; const float* lb = p->ln_b + l * DM;
    const float* xin = p->x; const float* cin = p->ctx; float* outp = p->out;
    for (int m0 = 2 * gw; m0 < mrows; m0 += 2 * NGW) {
        const int jb = m0 < MLAT ? (m0 >> 12) : 8;
        const float* md = MOD + (size_t)(l * 9 + jb) * 3072;
        const float* src[2]; float* dst[2]; f32x4 v[2][4]; float s[2] = {0.f, 0.f};
#pragma unroll
        for (int q = 0; q < 2; ++q) { const int m = m0 + q;
            src[q] = l == 0 ? (m < MLAT ? xin + (size_t)m * DM : cin + (size_t)(m - MLAT) * DM) : (m < MLAT ? outp + (size_t)m * DM : XC + (size_t)(m - MLAT) * DM);
            dst[q] = m < MLAT ? outp + (size_t)m * DM : XC + (size_t)(m - MLAT) * DM; }
#pragma unroll
        for (int j = 0; j < 4; ++j) { const int k = 4 * lane + 256 * j; const f32x4 g = *(const f32x4*)(md + 2048 + k);
#pragma unroll
            for (int q = 0; q < 2; ++q) { const f32x4 xv = *(const f32x4*)(src[q] + k); const u32x2 yw = *(const u32x2*)(Y + (size_t)(m0 + q) * DM + k);
                f32x4 y; y[0] = bflo(yw.x); y[1] = bfhi(yw.x); y[2] = bflo(yw.y); y[3] = bfhi(yw.y);
                v[q][j] = xv * ALPHA_DN + g * y; s[q] += (v[q][j][0] + v[q][j][1]) + (v[q][j][2] + v[q][j][3]); } }
        float rstd[2];
#pragma unroll
        for (int q = 0; q < 2; ++q) { const float mean = wave_sum(s[q]) * (1.f / DM); float s2 = 0.f;
#pragma unroll
            for (int j = 0; j < 4; ++j) { v[q][j] = v[q][j] - mean; s2 += (v[q][j][0] * v[q][j][0] + v[q][j][1] * v[q][j][1]) + (v[q][j][2] * v[q][j][2] + v[q][j][3] * v[q][j][3]); }
            rstd[q] = 1.f / sqrtf(wave_sum(s2) * (1.f / DM) + 1e-5f); }
        const float* md2 = MOD + (size_t)((l + 1) * 9 + jb) * 3072;
#pragma unroll
        for (int j = 0; j < 4; ++j) { const int k = 4 * lane + 256 * j; const f32x4 gg = *(const f32x4*)(lg + k), bb = *(const f32x4*)(lb + k);
            f32x4 sh = (f32x4){0.f, 0.f, 0.f, 0.f}, sc = sh; if (l < DEPTH - 1) { sh = *(const f32x4*)(md2 + k); sc = *(const f32x4*)(md2 + 1024 + k); }
#pragma unroll
            for (int q = 0; q < 2; ++q) { const f32x4 o = v[q][j] * rstd[q] * gg + bb;
                *(f32x4*)(dst[q] + k) = dummy ? *(const f32x4*)(src[q] + k) : o;
                if (l < DEPTH - 1) { const f32x4 h = o * (sc + 1.0f) + sh; u32x2 w; w.x = pk2(h[0], h[1]); w.y = pk2(h[2], h[3]); *(u32x2*)(H + (size_t)(m0 + q) * DM + k) = w; } } }
    }
}
constexpr int AT_KS = 0, AT_VS = 9216, AT_BUF = 18432, AT_PS = 36864, AT_RPB = AT_PS + 8 * 2304;
__device__ __forceinline__ bf16x8 frag_tr_perm(const LAS bf16* X, int ld, int k0, int n0, int lane) {
    const int g = lane >> 4, m = lane & 15, q = m >> 2, p = m & 3;
    const LAS bf16* a0 = X + (k0 + 4 * g + q) * ld + n0 + 4 * p;
    const s16x4 lo = __builtin_amdgcn_ds_read_tr16_b64_v4i16((LAS s16x4*)a0);
    const s16x4 hi = __builtin_amdgcn_ds_read_tr16_b64_v4i16((LAS s16x4*)(a0 + 16 * ld));
    bf16x8 r; r[0] = lo[0]; r[1] = lo[1]; r[2] = lo[2]; r[3] = lo[3]; r[4] = hi[0]; r[5] = hi[1]; r[6] = hi[2]; r[7] = hi[3]; return r;
}
__device__ __forceinline__ void attn_tile(const LAS bf16* Ks, const LAS bf16* Vs, const LAS float* rpb, const bf16x8 (&qa)[2][2], float (&mrow)[2], float (&lsum)[2], f32x4 (&oacc)[2][4],
                                          int mode, int i, int nlat, int qa_, int qb_, int ka_, int lane) {
    const int fq = lane >> 4, fr = lane & 15;
    const bool islat = i < nlat;
    bool active = true; int kt0 = 0;
    if (islat) {
        if (mode == 0) { kt0 = ka_ + i; const int rs = min(max(qa_ - 4, 0), 56); active = (kt0 >= rs) && (kt0 < rs + 8); }
        else { kt0 = ka_ + 64 * i; active = !(kt0 > qa_ + 31 + 128 || kt0 + 63 < qa_ - 128); }
    }
    if (!active) return;
    const bool nar = islat && mode == 0;
    const int ct0 = qb_ >> 4;
    int ntlo[2], nthi[2];
#pragma unroll
    for (int nq = 0; nq < 2; ++nq) { const int ct = ct0 + nq; ntlo[nq] = nar ? (ct < 2 ? 0 : ct - 1) : 0; nthi[nq] = nar ? (ct > 1 ? 3 : ct + 1) : 3; }
    const int ulo = min(ntlo[0], ntlo[1]), uhi = max(nthi[0], nthi[1]);
    f32x4 s[2][4];
#pragma unroll
    for (int mt = 0; mt < 4; ++mt) { s[0][mt] = (f32x4){0.f, 0.f, 0.f, 0.f}; s[1][mt] = (f32x4){0.f, 0.f, 0.f, 0.f};
        if (mt >= ulo && mt <= uhi) {
#pragma unroll
            for (int ks = 0; ks < 2; ++ks) { const bf16x8 kf = frag_rm(Ks, 72, 16 * mt, 32 * ks, lane);
                if (mt >= ntlo[0] && mt <= nthi[0]) s[0][mt] = MFMA(kf, qa[0][ks], s[0][mt]);
                if (mt >= ntlo[1] && mt <= nthi[1]) s[1][mt] = MFMA(kf, qa[1][ks], s[1][mt]); } } }
    unsigned pw[2][8];
#pragma unroll
    for (int nq = 0; nq < 2; ++nq) {
        float tmax = -3e38f;
#pragma unroll
        for (int mt = 0; mt < 4; ++mt) { if (mt >= ntlo[nq] && mt <= nthi[nq]) {
#pragma unroll
            for (int r = 0; r < 4; ++r) { float v = s[nq][mt][r]; const int kk = 16 * mt + 4 * fq + r;
                if (islat) {
                    if (mode == 0) { const int qc = qb_ + 16 * nq + fr, cs = min(max(qc - 8, 0), 48); const bool ok = (kk >= cs) && (kk < cs + 16);
                        const int bi = (kt0 - qa_ + 7) * 31 + (kk - qc + 15); v = ok ? v + rpb[ok ? bi : 0] : -3e38f; }
                    else { const int d = (qa_ + 16 * nq + fr) - (kt0 + kk); v = (d <= 128 && d >= -128) ? v : -3e38f; }
                }
                s[nq][mt][r] = v; tmax = fmaxf(tmax, v); } } }
        tmax = fmaxf(tmax, __shfl_xor(tmax, 16)); tmax = fmaxf(tmax, __shfl_xor(tmax, 32));
        const float mnew = fmaxf(mrow[nq], tmax); const float alpha = __expf(mrow[nq] - mnew); mrow[nq] = mnew;
        float ps = 0.f;
#pragma unroll
        for (int mt = 0; mt < 4; ++mt) { float p0 = 0.f, p1 = 0.f, p2 = 0.f, p3 = 0.f;
            if (mt >= ntlo[nq] && mt <= nthi[nq]) { p0 = __expf(s[nq][mt][0] - mnew); p1 = __expf(s[nq][mt][1] - mnew); p2 = __expf(s[nq][mt][2] - mnew); p3 = __expf(s[nq][mt][3] - mnew); ps += (p0 + p1) + (p2 + p3); }
            pw[nq][2 * mt] = pk2(p0, p1); pw[nq][2 * mt + 1] = pk2(p2, p3); oacc[nq][mt] = oacc[nq][mt] * alpha; }
        lsum[nq] = lsum[nq] * alpha + ps;
    }
#pragma unroll
    for (int ks = 0; ks < 2; ++ks) { if (ks == 0 ? (ulo < 2) : (uhi > 1)) {
        const u32x4 pu0 = (u32x4){pw[0][4 * ks], pw[0][4 * ks + 1], pw[0][4 * ks + 2], pw[0][4 * ks + 3]}, pu1 = (u32x4){pw[1][4 * ks], pw[1][4 * ks + 1], pw[1][4 * ks + 2], pw[1][4 * ks + 3]};
        const bf16x8 pb0 = __builtin_bit_cast(bf16x8, pu0), pb1 = __builtin_bit_cast(bf16x8, pu1);
#pragma unroll
        for (int mt = 0; mt < 4; ++mt) { const bf16x8 vf = frag_tr_perm(Vs, 72, 32 * ks, 16 * mt, lane); oacc[0][mt] = MFMA(vf, pb0, oacc[0][mt]); oacc[1][mt] = MFMA(vf, pb1, oacc[1][mt]); } } }
}
constexpr int AT_PSW = 32 * 72 * 2;
constexpr int AT_RPB2 = AT_PS + 8 * AT_PSW;
__device__ __forceinline__ void attn_item(LAS unsigned char* lds, const bf16* __restrict__ P, int ldp, bf16* __restrict__ Z, int mode,
                                          int qrow0, int qcol, int kcol, int vcol, int gcol, int zcol,
                                          int nlat, int lat_row0, int ctx_row0, int qa_, int qb_, int ka_, const float* __restrict__ rpb_g, float sink) {
    const int tid = otid(), lane = tid & 63, wave = tid >> 6, fq = lane >> 4, fr = lane & 15;
    LAS bf16* Ks0 = (LAS bf16*)(lds + AT_KS); LAS bf16* Vs0 = (LAS bf16*)(lds + AT_VS); LAS bf16* Ks1 = (LAS bf16*)(lds + AT_KS + AT_BUF); LAS bf16* Vs1 = (LAS bf16*)(lds + AT_VS + AT_BUF);
    LAS bf16* Ps = (LAS bf16*)(lds + AT_PS + wave * AT_PSW); LAS float* rpb = (LAS float*)(lds + AT_RPB2);
    const int ntile = nlat + 4, srow = tid >> 3, sch = tid & 7, soff = srow * 72 + 8 * sch;
#define AT_ROWB(j) (((j) < nlat) ? lat_row0 + 64 * (j) : ctx_row0 + 64 * ((j) - nlat))
#define AT_LOAD(kr, vr, j) do { const size_t ro_ = (size_t)(AT_ROWB(j) + srow) * ldp + 8 * sch; kr = *(const u32x4*)(P + ro_ + kcol); vr = *(const u32x4*)(P + ro_ + vcol); } while (0)
    u32x4 k0, v0, k1, v1;
    AT_LOAD(k0, v0, 0);
    bf16x8 qa[2][2];
#pragma unroll
    for (int nq = 0; nq < 2; ++nq)
#pragma unroll
        for (int ks = 0; ks < 2; ++ks) qa[nq][ks] = *(const bf16x8*)(P + (size_t)(qrow0 + 16 * nq + fr) * ldp + qcol + 32 * ks + 8 * fq);
    __syncthreads();
    if (mode == 0) { for (int e = tid; e < 465; e += NTHR) rpb[e] = rpb_g[e]; }
    *(LAS u32x4*)(Ks0 + soff) = k0; *(LAS u32x4*)(Vs0 + soff) = v0;
    AT_LOAD(k0, v0, 1);
    AT_LOAD(k1, v1, 2);
    float mrow[2] = {-1e30f, -1e30f}, lsum[2] = {0.f, 0.f}; f32x4 oacc[2][4];
#pragma unroll
    for (int nq = 0; nq < 2; ++nq)
#pragma unroll
        for (int r = 0; r < 4; ++r) oacc[nq][r] = (f32x4){0.f, 0.f, 0.f, 0.f};
    __syncthreads();
    for (int i = 0; i < ntile; i += 2) {
        attn_tile(Ks0, Vs0, rpb, qa, mrow, lsum, oacc, mode, i, nlat, qa_, qb_, ka_, lane);
        if (i + 1 < ntile) { *(LAS u32x4*)(Ks1 + soff) = k0; *(LAS u32x4*)(Vs1 + soff) = v0; }
        if (i + 3 < ntile) AT_LOAD(k0, v0, i + 3);
        __syncthreads();
        if (i + 1 >= ntile) break;
        attn_tile(Ks1, Vs1, rpb, qa, mrow, lsum, oacc, mode, i + 1, nlat, qa_, qb_, ka_, lane);
        if (i + 2 < ntile) { *(LAS u32x4*)(Ks0 + soff) = k1; *(LAS u32x4*)(Vs0 + soff) = v1; }
        if (i + 4 < ntile) AT_LOAD(k1, v1, i + 4);
        __syncthreads();
    }
#undef AT_LOAD
#undef AT_ROWB
    u32x4 gvv[4];
#pragma unroll
    for (int c2 = 0; c2 < 4; ++c2) { const int idx = lane + 64 * c2, q = idx >> 3, ch = idx & 7; gvv[c2] = *(const u32x4*)(P + (size_t)(qrow0 + q) * ldp + gcol + 8 * ch); }
#pragma unroll
    for (int nq = 0; nq < 2; ++nq) { float lt = lsum[nq]; lt += __shfl_xor(lt, 16); lt += __shfl_xor(lt, 32); float sc;
      if (mode == 1 || mode == 3) { const float mf = fmaxf(mrow[nq], sink); const float al = __expf(mrow[nq] - mf); lt = lt * al + __expf(sink - mf); sc = al / lt; } else sc = 1.f / lt;
#pragma unroll
      for (int mt = 0; mt < 4; ++mt) { u32x2 w; w.x = pk2(oacc[nq][mt][0] * sc, oacc[nq][mt][1] * sc); w.y = pk2(oacc[nq][mt][2] * sc, oacc[nq][mt][3] * sc); *(LAS u32x2*)(Ps + (16 * nq + fr) * 72 + 16 * mt + 4 * fq) = w; } }
    LDS_WAIT();
#pragma unroll
    for (int c2 = 0; c2 < 4; ++c2) { const int idx = lane + 64 * c2, q = idx >> 3, ch = idx & 7;
        const u32x4 ov = *(const LAS u32x4*)(Ps + q * 72 + 8 * ch); const u32x4 gv = gvv[c2];
        u32x4 w;
        w.x = pk2(bflo(ov.x) * siluf(bflo(gv.x)), bfhi(ov.x) * siluf(bfhi(gv.x))); w.y = pk2(bflo(ov.y) * siluf(bflo(gv.y)), bfhi(ov.y) * siluf(bfhi(gv.y)));
        w.z = pk2(bflo(ov.z) * siluf(bflo(gv.z)), bfhi(ov.z) * siluf(bfhi(gv.z))); w.w = pk2(bflo(ov.w) * siluf(bflo(gv.w)), bfhi(ov.w) * siluf(bfhi(gv.w)));
        *(u32x4*)(Z + (size_t)(qrow0 + q) * DM + zcol + 8 * ch) = w; }
    LDS_WAIT();
}
__device__ __forceinline__ void phase_attn(KP p, LAS unsigned char* lds, int l, bool need_ctx) {
    const int wave = otid() >> 6; const bool odd = l & 1; const int li = l >> 1;
    const bf16* P = (const bf16*)(p->ws + WS_P); bf16* Z = (bf16*)(p->ws + WS_H); const int ldp = odd ? NP_ODD : NP_EVEN;
    const int nmain = BATCH * 8 * 16, nctx = need_ctx ? BATCH * 8 : 0;
    for (int it = blockIdx.x; it < nmain + nctx; it += gridDim.x) {
        if (it < nmain) {
            const int b = it >> 7, h = (it >> 4) & 7, qb = it & 15;
            if (!odd) { const int r0 = 4 * qb, rw = r0 + (wave >> 1); const int rs0 = min(max(r0 - 4, 0), 56), rs3 = min(max(r0 + 3 - 4, 0), 56);
                attn_item(lds, P, ldp, Z, 0, b * SEQ + rw * 64 + 32 * (wave & 1), 1536 + h * 64, 2048 + h * 64, 2560 + h * 64, 3072 + h * 64, 512 + h * 64,
                          rs3 + 8 - rs0, b * SEQ + rs0 * 64, MLAT + b * CTXL, rw, 32 * (wave & 1), rs0, p->na_rpb + (size_t)(li * 8 + h) * 465, 0.f); }
            else { const int kv = h >> 2, t0 = 256 * qb, lt0 = max(0, 4 * qb - 2), lt1 = min(63, 4 * qb + 5);
                attn_item(lds, P, ldp, Z, 1, b * SEQ + t0 + 32 * wave, 1536 + h * 64, 2048 + kv * 64, 2176 + kv * 64, 2304 + h * 64, 512 + h * 64,
                          lt1 - lt0 + 1, b * SEQ + lt0 * 64, MLAT + b * CTXL, t0 + 32 * wave, 0, lt0 * 64, nullptr, p->sw_sink[li * 8 + h]); }
        } else {
            const int j = it - nmain, b = j >> 3, h = j & 7; const int q0 = MLAT + b * CTXL + 32 * wave;
            if (!odd) attn_item(lds, P, ldp, Z, 2, q0, 1536 + h * 64, 2048 + h * 64, 2560 + h * 64, 3072 + h * 64, 512 + h * 64, 0, 0, MLAT + b * CTXL, 0, 0, 0, nullptr, 0.f);
            else { const int kv = h >> 2; attn_item(lds, P, ldp, Z, 3, q0, 1536 + h * 64, 2048 + kv * 64, 2176 + kv * 64, 2304 + h * 64, 512 + h * 64, 0, 0, MLAT + b * CTXL, 0, 0, 0, nullptr, p->sw_sink[li * 8 + h]); }
        }
    }
}
__device__ __forceinline__ int chunk_row0(int b, int cp) { return cp < 4 ? MLAT + b * CTXL + cp * 64 : b * SEQ + (cp - 4) * 64; }
constexpr int SL_KDF = 0, SL_KDB = 9216, SL_VS = 18432, SL_SEG = 35840, SL_MISC = 39936;
__device__ __forceinline__ void phase_scan_local(KP p, LAS unsigned char* lds, int l) {
    const int tid = otid(), lane = tid & 63, wave = tid >> 6, fq = lane >> 4, fr = lane & 15; const bool odd = l & 1; const int li = l >> 1;
    const bf16* P = (const bf16*)(p->ws + WS_P); const int ldp = odd ? NP_ODD : NP_EVEN; const float* SM = (const float*)(p->ws + WS_SM);
    bf16* S = (bf16*)(p->ws + WS_S); float* GAM = (float*)(p->ws + WS_GAM); float* SC = (float*)(p->ws + WS_SC);
    LAS bf16* kdf = (LAS bf16*)(lds + SL_KDF); LAS bf16* kdb = (LAS bf16*)(lds + SL_KDB); LAS bf16* vs = (LAS bf16*)(lds + SL_VS);
    LAS float* seg = (LAS float*)(lds + SL_SEG); LAS float* misc = (LAS float*)(lds + SL_MISC);
    const int dk = tid & 63, sg = tid >> 6;
    for (int it = blockIdx.x; it < BATCH * 4 * NCHUNK; it += gridDim.x) {
        const int b = it / (4 * NCHUNK), h = (it / NCHUNK) & 3, cp = it % NCHUNK; const int row0 = chunk_row0(b, cp);
        const int slf = ((b * 4 + h) * 2 + 0) * NCHUNK + cp, slb = slf + NCHUNK;
        __syncthreads();
#pragma unroll
        for (int c2 = 0; c2 < 2; ++c2) { const int idx = tid + NTHR * c2, t = idx >> 4, ch = idx & 15; *(LAS u32x4*)(vs + t * 136 + 8 * ch) = *(const u32x4*)(P + (size_t)(row0 + t) * ldp + 512 + h * 128 + 8 * ch); }
        float kv[8];
#pragma unroll
        for (int tt = 0; tt < 8; ++tt) kv[tt] = bf2f(P[(size_t)(row0 + sg * 8 + tt) * ldp + 256 + h * 64 + dk]);
        if (!odd) {
            float gwf[16], gwb[16];
            const float* gw = p->gla_gate_w + (size_t)li * 2 * 16 * 256; const float* gb = p->gla_gate_b + (size_t)li * 2 * 256;
#pragma unroll
            for (int r = 0; r < 16; ++r) { gwf[r] = gw[r * 256 + h * 64 + dk]; gwb[r] = gw[(16 + r) * 256 + h * 64 + dk]; }
            const float gbf = gb[h * 64 + dk], gbb = gb[256 + h * 64 + dk];
            { const int t = tid >> 3, c4 = (tid & 7) * 4; *(LAS f32x4*)(misc + t * 32 + c4) = *(const f32x4*)(SM + (size_t)(row0 + t) * 32 + c4); }
            __syncthreads();
            float pf[8], sb[8];
#pragma unroll
            for (int tt = 0; tt < 8; ++tt) { const LAS float* lr = misc + (sg * 8 + tt) * 32; float zf = gbf, zb = gbb;
#pragma unroll
                for (int r = 0; r < 16; ++r) { zf += lr[r] * gwf[r]; zb += lr[16 + r] * gwb[r]; }
                pf[tt] = logsigf(zf) * 0.0625f; sb[tt] = logsigf(zb) * 0.0625f; }
#pragma unroll
            for (int tt = 1; tt < 8; ++tt) pf[tt] += pf[tt - 1];
#pragma unroll
            for (int tt = 6; tt >= 0; --tt) sb[tt] += sb[tt + 1];
            seg[(0 * 8 + sg) * 64 + dk] = pf[7]; seg[(1 * 8 + sg) * 64 + dk] = sb[0];
            __syncthreads();
            float offf = 0.f, totf = 0.f, offb = 0.f, totb = 0.f;
#pragma unroll
            for (int q = 0; q < 8; ++q) { const float a = seg[q * 64 + dk], c = seg[(8 + q) * 64 + dk]; totf += a; totb += c; if (q < sg) offf += a; if (q > sg) offb += c; }
#pragma unroll
            for (int tt = 0; tt < 8; ++tt) { const int t = sg * 8 + tt;
                kdf[t * 72 + dk] = (bf16)f2bf(kv[tt] * __expf(totf - (offf + pf[tt]))); kdb[t * 72 + dk] = (bf16)f2bf(kv[tt] * __expf(totb - (offb + sb[tt]))); }
            if (sg == 0) { GAM[(size_t)slf * 64 + dk] = __expf(totf); GAM[(size_t)slb * 64 + dk] = __expf(totb); }
        } else {
            const float* mb = p->ml_gate_b + li * 16;
            if (tid < 128) { const int d = tid >> 6, t = tid & 63; const float* gp = SM + (size_t)(row0 + t) * 32 + d * 8;
                misc[d * 128 + t] = gp[h] + mb[d * 8 + h]; misc[d * 128 + 64 + t] = logsigf(gp[4 + h] + mb[d * 8 + 4 + h]); }
            __syncthreads();
            if (tid < 128) { const int d = tid >> 6, t = tid & 63; const float run = wave_scan_sum(misc[d * 128 + 64 + t], t, d == 1);
                const float tot = d == 0 ? __shfl(run, 63) : __shfl(run, 0);
                const float wl = tot - run + misc[d * 128 + t]; const float ml = wave_max(wl);
                misc[256 + d * 64 + t] = __expf(wl - ml);
                if (t == 0) { const int sl = d == 0 ? slf : slb; SC[(size_t)sl * 4 + 0] = tot; SC[(size_t)sl * 4 + 1] = ml; } }
            __syncthreads();
            float nf = 0.f, nb = 0.f;
#pragma unroll
            for (int tt = 0; tt < 8; ++tt) { const int t = sg * 8 + tt; const float a = kv[tt] * misc[256 + t], c = kv[tt] * misc[256 + 64 + t]; nf += a; nb += c;
                kdf[t * 72 + dk] = (bf16)f2bf(a); kdb[t * 72 + dk] = (bf16)f2bf(c); }
            seg[(0 * 8 + sg) * 64 + dk] = nf; seg[(1 * 8 + sg) * 64 + dk] = nb;
            __syncthreads();
            if (sg < 2) { float s2 = 0.f;
#pragma unroll
                for (int q = 0; q < 8; ++q) s2 += seg[(sg * 8 + q) * 64 + dk];
                GAM[(size_t)(sg == 0 ? slf : slb) * 64 + dk] = s2; }
        }
        __syncthreads();
#pragma unroll
        for (int d = 0; d < 2; ++d) { const LAS bf16* kd = d ? kdb : kdf; f32x4 acc[4];
#pragma unroll
            for (int nt = 0; nt < 4; ++nt) acc[nt] = (f32x4){0.f, 0.f, 0.f, 0.f};
#pragma unroll
            for (int ks = 0; ks < 2; ++ks) { const bf16x8 av = frag_tr(vs, 136, 32 * ks, 16 * wave, lane);
#pragma unroll
                for (int nt = 0; nt < 4; ++nt) acc[nt] = MFMA(av, frag_tr(kd, 72, 32 * ks, 16 * nt, lane), acc[nt]); }
            bf16* dst = S + (size_t)(d ? slb : slf) * 8192;
#pragma unroll
            for (int nt = 0; nt < 4; ++nt) { u32x2 w; w.x = pk2(acc[nt][0], acc[nt][1]); w.y = pk2(acc[nt][2], acc[nt][3]); *(u32x2*)(dst + (16 * nt + fr) * 128 + 16 * wave + 4 * fq) = w; } }
    }
}
__device__ __forceinline__ void phase_scan_seq(KP p, int l, bool dummy = false) {
    const bool odd = l & 1;
    u32x2* S2 = (u32x2*)(p->ws + WS_S); float* GAM = (float*)(p->ws + WS_GAM); f32x4* GAM4 = (f32x4*)(p->ws + WS_GAM); float* SC = (float*)(p->ws + WS_SC);
    const int nthreads = gridDim.x * NTHR;
    for (int gid = blockIdx.x * NTHR + otid(); gid < 64 * 2048; gid += nthreads) {
        const int chain = gid >> 11, e4 = gid & 2047, dir = chain & 1, dkk = e4 >> 5; const int base = chain * NCHUNK;
        f32x4 st = (f32x4){0.f, 0.f, 0.f, 0.f}, nst = (f32x4){0.f, 0.f, 0.f, 0.f}; float m = 0.f; const bool hasn = odd && e4 < 16;
        for (int s0 = 0; s0 < NCHUNK; s0 += 4) {
            u32x2 dr[4]; f32x4 dn[4]; float g0[4], g1[4]; int idx[4];
#pragma unroll
            for (int u = 0; u < 4; ++u) { const int step = s0 + u; const int cp = dir == 0 ? step : (step < 4 ? 3 - step : 71 - step); idx[u] = base + cp;
                dr[u] = S2[(size_t)idx[u] * 2048 + e4];
                if (!odd) { g0[u] = GAM[(size_t)idx[u] * 64 + dkk]; g1[u] = 0.f; } else { g0[u] = SC[(size_t)idx[u] * 4 + 0]; g1[u] = SC[(size_t)idx[u] * 4 + 1]; if (hasn) dn[u] = GAM4[(size_t)idx[u] * 16 + e4]; } }
#pragma unroll
            for (int u = 0; u < 4; ++u) {
                const f32x4 d = (f32x4){bflo(dr[u].x), bfhi(dr[u].x), bflo(dr[u].y), bfhi(dr[u].y)};
                u32x2 w; w.x = pk2(st[0], st[1]); w.y = pk2(st[2], st[3]);
                S2[(size_t)idx[u] * 2048 + e4] = dummy ? dr[u] : w;
                if (!odd) { st = st * g0[u] + d; }
                else { if (hasn) GAM4[(size_t)idx[u] * 16 + e4] = dummy ? dn[u] : nst; if (e4 == 0 && !dummy) SC[(size_t)idx[u] * 4 + 2] = m;
                    const float mn = fmaxf(g0[u] + m, g1[u]); const float dec = __expf(g0[u] + m - mn), sc = __expf(g1[u] - mn);
                    st = st * dec + d * sc; if (hasn) nst = nst * dec + dn[u] * sc; m = mn; }
            }
        }
    }
}
constexpr int SO_QF = 0, SO_KF = 9216, SO_QB = 18432, SO_KB = 27648, SO_VS = 36864, SO_AF = 54272, SO_AB = 63488, SO_SF = 72704, SO_SB = 90112, SO_SEG = 107520, SO_SSQ = 111616, SO_MISC = 113664;
constexpr int SO_OST = 0;
__device__ __forceinline__ void scan_out_tail(LAS unsigned char* lds, f32x4 (&o)[4], const bf16* __restrict__ P, int ldp, bf16* __restrict__ Z, int row0, int h, const float* __restrict__ ng) {
    const int tid = otid(), lane = tid & 63, wave = tid >> 6, fq = lane >> 4, fr = lane & 15;
    LAS float* ost = (LAS float*)(lds + SO_OST);
    u32x4 gv[2]; f32x4 g0[2], g1[2];
#pragma unroll
    for (int c2 = 0; c2 < 2; ++c2) { const int idx = tid + NTHR * c2, t = idx >> 4, ch = idx & 15;
        gv[c2] = *(const u32x4*)(P + (size_t)(row0 + t) * ldp + 1024 + h * 128 + 8 * ch); g0[c2] = *(const f32x4*)(ng + h * 128 + 8 * ch); g1[c2] = *(const f32x4*)(ng + h * 128 + 8 * ch + 4); }
    __syncthreads();
#pragma unroll
    for (int mt = 0; mt < 4; ++mt)
#pragma unroll
        for (int r = 0; r < 4; ++r) ost[(16 * mt + 4 * fq + r) * 132 + 16 * wave + fr] = o[mt][r];
    __syncthreads();
#pragma unroll
    for (int c2 = 0; c2 < 2; ++c2) { const int idx = tid + NTHR * c2, t = idx >> 4, ch = idx & 15;
        f32x4 o0 = *(const LAS f32x4*)(ost + t * 132 + 8 * ch), o1 = *(const LAS f32x4*)(ost + t * 132 + 8 * ch + 4);
        const float q = red16_sum((o0[0] * o0[0] + o0[1] * o0[1]) + (o0[2] * o0[2] + o0[3] * o0[3]) + (o1[0] * o1[0] + o1[1] * o1[1]) + (o1[2] * o1[2] + o1[3] * o1[3]));
        const float rs = rsqrtf(q * (1.f / 128.f) + 1e-6f); o0 = o0 * rs * g0[c2]; o1 = o1 * rs * g1[c2];
        u32x4 w;
        w.x = pk2(o0[0] * siluf(bflo(gv[c2].x)), o0[1] * siluf(bfhi(gv[c2].x))); w.y = pk2(o0[2] * siluf(bflo(gv[c2].y)), o0[3] * siluf(bfhi(gv[c2].y)));
        w.z = pk2(o1[0] * siluf(bflo(gv[c2].z)), o1[1] * siluf(bfhi(gv[c2].z))); w.w = pk2(o1[2] * siluf(bflo(gv[c2].w)), o1[3] * siluf(bfhi(gv[c2].w)));
        *(u32x4*)(Z + (size_t)(row0 + t) * DM + h * 128 + 8 * ch) = w; }
}
__device__ __forceinline__ void stage_state(LAS bf16* dst, const bf16* __restrict__ src) {
    const int tid = otid();
#pragma unroll
    for (int c2 = 0; c2 < 2; ++c2) { const int idx = tid + NTHR * c2, r = idx >> 4, ch = idx & 15; *(LAS u32x4*)(dst + r * 136 + 8 * ch) = *(const u32x4*)(src + r * 128 + 8 * ch); }
}
__device__ __forceinline__ void phase_scan_out_gla(KP p, LAS unsigned char* lds, int l, bool need_ctx) {
    const int tid = otid(), lane = tid & 63, wave = tid >> 6, fq = lane >> 4, fr = lane & 15; const int li = l >> 1;
    const bf16* P = (const bf16*)(p->ws + WS_P); const int ldp = NP_EVEN; const float* SM = (const float*)(p->ws + WS_SM); bf16* Z = (bf16*)(p->ws + WS_H);
    const bf16* S = (const bf16*)(p->ws + WS_S);
    LAS bf16* qf = (LAS bf16*)(lds + SO_QF); LAS bf16* kf = (LAS bf16*)(lds + SO_KF); LAS bf16* qb = (LAS bf16*)(lds + SO_QB); LAS bf16* kb = (LAS bf16*)(lds + SO_KB);
    LAS bf16* vs = (LAS bf16*)(lds + SO_VS); LAS bf16* Af = (LAS bf16*)(lds + SO_AF); LAS bf16* Ab = (LAS bf16*)(lds + SO_AB); LAS bf16* Sf = (LAS bf16*)(lds + SO_SF); LAS bf16* Sb = (LAS bf16*)(lds + SO_SB);
    LAS float* seg = (LAS float*)(lds + SO_SEG); LAS float* lrs = (LAS float*)(lds + SO_MISC);
    const int dk = tid & 63, sg = tid >> 6;
    for (int it = blockIdx.x; it < BATCH * 4 * NCHUNK; it += gridDim.x) {
        const int b = it / (4 * NCHUNK), h = (it / NCHUNK) & 3, cp = it % NCHUNK; if (cp < 4 && !need_ctx) continue;
        const int row0 = chunk_row0(b, cp); const int slf = ((b * 4 + h) * 2 + 0) * NCHUNK + cp, slb = slf + NCHUNK;
        __syncthreads();
#pragma unroll
        for (int c2 = 0; c2 < 2; ++c2) { const int idx = tid + NTHR * c2, t = idx >> 4, ch = idx & 15; *(LAS u32x4*)(vs + t * 136 + 8 * ch) = *(const u32x4*)(P + (size_t)(row0 + t) * ldp + 512 + h * 128 + 8 * ch); }
        stage_state(Sf, S + (size_t)slf * 8192); stage_state(Sb, S + (size_t)slb * 8192);
        float qv[8], kv[8];
#pragma unroll
        for (int tt = 0; tt < 8; ++tt) { const size_t ro = (size_t)(row0 + sg * 8 + tt) * ldp + h * 64 + dk; qv[tt] = bf2f(P[ro]); kv[tt] = bf2f(P[ro + 256]); }
        float gwf[16], gwb[16];
        const float* gw = p->gla_gate_w + (size_t)li * 2 * 16 * 256; const float* gb = p->gla_gate_b + (size_t)li * 2 * 256;
#pragma unroll
        for (int r = 0; r < 16; ++r) { gwf[r] = gw[r * 256 + h * 64 + dk]; gwb[r] = gw[(16 + r) * 256 + h * 64 + dk]; }
        const float gbf = gb[h * 64 + dk], gbb = gb[256 + h * 64 + dk];
        { const int t = tid >> 3, c4 = (tid & 7) * 4; *(LAS f32x4*)(lrs + t * 32 + c4) = *(const f32x4*)(SM + (size_t)(row0 + t) * 32 + c4); }
        __syncthreads();
        float pf[8], sb[8];
#pragma unroll
        for (int tt = 0; tt < 8; ++tt) { const LAS float* lr = lrs + (sg * 8 + tt) * 32; float zf = gbf, zb = gbb;
#pragma unroll
            for (int r = 0; r < 16; ++r) { zf += lr[r] * gwf[r]; zb += lr[16 + r] * gwb[r]; }
            pf[tt] = logsigf(zf) * 0.0625f; sb[tt] = logsigf(zb) * 0.0625f; }
#pragma unroll
        for (int tt = 1; tt < 8; ++tt) pf[tt] += pf[tt - 1];
#pragma unroll
        for (int tt = 6; tt >= 0; --tt) sb[tt] += sb[tt + 1];
        seg[(0 * 8 + sg) * 64 + dk] = pf[7]; seg[(1 * 8 + sg) * 64 + dk] = sb[0];
        __syncthreads();
        float offf = 0.f, offb = 0.f;
#pragma unroll
        for (int q = 0; q < 8; ++q) { const float a = seg[q * 64 + dk], c = seg[(8 + q) * 64 + dk]; if (q < sg) offf += a; if (q > sg) offb += c; }
#pragma unroll
        for (int tt = 0; tt < 8; ++tt) { const int t = sg * 8 + tt; const float bf_ = offf + pf[tt], bb_ = offb + sb[tt];
            qf[t * 72 + dk] = (bf16)f2bf(qv[tt] * __expf(bf_)); kf[t * 72 + dk] = (bf16)f2bf(kv[tt] * __expf(-bf_));
            qb[t * 72 + dk] = (bf16)f2bf(qv[tt] * __expf(bb_)); kb[t * 72 + dk] = (bf16)f2bf(kv[tt] * __expf(-bb_)); }
        __syncthreads();
        { const int mt = wave >> 1;
#pragma unroll
          for (int n2 = 0; n2 < 2; ++n2) { const int nt = 2 * (wave & 1) + n2; f32x4 af = (f32x4){0.f, 0.f, 0.f, 0.f}, ab = (f32x4){0.f, 0.f, 0.f, 0.f};
#pragma unroll
              for (int ks = 0; ks < 2; ++ks) { af = MFMA(frag_rm(qf, 72, 16 * mt, 32 * ks, lane), frag_rm(kf, 72, 16 * nt, 32 * ks, lane), af);
                                               ab = MFMA(frag_rm(qb, 72, 16 * mt, 32 * ks, lane), frag_rm(kb, 72, 16 * nt, 32 * ks, lane), ab); }
#pragma unroll
              for (int r = 0; r < 4; ++r) { const int t = 16 * mt + 4 * fq + r, s = 16 * nt + fr;
                  Af[t * 72 + s] = (bf16)f2bf(s <= t ? af[r] : 0.f); Ab[t * 72 + s] = (bf16)f2bf(s >= t ? ab[r] : 0.f); } } }
        __syncthreads();
        f32x4 o[4];
#pragma unroll
        for (int mt = 0; mt < 4; ++mt) o[mt] = (f32x4){0.f, 0.f, 0.f, 0.f};
#pragma unroll
        for (int ks = 0; ks < 2; ++ks) { const bf16x8 bv = frag_tr(vs, 136, 32 * ks, 16 * wave, lane), bsf = frag_tr(Sf, 136, 32 * ks, 16 * wave, lane), bsb = frag_tr(Sb, 136, 32 * ks, 16 * wave, lane);
#pragma unroll
            for (int mt = 0; mt < 4; ++mt) { o[mt] = MFMA(frag_rm(Af, 72, 16 * mt, 32 * ks, lane), bv, o[mt]); o[mt] = MFMA(frag_rm(Ab, 72, 16 * mt, 32 * ks, lane), bv, o[mt]);
                o[mt] = MFMA(frag_rm(qf, 72, 16 * mt, 32 * ks, lane), bsf, o[mt]); o[mt] = MFMA(frag_rm(qb, 72, 16 * mt, 32 * ks, lane), bsb, o[mt]); } }
        scan_out_tail(lds, o, P, ldp, Z, row0, h, p->gla_norm_g + (size_t)li * 512);
    }
}
constexpr int MO_QS = 0, MO_KS = 9216, MO_QWF = 18432, MO_QWB = 27648;
__device__ __forceinline__ void phase_scan_out_mlstm(KP p, LAS unsigned char* lds, int l, bool need_ctx) {
    const int tid = otid(), lane = tid & 63, wave = tid >> 6, fq = lane >> 4, fr = lane & 15; const int li = l >> 1;
    const bf16* P = (const bf16*)(p->ws + WS_P); const int ldp = NP_ODD; const float* SM = (const float*)(p->ws + WS_SM); bf16* Z = (bf16*)(p->ws + WS_H);
    const bf16* S = (const bf16*)(p->ws + WS_S); const float* GAM = (const float*)(p->ws + WS_GAM); const float* SC = (const float*)(p->ws + WS_SC);
    LAS bf16* qs = (LAS bf16*)(lds + MO_QS); LAS bf16* ks_ = (LAS bf16*)(lds + MO_KS); LAS bf16* qwf = (LAS bf16*)(lds + MO_QWF); LAS bf16* qwb = (LAS bf16*)(lds + MO_QWB);
    LAS bf16* vs = (LAS bf16*)(lds + SO_VS); LAS bf16* Af = (LAS bf16*)(lds + SO_AF); LAS bf16* Ab = (LAS bf16*)(lds + SO_AB); LAS bf16* Cf = (LAS bf16*)(lds + SO_SF); LAS bf16* Cb = (LAS bf16*)(lds + SO_SB);
    LAS float* part = (LAS float*)(lds + SO_SEG);
    LAS float* misc = (LAS float*)(lds + SO_MISC);
    const float* mb = p->ml_gate_b + li * 16;
    for (int it = blockIdx.x; it < BATCH * 4 * NCHUNK; it += gridDim.x) {
        const int b = it / (4 * NCHUNK), h = (it / NCHUNK) & 3, cp = it % NCHUNK; if (cp < 4 && !need_ctx) continue;
        const int row0 = chunk_row0(b, cp); const int slf = ((b * 4 + h) * 2 + 0) * NCHUNK + cp, slb = slf + NCHUNK;
        __syncthreads();
#pragma unroll
        for (int c2 = 0; c2 < 2; ++c2) { const int idx = tid + NTHR * c2, t = idx >> 4, ch = idx & 15; *(LAS u32x4*)(vs + t * 136 + 8 * ch) = *(const u32x4*)(P + (size_t)(row0 + t) * ldp + 512 + h * 128 + 8 * ch); }
        stage_state(Cf, S + (size_t)slf * 8192); stage_state(Cb, S + (size_t)slb * 8192);
        { const int t = tid >> 3, ch = tid & 7; const size_t ro = (size_t)(row0 + t) * ldp + h * 64 + 8 * ch;
          *(LAS u32x4*)(qs + t * 72 + 8 * ch) = *(const u32x4*)(P + ro); *(LAS u32x4*)(ks_ + t * 72 + 8 * ch) = *(const u32x4*)(P + ro + 256); }
        if (tid < 128) { const int d = tid >> 6, t = tid & 63; const float* gp = SM + (size_t)(row0 + t) * 32 + d * 8;
            misc[d * 512 + t] = gp[h] + mb[d * 8 + h]; misc[d * 512 + 64 + t] = logsigf(gp[4 + h] + mb[d * 8 + 4 + h]);
            misc[1024 + d * 64 + t] = GAM[(size_t)(d ? slb : slf) * 64 + t]; }
        __syncthreads();
        if (tid < 128) { const int d = tid >> 6, t = tid & 63; LAS float* md = misc + d * 512; const float run = wave_scan_sum(md[64 + t], t, d == 1); const float pm = wave_scan_max(md[t] - run, t, d == 1);
            const float mprev = SC[(size_t)(d ? slb : slf) * 4 + 2];
            const float mt_ = fmaxf(run + pm, run + mprev);
            md[128 + t] = run; md[192 + t] = mt_; md[256 + t] = __expf(run + mprev - mt_); }
        __syncthreads();
        { const int t = tid >> 3, ch = tid & 7; const u32x4 qv = *(const LAS u32x4*)(qs + t * 72 + 8 * ch); const float wf = misc[256 + t], wb = misc[512 + 256 + t];
          u32x4 a, c;
          a.x = pk2(bflo(qv.x) * wf, bfhi(qv.x) * wf); a.y = pk2(bflo(qv.y) * wf, bfhi(qv.y) * wf); a.z = pk2(bflo(qv.z) * wf, bfhi(qv.z) * wf); a.w = pk2(bflo(qv.w) * wf, bfhi(qv.w) * wf);
          c.x = pk2(bflo(qv.x) * wb, bfhi(qv.x) * wb); c.y = pk2(bflo(qv.y) * wb, bfhi(qv.y) * wb); c.z = pk2(bflo(qv.z) * wb, bfhi(qv.z) * wb); c.w = pk2(bflo(qv.w) * wb, bfhi(qv.w) * wb);
          *(LAS u32x4*)(qwf + t * 72 + 8 * ch) = a; *(LAS u32x4*)(qwb + t * 72 + 8 * ch) = c;
          const float q0 = bflo(qv.x), q1 = bfhi(qv.x), q2 = bflo(qv.y), q3 = bfhi(qv.y), q4 = bflo(qv.z), q5 = bfhi(qv.z), q6 = bflo(qv.w), q7 = bfhi(qv.w);
#pragma unroll
          for (int d = 0; d < 2; ++d) { const LAS float* nv = misc + 1024 + d * 64 + 8 * ch;
              part[(d * 8 + ch) * 64 + t] = q0 * nv[0] + q1 * nv[1] + q2 * nv[2] + q3 * nv[3] + q4 * nv[4] + q5 * nv[5] + q6 * nv[6] + q7 * nv[7]; } }
        { const int mt = wave >> 1; float rsf[4] = {0.f, 0.f, 0.f, 0.f}, rsb[4] = {0.f, 0.f, 0.f, 0.f};
#pragma unroll
          for (int n2 = 0; n2 < 2; ++n2) { const int nt = 2 * (wave & 1) + n2; f32x4 a = (f32x4){0.f, 0.f, 0.f, 0.f};
#pragma unroll
              for (int ks = 0; ks < 2; ++ks) a = MFMA(frag_rm(qs, 72, 16 * mt, 32 * ks, lane), frag_rm(ks_, 72, 16 * nt, 32 * ks, lane), a);
#pragma unroll
              for (int r = 0; r < 4; ++r) { const int t = 16 * mt + 4 * fq + r, s = 16 * nt + fr;
                  const float wf = s <= t ? __expf(misc[128 + t] - misc[128 + s] + misc[s] - misc[192 + t]) : 0.f;
                  const float wb = s >= t ? __expf(misc[512 + 128 + t] - misc[512 + 128 + s] + misc[512 + s] - misc[512 + 192 + t]) : 0.f;
                  const float vf = a[r] * wf, vb = a[r] * wb; rsf[r] += vf; rsb[r] += vb;
                  Af[t * 72 + s] = (bf16)f2bf(vf); Ab[t * 72 + s] = (bf16)f2bf(vb); } }
#pragma unroll
          for (int r = 0; r < 4; ++r) { const float a = red16_sum(rsf[r]), c = red16_sum(rsb[r]);
              if (fr == 0) { misc[1152 + (0 * 2 + (wave & 1)) * 64 + 16 * mt + 4 * fq + r] = a; misc[1152 + (1 * 2 + (wave & 1)) * 64 + 16 * mt + 4 * fq + r] = c; } } }
        __syncthreads();
        if (tid < 128) { const int d = tid >> 6, t = tid & 63; float qn = 0.f;
#pragma unroll
            for (int q = 0; q < 8; ++q) qn += part[(d * 8 + q) * 64 + t];
            const float den = misc[1152 + (d * 2 + 0) * 64 + t] + misc[1152 + (d * 2 + 1) * 64 + t] + misc[d * 512 + 256 + t] * qn;
            misc[d * 512 + 320 + t] = 1.f / fmaxf(fabsf(den), __expf(-misc[d * 512 + 192 + t])); }
        f32x4 of[4], ob[4];
#pragma unroll
        for (int mt = 0; mt < 4; ++mt) { of[mt] = (f32x4){0.f, 0.f, 0.f, 0.f}; ob[mt] = (f32x4){0.f, 0.f, 0.f, 0.f}; }
#pragma unroll
        for (int ks = 0; ks < 2; ++ks) { const bf16x8 bv = frag_tr(vs, 136, 32 * ks, 16 * wave, lane), bcf = frag_tr(Cf, 136, 32 * ks, 16 * wave, lane), bcb = frag_tr(Cb, 136, 32 * ks, 16 * wave, lane);
#pragma unroll
            for (int mt = 0; mt < 4; ++mt) { of[mt] = MFMA(frag_rm(Af, 72, 16 * mt, 32 * ks, lane), bv, of[mt]); of[mt] = MFMA(frag_rm(qwf, 72, 16 * mt, 32 * ks, lane), bcf, of[mt]);
                ob[mt] = MFMA(frag_rm(Ab, 72, 16 * mt, 32 * ks, lane), bv, ob[mt]); ob[mt] = MFMA(frag_rm(qwb, 72, 16 * mt, 32 * ks, lane), bcb, ob[mt]); } }
        __syncthreads();
        f32x4 o[4];
#pragma unroll
        for (int mt = 0; mt < 4; ++mt)
#pragma unroll
            for (int r = 0; r < 4; ++r) { const int t = 16 * mt + 4 * fq + r; o[mt][r] = of[mt][r] * misc[320 + t] + ob[mt][r] * misc[512 + 320 + t]; }
        scan_out_tail(lds, o, P, ldp, Z, row0, h, p->ml_norm_g + (size_t)li * 512);
    }
}
#define XB_TMO      128
#define XB_XCNT(j)  (256  + 64 * (j))
#define XB_XSUB(j)  (1280 + 64 * (j))
#define XB_XGEN(j)  (2304 + 64 * (j))
#define XB_TOP      3328
#define XB_TOPGEN   3392
#define XCD_BAR_WORDS 3456
#define XB_SPIN_CAP (1u << 18)

__device__ __forceinline__ unsigned xb_ld(unsigned* p)              { return __hip_atomic_load(p, __ATOMIC_RELAXED, __HIP_MEMORY_SCOPE_AGENT); }
__device__ __forceinline__ unsigned xb_add(unsigned* p, unsigned v) { return __hip_atomic_fetch_add(p, v, __ATOMIC_RELAXED, __HIP_MEMORY_SCOPE_AGENT); }
__device__ __forceinline__ unsigned xb_xcc_id() { return (unsigned)__builtin_amdgcn_s_getreg((3 << 11) | 20) & 0xFu; }
#define XB_SPIN(cond, bar) do { unsigned _sp = 0; while (cond) { __builtin_amdgcn_s_sleep(1); \
    if ((++_sp & 255u) == 0u) { if (xb_ld(&(bar)[XB_TMO])) break; if (_sp > XB_SPIN_CAP) { atomicAdd(&(bar)[XB_TMO], 1u); break; } } } } while (0)

struct XcdBarrier {
    unsigned* bar; unsigned x;
    volatile LAS unsigned* st;
};

__device__ __forceinline__ XcdBarrier xcd_barrier_post(unsigned* bar, volatile LAS unsigned* st) {
    XcdBarrier b; b.bar = bar; b.x = xb_xcc_id(); b.st = st;
    if (otid() == 0) (void)xb_add(&bar[XB_XCNT(b.x)], 1u);
    return b;
}
__device__ __forceinline__ void xcd_barrier_complete(unsigned* bar, unsigned x, unsigned& nloc, unsigned& nx) {
    const unsigned G = gridDim.x * gridDim.y * gridDim.z;
    unsigned sum, cnt, mine, sp = 0u;
    for (;;) {
        sum = 0u; cnt = 0u; mine = 0u;
#pragma unroll
        for (unsigned j = 0; j < 16; ++j) { const unsigned c = xb_ld(&bar[XB_XCNT(j)]); sum += c; cnt += (c > 0u) ? 1u : 0u; mine = (j == x) ? c : mine; }
        if (sum == G) break;
        __builtin_amdgcn_s_sleep(1);
        if ((++sp & 255u) == 0u) { if (xb_ld(&bar[XB_TMO])) break; if (sp > XB_SPIN_CAP) { atomicAdd(&bar[XB_TMO], 1u); break; } }
    }
    nloc = mine > 0u ? mine : 1u; nx = cnt > 0u ? cnt : 1u;
}

__device__ __forceinline__ void xcd_barrier(const XcdBarrier& b) {
    asm volatile("s_waitcnt vmcnt(0)" ::: "memory");
    __syncthreads();
    if (otid() == 0) {
        unsigned* bar = b.bar;
        __builtin_amdgcn_s_waitcnt(0);
        unsigned nloc = b.st[0], nx = b.st[1];
        if (nloc == 0u) { xcd_barrier_complete(bar, b.x, nloc, nx); b.st[0] = nloc; b.st[1] = nx; }
        const unsigned old = xb_add(&bar[XB_XSUB(b.x)], 1u);
        const unsigned gen = old / nloc;
        if (old + 1u == (gen + 1u) * nloc) {
            __builtin_amdgcn_fence(__ATOMIC_RELEASE, "agent");
            asm volatile("s_waitcnt vmcnt(0)" ::: "memory");
            const unsigned og = xb_add(&bar[XB_TOP], 1u);
            const unsigned tg = og / nx;
            if (og + 1u == (tg + 1u) * nx) xb_add(&bar[XB_TOPGEN], 1u);
            else XB_SPIN(xb_ld(&bar[XB_TOPGEN]) == tg, bar);
            __builtin_amdgcn_fence(__ATOMIC_ACQUIRE, "agent");
            xb_add(&bar[XB_XGEN(b.x)], 1u);
            asm volatile("s_waitcnt vmcnt(0)" ::: "memory");
        } else {
            XB_SPIN(xb_ld(&bar[XB_XGEN(b.x)]) == gen, bar);
            __builtin_amdgcn_fence(__ATOMIC_ACQUIRE, "agent");
            asm volatile("s_waitcnt vmcnt(0)" ::: "memory");
        }
    }
    __syncthreads();
}

#define REP_GEMM 1
#define REP_ATT 1
#define REP_LOC 1
#define REP_OUT 1
#define REP_PRO 1
#define REP_SEQ 1
#define REP_LN 1
#ifndef MK_N_LAUNCHES
#define MK_N_LAUNCHES 1
#endif
constexpr int N_PHASES = 2 + 6 * DEPTH;
__global__ void __launch_bounds__(NTHR, 2) fwd_megakernel(Params p_unused) {
    extern __shared__ __attribute__((aligned(16))) unsigned char lds_raw[];
    LAS unsigned char* lds = (LAS unsigned char*)lds_raw;
    cg::grid_group grid = cg::this_grid();
    const int lo = (int)kparams()->ph_lo, hi = (int)kparams()->ph_hi;
#define IN(k) (lo <= (k) && (k) < hi)
    volatile LAS unsigned* bst = (volatile LAS unsigned*)(lds + LDS_BYTES - 64);
    if (otid() < 16) bst[otid()] = 0u;
    __syncthreads();
    XcdBarrier bar = xcd_barrier_post((unsigned*)(kparams()->ws + WS_BAR), bst);
#define SEAM(k) do { if (IN(k) && IN((k) + 1)) { if ((k) == 0) grid.sync(); else xcd_barrier(bar); } } while (0)
    if (IN(0)) { for (int rep = 0; rep < REP_PRO; ++rep) { phase_prologue(kparams(), lds); __syncthreads(); } } SEAM(0);
    if (IN(1)) { for (int rep = 0; rep < REP_PRO; ++rep) phase_h0(kparams()); } SEAM(1);
#pragma unroll 1
    for (int l = 0; l < DEPTH; ++l) {
        const int pb = 2 + 6 * l; const bool odd = l & 1; const int li = l >> 1; const bool need_ctx = l < DEPTH - 1;
        if (IN(pb + 0)) {
            const int npad = odd ? NPAD_ODD : NPAD_EVEN; unsigned char* ws = kparams()->ws;
            pg8::Gemm g{(const pg8::bf16_t*)(ws + WS_H), (const pg8::bf16_t*)(ws + (odd ? WS_WIO : WS_WIE)) + (size_t)li * npad * 1024, MTOT, npad, 1024};
            pg8::StaticOrder S; S.init(MTOT, npad, (int)gridDim.x, (int)blockIdx.x);
            pg8::EpiProj E{(pg8::bf16_t*)(ws + WS_P), odd ? NP_ODD : NP_EVEN, (float*)(ws + WS_SM), odd ? 16 : 32, npad / 256 - 1, odd ? 1 : 0, (const float*)(ws + WS_ROPE), (const float*)(ws + WS_ROPE) + 1024};
            for (int rep = 0; rep < REP_GEMM; ++rep) pg8::gemm_phase<pg8::EpiProj, pg8::StaticOrder, true, true>(lds, g, S, E);
        }
        SEAM(pb + 0);
        if (IN(pb + 1)) { for (int rep = 0; rep < REP_ATT; ++rep) phase_attn(kparams(), lds, l, need_ctx); for (int rep = 0; rep < REP_LOC; ++rep) phase_scan_local(kparams(), lds, l); }
        SEAM(pb + 1);
        if (IN(pb + 2)) { for (int rep = 1; rep < REP_SEQ; ++rep) { phase_scan_seq(kparams(), l, true); __syncthreads(); } phase_scan_seq(kparams(), l); }
        SEAM(pb + 2);
        if (IN(pb + 3)) { for (int rep = 0; rep < REP_OUT; ++rep) { if (odd) phase_scan_out_mlstm(kparams(), lds, l, need_ctx); else phase_scan_out_gla(kparams(), lds, l, need_ctx); } }
        SEAM(pb + 3);
        if (IN(pb + 4)) {
            const int mrows = need_ctx ? MTOT : MLAT; unsigned char* ws = kparams()->ws;
            pg8::Gemm g{(const pg8::bf16_t*)(ws + WS_H), (const pg8::bf16_t*)(ws + WS_WO) + (size_t)l * 1024 * 1024, mrows, 1024, 1024};
            pg8::StaticOrder S; S.init(mrows, 1024, (int)gridDim.x, (int)blockIdx.x);
            pg8::EpiProj E{(pg8::bf16_t*)(ws + WS_P), 1024, nullptr, 0, -1, 0, nullptr, nullptr};
            for (int rep = 0; rep < REP_GEMM; ++rep) pg8::gemm_phase<pg8::EpiProj, pg8::StaticOrder, true, true>(lds, g, S, E);
        }
        SEAM(pb + 4);
        if (IN(pb + 5)) { for (int rep = 1; rep < REP_LN; ++rep) { phase_ln(kparams(), l, true); } phase_ln(kparams(), l); }
        SEAM(pb + 5);
    }
}
extern "C" void kernel_launch(void* const* d_in, const int* in_sizes, int n_in, void* d_out, int out_size, void* d_ws, size_t ws_size, hipStream_t stream) {
    static int grid = 0;
    if (grid == 0) {
        if (n_in != 19 || ws_size < WS_END) { fprintf(stderr, "kernel_launch: need 19 inputs and %zu bytes of workspace; got %d, %zu\n", (size_t)WS_END, n_in, ws_size); grid = -1; return; }
        int dev = 0, cus = 0, per_cu = 0;
        if (hipGetDevice(&dev) != hipSuccess || hipDeviceGetAttribute(&cus, hipDeviceAttributeMultiprocessorCount, dev) != hipSuccess) { grid = -1; return; }
        if (hipFuncSetAttribute((const void*)fwd_megakernel, hipFuncAttributeMaxDynamicSharedMemorySize, LDS_BYTES) != hipSuccess) { fprintf(stderr, "kernel_launch: hipFuncSetAttribute failed\n"); grid = -1; return; }
        if (hipOccupancyMaxActiveBlocksPerMultiprocessor(&per_cu, (const void*)fwd_megakernel, NTHR, LDS_BYTES) != hipSuccess || per_cu < 1) per_cu = 1;
        grid = cus * per_cu;
    }
    if (grid < 0) return;
    Params p{};
    p.x = (const float*)d_in[0]; p.c = (const float*)d_in[1]; p.ctx = (const float*)d_in[2]; p.c_ctx = (const float*)d_in[3]; p.w_ada = (const float*)d_in[4]; p.b_ada = (const float*)d_in[5];
    p.ln_g = (const float*)d_in[6]; p.ln_b = (const float*)d_in[7]; p.w_in_even = (const float*)d_in[8]; p.w_out_even = (const float*)d_in[9]; p.gla_gate_w = (const float*)d_in[10]; p.gla_gate_b = (const float*)d_in[11];
    p.gla_norm_g = (const float*)d_in[12]; p.na_rpb = (const float*)d_in[13]; p.w_in_odd = (const float*)d_in[14]; p.w_out_odd = (const float*)d_in[15]; p.ml_gate_b = (const float*)d_in[16]; p.ml_norm_g = (const float*)d_in[17];
    p.sw_sink = (const float*)d_in[18]; p.out = (float*)d_out; p.ws = (unsigned char*)d_ws;
    if (hipMemsetAsync((char*)d_ws + WS_BAR, 0, XCD_BAR_WORDS * 4, stream) != hipSuccess) { fprintf(stderr, "kernel_launch: memset failed\n"); return; }
#if MK_N_LAUNCHES == 1
    p.ph_lo = 0; p.ph_hi = N_PHASES;
    void* args[] = {&p};
    hipError_t e = hipLaunchCooperativeKernel((const void*)fwd_megakernel, dim3(grid), dim3(NTHR), args, LDS_BYTES, stream);
    if (e != hipSuccess) fprintf(stderr, "kernel_launch: cooperative launch failed: %s (grid %d)\n", hipGetErrorString(e), grid);
#else
    for (int k = 0; k < N_PHASES; ++k) { p.ph_lo = k; p.ph_hi = k + 1; hipLaunchKernelGGL(fwd_megakernel, dim3(grid), dim3(NTHR), LDS_BYTES, stream, p); }
#endif
}
```

```cpp
#include <hip/hip_runtime.h>
#include <hip/hip_cooperative_groups.h>
#include <cstdio>
#include <cstdint>
namespace cg = cooperative_groups;
__device__ __forceinline__ int otid() { int t = threadIdx.x; asm volatile("" : "+v"(t)); return t; }
namespace pg8 {
#define PG8_LAS __attribute__((address_space(3)))
typedef unsigned short bf16_t;
typedef short bf16x8 __attribute__((ext_vector_type(8)));
typedef float f32x4 __attribute__((ext_vector_type(4)));
typedef unsigned u32x4 __attribute__((ext_vector_type(4)));
constexpr int BM = 256, BK = 64, HALF = 128, HTB = HALF * BK * 2  , STAGE_BYTES = 8 * HTB, NXCD = 8, WGM = 8;

__host__ __device__ __forceinline__ int lds_byte(int r, int c) { const int st = (r >> 4) * 2 + (c >> 5), rr = r & 15, cc = c & 31, ob = rr * 64 + cc * 2; return st * 1024 + (ob ^ (((ob >> 9) & 1) << 5)); }
__host__ __device__ __forceinline__ void stage_rc(int b, int& R, int& C) { const int st = b / 1024, sb = b % 1024, swz = sb ^ (((sb >> 9) & 1) << 5); R = (st >> 1) * 16 + swz / 64; C = (st & 1) * 32 + (swz % 64) / 2; }
__host__ __device__ __forceinline__ int perm32(int rho) { const int n = rho >> 4, i = rho & 15; return 8 * (i >> 2) + 4 * n + (i & 3); }

struct Unit { int pm, pn; };
struct Gemm { const bf16_t* A; const bf16_t* Bt; int M, N, K; };

struct StaticOrder {
    int nM, nN, nwg, G, c;
    __host__ __device__ void init(int M, int N, int G_, int c_) { nM = M / BM; nN = N / BM; nwg = nM * nN; G = G_; c = c_; }
    __host__ __device__ bool next(int i, Unit& u) const {
        const long L = (long)i * G + c; if (L >= nwg) return false;
        int wgid = (int)L; { const int q = nwg / NXCD, r = nwg % NXCD, xcd = wgid % NXCD, off = wgid / NXCD; wgid = (xcd < r ? xcd * (q + 1) : r * (q + 1) + (xcd - r) * q) + off; }
        const int nig = WGM * nN, gid = wgid / nig, fm = gid * WGM, gsz = (nM - fm) < WGM ? (nM - fm) : WGM;
        u.pm = fm + ((wgid % nig) % gsz); u.pn = (wgid % nig) / gsz; return true;
    }
    __device__ __forceinline__ void a_ready(const Unit&) const {}
    __device__ __forceinline__ void done(const Unit&) const {}
};

__device__ __forceinline__ unsigned cvt_pk_bf16(float lo, float hi) { unsigned r; asm volatile("v_cvt_pk_bf16_f32 %0, %1, %2" : "=v"(r) : "v"(lo), "v"(hi)); return r; }
struct EpiProj {
    static constexpr bool PERM = true, AFTER_DRAIN = false;
    bf16_t* P; int ldp; float* SM; int nsm; int last_pn; int rope; const float* cosT; const float* sinT;
    __device__ __forceinline__ void operator()(const f32x4 (&acc)[2][2][4][2], const Unit& u, int wr, int wc, int fr, int fq) const {
        const int row0 = u.pm * BM + wr * 64 + fr;
        if (u.pn == last_pn) {
            if (wc == 0) {
#pragma unroll
                for (int ai = 0; ai < 2; ++ai)
#pragma unroll
                    for (int m = 0; m < 4; ++m) { const int row = row0 + ai * HALF + m * 16;
#pragma unroll
                        for (int n = 0; n < 2; ++n) { const int col = 8 * fq + 4 * n; if (col < nsm) *(f32x4*)(SM + (size_t)row * 32 + col) = acc[ai][0][m][n]; } }
            }
            return;
        }
        const bool do_rope_tile = rope && (u.pn == 6 || u.pn == 7 || u.pn == 8) && (u.pm * BM < 32768);
#pragma unroll
        for (int ai = 0; ai < 2; ++ai)
#pragma unroll
            for (int m = 0; m < 4; ++m) { const int row = row0 + ai * HALF + m * 16; bf16_t* rowp = P + (size_t)row * ldp + u.pn * BM + wc * 32 + 8 * fq;
#pragma unroll
                for (int bj = 0; bj < 2; ++bj) { f32x4 v0 = acc[ai][bj][m][0], v1 = acc[ai][bj][m][1];
                    if (do_rope_tile && (u.pn != 8 || bj == 0)) {
                        const int t = row & 4095; const int pos = (wc & 1) ? (t & 63) : (t >> 6); const int i0 = pos * 16 + 8 * (fq & 1);
                        const f32x4 c0 = *(const f32x4*)(cosT + i0), c1 = *(const f32x4*)(cosT + i0 + 4), s0 = *(const f32x4*)(sinT + i0), s1 = *(const f32x4*)(sinT + i0 + 4);
                        f32x4 p0, p1;
#pragma unroll
                        for (int e = 0; e < 4; ++e) { p0[e] = __shfl_xor(v0[e], 32); p1[e] = __shfl_xor(v1[e], 32); }
                        if (fq < 2) { v0 = v0 * c0 - p0 * s0; v1 = v1 * c1 - p1 * s1; } else { v0 = p0 * s0 + v0 * c0; v1 = p1 * s1 + v1 * c1; }
                    }
                    u32x4 w; w.x = cvt_pk_bf16(v0[0], v0[1]); w.y = cvt_pk_bf16(v0[2], v0[3]); w.z = cvt_pk_bf16(v1[0], v1[1]); w.w = cvt_pk_bf16(v1[2], v1[3]);
                    *(u32x4*)(rowp + bj * HALF) = w; } }
    }
};
template <class Epi, class Sched, bool ALIGN_EPI = false, bool SP2 = false>
__device__ __forceinline__ void gemm_phase(PG8_LAS unsigned char* lds, const Gemm g, const Sched& S, const Epi& E) {
    const int tid = otid(), wid = __builtin_amdgcn_readfirstlane(tid >> 6), lane = tid & 63, wr = wid >> 2, wc = wid & 3, fr = lane & 15, fq = lane >> 4;
    const int K = g.K, nt = K / BK;
    unsigned voffA[2], voffB[2];
#pragma unroll
    for (int i = 0; i < 2; ++i) { int R, C; stage_rc(tid * 16 + i * 8192, R, C); const int Rb = Epi::PERM ? ((R & ~31) + perm32(R & 31)) : R;
        voffA[i] = (unsigned)(R * K + C) * 2u; voffB[i] = (unsigned)(Rb * K + C) * 2u; }
    const size_t kstep = (size_t)(BK * 2);
    const size_t hstep = (size_t)HALF * K * 2;
    const size_t tstep = 2 * hstep;
    const unsigned ldsw = (unsigned)wid * 1024u;
    const int aoff = lds_byte(wr * 64 + fr, fq * 8), boff = lds_byte(wc * 32 + fr, fq * 8);
#define PG8_SA(b, h) (((b) * 2 + (h)) * HTB)
#define PG8_SB(b, h) ((4 + (b) * 2 + (h)) * HTB)
#define PG8_STAGE(bufoff, gbase, voff) do { _Pragma("unroll") for (int _i = 0; _i < 2; ++_i) \
        __builtin_amdgcn_global_load_lds((const unsigned*)((const char*)(gbase) + (voff)[_i]), (PG8_LAS unsigned*)(lds + (bufoff) + ldsw + _i * 8192), 16, 0, 0); } while (0)
#define PG8_LDA(dst, b, h) do { _Pragma("unroll") for (int m = 0; m < 4; ++m) _Pragma("unroll") for (int k = 0; k < 2; ++k) dst[m][k] = *(const PG8_LAS bf16x8*)(lds + PG8_SA(b, h) + aoff + m * 2048 + k * 1024); } while (0)
#define PG8_LDB(dst, b, h) do { _Pragma("unroll") for (int n = 0; n < 2; ++n) _Pragma("unroll") for (int k = 0; k < 2; ++k) dst[n][k] = *(const PG8_LAS bf16x8*)(lds + PG8_SB(b, h) + boff + n * 2048 + k * 1024); } while (0)
#define PG8_MMA(ai, bj, At, Bt) do { __builtin_amdgcn_s_setprio(1); _Pragma("unroll") for (int m = 0; m < 4; ++m) _Pragma("unroll") for (int n = 0; n < 2; ++n) _Pragma("unroll") for (int k = 0; k < 2; ++k) \
        acc[ai][bj][m][n] = __builtin_amdgcn_mfma_f32_16x16x32_bf16(Bt[n][k], At[m][k], acc[ai][bj][m][n], 0, 0, 0); __builtin_amdgcn_s_setprio(0); } while (0)
#define PG8_WAIT_V(n) asm volatile("s_waitcnt vmcnt(" #n ")" ::: "memory")
#define PG8_WAIT_L(n) asm volatile("s_waitcnt lgkmcnt(" #n ")" ::: "memory")
#define PG8_BAR __builtin_amdgcn_s_barrier()
#define PG8_SCHED __builtin_amdgcn_sched_barrier(0)
    Unit cur, nxt; int ui = 0;
    if (!S.next(0, cur)) return;
    f32x4 acc[2][2][4][2];
#pragma unroll
    for (int a = 0; a < 2; ++a)
#pragma unroll
        for (int b = 0; b < 2; ++b)
#pragma unroll
            for (int m = 0; m < 4; ++m)
#pragma unroll
                for (int n = 0; n < 2; ++n) acc[a][b][m][n] = (f32x4){0.f, 0.f, 0.f, 0.f};
    bf16x8 At[4][2], B0[2][2], B1[2][2];
    const char* cA = (const char*)g.A + (size_t)cur.pm * tstep; const char* cB = (const char*)g.Bt + (size_t)cur.pn * tstep;
    S.a_ready(cur);
    if constexpr (SP2) {
        PG8_STAGE(PG8_SB(0, 0), cB, voffB); PG8_STAGE(PG8_SB(0, 1), cB + hstep, voffB); PG8_STAGE(PG8_SA(0, 0), cA, voffA); PG8_STAGE(PG8_SA(0, 1), cA + hstep, voffA);
        if (wr == 1) PG8_BAR;
        PG8_WAIT_V(2); PG8_BAR;
        PG8_STAGE(PG8_SB(1, 0), cB + kstep, voffB); PG8_STAGE(PG8_SA(1, 0), cA + kstep, voffA); PG8_STAGE(PG8_SB(1, 1), cB + hstep + kstep, voffB);
        PG8_WAIT_V(6); PG8_BAR;
    } else {
        PG8_STAGE(PG8_SB(0, 0), cB, voffB); PG8_STAGE(PG8_SA(0, 0), cA, voffA); PG8_STAGE(PG8_SB(0, 1), cB + hstep, voffB); PG8_STAGE(PG8_SA(0, 1), cA + hstep, voffA);
        if (wr == 1) PG8_BAR;
        PG8_WAIT_V(4); PG8_BAR;
        PG8_STAGE(PG8_SB(1, 0), cB + kstep, voffB); PG8_STAGE(PG8_SA(1, 0), cA + kstep, voffA); PG8_STAGE(PG8_SB(1, 1), cB + hstep + kstep, voffB);
        PG8_WAIT_V(6); PG8_BAR;
    }
    for (;;) {
        const bool has_next = S.next(ui + 1, nxt);
        const char* nA = has_next ? (const char*)g.A + (size_t)nxt.pm * tstep : cA; const char* nB = has_next ? (const char*)g.Bt + (size_t)nxt.pn * tstep : cB;
        for (int t = 0; t < nt; t += 2) {
            const bool last = (t == nt - 2);
            const char* a1 = cA + (size_t)(t + 1) * kstep;
            const char* a2 = last ? nA : cA + (size_t)(t + 2) * kstep; const char* b2 = last ? nB : cB + (size_t)(t + 2) * kstep;
            const char* a3 = a2 + kstep; const char* b3 = b2 + kstep;
            if (last && has_next) S.a_ready(nxt);
            if constexpr (SP2) {
            PG8_LDB(B0, 0, 0); PG8_LDB(B1, 0, 1); PG8_SCHED; PG8_LDA(At, 0, 0); PG8_STAGE(PG8_SA(1, 1), a1 + hstep, voffA);
            PG8_WAIT_V(8); PG8_WAIT_L(0); PG8_BAR; PG8_MMA(0, 0, At, B0); PG8_MMA(0, 1, At, B1); PG8_BAR; PG8_SCHED;
            PG8_LDA(At, 0, 1); PG8_STAGE(PG8_SB(0, 0), b2, voffB); PG8_STAGE(PG8_SB(0, 1), b2 + hstep, voffB); PG8_STAGE(PG8_SA(0, 0), a2, voffA);
            PG8_WAIT_V(8); PG8_WAIT_L(0); PG8_BAR; PG8_MMA(1, 0, At, B0); PG8_MMA(1, 1, At, B1); PG8_BAR; PG8_SCHED;
            PG8_LDB(B0, 1, 0); PG8_LDB(B1, 1, 1); PG8_SCHED; PG8_LDA(At, 1, 0); PG8_STAGE(PG8_SA(0, 1), a2 + hstep, voffA);
            PG8_WAIT_V(8); PG8_WAIT_L(0); PG8_BAR; PG8_MMA(0, 0, At, B0); PG8_MMA(0, 1, At, B1); PG8_BAR; PG8_SCHED;
            PG8_LDA(At, 1, 1); PG8_STAGE(PG8_SB(1, 0), b3, voffB); PG8_STAGE(PG8_SB(1, 1), b3 + hstep, voffB); PG8_STAGE(PG8_SA(1, 0), a3, voffA);
            PG8_WAIT_V(8); PG8_WAIT_L(0); PG8_BAR; PG8_MMA(1, 0, At, B0); PG8_MMA(1, 1, At, B1); PG8_BAR; PG8_SCHED;
            } else {
            PG8_LDB(B0, 0, 0); PG8_SCHED; PG8_LDA(At, 0, 0); PG8_STAGE(PG8_SA(1, 1), a1 + hstep, voffA);
            PG8_WAIT_L(8); PG8_BAR; PG8_WAIT_L(0); PG8_MMA(0, 0, At, B0); PG8_BAR; PG8_SCHED;
            PG8_LDB(B1, 0, 1); PG8_STAGE(PG8_SB(0, 0), b2, voffB);
            PG8_BAR; PG8_WAIT_L(0); PG8_MMA(0, 1, At, B1); PG8_BAR;
            PG8_LDA(At, 0, 1); PG8_STAGE(PG8_SA(0, 0), a2, voffA);
            PG8_BAR; PG8_WAIT_L(0); PG8_MMA(1, 0, At, B0); PG8_BAR; PG8_SCHED;
            PG8_STAGE(PG8_SB(0, 1), b2 + hstep, voffB);
            PG8_WAIT_V(6); PG8_BAR; PG8_MMA(1, 1, At, B1); PG8_BAR;
            PG8_LDB(B0, 1, 0); PG8_SCHED; PG8_LDA(At, 1, 0); PG8_STAGE(PG8_SA(0, 1), a2 + hstep, voffA);
            PG8_WAIT_L(8); PG8_BAR; PG8_WAIT_L(0); PG8_MMA(0, 0, At, B0); PG8_BAR; PG8_SCHED;
            PG8_LDB(B1, 1, 1); PG8_STAGE(PG8_SB(1, 0), b3, voffB);
            PG8_BAR; PG8_WAIT_L(0); PG8_MMA(0, 1, At, B1); PG8_BAR;
            PG8_LDA(At, 1, 1); PG8_STAGE(PG8_SA(1, 0), a3, voffA);
            PG8_BAR; PG8_WAIT_L(0); PG8_MMA(1, 0, At, B0); PG8_BAR; PG8_SCHED;
            PG8_STAGE(PG8_SB(1, 1), b3 + hstep, voffB);
            PG8_WAIT_V(6); PG8_BAR; PG8_MMA(1, 1, At, B1); PG8_BAR;
            }
        }
        if constexpr (ALIGN_EPI) { if (wr == 0) PG8_BAR; }
        if constexpr (!Epi::AFTER_DRAIN) { E(acc, cur, wr, wc, fr, fq); S.done(cur); }
        if (!has_next) break;
#pragma unroll
        for (int a = 0; a < 2; ++a)
#pragma unroll
            for (int b = 0; b < 2; ++b)
#pragma unroll
                for (int m = 0; m < 4; ++m)
#pragma unroll
                    for (int n = 0; n < 2; ++n) acc[a][b][m][n] = (f32x4){0.f, 0.f, 0.f, 0.f};
        cur = nxt; cA = nA; cB = nB; ++ui;
        if constexpr (ALIGN_EPI) { if (wr == 1) PG8_BAR; }
    }
    PG8_WAIT_V(0);
    if constexpr (!ALIGN_EPI) { if (wr == 0) PG8_BAR; }
    PG8_BAR;
    if constexpr (Epi::AFTER_DRAIN) { E.fused(acc, cur, wr, wc, fr, fq, lds, wid, lane); S.done(cur); }
#undef PG8_SA
#undef PG8_SB
#undef PG8_STAGE
#undef PG8_LDA
#undef PG8_LDB
#undef PG8_MMA
#undef PG8_WAIT_V
#undef PG8_WAIT_L
#undef PG8_BAR
#undef PG8_SCHED
}
}
constexpr int NWAVES = 8, NTHR = 512;
constexpr int BATCH = 8, SEQ = 4096, DM = 1024, CTXL = 256, DEPTH = 4;
constexpr int MLAT = BATCH * SEQ, MCTX = BATCH * CTXL, MTOT = MLAT + MCTX;
constexpr int NP_EVEN = 3584, NPAD_EVEN = 3840, NORIG_EVEN = 3616;
constexpr int NP_ODD = 2816, NPAD_ODD = 3072, NORIG_ODD = 2832;
constexpr int NCHUNK = 68;
constexpr int NSLOT = BATCH * 4 * 2 * NCHUNK;
constexpr float ALPHA_DN = 1.681792830507429f;
constexpr size_t MiB = 1u << 20;
constexpr size_t WS_MOD = 0;
constexpr size_t WS_BAR = 512 * 1024;
constexpr size_t WS_ROPE = 1 * MiB;
constexpr size_t WS_SC = WS_ROPE + 65536;
constexpr size_t WS_GAM = 2 * MiB;
constexpr size_t WS_SM = 4 * MiB;
constexpr size_t WS_WIE = 9 * MiB;
constexpr size_t WS_WIO = 24 * MiB;
constexpr size_t WS_WO = 36 * MiB;
constexpr size_t WS_XC = 44 * MiB;
constexpr size_t WS_H = 52 * MiB;
constexpr size_t WS_P = 120 * MiB;
constexpr size_t WS_S = 359 * MiB;
constexpr size_t WS_X16 = 427 * MiB;
constexpr size_t WS_END = WS_X16 + (size_t)MTOT * 1024 * 2;
static_assert(WS_S + (size_t)NSLOT * 8192 * 2 <= WS_X16, "ws map 4");
static_assert(WS_SC + (size_t)NSLOT * 16 <= WS_GAM && WS_GAM + (size_t)NSLOT * 256 <= WS_SM && WS_SM + (size_t)MTOT * 128 <= WS_WIE, "ws map 1");
static_assert(WS_WIE + (size_t)2 * NPAD_EVEN * 1024 * 2 <= WS_WIO && WS_WIO + (size_t)2 * NPAD_ODD * 1024 * 2 <= WS_WO && WS_WO + (size_t)4 * 1024 * 1024 * 2 <= WS_XC, "ws map 2");
static_assert(WS_XC + (size_t)MCTX * 1024 * 4 <= WS_H && WS_H + (size_t)MTOT * 1024 * 2 <= WS_P && WS_P + (size_t)MTOT * NP_EVEN * 2 <= WS_S && WS_END <= 512 * MiB, "ws map 3");
constexpr int LDS_BYTES = 147456;

#define LAS __attribute__((address_space(3)))
typedef unsigned short bf16;
typedef float f32x4 __attribute__((ext_vector_type(4)));
typedef short bf16x8 __attribute__((ext_vector_type(8)));
typedef short s16x4 __attribute__((ext_vector_type(4)));
typedef unsigned u32x4 __attribute__((ext_vector_type(4)));
typedef unsigned u32x2 __attribute__((ext_vector_type(2)));
#define LDS_WAIT() asm volatile("s_waitcnt lgkmcnt(0)" ::: "memory")

typedef __bf16 hbf2 __attribute__((ext_vector_type(2)));
typedef float f32x2_ __attribute__((ext_vector_type(2)));
__device__ __forceinline__ unsigned f2bf(float f) { const __bf16 b = (__bf16)f; return (unsigned)__builtin_bit_cast(unsigned short, b); }
__device__ __forceinline__ unsigned pk2(float lo, float hi) { const f32x2_ v = {lo, hi}; const hbf2 b = __builtin_convertvector(v, hbf2); return __builtin_bit_cast(unsigned, b); }
__device__ __forceinline__ float bf2f(unsigned short v) { return __builtin_bit_cast(float, (unsigned)v << 16); }
__device__ __forceinline__ float bflo(unsigned w) { return __builtin_bit_cast(float, w << 16); }
__device__ __forceinline__ float bfhi(unsigned w) { return __builtin_bit_cast(float, w & 0xffff0000u); }
__device__ __forceinline__ float siluf(float x) { return x * __builtin_amdgcn_rcpf(1.f + __expf(-x)); }
__device__ __forceinline__ float logsigf(float z) { return fminf(z, 0.f) - __logf(1.f + __expf(-fabsf(z))); }
template <int N> __device__ __forceinline__ float dpp_ror(float v) { return __builtin_bit_cast(float, __builtin_amdgcn_update_dpp(0, __builtin_bit_cast(int, v), 0x120 + N, 0xf, 0xf, false)); }
__device__ __forceinline__ float red16_max(float v) { v = fmaxf(v, dpp_ror<1>(v)); v = fmaxf(v, dpp_ror<2>(v)); v = fmaxf(v, dpp_ror<4>(v)); v = fmaxf(v, dpp_ror<8>(v)); return v; }
__device__ __forceinline__ float red16_sum(float v) { v += dpp_ror<1>(v); v += dpp_ror<2>(v); v += dpp_ror<4>(v); v += dpp_ror<8>(v); return v; }
__device__ __forceinline__ float wave_sum(float v) {
#pragma unroll
    for (int o = 1; o < 64; o <<= 1) v += __shfl_xor(v, o);
    return v;
}
__device__ __forceinline__ float wave_max(float v) {
#pragma unroll
    for (int o = 1; o < 64; o <<= 1) v = fmaxf(v, __shfl_xor(v, o));
    return v;
}
__device__ __forceinline__ float wave_scan_sum(float v, int lane, bool rev) {
#pragma unroll
    for (int o = 1; o < 64; o <<= 1) { const float t = rev ? __shfl_down(v, o) : __shfl_up(v, o); if (rev ? (lane + o < 64) : (lane >= o)) v += t; }
    return v;
}
__device__ __forceinline__ float wave_scan_max(float v, int lane, bool rev) {
#pragma unroll
    for (int o = 1; o < 64; o <<= 1) { const float t = rev ? __shfl_down(v, o) : __shfl_up(v, o); if (rev ? (lane + o < 64) : (lane >= o)) v = fmaxf(v, t); }
    return v;
}
#define MFMA(a, b, c) __builtin_amdgcn_mfma_f32_16x16x32_bf16((a), (b), (c), 0, 0, 0)
__device__ __forceinline__ bf16x8 frag_rm(const LAS bf16* X, int ld, int row0, int k0, int lane) {
    return *(const LAS bf16x8*)(X + (row0 + (lane & 15)) * ld + k0 + 8 * (lane >> 4));
}
__device__ __forceinline__ bf16x8 frag_tr(const LAS bf16* X, int ld, int k0, int n0, int lane) {
    const int g = lane >> 4, m = lane & 15, q = m >> 2, p = m & 3;
    const LAS bf16* a0 = X + (k0 + 8 * g + q) * ld + n0 + 4 * p;
    const s16x4 lo = __builtin_amdgcn_ds_read_tr16_b64_v4i16((LAS s16x4*)a0);
    const s16x4 hi = __builtin_amdgcn_ds_read_tr16_b64_v4i16((LAS s16x4*)(a0 + 4 * ld));
    bf16x8 r; r[0] = lo[0]; r[1] = lo[1]; r[2] = lo[2]; r[3] = lo[3]; r[4] = hi[0]; r[5] = hi[1]; r[6] = hi[2]; r[7] = hi[3]; return r;
}

struct Params {
    const float *x, *c, *ctx, *c_ctx, *w_ada, *b_ada, *ln_g, *ln_b, *w_in_even, *w_out_even, *gla_gate_w, *gla_gate_b, *gla_norm_g, *na_rpb, *w_in_odd, *w_out_odd, *ml_gate_b, *ml_norm_g, *sw_sink;
    float* out; unsigned char* ws; long long ph_lo, ph_hi;
};
typedef const __attribute__((address_space(4))) Params* KP;
__device__ __forceinline__ KP kparams() { unsigned long long v = (unsigned long long)__builtin_amdgcn_kernarg_segment_ptr(); asm volatile("" : "+s"(v)); return (KP)v; }

__device__ __forceinline__ int orig_col(int type, int n) {
    if (type == 0) { if (n < 1536) return n; if (n < 3584) return n + 32; if (n < 3616) return n - 3584 + 1536; return -1; }
    if (type == 1) { if (n < 1536) return n; if (n < 2816) return n + 16; if (n < 2832) return n - 2816 + 1536; return -1; }
    return n;
}
__device__ __forceinline__ float col_scale(int type, int n) {
    if (type == 0) return (n < 256 || (n >= 1536 && n < 2048)) ? 0.125f : 1.f;
    if (type == 1) return ((n >= 256 && n < 512) || (n >= 1536 && n < 2048)) ? 0.125f : 1.f;
    return 1.f;
}
__device__ __forceinline__ void p0_transpose_item(const float* __restrict__ W, int K, int Norig, int type, bf16* __restrict__ WT, LAS float* scr, int nblk, int item, int lane) {
    const int kb = item / nblk, nb = item % nblk, k0 = 64 * kb, n0 = 32 * nb;
    const int oc = orig_col(type, n0 + (lane & 31)); const float sc = col_scale(type, n0 + (lane & 31));
#pragma unroll 8
    for (int i = 0; i < 32; ++i) { const int kk = 2 * i + (lane >> 5); scr[kk * 33 + (lane & 31)] = oc >= 0 ? W[(size_t)(k0 + kk) * Norig + oc] * sc : 0.f; }
    LDS_WAIT();
    const int c = lane & 7;
#pragma unroll
    for (int j = 0; j < 4; ++j) { const int n = (lane >> 3) + 8 * j; const LAS float* s = scr + (8 * c) * 33 + n;
        u32x4 o; o.x = pk2(s[0 * 33], s[1 * 33]); o.y = pk2(s[2 * 33], s[3 * 33]); o.z = pk2(s[4 * 33], s[5 * 33]); o.w = pk2(s[6 * 33], s[7 * 33]);
        *(u32x4*)(WT + (size_t)(n0 + n) * K + k0 + 8 * c) = o; }
    LDS_WAIT();
}
__device__ __forceinline__ void phase_prologue(KP p, LAS unsigned char* lds) {
    const int tid = otid(), lane = tid & 63, wave = tid >> 6;
    unsigned char* ws = p->ws;
    float* MOD = (float*)(ws + WS_MOD);
    if ((int)blockIdx.x < 192) {
        LAS float* cond = (LAS float*)lds;
        LAS float* red = (LAS float*)(lds + 36864);
        for (int e = tid; e < 9 * 1024; e += NTHR) { const int j = e >> 10, k = e & 1023; const float v = j < 8 ? p->c[j * 1024 + k] : p->c_ctx[k]; cond[e] = siluf(v); }
        __syncthreads();
        for (int it = blockIdx.x; it < 192; it += gridDim.x) {
            const int l = it / 48, n0 = (it % 48) * 64, cq = tid & 15, ks = tid >> 4;
            float acc[9][4];
#pragma unroll
            for (int j = 0; j < 9; ++j) { acc[j][0] = 0.f; acc[j][1] = 0.f; acc[j][2] = 0.f; acc[j][3] = 0.f; }
            const float* wp = p->w_ada + (size_t)l * 1024 * 3072 + (size_t)(ks * 32) * 3072 + n0 + 4 * cq;
#pragma unroll 4
            for (int kk = 0; kk < 32; ++kk) { const f32x4 w = *(const f32x4*)(wp + (size_t)kk * 3072);
#pragma unroll
                for (int j = 0; j < 9; ++j) { const float cv = cond[j * 1024 + ks * 32 + kk]; acc[j][0] += cv * w[0]; acc[j][1] += cv * w[1]; acc[j][2] += cv * w[2]; acc[j][3] += cv * w[3]; } }
#pragma unroll
            for (int j = 0; j < 9; ++j)
#pragma unroll
                for (int i = 0; i < 4; ++i) red[ks * 576 + j * 64 + 4 * cq + i] = acc[j][i];
            __syncthreads();
            for (int o = tid; o < 576; o += NTHR) { float s = 0.f; for (int q = 0; q < 32; ++q) s += red[q * 576 + o]; const int j = o >> 6, n = n0 + (o & 63);
                MOD[(size_t)(l * 9 + j) * 3072 + n] = s + p->b_ada[l * 3072 + n]; }
            __syncthreads();
        }
    }
    if (blockIdx.x == gridDim.x - 1) {
        float* cosT = (float*)(ws + WS_ROPE); float* sinT = cosT + 1024;
        for (int e = tid; e < 1024; e += NTHR) { const int pos = e >> 4, i = e & 15;
            double f = 1.0; for (int q = 0; q < i; ++q) f *= 0.5623413251903491;
            const double f2 = f * f; double sn = 1.0, cs = 1.0;
            for (int q = 12; q >= 1; --q) { sn = 1.0 - f2 / ((2.0 * q) * (2.0 * q + 1.0)) * sn; cs = 1.0 - f2 / ((2.0 * q - 1.0) * (2.0 * q)) * cs; }
            sn *= f;
            double c = 1.0, s = 0.0; for (int q = 0; q < pos; ++q) { const double c2 = c * cs - s * sn, s2 = s * cs + c * sn; c = c2; s = s2; }
            cosT[e] = (float)c; sinT[e] = (float)s; }
    }
    __syncthreads();
    {
        LAS float* scr = (LAS float*)(lds + wave * 16384);
        const int gw = blockIdx.x * NWAVES + wave, NGW = gridDim.x * NWAVES;
        constexpr int I_E = 16 * (NPAD_EVEN / 32), I_O = 16 * (NPAD_ODD / 32), I_W = 16 * 32;
        constexpr int NIT = 2 * I_E + 2 * I_O + 4 * I_W;
        for (int it = gw; it < NIT; it += NGW) {
            int r = it;
            if (r < 2 * I_E) { const int i = r / I_E; r -= i * I_E; p0_transpose_item(p->w_in_even + (size_t)i * 1024 * NORIG_EVEN, 1024, NORIG_EVEN, 0, (bf16*)(ws + WS_WIE) + (size_t)i * NPAD_EVEN * 1024, scr, NPAD_EVEN / 32, r, lane); continue; }
            r -= 2 * I_E;
            if (r < 2 * I_O) { const int i = r / I_O; r -= i * I_O; p0_transpose_item(p->w_in_odd + (size_t)i * 1024 * NORIG_ODD, 1024, NORIG_ODD, 1, (bf16*)(ws + WS_WIO) + (size_t)i * NPAD_ODD * 1024, scr, NPAD_ODD / 32, r, lane); continue; }
            r -= 2 * I_O;
            { const int l = r / I_W; r -= l * I_W; const float* W = (l & 1) ? p->w_out_odd + (size_t)(l >> 1) * 1024 * 1024 : p->w_out_even + (size_t)(l >> 1) * 1024 * 1024;
              p0_transpose_item(W, 1024, 1024, 2, (bf16*)(ws + WS_WO) + (size_t)l * 1024 * 1024, scr, 32, r, lane); }
        }
    }
}
__device__ __forceinline__ void phase_h0(KP p) {
    const int lane = otid() & 63, gw = blockIdx.x * NWAVES + (otid() >> 6), NGW = gridDim.x * NWAVES;
    const float* MOD = (const float*)(p->ws + WS_MOD); bf16* H = (bf16*)(p->ws + WS_H);
    for (int m = gw; m < MTOT; m += NGW) {
        const int jb = m < MLAT ? (m >> 12) : 8;
        const float* src = m < MLAT ? p->x + (size_t)m * DM : p->ctx + (size_t)(m - MLAT) * DM;
        const float* md = MOD + (size_t)jb * 3072;
#pragma unroll
        for (int j = 0; j < 4; ++j) { const int k = 4 * lane + 256 * j; const f32x4 v = *(const f32x4*)(src + k), sh = *(const f32x4*)(md + k), sc = *(const f32x4*)(md + 1024 + k);
            const f32x4 h = v * (sc + 1.0f) + sh; u32x2 o; o.x = pk2(h[0], h[1]); o.y = pk2(h[2], h[3]); *(u32x2*)(H + (size_t)m * DM + k) = o; }
    }
}
typedef _Float16 f16x4 __attribute__((ext_vector_type(4)));
__device__ __forceinline__ void phase_ln(KP p, int l, bool dummy = false) {
    const int lane = otid() & 63, gw = blockIdx.x * NWAVES + (otid() >> 6), NGW = gridDim.x * NWAVES;
    const float* MOD = (const float*)(p->ws + WS_MOD); bf16* H = (bf16*)(p->ws + WS_H); const bf16* Y = (const bf16*)(p->ws + WS_P); _Float16* X16 = (_Float16*)(p->ws + WS_X16);
    const int mrows = l < DEPTH - 1 ? MTOT : MLAT;
    const float* lg = p->ln_g + l * DM; const float* lb = p->ln_b + l * DM;
    const float* xin = p->x; const float* cin = p->ctx; float* outp = p->out;
    for (int m0 = 2 * gw; m0 < mrows; m0 += 2 * NGW) {
        const int jb = m0 < MLAT ? (m0 >> 12) : 8;
        const float* md = MOD + (size_t)(l * 9 + jb) * 3072;
        f32x4 v[2][4], xs[2][4]; float s[2] = {0.f, 0.f};
#pragma unroll
        for (int j = 0; j < 4; ++j) { const int k = 4 * lane + 256 * j; const f32x4 g = *(const f32x4*)(md + 2048 + k);
#pragma unroll
            for (int q = 0; q < 2; ++q) { const int m = m0 + q; f32x4 xv;
                if (l == 0) xv = *(const f32x4*)((m < MLAT ? xin + (size_t)m * DM : cin + (size_t)(m - MLAT) * DM) + k);
                else xv = __builtin_convertvector(*(const f16x4*)(X16 + (size_t)m * DM + k), f32x4);
                const u32x2 yw = *(const u32x2*)(Y + (size_t)m * DM + k);
                f32x4 y; y[0] = bflo(yw.x); y[1] = bfhi(yw.x); y[2] = bflo(yw.y); y[3] = bfhi(yw.y);
                xs[q][j] = xv; v[q][j] = xv * ALPHA_DN + g * y; s[q] += (v[q][j][0] + v[q][j][1]) + (v[q][j][2] + v[q][j][3]); } }
        float rstd[2];
#pragma unroll
        for (int q = 0; q < 2; ++q) { const float mean = wave_sum(s[q]) * (1.f / DM); float s2 = 0.f;
#pragma unroll
            for (int j = 0; j < 4; ++j) { v[q][j] = v[q][j] - mean; s2 += (v[q][j][0] * v[q][j][0] + v[q][j][1] * v[q][j][1]) + (v[q][j][2] * v[q][j][2] + v[q][j][3] * v[q][j][3]); }
            rstd[q] = 1.f / sqrtf(wave_sum(s2) * (1.f / DM) + 1e-5f); }
        const float* md2 = MOD + (size_t)((l + 1) * 9 + jb) * 3072;
#pragma unroll
        for (int j = 0; j < 4; ++j) { const int k = 4 * lane + 256 * j; const f32x4 gg = *(const f32x4*)(lg + k), bb = *(const f32x4*)(lb + k);
            f32x4 sh = (f32x4){0.f, 0.f, 0.f, 0.f}, sc = sh; if (l < DEPTH - 1) { sh = *(const f32x4*)(md2 + k); sc = *(const f32x4*)(md2 + 1024 + k); }
#pragma unroll
            for (int q = 0; q < 2; ++q) { const int m = m0 + q; const f32x4 o = v[q][j] * rstd[q] * gg + bb;
                if (l < DEPTH - 1) { *(f16x4*)(X16 + (size_t)m * DM + k) = __builtin_convertvector(dummy ? xs[q][j] : o, f16x4);
                    const f32x4 h = o * (sc + 1.0f) + sh; u32x2 w; w.x = pk2(h[0], h[1]); w.y = pk2(h[2], h[3]); *(u32x2*)(H + (size_t)m * DM + k) = w; }
                else { if (!dummy) *(f32x4*)(outp + (size_t)m * DM + k) = o; } } }
    }
}
constexpr int AT_KS = 0, AT_VS = 9216, AT_BUF = 18432, AT_PS = 36864, AT_RPB = AT_PS + 8 * 2304;
__device__ __forceinline__ bf16x8 frag_tr_perm(const LAS bf16* X, int ld, int k0, int n0, int lane) {
    const int g = lane >> 4, m = lane & 15, q = m >> 2, p = m & 3;
    const LAS bf16* a0 = X + (k0 + 4 * g + q) * ld + n0 + 4 * p;
    const s16x4 lo = __builtin_amdgcn_ds_read_tr16_b64_v4i16((LAS s16x4*)a0);
    const s16x4 hi = __builtin_amdgcn_ds_read_tr16_b64_v4i16((LAS s16x4*)(a0 + 16 * ld));
    bf16x8 r; r[0] = lo[0]; r[1] = lo[1]; r[2] = lo[2]; r[3] = lo[3]; r[4] = hi[0]; r[5] = hi[1]; r[6] = hi[2]; r[7] = hi[3]; return r;
}
__device__ __forceinline__ void attn_tile(const LAS bf16* Ks, const LAS bf16* Vs, const LAS float* rpb, const bf16x8 (&qa)[2][2], float (&mrow)[2], float (&lsum)[2], f32x4 (&oacc)[2][4],
                                          int mode, int i, int nlat, int qa_, int qb_, int ka_, int lane) {
    const int fq = lane >> 4, fr = lane & 15;
    const bool islat = i < nlat;
    bool active = true; int kt0 = 0;
    if (islat) {
        if (mode == 0) { kt0 = ka_ + i; const int rs = min(max(qa_ - 4, 0), 56); active = (kt0 >= rs) && (kt0 < rs + 8); }
        else { kt0 = ka_ + 64 * i; active = !(kt0 > qa_ + 31 + 128 || kt0 + 63 < qa_ - 128); }
    }
    if (!active) return;
    const bool nar = islat && mode == 0;
    const int ct0 = qb_ >> 4;
    int ntlo[2], nthi[2];
#pragma unroll
    for (int nq = 0; nq < 2; ++nq) { const int ct = ct0 + nq; ntlo[nq] = nar ? (ct < 2 ? 0 : ct - 1) : 0; nthi[nq] = nar ? (ct > 1 ? 3 : ct + 1) : 3; }
    const int ulo = min(ntlo[0], ntlo[1]), uhi = max(nthi[0], nthi[1]);
    f32x4 s[2][4];
#pragma unroll
    for (int mt = 0; mt < 4; ++mt) { s[0][mt] = (f32x4){0.f, 0.f, 0.f, 0.f}; s[1][mt] = (f32x4){0.f, 0.f, 0.f, 0.f};
        if (mt >= ulo && mt <= uhi) {
#pragma unroll
            for (int ks = 0; ks < 2; ++ks) { const bf16x8 kf = frag_rm(Ks, 72, 16 * mt, 32 * ks, lane);
                if (mt >= ntlo[0] && mt <= nthi[0]) s[0][mt] = MFMA(kf, qa[0][ks], s[0][mt]);
                if (mt >= ntlo[1] && mt <= nthi[1]) s[1][mt] = MFMA(kf, qa[1][ks], s[1][mt]); } } }
    unsigned pw[2][8];
#pragma unroll
    for (int nq = 0; nq < 2; ++nq) {
        float tmax = -3e38f;
#pragma unroll
        for (int mt = 0; mt < 4; ++mt) { if (mt >= ntlo[nq] && mt <= nthi[nq]) {
#pragma unroll
            for (int r = 0; r < 4; ++r) { float v = s[nq][mt][r]; const int kk = 16 * mt + 4 * fq + r;
                if (islat) {
                    if (mode == 0) { const int qc = qb_ + 16 * nq + fr, cs = min(max(qc - 8, 0), 48); const bool ok = (kk >= cs) && (kk < cs + 16);
                        const int bi = (kt0 - qa_ + 7) * 31 + (kk - qc + 15); v = ok ? v + rpb[ok ? bi : 0] : -3e38f; }
                    else { const int d = (qa_ + 16 * nq + fr) - (kt0 + kk); v = (d <= 128 && d >= -128) ? v : -3e38f; }
                }
                s[nq][mt][r] = v; tmax = fmaxf(tmax, v); } } }
        tmax = fmaxf(tmax, __shfl_xor(tmax, 16)); tmax = fmaxf(tmax, __shfl_xor(tmax, 32));
        const float mnew = fmaxf(mrow[nq], tmax); const float alpha = __expf(mrow[nq] - mnew); mrow[nq] = mnew;
        float ps = 0.f;
#pragma unroll
        for (int mt = 0; mt < 4; ++mt) { float p0 = 0.f, p1 = 0.f, p2 = 0.f, p3 = 0.f;
            if (mt >= ntlo[nq] && mt <= nthi[nq]) { p0 = __expf(s[nq][mt][0] - mnew); p1 = __expf(s[nq][mt][1] - mnew); p2 = __expf(s[nq][mt][2] - mnew); p3 = __expf(s[nq][mt][3] - mnew); ps += (p0 + p1) + (p2 + p3); }
            pw[nq][2 * mt] = pk2(p0, p1); pw[nq][2 * mt + 1] = pk2(p2, p3); oacc[nq][mt] = oacc[nq][mt] * alpha; }
        lsum[nq] = lsum[nq] * alpha + ps;
    }
#pragma unroll
    for (int ks = 0; ks < 2; ++ks) { if (ks == 0 ? (ulo < 2) : (uhi > 1)) {
        const u32x4 pu0 = (u32x4){pw[0][4 * ks], pw[0][4 * ks + 1], pw[0][4 * ks + 2], pw[0][4 * ks + 3]}, pu1 = (u32x4){pw[1][4 * ks], pw[1][4 * ks + 1], pw[1][4 * ks + 2], pw[1][4 * ks + 3]};
        const bf16x8 pb0 = __builtin_bit_cast(bf16x8, pu0), pb1 = __builtin_bit_cast(bf16x8, pu1);
#pragma unroll
        for (int mt = 0; mt < 4; ++mt) { const bf16x8 vf = frag_tr_perm(Vs, 72, 32 * ks, 16 * mt, lane); oacc[0][mt] = MFMA(vf, pb0, oacc[0][mt]); oacc[1][mt] = MFMA(vf, pb1, oacc[1][mt]); } } }
}
constexpr int AT_PSW = 32 * 72 * 2;
constexpr int AT_RPB2 = AT_PS + 8 * AT_PSW;
__device__ __forceinline__ void attn_item(LAS unsigned char* lds, const bf16* __restrict__ P, int ldp, bf16* __restrict__ Z, int mode,
                                          int qrow0, int qcol, int kcol, int vcol, int gcol, int zcol,
                                          int nlat, int lat_row0, int ctx_row0, int qa_, int qb_, int ka_, const float* __restrict__ rpb_g, float sink) {
    const int tid = otid(), lane = tid & 63, wave = tid >> 6, fq = lane >> 4, fr = lane & 15;
    LAS bf16* Ks0 = (LAS bf16*)(lds + AT_KS); LAS bf16* Vs0 = (LAS bf16*)(lds + AT_VS); LAS bf16* Ks1 = (LAS bf16*)(lds + AT_KS + AT_BUF); LAS bf16* Vs1 = (LAS bf16*)(lds + AT_VS + AT_BUF);
    LAS bf16* Ps = (LAS bf16*)(lds + AT_PS + wave * AT_PSW); LAS float* rpb = (LAS float*)(lds + AT_RPB2);
    const int ntile = nlat + 4, srow = tid >> 3, sch = tid & 7, soff = srow * 72 + 8 * sch;
#define AT_ROWB(j) (((j) < nlat) ? lat_row0 + 64 * (j) : ctx_row0 + 64 * ((j) - nlat))
#define AT_LOAD(kr, vr, j) do { const size_t ro_ = (size_t)(AT_ROWB(j) + srow) * ldp + 8 * sch; kr = *(const u32x4*)(P + ro_ + kcol); vr = *(const u32x4*)(P + ro_ + vcol); } while (0)
    u32x4 k0, v0, k1, v1;
    AT_LOAD(k0, v0, 0);
    bf16x8 qa[2][2];
#pragma unroll
    for (int nq = 0; nq < 2; ++nq)
#pragma unroll
        for (int ks = 0; ks < 2; ++ks) qa[nq][ks] = *(const bf16x8*)(P + (size_t)(qrow0 + 16 * nq + fr) * ldp + qcol + 32 * ks + 8 * fq);
    __syncthreads();
    if (mode == 0) { for (int e = tid; e < 465; e += NTHR) rpb[e] = rpb_g[e]; }
    *(LAS u32x4*)(Ks0 + soff) = k0; *(LAS u32x4*)(Vs0 + soff) = v0;
    AT_LOAD(k0, v0, 1);
    AT_LOAD(k1, v1, 2);
    float mrow[2] = {-1e30f, -1e30f}, lsum[2] = {0.f, 0.f}; f32x4 oacc[2][4];
#pragma unroll
    for (int nq = 0; nq < 2; ++nq)
#pragma unroll
        for (int r = 0; r < 4; ++r) oacc[nq][r] = (f32x4){0.f, 0.f, 0.f, 0.f};
    __syncthreads();
    for (int i = 0; i < ntile; i += 2) {
        attn_tile(Ks0, Vs0, rpb, qa, mrow, lsum, oacc, mode, i, nlat, qa_, qb_, ka_, lane);
        if (i + 1 < ntile) { *(LAS u32x4*)(Ks1 + soff) = k0; *(LAS u32x4*)(Vs1 + soff) = v0; }
        if (i + 3 < ntile) AT_LOAD(k0, v0, i + 3);
        __syncthreads();
        if (i + 1 >= ntile) break;
        attn_tile(Ks1, Vs1, rpb, qa, mrow, lsum, oacc, mode, i + 1, nlat, qa_, qb_, ka_, lane);
        if (i + 2 < ntile) { *(LAS u32x4*)(Ks0 + soff) = k1; *(LAS u32x4*)(Vs0 + soff) = v1; }
        if (i + 4 < ntile) AT_LOAD(k1, v1, i + 4);
        __syncthreads();
    }
#undef AT_LOAD
#undef AT_ROWB
    u32x4 gvv[4];
#pragma unroll
    for (int c2 = 0; c2 < 4; ++c2) { const int idx = lane + 64 * c2, q = idx >> 3, ch = idx & 7; gvv[c2] = *(const u32x4*)(P + (size_t)(qrow0 + q) * ldp + gcol + 8 * ch); }
#pragma unroll
    for (int nq = 0; nq < 2; ++nq) { float lt = lsum[nq]; lt += __shfl_xor(lt, 16); lt += __shfl_xor(lt, 32); float sc;
      if (mode == 1 || mode == 3) { const float mf = fmaxf(mrow[nq], sink); const float al = __expf(mrow[nq] - mf); lt = lt * al + __expf(sink - mf); sc = al / lt; } else sc = 1.f / lt;
#pragma unroll
      for (int mt = 0; mt < 4; ++mt) { u32x2 w; w.x = pk2(oacc[nq][mt][0] * sc, oacc[nq][mt][1] * sc); w.y = pk2(oacc[nq][mt][2] * sc, oacc[nq][mt][3] * sc); *(LAS u32x2*)(Ps + (16 * nq + fr) * 72 + 16 * mt + 4 * fq) = w; } }
    LDS_WAIT();
#pragma unroll
    for (int c2 = 0; c2 < 4; ++c2) { const int idx = lane + 64 * c2, q = idx >> 3, ch = idx & 7;
        const u32x4 ov = *(const LAS u32x4*)(Ps + q * 72 + 8 * ch); const u32x4 gv = gvv[c2];
        u32x4 w;
        w.x = pk2(bflo(ov.x) * siluf(bflo(gv.x)), bfhi(ov.x) * siluf(bfhi(gv.x))); w.y = pk2(bflo(ov.y) * siluf(bflo(gv.y)), bfhi(ov.y) * siluf(bfhi(gv.y)));
        w.z = pk2(bflo(ov.z) * siluf(bflo(gv.z)), bfhi(ov.z) * siluf(bfhi(gv.z))); w.w = pk2(bflo(ov.w) * siluf(bflo(gv.w)), bfhi(ov.w) * siluf(bfhi(gv.w)));
        *(u32x4*)(Z + (size_t)(qrow0 + q) * DM + zcol + 8 * ch) = w; }
    LDS_WAIT();
}
__device__ __forceinline__ void phase_attn(KP p, LAS unsigned char* lds, int l, bool need_ctx) {
    const int wave = otid() >> 6; const bool odd = l & 1; const int li = l >> 1;
    const bf16* P = (const bf16*)(p->ws + WS_P); bf16* Z = (bf16*)(p->ws + WS_H); const int ldp = odd ? NP_ODD : NP_EVEN;
    const int nmain = BATCH * 8 * 16, nctx = need_ctx ? BATCH * 8 : 0;
    for (int it = blockIdx.x; it < nmain + nctx; it += gridDim.x) {
        if (it < nmain) {
            const int b = it >> 7, h = (it >> 4) & 7, qb = it & 15;
            if (!odd) { const int r0 = 4 * qb, rw = r0 + (wave >> 1); const int rs0 = min(max(r0 - 4, 0), 56), rs3 = min(max(r0 + 3 - 4, 0), 56);
                attn_item(lds, P, ldp, Z, 0, b * SEQ + rw * 64 + 32 * (wave & 1), 1536 + h * 64, 2048 + h * 64, 2560 + h * 64, 3072 + h * 64, 512 + h * 64,
                          rs3 + 8 - rs0, b * SEQ + rs0 * 64, MLAT + b * CTXL, rw, 32 * (wave & 1), rs0, p->na_rpb + (size_t)(li * 8 + h) * 465, 0.f); }
            else { const int kv = h >> 2, t0 = 256 * qb, lt0 = max(0, 4 * qb - 2), lt1 = min(63, 4 * qb + 5);
                attn_item(lds, P, ldp, Z, 1, b * SEQ + t0 + 32 * wave, 1536 + h * 64, 2048 + kv * 64, 2176 + kv * 64, 2304 + h * 64, 512 + h * 64,
                          lt1 - lt0 + 1, b * SEQ + lt0 * 64, MLAT + b * CTXL, t0 + 32 * wave, 0, lt0 * 64, nullptr, p->sw_sink[li * 8 + h]); }
        } else {
            const int j = it - nmain, b = j >> 3, h = j & 7; const int q0 = MLAT + b * CTXL + 32 * wave;
            if (!odd) attn_item(lds, P, ldp, Z, 2, q0, 1536 + h * 64, 2048 + h * 64, 2560 + h * 64, 3072 + h * 64, 512 + h * 64, 0, 0, MLAT + b * CTXL, 0, 0, 0, nullptr, 0.f);
            else { const int kv = h >> 2; attn_item(lds, P, ldp, Z, 3, q0, 1536 + h * 64, 2048 + kv * 64, 2176 + kv * 64, 2304 + h * 64, 512 + h * 64, 0, 0, MLAT + b * CTXL, 0, 0, 0, nullptr, p->sw_sink[li * 8 + h]); }
        }
    }
}
__device__ __forceinline__ int chunk_row0(int b, int cp) { return cp < 4 ? MLAT + b * CTXL + cp * 64 : b * SEQ + (cp - 4) * 64; }
constexpr int SL_KDF = 0, SL_KDB = 9216, SL_VS = 18432, SL_SEG = 35840, SL_MISC = 39936;
__device__ __forceinline__ void phase_scan_local(KP p, LAS unsigned char* lds, int l) {
    const int tid = otid(), lane = tid & 63, wave = tid >> 6, fq = lane >> 4, fr = lane & 15; const bool odd = l & 1; const int li = l >> 1;
    const bf16* P = (const bf16*)(p->ws + WS_P); const int ldp = odd ? NP_ODD : NP_EVEN; const float* SM = (const float*)(p->ws + WS_SM);
    bf16* S = (bf16*)(p->ws + WS_S); float* GAM = (float*)(p->ws + WS_GAM); float* SC = (float*)(p->ws + WS_SC);
    LAS bf16* kdf = (LAS bf16*)(lds + SL_KDF); LAS bf16* kdb = (LAS bf16*)(lds + SL_KDB); LAS bf16* vs = (LAS bf16*)(lds + SL_VS);
    LAS float* seg = (LAS float*)(lds + SL_SEG); LAS float* misc = (LAS float*)(lds + SL_MISC);
    const int dk = tid & 63, sg = tid >> 6;
    for (int it = blockIdx.x; it < BATCH * 4 * NCHUNK; it += gridDim.x) {
        const int b = it / (4 * NCHUNK), h = (it / NCHUNK) & 3, cp = it % NCHUNK; const int row0 = chunk_row0(b, cp);
        const int slf = ((b * 4 + h) * 2 + 0) * NCHUNK + cp, slb = slf + NCHUNK;
        __syncthreads();
#pragma unroll
        for (int c2 = 0; c2 < 2; ++c2) { const int idx = tid + NTHR * c2, t = idx >> 4, ch = idx & 15; *(LAS u32x4*)(vs + t * 136 + 8 * ch) = *(const u32x4*)(P + (size_t)(row0 + t) * ldp + 512 + h * 128 + 8 * ch); }
        float kv[8];
#pragma unroll
        for (int tt = 0; tt < 8; ++tt) kv[tt] = bf2f(P[(size_t)(row0 + sg * 8 + tt) * ldp + 256 + h * 64 + dk]);
        if (!odd) {
            float gwf[16], gwb[16];
            const float* gw = p->gla_gate_w + (size_t)li * 2 * 16 * 256; const float* gb = p->gla_gate_b + (size_t)li * 2 * 256;
#pragma unroll
            for (int r = 0; r < 16; ++r) { gwf[r] = gw[r * 256 + h * 64 + dk]; gwb[r] = gw[(16 + r) * 256 + h * 64 + dk]; }
            const float gbf = gb[h * 64 + dk], gbb = gb[256 + h * 64 + dk];
            { const int t = tid >> 3, c4 = (tid & 7) * 4; *(LAS f32x4*)(misc + t * 32 + c4) = *(const f32x4*)(SM + (size_t)(row0 + t) * 32 + c4); }
            __syncthreads();
            float pf[8], sb[8];
#pragma unroll
            for (int tt = 0; tt < 8; ++tt) { const LAS float* lr = misc + (sg * 8 + tt) * 32; float zf = gbf, zb = gbb;
#pragma unroll
                for (int r = 0; r < 16; ++r) { zf += lr[r] * gwf[r]; zb += lr[16 + r] * gwb[r]; }
                pf[tt] = logsigf(zf) * 0.0625f; sb[tt] = logsigf(zb) * 0.0625f; }
#pragma unroll
            for (int tt = 1; tt < 8; ++tt) pf[tt] += pf[tt - 1];
#pragma unroll
            for (int tt = 6; tt >= 0; --tt) sb[tt] += sb[tt + 1];
            seg[(0 * 8 + sg) * 64 + dk] = pf[7]; seg[(1 * 8 + sg) * 64 + dk] = sb[0];
            __syncthreads();
            float offf = 0.f, totf = 0.f, offb = 0.f, totb = 0.f;
#pragma unroll
            for (int q = 0; q < 8; ++q) { const float a = seg[q * 64 + dk], c = seg[(8 + q) * 64 + dk]; totf += a; totb += c; if (q < sg) offf += a; if (q > sg) offb += c; }
#pragma unroll
            for (int tt = 0; tt < 8; ++tt) { const int t = sg * 8 + tt;
                kdf[t * 72 + dk] = (bf16)f2bf(kv[tt] * __expf(totf - (offf + pf[tt]))); kdb[t * 72 + dk] = (bf16)f2bf(kv[tt] * __expf(totb - (offb + sb[tt]))); }
            if (sg == 0) { GAM[(size_t)slf * 64 + dk] = __expf(totf); GAM[(size_t)slb * 64 + dk] = __expf(totb); }
        } else {
            const float* mb = p->ml_gate_b + li * 16;
            if (tid < 128) { const int d = tid >> 6, t = tid & 63; const float* gp = SM + (size_t)(row0 + t) * 32 + d * 8;
                misc[d * 128 + t] = gp[h] + mb[d * 8 + h]; misc[d * 128 + 64 + t] = logsigf(gp[4 + h] + mb[d * 8 + 4 + h]); }
            __syncthreads();
            if (tid < 128) { const int d = tid >> 6, t = tid & 63; const float run = wave_scan_sum(misc[d * 128 + 64 + t], t, d == 1);
                const float tot = d == 0 ? __shfl(run, 63) : __shfl(run, 0);
                const float wl = tot - run + misc[d * 128 + t]; const float ml = wave_max(wl);
                misc[256 + d * 64 + t] = __expf(wl - ml);
                if (t == 0) { const int sl = d == 0 ? slf : slb; SC[(size_t)sl * 4 + 0] = tot; SC[(size_t)sl * 4 + 1] = ml; } }
            __syncthreads();
            float nf = 0.f, nb = 0.f;
#pragma unroll
            for (int tt = 0; tt < 8; ++tt) { const int t = sg * 8 + tt; const float a = kv[tt] * misc[256 + t], c = kv[tt] * misc[256 + 64 + t]; nf += a; nb += c;
                kdf[t * 72 + dk] = (bf16)f2bf(a); kdb[t * 72 + dk] = (bf16)f2bf(c); }
            seg[(0 * 8 + sg) * 64 + dk] = nf; seg[(1 * 8 + sg) * 64 + dk] = nb;
            __syncthreads();
            if (sg < 2) { float s2 = 0.f;
#pragma unroll
                for (int q = 0; q < 8; ++q) s2 += seg[(sg * 8 + q) * 64 + dk];
                GAM[(size_t)(sg == 0 ? slf : slb) * 64 + dk] = s2; }
        }
        __syncthreads();
#pragma unroll
        for (int d = 0; d < 2; ++d) { const LAS bf16* kd = d ? kdb : kdf; f32x4 acc[4];
#pragma unroll
            for (int nt = 0; nt < 4; ++nt) acc[nt] = (f32x4){0.f, 0.f, 0.f, 0.f};
#pragma unroll
            for (int ks = 0; ks < 2; ++ks) { const bf16x8 av = frag_tr(vs, 136, 32 * ks, 16 * wave, lane);
#pragma unroll
                for (int nt = 0; nt < 4; ++nt) acc[nt] = MFMA(av, frag_tr(kd, 72, 32 * ks, 16 * nt, lane), acc[nt]); }
            bf16* dst = S + (size_t)(d ? slb : slf) * 8192;
#pragma unroll
            for (int nt = 0; nt < 4; ++nt) { u32x2 w; w.x = pk2(acc[nt][0], acc[nt][1]); w.y = pk2(acc[nt][2], acc[nt][3]); *(u32x2*)(dst + (16 * nt + fr) * 128 + 16 * wave + 4 * fq) = w; } }
    }
}
__device__ __forceinline__ void phase_scan_seq(KP p, int l, bool dummy = false) {
    const bool odd = l & 1;
    u32x2* S2 = (u32x2*)(p->ws + WS_S); float* GAM = (float*)(p->ws + WS_GAM); f32x4* GAM4 = (f32x4*)(p->ws + WS_GAM); float* SC = (float*)(p->ws + WS_SC);
    const int nthreads = gridDim.x * NTHR;
    for (int gid = blockIdx.x * NTHR + otid(); gid < 64 * 2048; gid += nthreads) {
        const int chain = gid >> 11, e4 = gid & 2047, dir = chain & 1, dkk = e4 >> 5; const int base = chain * NCHUNK;
        f32x4 st = (f32x4){0.f, 0.f, 0.f, 0.f}, nst = (f32x4){0.f, 0.f, 0.f, 0.f}; float m = 0.f; const bool hasn = odd && e4 < 16;
        for (int s0 = 0; s0 < NCHUNK; s0 += 4) {
            u32x2 dr[4]; f32x4 dn[4]; float g0[4], g1[4]; int idx[4];
#pragma unroll
            for (int u = 0; u < 4; ++u) { const int step = s0 + u; const int cp = dir == 0 ? step : (step < 4 ? 3 - step : 71 - step); idx[u] = base + cp;
                dr[u] = S2[(size_t)idx[u] * 2048 + e4];
                if (!odd) { g0[u] = GAM[(size_t)idx[u] * 64 + dkk]; g1[u] = 0.f; } else { g0[u] = SC[(size_t)idx[u] * 4 + 0]; g1[u] = SC[(size_t)idx[u] * 4 + 1]; if (hasn) dn[u] = GAM4[(size_t)idx[u] * 16 + e4]; } }
#pragma unroll
            for (int u = 0; u < 4; ++u) {
                const f32x4 d = (f32x4){bflo(dr[u].x), bfhi(dr[u].x), bflo(dr[u].y), bfhi(dr[u].y)};
                u32x2 w; w.x = pk2(st[0], st[1]); w.y = pk2(st[2], st[3]);
                S2[(size_t)idx[u] * 2048 + e4] = dummy ? dr[u] : w;
                if (!odd) { st = st * g0[u] + d; }
                else { if (hasn) GAM4[(size_t)idx[u] * 16 + e4] = dummy ? dn[u] : nst; if (e4 == 0 && !dummy) SC[(size_t)idx[u] * 4 + 2] = m;
                    const float mn = fmaxf(g0[u] + m, g1[u]); const float dec = __expf(g0[u] + m - mn), sc = __expf(g1[u] - mn);
                    st = st * dec + d * sc; if (hasn) nst = nst * dec + dn[u] * sc; m = mn; }
            }
        }
    }
}
constexpr int SO_QF = 0, SO_KF = 9216, SO_QB = 18432, SO_KB = 27648, SO_VS = 36864, SO_AF = 54272, SO_AB = 63488, SO_SF = 72704, SO_SB = 90112, SO_SEG = 107520, SO_SSQ = 111616, SO_MISC = 113664;
constexpr int SO_OST = 0;
__device__ __forceinline__ void scan_out_tail(LAS unsigned char* lds, f32x4 (&o)[4], const bf16* __restrict__ P, int ldp, bf16* __restrict__ Z, int row0, int h, const float* __restrict__ ng) {
    const int tid = otid(), lane = tid & 63, wave = tid >> 6, fq = lane >> 4, fr = lane & 15;
    LAS float* ost = (LAS float*)(lds + SO_OST);
    u32x4 gv[2]; f32x4 g0[2], g1[2];
#pragma unroll
    for (int c2 = 0; c2 < 2; ++c2) { const int idx = tid + NTHR * c2, t = idx >> 4, ch = idx & 15;
        gv[c2] = *(const u32x4*)(P + (size_t)(row0 + t) * ldp + 1024 + h * 128 + 8 * ch); g0[c2] = *(const f32x4*)(ng + h * 128 + 8 * ch); g1[c2] = *(const f32x4*)(ng + h * 128 + 8 * ch + 4); }
    __syncthreads();
#pragma unroll
    for (int mt = 0; mt < 4; ++mt)
#pragma unroll
        for (int r = 0; r < 4; ++r) ost[(16 * mt + 4 * fq + r) * 132 + 16 * wave + fr] = o[mt][r];
    __syncthreads();
#pragma unroll
    for (int c2 = 0; c2 < 2; ++c2) { const int idx = tid + NTHR * c2, t = idx >> 4, ch = idx & 15;
        f32x4 o0 = *(const LAS f32x4*)(ost + t * 132 + 8 * ch), o1 = *(const LAS f32x4*)(ost + t * 132 + 8 * ch + 4);
        const float q = red16_sum((o0[0] * o0[0] + o0[1] * o0[1]) + (o0[2] * o0[2] + o0[3] * o0[3]) + (o1[0] * o1[0] + o1[1] * o1[1]) + (o1[2] * o1[2] + o1[3] * o1[3]));
        const float rs = rsqrtf(q * (1.f / 128.f) + 1e-6f); o0 = o0 * rs * g0[c2]; o1 = o1 * rs * g1[c2];
        u32x4 w;
        w.x = pk2(o0[0] * siluf(bflo(gv[c2].x)), o0[1] * siluf(bfhi(gv[c2].x))); w.y = pk2(o0[2] * siluf(bflo(gv[c2].y)), o0[3] * siluf(bfhi(gv[c2].y)));
        w.z = pk2(o1[0] * siluf(bflo(gv[c2].z)), o1[1] * siluf(bfhi(gv[c2].z))); w.w = pk2(o1[2] * siluf(bflo(gv[c2].w)), o1[3] * siluf(bfhi(gv[c2].w)));
        *(u32x4*)(Z + (size_t)(row0 + t) * DM + h * 128 + 8 * ch) = w; }
}
__device__ __forceinline__ void stage_state(LAS bf16* dst, const bf16* __restrict__ src) {
    const int tid = otid();
#pragma unroll
    for (int c2 = 0; c2 < 2; ++c2) { const int idx = tid + NTHR * c2, r = idx >> 4, ch = idx & 15; *(LAS u32x4*)(dst + r * 136 + 8 * ch) = *(const u32x4*)(src + r * 128 + 8 * ch); }
}
__device__ __forceinline__ void phase_scan_out_gla(KP p, LAS unsigned char* lds, int l, bool need_ctx) {
    const int tid = otid(), lane = tid & 63, wave = tid >> 6, fq = lane >> 4, fr = lane & 15; const int li = l >> 1;
    const bf16* P = (const bf16*)(p->ws + WS_P); const int ldp = NP_EVEN; const float* SM = (const float*)(p->ws + WS_SM); bf16* Z = (bf16*)(p->ws + WS_H);
    const bf16* S = (const bf16*)(p->ws + WS_S);
    LAS bf16* qf = (LAS bf16*)(lds + SO_QF); LAS bf16* kf = (LAS bf16*)(lds + SO_KF); LAS bf16* qb = (LAS bf16*)(lds + SO_QB); LAS bf16* kb = (LAS bf16*)(lds + SO_KB);
    LAS bf16* vs = (LAS bf16*)(lds + SO_VS); LAS bf16* Af = (LAS bf16*)(lds + SO_AF); LAS bf16* Ab = (LAS bf16*)(lds + SO_AB); LAS bf16* Sf = (LAS bf16*)(lds + SO_SF); LAS bf16* Sb = (LAS bf16*)(lds + SO_SB);
    LAS float* seg = (LAS float*)(lds + SO_SEG); LAS float* lrs = (LAS float*)(lds + SO_MISC);
    const int dk = tid & 63, sg = tid >> 6;
    for (int it = blockIdx.x; it < BATCH * 4 * NCHUNK; it += gridDim.x) {
        const int b = it / (4 * NCHUNK), h = (it / NCHUNK) & 3, cp = it % NCHUNK; if (cp < 4 && !need_ctx) continue;
        const int row0 = chunk_row0(b, cp); const int slf = ((b * 4 + h) * 2 + 0) * NCHUNK + cp, slb = slf + NCHUNK;
        __syncthreads();
#pragma unroll
        for (int c2 = 0; c2 < 2; ++c2) { const int idx = tid + NTHR * c2, t = idx >> 4, ch = idx & 15; *(LAS u32x4*)(vs + t * 136 + 8 * ch) = *(const u32x4*)(P + (size_t)(row0 + t) * ldp + 512 + h * 128 + 8 * ch); }
        stage_state(Sf, S + (size_t)slf * 8192); stage_state(Sb, S + (size_t)slb * 8192);
        float qv[8], kv[8];
#pragma unroll
        for (int tt = 0; tt < 8; ++tt) { const size_t ro = (size_t)(row0 + sg * 8 + tt) * ldp + h * 64 + dk; qv[tt] = bf2f(P[ro]); kv[tt] = bf2f(P[ro + 256]); }
        float gwf[16], gwb[16];
        const float* gw = p->gla_gate_w + (size_t)li * 2 * 16 * 256; const float* gb = p->gla_gate_b + (size_t)li * 2 * 256;
#pragma unroll
        for (int r = 0; r < 16; ++r) { gwf[r] = gw[r * 256 + h * 64 + dk]; gwb[r] = gw[(16 + r) * 256 + h * 64 + dk]; }
        const float gbf = gb[h * 64 + dk], gbb = gb[256 + h * 64 + dk];
        { const int t = tid >> 3, c4 = (tid & 7) * 4; *(LAS f32x4*)(lrs + t * 32 + c4) = *(const f32x4*)(SM + (size_t)(row0 + t) * 32 + c4); }
        __syncthreads();
        float pf[8], sb[8];
#pragma unroll
        for (int tt = 0; tt < 8; ++tt) { const LAS float* lr = lrs + (sg * 8 + tt) * 32; float zf = gbf, zb = gbb;
#pragma unroll
            for (int r = 0; r < 16; ++r) { zf += lr[r] * gwf[r]; zb += lr[16 + r] * gwb[r]; }
            pf[tt] = logsigf(zf) * 0.0625f; sb[tt] = logsigf(zb) * 0.0625f; }
#pragma unroll
        for (int tt = 1; tt < 8; ++tt) pf[tt] += pf[tt - 1];
#pragma unroll
        for (int tt = 6; tt >= 0; --tt) sb[tt] += sb[tt + 1];
        seg[(0 * 8 + sg) * 64 + dk] = pf[7]; seg[(1 * 8 + sg) * 64 + dk] = sb[0];
        __syncthreads();
        float offf = 0.f, offb = 0.f;
#pragma unroll
        for (int q = 0; q < 8; ++q) { const float a = seg[q * 64 + dk], c = seg[(8 + q) * 64 + dk]; if (q < sg) offf += a; if (q > sg) offb += c; }
#pragma unroll
        for (int tt = 0; tt < 8; ++tt) { const int t = sg * 8 + tt; const float bf_ = offf + pf[tt], bb_ = offb + sb[tt];
            qf[t * 72 + dk] = (bf16)f2bf(qv[tt] * __expf(bf_)); kf[t * 72 + dk] = (bf16)f2bf(kv[tt] * __expf(-bf_));
            qb[t * 72 + dk] = (bf16)f2bf(qv[tt] * __expf(bb_)); kb[t * 72 + dk] = (bf16)f2bf(kv[tt] * __expf(-bb_)); }
        __syncthreads();
        { const int mt = wave >> 1;
#pragma unroll
          for (int n2 = 0; n2 < 2; ++n2) { const int nt = 2 * (wave & 1) + n2; f32x4 af = (f32x4){0.f, 0.f, 0.f, 0.f}, ab = (f32x4){0.f, 0.f, 0.f, 0.f};
#pragma unroll
              for (int ks = 0; ks < 2; ++ks) { af = MFMA(frag_rm(qf, 72, 16 * mt, 32 * ks, lane), frag_rm(kf, 72, 16 * nt, 32 * ks, lane), af);
                                               ab = MFMA(frag_rm(qb, 72, 16 * mt, 32 * ks, lane), frag_rm(kb, 72, 16 * nt, 32 * ks, lane), ab); }
#pragma unroll
              for (int r = 0; r < 4; ++r) { const int t = 16 * mt + 4 * fq + r, s = 16 * nt + fr;
                  Af[t * 72 + s] = (bf16)f2bf(s <= t ? af[r] : 0.f); Ab[t * 72 + s] = (bf16)f2bf(s >= t ? ab[r] : 0.f); } } }
        __syncthreads();
        f32x4 o[4];
#pragma unroll
        for (int mt = 0; mt < 4; ++mt) o[mt] = (f32x4){0.f, 0.f, 0.f, 0.f};
#pragma unroll
        for (int ks = 0; ks < 2; ++ks) { const bf16x8 bv = frag_tr(vs, 136, 32 * ks, 16 * wave, lane), bsf = frag_tr(Sf, 136, 32 * ks, 16 * wave, lane), bsb = frag_tr(Sb, 136, 32 * ks, 16 * wave, lane);
#pragma unroll
            for (int mt = 0; mt < 4; ++mt) { o[mt] = MFMA(frag_rm(Af, 72, 16 * mt, 32 * ks, lane), bv, o[mt]); o[mt] = MFMA(frag_rm(Ab, 72, 16 * mt, 32 * ks, lane), bv, o[mt]);
                o[mt] = MFMA(frag_rm(qf, 72, 16 * mt, 32 * ks, lane), bsf, o[mt]); o[mt] = MFMA(frag_rm(qb, 72, 16 * mt, 32 * ks, lane), bsb, o[mt]); } }
        scan_out_tail(lds, o, P, ldp, Z, row0, h, p->gla_norm_g + (size_t)li * 512);
    }
}
constexpr int MO_QS = 0, MO_KS = 9216, MO_QWF = 18432, MO_QWB = 27648;
__device__ __forceinline__ void phase_scan_out_mlstm(KP p, LAS unsigned char* lds, int l, bool need_ctx) {
    const int tid = otid(), lane = tid & 63, wave = tid >> 6, fq = lane >> 4, fr = lane & 15; const int li = l >> 1;
    const bf16* P = (const bf16*)(p->ws + WS_P); const int ldp = NP_ODD; const float* SM = (const float*)(p->ws + WS_SM); bf16* Z = (bf16*)(p->ws + WS_H);
    const bf16* S = (const bf16*)(p->ws + WS_S); const float* GAM = (const float*)(p->ws + WS_GAM); const float* SC = (const float*)(p->ws + WS_SC);
    LAS bf16* qs = (LAS bf16*)(lds + MO_QS); LAS bf16* ks_ = (LAS bf16*)(lds + MO_KS); LAS bf16* qwf = (LAS bf16*)(lds + MO_QWF); LAS bf16* qwb = (LAS bf16*)(lds + MO_QWB);
    LAS bf16* vs = (LAS bf16*)(lds + SO_VS); LAS bf16* Af = (LAS bf16*)(lds + SO_AF); LAS bf16* Ab = (LAS bf16*)(lds + SO_AB); LAS bf16* Cf = (LAS bf16*)(lds + SO_SF); LAS bf16* Cb = (LAS bf16*)(lds + SO_SB);
    LAS float* part = (LAS float*)(lds + SO_SEG);
    LAS float* misc = (LAS float*)(lds + SO_MISC);
    const float* mb = p->ml_gate_b + li * 16;
    for (int it = blockIdx.x; it < BATCH * 4 * NCHUNK; it += gridDim.x) {
        const int b = it / (4 * NCHUNK), h = (it / NCHUNK) & 3, cp = it % NCHUNK; if (cp < 4 && !need_ctx) continue;
        const int row0 = chunk_row0(b, cp); const int slf = ((b * 4 + h) * 2 + 0) * NCHUNK + cp, slb = slf + NCHUNK;
        __syncthreads();
#pragma unroll
        for (int c2 = 0; c2 < 2; ++c2) { const int idx = tid + NTHR * c2, t = idx >> 4, ch = idx & 15; *(LAS u32x4*)(vs + t * 136 + 8 * ch) = *(const u32x4*)(P + (size_t)(row0 + t) * ldp + 512 + h * 128 + 8 * ch); }
        stage_state(Cf, S + (size_t)slf * 8192); stage_state(Cb, S + (size_t)slb * 8192);
        { const int t = tid >> 3, ch = tid & 7; const size_t ro = (size_t)(row0 + t) * ldp + h * 64 + 8 * ch;
          *(LAS u32x4*)(qs + t * 72 + 8 * ch) = *(const u32x4*)(P + ro); *(LAS u32x4*)(ks_ + t * 72 + 8 * ch) = *(const u32x4*)(P + ro + 256); }
        if (tid < 128) { const int d = tid >> 6, t = tid & 63; const float* gp = SM + (size_t)(row0 + t) * 32 + d * 8;
            misc[d * 512 + t] = gp[h] + mb[d * 8 + h]; misc[d * 512 + 64 + t] = logsigf(gp[4 + h] + mb[d * 8 + 4 + h]);
            misc[1024 + d * 64 + t] = GAM[(size_t)(d ? slb : slf) * 64 + t]; }
        __syncthreads();
        if (tid < 128) { const int d = tid >> 6, t = tid & 63; LAS float* md = misc + d * 512; const float run = wave_scan_sum(md[64 + t], t, d == 1); const float pm = wave_scan_max(md[t] - run, t, d == 1);
            const float mprev = SC[(size_t)(d ? slb : slf) * 4 + 2];
            const float mt_ = fmaxf(run + pm, run + mprev);
            md[128 + t] = run; md[192 + t] = mt_; md[256 + t] = __expf(run + mprev - mt_); }
        __syncthreads();
        { const int t = tid >> 3, ch = tid & 7; const u32x4 qv = *(const LAS u32x4*)(qs + t * 72 + 8 * ch); const float wf = misc[256 + t], wb = misc[512 + 256 + t];
          u32x4 a, c;
          a.x = pk2(bflo(qv.x) * wf, bfhi(qv.x) * wf); a.y = pk2(bflo(qv.y) * wf, bfhi(qv.y) * wf); a.z = pk2(bflo(qv.z) * wf, bfhi(qv.z) * wf); a.w = pk2(bflo(qv.w) * wf, bfhi(qv.w) * wf);
          c.x = pk2(bflo(qv.x) * wb, bfhi(qv.x) * wb); c.y = pk2(bflo(qv.y) * wb, bfhi(qv.y) * wb); c.z = pk2(bflo(qv.z) * wb, bfhi(qv.z) * wb); c.w = pk2(bflo(qv.w) * wb, bfhi(qv.w) * wb);
          *(LAS u32x4*)(qwf + t * 72 + 8 * ch) = a; *(LAS u32x4*)(qwb + t * 72 + 8 * ch) = c;
          const float q0 = bflo(qv.x), q1 = bfhi(qv.x), q2 = bflo(qv.y), q3 = bfhi(qv.y), q4 = bflo(qv.z), q5 = bfhi(qv.z), q6 = bflo(qv.w), q7 = bfhi(qv.w);
#pragma unroll
          for (int d = 0; d < 2; ++d) { const LAS float* nv = misc + 1024 + d * 64 + 8 * ch;
              part[(d * 8 + ch) * 64 + t] = q0 * nv[0] + q1 * nv[1] + q2 * nv[2] + q3 * nv[3] + q4 * nv[4] + q5 * nv[5] + q6 * nv[6] + q7 * nv[7]; } }
        { const int mt = wave >> 1; float rsf[4] = {0.f, 0.f, 0.f, 0.f}, rsb[4] = {0.f, 0.f, 0.f, 0.f};
#pragma unroll
          for (int n2 = 0; n2 < 2; ++n2) { const int nt = 2 * (wave & 1) + n2; f32x4 a = (f32x4){0.f, 0.f, 0.f, 0.f};
#pragma unroll
              for (int ks = 0; ks < 2; ++ks) a = MFMA(frag_rm(qs, 72, 16 * mt, 32 * ks, lane), frag_rm(ks_, 72, 16 * nt, 32 * ks, lane), a);
#pragma unroll
              for (int r = 0; r < 4; ++r) { const int t = 16 * mt + 4 * fq + r, s = 16 * nt + fr;
                  const float wf = s <= t ? __expf(misc[128 + t] - misc[128 + s] + misc[s] - misc[192 + t]) : 0.f;
                  const float wb = s >= t ? __expf(misc[512 + 128 + t] - misc[512 + 128 + s] + misc[512 + s] - misc[512 + 192 + t]) : 0.f;
                  const float vf = a[r] * wf, vb = a[r] * wb; rsf[r] += vf; rsb[r] += vb;
                  Af[t * 72 + s] = (bf16)f2bf(vf); Ab[t * 72 + s] = (bf16)f2bf(vb); } }
#pragma unroll
          for (int r = 0; r < 4; ++r) { const float a = red16_sum(rsf[r]), c = red16_sum(rsb[r]);
              if (fr == 0) { misc[1152 + (0 * 2 + (wave & 1)) * 64 + 16 * mt + 4 * fq + r] = a; misc[1152 + (1 * 2 + (wave & 1)) * 64 + 16 * mt + 4 * fq + r] = c; } } }
        __syncthreads();
        if (tid < 128) { const int d = tid >> 6, t = tid & 63; float qn = 0.f;
#pragma unroll
            for (int q = 0; q < 8; ++q) qn += part[(d * 8 + q) * 64 + t];
            const float den = misc[1152 + (d * 2 + 0) * 64 + t] + misc[1152 + (d * 2 + 1) * 64 + t] + misc[d * 512 + 256 + t] * qn;
            misc[d * 512 + 320 + t] = 1.f / fmaxf(fabsf(den), __expf(-misc[d * 512 + 192 + t])); }
        f32x4 of[4], ob[4];
#pragma unroll
        for (int mt = 0; mt < 4; ++mt) { of[mt] = (f32x4){0.f, 0.f, 0.f, 0.f}; ob[mt] = (f32x4){0.f, 0.f, 0.f, 0.f}; }
#pragma unroll
        for (int ks = 0; ks < 2; ++ks) { const bf16x8 bv = frag_tr(vs, 136, 32 * ks, 16 * wave, lane), bcf = frag_tr(Cf, 136, 32 * ks, 16 * wave, lane), bcb = frag_tr(Cb, 136, 32 * ks, 16 * wave, lane);
#pragma unroll
            for (int mt = 0; mt < 4; ++mt) { of[mt] = MFMA(frag_rm(Af, 72, 16 * mt, 32 * ks, lane), bv, of[mt]); of[mt] = MFMA(frag_rm(qwf, 72, 16 * mt, 32 * ks, lane), bcf, of[mt]);
                ob[mt] = MFMA(frag_rm(Ab, 72, 16 * mt, 32 * ks, lane), bv, ob[mt]); ob[mt] = MFMA(frag_rm(qwb, 72, 16 * mt, 32 * ks, lane), bcb, ob[mt]); } }
        __syncthreads();
        f32x4 o[4];
#pragma unroll
        for (int mt = 0; mt < 4; ++mt)
#pragma unroll
            for (int r = 0; r < 4; ++r) { const int t = 16 * mt + 4 * fq + r; o[mt][r] = of[mt][r] * misc[320 + t] + ob[mt][r] * misc[512 + 320 + t]; }
        scan_out_tail(lds, o, P, ldp, Z, row0, h, p->ml_norm_g + (size_t)li * 512);
    }
}
#define XB_TMO      128
#define XB_XCNT(j)  (256  + 64 * (j))
#define XB_XSUB(j)  (1280 + 64 * (j))
#define XB_XGEN(j)  (2304 + 64 * (j))
#define XB_TOP      3328
#define XB_TOPGEN   3392
#define XCD_BAR_WORDS 3456
#define XB_SPIN_CAP (1u << 18)

__device__ __forceinline__ unsigned xb_ld(unsigned* p)              { return __hip_atomic_load(p, __ATOMIC_RELAXED, __HIP_MEMORY_SCOPE_AGENT); }
__device__ __forceinline__ unsigned xb_add(unsigned* p, unsigned v) { return __hip_atomic_fetch_add(p, v, __ATOMIC_RELAXED, __HIP_MEMORY_SCOPE_AGENT); }
__device__ __forceinline__ unsigned xb_xcc_id() { return (unsigned)__builtin_amdgcn_s_getreg((3 << 11) | 20) & 0xFu; }
#define XB_SPIN(cond, bar) do { unsigned _sp = 0; while (cond) { __builtin_amdgcn_s_sleep(1); \
    if ((++_sp & 255u) == 0u) { if (xb_ld(&(bar)[XB_TMO])) break; if (_sp > XB_SPIN_CAP) { atomicAdd(&(bar)[XB_TMO], 1u); break; } } } } while (0)

struct XcdBarrier {
    unsigned* bar; unsigned x;
    volatile LAS unsigned* st;
};

__device__ __forceinline__ XcdBarrier xcd_barrier_post(unsigned* bar, volatile LAS unsigned* st) {
    XcdBarrier b; b.bar = bar; b.x = xb_xcc_id(); b.st = st;
    if (otid() == 0) (void)xb_add(&bar[XB_XCNT(b.x)], 1u);
    return b;
}
__device__ __forceinline__ void xcd_barrier_complete(unsigned* bar, unsigned x, unsigned& nloc, unsigned& nx) {
    const unsigned G = gridDim.x * gridDim.y * gridDim.z;
    unsigned sum, cnt, mine, sp = 0u;
    for (;;) {
        sum = 0u; cnt = 0u; mine = 0u;
#pragma unroll
        for (unsigned j = 0; j < 16; ++j) { const unsigned c = xb_ld(&bar[XB_XCNT(j)]); sum += c; cnt += (c > 0u) ? 1u : 0u; mine = (j == x) ? c : mine; }
        if (sum == G) break;
        __builtin_amdgcn_s_sleep(1);
        if ((++sp & 255u) == 0u) { if (xb_ld(&bar[XB_TMO])) break; if (sp > XB_SPIN_CAP) { atomicAdd(&bar[XB_TMO], 1u); break; } }
    }
    nloc = mine > 0u ? mine : 1u; nx = cnt > 0u ? cnt : 1u;
}

__device__ __forceinline__ void xcd_barrier(const XcdBarrier& b) {
    asm volatile("s_waitcnt vmcnt(0)" ::: "memory");
    __syncthreads();
    if (otid() == 0) {
        unsigned* bar = b.bar;
        __builtin_amdgcn_s_waitcnt(0);
        unsigned nloc = b.st[0], nx = b.st[1];
        if (nloc == 0u) { xcd_barrier_complete(bar, b.x, nloc, nx); b.st[0] = nloc; b.st[1] = nx; }
        const unsigned old = xb_add(&bar[XB_XSUB(b.x)], 1u);
        const unsigned gen = old / nloc;
        if (old + 1u == (gen + 1u) * nloc) {
            __builtin_amdgcn_fence(__ATOMIC_RELEASE, "agent");
            asm volatile("s_waitcnt vmcnt(0)" ::: "memory");
            const unsigned og = xb_add(&bar[XB_TOP], 1u);
            const unsigned tg = og / nx;
            if (og + 1u == (tg + 1u) * nx) xb_add(&bar[XB_TOPGEN], 1u);
            else XB_SPIN(xb_ld(&bar[XB_TOPGEN]) == tg, bar);
            __builtin_amdgcn_fence(__ATOMIC_ACQUIRE, "agent");
            xb_add(&bar[XB_XGEN(b.x)], 1u);
            asm volatile("s_waitcnt vmcnt(0)" ::: "memory");
        } else {
            XB_SPIN(xb_ld(&bar[XB_XGEN(b.x)]) == gen, bar);
            __builtin_amdgcn_fence(__ATOMIC_ACQUIRE, "agent");
            asm volatile("s_waitcnt vmcnt(0)" ::: "memory");
        }
    }
    __syncthreads();
}

#define REP_GEMM 1
#define REP_ATT 1
#define REP_LOC 1
#define REP_OUT 1
#define REP_PRO 1
#define REP_SEQ 1
#define REP_LN 1
#ifndef MK_N_LAUNCHES
#define MK_N_LAUNCHES 1
#endif
constexpr int N_PHASES = 2 + 6 * DEPTH;
__global__ void __launch_bounds__(NTHR, 2) fwd_megakernel(Params p_unused) {
    extern __shared__ __attribute__((aligned(16))) unsigned char lds_raw[];
    LAS unsigned char* lds = (LAS unsigned char*)lds_raw;
    cg::grid_group grid = cg::this_grid();
    const int lo = (int)kparams()->ph_lo, hi = (int)kparams()->ph_hi;
#define IN(k) (lo <= (k) && (k) < hi)
    volatile LAS unsigned* bst = (volatile LAS unsigned*)(lds + LDS_BYTES - 64);
    if (otid() < 16) bst[otid()] = 0u;
    __syncthreads();
    XcdBarrier bar = xcd_barrier_post((unsigned*)(kparams()->ws + WS_BAR), bst);
#define SEAM(k) do { if (IN(k) && IN((k) + 1)) { if ((k) == 0) grid.sync(); else xcd_barrier(bar); } } while (0)
    if (IN(0)) { for (int rep = 0; rep < REP_PRO; ++rep) { phase_prologue(kparams(), lds); __syncthreads(); } } SEAM(0);
    if (IN(1)) { for (int rep = 0; rep < REP_PRO; ++rep) phase_h0(kparams()); } SEAM(1);
#pragma unroll 1
    for (int l = 0; l < DEPTH; ++l) {
        const int pb = 2 + 6 * l; const bool odd = l & 1; const int li = l >> 1; const bool need_ctx = l < DEPTH - 1;
        if (IN(pb + 0)) {
            const int npad = odd ? NPAD_ODD : NPAD_EVEN; unsigned char* ws = kparams()->ws;
            pg8::Gemm g{(const pg8::bf16_t*)(ws + WS_H), (const pg8::bf16_t*)(ws + (odd ? WS_WIO : WS_WIE)) + (size_t)li * npad * 1024, MTOT, npad, 1024};
            pg8::StaticOrder S; S.init(MTOT, npad, (int)gridDim.x, (int)blockIdx.x);
            pg8::EpiProj E{(pg8::bf16_t*)(ws + WS_P), odd ? NP_ODD : NP_EVEN, (float*)(ws + WS_SM), odd ? 16 : 32, npad / 256 - 1, odd ? 1 : 0, (const float*)(ws + WS_ROPE), (const float*)(ws + WS_ROPE) + 1024};
            for (int rep = 0; rep < REP_GEMM; ++rep) pg8::gemm_phase<pg8::EpiProj, pg8::StaticOrder, true, true>(lds, g, S, E);
        }
        SEAM(pb + 0);
        if (IN(pb + 1)) { for (int rep = 0; rep < REP_ATT; ++rep) phase_attn(kparams(), lds, l, need_ctx); for (int rep = 0; rep < REP_LOC; ++rep) phase_scan_local(kparams(), lds, l); }
        SEAM(pb + 1);
        if (IN(pb + 2)) { for (int rep = 1; rep < REP_SEQ; ++rep) { phase_scan_seq(kparams(), l, true); __syncthreads(); } phase_scan_seq(kparams(), l); }
        SEAM(pb + 2);
        if (IN(pb + 3)) { for (int rep = 0; rep < REP_OUT; ++rep) { if (odd) phase_scan_out_mlstm(kparams(), lds, l, need_ctx); else phase_scan_out_gla(kparams(), lds, l, need_ctx); } }
        SEAM(pb + 3);
        if (IN(pb + 4)) {
            const int mrows = need_ctx ? MTOT : MLAT; unsigned char* ws = kparams()->ws;
            pg8::Gemm g{(const pg8::bf16_t*)(ws + WS_H), (const pg8::bf16_t*)(ws + WS_WO) + (size_t)l * 1024 * 1024, mrows, 1024, 1024};
            pg8::StaticOrder S; S.init(mrows, 1024, (int)gridDim.x, (int)blockIdx.x);
            pg8::EpiProj E{(pg8::bf16_t*)(ws + WS_P), 1024, nullptr, 0, -1, 0, nullptr, nullptr};
            for (int rep = 0; rep < REP_GEMM; ++rep) pg8::gemm_phase<pg8::EpiProj, pg8::StaticOrder, true, true>(lds, g, S, E);
        }
        SEAM(pb + 4);
        if (IN(pb + 5)) { for (int rep = 1; rep < REP_LN; ++rep) { phase_ln(kparams(), l, true); } phase_ln(kparams(), l); }
        SEAM(pb + 5);
    }
}
extern "C" void kernel_launch(void* const* d_in, const int* in_sizes, int n_in, void* d_out, int out_size, void* d_ws, size_t ws_size, hipStream_t stream) {
    static int grid = 0;
    if (grid == 0) {
        if (n_in != 19 || ws_size < WS_END) { fprintf(stderr, "kernel_launch: need 19 inputs and %zu bytes of workspace; got %d, %zu\n", (size_t)WS_END, n_in, ws_size); grid = -1; return; }
        int dev = 0, cus = 0, per_cu = 0;
        if (hipGetDevice(&dev) != hipSuccess || hipDeviceGetAttribute(&cus, hipDeviceAttributeMultiprocessorCount, dev) != hipSuccess) { grid = -1; return; }
        if (hipFuncSetAttribute((const void*)fwd_megakernel, hipFuncAttributeMaxDynamicSharedMemorySize, LDS_BYTES) != hipSuccess) { fprintf(stderr, "kernel_launch: hipFuncSetAttribute failed\n"); grid = -1; return; }
        if (hipOccupancyMaxActiveBlocksPerMultiprocessor(&per_cu, (const void*)fwd_megakernel, NTHR, LDS_BYTES) != hipSuccess || per_cu < 1) per_cu = 1;
        grid = cus * per_cu;
    }
    if (grid < 0) return;
    Params p{};
    p.x = (const float*)d_in[0]; p.c = (const float*)d_in[1]; p.ctx = (const float*)d_in[2]; p.c_ctx = (const float*)d_in[3]; p.w_ada = (const float*)d_in[4]; p.b_ada = (const float*)d_in[5];
    p.ln_g = (const float*)d_in[6]; p.ln_b = (const float*)d_in[7]; p.w_in_even = (const float*)d_in[8]; p.w_out_even = (const float*)d_in[9]; p.gla_gate_w = (const float*)d_in[10]; p.gla_gate_b = (const float*)d_in[11];
    p.gla_norm_g = (const float*)d_in[12]; p.na_rpb = (const float*)d_in[13]; p.w_in_odd = (const float*)d_in[14]; p.w_out_odd = (const float*)d_in[15]; p.ml_gate_b = (const float*)d_in[16]; p.ml_norm_g = (const float*)d_in[17];
    p.sw_sink = (const float*)d_in[18]; p.out = (float*)d_out; p.ws = (unsigned char*)d_ws;
    if (hipMemsetAsync((char*)d_ws + WS_BAR, 0, XCD_BAR_WORDS * 4, stream) != hipSuccess) { fprintf(stderr, "kernel_launch: memset failed\n"); return; }
#if MK_N_LAUNCHES == 1
    p.ph_lo = 0; p.ph_hi = N_PHASES;
    void* args[] = {&p};
    hipError_t e = hipLaunchCooperativeKernel((const void*)fwd_megakernel, dim3(grid), dim3(NTHR), args, LDS_BYTES, stream);
    if (e != hipSuccess) fprintf(stderr, "kernel_launch: cooperative launch failed: %s (grid %d)\n", hipGetErrorString(e), grid);
#else
    for (int k = 0; k < N_PHASES; ++k) { p.ph_lo = k; p.ph_hi = k + 1; hipLaunchKernelGGL(fwd_megakernel, dim3(grid), dim3(NTHR), LDS_BYTES, stream, p); }
#endif
}
```

```cpp
#include <hip/hip_runtime.h>
#include <hip/hip_cooperative_groups.h>
#include <cstdio>
#include <cstdint>
namespace cg = cooperative_groups;
__device__ __forceinline__ int otid() { int t = threadIdx.x; asm volatile("" : "+v"(t)); return t; }
namespace pg8 {
#define PG8_LAS __attribute__((address_space(3)))
typedef unsigned short bf16_t;
typedef short bf16x8 __attribute__((ext_vector_type(8)));
typedef float f32x4 __attribute__((ext_vector_type(4)));
typedef unsigned u32x4 __attribute__((ext_vector_type(4)));
constexpr int BM = 256, BK = 64, HALF = 128, HTB = HALF * BK * 2  , STAGE_BYTES = 8 * HTB, NXCD = 8, WGM = 8;

__host__ __device__ __forceinline__ int lds_byte(int r, int c) { const int st = (r >> 4) * 2 + (c >> 5), rr = r & 15, cc = c & 31, ob = rr * 64 + cc * 2; return st * 1024 + (ob ^ (((ob >> 9) & 1) << 5)); }
__host__ __device__ __forceinline__ void stage_rc(int b, int& R, int& C) { const int st = b / 1024, sb = b % 1024, swz = sb ^ (((sb >> 9) & 1) << 5); R = (st >> 1) * 16 + swz / 64; C = (st & 1) * 32 + (swz % 64) / 2; }
__host__ __device__ __forceinline__ int perm32(int rho) { const int n = rho >> 4, i = rho & 15; return 8 * (i >> 2) + 4 * n + (i & 3); }

struct Unit { int pm, pn; };
struct Gemm { const bf16_t* A; const bf16_t* Bt; int M, N, K; };

struct StaticOrder {
    int nM, nN, nwg, G, c;
    __host__ __device__ void init(int M, int N, int G_, int c_) { nM = M / BM; nN = N / BM; nwg = nM * nN; G = G_; c = c_; }
    __host__ __device__ bool next(int i, Unit& u) const {
        const long L = (long)i * G + c; if (L >= nwg) return false;
        int wgid = (int)L; { const int q = nwg / NXCD, r = nwg % NXCD, xcd = wgid % NXCD, off = wgid / NXCD; wgid = (xcd < r ? xcd * (q + 1) : r * (q + 1) + (xcd - r) * q) + off; }
        const int nig = WGM * nN, gid = wgid / nig, fm = gid * WGM, gsz = (nM - fm) < WGM ? (nM - fm) : WGM;
        u.pm = fm + ((wgid % nig) % gsz); u.pn = (wgid % nig) / gsz; return true;
    }
    __device__ __forceinline__ void a_ready(const Unit&) const {}
    __device__ __forceinline__ void done(const Unit&) const {}
};

__device__ __forceinline__ unsigned cvt_pk_bf16(float lo, float hi) { unsigned r; asm volatile("v_cvt_pk_bf16_f32 %0, %1, %2" : "=v"(r) : "v"(lo), "v"(hi)); return r; }
struct EpiProj {
    static constexpr bool PERM = true, AFTER_DRAIN = false;
    bf16_t* P; int ldp; float* SM; int nsm; int last_pn; int rope; const float* cosT; const float* sinT;
    __device__ __forceinline__ void operator()(const f32x4 (&acc)[2][2][4][2], const Unit& u, int wr, int wc, int fr, int fq) const {
        const int row0 = u.pm * BM + wr * 64 + fr;
        if (u.pn == last_pn) {
            if (wc == 0) {
#pragma unroll
                for (int ai = 0; ai < 2; ++ai)
#pragma unroll
                    for (int m = 0; m < 4; ++m) { const int row = row0 + ai * HALF + m * 16;
#pragma unroll
                        for (int n = 0; n < 2; ++n) { const int col = 8 * fq + 4 * n; if (col < nsm) *(f32x4*)(SM + (size_t)row * 32 + col) = acc[ai][0][m][n]; } }
            }
            return;
        }
        const bool do_rope_tile = rope && (u.pn == 6 || u.pn == 7 || u.pn == 8) && (u.pm * BM < 32768);
#pragma unroll
        for (int ai = 0; ai < 2; ++ai)
#pragma unroll
            for (int m = 0; m < 4; ++m) { const int row = row0 + ai * HALF + m * 16; bf16_t* rowp = P + (size_t)row * ldp + u.pn * BM + wc * 32 + 8 * fq;
#pragma unroll
                for (int bj = 0; bj < 2; ++bj) { f32x4 v0 = acc[ai][bj][m][0], v1 = acc[ai][bj][m][1];
                    if (do_rope_tile && (u.pn != 8 || bj == 0)) {
                        const int t = row & 4095; const int pos = (wc & 1) ? (t & 63) : (t >> 6); const int i0 = pos * 16 + 8 * (fq & 1);
                        const f32x4 c0 = *(const f32x4*)(cosT + i0), c1 = *(const f32x4*)(cosT + i0 + 4), s0 = *(const f32x4*)(sinT + i0), s1 = *(const f32x4*)(sinT + i0 + 4);
                        f32x4 p0, p1;
#pragma unroll
                        for (int e = 0; e < 4; ++e) { p0[e] = __shfl_xor(v0[e], 32); p1[e] = __shfl_xor(v1[e], 32); }
                        if (fq < 2) { v0 = v0 * c0 - p0 * s0; v1 = v1 * c1 - p1 * s1; } else { v0 = p0 * s0 + v0 * c0; v1 = p1 * s1 + v1 * c1; }
                    }
                    u32x4 w; w.x = cvt_pk_bf16(v0[0], v0[1]); w.y = cvt_pk_bf16(v0[2], v0[3]); w.z = cvt_pk_bf16(v1[0], v1[1]); w.w = cvt_pk_bf16(v1[2], v1[3]);
                    *(u32x4*)(rowp + bj * HALF) = w; } }
    }
};
template <class Epi, class Sched, bool ALIGN_EPI = false, bool SP2 = false>
__device__ __forceinline__ void gemm_phase(PG8_LAS unsigned char* lds, const Gemm g, const Sched& S, const Epi& E) {
    const int tid = otid(), wid = __builtin_amdgcn_readfirstlane(tid >> 6), lane = tid & 63, wr = wid >> 2, wc = wid & 3, fr = lane & 15, fq = lane >> 4;
    const int K = g.K, nt = K / BK;
    unsigned voffA[2], voffB[2];
#pragma unroll
    for (int i = 0; i < 2; ++i) { int R, C; stage_rc(tid * 16 + i * 8192, R, C); const int Rb = Epi::PERM ? ((R & ~31) + perm32(R & 31)) : R;
        voffA[i] = (unsigned)(R * K + C) * 2u; voffB[i] = (unsigned)(Rb * K + C) * 2u; }
    const size_t kstep = (size_t)(BK * 2);
    const size_t hstep = (size_t)HALF * K * 2;
    const size_t tstep = 2 * hstep;
    const unsigned ldsw = (unsigned)wid * 1024u;
    const int aoff = lds_byte(wr * 64 + fr, fq * 8), boff = lds_byte(wc * 32 + fr, fq * 8);
#define PG8_SA(b, h) (((b) * 2 + (h)) * HTB)
#define PG8_SB(b, h) ((4 + (b) * 2 + (h)) * HTB)
#define PG8_STAGE(bufoff, gbase, voff) do { _Pragma("unroll") for (int _i = 0; _i < 2; ++_i) \
        __builtin_amdgcn_global_load_lds((const unsigned*)((const char*)(gbase) + (voff)[_i]), (PG8_LAS unsigned*)(lds + (bufoff) + ldsw + _i * 8192), 16, 0, 0); } while (0)
#define PG8_LDA(dst, b, h) do { _Pragma("unroll") for (int m = 0; m < 4; ++m) _Pragma("unroll") for (int k = 0; k < 2; ++k) dst[m][k] = *(const PG8_LAS bf16x8*)(lds + PG8_SA(b, h) + aoff + m * 2048 + k * 1024); } while (0)
#define PG8_LDB(dst, b, h) do { _Pragma("unroll") for (int n = 0; n < 2; ++n) _Pragma("unroll") for (int k = 0; k < 2; ++k) dst[n][k] = *(const PG8_LAS bf16x8*)(lds + PG8_SB(b, h) + boff + n * 2048 + k * 1024); } while (0)
#define PG8_MMA(ai, bj, At, Bt) do { __builtin_amdgcn_s_setprio(1); _Pragma("unroll") for (int m = 0; m < 4; ++m) _Pragma("unroll") for (int n = 0; n < 2; ++n) _Pragma("unroll") for (int k = 0; k < 2; ++k) \
        acc[ai][bj][m][n] = __builtin_amdgcn_mfma_f32_16x16x32_bf16(Bt[n][k], At[m][k], acc[ai][bj][m][n], 0, 0, 0); __builtin_amdgcn_s_setprio(0); } while (0)
#define PG8_WAIT_V(n) asm volatile("s_waitcnt vmcnt(" #n ")" ::: "memory")
#define PG8_WAIT_L(n) asm volatile("s_waitcnt lgkmcnt(" #n ")" ::: "memory")
#define PG8_BAR __builtin_amdgcn_s_barrier()
#define PG8_SCHED __builtin_amdgcn_sched_barrier(0)
    Unit cur, nxt; int ui = 0;
    if (!S.next(0, cur)) return;
    f32x4 acc[2][2][4][2];
#pragma unroll
    for (int a = 0; a < 2; ++a)
#pragma unroll
        for (int b = 0; b < 2; ++b)
#pragma unroll
            for (int m = 0; m < 4; ++m)
#pragma unroll
                for (int n = 0; n < 2; ++n) acc[a][b][m][n] = (f32x4){0.f, 0.f, 0.f, 0.f};
    bf16x8 At[4][2], B0[2][2], B1[2][2];
    const char* cA = (const char*)g.A + (size_t)cur.pm * tstep; const char* cB = (const char*)g.Bt + (size_t)cur.pn * tstep;
    S.a_ready(cur);
    if constexpr (SP2) {
        PG8_STAGE(PG8_SB(0, 0), cB, voffB); PG8_STAGE(PG8_SB(0, 1), cB + hstep, voffB); PG8_STAGE(PG8_SA(0, 0), cA, voffA); PG8_STAGE(PG8_SA(0, 1), cA + hstep, voffA);
        if (wr == 1) PG8_BAR;
        PG8_WAIT_V(2); PG8_BAR;
        PG8_STAGE(PG8_SB(1, 0), cB + kstep, voffB); PG8_STAGE(PG8_SA(1, 0), cA + kstep, voffA); PG8_STAGE(PG8_SB(1, 1), cB + hstep + kstep, voffB);
        PG8_WAIT_V(6); PG8_BAR;
    } else {
        PG8_STAGE(PG8_SB(0, 0), cB, voffB); PG8_STAGE(PG8_SA(0, 0), cA, voffA); PG8_STAGE(PG8_SB(0, 1), cB + hstep, voffB); PG8_STAGE(PG8_SA(0, 1), cA + hstep, voffA);
        if (wr == 1) PG8_BAR;
        PG8_WAIT_V(4); PG8_BAR;
        PG8_STAGE(PG8_SB(1, 0), cB + kstep, voffB); PG8_STAGE(PG8_SA(1, 0), cA + kstep, voffA); PG8_STAGE(PG8_SB(1, 1), cB + hstep + kstep, voffB);
        PG8_WAIT_V(6); PG8_BAR;
    }
    for (;;) {
        const bool has_next = S.next(ui + 1, nxt);
        const char* nA = has_next ? (const char*)g.A + (size_t)nxt.pm * tstep : cA; const char* nB = has_next ? (const char*)g.Bt + (size_t)nxt.pn * tstep : cB;
        for (int t = 0; t < nt; t += 2) {
            const bool last = (t == nt - 2);
            const char* a1 = cA + (size_t)(t + 1) * kstep;
            const char* a2 = last ? nA : cA + (size_t)(t + 2) * kstep; const char* b2 = last ? nB : cB + (size_t)(t + 2) * kstep;
            const char* a3 = a2 + kstep; const char* b3 = b2 + kstep;
            if (last && has_next) S.a_ready(nxt);
            if constexpr (SP2) {
            PG8_LDB(B0, 0, 0); PG8_LDB(B1, 0, 1); PG8_SCHED; PG8_LDA(At, 0, 0); PG8_STAGE(PG8_SA(1, 1), a1 + hstep, voffA);
            PG8_WAIT_V(8); PG8_WAIT_L(0); PG8_BAR; PG8_MMA(0, 0, At, B0); PG8_MMA(0, 1, At, B1); PG8_BAR; PG8_SCHED;
            PG8_LDA(At, 0, 1); PG8_STAGE(PG8_SB(0, 0), b2, voffB); PG8_STAGE(PG8_SB(0, 1), b2 + hstep, voffB); PG8_STAGE(PG8_SA(0, 0), a2, voffA);
            PG8_WAIT_V(8); PG8_WAIT_L(0); PG8_BAR; PG8_MMA(1, 0, At, B0); PG8_MMA(1, 1, At, B1); PG8_BAR; PG8_SCHED;
            PG8_LDB(B0, 1, 0); PG8_LDB(B1, 1, 1); PG8_SCHED; PG8_LDA(At, 1, 0); PG8_STAGE(PG8_SA(0, 1), a2 + hstep, voffA);
            PG8_WAIT_V(8); PG8_WAIT_L(0); PG8_BAR; PG8_MMA(0, 0, At, B0); PG8_MMA(0, 1, At, B1); PG8_BAR; PG8_SCHED;
            PG8_LDA(At, 1, 1); PG8_STAGE(PG8_SB(1, 0), b3, voffB); PG8_STAGE(PG8_SB(1, 1), b3 + hstep, voffB); PG8_STAGE(PG8_SA(1, 0), a3, voffA);
            PG8_WAIT_V(8); PG8_WAIT_L(0); PG8_BAR; PG8_MMA(1, 0, At, B0); PG8_MMA(1, 1, At, B1); PG8_BAR; PG8_SCHED;
            } else {
            PG8_LDB(B0, 0, 0); PG8_SCHED; PG8_LDA(At, 0, 0); PG8_STAGE(PG8_SA(1, 1), a1 + hstep, voffA);
            PG8_WAIT_L(8); PG8_BAR; PG8_WAIT_L(0); PG8_MMA(0, 0, At, B0); PG8_BAR; PG8_SCHED;
            PG8_LDB(B1, 0, 1); PG8_STAGE(PG8_SB(0, 0), b2, voffB);
            PG8_BAR; PG8_WAIT_L(0); PG8_MMA(0, 1, At, B1); PG8_BAR;
            PG8_LDA(At, 0, 1); PG8_STAGE(PG8_SA(0, 0), a2, voffA);
            PG8_BAR; PG8_WAIT_L(0); PG8_MMA(1, 0, At, B0); PG8_BAR; PG8_SCHED;
            PG8_STAGE(PG8_SB(0, 1), b2 + hstep, voffB);
            PG8_WAIT_V(6); PG8_BAR; PG8_MMA(1, 1, At, B1); PG8_BAR;
            PG8_LDB(B0, 1, 0); PG8_SCHED; PG8_LDA(At, 1, 0); PG8_STAGE(PG8_SA(0, 1), a2 + hstep, voffA);
            PG8_WAIT_L(8); PG8_BAR; PG8_WAIT_L(0); PG8_MMA(0, 0, At, B0); PG8_BAR; PG8_SCHED;
            PG8_LDB(B1, 1, 1); PG8_STAGE(PG8_SB(1, 0), b3, voffB);
            PG8_BAR; PG8_WAIT_L(0); PG8_MMA(0, 1, At, B1); PG8_BAR;
            PG8_LDA(At, 1, 1); PG8_STAGE(PG8_SA(1, 0), a3, voffA);
            PG8_BAR; PG8_WAIT_L(0); PG8_MMA(1, 0, At, B0); PG8_BAR; PG8_SCHED;
            PG8_STAGE(PG8_SB(1, 1), b3 + hstep, voffB);
            PG8_WAIT_V(6); PG8_BAR; PG8_MMA(1, 1, At, B1); PG8_BAR;
            }
        }
        if constexpr (ALIGN_EPI) { if (wr == 0) PG8_BAR; }
        if constexpr (!Epi::AFTER_DRAIN) { E(acc, cur, wr, wc, fr, fq); S.done(cur); }
        if (!has_next) break;
#pragma unroll
        for (int a = 0; a < 2; ++a)
#pragma unroll
            for (int b = 0; b < 2; ++b)
#pragma unroll
                for (int m = 0; m < 4; ++m)
#pragma unroll
                    for (int n = 0; n < 2; ++n) acc[a][b][m][n] = (f32x4){0.f, 0.f, 0.f, 0.f};
        cur = nxt; cA = nA; cB = nB; ++ui;
        if constexpr (ALIGN_EPI) { if (wr == 1) PG8_BAR; }
    }
    PG8_WAIT_V(0);
    if constexpr (!ALIGN_EPI) { if (wr == 0) PG8_BAR; }
    PG8_BAR;
    if constexpr (Epi::AFTER_DRAIN) { E.fused(acc, cur, wr, wc, fr, fq, lds, wid, lane); S.done(cur); }
#undef PG8_SA
#undef PG8_SB
#undef PG8_STAGE
#undef PG8_LDA
#undef PG8_LDB
#undef PG8_MMA
#undef PG8_WAIT_V
#undef PG8_WAIT_L
#undef PG8_BAR
#undef PG8_SCHED
}
}
constexpr int NWAVES = 8, NTHR = 512;
constexpr int BATCH = 8, SEQ = 4096, DM = 1024, CTXL = 256, DEPTH = 4;
constexpr int MLAT = BATCH * SEQ, MCTX = BATCH * CTXL, MTOT = MLAT + MCTX;
constexpr int NP_EVEN = 3584, NPAD_EVEN = 3840, NORIG_EVEN = 3616;
constexpr int NP_ODD = 2816, NPAD_ODD = 3072, NORIG_ODD = 2832;
constexpr int NCHUNK = 68;
constexpr int NSLOT = BATCH * 4 * 2 * NCHUNK;
constexpr float ALPHA_DN = 1.681792830507429f;
constexpr size_t MiB = 1u << 20;
constexpr size_t WS_MOD = 0;
constexpr size_t WS_BAR = 512 * 1024;
constexpr size_t WS_ROPE = 1 * MiB;
constexpr size_t WS_SC = WS_ROPE + 65536;
constexpr size_t WS_GAM = 2 * MiB;
constexpr size_t WS_SM = 4 * MiB;
constexpr size_t WS_WIE = 9 * MiB;
constexpr size_t WS_WIO = 24 * MiB;
constexpr size_t WS_WO = 36 * MiB;
constexpr size_t WS_XC = 44 * MiB;
constexpr size_t WS_H = 52 * MiB;
constexpr size_t WS_P = 120 * MiB;
constexpr size_t WS_S = 359 * MiB;
constexpr size_t WS_X16 = 427 * MiB;
constexpr size_t WS_END = WS_X16 + (size_t)MTOT * 1024 * 2;
static_assert(WS_S + (size_t)NSLOT * 8192 * 2 <= WS_X16, "ws map 4");
static_assert(WS_SC + (size_t)NSLOT * 16 <= WS_GAM && WS_GAM + (size_t)NSLOT * 256 <= WS_SM && WS_SM + (size_t)MTOT * 128 <= WS_WIE, "ws map 1");
static_assert(WS_WIE + (size_t)2 * NPAD_EVEN * 1024 * 2 <= WS_WIO && WS_WIO + (size_t)2 * NPAD_ODD * 1024 * 2 <= WS_WO && WS_WO + (size_t)4 * 1024 * 1024 * 2 <= WS_XC, "ws map 2");
static_assert(WS_XC + (size_t)MCTX * 1024 * 4 <= WS_H && WS_H + (size_t)MTOT * 1024 * 2 <= WS_P && WS_P + (size_t)MTOT * NP_EVEN * 2 <= WS_S && WS_END <= 512 * MiB, "ws map 3");
constexpr int LDS_BYTES = 147456;

#define LAS __attribute__((address_space(3)))
typedef unsigned short bf16;
typedef float f32x4 __attribute__((ext_vector_type(4)));
typedef short bf16x8 __attribute__((ext_vector_type(8)));
typedef short s16x4 __attribute__((ext_vector_type(4)));
typedef unsigned u32x4 __attribute__((ext_vector_type(4)));
typedef unsigned u32x2 __attribute__((ext_vector_type(2)));
#define LDS_WAIT() asm volatile("s_waitcnt lgkmcnt(0)" ::: "memory")

typedef __bf16 hbf2 __attribute__((ext_vector_type(2)));
typedef float f32x2_ __attribute__((ext_vector_type(2)));
__device__ __forceinline__ unsigned f2bf(float f) { const __bf16 b = (__bf16)f; return (unsigned)__builtin_bit_cast(unsigned short, b); }
__device__ __forceinline__ unsigned pk2(float lo, float hi) { const f32x2_ v = {lo, hi}; const hbf2 b = __builtin_convertvector(v, hbf2); return __builtin_bit_cast(unsigned, b); }
__device__ __forceinline__ float bf2f(unsigned short v) { return __builtin_bit_cast(float, (unsigned)v << 16); }
__device__ __forceinline__ float bflo(unsigned w) { return __builtin_bit_cast(float, w << 16); }
__device__ __forceinline__ float bfhi(unsigned w) { return __builtin_bit_cast(float, w & 0xffff0000u); }
__device__ __forceinline__ float siluf(float x) { return x * __builtin_amdgcn_rcpf(1.f + __expf(-x)); }
__device__ __forceinline__ float logsigf(float z) { return fminf(z, 0.f) - __logf(1.f + __expf(-fabsf(z))); }
template <int N> __device__ __forceinline__ float dpp_ror(float v) { return __builtin_bit_cast(float, __builtin_amdgcn_update_dpp(0, __builtin_bit_cast(int, v), 0x120 + N, 0xf, 0xf, false)); }
__device__ __forceinline__ float red16_max(float v) { v = fmaxf(v, dpp_ror<1>(v)); v = fmaxf(v, dpp_ror<2>(v)); v = fmaxf(v, dpp_ror<4>(v)); v = fmaxf(v, dpp_ror<8>(v)); return v; }
__device__ __forceinline__ float red16_sum(float v) { v += dpp_ror<1>(v); v += dpp_ror<2>(v); v += dpp_ror<4>(v); v += dpp_ror<8>(v); return v; }
__device__ __forceinline__ float wave_sum(float v) {
#pragma unroll
    for (int o = 1; o < 64; o <<= 1) v += __shfl_xor(v, o);
    return v;
}
__device__ __forceinline__ float wave_max(float v) {
#pragma unroll
    for (int o = 1; o < 64; o <<= 1) v = fmaxf(v, __shfl_xor(v, o));
    return v;
}
__device__ __forceinline__ float wave_scan_sum(float v, int lane, bool rev) {
#pragma unroll
    for (int o = 1; o < 64; o <<= 1) { const float t = rev ? __shfl_down(v, o) : __shfl_up(v, o); if (rev ? (lane + o < 64) : (lane >= o)) v += t; }
    return v;
}
__device__ __forceinline__ float wave_scan_max(float v, int lane, bool rev) {
#pragma unroll
    for (int o = 1; o < 64; o <<= 1) { const float t = rev ? __shfl_down(v, o) : __shfl_up(v, o); if (rev ? (lane + o < 64) : (lane >= o)) v = fmaxf(v, t); }
    return v;
}
#define MFMA(a, b, c) __builtin_amdgcn_mfma_f32_16x16x32_bf16((a), (b), (c), 0, 0, 0)
__device__ __forceinline__ bf16x8 frag_rm(const LAS bf16* X, int ld, int row0, int k0, int lane) {
    return *(const LAS bf16x8*)(X + (row0 + (lane & 15)) * ld + k0 + 8 * (lane >> 4));
}
__device__ __forceinline__ bf16x8 frag_tr(const LAS bf16* X, int ld, int k0, int n0, int lane) {
    const int g = lane >> 4, m = lane & 15, q = m >> 2, p = m & 3;
    const LAS bf16* a0 = X + (k0 + 8 * g + q) * ld + n0 + 4 * p;
    const s16x4 lo = __builtin_amdgcn_ds_read_tr16_b64_v4i16((LAS s16x4*)a0);
    const s16x4 hi = __builtin_amdgcn_ds_read_tr16_b64_v4i16((LAS s16x4*)(a0 + 4 * ld));
    bf16x8 r; r[0] = lo[0]; r[1] = lo[1]; r[2] = lo[2]; r[3] = lo[3]; r[4] = hi[0]; r[5] = hi[1]; r[6] = hi[2]; r[7] = hi[3]; return r;
}

struct Params {
    const float *x, *c, *ctx, *c_ctx, *w_ada, *b_ada, *ln_g, *ln_b, *w_in_even, *w_out_even, *gla_gate_w, *gla_gate_b, *gla_norm_g, *na_rpb, *w_in_odd, *w_out_odd, *ml_gate_b, *ml_norm_g, *sw_sink;
    float* out; unsigned char* ws; long long ph_lo, ph_hi;
};
typedef const __attribute__((address_space(4))) Params* KP;
__device__ __forceinline__ KP kparams() { unsigned long long v = (unsigned long long)__builtin_amdgcn_kernarg_segment_ptr(); asm volatile("" : "+s"(v)); return (KP)v; }

__device__ __forceinline__ int orig_col(int type, int n) {
    if (type == 0) { if (n < 1536) return n; if (n < 3584) return n + 32; if (n < 3616) return n - 3584 + 1536; return -1; }
    if (type == 1) { if (n < 1536) return n; if (n < 2816) return n + 16; if (n < 2832) return n - 2816 + 1536; return -1; }
    return n;
}
__device__ __forceinline__ float col_scale(int type, int n) {
    if (type == 0) return (n < 256 || (n >= 1536 && n < 2048)) ? 0.125f : 1.f;
    if (type == 1) return ((n >= 256 && n < 512) || (n >= 1536 && n < 2048)) ? 0.125f : 1.f;
    return 1.f;
}
__device__ __forceinline__ void p0_transpose_item(const float* __restrict__ W, int K, int Norig, int type, bf16* __restrict__ WT, LAS float* scr, int nblk, int item, int lane) {
    const int kb = item / nblk, nb = item % nblk, k0 = 64 * kb, n0 = 32 * nb;
    const int oc = orig_col(type, n0 + (lane & 31)); const float sc = col_scale(type, n0 + (lane & 31));
#pragma unroll 8
    for (int i = 0; i < 32; ++i) { const int kk = 2 * i + (lane >> 5); scr[kk * 33 + (lane & 31)] = oc >= 0 ? W[(size_t)(k0 + kk) * Norig + oc] * sc : 0.f; }
    LDS_WAIT();
    const int c = lane & 7;
#pragma unroll
    for (int j = 0; j < 4; ++j) { const int n = (lane >> 3) + 8 * j; const LAS float* s = scr + (8 * c) * 33 + n;
        u32x4 o; o.x = pk2(s[0 * 33], s[1 * 33]); o.y = pk2(s[2 * 33], s[3 * 33]); o.z = pk2(s[4 * 33], s[5 * 33]); o.w = pk2(s[6 * 33], s[7 * 33]);
        *(u32x4*)(WT + (size_t)(n0 + n) * K + k0 + 8 * c) = o; }
    LDS_WAIT();
}
__device__ __forceinline__ void phase_prologue(KP p, LAS unsigned char* lds) {
    const int tid = otid(), lane = tid & 63, wave = tid >> 6;
    unsigned char* ws = p->ws;
    float* MOD = (float*)(ws + WS_MOD);
    if ((int)blockIdx.x < 192) {
        LAS float* cond = (LAS float*)lds;
        LAS float* red = (LAS float*)(lds + 36864);
        for (int e = tid; e < 9 * 1024; e += NTHR) { const int j = e >> 10, k = e & 1023; const float v = j < 8 ? p->c[j * 1024 + k] : p->c_ctx[k]; cond[e] = siluf(v); }
        __syncthreads();
        for (int it = blockIdx.x; it < 192; it += gridDim.x) {
            const int l = it / 48, n0 = (it % 48) * 64, cq = tid & 15, ks = tid >> 4;
            float acc[9][4];
#pragma unroll
            for (int j = 0; j < 9; ++j) { acc[j][0] = 0.f; acc[j][1] = 0.f; acc[j][2] = 0.f; acc[j][3] = 0.f; }
            const float* wp = p->w_ada + (size_t)l * 1024 * 3072 + (size_t)(ks * 32) * 3072 + n0 + 4 * cq;
#pragma unroll 4
            for (int kk = 0; kk < 32; ++kk) { const f32x4 w = *(const f32x4*)(wp + (size_t)kk * 3072);
#pragma unroll
                for (int j = 0; j < 9; ++j) { const float cv = cond[j * 1024 + ks * 32 + kk]; acc[j][0] += cv * w[0]; acc[j][1] += cv * w[1]; acc[j][2] += cv * w[2]; acc[j][3] += cv * w[3]; } }
#pragma unroll
            for (int j = 0; j < 9; ++j)
#pragma unroll
                for (int i = 0; i < 4; ++i) red[ks * 576 + j * 64 + 4 * cq + i] = acc[j][i];
            __syncthreads();
            for (int o = tid; o < 576; o += NTHR) { float s = 0.f; for (int q = 0; q < 32; ++q) s += red[q * 576 + o]; const int j = o >> 6, n = n0 + (o & 63);
                MOD[(size_t)(l * 9 + j) * 3072 + n] = s + p->b_ada[l * 3072 + n]; }
            __syncthreads();
        }
    }
    if (blockIdx.x == gridDim.x - 1) {
        float* cosT = (float*)(ws + WS_ROPE); float* sinT = cosT + 1024;
        for (int e = tid; e < 1024; e += NTHR) { const int pos = e >> 4, i = e & 15;
            double f = 1.0; for (int q = 0; q < i; ++q) f *= 0.5623413251903491;
            const double f2 = f * f; double sn = 1.0, cs = 1.0;
            for (int q = 12; q >= 1; --q) { sn = 1.0 - f2 / ((2.0 * q) * (2.0 * q + 1.0)) * sn; cs = 1.0 - f2 / ((2.0 * q - 1.0) * (2.0 * q)) * cs; }
            sn *= f;
            double c = 1.0, s = 0.0; for (int q = 0; q < pos; ++q) { const double c2 = c * cs - s * sn, s2 = s * cs + c * sn; c = c2; s = s2; }
            cosT[e] = (float)c; sinT[e] = (float)s; }
    }
    __syncthreads();
    {
        LAS float* scr = (LAS float*)(lds + wave * 16384);
        const int gw = blockIdx.x * NWAVES + wave, NGW = gridDim.x * NWAVES;
        constexpr int I_E = 16 * (NPAD_EVEN / 32), I_O = 16 * (NPAD_ODD / 32), I_W = 16 * 32;
        constexpr int NIT = 2 * I_E + 2 * I_O + 4 * I_W;
        for (int it = gw; it < NIT; it += NGW) {
            int r = it;
            if (r < 2 * I_E) { const int i = r / I_E; r -= i * I_E; p0_transpose_item(p->w_in_even + (size_t)i * 1024 * NORIG_EVEN, 1024, NORIG_EVEN, 0, (bf16*)(ws + WS_WIE) + (size_t)i * NPAD_EVEN * 1024, scr, NPAD_EVEN / 32, r, lane); continue; }
            r -= 2 * I_E;
            if (r < 2 * I_O) { const int i = r / I_O; r -= i * I_O; p0_transpose_item(p->w_in_odd + (size_t)i * 1024 * NORIG_ODD, 1024, NORIG_ODD, 1, (bf16*)(ws + WS_WIO) + (size_t)i * NPAD_ODD * 1024, scr, NPAD_ODD / 32, r, lane); continue; }
            r -= 2 * I_O;
            { const int l = r / I_W; r -= l * I_W; const float* W = (l & 1) ? p->w_out_odd + (size_t)(l >> 1) * 1024 * 1024 : p->w_out_even + (size_t)(l >> 1) * 1024 * 1024;
              p0_transpose_item(W, 1024, 1024, 2, (bf16*)(ws + WS_WO) + (size_t)l * 1024 * 1024, scr, 32, r, lane); }
        }
    }
}
__device__ __forceinline__ void phase_h0(KP p) {
    const int lane = otid() & 63, gw = blockIdx.x * NWAVES + (otid() >> 6), NGW = gridDim.x * NWAVES;
    const float* MOD = (const float*)(p->ws + WS_MOD); bf16* H = (bf16*)(p->ws + WS_H);
    for (int m = gw; m < MTOT; m += NGW) {
        const int jb = m < MLAT ? (m >> 12) : 8;
        const float* src = m < MLAT ? p->x + (size_t)m * DM : p->ctx + (size_t)(m - MLAT) * DM;
        const float* md = MOD + (size_t)jb * 3072;
#pragma unroll
        for (int j = 0; j < 4; ++j) { const int k = 4 * lane + 256 * j; const f32x4 v = *(const f32x4*)(src + k), sh = *(const f32x4*)(md + k), sc = *(const f32x4*)(md + 1024 + k);
            const f32x4 h = v * (sc + 1.0f) + sh; u32x2 o; o.x = pk2(h[0], h[1]); o.y = pk2(h[2], h[3]); *(u32x2*)(H + (size_t)m * DM + k) = o; }
    }
}
typedef _Float16 f16x4 __attribute__((ext_vector_type(4)));
struct LnRaw { f32x4 xf[2][4]; f16x4 xh[2][4]; u32x2 y[2][4]; };
__device__ __forceinline__ void ln_load(LnRaw& R, int l, int m0, int lane, const float* xin, const float* cin, const _Float16* X16, const bf16* Y) {
#pragma unroll
    for (int j = 0; j < 4; ++j) { const int k = 4 * lane + 256 * j;
#pragma unroll
        for (int q = 0; q < 2; ++q) { const int m = m0 + q;
            if (l == 0) R.xf[q][j] = *(const f32x4*)((m < MLAT ? xin + (size_t)m * DM : cin + (size_t)(m - MLAT) * DM) + k);
            else R.xh[q][j] = *(const f16x4*)(X16 + (size_t)m * DM + k);
            R.y[q][j] = *(const u32x2*)(Y + (size_t)m * DM + k); } }
}
__device__ __forceinline__ void phase_ln(KP p, int l, bool dummy = false) {
    const int lane = otid() & 63, gw = blockIdx.x * NWAVES + (otid() >> 6), NGW = gridDim.x * NWAVES;
    const float* MOD = (const float*)(p->ws + WS_MOD); bf16* H = (bf16*)(p->ws + WS_H); const bf16* Y = (const bf16*)(p->ws + WS_P); _Float16* X16 = (_Float16*)(p->ws + WS_X16);
    const int mrows = l < DEPTH - 1 ? MTOT : MLAT;
    const float* lg = p->ln_g + l * DM; const float* lb = p->ln_b + l * DM;
    const float* xin = p->x; const float* cin = p->ctx; float* outp = p->out;
    LnRaw R;
    if (2 * gw < mrows) ln_load(R, l, 2 * gw, lane, xin, cin, X16, Y);
    for (int m0 = 2 * gw; m0 < mrows; m0 += 2 * NGW) {
        const int jb = m0 < MLAT ? (m0 >> 12) : 8;
        const float* md = MOD + (size_t)(l * 9 + jb) * 3072;
        f32x4 v[2][4], xs[2][4]; float s[2] = {0.f, 0.f};
#pragma unroll
        for (int j = 0; j < 4; ++j) { const int k = 4 * lane + 256 * j; const f32x4 g = *(const f32x4*)(md + 2048 + k);
#pragma unroll
            for (int q = 0; q < 2; ++q) { const f32x4 xv = l == 0 ? R.xf[q][j] : __builtin_convertvector(R.xh[q][j], f32x4); const u32x2 yw = R.y[q][j];
                f32x4 y; y[0] = bflo(yw.x); y[1] = bfhi(yw.x); y[2] = bflo(yw.y); y[3] = bfhi(yw.y);
                xs[q][j] = xv; v[q][j] = xv * ALPHA_DN + g * y; s[q] += (v[q][j][0] + v[q][j][1]) + (v[q][j][2] + v[q][j][3]); } }
        if (m0 + 2 * NGW < mrows) ln_load(R, l, m0 + 2 * NGW, lane, xin, cin, X16, Y);
        float rstd[2];
#pragma unroll
        for (int q = 0; q < 2; ++q) { const float mean = wave_sum(s[q]) * (1.f / DM); float s2 = 0.f;
#pragma unroll
            for (int j = 0; j < 4; ++j) { v[q][j] = v[q][j] - mean; s2 += (v[q][j][0] * v[q][j][0] + v[q][j][1] * v[q][j][1]) + (v[q][j][2] * v[q][j][2] + v[q][j][3] * v[q][j][3]); }
            rstd[q] = 1.f / sqrtf(wave_sum(s2) * (1.f / DM) + 1e-5f); }
        const float* md2 = MOD + (size_t)((l + 1) * 9 + jb) * 3072;
#pragma unroll
        for (int j = 0; j < 4; ++j) { const int k = 4 * lane + 256 * j; const f32x4 gg = *(const f32x4*)(lg + k), bb = *(const f32x4*)(lb + k);
            f32x4 sh = (f32x4){0.f, 0.f, 0.f, 0.f}, sc = sh; if (l < DEPTH - 1) { sh = *(const f32x4*)(md2 + k); sc = *(const f32x4*)(md2 + 1024 + k); }
#pragma unroll
            for (int q = 0; q < 2; ++q) { const int m = m0 + q; const f32x4 o = v[q][j] * rstd[q] * gg + bb;
                if (l < DEPTH - 1) { *(f16x4*)(X16 + (size_t)m * DM + k) = __builtin_convertvector(dummy ? xs[q][j] : o, f16x4);
                    const f32x4 h = o * (sc + 1.0f) + sh; u32x2 w; w.x = pk2(h[0], h[1]); w.y = pk2(h[2], h[3]); *(u32x2*)(H + (size_t)m * DM + k) = w; }
                else { if (!dummy) *(f32x4*)(outp + (size_t)m * DM + k) = o; } } }
    }
}
constexpr int AT_KS = 0, AT_VS = 9216, AT_BUF = 18432, AT_PS = 36864, AT_RPB = AT_PS + 8 * 2304;
__device__ __forceinline__ bf16x8 frag_tr_perm(const LAS bf16* X, int ld, int k0, int n0, int lane) {
    const int g = lane >> 4, m = lane & 15, q = m >> 2, p = m & 3;
    const LAS bf16* a0 = X + (k0 + 4 * g + q) * ld + n0 + 4 * p;
    const s16x4 lo = __builtin_amdgcn_ds_read_tr16_b64_v4i16((LAS s16x4*)a0);
    const s16x4 hi = __builtin_amdgcn_ds_read_tr16_b64_v4i16((LAS s16x4*)(a0 + 16 * ld));
    bf16x8 r; r[0] = lo[0]; r[1] = lo[1]; r[2] = lo[2]; r[3] = lo[3]; r[4] = hi[0]; r[5] = hi[1]; r[6] = hi[2]; r[7] = hi[3]; return r;
}
__device__ __forceinline__ void attn_tile(const LAS bf16* Ks, const LAS bf16* Vs, const LAS float* rpb, const bf16x8 (&qa)[2][2], float (&mrow)[2], float (&lsum)[2], f32x4 (&oacc)[2][4],
                                          int mode, int i, int nlat, int qa_, int qb_, int ka_, int lane) {
    const int fq = lane >> 4, fr = lane & 15;
    const bool islat = i < nlat;
    bool active = true; int kt0 = 0;
    if (islat) {
        if (mode == 0) { kt0 = ka_ + i; const int rs = min(max(qa_ - 4, 0), 56); active = (kt0 >= rs) && (kt0 < rs + 8); }
        else { kt0 = ka_ + 64 * i; active = !(kt0 > qa_ + 31 + 128 || kt0 + 63 < qa_ - 128); }
    }
    if (!active) return;
    const bool nar = islat && mode == 0;
    const int ct0 = qb_ >> 4;
    int ntlo[2], nthi[2];
#pragma unroll
    for (int nq = 0; nq < 2; ++nq) { const int ct = ct0 + nq; ntlo[nq] = nar ? (ct < 2 ? 0 : ct - 1) : 0; nthi[nq] = nar ? (ct > 1 ? 3 : ct + 1) : 3; }
    const int ulo = min(ntlo[0], ntlo[1]), uhi = max(nthi[0], nthi[1]);
    f32x4 s[2][4];
#pragma unroll
    for (int mt = 0; mt < 4; ++mt) { s[0][mt] = (f32x4){0.f, 0.f, 0.f, 0.f}; s[1][mt] = (f32x4){0.f, 0.f, 0.f, 0.f};
        if (mt >= ulo && mt <= uhi) {
#pragma unroll
            for (int ks = 0; ks < 2; ++ks) { const bf16x8 kf = frag_rm(Ks, 72, 16 * mt, 32 * ks, lane);
                if (mt >= ntlo[0] && mt <= nthi[0]) s[0][mt] = MFMA(kf, qa[0][ks], s[0][mt]);
                if (mt >= ntlo[1] && mt <= nthi[1]) s[1][mt] = MFMA(kf, qa[1][ks], s[1][mt]); } } }
    unsigned pw[2][8];
#pragma unroll
    for (int nq = 0; nq < 2; ++nq) {
        float tmax = -3e38f;
#pragma unroll
        for (int mt = 0; mt < 4; ++mt) { if (mt >= ntlo[nq] && mt <= nthi[nq]) {
#pragma unroll
            for (int r = 0; r < 4; ++r) { float v = s[nq][mt][r]; const int kk = 16 * mt + 4 * fq + r;
                if (islat) {
                    if (mode == 0) { const int qc = qb_ + 16 * nq + fr, cs = min(max(qc - 8, 0), 48); const bool ok = (kk >= cs) && (kk < cs + 16);
                        const int bi = (kt0 - qa_ + 7) * 31 + (kk - qc + 15); v = ok ? v + rpb[ok ? bi : 0] : -3e38f; }
                    else { const int d = (qa_ + 16 * nq + fr) - (kt0 + kk); v = (d <= 128 && d >= -128) ? v : -3e38f; }
                }
                s[nq][mt][r] = v; tmax = fmaxf(tmax, v); } } }
        tmax = fmaxf(tmax, __shfl_xor(tmax, 16)); tmax = fmaxf(tmax, __shfl_xor(tmax, 32));
        const float mnew = fmaxf(mrow[nq], tmax); const float alpha = __expf(mrow[nq] - mnew); mrow[nq] = mnew;
        float ps = 0.f;
#pragma unroll
        for (int mt = 0; mt < 4; ++mt) { float p0 = 0.f, p1 = 0.f, p2 = 0.f, p3 = 0.f;
            if (mt >= ntlo[nq] && mt <= nthi[nq]) { p0 = __expf(s[nq][mt][0] - mnew); p1 = __expf(s[nq][mt][1] - mnew); p2 = __expf(s[nq][mt][2] - mnew); p3 = __expf(s[nq][mt][3] - mnew); ps += (p0 + p1) + (p2 + p3); }
            pw[nq][2 * mt] = pk2(p0, p1); pw[nq][2 * mt + 1] = pk2(p2, p3); oacc[nq][mt] = oacc[nq][mt] * alpha; }
        lsum[nq] = lsum[nq] * alpha + ps;
    }
#pragma unroll
    for (int ks = 0; ks < 2; ++ks) { if (ks == 0 ? (ulo < 2) : (uhi > 1)) {
        const u32x4 pu0 = (u32x4){pw[0][4 * ks], pw[0][4 * ks + 1], pw[0][4 * ks + 2], pw[0][4 * ks + 3]}, pu1 = (u32x4){pw[1][4 * ks], pw[1][4 * ks + 1], pw[1][4 * ks + 2], pw[1][4 * ks + 3]};
        const bf16x8 pb0 = __builtin_bit_cast(bf16x8, pu0), pb1 = __builtin_bit_cast(bf16x8, pu1);
#pragma unroll
        for (int mt = 0; mt < 4; ++mt) { const bf16x8 vf = frag_tr_perm(Vs, 72, 32 * ks, 16 * mt, lane); oacc[0][mt] = MFMA(vf, pb0, oacc[0][mt]); oacc[1][mt] = MFMA(vf, pb1, oacc[1][mt]); } } }
}
constexpr int AT_PSW = 32 * 72 * 2;
constexpr int AT_RPB2 = AT_PS + 8 * AT_PSW;
__device__ __forceinline__ void attn_item(LAS unsigned char* lds, const bf16* __restrict__ P, int ldp, bf16* __restrict__ Z, int mode,
                                          int qrow0, int qcol, int kcol, int vcol, int gcol, int zcol,
                                          int nlat, int lat_row0, int ctx_row0, int qa_, int qb_, int ka_, const float* __restrict__ rpb_g, float sink) {
    const int tid = otid(), lane = tid & 63, wave = tid >> 6, fq = lane >> 4, fr = lane & 15;
    LAS bf16* Ks0 = (LAS bf16*)(lds + AT_KS); LAS bf16* Vs0 = (LAS bf16*)(lds + AT_VS); LAS bf16* Ks1 = (LAS bf16*)(lds + AT_KS + AT_BUF); LAS bf16* Vs1 = (LAS bf16*)(lds + AT_VS + AT_BUF);
    LAS bf16* Ps = (LAS bf16*)(lds + AT_PS + wave * AT_PSW); LAS float* rpb = (LAS float*)(lds + AT_RPB2);
    const int ntile = nlat + 4, srow = tid >> 3, sch = tid & 7, soff = srow * 72 + 8 * sch;
#define AT_ROWB(j) (((j) < nlat) ? lat_row0 + 64 * (j) : ctx_row0 + 64 * ((j) - nlat))
#define AT_LOAD(kr, vr, j) do { const size_t ro_ = (size_t)(AT_ROWB(j) + srow) * ldp + 8 * sch; kr = *(const u32x4*)(P + ro_ + kcol); vr = *(const u32x4*)(P + ro_ + vcol); } while (0)
    u32x4 k0, v0, k1, v1;
    AT_LOAD(k0, v0, 0);
    bf16x8 qa[2][2];
#pragma unroll
    for (int nq = 0; nq < 2; ++nq)
#pragma unroll
        for (int ks = 0; ks < 2; ++ks) qa[nq][ks] = *(const bf16x8*)(P + (size_t)(qrow0 + 16 * nq + fr) * ldp + qcol + 32 * ks + 8 * fq);
    __syncthreads();
    if (mode == 0) { for (int e = tid; e < 465; e += NTHR) rpb[e] = rpb_g[e]; }
    *(LAS u32x4*)(Ks0 + soff) = k0; *(LAS u32x4*)(Vs0 + soff) = v0;
    AT_LOAD(k0, v0, 1);
    AT_LOAD(k1, v1, 2);
    float mrow[2] = {-1e30f, -1e30f}, lsum[2] = {0.f, 0.f}; f32x4 oacc[2][4];
#pragma unroll
    for (int nq = 0; nq < 2; ++nq)
#pragma unroll
        for (int r = 0; r < 4; ++r) oacc[nq][r] = (f32x4){0.f, 0.f, 0.f, 0.f};
    __syncthreads();
    for (int i = 0; i < ntile; i += 2) {
        attn_tile(Ks0, Vs0, rpb, qa, mrow, lsum, oacc, mode, i, nlat, qa_, qb_, ka_, lane);
        if (i + 1 < ntile) { *(LAS u32x4*)(Ks1 + soff) = k0; *(LAS u32x4*)(Vs1 + soff) = v0; }
        if (i + 3 < ntile) AT_LOAD(k0, v0, i + 3);
        __syncthreads();
        if (i + 1 >= ntile) break;
        attn_tile(Ks1, Vs1, rpb, qa, mrow, lsum, oacc, mode, i + 1, nlat, qa_, qb_, ka_, lane);
        if (i + 2 < ntile) { *(LAS u32x4*)(Ks0 + soff) = k1; *(LAS u32x4*)(Vs0 + soff) = v1; }
        if (i + 4 < ntile) AT_LOAD(k1, v1, i + 4);
        __syncthreads();
    }
#undef AT_LOAD
#undef AT_ROWB
    u32x4 gvv[4];
#pragma unroll
    for (int c2 = 0; c2 < 4; ++c2) { const int idx = lane + 64 * c2, q = idx >> 3, ch = idx & 7; gvv[c2] = *(const u32x4*)(P + (size_t)(qrow0 + q) * ldp + gcol + 8 * ch); }
#pragma unroll
    for (int nq = 0; nq < 2; ++nq) { float lt = lsum[nq]; lt += __shfl_xor(lt, 16); lt += __shfl_xor(lt, 32); float sc;
      if (mode == 1 || mode == 3) { const float mf = fmaxf(mrow[nq], sink); const float al = __expf(mrow[nq] - mf); lt = lt * al + __expf(sink - mf); sc = al / lt; } else sc = 1.f / lt;
#pragma unroll
      for (int mt = 0; mt < 4; ++mt) { u32x2 w; w.x = pk2(oacc[nq][mt][0] * sc, oacc[nq][mt][1] * sc); w.y = pk2(oacc[nq][mt][2] * sc, oacc[nq][mt][3] * sc); *(LAS u32x2*)(Ps + (16 * nq + fr) * 72 + 16 * mt + 4 * fq) = w; } }
    LDS_WAIT();
#pragma unroll
    for (int c2 = 0; c2 < 4; ++c2) { const int idx = lane + 64 * c2, q = idx >> 3, ch = idx & 7;
        const u32x4 ov = *(const LAS u32x4*)(Ps + q * 72 + 8 * ch); const u32x4 gv = gvv[c2];
        u32x4 w;
        w.x = pk2(bflo(ov.x) * siluf(bflo(gv.x)), bfhi(ov.x) * siluf(bfhi(gv.x))); w.y = pk2(bflo(ov.y) * siluf(bflo(gv.y)), bfhi(ov.y) * siluf(bfhi(gv.y)));
        w.z = pk2(bflo(ov.z) * siluf(bflo(gv.z)), bfhi(ov.z) * siluf(bfhi(gv.z))); w.w = pk2(bflo(ov.w) * siluf(bflo(gv.w)), bfhi(ov.w) * siluf(bfhi(gv.w)));
        *(u32x4*)(Z + (size_t)(qrow0 + q) * DM + zcol + 8 * ch) = w; }
    LDS_WAIT();
}
__device__ __forceinline__ void phase_attn(KP p, LAS unsigned char* lds, int l, bool need_ctx) {
    const int wave = otid() >> 6; const bool odd = l & 1; const int li = l >> 1;
    const bf16* P = (const bf16*)(p->ws + WS_P); bf16* Z = (bf16*)(p->ws + WS_H); const int ldp = odd ? NP_ODD : NP_EVEN;
    const int nmain = BATCH * 8 * 16, nctx = need_ctx ? BATCH * 8 : 0;
    for (int it = blockIdx.x; it < nmain + nctx; it += gridDim.x) {
        if (it < nmain) {
            int itv = it;
            if (gridDim.x == 256) { const int rnd = it >> 8, bx = it & 255, xcd = bx & 7, slot = bx >> 3; itv = ((rnd * 16 + 2 * xcd + (slot >> 4)) << 4) + (slot & 15); }
            const int b = itv >> 7, h = (itv >> 4) & 7, qb = itv & 15;
            if (!odd) { const int r0 = 4 * qb, rw = r0 + (wave >> 1); const int rs0 = min(max(r0 - 4, 0), 56), rs3 = min(max(r0 + 3 - 4, 0), 56);
                attn_item(lds, P, ldp, Z, 0, b * SEQ + rw * 64 + 32 * (wave & 1), 1536 + h * 64, 2048 + h * 64, 2560 + h * 64, 3072 + h * 64, 512 + h * 64,
                          rs3 + 8 - rs0, b * SEQ + rs0 * 64, MLAT + b * CTXL, rw, 32 * (wave & 1), rs0, p->na_rpb + (size_t)(li * 8 + h) * 465, 0.f); }
            else { const int kv = h >> 2, t0 = 256 * qb, lt0 = max(0, 4 * qb - 2), lt1 = min(63, 4 * qb + 5);
                attn_item(lds, P, ldp, Z, 1, b * SEQ + t0 + 32 * wave, 1536 + h * 64, 2048 + kv * 64, 2176 + kv * 64, 2304 + h * 64, 512 + h * 64,
                          lt1 - lt0 + 1, b * SEQ + lt0 * 64, MLAT + b * CTXL, t0 + 32 * wave, 0, lt0 * 64, nullptr, p->sw_sink[li * 8 + h]); }
        } else {
            const int j = it - nmain, b = j >> 3, h = j & 7; const int q0 = MLAT + b * CTXL + 32 * wave;
            if (!odd) attn_item(lds, P, ldp, Z, 2, q0, 1536 + h * 64, 2048 + h * 64, 2560 + h * 64, 3072 + h * 64, 512 + h * 64, 0, 0, MLAT + b * CTXL, 0, 0, 0, nullptr, 0.f);
            else { const int kv = h >> 2; attn_item(lds, P, ldp, Z, 3, q0, 1536 + h * 64, 2048 + kv * 64, 2176 + kv * 64, 2304 + h * 64, 512 + h * 64, 0, 0, MLAT + b * CTXL, 0, 0, 0, nullptr, p->sw_sink[li * 8 + h]); }
        }
    }
}
__device__ __forceinline__ int chunk_row0(int b, int cp) { return cp < 4 ? MLAT + b * CTXL + cp * 64 : b * SEQ + (cp - 4) * 64; }
constexpr int SL_KDF = 0, SL_KDB = 9216, SL_VS = 18432, SL_SEG = 35840, SL_MISC = 39936;
__device__ __forceinline__ void phase_scan_local(KP p, LAS unsigned char* lds, int l) {
    const int tid = otid(), lane = tid & 63, wave = tid >> 6, fq = lane >> 4, fr = lane & 15; const bool odd = l & 1; const int li = l >> 1;
    const bf16* P = (const bf16*)(p->ws + WS_P); const int ldp = odd ? NP_ODD : NP_EVEN; const float* SM = (const float*)(p->ws + WS_SM);
    bf16* S = (bf16*)(p->ws + WS_S); float* GAM = (float*)(p->ws + WS_GAM); float* SC = (float*)(p->ws + WS_SC);
    LAS bf16* kdf = (LAS bf16*)(lds + SL_KDF); LAS bf16* kdb = (LAS bf16*)(lds + SL_KDB); LAS bf16* vs = (LAS bf16*)(lds + SL_VS);
    LAS float* seg = (LAS float*)(lds + SL_SEG); LAS float* misc = (LAS float*)(lds + SL_MISC);
    const int dk = tid & 63, sg = tid >> 6;
    for (int it = blockIdx.x; it < BATCH * 4 * NCHUNK; it += gridDim.x) {
        const int b = it / (4 * NCHUNK), h = (it / NCHUNK) & 3, cp = it % NCHUNK; const int row0 = chunk_row0(b, cp);
        const int slf = ((b * 4 + h) * 2 + 0) * NCHUNK + cp, slb = slf + NCHUNK;
        __syncthreads();
#pragma unroll
        for (int c2 = 0; c2 < 2; ++c2) { const int idx = tid + NTHR * c2, t = idx >> 4, ch = idx & 15; *(LAS u32x4*)(vs + t * 136 + 8 * ch) = *(const u32x4*)(P + (size_t)(row0 + t) * ldp + 512 + h * 128 + 8 * ch); }
        float kv[8];
#pragma unroll
        for (int tt = 0; tt < 8; ++tt) kv[tt] = bf2f(P[(size_t)(row0 + sg * 8 + tt) * ldp + 256 + h * 64 + dk]);
        if (!odd) {
            float gwf[16], gwb[16];
            const float* gw = p->gla_gate_w + (size_t)li * 2 * 16 * 256; const float* gb = p->gla_gate_b + (size_t)li * 2 * 256;
#pragma unroll
            for (int r = 0; r < 16; ++r) { gwf[r] = gw[r * 256 + h * 64 + dk]; gwb[r] = gw[(16 + r) * 256 + h * 64 + dk]; }
            const float gbf = gb[h * 64 + dk], gbb = gb[256 + h * 64 + dk];
            { const int t = tid >> 3, c4 = (tid & 7) * 4; *(LAS f32x4*)(misc + t * 32 + c4) = *(const f32x4*)(SM + (size_t)(row0 + t) * 32 + c4); }
            __syncthreads();
            float pf[8], sb[8];
#pragma unroll
            for (int tt = 0; tt < 8; ++tt) { const LAS float* lr = misc + (sg * 8 + tt) * 32; float zf = gbf, zb = gbb;
#pragma unroll
                for (int r = 0; r < 16; ++r) { zf += lr[r] * gwf[r]; zb += lr[16 + r] * gwb[r]; }
                pf[tt] = logsigf(zf) * 0.0625f; sb[tt] = logsigf(zb) * 0.0625f; }
#pragma unroll
            for (int tt = 1; tt < 8; ++tt) pf[tt] += pf[tt - 1];
#pragma unroll
            for (int tt = 6; tt >= 0; --tt) sb[tt] += sb[tt + 1];
            seg[(0 * 8 + sg) * 64 + dk] = pf[7]; seg[(1 * 8 + sg) * 64 + dk] = sb[0];
            __syncthreads();
            float offf = 0.f, totf = 0.f, offb = 0.f, totb = 0.f;
#pragma unroll
            for (int q = 0; q < 8; ++q) { const float a = seg[q * 64 + dk], c = seg[(8 + q) * 64 + dk]; totf += a; totb += c; if (q < sg) offf += a; if (q > sg) offb += c; }
#pragma unroll
            for (int tt = 0; tt < 8; ++tt) { const int t = sg * 8 + tt;
                kdf[t * 72 + dk] = (bf16)f2bf(kv[tt] * __expf(totf - (offf + pf[tt]))); kdb[t * 72 + dk] = (bf16)f2bf(kv[tt] * __expf(totb - (offb + sb[tt]))); }
            if (sg == 0) { GAM[(size_t)slf * 64 + dk] = __expf(totf); GAM[(size_t)slb * 64 + dk] = __expf(totb); }
        } else {
            const float* mb = p->ml_gate_b + li * 16;
            if (tid < 128) { const int d = tid >> 6, t = tid & 63; const float* gp = SM + (size_t)(row0 + t) * 32 + d * 8;
                misc[d * 128 + t] = gp[h] + mb[d * 8 + h]; misc[d * 128 + 64 + t] = logsigf(gp[4 + h] + mb[d * 8 + 4 + h]); }
            __syncthreads();
            if (tid < 128) { const int d = tid >> 6, t = tid & 63; const float run = wave_scan_sum(misc[d * 128 + 64 + t], t, d == 1);
                const float tot = d == 0 ? __shfl(run, 63) : __shfl(run, 0);
                const float wl = tot - run + misc[d * 128 + t]; const float ml = wave_max(wl);
                misc[256 + d * 64 + t] = __expf(wl - ml);
                if (t == 0) { const int sl = d == 0 ? slf : slb; SC[(size_t)sl * 4 + 0] = tot; SC[(size_t)sl * 4 + 1] = ml; } }
            __syncthreads();
            float nf = 0.f, nb = 0.f;
#pragma unroll
            for (int tt = 0; tt < 8; ++tt) { const int t = sg * 8 + tt; const float a = kv[tt] * misc[256 + t], c = kv[tt] * misc[256 + 64 + t]; nf += a; nb += c;
                kdf[t * 72 + dk] = (bf16)f2bf(a); kdb[t * 72 + dk] = (bf16)f2bf(c); }
            seg[(0 * 8 + sg) * 64 + dk] = nf; seg[(1 * 8 + sg) * 64 + dk] = nb;
            __syncthreads();
            if (sg < 2) { float s2 = 0.f;
#pragma unroll
                for (int q = 0; q < 8; ++q) s2 += seg[(sg * 8 + q) * 64 + dk];
                GAM[(size_t)(sg == 0 ? slf : slb) * 64 + dk] = s2; }
        }
        __syncthreads();
#pragma unroll
        for (int d = 0; d < 2; ++d) { const LAS bf16* kd = d ? kdb : kdf; f32x4 acc[4];
#pragma unroll
            for (int nt = 0; nt < 4; ++nt) acc[nt] = (f32x4){0.f, 0.f, 0.f, 0.f};
#pragma unroll
            for (int ks = 0; ks < 2; ++ks) { const bf16x8 av = frag_tr(vs, 136, 32 * ks, 16 * wave, lane);
#pragma unroll
                for (int nt = 0; nt < 4; ++nt) acc[nt] = MFMA(av, frag_tr(kd, 72, 32 * ks, 16 * nt, lane), acc[nt]); }
            bf16* dst = S + (size_t)(d ? slb : slf) * 8192;
#pragma unroll
            for (int nt = 0; nt < 4; ++nt) { u32x2 w; w.x = pk2(acc[nt][0], acc[nt][1]); w.y = pk2(acc[nt][2], acc[nt][3]); *(u32x2*)(dst + (16 * nt + fr) * 128 + 16 * wave + 4 * fq) = w; } }
    }
}
__device__ __forceinline__ void phase_scan_seq(KP p, int l, bool dummy = false) {
    const bool odd = l & 1;
    u32x2* S2 = (u32x2*)(p->ws + WS_S); float* GAM = (float*)(p->ws + WS_GAM); f32x4* GAM4 = (f32x4*)(p->ws + WS_GAM); float* SC = (float*)(p->ws + WS_SC);
    const int nthreads = gridDim.x * NTHR;
    for (int gid = blockIdx.x * NTHR + otid(); gid < 64 * 2048; gid += nthreads) {
        const int chain = gid >> 11, e4 = gid & 2047, dir = chain & 1, dkk = e4 >> 5; const int base = chain * NCHUNK;
        f32x4 st = (f32x4){0.f, 0.f, 0.f, 0.f}, nst = (f32x4){0.f, 0.f, 0.f, 0.f}; float m = 0.f; const bool hasn = odd && e4 < 16;
        for (int s0 = 0; s0 < NCHUNK; s0 += 4) {
            u32x2 dr[4]; f32x4 dn[4]; float g0[4], g1[4]; int idx[4];
#pragma unroll
            for (int u = 0; u < 4; ++u) { const int step = s0 + u; const int cp = dir == 0 ? step : (step < 4 ? 3 - step : 71 - step); idx[u] = base + cp;
                dr[u] = S2[(size_t)idx[u] * 2048 + e4];
                if (!odd) { g0[u] = GAM[(size_t)idx[u] * 64 + dkk]; g1[u] = 0.f; } else { g0[u] = SC[(size_t)idx[u] * 4 + 0]; g1[u] = SC[(size_t)idx[u] * 4 + 1]; if (hasn) dn[u] = GAM4[(size_t)idx[u] * 16 + e4]; } }
#pragma unroll
            for (int u = 0; u < 4; ++u) {
                const f32x4 d = (f32x4){bflo(dr[u].x), bfhi(dr[u].x), bflo(dr[u].y), bfhi(dr[u].y)};
                u32x2 w; w.x = pk2(st[0], st[1]); w.y = pk2(st[2], st[3]);
                S2[(size_t)idx[u] * 2048 + e4] = dummy ? dr[u] : w;
                if (!odd) { st = st * g0[u] + d; }
                else { if (hasn) GAM4[(size_t)idx[u] * 16 + e4] = dummy ? dn[u] : nst; if (e4 == 0 && !dummy) SC[(size_t)idx[u] * 4 + 2] = m;
                    const float mn = fmaxf(g0[u] + m, g1[u]); const float dec = __expf(g0[u] + m - mn), sc = __expf(g1[u] - mn);
                    st = st * dec + d * sc; if (hasn) nst = nst * dec + dn[u] * sc; m = mn; }
            }
        }
    }
}
constexpr int SO_QF = 0, SO_KF = 9216, SO_QB = 18432, SO_KB = 27648, SO_VS = 36864, SO_AF = 54272, SO_AB = 63488, SO_SF = 72704, SO_SB = 90112, SO_SEG = 107520, SO_SSQ = 111616, SO_MISC = 113664;
constexpr int SO_OST = 0;
__device__ __forceinline__ void scan_out_tail(LAS unsigned char* lds, f32x4 (&o)[4], const bf16* __restrict__ P, int ldp, bf16* __restrict__ Z, int row0, int h, const float* __restrict__ ng) {
    const int tid = otid(), lane = tid & 63, wave = tid >> 6, fq = lane >> 4, fr = lane & 15;
    LAS float* ost = (LAS float*)(lds + SO_OST);
    u32x4 gv[2]; f32x4 g0[2], g1[2];
#pragma unroll
    for (int c2 = 0; c2 < 2; ++c2) { const int idx = tid + NTHR * c2, t = idx >> 4, ch = idx & 15;
        gv[c2] = *(const u32x4*)(P + (size_t)(row0 + t) * ldp + 1024 + h * 128 + 8 * ch); g0[c2] = *(const f32x4*)(ng + h * 128 + 8 * ch); g1[c2] = *(const f32x4*)(ng + h * 128 + 8 * ch + 4); }
    __syncthreads();
#pragma unroll
    for (int mt = 0; mt < 4; ++mt)
#pragma unroll
        for (int r = 0; r < 4; ++r) ost[(16 * mt + 4 * fq + r) * 132 + 16 * wave + fr] = o[mt][r];
    __syncthreads();
#pragma unroll
    for (int c2 = 0; c2 < 2; ++c2) { const int idx = tid + NTHR * c2, t = idx >> 4, ch = idx & 15;
        f32x4 o0 = *(const LAS f32x4*)(ost + t * 132 + 8 * ch), o1 = *(const LAS f32x4*)(ost + t * 132 + 8 * ch + 4);
        const float q = red16_sum((o0[0] * o0[0] + o0[1] * o0[1]) + (o0[2] * o0[2] + o0[3] * o0[3]) + (o1[0] * o1[0] + o1[1] * o1[1]) + (o1[2] * o1[2] + o1[3] * o1[3]));
        const float rs = rsqrtf(q * (1.f / 128.f) + 1e-6f); o0 = o0 * rs * g0[c2]; o1 = o1 * rs * g1[c2];
        u32x4 w;
        w.x = pk2(o0[0] * siluf(bflo(gv[c2].x)), o0[1] * siluf(bfhi(gv[c2].x))); w.y = pk2(o0[2] * siluf(bflo(gv[c2].y)), o0[3] * siluf(bfhi(gv[c2].y)));
        w.z = pk2(o1[0] * siluf(bflo(gv[c2].z)), o1[1] * siluf(bfhi(gv[c2].z))); w.w = pk2(o1[2] * siluf(bflo(gv[c2].w)), o1[3] * siluf(bfhi(gv[c2].w)));
        *(u32x4*)(Z + (size_t)(row0 + t) * DM + h * 128 + 8 * ch) = w; }
}
__device__ __forceinline__ void stage_state(LAS bf16* dst, const bf16* __restrict__ src) {
    const int tid = otid();
#pragma unroll
    for (int c2 = 0; c2 < 2; ++c2) { const int idx = tid + NTHR * c2, r = idx >> 4, ch = idx & 15; *(LAS u32x4*)(dst + r * 136 + 8 * ch) = *(const u32x4*)(src + r * 128 + 8 * ch); }
}
__device__ __forceinline__ void phase_scan_out_gla(KP p, LAS unsigned char* lds, int l, bool need_ctx) {
    const int tid = otid(), lane = tid & 63, wave = tid >> 6, fq = lane >> 4, fr = lane & 15; const int li = l >> 1;
    const bf16* P = (const bf16*)(p->ws + WS_P); const int ldp = NP_EVEN; const float* SM = (const float*)(p->ws + WS_SM); bf16* Z = (bf16*)(p->ws + WS_H);
    const bf16* S = (const bf16*)(p->ws + WS_S);
    LAS bf16* qf = (LAS bf16*)(lds + SO_QF); LAS bf16* kf = (LAS bf16*)(lds + SO_KF); LAS bf16* qb = (LAS bf16*)(lds + SO_QB); LAS bf16* kb = (LAS bf16*)(lds + SO_KB);
    LAS bf16* vs = (LAS bf16*)(lds + SO_VS); LAS bf16* Af = (LAS bf16*)(lds + SO_AF); LAS bf16* Ab = (LAS bf16*)(lds + SO_AB); LAS bf16* Sf = (LAS bf16*)(lds + SO_SF); LAS bf16* Sb = (LAS bf16*)(lds + SO_SB);
    LAS float* seg = (LAS float*)(lds + SO_SEG); LAS float* lrs = (LAS float*)(lds + SO_MISC);
    const int dk = tid & 63, sg = tid >> 6;
    for (int it = blockIdx.x; it < BATCH * 4 * NCHUNK; it += gridDim.x) {
        const int b = it / (4 * NCHUNK), h = (it / NCHUNK) & 3, cp = it % NCHUNK; if (cp < 4 && !need_ctx) continue;
        const int row0 = chunk_row0(b, cp); const int slf = ((b * 4 + h) * 2 + 0) * NCHUNK + cp, slb = slf + NCHUNK;
        __syncthreads();
#pragma unroll
        for (int c2 = 0; c2 < 2; ++c2) { const int idx = tid + NTHR * c2, t = idx >> 4, ch = idx & 15; *(LAS u32x4*)(vs + t * 136 + 8 * ch) = *(const u32x4*)(P + (size_t)(row0 + t) * ldp + 512 + h * 128 + 8 * ch); }
        stage_state(Sf, S + (size_t)slf * 8192); stage_state(Sb, S + (size_t)slb * 8192);
        float qv[8], kv[8];
#pragma unroll
        for (int tt = 0; tt < 8; ++tt) { const size_t ro = (size_t)(row0 + sg * 8 + tt) * ldp + h * 64 + dk; qv[tt] = bf2f(P[ro]); kv[tt] = bf2f(P[ro + 256]); }
        float gwf[16], gwb[16];
        const float* gw = p->gla_gate_w + (size_t)li * 2 * 16 * 256; const float* gb = p->gla_gate_b + (size_t)li * 2 * 256;
#pragma unroll
        for (int r = 0; r < 16; ++r) { gwf[r] = gw[r * 256 + h * 64 + dk]; gwb[r] = gw[(16 + r) * 256 + h * 64 + dk]; }
        const float gbf = gb[h * 64 + dk], gbb = gb[256 + h * 64 + dk];
        { const int t = tid >> 3, c4 = (tid & 7) * 4; *(LAS f32x4*)(lrs + t * 32 + c4) = *(const f32x4*)(SM + (size_t)(row0 + t) * 32 + c4); }
        __syncthreads();
        float pf[8], sb[8];
#pragma unroll
        for (int tt = 0; tt < 8; ++tt) { const LAS float* lr = lrs + (sg * 8 + tt) * 32; float zf = gbf, zb = gbb;
#pragma unroll
            for (int r = 0; r < 16; ++r) { zf += lr[r] * gwf[r]; zb += lr[16 + r] * gwb[r]; }
            pf[tt] = logsigf(zf) * 0.0625f; sb[tt] = logsigf(zb) * 0.0625f; }
#pragma unroll
        for (int tt = 1; tt < 8; ++tt) pf[tt] += pf[tt - 1];
#pragma unroll
        for (int tt = 6; tt >= 0; --tt) sb[tt] += sb[tt + 1];
        seg[(0 * 8 + sg) * 64 + dk] = pf[7]; seg[(1 * 8 + sg) * 64 + dk] = sb[0];
        __syncthreads();
        float offf = 0.f, offb = 0.f;
#pragma unroll
        for (int q = 0; q < 8; ++q) { const float a = seg[q * 64 + dk], c = seg[(8 + q) * 64 + dk]; if (q < sg) offf += a; if (q > sg) offb += c; }
#pragma unroll
        for (int tt = 0; tt < 8; ++tt) { const int t = sg * 8 + tt; const float bf_ = offf + pf[tt], bb_ = offb + sb[tt];
            qf[t * 72 + dk] = (bf16)f2bf(qv[tt] * __expf(bf_)); kf[t * 72 + dk] = (bf16)f2bf(kv[tt] * __expf(-bf_));
            qb[t * 72 + dk] = (bf16)f2bf(qv[tt] * __expf(bb_)); kb[t * 72 + dk] = (bf16)f2bf(kv[tt] * __expf(-bb_)); }
        __syncthreads();
        { const int mt = wave >> 1;
#pragma unroll
          for (int n2 = 0; n2 < 2; ++n2) { const int nt = 2 * (wave & 1) + n2; f32x4 af = (f32x4){0.f, 0.f, 0.f, 0.f}, ab = (f32x4){0.f, 0.f, 0.f, 0.f};
#pragma unroll
              for (int ks = 0; ks < 2; ++ks) { af = MFMA(frag_rm(qf, 72, 16 * mt, 32 * ks, lane), frag_rm(kf, 72, 16 * nt, 32 * ks, lane), af);
                                               ab = MFMA(frag_rm(qb, 72, 16 * mt, 32 * ks, lane), frag_rm(kb, 72, 16 * nt, 32 * ks, lane), ab); }
#pragma unroll
              for (int r = 0; r < 4; ++r) { const int t = 16 * mt + 4 * fq + r, s = 16 * nt + fr;
                  Af[t * 72 + s] = (bf16)f2bf(s <= t ? af[r] : 0.f); Ab[t * 72 + s] = (bf16)f2bf(s >= t ? ab[r] : 0.f); } } }
        __syncthreads();
        f32x4 o[4];
#pragma unroll
        for (int mt = 0; mt < 4; ++mt) o[mt] = (f32x4){0.f, 0.f, 0.f, 0.f};
#pragma unroll
        for (int ks = 0; ks < 2; ++ks) { const bf16x8 bv = frag_tr(vs, 136, 32 * ks, 16 * wave, lane), bsf = frag_tr(Sf, 136, 32 * ks, 16 * wave, lane), bsb = frag_tr(Sb, 136, 32 * ks, 16 * wave, lane);
#pragma unroll
            for (int mt = 0; mt < 4; ++mt) { o[mt] = MFMA(frag_rm(Af, 72, 16 * mt, 32 * ks, lane), bv, o[mt]); o[mt] = MFMA(frag_rm(Ab, 72, 16 * mt, 32 * ks, lane), bv, o[mt]);
                o[mt] = MFMA(frag_rm(qf, 72, 16 * mt, 32 * ks, lane), bsf, o[mt]); o[mt] = MFMA(frag_rm(qb, 72, 16 * mt, 32 * ks, lane), bsb, o[mt]); } }
        scan_out_tail(lds, o, P, ldp, Z, row0, h, p->gla_norm_g + (size_t)li * 512);
    }
}
constexpr int MO_QS = 0, MO_KS = 9216, MO_QWF = 18432, MO_QWB = 27648;
__device__ __forceinline__ void phase_scan_out_mlstm(KP p, LAS unsigned char* lds, int l, bool need_ctx) {
    const int tid = otid(), lane = tid & 63, wave = tid >> 6, fq = lane >> 4, fr = lane & 15; const int li = l >> 1;
    const bf16* P = (const bf16*)(p->ws + WS_P); const int ldp = NP_ODD; const float* SM = (const float*)(p->ws + WS_SM); bf16* Z = (bf16*)(p->ws + WS_H);
    const bf16* S = (const bf16*)(p->ws + WS_S); const float* GAM = (const float*)(p->ws + WS_GAM); const float* SC = (const float*)(p->ws + WS_SC);
    LAS bf16* qs = (LAS bf16*)(lds + MO_QS); LAS bf16* ks_ = (LAS bf16*)(lds + MO_KS); LAS bf16* qwf = (LAS bf16*)(lds + MO_QWF); LAS bf16* qwb = (LAS bf16*)(lds + MO_QWB);
    LAS bf16* vs = (LAS bf16*)(lds + SO_VS); LAS bf16* Af = (LAS bf16*)(lds + SO_AF); LAS bf16* Ab = (LAS bf16*)(lds + SO_AB); LAS bf16* Cf = (LAS bf16*)(lds + SO_SF); LAS bf16* Cb = (LAS bf16*)(lds + SO_SB);
    LAS float* part = (LAS float*)(lds + SO_SEG);
    LAS float* misc = (LAS float*)(lds + SO_MISC);
    const float* mb = p->ml_gate_b + li * 16;
    for (int it = blockIdx.x; it < BATCH * 4 * NCHUNK; it += gridDim.x) {
        const int b = it / (4 * NCHUNK), h = (it / NCHUNK) & 3, cp = it % NCHUNK; if (cp < 4 && !need_ctx) continue;
        const int row0 = chunk_row0(b, cp); const int slf = ((b * 4 + h) * 2 + 0) * NCHUNK + cp, slb = slf + NCHUNK;
        __syncthreads();
#pragma unroll
        for (int c2 = 0; c2 < 2; ++c2) { const int idx = tid + NTHR * c2, t = idx >> 4, ch = idx & 15; *(LAS u32x4*)(vs + t * 136 + 8 * ch) = *(const u32x4*)(P + (size_t)(row0 + t) * ldp + 512 + h * 128 + 8 * ch); }
        stage_state(Cf, S + (size_t)slf * 8192); stage_state(Cb, S + (size_t)slb * 8192);
        { const int t = tid >> 3, ch = tid & 7; const size_t ro = (size_t)(row0 + t) * ldp + h * 64 + 8 * ch;
          *(LAS u32x4*)(qs + t * 72 + 8 * ch) = *(const u32x4*)(P + ro); *(LAS u32x4*)(ks_ + t * 72 + 8 * ch) = *(const u32x4*)(P + ro + 256); }
        if (tid < 128) { const int d = tid >> 6, t = tid & 63; const float* gp = SM + (size_t)(row0 + t) * 32 + d * 8;
            misc[d * 512 + t] = gp[h] + mb[d * 8 + h]; misc[d * 512 + 64 + t] = logsigf(gp[4 + h] + mb[d * 8 + 4 + h]);
            misc[1024 + d * 64 + t] = GAM[(size_t)(d ? slb : slf) * 64 + t]; }
        __syncthreads();
        if (tid < 128) { const int d = tid >> 6, t = tid & 63; LAS float* md = misc + d * 512; const float run = wave_scan_sum(md[64 + t], t, d == 1); const float pm = wave_scan_max(md[t] - run, t, d == 1);
            const float mprev = SC[(size_t)(d ? slb : slf) * 4 + 2];
            const float mt_ = fmaxf(run + pm, run + mprev);
            md[128 + t] = run; md[192 + t] = mt_; md[256 + t] = __expf(run + mprev - mt_); }
        __syncthreads();
        { const int t = tid >> 3, ch = tid & 7; const u32x4 qv = *(const LAS u32x4*)(qs + t * 72 + 8 * ch); const float wf = misc[256 + t], wb = misc[512 + 256 + t];
          u32x4 a, c;
          a.x = pk2(bflo(qv.x) * wf, bfhi(qv.x) * wf); a.y = pk2(bflo(qv.y) * wf, bfhi(qv.y) * wf); a.z = pk2(bflo(qv.z) * wf, bfhi(qv.z) * wf); a.w = pk2(bflo(qv.w) * wf, bfhi(qv.w) * wf);
          c.x = pk2(bflo(qv.x) * wb, bfhi(qv.x) * wb); c.y = pk2(bflo(qv.y) * wb, bfhi(qv.y) * wb); c.z = pk2(bflo(qv.z) * wb, bfhi(qv.z) * wb); c.w = pk2(bflo(qv.w) * wb, bfhi(qv.w) * wb);
          *(LAS u32x4*)(qwf + t * 72 + 8 * ch) = a; *(LAS u32x4*)(qwb + t * 72 + 8 * ch) = c;
          const float q0 = bflo(qv.x), q1 = bfhi(qv.x), q2 = bflo(qv.y), q3 = bfhi(qv.y), q4 = bflo(qv.z), q5 = bfhi(qv.z), q6 = bflo(qv.w), q7 = bfhi(qv.w);
#pragma unroll
          for (int d = 0; d < 2; ++d) { const LAS float* nv = misc + 1024 + d * 64 + 8 * ch;
              part[(d * 8 + ch) * 64 + t] = q0 * nv[0] + q1 * nv[1] + q2 * nv[2] + q3 * nv[3] + q4 * nv[4] + q5 * nv[5] + q6 * nv[6] + q7 * nv[7]; } }
        { const int mt = wave >> 1; float rsf[4] = {0.f, 0.f, 0.f, 0.f}, rsb[4] = {0.f, 0.f, 0.f, 0.f};
#pragma unroll
          for (int n2 = 0; n2 < 2; ++n2) { const int nt = 2 * (wave & 1) + n2; f32x4 a = (f32x4){0.f, 0.f, 0.f, 0.f};
#pragma unroll
              for (int ks = 0; ks < 2; ++ks) a = MFMA(frag_rm(qs, 72, 16 * mt, 32 * ks, lane), frag_rm(ks_, 72, 16 * nt, 32 * ks, lane), a);
#pragma unroll
              for (int r = 0; r < 4; ++r) { const int t = 16 * mt + 4 * fq + r, s = 16 * nt + fr;
                  const float wf = s <= t ? __expf(misc[128 + t] - misc[128 + s] + misc[s] - misc[192 + t]) : 0.f;
                  const float wb = s >= t ? __expf(misc[512 + 128 + t] - misc[512 + 128 + s] + misc[512 + s] - misc[512 + 192 + t]) : 0.f;
                  const float vf = a[r] * wf, vb = a[r] * wb; rsf[r] += vf; rsb[r] += vb;
                  Af[t * 72 + s] = (bf16)f2bf(vf); Ab[t * 72 + s] = (bf16)f2bf(vb); } }
#pragma unroll
          for (int r = 0; r < 4; ++r) { const float a = red16_sum(rsf[r]), c = red16_sum(rsb[r]);
              if (fr == 0) { misc[1152 + (0 * 2 + (wave & 1)) * 64 + 16 * mt + 4 * fq + r] = a; misc[1152 + (1 * 2 + (wave & 1)) * 64 + 16 * mt + 4 * fq + r] = c; } } }
        __syncthreads();
        if (tid < 128) { const int d = tid >> 6, t = tid & 63; float qn = 0.f;
#pragma unroll
            for (int q = 0; q < 8; ++q) qn += part[(d * 8 + q) * 64 + t];
            const float den = misc[1152 + (d * 2 + 0) * 64 + t] + misc[1152 + (d * 2 + 1) * 64 + t] + misc[d * 512 + 256 + t] * qn;
            misc[d * 512 + 320 + t] = 1.f / fmaxf(fabsf(den), __expf(-misc[d * 512 + 192 + t])); }
        f32x4 of[4], ob[4];
#pragma unroll
        for (int mt = 0; mt < 4; ++mt) { of[mt] = (f32x4){0.f, 0.f, 0.f, 0.f}; ob[mt] = (f32x4){0.f, 0.f, 0.f, 0.f}; }
#pragma unroll
        for (int ks = 0; ks < 2; ++ks) { const bf16x8 bv = frag_tr(vs, 136, 32 * ks, 16 * wave, lane), bcf = frag_tr(Cf, 136, 32 * ks, 16 * wave, lane), bcb = frag_tr(Cb, 136, 32 * ks, 16 * wave, lane);
#pragma unroll
            for (int mt = 0; mt < 4; ++mt) { of[mt] = MFMA(frag_rm(Af, 72, 16 * mt, 32 * ks, lane), bv, of[mt]); of[mt] = MFMA(frag_rm(qwf, 72, 16 * mt, 32 * ks, lane), bcf, of[mt]);
                ob[mt] = MFMA(frag_rm(Ab, 72, 16 * mt, 32 * ks, lane), bv, ob[mt]); ob[mt] = MFMA(frag_rm(qwb, 72, 16 * mt, 32 * ks, lane), bcb, ob[mt]); } }
        __syncthreads();
        f32x4 o[4];
#pragma unroll
        for (int mt = 0; mt < 4; ++mt)
#pragma unroll
            for (int r = 0; r < 4; ++r) { const int t = 16 * mt + 4 * fq + r; o[mt][r] = of[mt][r] * misc[320 + t] + ob[mt][r] * misc[512 + 320 + t]; }
        scan_out_tail(lds, o, P, ldp, Z, row0, h, p->ml_norm_g + (size_t)li * 512);
    }
}
#define XB_TMO      128
#define XB_XCNT(j)  (256  + 64 * (j))
#define XB_XSUB(j)  (1280 + 64 * (j))
#define XB_XGEN(j)  (2304 + 64 * (j))
#define XB_TOP      3328
#define XB_TOPGEN   3392
#define XCD_BAR_WORDS 3456
#define XB_SPIN_CAP (1u << 18)

__device__ __forceinline__ unsigned xb_ld(unsigned* p)              { return __hip_atomic_load(p, __ATOMIC_RELAXED, __HIP_MEMORY_SCOPE_AGENT); }
__device__ __forceinline__ unsigned xb_add(unsigned* p, unsigned v) { return __hip_atomic_fetch_add(p, v, __ATOMIC_RELAXED, __HIP_MEMORY_SCOPE_AGENT); }
__device__ __forceinline__ unsigned xb_xcc_id() { return (unsigned)__builtin_amdgcn_s_getreg((3 << 11) | 20) & 0xFu; }
#define XB_SPIN(cond, bar) do { unsigned _sp = 0; while (cond) { __builtin_amdgcn_s_sleep(1); \
    if ((++_sp & 255u) == 0u) { if (xb_ld(&(bar)[XB_TMO])) break; if (_sp > XB_SPIN_CAP) { atomicAdd(&(bar)[XB_TMO], 1u); break; } } } } while (0)

struct XcdBarrier {
    unsigned* bar; unsigned x;
    volatile LAS unsigned* st;
};

__device__ __forceinline__ XcdBarrier xcd_barrier_post(unsigned* bar, volatile LAS unsigned* st) {
    XcdBarrier b; b.bar = bar; b.x = xb_xcc_id(); b.st = st;
    if (otid() == 0) (void)xb_add(&bar[XB_XCNT(b.x)], 1u);
    return b;
}
__device__ __forceinline__ void xcd_barrier_complete(unsigned* bar, unsigned x, unsigned& nloc, unsigned& nx) {
    const unsigned G = gridDim.x * gridDim.y * gridDim.z;
    unsigned sum, cnt, mine, sp = 0u;
    for (;;) {
        sum = 0u; cnt = 0u; mine = 0u;
#pragma unroll
        for (unsigned j = 0; j < 16; ++j) { const unsigned c = xb_ld(&bar[XB_XCNT(j)]); sum += c; cnt += (c > 0u) ? 1u : 0u; mine = (j == x) ? c : mine; }
        if (sum == G) break;
        __builtin_amdgcn_s_sleep(1);
        if ((++sp & 255u) == 0u) { if (xb_ld(&bar[XB_TMO])) break; if (sp > XB_SPIN_CAP) { atomicAdd(&bar[XB_TMO], 1u); break; } }
    }
    nloc = mine > 0u ? mine : 1u; nx = cnt > 0u ? cnt : 1u;
}

__device__ __forceinline__ void xcd_barrier(const XcdBarrier& b) {
    asm volatile("s_waitcnt vmcnt(0)" ::: "memory");
    __syncthreads();
    if (otid() == 0) {
        unsigned* bar = b.bar;
        __builtin_amdgcn_s_waitcnt(0);
        unsigned nloc = b.st[0], nx = b.st[1];
        if (nloc == 0u) { xcd_barrier_complete(bar, b.x, nloc, nx); b.st[0] = nloc; b.st[1] = nx; }
        const unsigned old = xb_add(&bar[XB_XSUB(b.x)], 1u);
        const unsigned gen = old / nloc;
        if (old + 1u == (gen + 1u) * nloc) {
            __builtin_amdgcn_fence(__ATOMIC_RELEASE, "agent");
            asm volatile("s_waitcnt vmcnt(0)" ::: "memory");
            const unsigned og = xb_add(&bar[XB_TOP], 1u);
            const unsigned tg = og / nx;
            if (og + 1u == (tg + 1u) * nx) xb_add(&bar[XB_TOPGEN], 1u);
            else XB_SPIN(xb_ld(&bar[XB_TOPGEN]) == tg, bar);
            __builtin_amdgcn_fence(__ATOMIC_ACQUIRE, "agent");
            xb_add(&bar[XB_XGEN(b.x)], 1u);
            asm volatile("s_waitcnt vmcnt(0)" ::: "memory");
        } else {
            XB_SPIN(xb_ld(&bar[XB_XGEN(b.x)]) == gen, bar);
            __builtin_amdgcn_fence(__ATOMIC_ACQUIRE, "agent");
            asm volatile("s_waitcnt vmcnt(0)" ::: "memory");
        }
    }
    __syncthreads();
}

#define REP_GEMM 1
#define REP_ATT 1
#define REP_LOC 1
#define REP_OUT 1
#define REP_PRO 1
#define REP_SEQ 1
#define REP_LN 1
#ifndef MK_N_LAUNCHES
#define MK_N_LAUNCHES 1
#endif
constexpr int N_PHASES = 2 + 6 * DEPTH;
__global__ void __launch_bounds__(NTHR, 2) fwd_megakernel(Params p_unused) {
    extern __shared__ __attribute__((aligned(16))) unsigned char lds_raw[];
    LAS unsigned char* lds = (LAS unsigned char*)lds_raw;
    cg::grid_group grid = cg::this_grid();
    const int lo = (int)kparams()->ph_lo, hi = (int)kparams()->ph_hi;
#define IN(k) (lo <= (k) && (k) < hi)
    volatile LAS unsigned* bst = (volatile LAS unsigned*)(lds + LDS_BYTES - 64);
    if (otid() < 16) bst[otid()] = 0u;
    __syncthreads();
    XcdBarrier bar = xcd_barrier_post((unsigned*)(kparams()->ws + WS_BAR), bst);
    if (kparams()->ph_hi < 0) grid.sync();
#define SEAM(k) do { if (IN(k) && IN((k) + 1)) xcd_barrier(bar); } while (0)
    if (IN(0)) { for (int rep = 0; rep < REP_PRO; ++rep) { phase_prologue(kparams(), lds); __syncthreads(); } } SEAM(0);
    if (IN(1)) { for (int rep = 0; rep < REP_PRO; ++rep) phase_h0(kparams()); } SEAM(1);
#pragma unroll 1
    for (int l = 0; l < DEPTH; ++l) {
        const int pb = 2 + 6 * l; const bool odd = l & 1; const int li = l >> 1; const bool need_ctx = l < DEPTH - 1;
        if (IN(pb + 0)) {
            const int npad = odd ? NPAD_ODD : NPAD_EVEN; unsigned char* ws = kparams()->ws;
            pg8::Gemm g{(const pg8::bf16_t*)(ws + WS_H), (const pg8::bf16_t*)(ws + (odd ? WS_WIO : WS_WIE)) + (size_t)li * npad * 1024, MTOT, npad, 1024};
            pg8::StaticOrder S; S.init(MTOT, npad, (int)gridDim.x, (int)blockIdx.x);
            pg8::EpiProj E{(pg8::bf16_t*)(ws + WS_P), odd ? NP_ODD : NP_EVEN, (float*)(ws + WS_SM), odd ? 16 : 32, npad / 256 - 1, odd ? 1 : 0, (const float*)(ws + WS_ROPE), (const float*)(ws + WS_ROPE) + 1024};
            for (int rep = 0; rep < REP_GEMM; ++rep) pg8::gemm_phase<pg8::EpiProj, pg8::StaticOrder, true, true>(lds, g, S, E);
        }
        SEAM(pb + 0);
        if (IN(pb + 1)) { for (int rep = 0; rep < REP_ATT; ++rep) phase_attn(kparams(), lds, l, need_ctx); for (int rep = 0; rep < REP_LOC; ++rep) phase_scan_local(kparams(), lds, l); }
        SEAM(pb + 1);
        if (IN(pb + 2)) { for (int rep = 1; rep < REP_SEQ; ++rep) { phase_scan_seq(kparams(), l, true); __syncthreads(); } phase_scan_seq(kparams(), l); }
        SEAM(pb + 2);
        if (IN(pb + 3)) { for (int rep = 0; rep < REP_OUT; ++rep) { if (odd) phase_scan_out_mlstm(kparams(), lds, l, need_ctx); else phase_scan_out_gla(kparams(), lds, l, need_ctx); } }
        SEAM(pb + 3);
        if (IN(pb + 4)) {
            const int mrows = need_ctx ? MTOT : MLAT; unsigned char* ws = kparams()->ws;
            pg8::Gemm g{(const pg8::bf16_t*)(ws + WS_H), (const pg8::bf16_t*)(ws + WS_WO) + (size_t)l * 1024 * 1024, mrows, 1024, 1024};
            pg8::StaticOrder S; S.init(mrows, 1024, (int)gridDim.x, (int)blockIdx.x);
            pg8::EpiProj E{(pg8::bf16_t*)(ws + WS_P), 1024, nullptr, 0, -1, 0, nullptr, nullptr};
            for (int rep = 0; rep < REP_GEMM; ++rep) pg8::gemm_phase<pg8::EpiProj, pg8::StaticOrder, true, true>(lds, g, S, E);
        }
        SEAM(pb + 4);
        if (IN(pb + 5)) { for (int rep = 1; rep < REP_LN; ++rep) { phase_ln(kparams(), l, true); } phase_ln(kparams(), l); }
        SEAM(pb + 5);
    }
}
extern "C" void kernel_launch(void* const* d_in, const int* in_sizes, int n_in, void* d_out, int out_size, void* d_ws, size_t ws_size, hipStream_t stream) {
    static int grid = 0;
    if (grid == 0) {
        if (n_in != 19 || ws_size < WS_END) { fprintf(stderr, "kernel_launch: need 19 inputs and %zu bytes of workspace; got %d, %zu\n", (size_t)WS_END, n_in, ws_size); grid = -1; return; }
        int dev = 0, cus = 0, per_cu = 0;
        if (hipGetDevice(&dev) != hipSuccess || hipDeviceGetAttribute(&cus, hipDeviceAttributeMultiprocessorCount, dev) != hipSuccess) { grid = -1; return; }
        if (hipFuncSetAttribute((const void*)fwd_megakernel, hipFuncAttributeMaxDynamicSharedMemorySize, LDS_BYTES) != hipSuccess) { fprintf(stderr, "kernel_launch: hipFuncSetAttribute failed\n"); grid = -1; return; }
        if (hipOccupancyMaxActiveBlocksPerMultiprocessor(&per_cu, (const void*)fwd_megakernel, NTHR, LDS_BYTES) != hipSuccess || per_cu < 1) per_cu = 1;
        grid = cus * per_cu;
    }
    if (grid < 0) return;
    Params p{};
    p.x = (const float*)d_in[0]; p.c = (const float*)d_in[1]; p.ctx = (const float*)d_in[2]; p.c_ctx = (const float*)d_in[3]; p.w_ada = (const float*)d_in[4]; p.b_ada = (const float*)d_in[5];
    p.ln_g = (const float*)d_in[6]; p.ln_b = (const float*)d_in[7]; p.w_in_even = (const float*)d_in[8]; p.w_out_even = (const float*)d_in[9]; p.gla_gate_w = (const float*)d_in[10]; p.gla_gate_b = (const float*)d_in[11];
    p.gla_norm_g = (const float*)d_in[12]; p.na_rpb = (const float*)d_in[13]; p.w_in_odd = (const float*)d_in[14]; p.w_out_odd = (const float*)d_in[15]; p.ml_gate_b = (const float*)d_in[16]; p.ml_norm_g = (const float*)d_in[17];
    p.sw_sink = (const float*)d_in[18]; p.out = (float*)d_out; p.ws = (unsigned char*)d_ws;
    if (hipMemsetAsync((char*)d_ws + WS_BAR, 0, XCD_BAR_WORDS * 4, stream) != hipSuccess) { fprintf(stderr, "kernel_launch: memset failed\n"); return; }
#if MK_N_LAUNCHES == 1
    p.ph_lo = 0; p.ph_hi = N_PHASES;
    void* args[] = {&p};
    hipError_t e = hipLaunchCooperativeKernel((const void*)fwd_megakernel, dim3(grid), dim3(NTHR), args, LDS_BYTES, stream);
    if (e != hipSuccess) fprintf(stderr, "kernel_launch: cooperative launch failed: %s (grid %d)\n", hipGetErrorString(e), grid);
#else
    for (int k = 0; k < N_PHASES; ++k) { p.ph_lo = k; p.ph_hi = k + 1; hipLaunchKernelGGL(fwd_megakernel, dim3(grid), dim3(NTHR), LDS_BYTES, stream, p); }
#endif
}
```

```cpp
#include <hip/hip_runtime.h>
#include <hip/hip_cooperative_groups.h>
#include <cstdio>
#include <cstdint>
namespace cg = cooperative_groups;
__device__ __forceinline__ int otid() { int t = threadIdx.x; asm volatile("" : "+v"(t)); return t; }
namespace pg8 {
#define PG8_LAS __attribute__((address_space(3)))
typedef unsigned short bf16_t;
typedef short bf16x8 __attribute__((ext_vector_type(8)));
typedef float f32x4 __attribute__((ext_vector_type(4)));
typedef unsigned u32x4 __attribute__((ext_vector_type(4)));
constexpr int BM = 256, BK = 64, HALF = 128, HTB = HALF * BK * 2  , STAGE_BYTES = 8 * HTB, NXCD = 8, WGM = 8;

__host__ __device__ __forceinline__ int lds_byte(int r, int c) { const int st = (r >> 4) * 2 + (c >> 5), rr = r & 15, cc = c & 31, ob = rr * 64 + cc * 2; return st * 1024 + (ob ^ (((ob >> 9) & 1) << 5)); }
__host__ __device__ __forceinline__ void stage_rc(int b, int& R, int& C) { const int st = b / 1024, sb = b % 1024, swz = sb ^ (((sb >> 9) & 1) << 5); R = (st >> 1) * 16 + swz / 64; C = (st & 1) * 32 + (swz % 64) / 2; }
__host__ __device__ __forceinline__ int perm32(int rho) { const int n = rho >> 4, i = rho & 15; return 8 * (i >> 2) + 4 * n + (i & 3); }

struct Unit { int pm, pn; };
struct Gemm { const bf16_t* A; const bf16_t* Bt; int M, N, K; };

struct StaticOrder {
    int nM, nN, nwg, G, c;
    __host__ __device__ void init(int M, int N, int G_, int c_) { nM = M / BM; nN = N / BM; nwg = nM * nN; G = G_; c = c_; }
    __host__ __device__ bool next(int i, Unit& u) const {
        const long L = (long)i * G + c; if (L >= nwg) return false;
        int wgid = (int)L; { const int q = nwg / NXCD, r = nwg % NXCD, xcd = wgid % NXCD, off = wgid / NXCD; wgid = (xcd < r ? xcd * (q + 1) : r * (q + 1) + (xcd - r) * q) + off; }
        const int nig = WGM * nN, gid = wgid / nig, fm = gid * WGM, gsz = (nM - fm) < WGM ? (nM - fm) : WGM;
        u.pm = fm + ((wgid % nig) % gsz); u.pn = (wgid % nig) / gsz; return true;
    }
    __device__ __forceinline__ void a_ready(const Unit&) const {}
    __device__ __forceinline__ void done(const Unit&) const {}
};

__device__ __forceinline__ unsigned cvt_pk_bf16(float lo, float hi) { unsigned r; asm volatile("v_cvt_pk_bf16_f32 %0, %1, %2" : "=v"(r) : "v"(lo), "v"(hi)); return r; }
struct EpiProj {
    static constexpr bool PERM = true, AFTER_DRAIN = false;
    bf16_t* P; int ldp; float* SM; int nsm; int last_pn; int rope; const float* cosT; const float* sinT;
    __device__ __forceinline__ void operator()(const f32x4 (&acc)[2][2][4][2], const Unit& u, int wr, int wc, int fr, int fq) const {
        const int row0 = u.pm * BM + wr * 64 + fr;
        if (u.pn == last_pn) {
            if (wc == 0) {
#pragma unroll
                for (int ai = 0; ai < 2; ++ai)
#pragma unroll
                    for (int m = 0; m < 4; ++m) { const int row = row0 + ai * HALF + m * 16;
#pragma unroll
                        for (int n = 0; n < 2; ++n) { const int col = 8 * fq + 4 * n; if (col < nsm) *(f32x4*)(SM + (size_t)row * 32 + col) = acc[ai][0][m][n]; } }
            }
            return;
        }
        const bool do_rope_tile = rope && (u.pn == 6 || u.pn == 7 || u.pn == 8) && (u.pm * BM < 32768);
#pragma unroll
        for (int ai = 0; ai < 2; ++ai)
#pragma unroll
            for (int m = 0; m < 4; ++m) { const int row = row0 + ai * HALF + m * 16; bf16_t* rowp = P + (size_t)row * ldp + u.pn * BM + wc * 32 + 8 * fq;
#pragma unroll
                for (int bj = 0; bj < 2; ++bj) { f32x4 v0 = acc[ai][bj][m][0], v1 = acc[ai][bj][m][1];
                    if (do_rope_tile && (u.pn != 8 || bj == 0)) {
                        const int t = row & 4095; const int pos = (wc & 1) ? (t & 63) : (t >> 6); const int i0 = pos * 16 + 8 * (fq & 1);
                        const f32x4 c0 = *(const f32x4*)(cosT + i0), c1 = *(const f32x4*)(cosT + i0 + 4), s0 = *(const f32x4*)(sinT + i0), s1 = *(const f32x4*)(sinT + i0 + 4);
                        f32x4 p0, p1;
#pragma unroll
                        for (int e = 0; e < 4; ++e) { p0[e] = __shfl_xor(v0[e], 32); p1[e] = __shfl_xor(v1[e], 32); }
                        if (fq < 2) { v0 = v0 * c0 - p0 * s0; v1 = v1 * c1 - p1 * s1; } else { v0 = p0 * s0 + v0 * c0; v1 = p1 * s1 + v1 * c1; }
                    }
                    u32x4 w; w.x = cvt_pk_bf16(v0[0], v0[1]); w.y = cvt_pk_bf16(v0[2], v0[3]); w.z = cvt_pk_bf16(v1[0], v1[1]); w.w = cvt_pk_bf16(v1[2], v1[3]);
                    *(u32x4*)(rowp + bj * HALF) = w; } }
    }
};
template <class Epi, class Sched, bool ALIGN_EPI = false, bool SP2 = false>
__device__ __forceinline__ void gemm_phase(PG8_LAS unsigned char* lds, const Gemm g, const Sched& S, const Epi& E) {
    const int tid = otid(), wid = __builtin_amdgcn_readfirstlane(tid >> 6), lane = tid & 63, wr = wid >> 2, wc = wid & 3, fr = lane & 15, fq = lane >> 4;
    const int K = g.K, nt = K / BK;
    unsigned voffA[2], voffB[2];
#pragma unroll
    for (int i = 0; i < 2; ++i) { int R, C; stage_rc(tid * 16 + i * 8192, R, C); const int Rb = Epi::PERM ? ((R & ~31) + perm32(R & 31)) : R;
        voffA[i] = (unsigned)(R * K + C) * 2u; voffB[i] = (unsigned)(Rb * K + C) * 2u; }
    const size_t kstep = (size_t)(BK * 2);
    const size_t hstep = (size_t)HALF * K * 2;
    const size_t tstep = 2 * hstep;
    const unsigned ldsw = (unsigned)wid * 1024u;
    const int aoff = lds_byte(wr * 64 + fr, fq * 8), boff = lds_byte(wc * 32 + fr, fq * 8);
#define PG8_SA(b, h) (((b) * 2 + (h)) * HTB)
#define PG8_SB(b, h) ((4 + (b) * 2 + (h)) * HTB)
#define PG8_STAGE(bufoff, gbase, voff) do { _Pragma("unroll") for (int _i = 0; _i < 2; ++_i) \
        __builtin_amdgcn_global_load_lds((const unsigned*)((const char*)(gbase) + (voff)[_i]), (PG8_LAS unsigned*)(lds + (bufoff) + ldsw + _i * 8192), 16, 0, 0); } while (0)
#define PG8_LDA(dst, b, h) do { _Pragma("unroll") for (int m = 0; m < 4; ++m) _Pragma("unroll") for (int k = 0; k < 2; ++k) dst[m][k] = *(const PG8_LAS bf16x8*)(lds + PG8_SA(b, h) + aoff + m * 2048 + k * 1024); } while (0)
#define PG8_LDB(dst, b, h) do { _Pragma("unroll") for (int n = 0; n < 2; ++n) _Pragma("unroll") for (int k = 0; k < 2; ++k) dst[n][k] = *(const PG8_LAS bf16x8*)(lds + PG8_SB(b, h) + boff + n * 2048 + k * 1024); } while (0)
#define PG8_MMA(ai, bj, At, Bt) do { __builtin_amdgcn_s_setprio(1); _Pragma("unroll") for (int m = 0; m < 4; ++m) _Pragma("unroll") for (int n = 0; n < 2; ++n) _Pragma("unroll") for (int k = 0; k < 2; ++k) \
        acc[ai][bj][m][n] = __builtin_amdgcn_mfma_f32_16x16x32_bf16(Bt[n][k], At[m][k], acc[ai][bj][m][n], 0, 0, 0); __builtin_amdgcn_s_setprio(0); } while (0)
#define PG8_WAIT_V(n) asm volatile("s_waitcnt vmcnt(" #n ")" ::: "memory")
#define PG8_WAIT_L(n) asm volatile("s_waitcnt lgkmcnt(" #n ")" ::: "memory")
#define PG8_BAR __builtin_amdgcn_s_barrier()
#define PG8_SCHED __builtin_amdgcn_sched_barrier(0)
    Unit cur, nxt; int ui = 0;
    if (!S.next(0, cur)) return;
    f32x4 acc[2][2][4][2];
#pragma unroll
    for (int a = 0; a < 2; ++a)
#pragma unroll
        for (int b = 0; b < 2; ++b)
#pragma unroll
            for (int m = 0; m < 4; ++m)
#pragma unroll
                for (int n = 0; n < 2; ++n) acc[a][b][m][n] = (f32x4){0.f, 0.f, 0.f, 0.f};
    bf16x8 At[4][2], B0[2][2], B1[2][2];
    const char* cA = (const char*)g.A + (size_t)cur.pm * tstep; const char* cB = (const char*)g.Bt + (size_t)cur.pn * tstep;
    S.a_ready(cur);
    if constexpr (SP2) {
        PG8_STAGE(PG8_SB(0, 0), cB, voffB); PG8_STAGE(PG8_SB(0, 1), cB + hstep, voffB); PG8_STAGE(PG8_SA(0, 0), cA, voffA); PG8_STAGE(PG8_SA(0, 1), cA + hstep, voffA);
        if (wr == 1) PG8_BAR;
        PG8_WAIT_V(2); PG8_BAR;
        PG8_STAGE(PG8_SB(1, 0), cB + kstep, voffB); PG8_STAGE(PG8_SA(1, 0), cA + kstep, voffA); PG8_STAGE(PG8_SB(1, 1), cB + hstep + kstep, voffB);
        PG8_WAIT_V(6); PG8_BAR;
    } else {
        PG8_STAGE(PG8_SB(0, 0), cB, voffB); PG8_STAGE(PG8_SA(0, 0), cA, voffA); PG8_STAGE(PG8_SB(0, 1), cB + hstep, voffB); PG8_STAGE(PG8_SA(0, 1), cA + hstep, voffA);
        if (wr == 1) PG8_BAR;
        PG8_WAIT_V(4); PG8_BAR;
        PG8_STAGE(PG8_SB(1, 0), cB + kstep, voffB); PG8_STAGE(PG8_SA(1, 0), cA + kstep, voffA); PG8_STAGE(PG8_SB(1, 1), cB + hstep + kstep, voffB);
        PG8_WAIT_V(6); PG8_BAR;
    }
    for (;;) {
        const bool has_next = S.next(ui + 1, nxt);
        const char* nA = has_next ? (const char*)g.A + (size_t)nxt.pm * tstep : cA; const char* nB = has_next ? (const char*)g.Bt + (size_t)nxt.pn * tstep : cB;
        for (int t = 0; t < nt; t += 2) {
            const bool last = (t == nt - 2);
            const char* a1 = cA + (size_t)(t + 1) * kstep;
            const char* a2 = last ? nA : cA + (size_t)(t + 2) * kstep; const char* b2 = last ? nB : cB + (size_t)(t + 2) * kstep;
            const char* a3 = a2 + kstep; const char* b3 = b2 + kstep;
            if (last && has_next) S.a_ready(nxt);
            if constexpr (SP2) {
            PG8_LDB(B0, 0, 0); PG8_LDB(B1, 0, 1); PG8_SCHED; PG8_LDA(At, 0, 0); PG8_STAGE(PG8_SA(1, 1), a1 + hstep, voffA);
            PG8_WAIT_V(8); PG8_WAIT_L(0); PG8_BAR; PG8_MMA(0, 0, At, B0); PG8_MMA(0, 1, At, B1); PG8_BAR; PG8_SCHED;
            PG8_LDA(At, 0, 1); PG8_STAGE(PG8_SB(0, 0), b2, voffB); PG8_STAGE(PG8_SB(0, 1), b2 + hstep, voffB); PG8_STAGE(PG8_SA(0, 0), a2, voffA);
            PG8_WAIT_V(8); PG8_WAIT_L(0); PG8_BAR; PG8_MMA(1, 0, At, B0); PG8_MMA(1, 1, At, B1); PG8_BAR; PG8_SCHED;
            PG8_LDB(B0, 1, 0); PG8_LDB(B1, 1, 1); PG8_SCHED; PG8_LDA(At, 1, 0); PG8_STAGE(PG8_SA(0, 1), a2 + hstep, voffA);
            PG8_WAIT_V(8); PG8_WAIT_L(0); PG8_BAR; PG8_MMA(0, 0, At, B0); PG8_MMA(0, 1, At, B1); PG8_BAR; PG8_SCHED;
            PG8_LDA(At, 1, 1); PG8_STAGE(PG8_SB(1, 0), b3, voffB); PG8_STAGE(PG8_SB(1, 1), b3 + hstep, voffB); PG8_STAGE(PG8_SA(1, 0), a3, voffA);
            PG8_WAIT_V(8); PG8_WAIT_L(0); PG8_BAR; PG8_MMA(1, 0, At, B0); PG8_MMA(1, 1, At, B1); PG8_BAR; PG8_SCHED;
            } else {
            PG8_LDB(B0, 0, 0); PG8_SCHED; PG8_LDA(At, 0, 0); PG8_STAGE(PG8_SA(1, 1), a1 + hstep, voffA);
            PG8_WAIT_L(8); PG8_BAR; PG8_WAIT_L(0); PG8_MMA(0, 0, At, B0); PG8_BAR; PG8_SCHED;
            PG8_LDB(B1, 0, 1); PG8_STAGE(PG8_SB(0, 0), b2, voffB);
            PG8_BAR; PG8_WAIT_L(0); PG8_MMA(0, 1, At, B1); PG8_BAR;
            PG8_LDA(At, 0, 1); PG8_STAGE(PG8_SA(0, 0), a2, voffA);
            PG8_BAR; PG8_WAIT_L(0); PG8_MMA(1, 0, At, B0); PG8_BAR; PG8_SCHED;
            PG8_STAGE(PG8_SB(0, 1), b2 + hstep, voffB);
            PG8_WAIT_V(6); PG8_BAR; PG8_MMA(1, 1, At, B1); PG8_BAR;
            PG8_LDB(B0, 1, 0); PG8_SCHED; PG8_LDA(At, 1, 0); PG8_STAGE(PG8_SA(0, 1), a2 + hstep, voffA);
            PG8_WAIT_L(8); PG8_BAR; PG8_WAIT_L(0); PG8_MMA(0, 0, At, B0); PG8_BAR; PG8_SCHED;
            PG8_LDB(B1, 1, 1); PG8_STAGE(PG8_SB(1, 0), b3, voffB);
            PG8_BAR; PG8_WAIT_L(0); PG8_MMA(0, 1, At, B1); PG8_BAR;
            PG8_LDA(At, 1, 1); PG8_STAGE(PG8_SA(1, 0), a3, voffA);
            PG8_BAR; PG8_WAIT_L(0); PG8_MMA(1, 0, At, B0); PG8_BAR; PG8_SCHED;
            PG8_STAGE(PG8_SB(1, 1), b3 + hstep, voffB);
            PG8_WAIT_V(6); PG8_BAR; PG8_MMA(1, 1, At, B1); PG8_BAR;
            }
        }
        if constexpr (ALIGN_EPI) { if (wr == 0) PG8_BAR; }
        if constexpr (!Epi::AFTER_DRAIN) { E(acc, cur, wr, wc, fr, fq); S.done(cur); }
        if (!has_next) break;
#pragma unroll
        for (int a = 0; a < 2; ++a)
#pragma unroll
            for (int b = 0; b < 2; ++b)
#pragma unroll
                for (int m = 0; m < 4; ++m)
#pragma unroll
                    for (int n = 0; n < 2; ++n) acc[a][b][m][n] = (f32x4){0.f, 0.f, 0.f, 0.f};
        cur = nxt; cA = nA; cB = nB; ++ui;
        if constexpr (ALIGN_EPI) { if (wr == 1) PG8_BAR; }
    }
    PG8_WAIT_V(0);
    if constexpr (!ALIGN_EPI) { if (wr == 0) PG8_BAR; }
    PG8_BAR;
    if constexpr (Epi::AFTER_DRAIN) { E.fused(acc, cur, wr, wc, fr, fq, lds, wid, lane); S.done(cur); }
#undef PG8_SA
#undef PG8_SB
#undef PG8_STAGE
#undef PG8_LDA
#undef PG8_LDB
#undef PG8_MMA
#undef PG8_WAIT_V
#undef PG8_WAIT_L
#undef PG8_BAR
#undef PG8_SCHED
}
}
constexpr int NWAVES = 8, NTHR = 512;
constexpr int BATCH = 8, SEQ = 4096, DM = 1024, CTXL = 256, DEPTH = 4;
constexpr int MLAT = BATCH * SEQ, MCTX = BATCH * CTXL, MTOT = MLAT + MCTX;
constexpr int NP_EVEN = 3584, NPAD_EVEN = 3840, NORIG_EVEN = 3616;
constexpr int NP_ODD = 2816, NPAD_ODD = 3072, NORIG_ODD = 2832;
constexpr int NCHUNK = 68;
constexpr int NSLOT = BATCH * 4 * 2 * NCHUNK;
constexpr float ALPHA_DN = 1.681792830507429f;
constexpr size_t MiB = 1u << 20;
constexpr size_t WS_MOD = 0;
constexpr size_t WS_BAR = 512 * 1024;
constexpr size_t WS_ROPE = 1 * MiB;
constexpr size_t WS_SC = WS_ROPE + 65536;
constexpr size_t WS_GAM = 2 * MiB;
constexpr size_t WS_SM = 4 * MiB;
constexpr size_t WS_WIE = 9 * MiB;
constexpr size_t WS_WIO = 24 * MiB;
constexpr size_t WS_WO = 36 * MiB;
constexpr size_t WS_XC = 44 * MiB;
constexpr size_t WS_H = 52 * MiB;
constexpr size_t WS_P = 120 * MiB;
constexpr size_t WS_S = 359 * MiB;
constexpr size_t WS_X16 = 427 * MiB;
constexpr size_t WS_END = WS_X16 + (size_t)MTOT * 1024 * 2;
static_assert(WS_S + (size_t)NSLOT * 8192 * 2 <= WS_X16, "ws map 4");
static_assert(WS_SC + (size_t)NSLOT * 16 <= WS_GAM && WS_GAM + (size_t)NSLOT * 256 <= WS_SM && WS_SM + (size_t)MTOT * 128 <= WS_WIE, "ws map 1");
static_assert(WS_WIE + (size_t)2 * NPAD_EVEN * 1024 * 2 <= WS_WIO && WS_WIO + (size_t)2 * NPAD_ODD * 1024 * 2 <= WS_WO && WS_WO + (size_t)4 * 1024 * 1024 * 2 <= WS_XC, "ws map 2");
static_assert(WS_XC + (size_t)MCTX * 1024 * 4 <= WS_H && WS_H + (size_t)MTOT * 1024 * 2 <= WS_P && WS_P + (size_t)MTOT * NP_EVEN * 2 <= WS_S && WS_END <= 512 * MiB, "ws map 3");
constexpr int LDS_BYTES = 147456;

#define LAS __attribute__((address_space(3)))
typedef unsigned short bf16;
typedef float f32x4 __attribute__((ext_vector_type(4)));
typedef short bf16x8 __attribute__((ext_vector_type(8)));
typedef short s16x4 __attribute__((ext_vector_type(4)));
typedef unsigned u32x4 __attribute__((ext_vector_type(4)));
typedef unsigned u32x2 __attribute__((ext_vector_type(2)));
#define LDS_WAIT() asm volatile("s_waitcnt lgkmcnt(0)" ::: "memory")

typedef __bf16 hbf2 __attribute__((ext_vector_type(2)));
typedef float f32x2_ __attribute__((ext_vector_type(2)));
__device__ __forceinline__ unsigned f2bf(float f) { const __bf16 b = (__bf16)f; return (unsigned)__builtin_bit_cast(unsigned short, b); }
__device__ __forceinline__ unsigned pk2(float lo, float hi) { const f32x2_ v = {lo, hi}; const hbf2 b = __builtin_convertvector(v, hbf2); return __builtin_bit_cast(unsigned, b); }
__device__ __forceinline__ float bf2f(unsigned short v) { return __builtin_bit_cast(float, (unsigned)v << 16); }
__device__ __forceinline__ float bflo(unsigned w) { return __builtin_bit_cast(float, w << 16); }
__device__ __forceinline__ float bfhi(unsigned w) { return __builtin_bit_cast(float, w & 0xffff0000u); }
__device__ __forceinline__ float siluf(float x) { return x * __builtin_amdgcn_rcpf(1.f + __expf(-x)); }
__device__ __forceinline__ float logsigf(float z) { return fminf(z, 0.f) - 0.69314718056f * __builtin_amdgcn_logf(1.f + __builtin_amdgcn_exp2f(-1.44269504089f * fabsf(z))); }
__device__ __forceinline__ float rdlane(float v, int l) { return __builtin_bit_cast(float, __builtin_amdgcn_readlane(__builtin_bit_cast(int, v), l)); }
template <int N> __device__ __forceinline__ float dpp_ror(float v) { return __builtin_bit_cast(float, __builtin_amdgcn_update_dpp(0, __builtin_bit_cast(int, v), 0x120 + N, 0xf, 0xf, false)); }
__device__ __forceinline__ float red16_max(float v) { v = fmaxf(v, dpp_ror<1>(v)); v = fmaxf(v, dpp_ror<2>(v)); v = fmaxf(v, dpp_ror<4>(v)); v = fmaxf(v, dpp_ror<8>(v)); return v; }
__device__ __forceinline__ float red16_sum(float v) { v += dpp_ror<1>(v); v += dpp_ror<2>(v); v += dpp_ror<4>(v); v += dpp_ror<8>(v); return v; }
__device__ __forceinline__ float wave_sum(float v) { v = red16_sum(v); return (rdlane(v, 0) + rdlane(v, 16)) + (rdlane(v, 32) + rdlane(v, 48)); }
__device__ __forceinline__ float wave_max(float v) { v = red16_max(v); return fmaxf(fmaxf(rdlane(v, 0), rdlane(v, 16)), fmaxf(rdlane(v, 32), rdlane(v, 48))); }
template <int N, bool REV> __device__ __forceinline__ float dpp_rshift(float v, float ident) {
    return __builtin_bit_cast(float, __builtin_amdgcn_update_dpp(__builtin_bit_cast(int, ident), __builtin_bit_cast(int, v), (REV ? 0x100 : 0x110) + N, 0xf, 0xf, false));
}
template <bool REV> __device__ __forceinline__ float wave_scan_sum_t(float v, int lane) {
    v += dpp_rshift<1, REV>(v, 0.f); v += dpp_rshift<2, REV>(v, 0.f); v += dpp_rshift<4, REV>(v, 0.f); v += dpp_rshift<8, REV>(v, 0.f);
    const int row = lane >> 4;
    if (!REV) { const float t0 = rdlane(v, 15), t1 = rdlane(v, 31), t2 = rdlane(v, 47);
        v += row == 1 ? t0 : row == 2 ? t0 + t1 : row == 3 ? t0 + t1 + t2 : 0.f; }
    else { const float t1 = rdlane(v, 16), t2 = rdlane(v, 32), t3 = rdlane(v, 48);
        v += row == 2 ? t3 : row == 1 ? t3 + t2 : row == 0 ? t3 + t2 + t1 : 0.f; }
    return v;
}
template <bool REV> __device__ __forceinline__ float wave_scan_max_t(float v, int lane) {
    v = fmaxf(v, dpp_rshift<1, REV>(v, -3e38f)); v = fmaxf(v, dpp_rshift<2, REV>(v, -3e38f)); v = fmaxf(v, dpp_rshift<4, REV>(v, -3e38f)); v = fmaxf(v, dpp_rshift<8, REV>(v, -3e38f));
    const int row = lane >> 4;
    if (!REV) { const float t0 = rdlane(v, 15), t1 = rdlane(v, 31), t2 = rdlane(v, 47);
        v = fmaxf(v, row == 1 ? t0 : row == 2 ? fmaxf(t0, t1) : row == 3 ? fmaxf(fmaxf(t0, t1), t2) : -3e38f); }
    else { const float t1 = rdlane(v, 16), t2 = rdlane(v, 32), t3 = rdlane(v, 48);
        v = fmaxf(v, row == 2 ? t3 : row == 1 ? fmaxf(t3, t2) : row == 0 ? fmaxf(fmaxf(t3, t2), t1) : -3e38f); }
    return v;
}
template <int N, bool REV> __device__ __forceinline__ float dpp_rshift0(float v) {
    return __builtin_bit_cast(float, __builtin_amdgcn_update_dpp(0, __builtin_bit_cast(int, v), (REV ? 0x100 : 0x110) + N, 0xf, 0xf, true));
}
template <int N, bool REV, bool MAX> __device__ __forceinline__ float scan_step(float v, int li) {
    const float t = dpp_rshift0<N, REV>(v); const bool ok = REV ? (li + N < 16) : (li >= N);
    return MAX ? (ok ? fmaxf(v, t) : v) : (ok ? v + t : v);
}
template <bool REV, bool MAX> __device__ __forceinline__ float wave_scan_t(float v, int lane) {
    const int li = lane & 15, row = lane >> 4;
    v = scan_step<1, REV, MAX>(v, li); v = scan_step<2, REV, MAX>(v, li); v = scan_step<4, REV, MAX>(v, li); v = scan_step<8, REV, MAX>(v, li);
    const float a0 = rdlane(v, REV ? 48 : 15), a1 = rdlane(v, REV ? 32 : 31), a2 = rdlane(v, REV ? 16 : 47);
    const int k = REV ? 3 - row : row;
    if (MAX) { float e = v; if (k >= 1) e = fmaxf(e, a0); if (k >= 2) e = fmaxf(e, a1); if (k >= 3) e = fmaxf(e, a2); return e; }
    float e = v; if (k >= 1) e += a0; if (k >= 2) e += a1; if (k >= 3) e += a2; return e;
}
__device__ __forceinline__ float wave_scan_sum(float v, int lane, bool rev) { return rev ? wave_scan_t<true, false>(v, lane) : wave_scan_t<false, false>(v, lane); }
__device__ __forceinline__ float wave_scan_max(float v, int lane, bool rev) { return rev ? wave_scan_t<true, true>(v, lane) : wave_scan_t<false, true>(v, lane); }
#define MFMA(a, b, c) __builtin_amdgcn_mfma_f32_16x16x32_bf16((a), (b), (c), 0, 0, 0)
__device__ __forceinline__ bf16x8 frag_rm(const LAS bf16* X, int ld, int row0, int k0, int lane) {
    return *(const LAS bf16x8*)(X + (row0 + (lane & 15)) * ld + k0 + 8 * (lane >> 4));
}
__device__ __forceinline__ bf16x8 frag_tr(const LAS bf16* X, int ld, int k0, int n0, int lane) {
    const int g = lane >> 4, m = lane & 15, q = m >> 2, p = m & 3;
    const LAS bf16* a0 = X + (k0 + 8 * g + q) * ld + n0 + 4 * p;
    const s16x4 lo = __builtin_amdgcn_ds_read_tr16_b64_v4i16((LAS s16x4*)a0);
    const s16x4 hi = __builtin_amdgcn_ds_read_tr16_b64_v4i16((LAS s16x4*)(a0 + 4 * ld));
    bf16x8 r; r[0] = lo[0]; r[1] = lo[1]; r[2] = lo[2]; r[3] = lo[3]; r[4] = hi[0]; r[5] = hi[1]; r[6] = hi[2]; r[7] = hi[3]; return r;
}

struct Params {
    const float *x, *c, *ctx, *c_ctx, *w_ada, *b_ada, *ln_g, *ln_b, *w_in_even, *w_out_even, *gla_gate_w, *gla_gate_b, *gla_norm_g, *na_rpb, *w_in_odd, *w_out_odd, *ml_gate_b, *ml_norm_g, *sw_sink;
    float* out; unsigned char* ws; long long ph_lo, ph_hi;
};
typedef const __attribute__((address_space(4))) Params* KP;
__device__ __forceinline__ KP kparams() { unsigned long long v = (unsigned long long)__builtin_amdgcn_kernarg_segment_ptr(); asm volatile("" : "+s"(v)); return (KP)v; }

__device__ __forceinline__ int orig_col(int type, int n) {
    if (type == 0) { if (n < 1536) return n; if (n < 3584) return n + 32; if (n < 3616) return n - 3584 + 1536; return -1; }
    if (type == 1) { if (n < 1536) return n; if (n < 2816) return n + 16; if (n < 2832) return n - 2816 + 1536; return -1; }
    return n;
}
__device__ __forceinline__ float col_scale(int type, int n) {
    if (type == 0) return (n < 256 || (n >= 1536 && n < 2048)) ? 0.125f : 1.f;
    if (type == 1) return ((n >= 256 && n < 512) || (n >= 1536 && n < 2048)) ? 0.125f : 1.f;
    return 1.f;
}
__device__ __forceinline__ void p0_transpose_item(const float* __restrict__ W, int K, int Norig, int type, bf16* __restrict__ WT, LAS float* scr, int nblk, int item, int lane) {
    const int kb = item / nblk, nb = item % nblk, k0 = 64 * kb, n0 = 32 * nb;
    const int oc = orig_col(type, n0 + (lane & 31)); const float sc = col_scale(type, n0 + (lane & 31));
#pragma unroll 8
    for (int i = 0; i < 32; ++i) { const int kk = 2 * i + (lane >> 5); scr[kk * 33 + (lane & 31)] = oc >= 0 ? W[(size_t)(k0 + kk) * Norig + oc] * sc : 0.f; }
    LDS_WAIT();
    const int c = lane & 7;
#pragma unroll
    for (int j = 0; j < 4; ++j) { const int n = (lane >> 3) + 8 * j; const LAS float* s = scr + (8 * c) * 33 + n;
        u32x4 o; o.x = pk2(s[0 * 33], s[1 * 33]); o.y = pk2(s[2 * 33], s[3 * 33]); o.z = pk2(s[4 * 33], s[5 * 33]); o.w = pk2(s[6 * 33], s[7 * 33]);
        *(u32x4*)(WT + (size_t)(n0 + n) * K + k0 + 8 * c) = o; }
    LDS_WAIT();
}
__device__ __forceinline__ void phase_prologue(KP p, LAS unsigned char* lds) {
    const int tid = otid(), lane = tid & 63, wave = tid >> 6;
    unsigned char* ws = p->ws;
    float* MOD = (float*)(ws + WS_MOD);
    if ((int)blockIdx.x < 192) {
        LAS float* cond = (LAS float*)lds;
        LAS float* red = (LAS float*)(lds + 36864);
        for (int e = tid; e < 9 * 1024; e += NTHR) { const int j = e >> 10, k = e & 1023; const float v = j < 8 ? p->c[j * 1024 + k] : p->c_ctx[k]; cond[e] = siluf(v); }
        __syncthreads();
        for (int it = blockIdx.x; it < 192; it += gridDim.x) {
            const int l = it / 48, n0 = (it % 48) * 64, cq = tid & 15, ks = tid >> 4;
            float acc[9][4];
#pragma unroll
            for (int j = 0; j < 9; ++j) { acc[j][0] = 0.f; acc[j][1] = 0.f; acc[j][2] = 0.f; acc[j][3] = 0.f; }
            const float* wp = p->w_ada + (size_t)l * 1024 * 3072 + (size_t)(ks * 32) * 3072 + n0 + 4 * cq;
#pragma unroll 4
            for (int kk = 0; kk < 32; ++kk) { const f32x4 w = *(const f32x4*)(wp + (size_t)kk * 3072);
#pragma unroll
                for (int j = 0; j < 9; ++j) { const float cv = cond[j * 1024 + ks * 32 + kk]; acc[j][0] += cv * w[0]; acc[j][1] += cv * w[1]; acc[j][2] += cv * w[2]; acc[j][3] += cv * w[3]; } }
#pragma unroll
            for (int j = 0; j < 9; ++j)
#pragma unroll
                for (int i = 0; i < 4; ++i) red[ks * 576 + j * 64 + 4 * cq + i] = acc[j][i];
            __syncthreads();
            for (int o = tid; o < 576; o += NTHR) { float s = 0.f; for (int q = 0; q < 32; ++q) s += red[q * 576 + o]; const int j = o >> 6, n = n0 + (o & 63);
                MOD[(size_t)(l * 9 + j) * 3072 + n] = s + p->b_ada[l * 3072 + n]; }
            __syncthreads();
        }
    }
    if (blockIdx.x == gridDim.x - 1) {
        float* cosT = (float*)(ws + WS_ROPE); float* sinT = cosT + 1024;
        for (int e = tid; e < 1024; e += NTHR) { const int pos = e >> 4, i = e & 15;
            double f = 1.0; for (int q = 0; q < i; ++q) f *= 0.5623413251903491;
            const double f2 = f * f; double sn = 1.0, cs = 1.0;
            for (int q = 12; q >= 1; --q) { sn = 1.0 - f2 / ((2.0 * q) * (2.0 * q + 1.0)) * sn; cs = 1.0 - f2 / ((2.0 * q - 1.0) * (2.0 * q)) * cs; }
            sn *= f;
            double c = 1.0, s = 0.0; for (int q = 0; q < pos; ++q) { const double c2 = c * cs - s * sn, s2 = s * cs + c * sn; c = c2; s = s2; }
            cosT[e] = (float)c; sinT[e] = (float)s; }
    }
    __syncthreads();
    {
        LAS float* scr = (LAS float*)(lds + wave * 16384);
        const int gw = blockIdx.x * NWAVES + wave, NGW = gridDim.x * NWAVES;
        constexpr int I_E = 16 * (NPAD_EVEN / 32), I_O = 16 * (NPAD_ODD / 32), I_W = 16 * 32;
        constexpr int NIT = 2 * I_E + 2 * I_O + 4 * I_W;
        for (int it = gw; it < NIT; it += NGW) {
            int r = it;
            if (r < 2 * I_E) { const int i = r / I_E; r -= i * I_E; p0_transpose_item(p->w_in_even + (size_t)i * 1024 * NORIG_EVEN, 1024, NORIG_EVEN, 0, (bf16*)(ws + WS_WIE) + (size_t)i * NPAD_EVEN * 1024, scr, NPAD_EVEN / 32, r, lane); continue; }
            r -= 2 * I_E;
            if (r < 2 * I_O) { const int i = r / I_O; r -= i * I_O; p0_transpose_item(p->w_in_odd + (size_t)i * 1024 * NORIG_ODD, 1024, NORIG_ODD, 1, (bf16*)(ws + WS_WIO) + (size_t)i * NPAD_ODD * 1024, scr, NPAD_ODD / 32, r, lane); continue; }
            r -= 2 * I_O;
            { const int l = r / I_W; r -= l * I_W; const float* W = (l & 1) ? p->w_out_odd + (size_t)(l >> 1) * 1024 * 1024 : p->w_out_even + (size_t)(l >> 1) * 1024 * 1024;
              p0_transpose_item(W, 1024, 1024, 2, (bf16*)(ws + WS_WO) + (size_t)l * 1024 * 1024, scr, 32, r, lane); }
        }
    }
}
__device__ __forceinline__ void phase_h0(KP p) {
    const int lane = otid() & 63, gw = blockIdx.x * NWAVES + (otid() >> 6), NGW = gridDim.x * NWAVES;
    const float* MOD = (const float*)(p->ws + WS_MOD); bf16* H = (bf16*)(p->ws + WS_H);
    for (int m = gw; m < MTOT; m += NGW) {
        const int jb = m < MLAT ? (m >> 12) : 8;
        const float* src = m < MLAT ? p->x + (size_t)m * DM : p->ctx + (size_t)(m - MLAT) * DM;
        const float* md = MOD + (size_t)jb * 3072;
#pragma unroll
        for (int j = 0; j < 4; ++j) { const int k = 4 * lane + 256 * j; const f32x4 v = *(const f32x4*)(src + k), sh = *(const f32x4*)(md + k), sc = *(const f32x4*)(md + 1024 + k);
            const f32x4 h = v * (sc + 1.0f) + sh; u32x2 o; o.x = pk2(h[0], h[1]); o.y = pk2(h[2], h[3]); *(u32x2*)(H + (size_t)m * DM + k) = o; }
    }
}
typedef _Float16 f16x4 __attribute__((ext_vector_type(4)));
struct LnRaw { f32x4 xf[2][4]; f16x4 xh[2][4]; u32x2 y[2][4]; };
__device__ __forceinline__ void ln_load(LnRaw& R, int l, int m0, int lane, const float* xin, const float* cin, const _Float16* X16, const bf16* Y) {
#pragma unroll
    for (int j = 0; j < 4; ++j) { const int k = 4 * lane + 256 * j;
#pragma unroll
        for (int q = 0; q < 2; ++q) { const int m = m0 + q;
            if (l == 0) R.xf[q][j] = *(const f32x4*)((m < MLAT ? xin + (size_t)m * DM : cin + (size_t)(m - MLAT) * DM) + k);
            else R.xh[q][j] = *(const f16x4*)(X16 + (size_t)m * DM + k);
            R.y[q][j] = *(const u32x2*)(Y + (size_t)m * DM + k); } }
}
__device__ __forceinline__ void phase_ln(KP p, int l, bool dummy = false) {
    const int lane = otid() & 63, gw = blockIdx.x * NWAVES + (otid() >> 6), NGW = gridDim.x * NWAVES;
    const float* MOD = (const float*)(p->ws + WS_MOD); bf16* H = (bf16*)(p->ws + WS_H); const bf16* Y = (const bf16*)(p->ws + WS_P); _Float16* X16 = (_Float16*)(p->ws + WS_X16);
    const int mrows = l < DEPTH - 1 ? MTOT : MLAT;
    const float* lg = p->ln_g + l * DM; const float* lb = p->ln_b + l * DM;
    const float* xin = p->x; const float* cin = p->ctx; float* outp = p->out;
    LnRaw R;
    if (2 * gw < mrows) ln_load(R, l, 2 * gw, lane, xin, cin, X16, Y);
    for (int m0 = 2 * gw; m0 < mrows; m0 += 2 * NGW) {
        const int jb = m0 < MLAT ? (m0 >> 12) : 8;
        const float* md = MOD + (size_t)(l * 9 + jb) * 3072;
        f32x4 v[2][4], xs[2][4]; float s[2] = {0.f, 0.f};
#pragma unroll
        for (int j = 0; j < 4; ++j) { const int k = 4 * lane + 256 * j; const f32x4 g = *(const f32x4*)(md + 2048 + k);
#pragma unroll
            for (int q = 0; q < 2; ++q) { const f32x4 xv = l == 0 ? R.xf[q][j] : __builtin_convertvector(R.xh[q][j], f32x4); const u32x2 yw = R.y[q][j];
                f32x4 y; y[0] = bflo(yw.x); y[1] = bfhi(yw.x); y[2] = bflo(yw.y); y[3] = bfhi(yw.y);
                xs[q][j] = xv; v[q][j] = xv * ALPHA_DN + g * y; s[q] += (v[q][j][0] + v[q][j][1]) + (v[q][j][2] + v[q][j][3]); } }
        if (m0 + 2 * NGW < mrows) ln_load(R, l, m0 + 2 * NGW, lane, xin, cin, X16, Y);
        float rstd[2];
#pragma unroll
        for (int q = 0; q < 2; ++q) { const float mean = wave_sum(s[q]) * (1.f / DM); float s2 = 0.f;
#pragma unroll
            for (int j = 0; j < 4; ++j) { v[q][j] = v[q][j] - mean; s2 += (v[q][j][0] * v[q][j][0] + v[q][j][1] * v[q][j][1]) + (v[q][j][2] * v[q][j][2] + v[q][j][3] * v[q][j][3]); }
            rstd[q] = 1.f / sqrtf(wave_sum(s2) * (1.f / DM) + 1e-5f); }
        const float* md2 = MOD + (size_t)((l + 1) * 9 + jb) * 3072;
#pragma unroll
        for (int j = 0; j < 4; ++j) { const int k = 4 * lane + 256 * j; const f32x4 gg = *(const f32x4*)(lg + k), bb = *(const f32x4*)(lb + k);
            f32x4 sh = (f32x4){0.f, 0.f, 0.f, 0.f}, sc = sh; if (l < DEPTH - 1) { sh = *(const f32x4*)(md2 + k); sc = *(const f32x4*)(md2 + 1024 + k); }
#pragma unroll
            for (int q = 0; q < 2; ++q) { const int m = m0 + q; const f32x4 o = v[q][j] * rstd[q] * gg + bb;
                if (l < DEPTH - 1) { *(f16x4*)(X16 + (size_t)m * DM + k) = __builtin_convertvector(dummy ? xs[q][j] : o, f16x4);
                    const f32x4 h = o * (sc + 1.0f) + sh; u32x2 w; w.x = pk2(h[0], h[1]); w.y = pk2(h[2], h[3]); *(u32x2*)(H + (size_t)m * DM + k) = w; }
                else { if (!dummy) *(f32x4*)(outp + (size_t)m * DM + k) = o; } } }
    }
}
constexpr int AT_KS = 0, AT_VS = 9216, AT_BUF = 18432, AT_PS = 36864, AT_RPB = AT_PS + 8 * 2304;
__device__ __forceinline__ bf16x8 frag_tr_perm(const LAS bf16* X, int ld, int k0, int n0, int lane) {
    const int g = lane >> 4, m = lane & 15, q = m >> 2, p = m & 3;
    const LAS bf16* a0 = X + (k0 + 4 * g + q) * ld + n0 + 4 * p;
    const s16x4 lo = __builtin_amdgcn_ds_read_tr16_b64_v4i16((LAS s16x4*)a0);
    const s16x4 hi = __builtin_amdgcn_ds_read_tr16_b64_v4i16((LAS s16x4*)(a0 + 16 * ld));
    bf16x8 r; r[0] = lo[0]; r[1] = lo[1]; r[2] = lo[2]; r[3] = lo[3]; r[4] = hi[0]; r[5] = hi[1]; r[6] = hi[2]; r[7] = hi[3]; return r;
}
__device__ __forceinline__ void attn_tile(const LAS bf16* Ks, const LAS bf16* Vs, const LAS float* rpb, const bf16x8 (&qa)[2][2], float (&mrow)[2], float (&lsum)[2], f32x4 (&oacc)[2][4],
                                          int mode, int i, int nlat, int qa_, int qb_, int ka_, int lane) {
    const int fq = lane >> 4, fr = lane & 15;
    const bool islat = i < nlat;
    bool active = true; int kt0 = 0;
    if (islat) {
        if (mode == 0) { kt0 = ka_ + i; const int rs = min(max(qa_ - 4, 0), 56); active = (kt0 >= rs) && (kt0 < rs + 8); }
        else { kt0 = ka_ + 64 * i; active = !(kt0 > qa_ + 31 + 128 || kt0 + 63 < qa_ - 128); }
    }
    if (!active) return;
    const bool nar = islat && mode == 0;
    const int ct0 = qb_ >> 4;
    int ntlo[2], nthi[2];
#pragma unroll
    for (int nq = 0; nq < 2; ++nq) { const int ct = ct0 + nq; ntlo[nq] = nar ? (ct < 2 ? 0 : ct - 1) : 0; nthi[nq] = nar ? (ct > 1 ? 3 : ct + 1) : 3; }
    const int ulo = min(ntlo[0], ntlo[1]), uhi = max(nthi[0], nthi[1]);
    f32x4 s[2][4];
#pragma unroll
    for (int mt = 0; mt < 4; ++mt) { s[0][mt] = (f32x4){0.f, 0.f, 0.f, 0.f}; s[1][mt] = (f32x4){0.f, 0.f, 0.f, 0.f};
        if (mt >= ulo && mt <= uhi) {
#pragma unroll
            for (int ks = 0; ks < 2; ++ks) { const bf16x8 kf = frag_rm(Ks, 72, 16 * mt, 32 * ks, lane);
                if (mt >= ntlo[0] && mt <= nthi[0]) s[0][mt] = MFMA(kf, qa[0][ks], s[0][mt]);
                if (mt >= ntlo[1] && mt <= nthi[1]) s[1][mt] = MFMA(kf, qa[1][ks], s[1][mt]); } } }
    unsigned pw[2][8];
#pragma unroll
    for (int nq = 0; nq < 2; ++nq) {
        float tmax = -3e38f;
#pragma unroll
        for (int mt = 0; mt < 4; ++mt) { if (mt >= ntlo[nq] && mt <= nthi[nq]) {
#pragma unroll
            for (int r = 0; r < 4; ++r) { float v = s[nq][mt][r]; const int kk = 16 * mt + 4 * fq + r;
                if (islat) {
                    if (mode == 0) { const int qc = qb_ + 16 * nq + fr, cs = min(max(qc - 8, 0), 48); const bool ok = (kk >= cs) && (kk < cs + 16);
                        const int bi = (kt0 - qa_ + 7) * 31 + (kk - qc + 15); v = ok ? v + rpb[ok ? bi : 0] : -3e38f; }
                    else { const int d = (qa_ + 16 * nq + fr) - (kt0 + kk); v = (d <= 128 && d >= -128) ? v : -3e38f; }
                }
                s[nq][mt][r] = v; tmax = fmaxf(tmax, v); } } }
        tmax = fmaxf(tmax, __shfl_xor(tmax, 16)); tmax = fmaxf(tmax, __shfl_xor(tmax, 32));
        const float mnew = fmaxf(mrow[nq], tmax); const float alpha = __expf(mrow[nq] - mnew); mrow[nq] = mnew;
        float ps = 0.f;
#pragma unroll
        for (int mt = 0; mt < 4; ++mt) { float p0 = 0.f, p1 = 0.f, p2 = 0.f, p3 = 0.f;
            if (mt >= ntlo[nq] && mt <= nthi[nq]) { p0 = __expf(s[nq][mt][0] - mnew); p1 = __expf(s[nq][mt][1] - mnew); p2 = __expf(s[nq][mt][2] - mnew); p3 = __expf(s[nq][mt][3] - mnew); ps += (p0 + p1) + (p2 + p3); }
            pw[nq][2 * mt] = pk2(p0, p1); pw[nq][2 * mt + 1] = pk2(p2, p3); oacc[nq][mt] = oacc[nq][mt] * alpha; }
        lsum[nq] = lsum[nq] * alpha + ps;
    }
#pragma unroll
    for (int ks = 0; ks < 2; ++ks) { if (ks == 0 ? (ulo < 2) : (uhi > 1)) {
        const u32x4 pu0 = (u32x4){pw[0][4 * ks], pw[0][4 * ks + 1], pw[0][4 * ks + 2], pw[0][4 * ks + 3]}, pu1 = (u32x4){pw[1][4 * ks], pw[1][4 * ks + 1], pw[1][4 * ks + 2], pw[1][4 * ks + 3]};
        const bf16x8 pb0 = __builtin_bit_cast(bf16x8, pu0), pb1 = __builtin_bit_cast(bf16x8, pu1);
#pragma unroll
        for (int mt = 0; mt < 4; ++mt) { const bf16x8 vf = frag_tr_perm(Vs, 72, 32 * ks, 16 * mt, lane); oacc[0][mt] = MFMA(vf, pb0, oacc[0][mt]); oacc[1][mt] = MFMA(vf, pb1, oacc[1][mt]); } } }
}
constexpr int AT_PSW = 32 * 72 * 2;
constexpr int AT_RPB2 = AT_PS + 8 * AT_PSW;
__device__ __forceinline__ void attn_item(LAS unsigned char* lds, const bf16* __restrict__ P, int ldp, bf16* __restrict__ Z, int mode,
                                          int qrow0, int qcol, int kcol, int vcol, int gcol, int zcol,
                                          int nlat, int lat_row0, int ctx_row0, int qa_, int qb_, int ka_, const float* __restrict__ rpb_g, float sink) {
    const int tid = otid(), lane = tid & 63, wave = tid >> 6, fq = lane >> 4, fr = lane & 15;
    LAS bf16* Ks0 = (LAS bf16*)(lds + AT_KS); LAS bf16* Vs0 = (LAS bf16*)(lds + AT_VS); LAS bf16* Ks1 = (LAS bf16*)(lds + AT_KS + AT_BUF); LAS bf16* Vs1 = (LAS bf16*)(lds + AT_VS + AT_BUF);
    LAS bf16* Ps = (LAS bf16*)(lds + AT_PS + wave * AT_PSW); LAS float* rpb = (LAS float*)(lds + AT_RPB2);
    const int ntile = nlat + 4, srow = tid >> 3, sch = tid & 7, soff = srow * 72 + 8 * sch;
#define AT_ROWB(j) (((j) < nlat) ? lat_row0 + 64 * (j) : ctx_row0 + 64 * ((j) - nlat))
#define AT_LOAD(kr, vr, j) do { const size_t ro_ = (size_t)(AT_ROWB(j) + srow) * ldp + 8 * sch; kr = *(const u32x4*)(P + ro_ + kcol); vr = *(const u32x4*)(P + ro_ + vcol); } while (0)
    u32x4 k0, v0, k1, v1;
    AT_LOAD(k0, v0, 0);
    bf16x8 qa[2][2];
#pragma unroll
    for (int nq = 0; nq < 2; ++nq)
#pragma unroll
        for (int ks = 0; ks < 2; ++ks) qa[nq][ks] = *(const bf16x8*)(P + (size_t)(qrow0 + 16 * nq + fr) * ldp + qcol + 32 * ks + 8 * fq);
    __syncthreads();
    if (mode == 0) { for (int e = tid; e < 465; e += NTHR) rpb[e] = rpb_g[e]; }
    *(LAS u32x4*)(Ks0 + soff) = k0; *(LAS u32x4*)(Vs0 + soff) = v0;
    AT_LOAD(k0, v0, 1);
    AT_LOAD(k1, v1, 2);
    float mrow[2] = {-1e30f, -1e30f}, lsum[2] = {0.f, 0.f}; f32x4 oacc[2][4];
#pragma unroll
    for (int nq = 0; nq < 2; ++nq)
#pragma unroll
        for (int r = 0; r < 4; ++r) oacc[nq][r] = (f32x4){0.f, 0.f, 0.f, 0.f};
    __syncthreads();
    for (int i = 0; i < ntile; i += 2) {
        attn_tile(Ks0, Vs0, rpb, qa, mrow, lsum, oacc, mode, i, nlat, qa_, qb_, ka_, lane);
        if (i + 1 < ntile) { *(LAS u32x4*)(Ks1 + soff) = k0; *(LAS u32x4*)(Vs1 + soff) = v0; }
        if (i + 3 < ntile) AT_LOAD(k0, v0, i + 3);
        __syncthreads();
        if (i + 1 >= ntile) break;
        attn_tile(Ks1, Vs1, rpb, qa, mrow, lsum, oacc, mode, i + 1, nlat, qa_, qb_, ka_, lane);
        if (i + 2 < ntile) { *(LAS u32x4*)(Ks0 + soff) = k1; *(LAS u32x4*)(Vs0 + soff) = v1; }
        if (i + 4 < ntile) AT_LOAD(k1, v1, i + 4);
        __syncthreads();
    }
#undef AT_LOAD
#undef AT_ROWB
    u32x4 gvv[4];
#pragma unroll
    for (int c2 = 0; c2 < 4; ++c2) { const int idx = lane + 64 * c2, q = idx >> 3, ch = idx & 7; gvv[c2] = *(const u32x4*)(P + (size_t)(qrow0 + q) * ldp + gcol + 8 * ch); }
#pragma unroll
    for (int nq = 0; nq < 2; ++nq) { float lt = lsum[nq]; lt += __shfl_xor(lt, 16); lt += __shfl_xor(lt, 32); float sc;
      if (mode == 1 || mode == 3) { const float mf = fmaxf(mrow[nq], sink); const float al = __expf(mrow[nq] - mf); lt = lt * al + __expf(sink - mf); sc = al / lt; } else sc = 1.f / lt;
#pragma unroll
      for (int mt = 0; mt < 4; ++mt) { u32x2 w; w.x = pk2(oacc[nq][mt][0] * sc, oacc[nq][mt][1] * sc); w.y = pk2(oacc[nq][mt][2] * sc, oacc[nq][mt][3] * sc); *(LAS u32x2*)(Ps + (16 * nq + fr) * 72 + 16 * mt + 4 * fq) = w; } }
    LDS_WAIT();
#pragma unroll
    for (int c2 = 0; c2 < 4; ++c2) { const int idx = lane + 64 * c2, q = idx >> 3, ch = idx & 7;
        const u32x4 ov = *(const LAS u32x4*)(Ps + q * 72 + 8 * ch); const u32x4 gv = gvv[c2];
        u32x4 w;
        w.x = pk2(bflo(ov.x) * siluf(bflo(gv.x)), bfhi(ov.x) * siluf(bfhi(gv.x))); w.y = pk2(bflo(ov.y) * siluf(bflo(gv.y)), bfhi(ov.y) * siluf(bfhi(gv.y)));
        w.z = pk2(bflo(ov.z) * siluf(bflo(gv.z)), bfhi(ov.z) * siluf(bfhi(gv.z))); w.w = pk2(bflo(ov.w) * siluf(bflo(gv.w)), bfhi(ov.w) * siluf(bfhi(gv.w)));
        *(u32x4*)(Z + (size_t)(qrow0 + q) * DM + zcol + 8 * ch) = w; }
    LDS_WAIT();
}
__device__ __forceinline__ void phase_attn(KP p, LAS unsigned char* lds, int l, bool need_ctx) {
    const int wave = otid() >> 6; const bool odd = l & 1; const int li = l >> 1;
    const bf16* P = (const bf16*)(p->ws + WS_P); bf16* Z = (bf16*)(p->ws + WS_H); const int ldp = odd ? NP_ODD : NP_EVEN;
    const int nmain = BATCH * 8 * 16, nctx = need_ctx ? BATCH * 8 : 0;
    for (int it = blockIdx.x; it < nmain + nctx; it += gridDim.x) {
        if (it < nmain) {
            int itv = it;
            if (gridDim.x == 256) { const int rnd = it >> 8, bx = it & 255, xcd = bx & 7, slot = bx >> 3; itv = ((rnd * 16 + 2 * xcd + (slot >> 4)) << 4) + (slot & 15); }
            const int b = itv >> 7, h = (itv >> 4) & 7, qb = itv & 15;
            if (!odd) { const int r0 = 4 * qb, rw = r0 + (wave >> 1); const int rs0 = min(max(r0 - 4, 0), 56), rs3 = min(max(r0 + 3 - 4, 0), 56);
                attn_item(lds, P, ldp, Z, 0, b * SEQ + rw * 64 + 32 * (wave & 1), 1536 + h * 64, 2048 + h * 64, 2560 + h * 64, 3072 + h * 64, 512 + h * 64,
                          rs3 + 8 - rs0, b * SEQ + rs0 * 64, MLAT + b * CTXL, rw, 32 * (wave & 1), rs0, p->na_rpb + (size_t)(li * 8 + h) * 465, 0.f); }
            else { const int kv = h >> 2, t0 = 256 * qb, lt0 = max(0, 4 * qb - 2), lt1 = min(63, 4 * qb + 5);
                attn_item(lds, P, ldp, Z, 1, b * SEQ + t0 + 32 * wave, 1536 + h * 64, 2048 + kv * 64, 2176 + kv * 64, 2304 + h * 64, 512 + h * 64,
                          lt1 - lt0 + 1, b * SEQ + lt0 * 64, MLAT + b * CTXL, t0 + 32 * wave, 0, lt0 * 64, nullptr, p->sw_sink[li * 8 + h]); }
        } else {
            const int j = it - nmain, b = j >> 3, h = j & 7; const int q0 = MLAT + b * CTXL + 32 * wave;
            if (!odd) attn_item(lds, P, ldp, Z, 2, q0, 1536 + h * 64, 2048 + h * 64, 2560 + h * 64, 3072 + h * 64, 512 + h * 64, 0, 0, MLAT + b * CTXL, 0, 0, 0, nullptr, 0.f);
            else { const int kv = h >> 2; attn_item(lds, P, ldp, Z, 3, q0, 1536 + h * 64, 2048 + kv * 64, 2176 + kv * 64, 2304 + h * 64, 512 + h * 64, 0, 0, MLAT + b * CTXL, 0, 0, 0, nullptr, p->sw_sink[li * 8 + h]); }
        }
    }
}
__device__ __forceinline__ int chunk_row0(int b, int cp) { return cp < 4 ? MLAT + b * CTXL + cp * 64 : b * SEQ + (cp - 4) * 64; }
constexpr int SL_KDF = 0, SL_KDB = 9216, SL_VS = 18432, SL_SEG = 35840, SL_MISC = 39936;
__device__ __forceinline__ void phase_scan_local(KP p, LAS unsigned char* lds, int l) {
    const int tid = otid(), lane = tid & 63, wave = tid >> 6, fq = lane >> 4, fr = lane & 15; const bool odd = l & 1; const int li = l >> 1;
    const bf16* P = (const bf16*)(p->ws + WS_P); const int ldp = odd ? NP_ODD : NP_EVEN; const float* SM = (const float*)(p->ws + WS_SM);
    bf16* S = (bf16*)(p->ws + WS_S); float* GAM = (float*)(p->ws + WS_GAM); float* SC = (float*)(p->ws + WS_SC);
    LAS bf16* kdf = (LAS bf16*)(lds + SL_KDF); LAS bf16* kdb = (LAS bf16*)(lds + SL_KDB); LAS bf16* vs = (LAS bf16*)(lds + SL_VS);
    LAS float* seg = (LAS float*)(lds + SL_SEG); LAS float* misc = (LAS float*)(lds + SL_MISC);
    const int dk = tid & 63, sg = tid >> 6;
    for (int it = blockIdx.x; it < BATCH * 4 * NCHUNK; it += gridDim.x) {
        const int b = it / (4 * NCHUNK), h = (it / NCHUNK) & 3, cp = it % NCHUNK; const int row0 = chunk_row0(b, cp);
        const int slf = ((b * 4 + h) * 2 + 0) * NCHUNK + cp, slb = slf + NCHUNK;
        __syncthreads();
#pragma unroll
        for (int c2 = 0; c2 < 2; ++c2) { const int idx = tid + NTHR * c2, t = idx >> 4, ch = idx & 15; *(LAS u32x4*)(vs + t * 136 + 8 * ch) = *(const u32x4*)(P + (size_t)(row0 + t) * ldp + 512 + h * 128 + 8 * ch); }
        float kv[8];
#pragma unroll
        for (int tt = 0; tt < 8; ++tt) kv[tt] = bf2f(P[(size_t)(row0 + sg * 8 + tt) * ldp + 256 + h * 64 + dk]);
        if (!odd) {
            float gwf[16], gwb[16];
            const float* gw = p->gla_gate_w + (size_t)li * 2 * 16 * 256; const float* gb = p->gla_gate_b + (size_t)li * 2 * 256;
#pragma unroll
            for (int r = 0; r < 16; ++r) { gwf[r] = gw[r * 256 + h * 64 + dk]; gwb[r] = gw[(16 + r) * 256 + h * 64 + dk]; }
            const float gbf = gb[h * 64 + dk], gbb = gb[256 + h * 64 + dk];
            { const int t = tid >> 3, c4 = (tid & 7) * 4; *(LAS f32x4*)(misc + t * 32 + c4) = *(const f32x4*)(SM + (size_t)(row0 + t) * 32 + c4); }
            __syncthreads();
            float pf[8], sb[8];
            f32x4 L[2][8];
#pragma unroll
            for (int i = 0; i < 8; ++i) L[0][i] = *(const LAS f32x4*)(misc + (sg * 8) * 32 + 4 * i);
#pragma unroll
            for (int tt = 0; tt < 8; ++tt) {
                if (tt < 7) {
#pragma unroll
                    for (int i = 0; i < 8; ++i) L[(tt + 1) & 1][i] = *(const LAS f32x4*)(misc + (sg * 8 + tt + 1) * 32 + 4 * i); }
                float zf = gbf, zb = gbb, zf2 = 0.f, zb2 = 0.f;
#pragma unroll
                for (int i = 0; i < 4; i += 2)
#pragma unroll
                    for (int e = 0; e < 4; ++e) { zf += L[tt & 1][i][e] * gwf[4 * i + e]; zf2 += L[tt & 1][i + 1][e] * gwf[4 * i + 4 + e]; zb += L[tt & 1][4 + i][e] * gwb[4 * i + e]; zb2 += L[tt & 1][5 + i][e] * gwb[4 * i + 4 + e]; }
                pf[tt] = logsigf(zf + zf2) * 0.0625f; sb[tt] = logsigf(zb + zb2) * 0.0625f; }
#pragma unroll
            for (int tt = 1; tt < 8; ++tt) pf[tt] += pf[tt - 1];
#pragma unroll
            for (int tt = 6; tt >= 0; --tt) sb[tt] += sb[tt + 1];
            seg[(0 * 8 + sg) * 64 + dk] = pf[7]; seg[(1 * 8 + sg) * 64 + dk] = sb[0];
            __syncthreads();
            float offf = 0.f, totf = 0.f, offb = 0.f, totb = 0.f;
#pragma unroll
            for (int q = 0; q < 8; ++q) { const float a = seg[q * 64 + dk], c = seg[(8 + q) * 64 + dk]; totf += a; totb += c; if (q < sg) offf += a; if (q > sg) offb += c; }
#pragma unroll
            for (int tt = 0; tt < 8; ++tt) { const int t = sg * 8 + tt;
                kdf[t * 72 + dk] = (bf16)f2bf(kv[tt] * __expf(totf - (offf + pf[tt]))); kdb[t * 72 + dk] = (bf16)f2bf(kv[tt] * __expf(totb - (offb + sb[tt]))); }
            if (sg == 0) { GAM[(size_t)slf * 64 + dk] = __expf(totf); GAM[(size_t)slb * 64 + dk] = __expf(totb); }
        } else {
            const float* mb = p->ml_gate_b + li * 16;
            if (tid < 128) { const int d = tid >> 6, t = tid & 63; const float* gp = SM + (size_t)(row0 + t) * 32 + d * 8;
                misc[d * 128 + t] = gp[h] + mb[d * 8 + h]; misc[d * 128 + 64 + t] = logsigf(gp[4 + h] + mb[d * 8 + 4 + h]); }
            __syncthreads();
            if (tid < 128) { const int d = tid >> 6, t = tid & 63; const float run = wave_scan_sum(misc[d * 128 + 64 + t], t, d == 1);
                const float tot = d == 0 ? __shfl(run, 63) : __shfl(run, 0);
                const float wl = tot - run + misc[d * 128 + t]; const float ml = wave_max(wl);
                misc[256 + d * 64 + t] = __expf(wl - ml);
                if (t == 0) { const int sl = d == 0 ? slf : slb; SC[(size_t)sl * 4 + 0] = tot; SC[(size_t)sl * 4 + 1] = ml; } }
            __syncthreads();
            float nf = 0.f, nb = 0.f;
#pragma unroll
            for (int tt = 0; tt < 8; ++tt) { const int t = sg * 8 + tt; const float a = kv[tt] * misc[256 + t], c = kv[tt] * misc[256 + 64 + t]; nf += a; nb += c;
                kdf[t * 72 + dk] = (bf16)f2bf(a); kdb[t * 72 + dk] = (bf16)f2bf(c); }
            seg[(0 * 8 + sg) * 64 + dk] = nf; seg[(1 * 8 + sg) * 64 + dk] = nb;
            __syncthreads();
            if (sg < 2) { float s2 = 0.f;
#pragma unroll
                for (int q = 0; q < 8; ++q) s2 += seg[(sg * 8 + q) * 64 + dk];
                GAM[(size_t)(sg == 0 ? slf : slb) * 64 + dk] = s2; }
        }
        __syncthreads();
#pragma unroll
        for (int d = 0; d < 2; ++d) { const LAS bf16* kd = d ? kdb : kdf; f32x4 acc[4];
#pragma unroll
            for (int nt = 0; nt < 4; ++nt) acc[nt] = (f32x4){0.f, 0.f, 0.f, 0.f};
#pragma unroll
            for (int ks = 0; ks < 2; ++ks) { const bf16x8 av = frag_tr(vs, 136, 32 * ks, 16 * wave, lane);
#pragma unroll
                for (int nt = 0; nt < 4; ++nt) acc[nt] = MFMA(av, frag_tr(kd, 72, 32 * ks, 16 * nt, lane), acc[nt]); }
            bf16* dst = S + (size_t)(d ? slb : slf) * 8192;
#pragma unroll
            for (int nt = 0; nt < 4; ++nt) { u32x2 w; w.x = pk2(acc[nt][0], acc[nt][1]); w.y = pk2(acc[nt][2], acc[nt][3]); *(u32x2*)(dst + (16 * nt + fr) * 128 + 16 * wave + 4 * fq) = w; } }
    }
}
__device__ __forceinline__ void phase_scan_seq(KP p, int l, bool dummy = false) {
    const bool odd = l & 1;
    u32x2* S2 = (u32x2*)(p->ws + WS_S); float* GAM = (float*)(p->ws + WS_GAM); f32x4* GAM4 = (f32x4*)(p->ws + WS_GAM); float* SC = (float*)(p->ws + WS_SC);
    const int nthreads = gridDim.x * NTHR;
    for (int gid = blockIdx.x * NTHR + otid(); gid < 64 * 2048; gid += nthreads) {
        const int chain = gid >> 11, e4 = gid & 2047, dir = chain & 1, dkk = e4 >> 5; const int base = chain * NCHUNK;
        f32x4 st = (f32x4){0.f, 0.f, 0.f, 0.f}, nst = (f32x4){0.f, 0.f, 0.f, 0.f}; float m = 0.f; const bool hasn = odd && e4 < 16;
        for (int s0 = 0; s0 < NCHUNK; s0 += 4) {
            u32x2 dr[4]; f32x4 dn[4]; float g0[4], g1[4]; int idx[4];
#pragma unroll
            for (int u = 0; u < 4; ++u) { const int step = s0 + u; const int cp = dir == 0 ? step : (step < 4 ? 3 - step : 71 - step); idx[u] = base + cp;
                dr[u] = S2[(size_t)idx[u] * 2048 + e4];
                if (!odd) { g0[u] = GAM[(size_t)idx[u] * 64 + dkk]; g1[u] = 0.f; } else { g0[u] = SC[(size_t)idx[u] * 4 + 0]; g1[u] = SC[(size_t)idx[u] * 4 + 1]; if (hasn) dn[u] = GAM4[(size_t)idx[u] * 16 + e4]; } }
#pragma unroll
            for (int u = 0; u < 4; ++u) {
                const f32x4 d = (f32x4){bflo(dr[u].x), bfhi(dr[u].x), bflo(dr[u].y), bfhi(dr[u].y)};
                u32x2 w; w.x = pk2(st[0], st[1]); w.y = pk2(st[2], st[3]);
                S2[(size_t)idx[u] * 2048 + e4] = dummy ? dr[u] : w;
                if (!odd) { st = st * g0[u] + d; }
                else { if (hasn) GAM4[(size_t)idx[u] * 16 + e4] = dummy ? dn[u] : nst; if (e4 == 0 && !dummy) SC[(size_t)idx[u] * 4 + 2] = m;
                    const float mn = fmaxf(g0[u] + m, g1[u]); const float dec = __expf(g0[u] + m - mn), sc = __expf(g1[u] - mn);
                    st = st * dec + d * sc; if (hasn) nst = nst * dec + dn[u] * sc; m = mn; }
            }
        }
    }
}
constexpr int SO_QF = 0, SO_KF = 9216, SO_QB = 18432, SO_KB = 27648, SO_VS = 36864, SO_AF = 54272, SO_AB = 63488, SO_SF = 72704, SO_SB = 90112, SO_SEG = 107520, SO_SSQ = 111616, SO_MISC = 113664;
constexpr int SO_OST = 0;
__device__ __forceinline__ void scan_out_tail(LAS unsigned char* lds, f32x4 (&o)[4], const bf16* __restrict__ P, int ldp, bf16* __restrict__ Z, int row0, int h, const float* __restrict__ ng) {
    const int tid = otid(), lane = tid & 63, wave = tid >> 6, fq = lane >> 4, fr = lane & 15;
    LAS float* ost = (LAS float*)(lds + SO_OST);
    u32x4 gv[2]; f32x4 g0[2], g1[2];
#pragma unroll
    for (int c2 = 0; c2 < 2; ++c2) { const int idx = tid + NTHR * c2, t = idx >> 4, ch = idx & 15;
        gv[c2] = *(const u32x4*)(P + (size_t)(row0 + t) * ldp + 1024 + h * 128 + 8 * ch); g0[c2] = *(const f32x4*)(ng + h * 128 + 8 * ch); g1[c2] = *(const f32x4*)(ng + h * 128 + 8 * ch + 4); }
    __syncthreads();
#pragma unroll
    for (int mt = 0; mt < 4; ++mt)
#pragma unroll
        for (int r = 0; r < 4; ++r) ost[(16 * mt + 4 * fq + r) * 132 + 16 * wave + fr] = o[mt][r];
    __syncthreads();
#pragma unroll
    for (int c2 = 0; c2 < 2; ++c2) { const int idx = tid + NTHR * c2, t = idx >> 4, ch = idx & 15;
        f32x4 o0 = *(const LAS f32x4*)(ost + t * 132 + 8 * ch), o1 = *(const LAS f32x4*)(ost + t * 132 + 8 * ch + 4);
        const float q = red16_sum((o0[0] * o0[0] + o0[1] * o0[1]) + (o0[2] * o0[2] + o0[3] * o0[3]) + (o1[0] * o1[0] + o1[1] * o1[1]) + (o1[2] * o1[2] + o1[3] * o1[3]));
        const float rs = rsqrtf(q * (1.f / 128.f) + 1e-6f); o0 = o0 * rs * g0[c2]; o1 = o1 * rs * g1[c2];
        u32x4 w;
        w.x = pk2(o0[0] * siluf(bflo(gv[c2].x)), o0[1] * siluf(bfhi(gv[c2].x))); w.y = pk2(o0[2] * siluf(bflo(gv[c2].y)), o0[3] * siluf(bfhi(gv[c2].y)));
        w.z = pk2(o1[0] * siluf(bflo(gv[c2].z)), o1[1] * siluf(bfhi(gv[c2].z))); w.w = pk2(o1[2] * siluf(bflo(gv[c2].w)), o1[3] * siluf(bfhi(gv[c2].w)));
        *(u32x4*)(Z + (size_t)(row0 + t) * DM + h * 128 + 8 * ch) = w; }
}
__device__ __forceinline__ void stage_state(LAS bf16* dst, const bf16* __restrict__ src) {
    const int tid = otid();
#pragma unroll
    for (int c2 = 0; c2 < 2; ++c2) { const int idx = tid + NTHR * c2, r = idx >> 4, ch = idx & 15; *(LAS u32x4*)(dst + r * 136 + 8 * ch) = *(const u32x4*)(src + r * 128 + 8 * ch); }
}
__device__ __forceinline__ void phase_scan_out_gla(KP p, LAS unsigned char* lds, int l, bool need_ctx) {
    const int tid = otid(), lane = tid & 63, wave = tid >> 6, fq = lane >> 4, fr = lane & 15; const int li = l >> 1;
    const bf16* P = (const bf16*)(p->ws + WS_P); const int ldp = NP_EVEN; const float* SM = (const float*)(p->ws + WS_SM); bf16* Z = (bf16*)(p->ws + WS_H);
    const bf16* S = (const bf16*)(p->ws + WS_S);
    LAS bf16* qf = (LAS bf16*)(lds + SO_QF); LAS bf16* kf = (LAS bf16*)(lds + SO_KF); LAS bf16* qb = (LAS bf16*)(lds + SO_QB); LAS bf16* kb = (LAS bf16*)(lds + SO_KB);
    LAS bf16* vs = (LAS bf16*)(lds + SO_VS); LAS bf16* Af = (LAS bf16*)(lds + SO_AF); LAS bf16* Ab = (LAS bf16*)(lds + SO_AB); LAS bf16* Sf = (LAS bf16*)(lds + SO_SF); LAS bf16* Sb = (LAS bf16*)(lds + SO_SB);
    LAS float* seg = (LAS float*)(lds + SO_SEG); LAS float* lrs = (LAS float*)(lds + SO_MISC);
    const int dk = tid & 63, sg = tid >> 6;
    for (int it = blockIdx.x; it < BATCH * 4 * NCHUNK; it += gridDim.x) {
        const int b = it / (4 * NCHUNK), h = (it / NCHUNK) & 3, cp = it % NCHUNK; if (cp < 4 && !need_ctx) continue;
        const int row0 = chunk_row0(b, cp); const int slf = ((b * 4 + h) * 2 + 0) * NCHUNK + cp, slb = slf + NCHUNK;
        __syncthreads();
#pragma unroll
        for (int c2 = 0; c2 < 2; ++c2) { const int idx = tid + NTHR * c2, t = idx >> 4, ch = idx & 15; *(LAS u32x4*)(vs + t * 136 + 8 * ch) = *(const u32x4*)(P + (size_t)(row0 + t) * ldp + 512 + h * 128 + 8 * ch); }
        stage_state(Sf, S + (size_t)slf * 8192); stage_state(Sb, S + (size_t)slb * 8192);
        float qv[8], kv[8];
#pragma unroll
        for (int tt = 0; tt < 8; ++tt) { const size_t ro = (size_t)(row0 + sg * 8 + tt) * ldp + h * 64 + dk; qv[tt] = bf2f(P[ro]); kv[tt] = bf2f(P[ro + 256]); }
        float gwf[16], gwb[16];
        const float* gw = p->gla_gate_w + (size_t)li * 2 * 16 * 256; const float* gb = p->gla_gate_b + (size_t)li * 2 * 256;
#pragma unroll
        for (int r = 0; r < 16; ++r) { gwf[r] = gw[r * 256 + h * 64 + dk]; gwb[r] = gw[(16 + r) * 256 + h * 64 + dk]; }
        const float gbf = gb[h * 64 + dk], gbb = gb[256 + h * 64 + dk];
        { const int t = tid >> 3, c4 = (tid & 7) * 4; *(LAS f32x4*)(lrs + t * 32 + c4) = *(const f32x4*)(SM + (size_t)(row0 + t) * 32 + c4); }
        __syncthreads();
        float pf[8], sb[8];
        f32x4 L[2][8];
#pragma unroll
        for (int i = 0; i < 8; ++i) L[0][i] = *(const LAS f32x4*)(lrs + (sg * 8) * 32 + 4 * i);
#pragma unroll
        for (int tt = 0; tt < 8; ++tt) {
            if (tt < 7) {
#pragma unroll
                for (int i = 0; i < 8; ++i) L[(tt + 1) & 1][i] = *(const LAS f32x4*)(lrs + (sg * 8 + tt + 1) * 32 + 4 * i); }
            float zf = gbf, zb = gbb, zf2 = 0.f, zb2 = 0.f;
#pragma unroll
            for (int i = 0; i < 4; i += 2)
#pragma unroll
                for (int e = 0; e < 4; ++e) { zf += L[tt & 1][i][e] * gwf[4 * i + e]; zf2 += L[tt & 1][i + 1][e] * gwf[4 * i + 4 + e]; zb += L[tt & 1][4 + i][e] * gwb[4 * i + e]; zb2 += L[tt & 1][5 + i][e] * gwb[4 * i + 4 + e]; }
            pf[tt] = logsigf(zf + zf2) * 0.0625f; sb[tt] = logsigf(zb + zb2) * 0.0625f; }
#pragma unroll
        for (int tt = 1; tt < 8; ++tt) pf[tt] += pf[tt - 1];
#pragma unroll
        for (int tt = 6; tt >= 0; --tt) sb[tt] += sb[tt + 1];
        seg[(0 * 8 + sg) * 64 + dk] = pf[7]; seg[(1 * 8 + sg) * 64 + dk] = sb[0];
        __syncthreads();
        float offf = 0.f, offb = 0.f;
#pragma unroll
        for (int q = 0; q < 8; ++q) { const float a = seg[q * 64 + dk], c = seg[(8 + q) * 64 + dk]; if (q < sg) offf += a; if (q > sg) offb += c; }
#pragma unroll
        for (int tt = 0; tt < 8; ++tt) { const int t = sg * 8 + tt; const float bf_ = offf + pf[tt], bb_ = offb + sb[tt];
            qf[t * 72 + dk] = (bf16)f2bf(qv[tt] * __expf(bf_)); kf[t * 72 + dk] = (bf16)f2bf(kv[tt] * __expf(-bf_));
            qb[t * 72 + dk] = (bf16)f2bf(qv[tt] * __expf(bb_)); kb[t * 72 + dk] = (bf16)f2bf(kv[tt] * __expf(-bb_)); }
        __syncthreads();
        { const int mt = wave >> 1;
#pragma unroll
          for (int n2 = 0; n2 < 2; ++n2) { const int nt = 2 * (wave & 1) + n2; f32x4 af = (f32x4){0.f, 0.f, 0.f, 0.f}, ab = (f32x4){0.f, 0.f, 0.f, 0.f};
#pragma unroll
              for (int ks = 0; ks < 2; ++ks) { af = MFMA(frag_rm(qf, 72, 16 * mt, 32 * ks, lane), frag_rm(kf, 72, 16 * nt, 32 * ks, lane), af);
                                               ab = MFMA(frag_rm(qb, 72, 16 * mt, 32 * ks, lane), frag_rm(kb, 72, 16 * nt, 32 * ks, lane), ab); }
#pragma unroll
              for (int r = 0; r < 4; ++r) { const int t = 16 * mt + 4 * fq + r, s = 16 * nt + fr;
                  Af[t * 72 + s] = (bf16)f2bf(s <= t ? af[r] : 0.f); Ab[t * 72 + s] = (bf16)f2bf(s >= t ? ab[r] : 0.f); } } }
        __syncthreads();
        f32x4 o[4];
#pragma unroll
        for (int mt = 0; mt < 4; ++mt) o[mt] = (f32x4){0.f, 0.f, 0.f, 0.f};
#pragma unroll
        for (int ks = 0; ks < 2; ++ks) { const bf16x8 bv = frag_tr(vs, 136, 32 * ks, 16 * wave, lane), bsf = frag_tr(Sf, 136, 32 * ks, 16 * wave, lane), bsb = frag_tr(Sb, 136, 32 * ks, 16 * wave, lane);
#pragma unroll
            for (int mt = 0; mt < 4; ++mt) { o[mt] = MFMA(frag_rm(Af, 72, 16 * mt, 32 * ks, lane), bv, o[mt]); o[mt] = MFMA(frag_rm(Ab, 72, 16 * mt, 32 * ks, lane), bv, o[mt]);
                o[mt] = MFMA(frag_rm(qf, 72, 16 * mt, 32 * ks, lane), bsf, o[mt]); o[mt] = MFMA(frag_rm(qb, 72, 16 * mt, 32 * ks, lane), bsb, o[mt]); } }
        scan_out_tail(lds, o, P, ldp, Z, row0, h, p->gla_norm_g + (size_t)li * 512);
    }
}
constexpr int MO_QS = 0, MO_KS = 9216, MO_QWF = 18432, MO_QWB = 27648;
__device__ __forceinline__ void phase_scan_out_mlstm(KP p, LAS unsigned char* lds, int l, bool need_ctx) {
    const int tid = otid(), lane = tid & 63, wave = tid >> 6, fq = lane >> 4, fr = lane & 15; const int li = l >> 1;
    const bf16* P = (const bf16*)(p->ws + WS_P); const int ldp = NP_ODD; const float* SM = (const float*)(p->ws + WS_SM); bf16* Z = (bf16*)(p->ws + WS_H);
    const bf16* S = (const bf16*)(p->ws + WS_S); const float* GAM = (const float*)(p->ws + WS_GAM); const float* SC = (const float*)(p->ws + WS_SC);
    LAS bf16* qs = (LAS bf16*)(lds + MO_QS); LAS bf16* ks_ = (LAS bf16*)(lds + MO_KS); LAS bf16* qwf = (LAS bf16*)(lds + MO_QWF); LAS bf16* qwb = (LAS bf16*)(lds + MO_QWB);
    LAS bf16* vs = (LAS bf16*)(lds + SO_VS); LAS bf16* Af = (LAS bf16*)(lds + SO_AF); LAS bf16* Ab = (LAS bf16*)(lds + SO_AB); LAS bf16* Cf = (LAS bf16*)(lds + SO_SF); LAS bf16* Cb = (LAS bf16*)(lds + SO_SB);
    LAS float* part = (LAS float*)(lds + SO_SEG);
    LAS float* misc = (LAS float*)(lds + SO_MISC);
    const float* mb = p->ml_gate_b + li * 16;
    for (int it = blockIdx.x; it < BATCH * 4 * NCHUNK; it += gridDim.x) {
        const int b = it / (4 * NCHUNK), h = (it / NCHUNK) & 3, cp = it % NCHUNK; if (cp < 4 && !need_ctx) continue;
        const int row0 = chunk_row0(b, cp); const int slf = ((b * 4 + h) * 2 + 0) * NCHUNK + cp, slb = slf + NCHUNK;
        __syncthreads();
#pragma unroll
        for (int c2 = 0; c2 < 2; ++c2) { const int idx = tid + NTHR * c2, t = idx >> 4, ch = idx & 15; *(LAS u32x4*)(vs + t * 136 + 8 * ch) = *(const u32x4*)(P + (size_t)(row0 + t) * ldp + 512 + h * 128 + 8 * ch); }
        stage_state(Cf, S + (size_t)slf * 8192); stage_state(Cb, S + (size_t)slb * 8192);
        { const int t = tid >> 3, ch = tid & 7; const size_t ro = (size_t)(row0 + t) * ldp + h * 64 + 8 * ch;
          *(LAS u32x4*)(qs + t * 72 + 8 * ch) = *(const u32x4*)(P + ro); *(LAS u32x4*)(ks_ + t * 72 + 8 * ch) = *(const u32x4*)(P + ro + 256); }
        float mprev_r = 0.f;
        if (tid < 128) { const int d = tid >> 6, t = tid & 63; const float* gp = SM + (size_t)(row0 + t) * 32 + d * 8;
            misc[d * 512 + t] = gp[h] + mb[d * 8 + h]; misc[d * 512 + 64 + t] = logsigf(gp[4 + h] + mb[d * 8 + 4 + h]);
            misc[1024 + d * 64 + t] = GAM[(size_t)(d ? slb : slf) * 64 + t]; mprev_r = SC[(size_t)(d ? slb : slf) * 4 + 2]; }
        __syncthreads();
        if (tid < 128) { const int d = tid >> 6, t = tid & 63; LAS float* md = misc + d * 512; const float run = wave_scan_sum(md[64 + t], t, d == 1); const float pm = wave_scan_max(md[t] - run, t, d == 1);
            const float mprev = mprev_r;
            const float mt_ = fmaxf(run + pm, run + mprev);
            md[128 + t] = run; md[192 + t] = mt_; md[256 + t] = __expf(run + mprev - mt_); }
        __syncthreads();
        { const int t = tid >> 3, ch = tid & 7; const u32x4 qv = *(const LAS u32x4*)(qs + t * 72 + 8 * ch); const float wf = misc[256 + t], wb = misc[512 + 256 + t];
          u32x4 a, c;
          a.x = pk2(bflo(qv.x) * wf, bfhi(qv.x) * wf); a.y = pk2(bflo(qv.y) * wf, bfhi(qv.y) * wf); a.z = pk2(bflo(qv.z) * wf, bfhi(qv.z) * wf); a.w = pk2(bflo(qv.w) * wf, bfhi(qv.w) * wf);
          c.x = pk2(bflo(qv.x) * wb, bfhi(qv.x) * wb); c.y = pk2(bflo(qv.y) * wb, bfhi(qv.y) * wb); c.z = pk2(bflo(qv.z) * wb, bfhi(qv.z) * wb); c.w = pk2(bflo(qv.w) * wb, bfhi(qv.w) * wb);
          *(LAS u32x4*)(qwf + t * 72 + 8 * ch) = a; *(LAS u32x4*)(qwb + t * 72 + 8 * ch) = c;
          const float q0 = bflo(qv.x), q1 = bfhi(qv.x), q2 = bflo(qv.y), q3 = bfhi(qv.y), q4 = bflo(qv.z), q5 = bfhi(qv.z), q6 = bflo(qv.w), q7 = bfhi(qv.w);
#pragma unroll
          for (int d = 0; d < 2; ++d) { const LAS float* nv = misc + 1024 + d * 64 + 8 * ch;
              part[(d * 8 + ch) * 64 + t] = q0 * nv[0] + q1 * nv[1] + q2 * nv[2] + q3 * nv[3] + q4 * nv[4] + q5 * nv[5] + q6 * nv[6] + q7 * nv[7]; } }
        { const int mt = wave >> 1; float rsf[4] = {0.f, 0.f, 0.f, 0.f}, rsb[4] = {0.f, 0.f, 0.f, 0.f};
#pragma unroll
          for (int n2 = 0; n2 < 2; ++n2) { const int nt = 2 * (wave & 1) + n2; f32x4 a = (f32x4){0.f, 0.f, 0.f, 0.f};
#pragma unroll
              for (int ks = 0; ks < 2; ++ks) a = MFMA(frag_rm(qs, 72, 16 * mt, 32 * ks, lane), frag_rm(ks_, 72, 16 * nt, 32 * ks, lane), a);
#pragma unroll
              for (int r = 0; r < 4; ++r) { const int t = 16 * mt + 4 * fq + r, s = 16 * nt + fr;
                  const float wf = s <= t ? __expf(misc[128 + t] - misc[128 + s] + misc[s] - misc[192 + t]) : 0.f;
                  const float wb = s >= t ? __expf(misc[512 + 128 + t] - misc[512 + 128 + s] + misc[512 + s] - misc[512 + 192 + t]) : 0.f;
                  const float vf = a[r] * wf, vb = a[r] * wb; rsf[r] += vf; rsb[r] += vb;
                  Af[t * 72 + s] = (bf16)f2bf(vf); Ab[t * 72 + s] = (bf16)f2bf(vb); } }
#pragma unroll
          for (int r = 0; r < 4; ++r) { const float a = red16_sum(rsf[r]), c = red16_sum(rsb[r]);
              if (fr == 0) { misc[1152 + (0 * 2 + (wave & 1)) * 64 + 16 * mt + 4 * fq + r] = a; misc[1152 + (1 * 2 + (wave & 1)) * 64 + 16 * mt + 4 * fq + r] = c; } } }
        __syncthreads();
        if (tid < 128) { const int d = tid >> 6, t = tid & 63; float qn = 0.f;
#pragma unroll
            for (int q = 0; q < 8; ++q) qn += part[(d * 8 + q) * 64 + t];
            const float den = misc[1152 + (d * 2 + 0) * 64 + t] + misc[1152 + (d * 2 + 1) * 64 + t] + misc[d * 512 + 256 + t] * qn;
            misc[d * 512 + 320 + t] = 1.f / fmaxf(fabsf(den), __expf(-misc[d * 512 + 192 + t])); }
        f32x4 of[4], ob[4];
#pragma unroll
        for (int mt = 0; mt < 4; ++mt) { of[mt] = (f32x4){0.f, 0.f, 0.f, 0.f}; ob[mt] = (f32x4){0.f, 0.f, 0.f, 0.f}; }
#pragma unroll
        for (int ks = 0; ks < 2; ++ks) { const bf16x8 bv = frag_tr(vs, 136, 32 * ks, 16 * wave, lane), bcf = frag_tr(Cf, 136, 32 * ks, 16 * wave, lane), bcb = frag_tr(Cb, 136, 32 * ks, 16 * wave, lane);
#pragma unroll
            for (int mt = 0; mt < 4; ++mt) { of[mt] = MFMA(frag_rm(Af, 72, 16 * mt, 32 * ks, lane), bv, of[mt]); of[mt] = MFMA(frag_rm(qwf, 72, 16 * mt, 32 * ks, lane), bcf, of[mt]);
                ob[mt] = MFMA(frag_rm(Ab, 72, 16 * mt, 32 * ks, lane), bv, ob[mt]); ob[mt] = MFMA(frag_rm(qwb, 72, 16 * mt, 32 * ks, lane), bcb, ob[mt]); } }
        __syncthreads();
        f32x4 o[4];
#pragma unroll
        for (int mt = 0; mt < 4; ++mt)
#pragma unroll
            for (int r = 0; r < 4; ++r) { const int t = 16 * mt + 4 * fq + r; o[mt][r] = of[mt][r] * misc[320 + t] + ob[mt][r] * misc[512 + 320 + t]; }
        scan_out_tail(lds, o, P, ldp, Z, row0, h, p->ml_norm_g + (size_t)li * 512);
    }
}
#define XB_TMO      128
#define XB_XCNT(j)  (256  + 64 * (j))
#define XB_XSUB(j)  (1280 + 64 * (j))
#define XB_XGEN(j)  (2304 + 64 * (j))
#define XB_TOP      3328
#define XB_TOPGEN   3392
#define XCD_BAR_WORDS 3456
#define XB_SPIN_CAP (1u << 18)

__device__ __forceinline__ unsigned xb_ld(unsigned* p)              { return __hip_atomic_load(p, __ATOMIC_RELAXED, __HIP_MEMORY_SCOPE_AGENT); }
__device__ __forceinline__ unsigned xb_add(unsigned* p, unsigned v) { return __hip_atomic_fetch_add(p, v, __ATOMIC_RELAXED, __HIP_MEMORY_SCOPE_AGENT); }
__device__ __forceinline__ unsigned xb_xcc_id() { return (unsigned)__builtin_amdgcn_s_getreg((3 << 11) | 20) & 0xFu; }
#define XB_SPIN(cond, bar) do { unsigned _sp = 0; while (cond) { __builtin_amdgcn_s_sleep(1); \
    if ((++_sp & 255u) == 0u) { if (xb_ld(&(bar)[XB_TMO])) break; if (_sp > XB_SPIN_CAP) { atomicAdd(&(bar)[XB_TMO], 1u); break; } } } } while (0)

struct XcdBarrier {
    unsigned* bar; unsigned x;
    volatile LAS unsigned* st;
};

__device__ __forceinline__ XcdBarrier xcd_barrier_post(unsigned* bar, volatile LAS unsigned* st) {
    XcdBarrier b; b.bar = bar; b.x = xb_xcc_id(); b.st = st;
    if (otid() == 0) (void)xb_add(&bar[XB_XCNT(b.x)], 1u);
    return b;
}
__device__ __forceinline__ void xcd_barrier_complete(unsigned* bar, unsigned x, unsigned& nloc, unsigned& nx) {
    const unsigned G = gridDim.x * gridDim.y * gridDim.z;
    unsigned sum, cnt, mine, sp = 0u;
    for (;;) {
        sum = 0u; cnt = 0u; mine = 0u;
#pragma unroll
        for (unsigned j = 0; j < 16; ++j) { const unsigned c = xb_ld(&bar[XB_XCNT(j)]); sum += c; cnt += (c > 0u) ? 1u : 0u; mine = (j == x) ? c : mine; }
        if (sum == G) break;
        __builtin_amdgcn_s_sleep(1);
        if ((++sp & 255u) == 0u) { if (xb_ld(&bar[XB_TMO])) break; if (sp > XB_SPIN_CAP) { atomicAdd(&bar[XB_TMO], 1u); break; } }
    }
    nloc = mine > 0u ? mine : 1u; nx = cnt > 0u ? cnt : 1u;
}

__device__ __forceinline__ void xcd_barrier(const XcdBarrier& b) {
    asm volatile("s_waitcnt vmcnt(0)" ::: "memory");
    __syncthreads();
    if (otid() == 0) {
        unsigned* bar = b.bar;
        __builtin_amdgcn_s_waitcnt(0);
        unsigned nloc = b.st[0], nx = b.st[1];
        if (nloc == 0u) { xcd_barrier_complete(bar, b.x, nloc, nx); b.st[0] = nloc; b.st[1] = nx; }
        const unsigned old = xb_add(&bar[XB_XSUB(b.x)], 1u);
        const unsigned gen = old / nloc;
        if (old + 1u == (gen + 1u) * nloc) {
            __builtin_amdgcn_fence(__ATOMIC_RELEASE, "agent");
            asm volatile("s_waitcnt vmcnt(0)" ::: "memory");
            const unsigned og = xb_add(&bar[XB_TOP], 1u);
            const unsigned tg = og / nx;
            if (og + 1u == (tg + 1u) * nx) xb_add(&bar[XB_TOPGEN], 1u);
            else XB_SPIN(xb_ld(&bar[XB_TOPGEN]) == tg, bar);
            __builtin_amdgcn_fence(__ATOMIC_ACQUIRE, "agent");
            xb_add(&bar[XB_XGEN(b.x)], 1u);
            asm volatile("s_waitcnt vmcnt(0)" ::: "memory");
        } else {
            XB_SPIN(xb_ld(&bar[XB_XGEN(b.x)]) == gen, bar);
            __builtin_amdgcn_fence(__ATOMIC_ACQUIRE, "agent");
            asm volatile("s_waitcnt vmcnt(0)" ::: "memory");
        }
    }
    __syncthreads();
}

#define REP_GEMM 1
#define REP_ATT 1
#define REP_LOC 1
#define REP_OUT 1
#define REP_PRO 1
#define REP_SEQ 1
#define REP_LN 1
#ifndef MK_N_LAUNCHES
#define MK_N_LAUNCHES 1
#endif
constexpr int N_PHASES = 2 + 6 * DEPTH;
__global__ void __launch_bounds__(NTHR, 2) fwd_megakernel(Params p_unused) {
    extern __shared__ __attribute__((aligned(16))) unsigned char lds_raw[];
    LAS unsigned char* lds = (LAS unsigned char*)lds_raw;
    cg::grid_group grid = cg::this_grid();
    const int lo = (int)kparams()->ph_lo, hi = (int)kparams()->ph_hi;
#define IN(k) (lo <= (k) && (k) < hi)
    volatile LAS unsigned* bst = (volatile LAS unsigned*)(lds + LDS_BYTES - 64);
    if (otid() < 16) bst[otid()] = 0u;
    __syncthreads();
    XcdBarrier bar = xcd_barrier_post((unsigned*)(kparams()->ws + WS_BAR), bst);
    if (kparams()->ph_hi < 0) grid.sync();
#define SEAM(k) do { if (IN(k) && IN((k) + 1)) xcd_barrier(bar); } while (0)
    if (IN(0)) { for (int rep = 0; rep < REP_PRO; ++rep) { phase_prologue(kparams(), lds); __syncthreads(); } } SEAM(0);
    if (IN(1)) { for (int rep = 0; rep < REP_PRO; ++rep) phase_h0(kparams()); } SEAM(1);
#pragma unroll 1
    for (int l = 0; l < DEPTH; ++l) {
        const int pb = 2 + 6 * l; const bool odd = l & 1; const int li = l >> 1; const bool need_ctx = l < DEPTH - 1;
        if (IN(pb + 0)) {
            const int npad = odd ? NPAD_ODD : NPAD_EVEN; unsigned char* ws = kparams()->ws;
            pg8::Gemm g{(const pg8::bf16_t*)(ws + WS_H), (const pg8::bf16_t*)(ws + (odd ? WS_WIO : WS_WIE)) + (size_t)li * npad * 1024, MTOT, npad, 1024};
            pg8::StaticOrder S; S.init(MTOT, npad, (int)gridDim.x, (int)blockIdx.x);
            pg8::EpiProj E{(pg8::bf16_t*)(ws + WS_P), odd ? NP_ODD : NP_EVEN, (float*)(ws + WS_SM), odd ? 16 : 32, npad / 256 - 1, odd ? 1 : 0, (const float*)(ws + WS_ROPE), (const float*)(ws + WS_ROPE) + 1024};
            for (int rep = 0; rep < REP_GEMM; ++rep) pg8::gemm_phase<pg8::EpiProj, pg8::StaticOrder, true, true>(lds, g, S, E);
        }
        SEAM(pb + 0);
        if (IN(pb + 1)) { for (int rep = 0; rep < REP_ATT; ++rep) phase_attn(kparams(), lds, l, need_ctx); for (int rep = 0; rep < REP_LOC; ++rep) phase_scan_local(kparams(), lds, l); }
        SEAM(pb + 1);
        if (IN(pb + 2)) { for (int rep = 1; rep < REP_SEQ; ++rep) { phase_scan_seq(kparams(), l, true); __syncthreads(); } phase_scan_seq(kparams(), l); }
        SEAM(pb + 2);
        if (IN(pb + 3)) { for (int rep = 0; rep < REP_OUT; ++rep) { if (odd) phase_scan_out_mlstm(kparams(), lds, l, need_ctx); else phase_scan_out_gla(kparams(), lds, l, need_ctx); } }
        SEAM(pb + 3);
        if (IN(pb + 4)) {
            const int mrows = need_ctx ? MTOT : MLAT; unsigned char* ws = kparams()->ws;
            pg8::Gemm g{(const pg8::bf16_t*)(ws + WS_H), (const pg8::bf16_t*)(ws + WS_WO) + (size_t)l * 1024 * 1024, mrows, 1024, 1024};
            pg8::StaticOrder S; S.init(mrows, 1024, (int)gridDim.x, (int)blockIdx.x);
            pg8::EpiProj E{(pg8::bf16_t*)(ws + WS_P), 1024, nullptr, 0, -1, 0, nullptr, nullptr};
            for (int rep = 0; rep < REP_GEMM; ++rep) pg8::gemm_phase<pg8::EpiProj, pg8::StaticOrder, true, true>(lds, g, S, E);
        }
        SEAM(pb + 4);
        if (IN(pb + 5)) { for (int rep = 1; rep < REP_LN; ++rep) { phase_ln(kparams(), l, true); } phase_ln(kparams(), l); }
        SEAM(pb + 5);
    }
}
extern "C" void kernel_launch(void* const* d_in, const int* in_sizes, int n_in, void* d_out, int out_size, void* d_ws, size_t ws_size, hipStream_t stream) {
    static int grid = 0;
    if (grid == 0) {
        if (n_in != 19 || ws_size < WS_END) { fprintf(stderr, "kernel_launch: need 19 inputs and %zu bytes of workspace; got %d, %zu\n", (size_t)WS_END, n_in, ws_size); grid = -1; return; }
        int dev = 0, cus = 0, per_cu = 0;
        if (hipGetDevice(&dev) != hipSuccess || hipDeviceGetAttribute(&cus, hipDeviceAttributeMultiprocessorCount, dev) != hipSuccess) { grid = -1; return; }
        if (hipFuncSetAttribute((const void*)fwd_megakernel, hipFuncAttributeMaxDynamicSharedMemorySize, LDS_BYTES) != hipSuccess) { fprintf(stderr, "kernel_launch: hipFuncSetAttribute failed\n"); grid = -1; return; }
        if (hipOccupancyMaxActiveBlocksPerMultiprocessor(&per_cu, (const void*)fwd_megakernel, NTHR, LDS_BYTES) != hipSuccess || per_cu < 1) per_cu = 1;
        grid = cus * per_cu;
    }
    if (grid < 0) return;
    Params p{};
    p.x = (const float*)d_in[0]; p.c = (const float*)d_in[1]; p.ctx = (const float*)d_in[2]; p.c_ctx = (const float*)d_in[3]; p.w_ada = (const float*)d_in[4]; p.b_ada = (const float*)d_in[5];
    p.ln_g = (const float*)d_in[6]; p.ln_b = (const float*)d_in[7]; p.w_in_even = (const float*)d_in[8]; p.w_out_even = (const float*)d_in[9]; p.gla_gate_w = (const float*)d_in[10]; p.gla_gate_b = (const float*)d_in[11];
    p.gla_norm_g = (const float*)d_in[12]; p.na_rpb = (const float*)d_in[13]; p.w_in_odd = (const float*)d_in[14]; p.w_out_odd = (const float*)d_in[15]; p.ml_gate_b = (const float*)d_in[16]; p.ml_norm_g = (const float*)d_in[17];
    p.sw_sink = (const float*)d_in[18]; p.out = (float*)d_out; p.ws = (unsigned char*)d_ws;
    if (hipMemsetAsync((char*)d_ws + WS_BAR, 0, XCD_BAR_WORDS * 4, stream) != hipSuccess) { fprintf(stderr, "kernel_launch: memset failed\n"); return; }
#if MK_N_LAUNCHES == 1
    p.ph_lo = 0; p.ph_hi = N_PHASES;
    void* args[] = {&p};
    hipError_t e = hipLaunchCooperativeKernel((const void*)fwd_megakernel, dim3(grid), dim3(NTHR), args, LDS_BYTES, stream);
    if (e != hipSuccess) fprintf(stderr, "kernel_launch: cooperative launch failed: %s (grid %d)\n", hipGetErrorString(e), grid);
#else
    for (int k = 0; k < N_PHASES; ++k) { p.ph_lo = k; p.ph_hi = k + 1; hipLaunchKernelGGL(fwd_megakernel, dim3(grid), dim3(NTHR), LDS_BYTES, stream, p); }
#endif
}
```

```cpp
#include <hip/hip_runtime.h>
#include <hip/hip_cooperative_groups.h>
#include <cstdio>
#include <cstdint>
namespace cg = cooperative_groups;
__device__ __forceinline__ int otid() { int t = threadIdx.x; asm volatile("" : "+v"(t)); return t; }
namespace pg8 {
#define PG8_LAS __attribute__((address_space(3)))
typedef unsigned short bf16_t;
typedef short bf16x8 __attribute__((ext_vector_type(8)));
typedef float f32x4 __attribute__((ext_vector_type(4)));
typedef unsigned u32x4 __attribute__((ext_vector_type(4)));
constexpr int BM = 256, BK = 64, HALF = 128, HTB = HALF * BK * 2  , STAGE_BYTES = 8 * HTB, NXCD = 8, WGM = 8;

__host__ __device__ __forceinline__ int lds_byte(int r, int c) { const int st = (r >> 4) * 2 + (c >> 5), rr = r & 15, cc = c & 31, ob = rr * 64 + cc * 2; return st * 1024 + (ob ^ (((ob >> 9) & 1) << 5)); }
__host__ __device__ __forceinline__ void stage_rc(int b, int& R, int& C) { const int st = b / 1024, sb = b % 1024, swz = sb ^ (((sb >> 9) & 1) << 5); R = (st >> 1) * 16 + swz / 64; C = (st & 1) * 32 + (swz % 64) / 2; }
__host__ __device__ __forceinline__ int perm32(int rho) { const int n = rho >> 4, i = rho & 15; return 8 * (i >> 2) + 4 * n + (i & 3); }

struct Unit { int pm, pn; };
struct Gemm { const bf16_t* A; const bf16_t* Bt; int M, N, K; };

struct StaticOrder {
    int nM, nN, nwg, G, c;
    __host__ __device__ void init(int M, int N, int G_, int c_) { nM = M / BM; nN = N / BM; nwg = nM * nN; G = G_; c = c_; }
    __host__ __device__ bool next(int i, Unit& u) const {
        const long L = (long)i * G + c; if (L >= nwg) return false;
        int wgid = (int)L; { const int q = nwg / NXCD, r = nwg % NXCD, xcd = wgid % NXCD, off = wgid / NXCD; wgid = (xcd < r ? xcd * (q + 1) : r * (q + 1) + (xcd - r) * q) + off; }
        const int nig = WGM * nN, gid = wgid / nig, fm = gid * WGM, gsz = (nM - fm) < WGM ? (nM - fm) : WGM;
        u.pm = fm + ((wgid % nig) % gsz); u.pn = (wgid % nig) / gsz; return true;
    }
    __device__ __forceinline__ void a_ready(const Unit&) const {}
    __device__ __forceinline__ void done(const Unit&) const {}
};

__device__ __forceinline__ unsigned cvt_pk_bf16(float lo, float hi) { unsigned r; asm volatile("v_cvt_pk_bf16_f32 %0, %1, %2" : "=v"(r) : "v"(lo), "v"(hi)); return r; }
struct EpiProj {
    static constexpr bool PERM = true, AFTER_DRAIN = false;
    bf16_t* P; int ldp; float* SM; int nsm; int last_pn; int rope; const float* cosT; const float* sinT;
    __device__ __forceinline__ void operator()(const f32x4 (&acc)[2][2][4][2], const Unit& u, int wr, int wc, int fr, int fq) const {
        const int row0 = u.pm * BM + wr * 64 + fr;
        if (u.pn == last_pn) {
            if (wc == 0) {
#pragma unroll
                for (int ai = 0; ai < 2; ++ai)
#pragma unroll
                    for (int m = 0; m < 4; ++m) { const int row = row0 + ai * HALF + m * 16;
#pragma unroll
                        for (int n = 0; n < 2; ++n) { const int col = 8 * fq + 4 * n; if (col < nsm) *(f32x4*)(SM + (size_t)row * 32 + col) = acc[ai][0][m][n]; } }
            }
            return;
        }
        const bool do_rope_tile = rope && (u.pn == 6 || u.pn == 7 || u.pn == 8) && (u.pm * BM < 32768);
#pragma unroll
        for (int ai = 0; ai < 2; ++ai)
#pragma unroll
            for (int m = 0; m < 4; ++m) { const int row = row0 + ai * HALF + m * 16; bf16_t* rowp = P + (size_t)row * ldp + u.pn * BM + wc * 32 + 8 * fq;
#pragma unroll
                for (int bj = 0; bj < 2; ++bj) { f32x4 v0 = acc[ai][bj][m][0], v1 = acc[ai][bj][m][1];
                    if (do_rope_tile && (u.pn != 8 || bj == 0)) {
                        const int t = row & 4095; const int pos = (wc & 1) ? (t & 63) : (t >> 6); const int i0 = pos * 16 + 8 * (fq & 1);
                        const f32x4 c0 = *(const f32x4*)(cosT + i0), c1 = *(const f32x4*)(cosT + i0 + 4), s0 = *(const f32x4*)(sinT + i0), s1 = *(const f32x4*)(sinT + i0 + 4);
                        f32x4 p0, p1;
#pragma unroll
                        for (int e = 0; e < 4; ++e) { p0[e] = __shfl_xor(v0[e], 32); p1[e] = __shfl_xor(v1[e], 32); }
                        if (fq < 2) { v0 = v0 * c0 - p0 * s0; v1 = v1 * c1 - p1 * s1; } else { v0 = p0 * s0 + v0 * c0; v1 = p1 * s1 + v1 * c1; }
                    }
                    u32x4 w; w.x = cvt_pk_bf16(v0[0], v0[1]); w.y = cvt_pk_bf16(v0[2], v0[3]); w.z = cvt_pk_bf16(v1[0], v1[1]); w.w = cvt_pk_bf16(v1[2], v1[3]);
                    *(u32x4*)(rowp + bj * HALF) = w; } }
    }
};
template <class Epi, class Sched, bool ALIGN_EPI = false, bool SP2 = false>
__device__ __forceinline__ void gemm_phase(PG8_LAS unsigned char* lds, const Gemm g, const Sched& S, const Epi& E) {
    const int tid = otid(), wid = __builtin_amdgcn_readfirstlane(tid >> 6), lane = tid & 63, wr = wid >> 2, wc = wid & 3, fr = lane & 15, fq = lane >> 4;
    const int K = g.K, nt = K / BK;
    unsigned voffA[2], voffB[2];
#pragma unroll
    for (int i = 0; i < 2; ++i) { int R, C; stage_rc(tid * 16 + i * 8192, R, C); const int Rb = Epi::PERM ? ((R & ~31) + perm32(R & 31)) : R;
        voffA[i] = (unsigned)(R * K + C) * 2u; voffB[i] = (unsigned)(Rb * K + C) * 2u; }
    const size_t kstep = (size_t)(BK * 2);
    const size_t hstep = (size_t)HALF * K * 2;
    const size_t tstep = 2 * hstep;
    const unsigned ldsw = (unsigned)wid * 1024u;
    const int aoff = lds_byte(wr * 64 + fr, fq * 8), boff = lds_byte(wc * 32 + fr, fq * 8);
#define PG8_SA(b, h) (((b) * 2 + (h)) * HTB)
#define PG8_SB(b, h) ((4 + (b) * 2 + (h)) * HTB)
#define PG8_STAGE(bufoff, gbase, voff) do { _Pragma("unroll") for (int _i = 0; _i < 2; ++_i) \
        __builtin_amdgcn_global_load_lds((const unsigned*)((const char*)(gbase) + (voff)[_i]), (PG8_LAS unsigned*)(lds + (bufoff) + ldsw + _i * 8192), 16, 0, 0); } while (0)
#define PG8_LDA(dst, b, h) do { _Pragma("unroll") for (int m = 0; m < 4; ++m) _Pragma("unroll") for (int k = 0; k < 2; ++k) dst[m][k] = *(const PG8_LAS bf16x8*)(lds + PG8_SA(b, h) + aoff + m * 2048 + k * 1024); } while (0)
#define PG8_LDB(dst, b, h) do { _Pragma("unroll") for (int n = 0; n < 2; ++n) _Pragma("unroll") for (int k = 0; k < 2; ++k) dst[n][k] = *(const PG8_LAS bf16x8*)(lds + PG8_SB(b, h) + boff + n * 2048 + k * 1024); } while (0)
#define PG8_MMA(ai, bj, At, Bt) do { __builtin_amdgcn_s_setprio(1); _Pragma("unroll") for (int m = 0; m < 4; ++m) _Pragma("unroll") for (int n = 0; n < 2; ++n) _Pragma("unroll") for (int k = 0; k < 2; ++k) \
        acc[ai][bj][m][n] = __builtin_amdgcn_mfma_f32_16x16x32_bf16(Bt[n][k], At[m][k], acc[ai][bj][m][n], 0, 0, 0); __builtin_amdgcn_s_setprio(0); } while (0)
#define PG8_WAIT_V(n) asm volatile("s_waitcnt vmcnt(" #n ")" ::: "memory")
#define PG8_WAIT_L(n) asm volatile("s_waitcnt lgkmcnt(" #n ")" ::: "memory")
#define PG8_BAR __builtin_amdgcn_s_barrier()
#define PG8_SCHED __builtin_amdgcn_sched_barrier(0)
    Unit cur, nxt; int ui = 0;
    if (!S.next(0, cur)) return;
    f32x4 acc[2][2][4][2];
#pragma unroll
    for (int a = 0; a < 2; ++a)
#pragma unroll
        for (int b = 0; b < 2; ++b)
#pragma unroll
            for (int m = 0; m < 4; ++m)
#pragma unroll
                for (int n = 0; n < 2; ++n) acc[a][b][m][n] = (f32x4){0.f, 0.f, 0.f, 0.f};
    bf16x8 At[4][2], B0[2][2], B1[2][2];
    const char* cA = (const char*)g.A + (size_t)cur.pm * tstep; const char* cB = (const char*)g.Bt + (size_t)cur.pn * tstep;
    S.a_ready(cur);
    if constexpr (SP2) {
        PG8_STAGE(PG8_SB(0, 0), cB, voffB); PG8_STAGE(PG8_SB(0, 1), cB + hstep, voffB); PG8_STAGE(PG8_SA(0, 0), cA, voffA); PG8_STAGE(PG8_SA(0, 1), cA + hstep, voffA);
        if (wr == 1) PG8_BAR;
        PG8_WAIT_V(2); PG8_BAR;
        PG8_STAGE(PG8_SB(1, 0), cB + kstep, voffB); PG8_STAGE(PG8_SA(1, 0), cA + kstep, voffA); PG8_STAGE(PG8_SB(1, 1), cB + hstep + kstep, voffB);
        PG8_WAIT_V(6); PG8_BAR;
    } else {
        PG8_STAGE(PG8_SB(0, 0), cB, voffB); PG8_STAGE(PG8_SA(0, 0), cA, voffA); PG8_STAGE(PG8_SB(0, 1), cB + hstep, voffB); PG8_STAGE(PG8_SA(0, 1), cA + hstep, voffA);
        if (wr == 1) PG8_BAR;
        PG8_WAIT_V(4); PG8_BAR;
        PG8_STAGE(PG8_SB(1, 0), cB + kstep, voffB); PG8_STAGE(PG8_SA(1, 0), cA + kstep, voffA); PG8_STAGE(PG8_SB(1, 1), cB + hstep + kstep, voffB);
        PG8_WAIT_V(6); PG8_BAR;
    }
    for (;;) {
        const bool has_next = S.next(ui + 1, nxt);
        const char* nA = has_next ? (const char*)g.A + (size_t)nxt.pm * tstep : cA; const char* nB = has_next ? (const char*)g.Bt + (size_t)nxt.pn * tstep : cB;
        for (int t = 0; t < nt; t += 2) {
            const bool last = (t == nt - 2);
            const char* a1 = cA + (size_t)(t + 1) * kstep;
            const char* a2 = last ? nA : cA + (size_t)(t + 2) * kstep; const char* b2 = last ? nB : cB + (size_t)(t + 2) * kstep;
            const char* a3 = a2 + kstep; const char* b3 = b2 + kstep;
            if (last && has_next) S.a_ready(nxt);
            if constexpr (SP2) {
            PG8_LDB(B0, 0, 0); PG8_LDB(B1, 0, 1); PG8_SCHED; PG8_LDA(At, 0, 0); PG8_STAGE(PG8_SA(1, 1), a1 + hstep, voffA);
            PG8_WAIT_V(8); PG8_WAIT_L(0); PG8_BAR; PG8_MMA(0, 0, At, B0); PG8_MMA(0, 1, At, B1); PG8_BAR; PG8_SCHED;
            PG8_LDA(At, 0, 1); PG8_STAGE(PG8_SB(0, 0), b2, voffB); PG8_STAGE(PG8_SB(0, 1), b2 + hstep, voffB); PG8_STAGE(PG8_SA(0, 0), a2, voffA);
            PG8_WAIT_V(8); PG8_WAIT_L(0); PG8_BAR; PG8_MMA(1, 0, At, B0); PG8_MMA(1, 1, At, B1); PG8_BAR; PG8_SCHED;
            PG8_LDB(B0, 1, 0); PG8_LDB(B1, 1, 1); PG8_SCHED; PG8_LDA(At, 1, 0); PG8_STAGE(PG8_SA(0, 1), a2 + hstep, voffA);
            PG8_WAIT_V(8); PG8_WAIT_L(0); PG8_BAR; PG8_MMA(0, 0, At, B0); PG8_MMA(0, 1, At, B1); PG8_BAR; PG8_SCHED;
            PG8_LDA(At, 1, 1); PG8_STAGE(PG8_SB(1, 0), b3, voffB); PG8_STAGE(PG8_SB(1, 1), b3 + hstep, voffB); PG8_STAGE(PG8_SA(1, 0), a3, voffA);
            PG8_WAIT_V(8); PG8_WAIT_L(0); PG8_BAR; PG8_MMA(1, 0, At, B0); PG8_MMA(1, 1, At, B1); PG8_BAR; PG8_SCHED;
            } else {
            PG8_LDB(B0, 0, 0); PG8_SCHED; PG8_LDA(At, 0, 0); PG8_STAGE(PG8_SA(1, 1), a1 + hstep, voffA);
            PG8_WAIT_L(8); PG8_BAR; PG8_WAIT_L(0); PG8_MMA(0, 0, At, B0); PG8_BAR; PG8_SCHED;
            PG8_LDB(B1, 0, 1); PG8_STAGE(PG8_SB(0, 0), b2, voffB);
            PG8_BAR; PG8_WAIT_L(0); PG8_MMA(0, 1, At, B1); PG8_BAR;
            PG8_LDA(At, 0, 1); PG8_STAGE(PG8_SA(0, 0), a2, voffA);
            PG8_BAR; PG8_WAIT_L(0); PG8_MMA(1, 0, At, B0); PG8_BAR; PG8_SCHED;
            PG8_STAGE(PG8_SB(0, 1), b2 + hstep, voffB);
            PG8_WAIT_V(6); PG8_BAR; PG8_MMA(1, 1, At, B1); PG8_BAR;
            PG8_LDB(B0, 1, 0); PG8_SCHED; PG8_LDA(At, 1, 0); PG8_STAGE(PG8_SA(0, 1), a2 + hstep, voffA);
            PG8_WAIT_L(8); PG8_BAR; PG8_WAIT_L(0); PG8_MMA(0, 0, At, B0); PG8_BAR; PG8_SCHED;
            PG8_LDB(B1, 1, 1); PG8_STAGE(PG8_SB(1, 0), b3, voffB);
            PG8_BAR; PG8_WAIT_L(0); PG8_MMA(0, 1, At, B1); PG8_BAR;
            PG8_LDA(At, 1, 1); PG8_STAGE(PG8_SA(1, 0), a3, voffA);
            PG8_BAR; PG8_WAIT_L(0); PG8_MMA(1, 0, At, B0); PG8_BAR; PG8_SCHED;
            PG8_STAGE(PG8_SB(1, 1), b3 + hstep, voffB);
            PG8_WAIT_V(6); PG8_BAR; PG8_MMA(1, 1, At, B1); PG8_BAR;
            }
        }
        if constexpr (ALIGN_EPI) { if (wr == 0) PG8_BAR; }
        if constexpr (!Epi::AFTER_DRAIN) { E(acc, cur, wr, wc, fr, fq); S.done(cur); }
        if (!has_next) break;
#pragma unroll
        for (int a = 0; a < 2; ++a)
#pragma unroll
            for (int b = 0; b < 2; ++b)
#pragma unroll
                for (int m = 0; m < 4; ++m)
#pragma unroll
                    for (int n = 0; n < 2; ++n) acc[a][b][m][n] = (f32x4){0.f, 0.f, 0.f, 0.f};
        cur = nxt; cA = nA; cB = nB; ++ui;
        if constexpr (ALIGN_EPI) { if (wr == 1) PG8_BAR; }
    }
    PG8_WAIT_V(0);
    if constexpr (!ALIGN_EPI) { if (wr == 0) PG8_BAR; }
    PG8_BAR;
    if constexpr (Epi::AFTER_DRAIN) { E.fused(acc, cur, wr, wc, fr, fq, lds, wid, lane); S.done(cur); }
#undef PG8_SA
#undef PG8_SB
#undef PG8_STAGE
#undef PG8_LDA
#undef PG8_LDB
#undef PG8_MMA
#undef PG8_WAIT_V
#undef PG8_WAIT_L
#undef PG8_BAR
#undef PG8_SCHED
}
}
constexpr int NWAVES = 8, NTHR = 512;
constexpr int BATCH = 8, SEQ = 4096, DM = 1024, CTXL = 256, DEPTH = 4;
constexpr int MLAT = BATCH * SEQ, MCTX = BATCH * CTXL, MTOT = MLAT + MCTX;
constexpr int NP_EVEN = 3584, NPAD_EVEN = 3840, NORIG_EVEN = 3616;
constexpr int NP_ODD = 2816, NPAD_ODD = 3072, NORIG_ODD = 2832;
constexpr int NCHUNK = 68;
constexpr int NSLOT = BATCH * 4 * 2 * NCHUNK;
constexpr float ALPHA_DN = 1.681792830507429f;
constexpr size_t MiB = 1u << 20;
constexpr size_t WS_MOD = 0;
constexpr size_t WS_BAR = 512 * 1024;
constexpr size_t WS_ROPE = 1 * MiB;
constexpr size_t WS_SC = WS_ROPE + 65536;
constexpr size_t WS_GAM = 2 * MiB;
constexpr size_t WS_SM = 4 * MiB;
constexpr size_t WS_WIE = 9 * MiB;
constexpr size_t WS_WIO = 24 * MiB;
constexpr size_t WS_WO = 36 * MiB;
constexpr size_t WS_XC = 44 * MiB;
constexpr size_t WS_H = 52 * MiB;
constexpr size_t WS_P = 120 * MiB;
constexpr size_t WS_S = 359 * MiB;
constexpr size_t WS_X16 = 427 * MiB;
constexpr size_t WS_END = WS_X16 + (size_t)MTOT * 1024 * 2;
static_assert(WS_S + (size_t)NSLOT * 8192 * 2 <= WS_X16, "ws map 4");
static_assert(WS_SC + (size_t)NSLOT * 16 <= WS_GAM && WS_GAM + (size_t)NSLOT * 256 <= WS_SM && WS_SM + (size_t)MTOT * 128 <= WS_WIE, "ws map 1");
static_assert(WS_WIE + (size_t)2 * NPAD_EVEN * 1024 * 2 <= WS_WIO && WS_WIO + (size_t)2 * NPAD_ODD * 1024 * 2 <= WS_WO && WS_WO + (size_t)4 * 1024 * 1024 * 2 <= WS_XC, "ws map 2");
static_assert(WS_XC + (size_t)MCTX * 1024 * 4 <= WS_H && WS_H + (size_t)MTOT * 1024 * 2 <= WS_P && WS_P + (size_t)MTOT * NP_EVEN * 2 <= WS_S && WS_END <= 512 * MiB, "ws map 3");
constexpr int LDS_BYTES = 147456;

#define LAS __attribute__((address_space(3)))
typedef unsigned short bf16;
typedef float f32x4 __attribute__((ext_vector_type(4)));
typedef short bf16x8 __attribute__((ext_vector_type(8)));
typedef short s16x4 __attribute__((ext_vector_type(4)));
typedef unsigned u32x4 __attribute__((ext_vector_type(4)));
typedef unsigned u32x2 __attribute__((ext_vector_type(2)));
#define LDS_WAIT() asm volatile("s_waitcnt lgkmcnt(0)" ::: "memory")

typedef __bf16 hbf2 __attribute__((ext_vector_type(2)));
typedef float f32x2_ __attribute__((ext_vector_type(2)));
__device__ __forceinline__ unsigned f2bf(float f) { const __bf16 b = (__bf16)f; return (unsigned)__builtin_bit_cast(unsigned short, b); }
__device__ __forceinline__ unsigned pk2(float lo, float hi) { const f32x2_ v = {lo, hi}; const hbf2 b = __builtin_convertvector(v, hbf2); return __builtin_bit_cast(unsigned, b); }
__device__ __forceinline__ float bf2f(unsigned short v) { return __builtin_bit_cast(float, (unsigned)v << 16); }
__device__ __forceinline__ float bflo(unsigned w) { return __builtin_bit_cast(float, w << 16); }
__device__ __forceinline__ float bfhi(unsigned w) { return __builtin_bit_cast(float, w & 0xffff0000u); }
__device__ __forceinline__ float siluf(float x) { return x * __builtin_amdgcn_rcpf(1.f + __expf(-x)); }
__device__ __forceinline__ float logsigf(float z) { return fminf(z, 0.f) - 0.69314718056f * __builtin_amdgcn_logf(1.f + __builtin_amdgcn_exp2f(-1.44269504089f * fabsf(z))); }
__device__ __forceinline__ float rdlane(float v, int l) { return __builtin_bit_cast(float, __builtin_amdgcn_readlane(__builtin_bit_cast(int, v), l)); }
template <int N> __device__ __forceinline__ float dpp_ror(float v) { return __builtin_bit_cast(float, __builtin_amdgcn_update_dpp(0, __builtin_bit_cast(int, v), 0x120 + N, 0xf, 0xf, false)); }
__device__ __forceinline__ float red16_max(float v) { v = fmaxf(v, dpp_ror<1>(v)); v = fmaxf(v, dpp_ror<2>(v)); v = fmaxf(v, dpp_ror<4>(v)); v = fmaxf(v, dpp_ror<8>(v)); return v; }
__device__ __forceinline__ float red16_sum(float v) { v += dpp_ror<1>(v); v += dpp_ror<2>(v); v += dpp_ror<4>(v); v += dpp_ror<8>(v); return v; }
__device__ __forceinline__ float wave_sum(float v) { v = red16_sum(v); return (rdlane(v, 0) + rdlane(v, 16)) + (rdlane(v, 32) + rdlane(v, 48)); }
__device__ __forceinline__ float wave_max(float v) { v = red16_max(v); return fmaxf(fmaxf(rdlane(v, 0), rdlane(v, 16)), fmaxf(rdlane(v, 32), rdlane(v, 48))); }
template <int N, bool REV> __device__ __forceinline__ float dpp_rshift(float v, float ident) {
    return __builtin_bit_cast(float, __builtin_amdgcn_update_dpp(__builtin_bit_cast(int, ident), __builtin_bit_cast(int, v), (REV ? 0x100 : 0x110) + N, 0xf, 0xf, false));
}
template <bool REV> __device__ __forceinline__ float wave_scan_sum_t(float v, int lane) {
    v += dpp_rshift<1, REV>(v, 0.f); v += dpp_rshift<2, REV>(v, 0.f); v += dpp_rshift<4, REV>(v, 0.f); v += dpp_rshift<8, REV>(v, 0.f);
    const int row = lane >> 4;
    if (!REV) { const float t0 = rdlane(v, 15), t1 = rdlane(v, 31), t2 = rdlane(v, 47);
        v += row == 1 ? t0 : row == 2 ? t0 + t1 : row == 3 ? t0 + t1 + t2 : 0.f; }
    else { const float t1 = rdlane(v, 16), t2 = rdlane(v, 32), t3 = rdlane(v, 48);
        v += row == 2 ? t3 : row == 1 ? t3 + t2 : row == 0 ? t3 + t2 + t1 : 0.f; }
    return v;
}
template <bool REV> __device__ __forceinline__ float wave_scan_max_t(float v, int lane) {
    v = fmaxf(v, dpp_rshift<1, REV>(v, -3e38f)); v = fmaxf(v, dpp_rshift<2, REV>(v, -3e38f)); v = fmaxf(v, dpp_rshift<4, REV>(v, -3e38f)); v = fmaxf(v, dpp_rshift<8, REV>(v, -3e38f));
    const int row = lane >> 4;
    if (!REV) { const float t0 = rdlane(v, 15), t1 = rdlane(v, 31), t2 = rdlane(v, 47);
        v = fmaxf(v, row == 1 ? t0 : row == 2 ? fmaxf(t0, t1) : row == 3 ? fmaxf(fmaxf(t0, t1), t2) : -3e38f); }
    else { const float t1 = rdlane(v, 16), t2 = rdlane(v, 32), t3 = rdlane(v, 48);
        v = fmaxf(v, row == 2 ? t3 : row == 1 ? fmaxf(t3, t2) : row == 0 ? fmaxf(fmaxf(t3, t2), t1) : -3e38f); }
    return v;
}
template <int N, bool REV> __device__ __forceinline__ float dpp_rshift0(float v) {
    return __builtin_bit_cast(float, __builtin_amdgcn_update_dpp(0, __builtin_bit_cast(int, v), (REV ? 0x100 : 0x110) + N, 0xf, 0xf, true));
}
template <int N, bool REV, bool MAX> __device__ __forceinline__ float scan_step(float v, int li) {
    const float t = dpp_rshift0<N, REV>(v); const bool ok = REV ? (li + N < 16) : (li >= N);
    return MAX ? (ok ? fmaxf(v, t) : v) : (ok ? v + t : v);
}
template <bool REV, bool MAX> __device__ __forceinline__ float wave_scan_t(float v, int lane) {
    const int li = lane & 15, row = lane >> 4;
    v = scan_step<1, REV, MAX>(v, li); v = scan_step<2, REV, MAX>(v, li); v = scan_step<4, REV, MAX>(v, li); v = scan_step<8, REV, MAX>(v, li);
    const float a0 = rdlane(v, REV ? 48 : 15), a1 = rdlane(v, REV ? 32 : 31), a2 = rdlane(v, REV ? 16 : 47);
    const int k = REV ? 3 - row : row;
    if (MAX) { float e = v; if (k >= 1) e = fmaxf(e, a0); if (k >= 2) e = fmaxf(e, a1); if (k >= 3) e = fmaxf(e, a2); return e; }
    float e = v; if (k >= 1) e += a0; if (k >= 2) e += a1; if (k >= 3) e += a2; return e;
}
__device__ __forceinline__ float wave_scan_sum(float v, int lane, bool rev) { return rev ? wave_scan_t<true, false>(v, lane) : wave_scan_t<false, false>(v, lane); }
__device__ __forceinline__ float wave_scan_max(float v, int lane, bool rev) { return rev ? wave_scan_t<true, true>(v, lane) : wave_scan_t<false, true>(v, lane); }
#define MFMA(a, b, c) __builtin_amdgcn_mfma_f32_16x16x32_bf16((a), (b), (c), 0, 0, 0)
__device__ __forceinline__ bf16x8 frag_rm(const LAS bf16* X, int ld, int row0, int k0, int lane) {
    return *(const LAS bf16x8*)(X + (row0 + (lane & 15)) * ld + k0 + 8 * (lane >> 4));
}
__device__ __forceinline__ bf16x8 frag_tr(const LAS bf16* X, int ld, int k0, int n0, int lane) {
    const int g = lane >> 4, m = lane & 15, q = m >> 2, p = m & 3;
    const LAS bf16* a0 = X + (k0 + 8 * g + q) * ld + n0 + 4 * p;
    const s16x4 lo = __builtin_amdgcn_ds_read_tr16_b64_v4i16((LAS s16x4*)a0);
    const s16x4 hi = __builtin_amdgcn_ds_read_tr16_b64_v4i16((LAS s16x4*)(a0 + 4 * ld));
    bf16x8 r; r[0] = lo[0]; r[1] = lo[1]; r[2] = lo[2]; r[3] = lo[3]; r[4] = hi[0]; r[5] = hi[1]; r[6] = hi[2]; r[7] = hi[3]; return r;
}

struct Params {
    const float *x, *c, *ctx, *c_ctx, *w_ada, *b_ada, *ln_g, *ln_b, *w_in_even, *w_out_even, *gla_gate_w, *gla_gate_b, *gla_norm_g, *na_rpb, *w_in_odd, *w_out_odd, *ml_gate_b, *ml_norm_g, *sw_sink;
    float* out; unsigned char* ws; long long ph_lo, ph_hi;
};
typedef const __attribute__((address_space(4))) Params* KP;
__device__ __forceinline__ KP kparams() { unsigned long long v = (unsigned long long)__builtin_amdgcn_kernarg_segment_ptr(); asm volatile("" : "+s"(v)); return (KP)v; }

__device__ __forceinline__ int orig_col(int type, int n) {
    if (type == 0) { if (n < 1536) return n; if (n < 3584) return n + 32; if (n < 3616) return n - 3584 + 1536; return -1; }
    if (type == 1) { if (n < 1536) return n; if (n < 2816) return n + 16; if (n < 2832) return n - 2816 + 1536; return -1; }
    return n;
}
__device__ __forceinline__ float col_scale(int type, int n) {
    if (type == 0) return (n < 256 || (n >= 1536 && n < 2048)) ? 0.125f : 1.f;
    if (type == 1) return ((n >= 256 && n < 512) || (n >= 1536 && n < 2048)) ? 0.125f : 1.f;
    return 1.f;
}
__device__ __forceinline__ void p0_transpose_item(const float* __restrict__ W, int K, int Norig, int type, bf16* __restrict__ WT, LAS float* scr, int nblk, int item, int lane) {
    const int kb = item / nblk, nb = item % nblk, k0 = 64 * kb, n0 = 32 * nb;
    const int oc = orig_col(type, n0 + (lane & 31)); const float sc = col_scale(type, n0 + (lane & 31));
#pragma unroll 8
    for (int i = 0; i < 32; ++i) { const int kk = 2 * i + (lane >> 5); scr[kk * 33 + (lane & 31)] = oc >= 0 ? W[(size_t)(k0 + kk) * Norig + oc] * sc : 0.f; }
    LDS_WAIT();
    const int c = lane & 7;
#pragma unroll
    for (int j = 0; j < 4; ++j) { const int n = (lane >> 3) + 8 * j; const LAS float* s = scr + (8 * c) * 33 + n;
        u32x4 o; o.x = pk2(s[0 * 33], s[1 * 33]); o.y = pk2(s[2 * 33], s[3 * 33]); o.z = pk2(s[4 * 33], s[5 * 33]); o.w = pk2(s[6 * 33], s[7 * 33]);
        *(u32x4*)(WT + (size_t)(n0 + n) * K + k0 + 8 * c) = o; }
    LDS_WAIT();
}
__device__ __forceinline__ void phase_prologue(KP p, LAS unsigned char* lds) {
    const int tid = otid(), lane = tid & 63, wave = tid >> 6;
    unsigned char* ws = p->ws;
    float* MOD = (float*)(ws + WS_MOD);
    if ((int)blockIdx.x < 192) {
        LAS float* cond = (LAS float*)lds;
        LAS float* red = (LAS float*)(lds + 36864);
        for (int e = tid; e < 9 * 1024; e += NTHR) { const int j = e >> 10, k = e & 1023; const float v = j < 8 ? p->c[j * 1024 + k] : p->c_ctx[k]; cond[e] = siluf(v); }
        __syncthreads();
        for (int it = blockIdx.x; it < 192; it += gridDim.x) {
            const int l = it / 48, n0 = (it % 48) * 64, cq = tid & 15, ks = tid >> 4;
            float acc[9][4];
#pragma unroll
            for (int j = 0; j < 9; ++j) { acc[j][0] = 0.f; acc[j][1] = 0.f; acc[j][2] = 0.f; acc[j][3] = 0.f; }
            const float* wp = p->w_ada + (size_t)l * 1024 * 3072 + (size_t)(ks * 32) * 3072 + n0 + 4 * cq;
#pragma unroll 4
            for (int kk = 0; kk < 32; ++kk) { const f32x4 w = *(const f32x4*)(wp + (size_t)kk * 3072);
#pragma unroll
                for (int j = 0; j < 9; ++j) { const float cv = cond[j * 1024 + ks * 32 + kk]; acc[j][0] += cv * w[0]; acc[j][1] += cv * w[1]; acc[j][2] += cv * w[2]; acc[j][3] += cv * w[3]; } }
#pragma unroll
            for (int j = 0; j < 9; ++j)
#pragma unroll
                for (int i = 0; i < 4; ++i) red[ks * 576 + j * 64 + 4 * cq + i] = acc[j][i];
            __syncthreads();
            for (int o = tid; o < 576; o += NTHR) { float s = 0.f; for (int q = 0; q < 32; ++q) s += red[q * 576 + o]; const int j = o >> 6, n = n0 + (o & 63);
                MOD[(size_t)(l * 9 + j) * 3072 + n] = s + p->b_ada[l * 3072 + n]; }
            __syncthreads();
        }
    }
    if (blockIdx.x == gridDim.x - 1) {
        float* cosT = (float*)(ws + WS_ROPE); float* sinT = cosT + 1024;
        for (int e = tid; e < 1024; e += NTHR) { const int pos = e >> 4, i = e & 15;
            double f = 1.0; for (int q = 0; q < i; ++q) f *= 0.5623413251903491;
            const double f2 = f * f; double sn = 1.0, cs = 1.0;
            for (int q = 12; q >= 1; --q) { sn = 1.0 - f2 / ((2.0 * q) * (2.0 * q + 1.0)) * sn; cs = 1.0 - f2 / ((2.0 * q - 1.0) * (2.0 * q)) * cs; }
            sn *= f;
            double c = 1.0, s = 0.0; for (int q = 0; q < pos; ++q) { const double c2 = c * cs - s * sn, s2 = s * cs + c * sn; c = c2; s = s2; }
            cosT[e] = (float)c; sinT[e] = (float)s; }
    }
    __syncthreads();
    {
        LAS float* scr = (LAS float*)(lds + wave * 16384);
        const int gw = blockIdx.x * NWAVES + wave, NGW = gridDim.x * NWAVES;
        constexpr int I_E = 16 * (NPAD_EVEN / 32), I_O = 16 * (NPAD_ODD / 32), I_W = 16 * 32;
        constexpr int NIT = 2 * I_E + 2 * I_O + 4 * I_W;
        for (int it = gw; it < NIT; it += NGW) {
            int r = it;
            if (r < 2 * I_E) { const int i = r / I_E; r -= i * I_E; p0_transpose_item(p->w_in_even + (size_t)i * 1024 * NORIG_EVEN, 1024, NORIG_EVEN, 0, (bf16*)(ws + WS_WIE) + (size_t)i * NPAD_EVEN * 1024, scr, NPAD_EVEN / 32, r, lane); continue; }
            r -= 2 * I_E;
            if (r < 2 * I_O) { const int i = r / I_O; r -= i * I_O; p0_transpose_item(p->w_in_odd + (size_t)i * 1024 * NORIG_ODD, 1024, NORIG_ODD, 1, (bf16*)(ws + WS_WIO) + (size_t)i * NPAD_ODD * 1024, scr, NPAD_ODD / 32, r, lane); continue; }
            r -= 2 * I_O;
            { const int l = r / I_W; r -= l * I_W; const float* W = (l & 1) ? p->w_out_odd + (size_t)(l >> 1) * 1024 * 1024 : p->w_out_even + (size_t)(l >> 1) * 1024 * 1024;
              p0_transpose_item(W, 1024, 1024, 2, (bf16*)(ws + WS_WO) + (size_t)l * 1024 * 1024, scr, 32, r, lane); }
        }
    }
}
__device__ __forceinline__ void phase_h0(KP p) {
    const int lane = otid() & 63, gw = blockIdx.x * NWAVES + (otid() >> 6), NGW = gridDim.x * NWAVES;
    const float* MOD = (const float*)(p->ws + WS_MOD); bf16* H = (bf16*)(p->ws + WS_H);
    for (int m = gw; m < MTOT; m += NGW) {
        const int jb = m < MLAT ? (m >> 12) : 8;
        const float* src = m < MLAT ? p->x + (size_t)m * DM : p->ctx + (size_t)(m - MLAT) * DM;
        const float* md = MOD + (size_t)jb * 3072;
#pragma unroll
        for (int j = 0; j < 4; ++j) { const int k = 4 * lane + 256 * j; const f32x4 v = *(const f32x4*)(src + k), sh = *(const f32x4*)(md + k), sc = *(const f32x4*)(md + 1024 + k);
            const f32x4 h = v * (sc + 1.0f) + sh; u32x2 o; o.x = pk2(h[0], h[1]); o.y = pk2(h[2], h[3]); *(u32x2*)(H + (size_t)m * DM + k) = o; }
    }
}
typedef _Float16 f16x4 __attribute__((ext_vector_type(4)));
struct LnRaw { f32x4 xf[2][4]; f16x4 xh[2][4]; u32x2 y[2][4]; };
__device__ __forceinline__ void ln_load(LnRaw& R, int l, int m0, int lane, const float* xin, const float* cin, const _Float16* X16, const bf16* Y) {
#pragma unroll
    for (int j = 0; j < 4; ++j) { const int k = 4 * lane + 256 * j;
#pragma unroll
        for (int q = 0; q < 2; ++q) { const int m = m0 + q;
            if (l == 0) R.xf[q][j] = *(const f32x4*)((m < MLAT ? xin + (size_t)m * DM : cin + (size_t)(m - MLAT) * DM) + k);
            else R.xh[q][j] = *(const f16x4*)(X16 + (size_t)m * DM + k);
            R.y[q][j] = *(const u32x2*)(Y + (size_t)m * DM + k); } }
}
__device__ __forceinline__ void phase_ln(KP p, int l, bool dummy = false) {
    const int lane = otid() & 63, gw = blockIdx.x * NWAVES + (otid() >> 6), NGW = gridDim.x * NWAVES;
    const float* MOD = (const float*)(p->ws + WS_MOD); bf16* H = (bf16*)(p->ws + WS_H); const bf16* Y = (const bf16*)(p->ws + WS_P); _Float16* X16 = (_Float16*)(p->ws + WS_X16);
    const int mrows = l < DEPTH - 1 ? MTOT : MLAT;
    const float* lg = p->ln_g + l * DM; const float* lb = p->ln_b + l * DM;
    const float* xin = p->x; const float* cin = p->ctx; float* outp = p->out;
    LnRaw R;
    if (2 * gw < mrows) ln_load(R, l, 2 * gw, lane, xin, cin, X16, Y);
    for (int m0 = 2 * gw; m0 < mrows; m0 += 2 * NGW) {
        const int jb = m0 < MLAT ? (m0 >> 12) : 8;
        const float* md = MOD + (size_t)(l * 9 + jb) * 3072;
        f32x4 v[2][4], xs[2][4]; float s[2] = {0.f, 0.f};
#pragma unroll
        for (int j = 0; j < 4; ++j) { const int k = 4 * lane + 256 * j; const f32x4 g = *(const f32x4*)(md + 2048 + k);
#pragma unroll
            for (int q = 0; q < 2; ++q) { const f32x4 xv = l == 0 ? R.xf[q][j] : __builtin_convertvector(R.xh[q][j], f32x4); const u32x2 yw = R.y[q][j];
                f32x4 y; y[0] = bflo(yw.x); y[1] = bfhi(yw.x); y[2] = bflo(yw.y); y[3] = bfhi(yw.y);
                xs[q][j] = xv; v[q][j] = xv * ALPHA_DN + g * y; s[q] += (v[q][j][0] + v[q][j][1]) + (v[q][j][2] + v[q][j][3]); } }
        if (m0 + 2 * NGW < mrows) ln_load(R, l, m0 + 2 * NGW, lane, xin, cin, X16, Y);
        float rstd[2];
#pragma unroll
        for (int q = 0; q < 2; ++q) { const float mean = wave_sum(s[q]) * (1.f / DM); float s2 = 0.f;
#pragma unroll
            for (int j = 0; j < 4; ++j) { v[q][j] = v[q][j] - mean; s2 += (v[q][j][0] * v[q][j][0] + v[q][j][1] * v[q][j][1]) + (v[q][j][2] * v[q][j][2] + v[q][j][3] * v[q][j][3]); }
            rstd[q] = 1.f / sqrtf(wave_sum(s2) * (1.f / DM) + 1e-5f); }
        const float* md2 = MOD + (size_t)((l + 1) * 9 + jb) * 3072;
#pragma unroll
        for (int j = 0; j < 4; ++j) { const int k = 4 * lane + 256 * j; const f32x4 gg = *(const f32x4*)(lg + k), bb = *(const f32x4*)(lb + k);
            f32x4 sh = (f32x4){0.f, 0.f, 0.f, 0.f}, sc = sh; if (l < DEPTH - 1) { sh = *(const f32x4*)(md2 + k); sc = *(const f32x4*)(md2 + 1024 + k); }
#pragma unroll
            for (int q = 0; q < 2; ++q) { const int m = m0 + q; const f32x4 o = v[q][j] * rstd[q] * gg + bb;
                if (l < DEPTH - 1) { *(f16x4*)(X16 + (size_t)m * DM + k) = __builtin_convertvector(dummy ? xs[q][j] : o, f16x4);
                    const f32x4 h = o * (sc + 1.0f) + sh; u32x2 w; w.x = pk2(h[0], h[1]); w.y = pk2(h[2], h[3]); *(u32x2*)(H + (size_t)m * DM + k) = w; }
                else { if (!dummy) *(f32x4*)(outp + (size_t)m * DM + k) = o; } } }
    }
}
constexpr int AT_KS = 0, AT_VS = 9216, AT_BUF = 18432, AT_PS = 36864, AT_RPB = AT_PS + 8 * 2304;
__device__ __forceinline__ bf16x8 frag_tr_perm(const LAS bf16* X, int ld, int k0, int n0, int lane) {
    const int g = lane >> 4, m = lane & 15, q = m >> 2, p = m & 3;
    const LAS bf16* a0 = X + (k0 + 4 * g + q) * ld + n0 + 4 * p;
    const s16x4 lo = __builtin_amdgcn_ds_read_tr16_b64_v4i16((LAS s16x4*)a0);
    const s16x4 hi = __builtin_amdgcn_ds_read_tr16_b64_v4i16((LAS s16x4*)(a0 + 16 * ld));
    bf16x8 r; r[0] = lo[0]; r[1] = lo[1]; r[2] = lo[2]; r[3] = lo[3]; r[4] = hi[0]; r[5] = hi[1]; r[6] = hi[2]; r[7] = hi[3]; return r;
}
__device__ __forceinline__ void attn_tile(const LAS bf16* Ks, const LAS bf16* Vs, const LAS float* rpb, const bf16x8 (&qa)[2][2], float (&mrow)[2], float (&lsum)[2], f32x4 (&oacc)[2][4],
                                          int mode, int i, int nlat, int qa_, int qb_, int ka_, int lane) {
    const int fq = lane >> 4, fr = lane & 15;
    const bool islat = i < nlat;
    bool active = true; int kt0 = 0;
    if (islat) {
        if (mode == 0) { kt0 = ka_ + i; const int rs = min(max(qa_ - 4, 0), 56); active = (kt0 >= rs) && (kt0 < rs + 8); }
        else { kt0 = ka_ + 64 * i; active = !(kt0 > qa_ + 31 + 128 || kt0 + 63 < qa_ - 128); }
    }
    if (!active) return;
    const bool nar = islat && mode == 0;
    const int ct0 = qb_ >> 4;
    int ntlo[2], nthi[2];
#pragma unroll
    for (int nq = 0; nq < 2; ++nq) { const int ct = ct0 + nq; ntlo[nq] = nar ? (ct < 2 ? 0 : ct - 1) : 0; nthi[nq] = nar ? (ct > 1 ? 3 : ct + 1) : 3; }
    const int ulo = min(ntlo[0], ntlo[1]), uhi = max(nthi[0], nthi[1]);
    f32x4 s[2][4];
#pragma unroll
    for (int mt = 0; mt < 4; ++mt) { s[0][mt] = (f32x4){0.f, 0.f, 0.f, 0.f}; s[1][mt] = (f32x4){0.f, 0.f, 0.f, 0.f};
        if (mt >= ulo && mt <= uhi) {
#pragma unroll
            for (int ks = 0; ks < 2; ++ks) { const bf16x8 kf = frag_rm(Ks, 72, 16 * mt, 32 * ks, lane);
                if (mt >= ntlo[0] && mt <= nthi[0]) s[0][mt] = MFMA(kf, qa[0][ks], s[0][mt]);
                if (mt >= ntlo[1] && mt <= nthi[1]) s[1][mt] = MFMA(kf, qa[1][ks], s[1][mt]); } } }
    unsigned pw[2][8];
    const bool swa_mask = islat && mode == 1 && !((qa_ + 31 - kt0 <= 128) && (qa_ - kt0 - 63 >= -128));
    constexpr float L2E = 1.44269504089f;
#pragma unroll
    for (int nq = 0; nq < 2; ++nq) {
        float tmax = -3e38f;
        if (nar) {
            const int qc = qb_ + 16 * nq + fr, cs = min(max(qc - 8, 0), 48);
            const unsigned long long ml = (0xFFFFull << cs) >> (4 * fq);
            const unsigned mlo = (unsigned)ml, mhi = (unsigned)(ml >> 32);
            const LAS float* bp = rpb + (kt0 - qa_ + 7) * 31 + (4 * fq - qc + 15);
#pragma unroll
            for (int mt = 0; mt < 4; ++mt) { if (mt >= ntlo[nq] && mt <= nthi[nq]) {
#pragma unroll
                for (int r = 0; r < 4; ++r) { const int pbit = 16 * mt + r; const bool ok = ((pbit < 32 ? mlo >> pbit : mhi >> (pbit - 32)) & 1u) != 0u;
                    const float v = ok ? s[nq][mt][r] + bp[ok ? pbit : 0] : -3e38f; s[nq][mt][r] = v; tmax = fmaxf(tmax, v); } } }
        } else if (swa_mask) {
            const int d0 = (qa_ + 16 * nq + fr) - (kt0 + 4 * fq);
#pragma unroll
            for (int mt = 0; mt < 4; ++mt)
#pragma unroll
                for (int r = 0; r < 4; ++r) { const int d = d0 - (16 * mt + r); const float v = (d <= 128 && d >= -128) ? s[nq][mt][r] : -3e38f; s[nq][mt][r] = v; tmax = fmaxf(tmax, v); }
        } else {
#pragma unroll
            for (int mt = 0; mt < 4; ++mt)
#pragma unroll
                for (int r = 0; r < 4; ++r) tmax = fmaxf(tmax, s[nq][mt][r]);
        }
        tmax = fmaxf(tmax, __shfl_xor(tmax, 16)); tmax = fmaxf(tmax, __shfl_xor(tmax, 32));
        const float mnew = fmaxf(mrow[nq], tmax); const float alpha = __builtin_amdgcn_exp2f((mrow[nq] - mnew) * L2E); mrow[nq] = mnew;
        const float nm = -mnew * L2E;
        float ps = 0.f;
#pragma unroll
        for (int mt = 0; mt < 4; ++mt) { float p0 = 0.f, p1 = 0.f, p2 = 0.f, p3 = 0.f;
            if (mt >= ntlo[nq] && mt <= nthi[nq]) { p0 = __builtin_amdgcn_exp2f(__builtin_fmaf(s[nq][mt][0], L2E, nm)); p1 = __builtin_amdgcn_exp2f(__builtin_fmaf(s[nq][mt][1], L2E, nm));
                p2 = __builtin_amdgcn_exp2f(__builtin_fmaf(s[nq][mt][2], L2E, nm)); p3 = __builtin_amdgcn_exp2f(__builtin_fmaf(s[nq][mt][3], L2E, nm)); ps += (p0 + p1) + (p2 + p3); }
            pw[nq][2 * mt] = pk2(p0, p1); pw[nq][2 * mt + 1] = pk2(p2, p3); oacc[nq][mt] = oacc[nq][mt] * alpha; }
        lsum[nq] = lsum[nq] * alpha + ps;
    }
#pragma unroll
    for (int ks = 0; ks < 2; ++ks) { if (ks == 0 ? (ulo < 2) : (uhi > 1)) {
        const u32x4 pu0 = (u32x4){pw[0][4 * ks], pw[0][4 * ks + 1], pw[0][4 * ks + 2], pw[0][4 * ks + 3]}, pu1 = (u32x4){pw[1][4 * ks], pw[1][4 * ks + 1], pw[1][4 * ks + 2], pw[1][4 * ks + 3]};
        const bf16x8 pb0 = __builtin_bit_cast(bf16x8, pu0), pb1 = __builtin_bit_cast(bf16x8, pu1);
#pragma unroll
        for (int mt = 0; mt < 4; ++mt) { const bf16x8 vf = frag_tr_perm(Vs, 72, 32 * ks, 16 * mt, lane); oacc[0][mt] = MFMA(vf, pb0, oacc[0][mt]); oacc[1][mt] = MFMA(vf, pb1, oacc[1][mt]); } } }
}
constexpr int AT_PSW = 32 * 72 * 2;
constexpr int AT_RPB2 = AT_PS + 8 * AT_PSW;
__device__ __forceinline__ void attn_item(LAS unsigned char* lds, const bf16* __restrict__ P, int ldp, bf16* __restrict__ Z, int mode,
                                          int qrow0, int qcol, int kcol, int vcol, int gcol, int zcol,
                                          int nlat, int lat_row0, int ctx_row0, int qa_, int qb_, int ka_, const float* __restrict__ rpb_g, float sink) {
    const int tid = otid(), lane = tid & 63, wave = tid >> 6, fq = lane >> 4, fr = lane & 15;
    LAS bf16* Ks0 = (LAS bf16*)(lds + AT_KS); LAS bf16* Vs0 = (LAS bf16*)(lds + AT_VS); LAS bf16* Ks1 = (LAS bf16*)(lds + AT_KS + AT_BUF); LAS bf16* Vs1 = (LAS bf16*)(lds + AT_VS + AT_BUF);
    LAS bf16* Ps = (LAS bf16*)(lds + AT_PS + wave * AT_PSW); LAS float* rpb = (LAS float*)(lds + AT_RPB2);
    const int ntile = nlat + 4, srow = tid >> 3, sch = tid & 7, soff = srow * 72 + 8 * sch;
#define AT_ROWB(j) (((j) < nlat) ? lat_row0 + 64 * (j) : ctx_row0 + 64 * ((j) - nlat))
#define AT_LOAD(kr, vr, j) do { const size_t ro_ = (size_t)(AT_ROWB(j) + srow) * ldp + 8 * sch; kr = *(const u32x4*)(P + ro_ + kcol); vr = *(const u32x4*)(P + ro_ + vcol); } while (0)
    u32x4 k0, v0, k1, v1;
    AT_LOAD(k0, v0, 0);
    bf16x8 qa[2][2];
#pragma unroll
    for (int nq = 0; nq < 2; ++nq)
#pragma unroll
        for (int ks = 0; ks < 2; ++ks) qa[nq][ks] = *(const bf16x8*)(P + (size_t)(qrow0 + 16 * nq + fr) * ldp + qcol + 32 * ks + 8 * fq);
    __syncthreads();
    if (mode == 0) { for (int e = tid; e < 465; e += NTHR) rpb[e] = rpb_g[e]; }
    *(LAS u32x4*)(Ks0 + soff) = k0; *(LAS u32x4*)(Vs0 + soff) = v0;
    AT_LOAD(k0, v0, 1);
    AT_LOAD(k1, v1, 2);
    float mrow[2] = {-1e30f, -1e30f}, lsum[2] = {0.f, 0.f}; f32x4 oacc[2][4];
#pragma unroll
    for (int nq = 0; nq < 2; ++nq)
#pragma unroll
        for (int r = 0; r < 4; ++r) oacc[nq][r] = (f32x4){0.f, 0.f, 0.f, 0.f};
    __syncthreads();
    for (int i = 0; i < ntile; i += 2) {
        attn_tile(Ks0, Vs0, rpb, qa, mrow, lsum, oacc, mode, i, nlat, qa_, qb_, ka_, lane);
        if (i + 1 < ntile) { *(LAS u32x4*)(Ks1 + soff) = k0; *(LAS u32x4*)(Vs1 + soff) = v0; }
        if (i + 3 < ntile) AT_LOAD(k0, v0, i + 3);
        __syncthreads();
        if (i + 1 >= ntile) break;
        attn_tile(Ks1, Vs1, rpb, qa, mrow, lsum, oacc, mode, i + 1, nlat, qa_, qb_, ka_, lane);
        if (i + 2 < ntile) { *(LAS u32x4*)(Ks0 + soff) = k1; *(LAS u32x4*)(Vs0 + soff) = v1; }
        if (i + 4 < ntile) AT_LOAD(k1, v1, i + 4);
        __syncthreads();
    }
#undef AT_LOAD
#undef AT_ROWB
    u32x4 gvv[4];
#pragma unroll
    for (int c2 = 0; c2 < 4; ++c2) { const int idx = lane + 64 * c2, q = idx >> 3, ch = idx & 7; gvv[c2] = *(const u32x4*)(P + (size_t)(qrow0 + q) * ldp + gcol + 8 * ch); }
#pragma unroll
    for (int nq = 0; nq < 2; ++nq) { float lt = lsum[nq]; lt += __shfl_xor(lt, 16); lt += __shfl_xor(lt, 32); float sc;
      if (mode == 1 || mode == 3) { const float mf = fmaxf(mrow[nq], sink); const float al = __expf(mrow[nq] - mf); lt = lt * al + __expf(sink - mf); sc = al / lt; } else sc = 1.f / lt;
#pragma unroll
      for (int mt = 0; mt < 4; ++mt) { u32x2 w; w.x = pk2(oacc[nq][mt][0] * sc, oacc[nq][mt][1] * sc); w.y = pk2(oacc[nq][mt][2] * sc, oacc[nq][mt][3] * sc); *(LAS u32x2*)(Ps + (16 * nq + fr) * 72 + 16 * mt + 4 * fq) = w; } }
    LDS_WAIT();
#pragma unroll
    for (int c2 = 0; c2 < 4; ++c2) { const int idx = lane + 64 * c2, q = idx >> 3, ch = idx & 7;
        const u32x4 ov = *(const LAS u32x4*)(Ps + q * 72 + 8 * ch); const u32x4 gv = gvv[c2];
        u32x4 w;
        w.x = pk2(bflo(ov.x) * siluf(bflo(gv.x)), bfhi(ov.x) * siluf(bfhi(gv.x))); w.y = pk2(bflo(ov.y) * siluf(bflo(gv.y)), bfhi(ov.y) * siluf(bfhi(gv.y)));
        w.z = pk2(bflo(ov.z) * siluf(bflo(gv.z)), bfhi(ov.z) * siluf(bfhi(gv.z))); w.w = pk2(bflo(ov.w) * siluf(bflo(gv.w)), bfhi(ov.w) * siluf(bfhi(gv.w)));
        *(u32x4*)(Z + (size_t)(qrow0 + q) * DM + zcol + 8 * ch) = w; }
    LDS_WAIT();
}
__device__ __forceinline__ void phase_attn(KP p, LAS unsigned char* lds, int l, bool need_ctx) {
    const int wave = otid() >> 6; const bool odd = l & 1; const int li = l >> 1;
    const bf16* P = (const bf16*)(p->ws + WS_P); bf16* Z = (bf16*)(p->ws + WS_H); const int ldp = odd ? NP_ODD : NP_EVEN;
    const int nmain = BATCH * 8 * 16, nctx = need_ctx ? BATCH * 8 : 0;
    for (int it = blockIdx.x; it < nmain + nctx; it += gridDim.x) {
        if (it < nmain) {
            int itv = it;
            if (gridDim.x == 256) { const int rnd = it >> 8, bx = it & 255, xcd = bx & 7, slot = bx >> 3; itv = ((rnd * 16 + 2 * xcd + (slot >> 4)) << 4) + (slot & 15); }
            const int b = itv >> 7, h = (itv >> 4) & 7, qb = itv & 15;
            if (!odd) { const int r0 = 4 * qb, rw = r0 + (wave >> 1); const int rs0 = min(max(r0 - 4, 0), 56), rs3 = min(max(r0 + 3 - 4, 0), 56);
                attn_item(lds, P, ldp, Z, 0, b * SEQ + rw * 64 + 32 * (wave & 1), 1536 + h * 64, 2048 + h * 64, 2560 + h * 64, 3072 + h * 64, 512 + h * 64,
                          rs3 + 8 - rs0, b * SEQ + rs0 * 64, MLAT + b * CTXL, rw, 32 * (wave & 1), rs0, p->na_rpb + (size_t)(li * 8 + h) * 465, 0.f); }
            else { const int kv = h >> 2, t0 = 256 * qb, lt0 = max(0, 4 * qb - 2), lt1 = min(63, 4 * qb + 5);
                attn_item(lds, P, ldp, Z, 1, b * SEQ + t0 + 32 * wave, 1536 + h * 64, 2048 + kv * 64, 2176 + kv * 64, 2304 + h * 64, 512 + h * 64,
                          lt1 - lt0 + 1, b * SEQ + lt0 * 64, MLAT + b * CTXL, t0 + 32 * wave, 0, lt0 * 64, nullptr, p->sw_sink[li * 8 + h]); }
        } else {
            const int j = it - nmain, b = j >> 3, h = j & 7; const int q0 = MLAT + b * CTXL + 32 * wave;
            if (!odd) attn_item(lds, P, ldp, Z, 2, q0, 1536 + h * 64, 2048 + h * 64, 2560 + h * 64, 3072 + h * 64, 512 + h * 64, 0, 0, MLAT + b * CTXL, 0, 0, 0, nullptr, 0.f);
            else { const int kv = h >> 2; attn_item(lds, P, ldp, Z, 3, q0, 1536 + h * 64, 2048 + kv * 64, 2176 + kv * 64, 2304 + h * 64, 512 + h * 64, 0, 0, MLAT + b * CTXL, 0, 0, 0, nullptr, p->sw_sink[li * 8 + h]); }
        }
    }
}
__device__ __forceinline__ int chunk_row0(int b, int cp) { return cp < 4 ? MLAT + b * CTXL + cp * 64 : b * SEQ + (cp - 4) * 64; }
constexpr int SL_KDF = 0, SL_KDB = 9216, SL_VS = 18432, SL_SEG = 35840, SL_MISC = 39936;
__device__ __forceinline__ void phase_scan_local(KP p, LAS unsigned char* lds, int l) {
    const int tid = otid(), lane = tid & 63, wave = tid >> 6, fq = lane >> 4, fr = lane & 15; const bool odd = l & 1; const int li = l >> 1;
    const bf16* P = (const bf16*)(p->ws + WS_P); const int ldp = odd ? NP_ODD : NP_EVEN; const float* SM = (const float*)(p->ws + WS_SM);
    bf16* S = (bf16*)(p->ws + WS_S); float* GAM = (float*)(p->ws + WS_GAM); float* SC = (float*)(p->ws + WS_SC);
    LAS bf16* kdf = (LAS bf16*)(lds + SL_KDF); LAS bf16* kdb = (LAS bf16*)(lds + SL_KDB); LAS bf16* vs = (LAS bf16*)(lds + SL_VS);
    LAS float* seg = (LAS float*)(lds + SL_SEG); LAS float* misc = (LAS float*)(lds + SL_MISC);
    const int dk = tid & 63, sg = tid >> 6;
    for (int it = blockIdx.x; it < BATCH * 4 * NCHUNK; it += gridDim.x) {
        const int b = it / (4 * NCHUNK), h = (it / NCHUNK) & 3, cp = it % NCHUNK; const int row0 = chunk_row0(b, cp);
        const int slf = ((b * 4 + h) * 2 + 0) * NCHUNK + cp, slb = slf + NCHUNK;
        __syncthreads();
#pragma unroll
        for (int c2 = 0; c2 < 2; ++c2) { const int idx = tid + NTHR * c2, t = idx >> 4, ch = idx & 15; *(LAS u32x4*)(vs + t * 136 + 8 * ch) = *(const u32x4*)(P + (size_t)(row0 + t) * ldp + 512 + h * 128 + 8 * ch); }
        float kv[8];
#pragma unroll
        for (int tt = 0; tt < 8; ++tt) kv[tt] = bf2f(P[(size_t)(row0 + sg * 8 + tt) * ldp + 256 + h * 64 + dk]);
        if (!odd) {
            float gwf[16], gwb[16];
            const float* gw = p->gla_gate_w + (size_t)li * 2 * 16 * 256; const float* gb = p->gla_gate_b + (size_t)li * 2 * 256;
#pragma unroll
            for (int r = 0; r < 16; ++r) { gwf[r] = gw[r * 256 + h * 64 + dk]; gwb[r] = gw[(16 + r) * 256 + h * 64 + dk]; }
            const float gbf = gb[h * 64 + dk], gbb = gb[256 + h * 64 + dk];
            { const int t = tid >> 3, c4 = (tid & 7) * 4; *(LAS f32x4*)(misc + t * 32 + c4) = *(const f32x4*)(SM + (size_t)(row0 + t) * 32 + c4); }
            __syncthreads();
            float pf[8], sb[8];
            f32x4 L[2][8];
#pragma unroll
            for (int i = 0; i < 8; ++i) L[0][i] = *(const LAS f32x4*)(misc + (sg * 8) * 32 + 4 * i);
#pragma unroll
            for (int tt = 0; tt < 8; ++tt) {
                if (tt < 7) {
#pragma unroll
                    for (int i = 0; i < 8; ++i) L[(tt + 1) & 1][i] = *(const LAS f32x4*)(misc + (sg * 8 + tt + 1) * 32 + 4 * i); }
                float zf = gbf, zb = gbb, zf2 = 0.f, zb2 = 0.f;
#pragma unroll
                for (int i = 0; i < 4; i += 2)
#pragma unroll
                    for (int e = 0; e < 4; ++e) { zf += L[tt & 1][i][e] * gwf[4 * i + e]; zf2 += L[tt & 1][i + 1][e] * gwf[4 * i + 4 + e]; zb += L[tt & 1][4 + i][e] * gwb[4 * i + e]; zb2 += L[tt & 1][5 + i][e] * gwb[4 * i + 4 + e]; }
                pf[tt] = logsigf(zf + zf2) * 0.0625f; sb[tt] = logsigf(zb + zb2) * 0.0625f; }
#pragma unroll
            for (int tt = 1; tt < 8; ++tt) pf[tt] += pf[tt - 1];
#pragma unroll
            for (int tt = 6; tt >= 0; --tt) sb[tt] += sb[tt + 1];
            seg[(0 * 8 + sg) * 64 + dk] = pf[7]; seg[(1 * 8 + sg) * 64 + dk] = sb[0];
            __syncthreads();
            float offf = 0.f, totf = 0.f, offb = 0.f, totb = 0.f;
#pragma unroll
            for (int q = 0; q < 8; ++q) { const float a = seg[q * 64 + dk], c = seg[(8 + q) * 64 + dk]; totf += a; totb += c; if (q < sg) offf += a; if (q > sg) offb += c; }
#pragma unroll
            for (int tt = 0; tt < 8; ++tt) { const int t = sg * 8 + tt;
                kdf[t * 72 + dk] = (bf16)f2bf(kv[tt] * __expf(totf - (offf + pf[tt]))); kdb[t * 72 + dk] = (bf16)f2bf(kv[tt] * __expf(totb - (offb + sb[tt]))); }
            if (sg == 0) { GAM[(size_t)slf * 64 + dk] = __expf(totf); GAM[(size_t)slb * 64 + dk] = __expf(totb); }
        } else {
            const float* mb = p->ml_gate_b + li * 16;
            if (tid < 128) { const int d = tid >> 6, t = tid & 63; const float* gp = SM + (size_t)(row0 + t) * 32 + d * 8;
                misc[d * 128 + t] = gp[h] + mb[d * 8 + h]; misc[d * 128 + 64 + t] = logsigf(gp[4 + h] + mb[d * 8 + 4 + h]); }
            __syncthreads();
            if (tid < 128) { const int d = tid >> 6, t = tid & 63; const float run = wave_scan_sum(misc[d * 128 + 64 + t], t, d == 1);
                const float tot = d == 0 ? __shfl(run, 63) : __shfl(run, 0);
                const float wl = tot - run + misc[d * 128 + t]; const float ml = wave_max(wl);
                misc[256 + d * 64 + t] = __expf(wl - ml);
                if (t == 0) { const int sl = d == 0 ? slf : slb; SC[(size_t)sl * 4 + 0] = tot; SC[(size_t)sl * 4 + 1] = ml; } }
            __syncthreads();
            float nf = 0.f, nb = 0.f;
#pragma unroll
            for (int tt = 0; tt < 8; ++tt) { const int t = sg * 8 + tt; const float a = kv[tt] * misc[256 + t], c = kv[tt] * misc[256 + 64 + t]; nf += a; nb += c;
                kdf[t * 72 + dk] = (bf16)f2bf(a); kdb[t * 72 + dk] = (bf16)f2bf(c); }
            seg[(0 * 8 + sg) * 64 + dk] = nf; seg[(1 * 8 + sg) * 64 + dk] = nb;
            __syncthreads();
            if (sg < 2) { float s2 = 0.f;
#pragma unroll
                for (int q = 0; q < 8; ++q) s2 += seg[(sg * 8 + q) * 64 + dk];
                GAM[(size_t)(sg == 0 ? slf : slb) * 64 + dk] = s2; }
        }
        __syncthreads();
#pragma unroll
        for (int d = 0; d < 2; ++d) { const LAS bf16* kd = d ? kdb : kdf; f32x4 acc[4];
#pragma unroll
            for (int nt = 0; nt < 4; ++nt) acc[nt] = (f32x4){0.f, 0.f, 0.f, 0.f};
#pragma unroll
            for (int ks = 0; ks < 2; ++ks) { const bf16x8 av = frag_tr(vs, 136, 32 * ks, 16 * wave, lane);
#pragma unroll
                for (int nt = 0; nt < 4; ++nt) acc[nt] = MFMA(av, frag_tr(kd, 72, 32 * ks, 16 * nt, lane), acc[nt]); }
            bf16* dst = S + (size_t)(d ? slb : slf) * 8192;
#pragma unroll
            for (int nt = 0; nt < 4; ++nt) { u32x2 w; w.x = pk2(acc[nt][0], acc[nt][1]); w.y = pk2(acc[nt][2], acc[nt][3]); *(u32x2*)(dst + (16 * nt + fr) * 128 + 16 * wave + 4 * fq) = w; } }
    }
}
__device__ __forceinline__ void phase_scan_seq(KP p, int l, bool dummy = false) {
    const bool odd = l & 1;
    u32x2* S2 = (u32x2*)(p->ws + WS_S); float* GAM = (float*)(p->ws + WS_GAM); f32x4* GAM4 = (f32x4*)(p->ws + WS_GAM); float* SC = (float*)(p->ws + WS_SC);
    const int nthreads = gridDim.x * NTHR;
    for (int gid = blockIdx.x * NTHR + otid(); gid < 64 * 2048; gid += nthreads) {
        const int chain = gid >> 11, e4 = gid & 2047, dir = chain & 1, dkk = e4 >> 5; const int base = chain * NCHUNK;
        f32x4 st = (f32x4){0.f, 0.f, 0.f, 0.f}, nst = (f32x4){0.f, 0.f, 0.f, 0.f}; float m = 0.f; const bool hasn = odd && e4 < 16;
        for (int s0 = 0; s0 < NCHUNK; s0 += 4) {
            u32x2 dr[4]; f32x4 dn[4]; float g0[4], g1[4]; int idx[4];
#pragma unroll
            for (int u = 0; u < 4; ++u) { const int step = s0 + u; const int cp = dir == 0 ? step : (step < 4 ? 3 - step : 71 - step); idx[u] = base + cp;
                dr[u] = S2[(size_t)idx[u] * 2048 + e4];
                if (!odd) { g0[u] = GAM[(size_t)idx[u] * 64 + dkk]; g1[u] = 0.f; } else { g0[u] = SC[(size_t)idx[u] * 4 + 0]; g1[u] = SC[(size_t)idx[u] * 4 + 1]; if (hasn) dn[u] = GAM4[(size_t)idx[u] * 16 + e4]; } }
#pragma unroll
            for (int u = 0; u < 4; ++u) {
                const f32x4 d = (f32x4){bflo(dr[u].x), bfhi(dr[u].x), bflo(dr[u].y), bfhi(dr[u].y)};
                u32x2 w; w.x = pk2(st[0], st[1]); w.y = pk2(st[2], st[3]);
                S2[(size_t)idx[u] * 2048 + e4] = dummy ? dr[u] : w;
                if (!odd) { st = st * g0[u] + d; }
                else { if (hasn) GAM4[(size_t)idx[u] * 16 + e4] = dummy ? dn[u] : nst; if (e4 == 0 && !dummy) SC[(size_t)idx[u] * 4 + 2] = m;
                    const float mn = fmaxf(g0[u] + m, g1[u]); const float dec = __expf(g0[u] + m - mn), sc = __expf(g1[u] - mn);
                    st = st * dec + d * sc; if (hasn) nst = nst * dec + dn[u] * sc; m = mn; }
            }
        }
    }
}
constexpr int SO_QF = 0, SO_KF = 9216, SO_QB = 18432, SO_KB = 27648, SO_VS = 36864, SO_AF = 54272, SO_AB = 63488, SO_SF = 72704, SO_SB = 90112, SO_SEG = 107520, SO_SSQ = 111616, SO_MISC = 113664;
constexpr int SO_OST = 0;
__device__ __forceinline__ void scan_out_tail(LAS unsigned char* lds, f32x4 (&o)[4], const bf16* __restrict__ P, int ldp, bf16* __restrict__ Z, int row0, int h, const float* __restrict__ ng) {
    const int tid = otid(), lane = tid & 63, wave = tid >> 6, fq = lane >> 4, fr = lane & 15;
    LAS float* ost = (LAS float*)(lds + SO_OST);
    u32x4 gv[2]; f32x4 g0[2], g1[2];
#pragma unroll
    for (int c2 = 0; c2 < 2; ++c2) { const int idx = tid + NTHR * c2, t = idx >> 4, ch = idx & 15;
        gv[c2] = *(const u32x4*)(P + (size_t)(row0 + t) * ldp + 1024 + h * 128 + 8 * ch); g0[c2] = *(const f32x4*)(ng + h * 128 + 8 * ch); g1[c2] = *(const f32x4*)(ng + h * 128 + 8 * ch + 4); }
    __syncthreads();
#pragma unroll
    for (int mt = 0; mt < 4; ++mt)
#pragma unroll
        for (int r = 0; r < 4; ++r) ost[(16 * mt + 4 * fq + r) * 132 + 16 * wave + fr] = o[mt][r];
    __syncthreads();
#pragma unroll
    for (int c2 = 0; c2 < 2; ++c2) { const int idx = tid + NTHR * c2, t = idx >> 4, ch = idx & 15;
        f32x4 o0 = *(const LAS f32x4*)(ost + t * 132 + 8 * ch), o1 = *(const LAS f32x4*)(ost + t * 132 + 8 * ch + 4);
        const float q = red16_sum((o0[0] * o0[0] + o0[1] * o0[1]) + (o0[2] * o0[2] + o0[3] * o0[3]) + (o1[0] * o1[0] + o1[1] * o1[1]) + (o1[2] * o1[2] + o1[3] * o1[3]));
        const float rs = rsqrtf(q * (1.f / 128.f) + 1e-6f); o0 = o0 * rs * g0[c2]; o1 = o1 * rs * g1[c2];
        u32x4 w;
        w.x = pk2(o0[0] * siluf(bflo(gv[c2].x)), o0[1] * siluf(bfhi(gv[c2].x))); w.y = pk2(o0[2] * siluf(bflo(gv[c2].y)), o0[3] * siluf(bfhi(gv[c2].y)));
        w.z = pk2(o1[0] * siluf(bflo(gv[c2].z)), o1[1] * siluf(bfhi(gv[c2].z))); w.w = pk2(o1[2] * siluf(bflo(gv[c2].w)), o1[3] * siluf(bfhi(gv[c2].w)));
        *(u32x4*)(Z + (size_t)(row0 + t) * DM + h * 128 + 8 * ch) = w; }
}
__device__ __forceinline__ void stage_state(LAS bf16* dst, const bf16* __restrict__ src) {
    const int tid = otid();
#pragma unroll
    for (int c2 = 0; c2 < 2; ++c2) { const int idx = tid + NTHR * c2, r = idx >> 4, ch = idx & 15; *(LAS u32x4*)(dst + r * 136 + 8 * ch) = *(const u32x4*)(src + r * 128 + 8 * ch); }
}
__device__ __forceinline__ void phase_scan_out_gla(KP p, LAS unsigned char* lds, int l, bool need_ctx) {
    const int tid = otid(), lane = tid & 63, wave = tid >> 6, fq = lane >> 4, fr = lane & 15; const int li = l >> 1;
    const bf16* P = (const bf16*)(p->ws + WS_P); const int ldp = NP_EVEN; const float* SM = (const float*)(p->ws + WS_SM); bf16* Z = (bf16*)(p->ws + WS_H);
    const bf16* S = (const bf16*)(p->ws + WS_S);
    LAS bf16* qf = (LAS bf16*)(lds + SO_QF); LAS bf16* kf = (LAS bf16*)(lds + SO_KF); LAS bf16* qb = (LAS bf16*)(lds + SO_QB); LAS bf16* kb = (LAS bf16*)(lds + SO_KB);
    LAS bf16* vs = (LAS bf16*)(lds + SO_VS); LAS bf16* Af = (LAS bf16*)(lds + SO_AF); LAS bf16* Ab = (LAS bf16*)(lds + SO_AB); LAS bf16* Sf = (LAS bf16*)(lds + SO_SF); LAS bf16* Sb = (LAS bf16*)(lds + SO_SB);
    LAS float* seg = (LAS float*)(lds + SO_SEG); LAS float* lrs = (LAS float*)(lds + SO_MISC);
    const int dk = tid & 63, sg = tid >> 6;
    for (int it = blockIdx.x; it < BATCH * 4 * NCHUNK; it += gridDim.x) {
        const int b = it / (4 * NCHUNK), h = (it / NCHUNK) & 3, cp = it % NCHUNK; if (cp < 4 && !need_ctx) continue;
        const int row0 = chunk_row0(b, cp); const int slf = ((b * 4 + h) * 2 + 0) * NCHUNK + cp, slb = slf + NCHUNK;
        __syncthreads();
#pragma unroll
        for (int c2 = 0; c2 < 2; ++c2) { const int idx = tid + NTHR * c2, t = idx >> 4, ch = idx & 15; *(LAS u32x4*)(vs + t * 136 + 8 * ch) = *(const u32x4*)(P + (size_t)(row0 + t) * ldp + 512 + h * 128 + 8 * ch); }
        stage_state(Sf, S + (size_t)slf * 8192); stage_state(Sb, S + (size_t)slb * 8192);
        float qv[8], kv[8];
#pragma unroll
        for (int tt = 0; tt < 8; ++tt) { const size_t ro = (size_t)(row0 + sg * 8 + tt) * ldp + h * 64 + dk; qv[tt] = bf2f(P[ro]); kv[tt] = bf2f(P[ro + 256]); }
        float gwf[16], gwb[16];
        const float* gw = p->gla_gate_w + (size_t)li * 2 * 16 * 256; const float* gb = p->gla_gate_b + (size_t)li * 2 * 256;
#pragma unroll
        for (int r = 0; r < 16; ++r) { gwf[r] = gw[r * 256 + h * 64 + dk]; gwb[r] = gw[(16 + r) * 256 + h * 64 + dk]; }
        const float gbf = gb[h * 64 + dk], gbb = gb[256 + h * 64 + dk];
        { const int t = tid >> 3, c4 = (tid & 7) * 4; *(LAS f32x4*)(lrs + t * 32 + c4) = *(const f32x4*)(SM + (size_t)(row0 + t) * 32 + c4); }
        __syncthreads();
        float pf[8], sb[8];
        f32x4 L[2][8];
#pragma unroll
        for (int i = 0; i < 8; ++i) L[0][i] = *(const LAS f32x4*)(lrs + (sg * 8) * 32 + 4 * i);
#pragma unroll
        for (int tt = 0; tt < 8; ++tt) {
            if (tt < 7) {
#pragma unroll
                for (int i = 0; i < 8; ++i) L[(tt + 1) & 1][i] = *(const LAS f32x4*)(lrs + (sg * 8 + tt + 1) * 32 + 4 * i); }
            float zf = gbf, zb = gbb, zf2 = 0.f, zb2 = 0.f;
#pragma unroll
            for (int i = 0; i < 4; i += 2)
#pragma unroll
                for (int e = 0; e < 4; ++e) { zf += L[tt & 1][i][e] * gwf[4 * i + e]; zf2 += L[tt & 1][i + 1][e] * gwf[4 * i + 4 + e]; zb += L[tt & 1][4 + i][e] * gwb[4 * i + e]; zb2 += L[tt & 1][5 + i][e] * gwb[4 * i + 4 + e]; }
            pf[tt] = logsigf(zf + zf2) * 0.0625f; sb[tt] = logsigf(zb + zb2) * 0.0625f; }
#pragma unroll
        for (int tt = 1; tt < 8; ++tt) pf[tt] += pf[tt - 1];
#pragma unroll
        for (int tt = 6; tt >= 0; --tt) sb[tt] += sb[tt + 1];
        seg[(0 * 8 + sg) * 64 + dk] = pf[7]; seg[(1 * 8 + sg) * 64 + dk] = sb[0];
        __syncthreads();
        float offf = 0.f, offb = 0.f;
#pragma unroll
        for (int q = 0; q < 8; ++q) { const float a = seg[q * 64 + dk], c = seg[(8 + q) * 64 + dk]; if (q < sg) offf += a; if (q > sg) offb += c; }
#pragma unroll
        for (int tt = 0; tt < 8; ++tt) { const int t = sg * 8 + tt; const float bf_ = offf + pf[tt], bb_ = offb + sb[tt];
            qf[t * 72 + dk] = (bf16)f2bf(qv[tt] * __expf(bf_)); kf[t * 72 + dk] = (bf16)f2bf(kv[tt] * __expf(-bf_));
            qb[t * 72 + dk] = (bf16)f2bf(qv[tt] * __expf(bb_)); kb[t * 72 + dk] = (bf16)f2bf(kv[tt] * __expf(-bb_)); }
        __syncthreads();
        { const int mt = wave >> 1;
#pragma unroll
          for (int n2 = 0; n2 < 2; ++n2) { const int nt = 2 * (wave & 1) + n2; f32x4 af = (f32x4){0.f, 0.f, 0.f, 0.f}, ab = (f32x4){0.f, 0.f, 0.f, 0.f};
#pragma unroll
              for (int ks = 0; ks < 2; ++ks) { af = MFMA(frag_rm(qf, 72, 16 * mt, 32 * ks, lane), frag_rm(kf, 72, 16 * nt, 32 * ks, lane), af);
                                               ab = MFMA(frag_rm(qb, 72, 16 * mt, 32 * ks, lane), frag_rm(kb, 72, 16 * nt, 32 * ks, lane), ab); }
#pragma unroll
              for (int r = 0; r < 4; ++r) { const int t = 16 * mt + 4 * fq + r, s = 16 * nt + fr;
                  Af[t * 72 + s] = (bf16)f2bf(s <= t ? af[r] : 0.f); Ab[t * 72 + s] = (bf16)f2bf(s >= t ? ab[r] : 0.f); } } }
        __syncthreads();
        f32x4 o[4];
#pragma unroll
        for (int mt = 0; mt < 4; ++mt) o[mt] = (f32x4){0.f, 0.f, 0.f, 0.f};
#pragma unroll
        for (int ks = 0; ks < 2; ++ks) { const bf16x8 bv = frag_tr(vs, 136, 32 * ks, 16 * wave, lane), bsf = frag_tr(Sf, 136, 32 * ks, 16 * wave, lane), bsb = frag_tr(Sb, 136, 32 * ks, 16 * wave, lane);
#pragma unroll
            for (int mt = 0; mt < 4; ++mt) { o[mt] = MFMA(frag_rm(Af, 72, 16 * mt, 32 * ks, lane), bv, o[mt]); o[mt] = MFMA(frag_rm(Ab, 72, 16 * mt, 32 * ks, lane), bv, o[mt]);
                o[mt] = MFMA(frag_rm(qf, 72, 16 * mt, 32 * ks, lane), bsf, o[mt]); o[mt] = MFMA(frag_rm(qb, 72, 16 * mt, 32 * ks, lane), bsb, o[mt]); } }
        scan_out_tail(lds, o, P, ldp, Z, row0, h, p->gla_norm_g + (size_t)li * 512);
    }
}
constexpr int MO_QS = 0, MO_KS = 9216, MO_QWF = 18432, MO_QWB = 27648;
__device__ __forceinline__ void phase_scan_out_mlstm(KP p, LAS unsigned char* lds, int l, bool need_ctx) {
    const int tid = otid(), lane = tid & 63, wave = tid >> 6, fq = lane >> 4, fr = lane & 15; const int li = l >> 1;
    const bf16* P = (const bf16*)(p->ws + WS_P); const int ldp = NP_ODD; const float* SM = (const float*)(p->ws + WS_SM); bf16* Z = (bf16*)(p->ws + WS_H);
    const bf16* S = (const bf16*)(p->ws + WS_S); const float* GAM = (const float*)(p->ws + WS_GAM); const float* SC = (const float*)(p->ws + WS_SC);
    LAS bf16* qs = (LAS bf16*)(lds + MO_QS); LAS bf16* ks_ = (LAS bf16*)(lds + MO_KS); LAS bf16* qwf = (LAS bf16*)(lds + MO_QWF); LAS bf16* qwb = (LAS bf16*)(lds + MO_QWB);
    LAS bf16* vs = (LAS bf16*)(lds + SO_VS); LAS bf16* Af = (LAS bf16*)(lds + SO_AF); LAS bf16* Ab = (LAS bf16*)(lds + SO_AB); LAS bf16* Cf = (LAS bf16*)(lds + SO_SF); LAS bf16* Cb = (LAS bf16*)(lds + SO_SB);
    LAS float* part = (LAS float*)(lds + SO_SEG);
    LAS float* misc = (LAS float*)(lds + SO_MISC);
    const float* mb = p->ml_gate_b + li * 16;
    for (int it = blockIdx.x; it < BATCH * 4 * NCHUNK; it += gridDim.x) {
        const int b = it / (4 * NCHUNK), h = (it / NCHUNK) & 3, cp = it % NCHUNK; if (cp < 4 && !need_ctx) continue;
        const int row0 = chunk_row0(b, cp); const int slf = ((b * 4 + h) * 2 + 0) * NCHUNK + cp, slb = slf + NCHUNK;
        __syncthreads();
#pragma unroll
        for (int c2 = 0; c2 < 2; ++c2) { const int idx = tid + NTHR * c2, t = idx >> 4, ch = idx & 15; *(LAS u32x4*)(vs + t * 136 + 8 * ch) = *(const u32x4*)(P + (size_t)(row0 + t) * ldp + 512 + h * 128 + 8 * ch); }
        stage_state(Cf, S + (size_t)slf * 8192); stage_state(Cb, S + (size_t)slb * 8192);
        { const int t = tid >> 3, ch = tid & 7; const size_t ro = (size_t)(row0 + t) * ldp + h * 64 + 8 * ch;
          *(LAS u32x4*)(qs + t * 72 + 8 * ch) = *(const u32x4*)(P + ro); *(LAS u32x4*)(ks_ + t * 72 + 8 * ch) = *(const u32x4*)(P + ro + 256); }
        float mprev_r = 0.f;
        if (tid < 128) { const int d = tid >> 6, t = tid & 63; const float* gp = SM + (size_t)(row0 + t) * 32 + d * 8;
            misc[d * 512 + t] = gp[h] + mb[d * 8 + h]; misc[d * 512 + 64 + t] = logsigf(gp[4 + h] + mb[d * 8 + 4 + h]);
            misc[1024 + d * 64 + t] = GAM[(size_t)(d ? slb : slf) * 64 + t]; mprev_r = SC[(size_t)(d ? slb : slf) * 4 + 2]; }
        __syncthreads();
        if (tid < 128) { const int d = tid >> 6, t = tid & 63; LAS float* md = misc + d * 512; const float run = wave_scan_sum(md[64 + t], t, d == 1); const float pm = wave_scan_max(md[t] - run, t, d == 1);
            const float mprev = mprev_r;
            const float mt_ = fmaxf(run + pm, run + mprev);
            md[128 + t] = run; md[192 + t] = mt_; md[256 + t] = __expf(run + mprev - mt_); }
        __syncthreads();
        { const int t = tid >> 3, ch = tid & 7; const u32x4 qv = *(const LAS u32x4*)(qs + t * 72 + 8 * ch); const float wf = misc[256 + t], wb = misc[512 + 256 + t];
          u32x4 a, c;
          a.x = pk2(bflo(qv.x) * wf, bfhi(qv.x) * wf); a.y = pk2(bflo(qv.y) * wf, bfhi(qv.y) * wf); a.z = pk2(bflo(qv.z) * wf, bfhi(qv.z) * wf); a.w = pk2(bflo(qv.w) * wf, bfhi(qv.w) * wf);
          c.x = pk2(bflo(qv.x) * wb, bfhi(qv.x) * wb); c.y = pk2(bflo(qv.y) * wb, bfhi(qv.y) * wb); c.z = pk2(bflo(qv.z) * wb, bfhi(qv.z) * wb); c.w = pk2(bflo(qv.w) * wb, bfhi(qv.w) * wb);
          *(LAS u32x4*)(qwf + t * 72 + 8 * ch) = a; *(LAS u32x4*)(qwb + t * 72 + 8 * ch) = c;
          const float q0 = bflo(qv.x), q1 = bfhi(qv.x), q2 = bflo(qv.y), q3 = bfhi(qv.y), q4 = bflo(qv.z), q5 = bfhi(qv.z), q6 = bflo(qv.w), q7 = bfhi(qv.w);
#pragma unroll
          for (int d = 0; d < 2; ++d) { const LAS float* nv = misc + 1024 + d * 64 + 8 * ch;
              part[(d * 8 + ch) * 64 + t] = q0 * nv[0] + q1 * nv[1] + q2 * nv[2] + q3 * nv[3] + q4 * nv[4] + q5 * nv[5] + q6 * nv[6] + q7 * nv[7]; } }
        { const int mt = wave >> 1; float rsf[4] = {0.f, 0.f, 0.f, 0.f}, rsb[4] = {0.f, 0.f, 0.f, 0.f};
#pragma unroll
          for (int n2 = 0; n2 < 2; ++n2) { const int nt = 2 * (wave & 1) + n2; f32x4 a = (f32x4){0.f, 0.f, 0.f, 0.f};
#pragma unroll
              for (int ks = 0; ks < 2; ++ks) a = MFMA(frag_rm(qs, 72, 16 * mt, 32 * ks, lane), frag_rm(ks_, 72, 16 * nt, 32 * ks, lane), a);
#pragma unroll
              for (int r = 0; r < 4; ++r) { const int t = 16 * mt + 4 * fq + r, s = 16 * nt + fr;
                  const float wf = s <= t ? __expf(misc[128 + t] - misc[128 + s] + misc[s] - misc[192 + t]) : 0.f;
                  const float wb = s >= t ? __expf(misc[512 + 128 + t] - misc[512 + 128 + s] + misc[512 + s] - misc[512 + 192 + t]) : 0.f;
                  const float vf = a[r] * wf, vb = a[r] * wb; rsf[r] += vf; rsb[r] += vb;
                  Af[t * 72 + s] = (bf16)f2bf(vf); Ab[t * 72 + s] = (bf16)f2bf(vb); } }
#pragma unroll
          for (int r = 0; r < 4; ++r) { const float a = red16_sum(rsf[r]), c = red16_sum(rsb[r]);
              if (fr == 0) { misc[1152 + (0 * 2 + (wave & 1)) * 64 + 16 * mt + 4 * fq + r] = a; misc[1152 + (1 * 2 + (wave & 1)) * 64 + 16 * mt + 4 * fq + r] = c; } } }
        __syncthreads();
        if (tid < 128) { const int d = tid >> 6, t = tid & 63; float qn = 0.f;
#pragma unroll
            for (int q = 0; q < 8; ++q) qn += part[(d * 8 + q) * 64 + t];
            const float den = misc[1152 + (d * 2 + 0) * 64 + t] + misc[1152 + (d * 2 + 1) * 64 + t] + misc[d * 512 + 256 + t] * qn;
            misc[d * 512 + 320 + t] = 1.f / fmaxf(fabsf(den), __expf(-misc[d * 512 + 192 + t])); }
        f32x4 of[4], ob[4];
#pragma unroll
        for (int mt = 0; mt < 4; ++mt) { of[mt] = (f32x4){0.f, 0.f, 0.f, 0.f}; ob[mt] = (f32x4){0.f, 0.f, 0.f, 0.f}; }
#pragma unroll
        for (int ks = 0; ks < 2; ++ks) { const bf16x8 bv = frag_tr(vs, 136, 32 * ks, 16 * wave, lane), bcf = frag_tr(Cf, 136, 32 * ks, 16 * wave, lane), bcb = frag_tr(Cb, 136, 32 * ks, 16 * wave, lane);
#pragma unroll
            for (int mt = 0; mt < 4; ++mt) { of[mt] = MFMA(frag_rm(Af, 72, 16 * mt, 32 * ks, lane), bv, of[mt]); of[mt] = MFMA(frag_rm(qwf, 72, 16 * mt, 32 * ks, lane), bcf, of[mt]);
                ob[mt] = MFMA(frag_rm(Ab, 72, 16 * mt, 32 * ks, lane), bv, ob[mt]); ob[mt] = MFMA(frag_rm(qwb, 72, 16 * mt, 32 * ks, lane), bcb, ob[mt]); } }
        __syncthreads();
        f32x4 o[4];
#pragma unroll
        for (int mt = 0; mt < 4; ++mt)
#pragma unroll
            for (int r = 0; r < 4; ++r) { const int t = 16 * mt + 4 * fq + r; o[mt][r] = of[mt][r] * misc[320 + t] + ob[mt][r] * misc[512 + 320 + t]; }
        scan_out_tail(lds, o, P, ldp, Z, row0, h, p->ml_norm_g + (size_t)li * 512);
    }
}
#define XB_TMO      128
#define XB_XCNT(j)  (256  + 64 * (j))
#define XB_XSUB(j)  (1280 + 64 * (j))
#define XB_XGEN(j)  (2304 + 64 * (j))
#define XB_TOP      3328
#define XB_TOPGEN   3392
#define XCD_BAR_WORDS 3456
#define XB_SPIN_CAP (1u << 18)

__device__ __forceinline__ unsigned xb_ld(unsigned* p)              { return __hip_atomic_load(p, __ATOMIC_RELAXED, __HIP_MEMORY_SCOPE_AGENT); }
__device__ __forceinline__ unsigned xb_add(unsigned* p, unsigned v) { return __hip_atomic_fetch_add(p, v, __ATOMIC_RELAXED, __HIP_MEMORY_SCOPE_AGENT); }
__device__ __forceinline__ unsigned xb_xcc_id() { return (unsigned)__builtin_amdgcn_s_getreg((3 << 11) | 20) & 0xFu; }
#define XB_SPIN(cond, bar) do { unsigned _sp = 0; while (cond) { __builtin_amdgcn_s_sleep(1); \
    if ((++_sp & 255u) == 0u) { if (xb_ld(&(bar)[XB_TMO])) break; if (_sp > XB_SPIN_CAP) { atomicAdd(&(bar)[XB_TMO], 1u); break; } } } } while (0)

struct XcdBarrier {
    unsigned* bar; unsigned x;
    volatile LAS unsigned* st;
};

__device__ __forceinline__ XcdBarrier xcd_barrier_post(unsigned* bar, volatile LAS unsigned* st) {
    XcdBarrier b; b.bar = bar; b.x = xb_xcc_id(); b.st = st;
    if (otid() == 0) (void)xb_add(&bar[XB_XCNT(b.x)], 1u);
    return b;
}
__device__ __forceinline__ void xcd_barrier_complete(unsigned* bar, unsigned x, unsigned& nloc, unsigned& nx) {
    const unsigned G = gridDim.x * gridDim.y * gridDim.z;
    unsigned sum, cnt, mine, sp = 0u;
    for (;;) {
        sum = 0u; cnt = 0u; mine = 0u;
#pragma unroll
        for (unsigned j = 0; j < 16; ++j) { const unsigned c = xb_ld(&bar[XB_XCNT(j)]); sum += c; cnt += (c > 0u) ? 1u : 0u; mine = (j == x) ? c : mine; }
        if (sum == G) break;
        __builtin_amdgcn_s_sleep(1);
        if ((++sp & 255u) == 0u) { if (xb_ld(&bar[XB_TMO])) break; if (sp > XB_SPIN_CAP) { atomicAdd(&bar[XB_TMO], 1u); break; } }
    }
    nloc = mine > 0u ? mine : 1u; nx = cnt > 0u ? cnt : 1u;
}

__device__ __forceinline__ void xcd_barrier(const XcdBarrier& b) {
    asm volatile("s_waitcnt vmcnt(0)" ::: "memory");
    __syncthreads();
    if (otid() == 0) {
        unsigned* bar = b.bar;
        __builtin_amdgcn_s_waitcnt(0);
        unsigned nloc = b.st[0], nx = b.st[1];
        if (nloc == 0u) { xcd_barrier_complete(bar, b.x, nloc, nx); b.st[0] = nloc; b.st[1] = nx; }
        const unsigned old = xb_add(&bar[XB_XSUB(b.x)], 1u);
        const unsigned gen = old / nloc;
        if (old + 1u == (gen + 1u) * nloc) {
            __builtin_amdgcn_fence(__ATOMIC_RELEASE, "agent");
            asm volatile("s_waitcnt vmcnt(0)" ::: "memory");
            const unsigned og = xb_add(&bar[XB_TOP], 1u);
            const unsigned tg = og / nx;
            if (og + 1u == (tg + 1u) * nx) xb_add(&bar[XB_TOPGEN], 1u);
            else XB_SPIN(xb_ld(&bar[XB_TOPGEN]) == tg, bar);
            __builtin_amdgcn_fence(__ATOMIC_ACQUIRE, "agent");
            xb_add(&bar[XB_XGEN(b.x)], 1u);
            asm volatile("s_waitcnt vmcnt(0)" ::: "memory");
        } else {
            XB_SPIN(xb_ld(&bar[XB_XGEN(b.x)]) == gen, bar);
            __builtin_amdgcn_fence(__ATOMIC_ACQUIRE, "agent");
            asm volatile("s_waitcnt vmcnt(0)" ::: "memory");
        }
    }
    __syncthreads();
}

#define REP_GEMM 1
#define REP_ATT 1
#define REP_LOC 1
#define REP_OUT 1
#define REP_PRO 1
#define REP_SEQ 1
#define REP_LN 1
#ifndef MK_N_LAUNCHES
#define MK_N_LAUNCHES 1
#endif
constexpr int N_PHASES = 2 + 6 * DEPTH;
__global__ void __launch_bounds__(NTHR, 2) fwd_megakernel(Params p_unused) {
    extern __shared__ __attribute__((aligned(16))) unsigned char lds_raw[];
    LAS unsigned char* lds = (LAS unsigned char*)lds_raw;
    cg::grid_group grid = cg::this_grid();
    const int lo = (int)kparams()->ph_lo, hi = (int)kparams()->ph_hi;
#define IN(k) (lo <= (k) && (k) < hi)
    volatile LAS unsigned* bst = (volatile LAS unsigned*)(lds + LDS_BYTES - 64);
    if (otid() < 16) bst[otid()] = 0u;
    __syncthreads();
    XcdBarrier bar = xcd_barrier_post((unsigned*)(kparams()->ws + WS_BAR), bst);
    if (kparams()->ph_hi < 0) grid.sync();
#define SEAM(k) do { if (IN(k) && IN((k) + 1)) xcd_barrier(bar); } while (0)
    if (IN(0)) { for (int rep = 0; rep < REP_PRO; ++rep) { phase_prologue(kparams(), lds); __syncthreads(); } } SEAM(0);
    if (IN(1)) { for (int rep = 0; rep < REP_PRO; ++rep) phase_h0(kparams()); } SEAM(1);
#pragma unroll 1
    for (int l = 0; l < DEPTH; ++l) {
        const int pb = 2 + 6 * l; const bool odd = l & 1; const int li = l >> 1; const bool need_ctx = l < DEPTH - 1;
        if (IN(pb + 0)) {
            const int npad = odd ? NPAD_ODD : NPAD_EVEN; unsigned char* ws = kparams()->ws;
            pg8::Gemm g{(const pg8::bf16_t*)(ws + WS_H), (const pg8::bf16_t*)(ws + (odd ? WS_WIO : WS_WIE)) + (size_t)li * npad * 1024, MTOT, npad, 1024};
            pg8::StaticOrder S; S.init(MTOT, npad, (int)gridDim.x, (int)blockIdx.x);
            pg8::EpiProj E{(pg8::bf16_t*)(ws + WS_P), odd ? NP_ODD : NP_EVEN, (float*)(ws + WS_SM), odd ? 16 : 32, npad / 256 - 1, odd ? 1 : 0, (const float*)(ws + WS_ROPE), (const float*)(ws + WS_ROPE) + 1024};
            for (int rep = 0; rep < REP_GEMM; ++rep) pg8::gemm_phase<pg8::EpiProj, pg8::StaticOrder, true, true>(lds, g, S, E);
        }
        SEAM(pb + 0);
        if (IN(pb + 1)) { for (int rep = 0; rep < REP_ATT; ++rep) phase_attn(kparams(), lds, l, need_ctx); for (int rep = 0; rep < REP_LOC; ++rep) phase_scan_local(kparams(), lds, l); }
        SEAM(pb + 1);
        if (IN(pb + 2)) { for (int rep = 1; rep < REP_SEQ; ++rep) { phase_scan_seq(kparams(), l, true); __syncthreads(); } phase_scan_seq(kparams(), l); }
        SEAM(pb + 2);
        if (IN(pb + 3)) { for (int rep = 0; rep < REP_OUT; ++rep) { if (odd) phase_scan_out_mlstm(kparams(), lds, l, need_ctx); else phase_scan_out_gla(kparams(), lds, l, need_ctx); } }
        SEAM(pb + 3);
        if (IN(pb + 4)) {
            const int mrows = need_ctx ? MTOT : MLAT; unsigned char* ws = kparams()->ws;
            pg8::Gemm g{(const pg8::bf16_t*)(ws + WS_H), (const pg8::bf16_t*)(ws + WS_WO) + (size_t)l * 1024 * 1024, mrows, 1024, 1024};
            pg8::StaticOrder S; S.init(mrows, 1024, (int)gridDim.x, (int)blockIdx.x);
            pg8::EpiProj E{(pg8::bf16_t*)(ws + WS_P), 1024, nullptr, 0, -1, 0, nullptr, nullptr};
            for (int rep = 0; rep < REP_GEMM; ++rep) pg8::gemm_phase<pg8::EpiProj, pg8::StaticOrder, true, true>(lds, g, S, E);
        }
        SEAM(pb + 4);
        if (IN(pb + 5)) { for (int rep = 1; rep < REP_LN; ++rep) { phase_ln(kparams(), l, true); } phase_ln(kparams(), l); }
        SEAM(pb + 5);
    }
}
extern "C" void kernel_launch(void* const* d_in, const int* in_sizes, int n_in, void* d_out, int out_size, void* d_ws, size_t ws_size, hipStream_t stream) {
    static int grid = 0;
    if (grid == 0) {
        if (n_in != 19 || ws_size < WS_END) { fprintf(stderr, "kernel_launch: need 19 inputs and %zu bytes of workspace; got %d, %zu\n", (size_t)WS_END, n_in, ws_size); grid = -1; return; }
        int dev = 0, cus = 0, per_cu = 0;
        if (hipGetDevice(&dev) != hipSuccess || hipDeviceGetAttribute(&cus, hipDeviceAttributeMultiprocessorCount, dev) != hipSuccess) { grid = -1; return; }
        if (hipFuncSetAttribute((const void*)fwd_megakernel, hipFuncAttributeMaxDynamicSharedMemorySize, LDS_BYTES) != hipSuccess) { fprintf(stderr, "kernel_launch: hipFuncSetAttribute failed\n"); grid = -1; return; }
        if (hipOccupancyMaxActiveBlocksPerMultiprocessor(&per_cu, (const void*)fwd_megakernel, NTHR, LDS_BYTES) != hipSuccess || per_cu < 1) per_cu = 1;
        grid = cus * per_cu;
    }
    if (grid < 0) return;
    Params p{};
    p.x = (const float*)d_in[0]; p.c = (const float*)d_in[1]; p.ctx = (const float*)d_in[2]; p.c_ctx = (const float*)d_in[3]; p.w_ada = (const float*)d_in[4]; p.b_ada = (const float*)d_in[5];
    p.ln_g = (const float*)d_in[6]; p.ln_b = (const float*)d_in[7]; p.w_in_even = (const float*)d_in[8]; p.w_out_even = (const float*)d_in[9]; p.gla_gate_w = (const float*)d_in[10]; p.gla_gate_b = (const float*)d_in[11];
    p.gla_norm_g = (const float*)d_in[12]; p.na_rpb = (const float*)d_in[13]; p.w_in_odd = (const float*)d_in[14]; p.w_out_odd = (const float*)d_in[15]; p.ml_gate_b = (const float*)d_in[16]; p.ml_norm_g = (const float*)d_in[17];
    p.sw_sink = (const float*)d_in[18]; p.out = (float*)d_out; p.ws = (unsigned char*)d_ws;
    if (hipMemsetAsync((char*)d_ws + WS_BAR, 0, XCD_BAR_WORDS * 4, stream) != hipSuccess) { fprintf(stderr, "kernel_launch: memset failed\n"); return; }
#if MK_N_LAUNCHES == 1
    p.ph_lo = 0; p.ph_hi = N_PHASES;
    void* args[] = {&p};
    hipError_t e = hipLaunchCooperativeKernel((const void*)fwd_megakernel, dim3(grid), dim3(NTHR), args, LDS_BYTES, stream);
    if (e != hipSuccess) fprintf(stderr, "kernel_launch: cooperative launch failed: %s (grid %d)\n", hipGetErrorString(e), grid);
#else
    for (int k = 0; k < N_PHASES; ++k) { p.ph_lo = k; p.ph_hi = k + 1; hipLaunchKernelGGL(fwd_megakernel, dim3(grid), dim3(NTHR), LDS_BYTES, stream, p); }
#endif
}
```

```cpp
#include <hip/hip_runtime.h>
#include <hip/hip_cooperative_groups.h>
#include <cstdio>
#include <cstdint>
namespace cg = cooperative_groups;
__device__ __forceinline__ int otid() { int t = threadIdx.x; asm volatile("" : "+v"(t)); return t; }
namespace pg8 {
#define PG8_LAS __attribute__((address_space(3)))
typedef unsigned short bf16_t;
typedef short bf16x8 __attribute__((ext_vector_type(8)));
typedef float f32x4 __attribute__((ext_vector_type(4)));
typedef unsigned u32x4 __attribute__((ext_vector_type(4)));
constexpr int BM = 256, BK = 64, HALF = 128, HTB = HALF * BK * 2  , STAGE_BYTES = 8 * HTB, NXCD = 8, WGM = 8;

__host__ __device__ __forceinline__ int lds_byte(int r, int c) { const int st = (r >> 4) * 2 + (c >> 5), rr = r & 15, cc = c & 31, ob = rr * 64 + cc * 2; return st * 1024 + (ob ^ (((ob >> 9) & 1) << 5)); }
__host__ __device__ __forceinline__ void stage_rc(int b, int& R, int& C) { const int st = b / 1024, sb = b % 1024, swz = sb ^ (((sb >> 9) & 1) << 5); R = (st >> 1) * 16 + swz / 64; C = (st & 1) * 32 + (swz % 64) / 2; }
__host__ __device__ __forceinline__ int perm32(int rho) { const int n = rho >> 4, i = rho & 15; return 8 * (i >> 2) + 4 * n + (i & 3); }

struct Unit { int pm, pn; };
struct Gemm { const bf16_t* A; const bf16_t* Bt; int M, N, K; };

struct StaticOrder {
    int nM, nN, nwg, G, c;
    __host__ __device__ void init(int M, int N, int G_, int c_) { nM = M / BM; nN = N / BM; nwg = nM * nN; G = G_; c = c_; }
    __host__ __device__ bool next(int i, Unit& u) const {
        const long L = (long)i * G + c; if (L >= nwg) return false;
        int wgid = (int)L; { const int q = nwg / NXCD, r = nwg % NXCD, xcd = wgid % NXCD, off = wgid / NXCD; wgid = (xcd < r ? xcd * (q + 1) : r * (q + 1) + (xcd - r) * q) + off; }
        const int nig = WGM * nN, gid = wgid / nig, fm = gid * WGM, gsz = (nM - fm) < WGM ? (nM - fm) : WGM;
        u.pm = fm + ((wgid % nig) % gsz); u.pn = (wgid % nig) / gsz; return true;
    }
    __device__ __forceinline__ void a_ready(const Unit&) const {}
    __device__ __forceinline__ void done(const Unit&) const {}
};

__device__ __forceinline__ unsigned cvt_pk_bf16(float lo, float hi) { unsigned r; asm volatile("v_cvt_pk_bf16_f32 %0, %1, %2" : "=v"(r) : "v"(lo), "v"(hi)); return r; }
struct EpiProj {
    static constexpr bool PERM = true, AFTER_DRAIN = false;
    bf16_t* P; int ldp; float* SM; int nsm; int last_pn; int rope; const float* cosT; const float* sinT;
    __device__ __forceinline__ void operator()(const f32x4 (&acc)[2][2][4][2], const Unit& u, int wr, int wc, int fr, int fq) const {
        const int row0 = u.pm * BM + wr * 64 + fr;
        if (u.pn == last_pn) {
            if (wc == 0) {
#pragma unroll
                for (int ai = 0; ai < 2; ++ai)
#pragma unroll
                    for (int m = 0; m < 4; ++m) { const int row = row0 + ai * HALF + m * 16;
#pragma unroll
                        for (int n = 0; n < 2; ++n) { const int col = 8 * fq + 4 * n; if (col < nsm) *(f32x4*)(SM + (size_t)row * 32 + col) = acc[ai][0][m][n]; } }
            }
            return;
        }
        const bool do_rope_tile = rope && (u.pn == 6 || u.pn == 7 || u.pn == 8) && (u.pm * BM < 32768);
#pragma unroll
        for (int ai = 0; ai < 2; ++ai)
#pragma unroll
            for (int m = 0; m < 4; ++m) { const int row = row0 + ai * HALF + m * 16; bf16_t* rowp = P + (size_t)row * ldp + u.pn * BM + wc * 32 + 8 * fq;
#pragma unroll
                for (int bj = 0; bj < 2; ++bj) { f32x4 v0 = acc[ai][bj][m][0], v1 = acc[ai][bj][m][1];
                    if (do_rope_tile && (u.pn != 8 || bj == 0)) {
                        const int t = row & 4095; const int pos = (wc & 1) ? (t & 63) : (t >> 6); const int i0 = pos * 16 + 8 * (fq & 1);
                        const f32x4 c0 = *(const f32x4*)(cosT + i0), c1 = *(const f32x4*)(cosT + i0 + 4), s0 = *(const f32x4*)(sinT + i0), s1 = *(const f32x4*)(sinT + i0 + 4);
                        f32x4 p0, p1;
#pragma unroll
                        for (int e = 0; e < 4; ++e) { p0[e] = __shfl_xor(v0[e], 32); p1[e] = __shfl_xor(v1[e], 32); }
                        if (fq < 2) { v0 = v0 * c0 - p0 * s0; v1 = v1 * c1 - p1 * s1; } else { v0 = p0 * s0 + v0 * c0; v1 = p1 * s1 + v1 * c1; }
                    }
                    u32x4 w; w.x = cvt_pk_bf16(v0[0], v0[1]); w.y = cvt_pk_bf16(v0[2], v0[3]); w.z = cvt_pk_bf16(v1[0], v1[1]); w.w = cvt_pk_bf16(v1[2], v1[3]);
                    *(u32x4*)(rowp + bj * HALF) = w; } }
    }
};
template <class Epi, class Sched, bool ALIGN_EPI = false, bool SP2 = false>
__device__ __forceinline__ void gemm_phase(PG8_LAS unsigned char* lds, const Gemm g, const Sched& S, const Epi& E) {
    const int tid = otid(), wid = __builtin_amdgcn_readfirstlane(tid >> 6), lane = tid & 63, wr = wid >> 2, wc = wid & 3, fr = lane & 15, fq = lane >> 4;
    const int K = g.K, nt = K / BK;
    unsigned voffA[2], voffB[2];
#pragma unroll
    for (int i = 0; i < 2; ++i) { int R, C; stage_rc(tid * 16 + i * 8192, R, C); const int Rb = Epi::PERM ? ((R & ~31) + perm32(R & 31)) : R;
        voffA[i] = (unsigned)(R * K + C) * 2u; voffB[i] = (unsigned)(Rb * K + C) * 2u; }
    const size_t kstep = (size_t)(BK * 2);
    const size_t hstep = (size_t)HALF * K * 2;
    const size_t tstep = 2 * hstep;
    const unsigned ldsw = (unsigned)wid * 1024u;
    const int aoff = lds_byte(wr * 64 + fr, fq * 8), boff = lds_byte(wc * 32 + fr, fq * 8);
#define PG8_SA(b, h) (((b) * 2 + (h)) * HTB)
#define PG8_SB(b, h) ((4 + (b) * 2 + (h)) * HTB)
#define PG8_STAGE(bufoff, gbase, voff) do { _Pragma("unroll") for (int _i = 0; _i < 2; ++_i) \
        __builtin_amdgcn_global_load_lds((const unsigned*)((const char*)(gbase) + (voff)[_i]), (PG8_LAS unsigned*)(lds + (bufoff) + ldsw + _i * 8192), 16, 0, 0); } while (0)
#define PG8_LDA(dst, b, h) do { _Pragma("unroll") for (int m = 0; m < 4; ++m) _Pragma("unroll") for (int k = 0; k < 2; ++k) dst[m][k] = *(const PG8_LAS bf16x8*)(lds + PG8_SA(b, h) + aoff + m * 2048 + k * 1024); } while (0)
#define PG8_LDB(dst, b, h) do { _Pragma("unroll") for (int n = 0; n < 2; ++n) _Pragma("unroll") for (int k = 0; k < 2; ++k) dst[n][k] = *(const PG8_LAS bf16x8*)(lds + PG8_SB(b, h) + boff + n * 2048 + k * 1024); } while (0)
#define PG8_MMA(ai, bj, At, Bt) do { __builtin_amdgcn_s_setprio(1); _Pragma("unroll") for (int m = 0; m < 4; ++m) _Pragma("unroll") for (int n = 0; n < 2; ++n) _Pragma("unroll") for (int k = 0; k < 2; ++k) \
        acc[ai][bj][m][n] = __builtin_amdgcn_mfma_f32_16x16x32_bf16(Bt[n][k], At[m][k], acc[ai][bj][m][n], 0, 0, 0); __builtin_amdgcn_s_setprio(0); } while (0)
#define PG8_WAIT_V(n) asm volatile("s_waitcnt vmcnt(" #n ")" ::: "memory")
#define PG8_WAIT_L(n) asm volatile("s_waitcnt lgkmcnt(" #n ")" ::: "memory")
#define PG8_BAR __builtin_amdgcn_s_barrier()
#define PG8_SCHED __builtin_amdgcn_sched_barrier(0)
    Unit cur, nxt; int ui = 0;
    if (!S.next(0, cur)) return;
    f32x4 acc[2][2][4][2];
#pragma unroll
    for (int a = 0; a < 2; ++a)
#pragma unroll
        for (int b = 0; b < 2; ++b)
#pragma unroll
            for (int m = 0; m < 4; ++m)
#pragma unroll
                for (int n = 0; n < 2; ++n) acc[a][b][m][n] = (f32x4){0.f, 0.f, 0.f, 0.f};
    bf16x8 At[4][2], B0[2][2], B1[2][2];
    const char* cA = (const char*)g.A + (size_t)cur.pm * tstep; const char* cB = (const char*)g.Bt + (size_t)cur.pn * tstep;
    S.a_ready(cur);
    if constexpr (SP2) {
        PG8_STAGE(PG8_SB(0, 0), cB, voffB); PG8_STAGE(PG8_SB(0, 1), cB + hstep, voffB); PG8_STAGE(PG8_SA(0, 0), cA, voffA); PG8_STAGE(PG8_SA(0, 1), cA + hstep, voffA);
        if (wr == 1) PG8_BAR;
        PG8_WAIT_V(2); PG8_BAR;
        PG8_STAGE(PG8_SB(1, 0), cB + kstep, voffB); PG8_STAGE(PG8_SA(1, 0), cA + kstep, voffA); PG8_STAGE(PG8_SB(1, 1), cB + hstep + kstep, voffB);
        PG8_WAIT_V(6); PG8_BAR;
    } else {
        PG8_STAGE(PG8_SB(0, 0), cB, voffB); PG8_STAGE(PG8_SA(0, 0), cA, voffA); PG8_STAGE(PG8_SB(0, 1), cB + hstep, voffB); PG8_STAGE(PG8_SA(0, 1), cA + hstep, voffA);
        if (wr == 1) PG8_BAR;
        PG8_WAIT_V(4); PG8_BAR;
        PG8_STAGE(PG8_SB(1, 0), cB + kstep, voffB); PG8_STAGE(PG8_SA(1, 0), cA + kstep, voffA); PG8_STAGE(PG8_SB(1, 1), cB + hstep + kstep, voffB);
        PG8_WAIT_V(6); PG8_BAR;
    }
    for (;;) {
        const bool has_next = S.next(ui + 1, nxt);
        const char* nA = has_next ? (const char*)g.A + (size_t)nxt.pm * tstep : cA; const char* nB = has_next ? (const char*)g.Bt + (size_t)nxt.pn * tstep : cB;
        for (int t = 0; t < nt; t += 2) {
            const bool last = (t == nt - 2);
            const char* a1 = cA + (size_t)(t + 1) * kstep;
            const char* a2 = last ? nA : cA + (size_t)(t + 2) * kstep; const char* b2 = last ? nB : cB + (size_t)(t + 2) * kstep;
            const char* a3 = a2 + kstep; const char* b3 = b2 + kstep;
            if (last && has_next) S.a_ready(nxt);
            if constexpr (SP2) {
            PG8_LDB(B0, 0, 0); PG8_LDB(B1, 0, 1); PG8_SCHED; PG8_LDA(At, 0, 0); PG8_STAGE(PG8_SA(1, 1), a1 + hstep, voffA);
            PG8_WAIT_V(8); PG8_WAIT_L(0); PG8_BAR; PG8_MMA(0, 0, At, B0); PG8_MMA(0, 1, At, B1); PG8_BAR; PG8_SCHED;
            PG8_LDA(At, 0, 1); PG8_STAGE(PG8_SB(0, 0), b2, voffB); PG8_STAGE(PG8_SB(0, 1), b2 + hstep, voffB); PG8_STAGE(PG8_SA(0, 0), a2, voffA);
            PG8_WAIT_V(8); PG8_WAIT_L(0); PG8_BAR; PG8_MMA(1, 0, At, B0); PG8_MMA(1, 1, At, B1); PG8_BAR; PG8_SCHED;
            PG8_LDB(B0, 1, 0); PG8_LDB(B1, 1, 1); PG8_SCHED; PG8_LDA(At, 1, 0); PG8_STAGE(PG8_SA(0, 1), a2 + hstep, voffA);
            PG8_WAIT_V(8); PG8_WAIT_L(0); PG8_BAR; PG8_MMA(0, 0, At, B0); PG8_MMA(0, 1, At, B1); PG8_BAR; PG8_SCHED;
            PG8_LDA(At, 1, 1); PG8_STAGE(PG8_SB(1, 0), b3, voffB); PG8_STAGE(PG8_SB(1, 1), b3 + hstep, voffB); PG8_STAGE(PG8_SA(1, 0), a3, voffA);
            PG8_WAIT_V(8); PG8_WAIT_L(0); PG8_BAR; PG8_MMA(1, 0, At, B0); PG8_MMA(1, 1, At, B1); PG8_BAR; PG8_SCHED;
            } else {
            PG8_LDB(B0, 0, 0); PG8_SCHED; PG8_LDA(At, 0, 0); PG8_STAGE(PG8_SA(1, 1), a1 + hstep, voffA);
            PG8_WAIT_L(8); PG8_BAR; PG8_WAIT_L(0); PG8_MMA(0, 0, At, B0); PG8_BAR; PG8_SCHED;
            PG8_LDB(B1, 0, 1); PG8_STAGE(PG8_SB(0, 0), b2, voffB);
            PG8_BAR; PG8_WAIT_L(0); PG8_MMA(0, 1, At, B1); PG8_BAR;
            PG8_LDA(At, 0, 1); PG8_STAGE(PG8_SA(0, 0), a2, voffA);
            PG8_BAR; PG8_WAIT_L(0); PG8_MMA(1, 0, At, B0); PG8_BAR; PG8_SCHED;
            PG8_STAGE(PG8_SB(0, 1), b2 + hstep, voffB);
            PG8_WAIT_V(6); PG8_BAR; PG8_MMA(1, 1, At, B1); PG8_BAR;
            PG8_LDB(B0, 1, 0); PG8_SCHED; PG8_LDA(At, 1, 0); PG8_STAGE(PG8_SA(0, 1), a2 + hstep, voffA);
            PG8_WAIT_L(8); PG8_BAR; PG8_WAIT_L(0); PG8_MMA(0, 0, At, B0); PG8_BAR; PG8_SCHED;
            PG8_LDB(B1, 1, 1); PG8_STAGE(PG8_SB(1, 0), b3, voffB);
            PG8_BAR; PG8_WAIT_L(0); PG8_MMA(0, 1, At, B1); PG8_BAR;
            PG8_LDA(At, 1, 1); PG8_STAGE(PG8_SA(1, 0), a3, voffA);
            PG8_BAR; PG8_WAIT_L(0); PG8_MMA(1, 0, At, B0); PG8_BAR; PG8_SCHED;
            PG8_STAGE(PG8_SB(1, 1), b3 + hstep, voffB);
            PG8_WAIT_V(6); PG8_BAR; PG8_MMA(1, 1, At, B1); PG8_BAR;
            }
        }
        if constexpr (ALIGN_EPI) { if (wr == 0) PG8_BAR; }
        if constexpr (!Epi::AFTER_DRAIN) { E(acc, cur, wr, wc, fr, fq); S.done(cur); }
        if (!has_next) break;
#pragma unroll
        for (int a = 0; a < 2; ++a)
#pragma unroll
            for (int b = 0; b < 2; ++b)
#pragma unroll
                for (int m = 0; m < 4; ++m)
#pragma unroll
                    for (int n = 0; n < 2; ++n) acc[a][b][m][n] = (f32x4){0.f, 0.f, 0.f, 0.f};
        cur = nxt; cA = nA; cB = nB; ++ui;
        if constexpr (ALIGN_EPI) { if (wr == 1) PG8_BAR; }
    }
    PG8_WAIT_V(0);
    if constexpr (!ALIGN_EPI) { if (wr == 0) PG8_BAR; }
    PG8_BAR;
    if constexpr (Epi::AFTER_DRAIN) { E.fused(acc, cur, wr, wc, fr, fq, lds, wid, lane); S.done(cur); }
#undef PG8_SA
#undef PG8_SB
#undef PG8_STAGE
#undef PG8_LDA
#undef PG8_LDB
#undef PG8_MMA
#undef PG8_WAIT_V
#undef PG8_WAIT_L
#undef PG8_BAR
#undef PG8_SCHED
}
}
constexpr int NWAVES = 8, NTHR = 512;
constexpr int BATCH = 8, SEQ = 4096, DM = 1024, CTXL = 256, DEPTH = 4;
constexpr int MLAT = BATCH * SEQ, MCTX = BATCH * CTXL, MTOT = MLAT + MCTX;
constexpr int NP_EVEN = 3584, NPAD_EVEN = 3840, NORIG_EVEN = 3616;
constexpr int NP_ODD = 2816, NPAD_ODD = 3072, NORIG_ODD = 2832;
constexpr int NCHUNK = 68;
constexpr int NSLOT = BATCH * 4 * 2 * NCHUNK;
constexpr float ALPHA_DN = 1.681792830507429f;
constexpr size_t MiB = 1u << 20;
constexpr size_t WS_MOD = 0;
constexpr size_t WS_BAR = 512 * 1024;
constexpr size_t WS_ROPE = 1 * MiB;
constexpr size_t WS_SC = WS_ROPE + 65536;
constexpr size_t WS_GAM = 2 * MiB;
constexpr size_t WS_SM = 4 * MiB;
constexpr size_t WS_WIE = 9 * MiB;
constexpr size_t WS_WIO = 24 * MiB;
constexpr size_t WS_WO = 36 * MiB;
constexpr size_t WS_XC = 44 * MiB;
constexpr size_t WS_H = 52 * MiB;
constexpr size_t WS_P = 120 * MiB;
constexpr size_t WS_S = 359 * MiB;
constexpr size_t WS_X16 = 427 * MiB;
constexpr size_t WS_END = WS_X16 + (size_t)MTOT * 1024 * 2;
static_assert(WS_S + (size_t)NSLOT * 8192 * 2 <= WS_X16, "ws map 4");
static_assert(WS_SC + (size_t)NSLOT * 16 <= WS_GAM && WS_GAM + (size_t)NSLOT * 256 <= WS_SM && WS_SM + (size_t)MTOT * 128 <= WS_WIE, "ws map 1");
static_assert(WS_WIE + (size_t)2 * NPAD_EVEN * 1024 * 2 <= WS_WIO && WS_WIO + (size_t)2 * NPAD_ODD * 1024 * 2 <= WS_WO && WS_WO + (size_t)4 * 1024 * 1024 * 2 <= WS_XC, "ws map 2");
static_assert(WS_XC + (size_t)MCTX * 1024 * 4 <= WS_H && WS_H + (size_t)MTOT * 1024 * 2 <= WS_P && WS_P + (size_t)MTOT * NP_EVEN * 2 <= WS_S && WS_END <= 512 * MiB, "ws map 3");
constexpr int LDS_BYTES = 147456;

#define LAS __attribute__((address_space(3)))
typedef unsigned short bf16;
typedef float f32x4 __attribute__((ext_vector_type(4)));
typedef short bf16x8 __attribute__((ext_vector_type(8)));
typedef short s16x4 __attribute__((ext_vector_type(4)));
typedef unsigned u32x4 __attribute__((ext_vector_type(4)));
typedef unsigned u32x2 __attribute__((ext_vector_type(2)));
#define LDS_WAIT() asm volatile("s_waitcnt lgkmcnt(0)" ::: "memory")

typedef __bf16 hbf2 __attribute__((ext_vector_type(2)));
typedef float f32x2_ __attribute__((ext_vector_type(2)));
__device__ __forceinline__ unsigned f2bf(float f) { const __bf16 b = (__bf16)f; return (unsigned)__builtin_bit_cast(unsigned short, b); }
__device__ __forceinline__ unsigned pk2(float lo, float hi) { const f32x2_ v = {lo, hi}; const hbf2 b = __builtin_convertvector(v, hbf2); return __builtin_bit_cast(unsigned, b); }
__device__ __forceinline__ float bf2f(unsigned short v) { return __builtin_bit_cast(float, (unsigned)v << 16); }
__device__ __forceinline__ float bflo(unsigned w) { return __builtin_bit_cast(float, w << 16); }
__device__ __forceinline__ float bfhi(unsigned w) { return __builtin_bit_cast(float, w & 0xffff0000u); }
__device__ __forceinline__ float siluf(float x) { return x * __builtin_amdgcn_rcpf(1.f + __expf(-x)); }
__device__ __forceinline__ float logsigf(float z) { return fminf(z, 0.f) - 0.69314718056f * __builtin_amdgcn_logf(1.f + __builtin_amdgcn_exp2f(-1.44269504089f * fabsf(z))); }
__device__ __forceinline__ float rdlane(float v, int l) { return __builtin_bit_cast(float, __builtin_amdgcn_readlane(__builtin_bit_cast(int, v), l)); }
template <int N> __device__ __forceinline__ float dpp_ror(float v) { return __builtin_bit_cast(float, __builtin_amdgcn_update_dpp(0, __builtin_bit_cast(int, v), 0x120 + N, 0xf, 0xf, false)); }
__device__ __forceinline__ float red16_max(float v) { v = fmaxf(v, dpp_ror<1>(v)); v = fmaxf(v, dpp_ror<2>(v)); v = fmaxf(v, dpp_ror<4>(v)); v = fmaxf(v, dpp_ror<8>(v)); return v; }
__device__ __forceinline__ float red16_sum(float v) { v += dpp_ror<1>(v); v += dpp_ror<2>(v); v += dpp_ror<4>(v); v += dpp_ror<8>(v); return v; }
__device__ __forceinline__ float wave_sum(float v) { v = red16_sum(v); return (rdlane(v, 0) + rdlane(v, 16)) + (rdlane(v, 32) + rdlane(v, 48)); }
__device__ __forceinline__ float wave_max(float v) { v = red16_max(v); return fmaxf(fmaxf(rdlane(v, 0), rdlane(v, 16)), fmaxf(rdlane(v, 32), rdlane(v, 48))); }
template <int N, bool REV> __device__ __forceinline__ float dpp_rshift(float v, float ident) {
    return __builtin_bit_cast(float, __builtin_amdgcn_update_dpp(__builtin_bit_cast(int, ident), __builtin_bit_cast(int, v), (REV ? 0x100 : 0x110) + N, 0xf, 0xf, false));
}
template <bool REV> __device__ __forceinline__ float wave_scan_sum_t(float v, int lane) {
    v += dpp_rshift<1, REV>(v, 0.f); v += dpp_rshift<2, REV>(v, 0.f); v += dpp_rshift<4, REV>(v, 0.f); v += dpp_rshift<8, REV>(v, 0.f);
    const int row = lane >> 4;
    if (!REV) { const float t0 = rdlane(v, 15), t1 = rdlane(v, 31), t2 = rdlane(v, 47);
        v += row == 1 ? t0 : row == 2 ? t0 + t1 : row == 3 ? t0 + t1 + t2 : 0.f; }
    else { const float t1 = rdlane(v, 16), t2 = rdlane(v, 32), t3 = rdlane(v, 48);
        v += row == 2 ? t3 : row == 1 ? t3 + t2 : row == 0 ? t3 + t2 + t1 : 0.f; }
    return v;
}
template <bool REV> __device__ __forceinline__ float wave_scan_max_t(float v, int lane) {
    v = fmaxf(v, dpp_rshift<1, REV>(v, -3e38f)); v = fmaxf(v, dpp_rshift<2, REV>(v, -3e38f)); v = fmaxf(v, dpp_rshift<4, REV>(v, -3e38f)); v = fmaxf(v, dpp_rshift<8, REV>(v, -3e38f));
    const int row = lane >> 4;
    if (!REV) { const float t0 = rdlane(v, 15), t1 = rdlane(v, 31), t2 = rdlane(v, 47);
        v = fmaxf(v, row == 1 ? t0 : row == 2 ? fmaxf(t0, t1) : row == 3 ? fmaxf(fmaxf(t0, t1), t2) : -3e38f); }
    else { const float t1 = rdlane(v, 16), t2 = rdlane(v, 32), t3 = rdlane(v, 48);
        v = fmaxf(v, row == 2 ? t3 : row == 1 ? fmaxf(t3, t2) : row == 0 ? fmaxf(fmaxf(t3, t2), t1) : -3e38f); }
    return v;
}
template <int N, bool REV> __device__ __forceinline__ float dpp_rshift0(float v) {
    return __builtin_bit_cast(float, __builtin_amdgcn_update_dpp(0, __builtin_bit_cast(int, v), (REV ? 0x100 : 0x110) + N, 0xf, 0xf, true));
}
template <int N, bool REV, bool MAX> __device__ __forceinline__ float scan_step(float v, int li) {
    const float t = dpp_rshift0<N, REV>(v); const bool ok = REV ? (li + N < 16) : (li >= N);
    return MAX ? (ok ? fmaxf(v, t) : v) : (ok ? v + t : v);
}
template <bool REV, bool MAX> __device__ __forceinline__ float wave_scan_t(float v, int lane) {
    const int li = lane & 15, row = lane >> 4;
    v = scan_step<1, REV, MAX>(v, li); v = scan_step<2, REV, MAX>(v, li); v = scan_step<4, REV, MAX>(v, li); v = scan_step<8, REV, MAX>(v, li);
    const float a0 = rdlane(v, REV ? 48 : 15), a1 = rdlane(v, REV ? 32 : 31), a2 = rdlane(v, REV ? 16 : 47);
    const int k = REV ? 3 - row : row;
    if (MAX) { float e = v; if (k >= 1) e = fmaxf(e, a0); if (k >= 2) e = fmaxf(e, a1); if (k >= 3) e = fmaxf(e, a2); return e; }
    float e = v; if (k >= 1) e += a0; if (k >= 2) e += a1; if (k >= 3) e += a2; return e;
}
__device__ __forceinline__ float wave_scan_sum(float v, int lane, bool rev) { return rev ? wave_scan_t<true, false>(v, lane) : wave_scan_t<false, false>(v, lane); }
__device__ __forceinline__ float wave_scan_max(float v, int lane, bool rev) { return rev ? wave_scan_t<true, true>(v, lane) : wave_scan_t<false, true>(v, lane); }
#define MFMA(a, b, c) __builtin_amdgcn_mfma_f32_16x16x32_bf16((a), (b), (c), 0, 0, 0)
__device__ __forceinline__ bf16x8 frag_rm(const LAS bf16* X, int ld, int row0, int k0, int lane) {
    return *(const LAS bf16x8*)(X + (row0 + (lane & 15)) * ld + k0 + 8 * (lane >> 4));
}
__device__ __forceinline__ bf16x8 frag_tr(const LAS bf16* X, int ld, int k0, int n0, int lane) {
    const int g = lane >> 4, m = lane & 15, q = m >> 2, p = m & 3;
    const LAS bf16* a0 = X + (k0 + 8 * g + q) * ld + n0 + 4 * p;
    const s16x4 lo = __builtin_amdgcn_ds_read_tr16_b64_v4i16((LAS s16x4*)a0);
    const s16x4 hi = __builtin_amdgcn_ds_read_tr16_b64_v4i16((LAS s16x4*)(a0 + 4 * ld));
    bf16x8 r; r[0] = lo[0]; r[1] = lo[1]; r[2] = lo[2]; r[3] = lo[3]; r[4] = hi[0]; r[5] = hi[1]; r[6] = hi[2]; r[7] = hi[3]; return r;
}

struct Params {
    const float *x, *c, *ctx, *c_ctx, *w_ada, *b_ada, *ln_g, *ln_b, *w_in_even, *w_out_even, *gla_gate_w, *gla_gate_b, *gla_norm_g, *na_rpb, *w_in_odd, *w_out_odd, *ml_gate_b, *ml_norm_g, *sw_sink;
    float* out; unsigned char* ws; long long ph_lo, ph_hi;
};
typedef const __attribute__((address_space(4))) Params* KP;
__device__ __forceinline__ KP kparams() { unsigned long long v = (unsigned long long)__builtin_amdgcn_kernarg_segment_ptr(); asm volatile("" : "+s"(v)); return (KP)v; }

__device__ __forceinline__ int orig_col(int type, int n) {
    if (type == 0) { if (n < 1536) return n; if (n < 3584) return n + 32; if (n < 3616) return n - 3584 + 1536; return -1; }
    if (type == 1) { if (n < 1536) return n; if (n < 2816) return n + 16; if (n < 2832) return n - 2816 + 1536; return -1; }
    return n;
}
__device__ __forceinline__ float col_scale(int type, int n) {
    if (type == 0) return (n < 256 || (n >= 1536 && n < 2048)) ? 0.125f : 1.f;
    if (type == 1) return ((n >= 256 && n < 512) || (n >= 1536 && n < 2048)) ? 0.125f : 1.f;
    return 1.f;
}
__device__ __forceinline__ void p0_transpose_item(const float* __restrict__ W, int K, int Norig, int type, bf16* __restrict__ WT, LAS float* scr, int nblk, int item, int lane) {
    const int kb = item / nblk, nb = item % nblk, k0 = 64 * kb, n0 = 32 * nb;
    const int oc = orig_col(type, n0 + (lane & 31)); const float sc = col_scale(type, n0 + (lane & 31));
#pragma unroll 8
    for (int i = 0; i < 32; ++i) { const int kk = 2 * i + (lane >> 5); scr[kk * 33 + (lane & 31)] = oc >= 0 ? W[(size_t)(k0 + kk) * Norig + oc] * sc : 0.f; }
    LDS_WAIT();
    const int c = lane & 7;
#pragma unroll
    for (int j = 0; j < 4; ++j) { const int n = (lane >> 3) + 8 * j; const LAS float* s = scr + (8 * c) * 33 + n;
        u32x4 o; o.x = pk2(s[0 * 33], s[1 * 33]); o.y = pk2(s[2 * 33], s[3 * 33]); o.z = pk2(s[4 * 33], s[5 * 33]); o.w = pk2(s[6 * 33], s[7 * 33]);
        *(u32x4*)(WT + (size_t)(n0 + n) * K + k0 + 8 * c) = o; }
    LDS_WAIT();
}
__device__ __forceinline__ void phase_prologue(KP p, LAS unsigned char* lds) {
    const int tid = otid(), lane = tid & 63, wave = tid >> 6;
    unsigned char* ws = p->ws;
    float* MOD = (float*)(ws + WS_MOD);
    if ((int)blockIdx.x < 192) {
        LAS float* cond = (LAS float*)lds;
        LAS float* red = (LAS float*)(lds + 36864);
        for (int e = tid; e < 9 * 1024; e += NTHR) { const int j = e >> 10, k = e & 1023; const float v = j < 8 ? p->c[j * 1024 + k] : p->c_ctx[k]; cond[e] = siluf(v); }
        __syncthreads();
        for (int it = blockIdx.x; it < 192; it += gridDim.x) {
            const int l = it / 48, n0 = (it % 48) * 64, cq = tid & 15, ks = tid >> 4;
            float acc[9][4];
#pragma unroll
            for (int j = 0; j < 9; ++j) { acc[j][0] = 0.f; acc[j][1] = 0.f; acc[j][2] = 0.f; acc[j][3] = 0.f; }
            const float* wp = p->w_ada + (size_t)l * 1024 * 3072 + (size_t)(ks * 32) * 3072 + n0 + 4 * cq;
#pragma unroll 4
            for (int kk = 0; kk < 32; ++kk) { const f32x4 w = *(const f32x4*)(wp + (size_t)kk * 3072);
#pragma unroll
                for (int j = 0; j < 9; ++j) { const float cv = cond[j * 1024 + ks * 32 + kk]; acc[j][0] += cv * w[0]; acc[j][1] += cv * w[1]; acc[j][2] += cv * w[2]; acc[j][3] += cv * w[3]; } }
#pragma unroll
            for (int j = 0; j < 9; ++j)
#pragma unroll
                for (int i = 0; i < 4; ++i) red[ks * 576 + j * 64 + 4 * cq + i] = acc[j][i];
            __syncthreads();
            for (int o = tid; o < 576; o += NTHR) { float s = 0.f; for (int q = 0; q < 32; ++q) s += red[q * 576 + o]; const int j = o >> 6, n = n0 + (o & 63);
                MOD[(size_t)(l * 9 + j) * 3072 + n] = s + p->b_ada[l * 3072 + n]; }
            __syncthreads();
        }
    }
    if (blockIdx.x == gridDim.x - 1) {
        float* cosT = (float*)(ws + WS_ROPE); float* sinT = cosT + 1024;
        for (int e = tid; e < 1024; e += NTHR) { const int pos = e >> 4, i = e & 15;
            double f = 1.0; for (int q = 0; q < i; ++q) f *= 0.5623413251903491;
            const double f2 = f * f; double sn = 1.0, cs = 1.0;
            for (int q = 12; q >= 1; --q) { sn = 1.0 - f2 / ((2.0 * q) * (2.0 * q + 1.0)) * sn; cs = 1.0 - f2 / ((2.0 * q - 1.0) * (2.0 * q)) * cs; }
            sn *= f;
            double c = 1.0, s = 0.0; for (int q = 0; q < pos; ++q) { const double c2 = c * cs - s * sn, s2 = s * cs + c * sn; c = c2; s = s2; }
            cosT[e] = (float)c; sinT[e] = (float)s; }
    }
    __syncthreads();
    {
        LAS float* scr = (LAS float*)(lds + wave * 16384);
        const int gw = blockIdx.x * NWAVES + wave, NGW = gridDim.x * NWAVES;
        constexpr int I_E = 16 * (NPAD_EVEN / 32), I_O = 16 * (NPAD_ODD / 32), I_W = 16 * 32;
        constexpr int NIT = 2 * I_E + 2 * I_O + 4 * I_W;
        for (int it = gw; it < NIT; it += NGW) {
            int r = it;
            if (r < 2 * I_E) { const int i = r / I_E; r -= i * I_E; p0_transpose_item(p->w_in_even + (size_t)i * 1024 * NORIG_EVEN, 1024, NORIG_EVEN, 0, (bf16*)(ws + WS_WIE) + (size_t)i * NPAD_EVEN * 1024, scr, NPAD_EVEN / 32, r, lane); continue; }
            r -= 2 * I_E;
            if (r < 2 * I_O) { const int i = r / I_O; r -= i * I_O; p0_transpose_item(p->w_in_odd + (size_t)i * 1024 * NORIG_ODD, 1024, NORIG_ODD, 1, (bf16*)(ws + WS_WIO) + (size_t)i * NPAD_ODD * 1024, scr, NPAD_ODD / 32, r, lane); continue; }
            r -= 2 * I_O;
            { const int l = r / I_W; r -= l * I_W; const float* W = (l & 1) ? p->w_out_odd + (size_t)(l >> 1) * 1024 * 1024 : p->w_out_even + (size_t)(l >> 1) * 1024 * 1024;
              p0_transpose_item(W, 1024, 1024, 2, (bf16*)(ws + WS_WO) + (size_t)l * 1024 * 1024, scr, 32, r, lane); }
        }
    }
}
__device__ __forceinline__ void phase_h0(KP p) {
    const int lane = otid() & 63, gw = blockIdx.x * NWAVES + (otid() >> 6), NGW = gridDim.x * NWAVES;
    const float* MOD = (const float*)(p->ws + WS_MOD); bf16* H = (bf16*)(p->ws + WS_H);
    for (int m = gw; m < MTOT; m += NGW) {
        const int jb = m < MLAT ? (m >> 12) : 8;
        const float* src = m < MLAT ? p->x + (size_t)m * DM : p->ctx + (size_t)(m - MLAT) * DM;
        const float* md = MOD + (size_t)jb * 3072;
#pragma unroll
        for (int j = 0; j < 4; ++j) { const int k = 4 * lane + 256 * j; const f32x4 v = *(const f32x4*)(src + k), sh = *(const f32x4*)(md + k), sc = *(const f32x4*)(md + 1024 + k);
            const f32x4 h = v * (sc + 1.0f) + sh; u32x2 o; o.x = pk2(h[0], h[1]); o.y = pk2(h[2], h[3]); *(u32x2*)(H + (size_t)m * DM + k) = o; }
    }
}
typedef _Float16 f16x4 __attribute__((ext_vector_type(4)));
struct LnRaw { f32x4 xf[2][4]; f16x4 xh[2][4]; u32x2 y[2][4]; };
__device__ __forceinline__ void ln_load(LnRaw& R, int l, int m0, int lane, const float* xin, const float* cin, const _Float16* X16, const bf16* Y) {
#pragma unroll
    for (int j = 0; j < 4; ++j) { const int k = 4 * lane + 256 * j;
#pragma unroll
        for (int q = 0; q < 2; ++q) { const int m = m0 + q;
            if (l == 0) R.xf[q][j] = *(const f32x4*)((m < MLAT ? xin + (size_t)m * DM : cin + (size_t)(m - MLAT) * DM) + k);
            else R.xh[q][j] = *(const f16x4*)(X16 + (size_t)m * DM + k);
            R.y[q][j] = *(const u32x2*)(Y + (size_t)m * DM + k); } }
}
__device__ __forceinline__ void phase_ln(KP p, int l, bool dummy = false) {
    const int lane = otid() & 63, gw = blockIdx.x * NWAVES + (otid() >> 6), NGW = gridDim.x * NWAVES;
    const float* MOD = (const float*)(p->ws + WS_MOD); bf16* H = (bf16*)(p->ws + WS_H); const bf16* Y = (const bf16*)(p->ws + WS_P); _Float16* X16 = (_Float16*)(p->ws + WS_X16);
    const int mrows = l < DEPTH - 1 ? MTOT : MLAT;
    const float* lg = p->ln_g + l * DM; const float* lb = p->ln_b + l * DM;
    const float* xin = p->x; const float* cin = p->ctx; float* outp = p->out;
    LnRaw R;
    if (2 * gw < mrows) ln_load(R, l, 2 * gw, lane, xin, cin, X16, Y);
    for (int m0 = 2 * gw; m0 < mrows; m0 += 2 * NGW) {
        const int jb = m0 < MLAT ? (m0 >> 12) : 8;
        const float* md = MOD + (size_t)(l * 9 + jb) * 3072;
        f32x4 v[2][4], xs[2][4]; float s[2] = {0.f, 0.f};
#pragma unroll
        for (int j = 0; j < 4; ++j) { const int k = 4 * lane + 256 * j; const f32x4 g = *(const f32x4*)(md + 2048 + k);
#pragma unroll
            for (int q = 0; q < 2; ++q) { const f32x4 xv = l == 0 ? R.xf[q][j] : __builtin_convertvector(R.xh[q][j], f32x4); const u32x2 yw = R.y[q][j];
                f32x4 y; y[0] = bflo(yw.x); y[1] = bfhi(yw.x); y[2] = bflo(yw.y); y[3] = bfhi(yw.y);
                xs[q][j] = xv; v[q][j] = xv * ALPHA_DN + g * y; s[q] += (v[q][j][0] + v[q][j][1]) + (v[q][j][2] + v[q][j][3]); } }
        if (m0 + 2 * NGW < mrows) ln_load(R, l, m0 + 2 * NGW, lane, xin, cin, X16, Y);
        float rstd[2];
#pragma unroll
        for (int q = 0; q < 2; ++q) { const float mean = wave_sum(s[q]) * (1.f / DM); float s2 = 0.f;
#pragma unroll
            for (int j = 0; j < 4; ++j) { v[q][j] = v[q][j] - mean; s2 += (v[q][j][0] * v[q][j][0] + v[q][j][1] * v[q][j][1]) + (v[q][j][2] * v[q][j][2] + v[q][j][3] * v[q][j][3]); }
            rstd[q] = 1.f / sqrtf(wave_sum(s2) * (1.f / DM) + 1e-5f); }
        const float* md2 = MOD + (size_t)((l + 1) * 9 + jb) * 3072;
#pragma unroll
        for (int j = 0; j < 4; ++j) { const int k = 4 * lane + 256 * j; const f32x4 gg = *(const f32x4*)(lg + k), bb = *(const f32x4*)(lb + k);
            f32x4 sh = (f32x4){0.f, 0.f, 0.f, 0.f}, sc = sh; if (l < DEPTH - 1) { sh = *(const f32x4*)(md2 + k); sc = *(const f32x4*)(md2 + 1024 + k); }
#pragma unroll
            for (int q = 0; q < 2; ++q) { const int m = m0 + q; const f32x4 o = v[q][j] * rstd[q] * gg + bb;
                if (l < DEPTH - 1) { *(f16x4*)(X16 + (size_t)m * DM + k) = __builtin_convertvector(dummy ? xs[q][j] : o, f16x4);
                    const f32x4 h = o * (sc + 1.0f) + sh; u32x2 w; w.x = pk2(h[0], h[1]); w.y = pk2(h[2], h[3]); *(u32x2*)(H + (size_t)m * DM + k) = w; }
                else { if (!dummy) *(f32x4*)(outp + (size_t)m * DM + k) = o; } } }
    }
}
constexpr int AT_KS = 0, AT_VS = 9216, AT_BUF = 18432, AT_PS = 36864, AT_RPB = AT_PS + 8 * 2304;
__device__ __forceinline__ bf16x8 frag_tr_perm(const LAS bf16* X, int ld, int k0, int n0, int lane) {
    const int g = lane >> 4, m = lane & 15, q = m >> 2, p = m & 3;
    const LAS bf16* a0 = X + (k0 + 4 * g + q) * ld + n0 + 4 * p;
    const s16x4 lo = __builtin_amdgcn_ds_read_tr16_b64_v4i16((LAS s16x4*)a0);
    const s16x4 hi = __builtin_amdgcn_ds_read_tr16_b64_v4i16((LAS s16x4*)(a0 + 16 * ld));
    bf16x8 r; r[0] = lo[0]; r[1] = lo[1]; r[2] = lo[2]; r[3] = lo[3]; r[4] = hi[0]; r[5] = hi[1]; r[6] = hi[2]; r[7] = hi[3]; return r;
}
__device__ __forceinline__ void attn_tile(const LAS bf16* Ks, const LAS bf16* Vs, const LAS float* rpb, const bf16x8 (&qa)[2][2], float (&mrow)[2], float (&lsum)[2], f32x4 (&oacc)[2][4],
                                          int mode, int i, int nlat, int qa_, int qb_, int ka_, int lane) {
    const int fq = lane >> 4, fr = lane & 15;
    const bool islat = i < nlat;
    bool active = true; int kt0 = 0;
    if (islat) {
        if (mode == 0) { kt0 = ka_ + i; const int rs = min(max(qa_ - 4, 0), 56); active = (kt0 >= rs) && (kt0 < rs + 8); }
        else { kt0 = ka_ + 64 * i; active = !(kt0 > qa_ + 31 + 128 || kt0 + 63 < qa_ - 128); }
    }
    if (!active) return;
    const bool nar = islat && mode == 0;
    const int ct0 = qb_ >> 4;
    int ntlo[2], nthi[2];
#pragma unroll
    for (int nq = 0; nq < 2; ++nq) { const int ct = ct0 + nq; ntlo[nq] = nar ? (ct < 2 ? 0 : ct - 1) : 0; nthi[nq] = nar ? (ct > 1 ? 3 : ct + 1) : 3; }
    const int ulo = min(ntlo[0], ntlo[1]), uhi = max(nthi[0], nthi[1]);
    f32x4 s[2][4];
#pragma unroll
    for (int mt = 0; mt < 4; ++mt) { s[0][mt] = (f32x4){0.f, 0.f, 0.f, 0.f}; s[1][mt] = (f32x4){0.f, 0.f, 0.f, 0.f};
        if (mt >= ulo && mt <= uhi) {
#pragma unroll
            for (int ks = 0; ks < 2; ++ks) { const bf16x8 kf = frag_rm(Ks, 72, 16 * mt, 32 * ks, lane);
                if (mt >= ntlo[0] && mt <= nthi[0]) s[0][mt] = MFMA(kf, qa[0][ks], s[0][mt]);
                if (mt >= ntlo[1] && mt <= nthi[1]) s[1][mt] = MFMA(kf, qa[1][ks], s[1][mt]); } } }
    unsigned pw[2][8];
    const bool swa_mask = islat && mode == 1 && !((qa_ + 31 - kt0 <= 128) && (qa_ - kt0 - 63 >= -128));
    constexpr float L2E = 1.44269504089f;
#pragma unroll
    for (int nq = 0; nq < 2; ++nq) {
        float tmax = -3e38f;
        if (nar) {
            const int qc = qb_ + 16 * nq + fr, cs = min(max(qc - 8, 0), 48);
            const unsigned long long ml = (0xFFFFull << cs) >> (4 * fq);
            const unsigned mlo = (unsigned)ml, mhi = (unsigned)(ml >> 32);
            const LAS float* bp = rpb + (kt0 - qa_ + 7) * 31 + (4 * fq - qc + 15);
#pragma unroll
            for (int mt = 0; mt < 4; ++mt) { if (mt >= ntlo[nq] && mt <= nthi[nq]) {
#pragma unroll
                for (int r = 0; r < 4; ++r) { const int pbit = 16 * mt + r; const bool ok = ((pbit < 32 ? mlo >> pbit : mhi >> (pbit - 32)) & 1u) != 0u;
                    const float v = ok ? s[nq][mt][r] + bp[ok ? pbit : 0] : -3e38f; s[nq][mt][r] = v; tmax = fmaxf(tmax, v); } } }
        } else if (swa_mask) {
            const int d0 = (qa_ + 16 * nq + fr) - (kt0 + 4 * fq);
#pragma unroll
            for (int mt = 0; mt < 4; ++mt)
#pragma unroll
                for (int r = 0; r < 4; ++r) { const int d = d0 - (16 * mt + r); const float v = (d <= 128 && d >= -128) ? s[nq][mt][r] : -3e38f; s[nq][mt][r] = v; tmax = fmaxf(tmax, v); }
        } else {
#pragma unroll
            for (int mt = 0; mt < 4; ++mt)
#pragma unroll
                for (int r = 0; r < 4; ++r) tmax = fmaxf(tmax, s[nq][mt][r]);
        }
        tmax = fmaxf(tmax, __shfl_xor(tmax, 16)); tmax = fmaxf(tmax, __shfl_xor(tmax, 32));
        const float mnew = fmaxf(mrow[nq], tmax); const float alpha = __builtin_amdgcn_exp2f((mrow[nq] - mnew) * L2E); mrow[nq] = mnew;
        const float nm = -mnew * L2E;
        float ps = 0.f;
#pragma unroll
        for (int mt = 0; mt < 4; ++mt) { float p0 = 0.f, p1 = 0.f, p2 = 0.f, p3 = 0.f;
            if (mt >= ntlo[nq] && mt <= nthi[nq]) { p0 = __builtin_amdgcn_exp2f(__builtin_fmaf(s[nq][mt][0], L2E, nm)); p1 = __builtin_amdgcn_exp2f(__builtin_fmaf(s[nq][mt][1], L2E, nm));
                p2 = __builtin_amdgcn_exp2f(__builtin_fmaf(s[nq][mt][2], L2E, nm)); p3 = __builtin_amdgcn_exp2f(__builtin_fmaf(s[nq][mt][3], L2E, nm)); ps += (p0 + p1) + (p2 + p3); }
            pw[nq][2 * mt] = pk2(p0, p1); pw[nq][2 * mt + 1] = pk2(p2, p3); oacc[nq][mt] = oacc[nq][mt] * alpha; }
        lsum[nq] = lsum[nq] * alpha + ps;
    }
#pragma unroll
    for (int ks = 0; ks < 2; ++ks) { if (ks == 0 ? (ulo < 2) : (uhi > 1)) {
        const u32x4 pu0 = (u32x4){pw[0][4 * ks], pw[0][4 * ks + 1], pw[0][4 * ks + 2], pw[0][4 * ks + 3]}, pu1 = (u32x4){pw[1][4 * ks], pw[1][4 * ks + 1], pw[1][4 * ks + 2], pw[1][4 * ks + 3]};
        const bf16x8 pb0 = __builtin_bit_cast(bf16x8, pu0), pb1 = __builtin_bit_cast(bf16x8, pu1);
#pragma unroll
        for (int mt = 0; mt < 4; ++mt) { const bf16x8 vf = frag_tr_perm(Vs, 72, 32 * ks, 16 * mt, lane); oacc[0][mt] = MFMA(vf, pb0, oacc[0][mt]); oacc[1][mt] = MFMA(vf, pb1, oacc[1][mt]); } } }
}
constexpr int AT_PSW = 32 * 72 * 2;
constexpr int AT_RPB2 = AT_PS + 8 * AT_PSW;
__device__ __forceinline__ void attn_item(LAS unsigned char* lds, const bf16* __restrict__ P, int ldp, bf16* __restrict__ Z, int mode,
                                          int qrow0, int qcol, int kcol, int vcol, int gcol, int zcol,
                                          int nlat, int lat_row0, int ctx_row0, int qa_, int qb_, int ka_, const float* __restrict__ rpb_g, float sink) {
    const int tid = otid(), lane = tid & 63, wave = tid >> 6, fq = lane >> 4, fr = lane & 15;
    LAS bf16* Ks0 = (LAS bf16*)(lds + AT_KS); LAS bf16* Vs0 = (LAS bf16*)(lds + AT_VS); LAS bf16* Ks1 = (LAS bf16*)(lds + AT_KS + AT_BUF); LAS bf16* Vs1 = (LAS bf16*)(lds + AT_VS + AT_BUF);
    LAS bf16* Ps = (LAS bf16*)(lds + AT_PS + wave * AT_PSW); LAS float* rpb = (LAS float*)(lds + AT_RPB2);
    const int ntile = nlat + 4, srow = tid >> 3, sch = tid & 7, soff = srow * 72 + 8 * sch;
#define AT_ROWB(j) (((j) < nlat) ? lat_row0 + 64 * (j) : ctx_row0 + 64 * ((j) - nlat))
#define AT_LOAD(kr, vr, j) do { const size_t ro_ = (size_t)(AT_ROWB(j) + srow) * ldp + 8 * sch; kr = *(const u32x4*)(P + ro_ + kcol); vr = *(const u32x4*)(P + ro_ + vcol); } while (0)
    u32x4 k0, v0, k1, v1;
    AT_LOAD(k0, v0, 0);
    bf16x8 qa[2][2];
#pragma unroll
    for (int nq = 0; nq < 2; ++nq)
#pragma unroll
        for (int ks = 0; ks < 2; ++ks) qa[nq][ks] = *(const bf16x8*)(P + (size_t)(qrow0 + 16 * nq + fr) * ldp + qcol + 32 * ks + 8 * fq);
    __syncthreads();
    if (mode == 0) { for (int e = tid; e < 465; e += NTHR) rpb[e] = rpb_g[e]; }
    *(LAS u32x4*)(Ks0 + soff) = k0; *(LAS u32x4*)(Vs0 + soff) = v0;
    AT_LOAD(k0, v0, 1);
    AT_LOAD(k1, v1, 2);
    float mrow[2] = {-1e30f, -1e30f}, lsum[2] = {0.f, 0.f}; f32x4 oacc[2][4];
#pragma unroll
    for (int nq = 0; nq < 2; ++nq)
#pragma unroll
        for (int r = 0; r < 4; ++r) oacc[nq][r] = (f32x4){0.f, 0.f, 0.f, 0.f};
    __syncthreads();
    for (int i = 0; i < ntile; i += 2) {
        attn_tile(Ks0, Vs0, rpb, qa, mrow, lsum, oacc, mode, i, nlat, qa_, qb_, ka_, lane);
        if (i + 1 < ntile) { *(LAS u32x4*)(Ks1 + soff) = k0; *(LAS u32x4*)(Vs1 + soff) = v0; }
        if (i + 3 < ntile) AT_LOAD(k0, v0, i + 3);
        __syncthreads();
        if (i + 1 >= ntile) break;
        attn_tile(Ks1, Vs1, rpb, qa, mrow, lsum, oacc, mode, i + 1, nlat, qa_, qb_, ka_, lane);
        if (i + 2 < ntile) { *(LAS u32x4*)(Ks0 + soff) = k1; *(LAS u32x4*)(Vs0 + soff) = v1; }
        if (i + 4 < ntile) AT_LOAD(k1, v1, i + 4);
        __syncthreads();
    }
#undef AT_LOAD
#undef AT_ROWB
    u32x4 gvv[4];
#pragma unroll
    for (int c2 = 0; c2 < 4; ++c2) { const int idx = lane + 64 * c2, q = idx >> 3, ch = idx & 7; gvv[c2] = *(const u32x4*)(P + (size_t)(qrow0 + q) * ldp + gcol + 8 * ch); }
#pragma unroll
    for (int nq = 0; nq < 2; ++nq) { float lt = lsum[nq]; lt += __shfl_xor(lt, 16); lt += __shfl_xor(lt, 32); float sc;
      if (mode == 1 || mode == 3) { const float mf = fmaxf(mrow[nq], sink); const float al = __expf(mrow[nq] - mf); lt = lt * al + __expf(sink - mf); sc = al / lt; } else sc = 1.f / lt;
#pragma unroll
      for (int mt = 0; mt < 4; ++mt) { u32x2 w; w.x = pk2(oacc[nq][mt][0] * sc, oacc[nq][mt][1] * sc); w.y = pk2(oacc[nq][mt][2] * sc, oacc[nq][mt][3] * sc); *(LAS u32x2*)(Ps + (16 * nq + fr) * 72 + 16 * mt + 4 * fq) = w; } }
    LDS_WAIT();
#pragma unroll
    for (int c2 = 0; c2 < 4; ++c2) { const int idx = lane + 64 * c2, q = idx >> 3, ch = idx & 7;
        const u32x4 ov = *(const LAS u32x4*)(Ps + q * 72 + 8 * ch); const u32x4 gv = gvv[c2];
        u32x4 w;
        w.x = pk2(bflo(ov.x) * siluf(bflo(gv.x)), bfhi(ov.x) * siluf(bfhi(gv.x))); w.y = pk2(bflo(ov.y) * siluf(bflo(gv.y)), bfhi(ov.y) * siluf(bfhi(gv.y)));
        w.z = pk2(bflo(ov.z) * siluf(bflo(gv.z)), bfhi(ov.z) * siluf(bfhi(gv.z))); w.w = pk2(bflo(ov.w) * siluf(bflo(gv.w)), bfhi(ov.w) * siluf(bfhi(gv.w)));
        *(u32x4*)(Z + (size_t)(qrow0 + q) * DM + zcol + 8 * ch) = w; }
    LDS_WAIT();
}
__device__ __forceinline__ void phase_attn(KP p, LAS unsigned char* lds, int l, bool need_ctx) {
    const int wave = otid() >> 6; const bool odd = l & 1; const int li = l >> 1;
    const bf16* P = (const bf16*)(p->ws + WS_P); bf16* Z = (bf16*)(p->ws + WS_H); const int ldp = odd ? NP_ODD : NP_EVEN;
    const int nmain = BATCH * 8 * 16, nctx = need_ctx ? BATCH * 8 : 0;
    for (int it = blockIdx.x; it < nmain + nctx; it += gridDim.x) {
        if (it < nmain) {
            int itv = it;
            if (gridDim.x == 256) { const int rnd = it >> 8, bx = it & 255, xcd = bx & 7, slot = bx >> 3; itv = ((rnd * 16 + 2 * xcd + (slot >> 4)) << 4) + (slot & 15); }
            const int b = itv >> 7, h = (itv >> 4) & 7, qb = itv & 15;
            if (!odd) { const int r0 = 4 * qb, rw = r0 + (wave >> 1); const int rs0 = min(max(r0 - 4, 0), 56), rs3 = min(max(r0 + 3 - 4, 0), 56);
                attn_item(lds, P, ldp, Z, 0, b * SEQ + rw * 64 + 32 * (wave & 1), 1536 + h * 64, 2048 + h * 64, 2560 + h * 64, 3072 + h * 64, 512 + h * 64,
                          rs3 + 8 - rs0, b * SEQ + rs0 * 64, MLAT + b * CTXL, rw, 32 * (wave & 1), rs0, p->na_rpb + (size_t)(li * 8 + h) * 465, 0.f); }
            else {
                int itw = it; if (gridDim.x == 256) { const int rnd = it >> 8, bx = it & 255, xcd = bx & 7, slot = bx >> 3; itw = ((rnd * 8 + xcd) << 5) + slot; }
                const int bb = itw >> 7, kv = (itw >> 6) & 1, qb2 = itw & 63, hh = 4 * kv + (wave >> 1), w2 = wave & 1;
                const int t0 = 64 * qb2, lt0 = max(0, qb2 - 2), lt1 = min(63, qb2 + 2);
                attn_item(lds, P, ldp, Z, 1, bb * SEQ + t0 + 32 * w2, 1536 + hh * 64, 2048 + kv * 64, 2176 + kv * 64, 2304 + hh * 64, 512 + hh * 64,
                          lt1 - lt0 + 1, bb * SEQ + lt0 * 64, MLAT + bb * CTXL, t0 + 32 * w2, 0, lt0 * 64, nullptr, p->sw_sink[li * 8 + hh]); }
        } else {
            const int j = it - nmain, b = j >> 3, h = j & 7; const int q0 = MLAT + b * CTXL + 32 * wave;
            if (!odd) attn_item(lds, P, ldp, Z, 2, q0, 1536 + h * 64, 2048 + h * 64, 2560 + h * 64, 3072 + h * 64, 512 + h * 64, 0, 0, MLAT + b * CTXL, 0, 0, 0, nullptr, 0.f);
            else { const int kv = h >> 2; attn_item(lds, P, ldp, Z, 3, q0, 1536 + h * 64, 2048 + kv * 64, 2176 + kv * 64, 2304 + h * 64, 512 + h * 64, 0, 0, MLAT + b * CTXL, 0, 0, 0, nullptr, p->sw_sink[li * 8 + h]); }
        }
    }
}
__device__ __forceinline__ int chunk_row0(int b, int cp) { return cp < 4 ? MLAT + b * CTXL + cp * 64 : b * SEQ + (cp - 4) * 64; }
constexpr int SL_KDF = 0, SL_KDB = 9216, SL_VS = 18432, SL_SEG = 35840, SL_MISC = 39936;
__device__ __forceinline__ void phase_scan_local(KP p, LAS unsigned char* lds, int l) {
    const int tid = otid(), lane = tid & 63, wave = tid >> 6, fq = lane >> 4, fr = lane & 15; const bool odd = l & 1; const int li = l >> 1;
    const bf16* P = (const bf16*)(p->ws + WS_P); const int ldp = odd ? NP_ODD : NP_EVEN; const float* SM = (const float*)(p->ws + WS_SM);
    bf16* S = (bf16*)(p->ws + WS_S); float* GAM = (float*)(p->ws + WS_GAM); float* SC = (float*)(p->ws + WS_SC);
    LAS bf16* kdf = (LAS bf16*)(lds + SL_KDF); LAS bf16* kdb = (LAS bf16*)(lds + SL_KDB); LAS bf16* vs = (LAS bf16*)(lds + SL_VS);
    LAS float* seg = (LAS float*)(lds + SL_SEG); LAS float* misc = (LAS float*)(lds + SL_MISC);
    const int dk = tid & 63, sg = tid >> 6;
    for (int it = blockIdx.x; it < BATCH * 4 * NCHUNK; it += gridDim.x) {
        const int b = it / (4 * NCHUNK), h = (it / NCHUNK) & 3, cp = it % NCHUNK; const int row0 = chunk_row0(b, cp);
        const int slf = ((b * 4 + h) * 2 + 0) * NCHUNK + cp, slb = slf + NCHUNK;
        __syncthreads();
#pragma unroll
        for (int c2 = 0; c2 < 2; ++c2) { const int idx = tid + NTHR * c2, t = idx >> 4, ch = idx & 15; *(LAS u32x4*)(vs + t * 136 + 8 * ch) = *(const u32x4*)(P + (size_t)(row0 + t) * ldp + 512 + h * 128 + 8 * ch); }
        float kv[8];
#pragma unroll
        for (int tt = 0; tt < 8; ++tt) kv[tt] = bf2f(P[(size_t)(row0 + sg * 8 + tt) * ldp + 256 + h * 64 + dk]);
        if (!odd) {
            float gwf[16], gwb[16];
            const float* gw = p->gla_gate_w + (size_t)li * 2 * 16 * 256; const float* gb = p->gla_gate_b + (size_t)li * 2 * 256;
#pragma unroll
            for (int r = 0; r < 16; ++r) { gwf[r] = gw[r * 256 + h * 64 + dk]; gwb[r] = gw[(16 + r) * 256 + h * 64 + dk]; }
            const float gbf = gb[h * 64 + dk], gbb = gb[256 + h * 64 + dk];
            { const int t = tid >> 3, c4 = (tid & 7) * 4; *(LAS f32x4*)(misc + t * 32 + c4) = *(const f32x4*)(SM + (size_t)(row0 + t) * 32 + c4); }
            __syncthreads();
            float pf[8], sb[8];
            f32x4 L[2][8];
#pragma unroll
            for (int i = 0; i < 8; ++i) L[0][i] = *(const LAS f32x4*)(misc + (sg * 8) * 32 + 4 * i);
#pragma unroll
            for (int tt = 0; tt < 8; ++tt) {
                if (tt < 7) {
#pragma unroll
                    for (int i = 0; i < 8; ++i) L[(tt + 1) & 1][i] = *(const LAS f32x4*)(misc + (sg * 8 + tt + 1) * 32 + 4 * i); }
                float zf = gbf, zb = gbb, zf2 = 0.f, zb2 = 0.f;
#pragma unroll
                for (int i = 0; i < 4; i += 2)
#pragma unroll
                    for (int e = 0; e < 4; ++e) { zf += L[tt & 1][i][e] * gwf[4 * i + e]; zf2 += L[tt & 1][i + 1][e] * gwf[4 * i + 4 + e]; zb += L[tt & 1][4 + i][e] * gwb[4 * i + e]; zb2 += L[tt & 1][5 + i][e] * gwb[4 * i + 4 + e]; }
                pf[tt] = logsigf(zf + zf2) * 0.0625f; sb[tt] = logsigf(zb + zb2) * 0.0625f; }
#pragma unroll
            for (int tt = 1; tt < 8; ++tt) pf[tt] += pf[tt - 1];
#pragma unroll
            for (int tt = 6; tt >= 0; --tt) sb[tt] += sb[tt + 1];
            seg[(0 * 8 + sg) * 64 + dk] = pf[7]; seg[(1 * 8 + sg) * 64 + dk] = sb[0];
            __syncthreads();
            float offf = 0.f, totf = 0.f, offb = 0.f, totb = 0.f;
#pragma unroll
            for (int q = 0; q < 8; ++q) { const float a = seg[q * 64 + dk], c = seg[(8 + q) * 64 + dk]; totf += a; totb += c; if (q < sg) offf += a; if (q > sg) offb += c; }
#pragma unroll
            for (int tt = 0; tt < 8; ++tt) { const int t = sg * 8 + tt;
                kdf[t * 72 + dk] = (bf16)f2bf(kv[tt] * __expf(totf - (offf + pf[tt]))); kdb[t * 72 + dk] = (bf16)f2bf(kv[tt] * __expf(totb - (offb + sb[tt]))); }
            if (sg == 0) { GAM[(size_t)slf * 64 + dk] = __expf(totf); GAM[(size_t)slb * 64 + dk] = __expf(totb); }
        } else {
            const float* mb = p->ml_gate_b + li * 16;
            if (tid < 128) { const int d = tid >> 6, t = tid & 63; const float* gp = SM + (size_t)(row0 + t) * 32 + d * 8;
                misc[d * 128 + t] = gp[h] + mb[d * 8 + h]; misc[d * 128 + 64 + t] = logsigf(gp[4 + h] + mb[d * 8 + 4 + h]); }
            __syncthreads();
            if (tid < 128) { const int d = tid >> 6, t = tid & 63; const float run = wave_scan_sum(misc[d * 128 + 64 + t], t, d == 1);
                const float tot = d == 0 ? __shfl(run, 63) : __shfl(run, 0);
                const float wl = tot - run + misc[d * 128 + t]; const float ml = wave_max(wl);
                misc[256 + d * 64 + t] = __expf(wl - ml);
                if (t == 0) { const int sl = d == 0 ? slf : slb; SC[(size_t)sl * 4 + 0] = tot; SC[(size_t)sl * 4 + 1] = ml; } }
            __syncthreads();
            float nf = 0.f, nb = 0.f;
#pragma unroll
            for (int tt = 0; tt < 8; ++tt) { const int t = sg * 8 + tt; const float a = kv[tt] * misc[256 + t], c = kv[tt] * misc[256 + 64 + t]; nf += a; nb += c;
                kdf[t * 72 + dk] = (bf16)f2bf(a); kdb[t * 72 + dk] = (bf16)f2bf(c); }
            seg[(0 * 8 + sg) * 64 + dk] = nf; seg[(1 * 8 + sg) * 64 + dk] = nb;
            __syncthreads();
            if (sg < 2) { float s2 = 0.f;
#pragma unroll
                for (int q = 0; q < 8; ++q) s2 += seg[(sg * 8 + q) * 64 + dk];
                GAM[(size_t)(sg == 0 ? slf : slb) * 64 + dk] = s2; }
        }
        __syncthreads();
#pragma unroll
        for (int d = 0; d < 2; ++d) { const LAS bf16* kd = d ? kdb : kdf; f32x4 acc[4];
#pragma unroll
            for (int nt = 0; nt < 4; ++nt) acc[nt] = (f32x4){0.f, 0.f, 0.f, 0.f};
#pragma unroll
            for (int ks = 0; ks < 2; ++ks) { const bf16x8 av = frag_tr(vs, 136, 32 * ks, 16 * wave, lane);
#pragma unroll
                for (int nt = 0; nt < 4; ++nt) acc[nt] = MFMA(av, frag_tr(kd, 72, 32 * ks, 16 * nt, lane), acc[nt]); }
            bf16* dst = S + (size_t)(d ? slb : slf) * 8192;
#pragma unroll
            for (int nt = 0; nt < 4; ++nt) { u32x2 w; w.x = pk2(acc[nt][0], acc[nt][1]); w.y = pk2(acc[nt][2], acc[nt][3]); *(u32x2*)(dst + (16 * nt + fr) * 128 + 16 * wave + 4 * fq) = w; } }
    }
}
__device__ __forceinline__ void phase_scan_seq(KP p, int l, bool dummy = false) {
    const bool odd = l & 1;
    u32x2* S2 = (u32x2*)(p->ws + WS_S); float* GAM = (float*)(p->ws + WS_GAM); f32x4* GAM4 = (f32x4*)(p->ws + WS_GAM); float* SC = (float*)(p->ws + WS_SC);
    const int nthreads = gridDim.x * NTHR;
    for (int gid = blockIdx.x * NTHR + otid(); gid < 64 * 2048; gid += nthreads) {
        const int chain = gid >> 11, e4 = gid & 2047, dir = chain & 1, dkk = e4 >> 5; const int base = chain * NCHUNK;
        f32x4 st = (f32x4){0.f, 0.f, 0.f, 0.f}, nst = (f32x4){0.f, 0.f, 0.f, 0.f}; float m = 0.f; const bool hasn = odd && e4 < 16;
        for (int s0 = 0; s0 < NCHUNK; s0 += 4) {
            u32x2 dr[4]; f32x4 dn[4]; float g0[4], g1[4]; int idx[4];
#pragma unroll
            for (int u = 0; u < 4; ++u) { const int step = s0 + u; const int cp = dir == 0 ? step : (step < 4 ? 3 - step : 71 - step); idx[u] = base + cp;
                dr[u] = S2[(size_t)idx[u] * 2048 + e4];
                if (!odd) { g0[u] = GAM[(size_t)idx[u] * 64 + dkk]; g1[u] = 0.f; } else { g0[u] = SC[(size_t)idx[u] * 4 + 0]; g1[u] = SC[(size_t)idx[u] * 4 + 1]; if (hasn) dn[u] = GAM4[(size_t)idx[u] * 16 + e4]; } }
#pragma unroll
            for (int u = 0; u < 4; ++u) {
                const f32x4 d = (f32x4){bflo(dr[u].x), bfhi(dr[u].x), bflo(dr[u].y), bfhi(dr[u].y)};
                u32x2 w; w.x = pk2(st[0], st[1]); w.y = pk2(st[2], st[3]);
                S2[(size_t)idx[u] * 2048 + e4] = dummy ? dr[u] : w;
                if (!odd) { st = st * g0[u] + d; }
                else { if (hasn) GAM4[(size_t)idx[u] * 16 + e4] = dummy ? dn[u] : nst; if (e4 == 0 && !dummy) SC[(size_t)idx[u] * 4 + 2] = m;
                    const float mn = fmaxf(g0[u] + m, g1[u]); const float dec = __expf(g0[u] + m - mn), sc = __expf(g1[u] - mn);
                    st = st * dec + d * sc; if (hasn) nst = nst * dec + dn[u] * sc; m = mn; }
            }
        }
    }
}
constexpr int SO_QF = 0, SO_KF = 9216, SO_QB = 18432, SO_KB = 27648, SO_VS = 36864, SO_AF = 54272, SO_AB = 63488, SO_SF = 72704, SO_SB = 90112, SO_SEG = 107520, SO_SSQ = 111616, SO_MISC = 113664;
constexpr int SO_OST = 0;
__device__ __forceinline__ void scan_out_tail(LAS unsigned char* lds, f32x4 (&o)[4], const bf16* __restrict__ P, int ldp, bf16* __restrict__ Z, int row0, int h, const float* __restrict__ ng) {
    const int tid = otid(), lane = tid & 63, wave = tid >> 6, fq = lane >> 4, fr = lane & 15;
    LAS float* ost = (LAS float*)(lds + SO_OST);
    u32x4 gv[2]; f32x4 g0[2], g1[2];
#pragma unroll
    for (int c2 = 0; c2 < 2; ++c2) { const int idx = tid + NTHR * c2, t = idx >> 4, ch = idx & 15;
        gv[c2] = *(const u32x4*)(P + (size_t)(row0 + t) * ldp + 1024 + h * 128 + 8 * ch); g0[c2] = *(const f32x4*)(ng + h * 128 + 8 * ch); g1[c2] = *(const f32x4*)(ng + h * 128 + 8 * ch + 4); }
    __syncthreads();
#pragma unroll
    for (int mt = 0; mt < 4; ++mt)
#pragma unroll
        for (int r = 0; r < 4; ++r) ost[(16 * mt + 4 * fq + r) * 132 + 16 * wave + fr] = o[mt][r];
    __syncthreads();
#pragma unroll
    for (int c2 = 0; c2 < 2; ++c2) { const int idx = tid + NTHR * c2, t = idx >> 4, ch = idx & 15;
        f32x4 o0 = *(const LAS f32x4*)(ost + t * 132 + 8 * ch), o1 = *(const LAS f32x4*)(ost + t * 132 + 8 * ch + 4);
        const float q = red16_sum((o0[0] * o0[0] + o0[1] * o0[1]) + (o0[2] * o0[2] + o0[3] * o0[3]) + (o1[0] * o1[0] + o1[1] * o1[1]) + (o1[2] * o1[2] + o1[3] * o1[3]));
        const float rs = rsqrtf(q * (1.f / 128.f) + 1e-6f); o0 = o0 * rs * g0[c2]; o1 = o1 * rs * g1[c2];
        u32x4 w;
        w.x = pk2(o0[0] * siluf(bflo(gv[c2].x)), o0[1] * siluf(bfhi(gv[c2].x))); w.y = pk2(o0[2] * siluf(bflo(gv[c2].y)), o0[3] * siluf(bfhi(gv[c2].y)));
        w.z = pk2(o1[0] * siluf(bflo(gv[c2].z)), o1[1] * siluf(bfhi(gv[c2].z))); w.w = pk2(o1[2] * siluf(bflo(gv[c2].w)), o1[3] * siluf(bfhi(gv[c2].w)));
        *(u32x4*)(Z + (size_t)(row0 + t) * DM + h * 128 + 8 * ch) = w; }
}
__device__ __forceinline__ void stage_state(LAS bf16* dst, const bf16* __restrict__ src) {
    const int tid = otid();
#pragma unroll
    for (int c2 = 0; c2 < 2; ++c2) { const int idx = tid + NTHR * c2, r = idx >> 4, ch = idx & 15; *(LAS u32x4*)(dst + r * 136 + 8 * ch) = *(const u32x4*)(src + r * 128 + 8 * ch); }
}
__device__ __forceinline__ void phase_scan_out_gla(KP p, LAS unsigned char* lds, int l, bool need_ctx) {
    const int tid = otid(), lane = tid & 63, wave = tid >> 6, fq = lane >> 4, fr = lane & 15; const int li = l >> 1;
    const bf16* P = (const bf16*)(p->ws + WS_P); const int ldp = NP_EVEN; const float* SM = (const float*)(p->ws + WS_SM); bf16* Z = (bf16*)(p->ws + WS_H);
    const bf16* S = (const bf16*)(p->ws + WS_S);
    LAS bf16* qf = (LAS bf16*)(lds + SO_QF); LAS bf16* kf = (LAS bf16*)(lds + SO_KF); LAS bf16* qb = (LAS bf16*)(lds + SO_QB); LAS bf16* kb = (LAS bf16*)(lds + SO_KB);
    LAS bf16* vs = (LAS bf16*)(lds + SO_VS); LAS bf16* Af = (LAS bf16*)(lds + SO_AF); LAS bf16* Ab = (LAS bf16*)(lds + SO_AB); LAS bf16* Sf = (LAS bf16*)(lds + SO_SF); LAS bf16* Sb = (LAS bf16*)(lds + SO_SB);
    LAS float* seg = (LAS float*)(lds + SO_SEG); LAS float* lrs = (LAS float*)(lds + SO_MISC);
    const int dk = tid & 63, sg = tid >> 6;
    for (int it = blockIdx.x; it < BATCH * 4 * NCHUNK; it += gridDim.x) {
        const int b = it / (4 * NCHUNK), h = (it / NCHUNK) & 3, cp = it % NCHUNK; if (cp < 4 && !need_ctx) continue;
        const int row0 = chunk_row0(b, cp); const int slf = ((b * 4 + h) * 2 + 0) * NCHUNK + cp, slb = slf + NCHUNK;
        __syncthreads();
#pragma unroll
        for (int c2 = 0; c2 < 2; ++c2) { const int idx = tid + NTHR * c2, t = idx >> 4, ch = idx & 15; *(LAS u32x4*)(vs + t * 136 + 8 * ch) = *(const u32x4*)(P + (size_t)(row0 + t) * ldp + 512 + h * 128 + 8 * ch); }
        stage_state(Sf, S + (size_t)slf * 8192); stage_state(Sb, S + (size_t)slb * 8192);
        float qv[8], kv[8];
#pragma unroll
        for (int tt = 0; tt < 8; ++tt) { const size_t ro = (size_t)(row0 + sg * 8 + tt) * ldp + h * 64 + dk; qv[tt] = bf2f(P[ro]); kv[tt] = bf2f(P[ro + 256]); }
        float gwf[16], gwb[16];
        const float* gw = p->gla_gate_w + (size_t)li * 2 * 16 * 256; const float* gb = p->gla_gate_b + (size_t)li * 2 * 256;
#pragma unroll
        for (int r = 0; r < 16; ++r) { gwf[r] = gw[r * 256 + h * 64 + dk]; gwb[r] = gw[(16 + r) * 256 + h * 64 + dk]; }
        const float gbf = gb[h * 64 + dk], gbb = gb[256 + h * 64 + dk];
        { const int t = tid >> 3, c4 = (tid & 7) * 4; *(LAS f32x4*)(lrs + t * 32 + c4) = *(const f32x4*)(SM + (size_t)(row0 + t) * 32 + c4); }
        __syncthreads();
        float pf[8], sb[8];
        f32x4 L[2][8];
#pragma unroll
        for (int i = 0; i < 8; ++i) L[0][i] = *(const LAS f32x4*)(lrs + (sg * 8) * 32 + 4 * i);
#pragma unroll
        for (int tt = 0; tt < 8; ++tt) {
            if (tt < 7) {
#pragma unroll
                for (int i = 0; i < 8; ++i) L[(tt + 1) & 1][i] = *(const LAS f32x4*)(lrs + (sg * 8 + tt + 1) * 32 + 4 * i); }
            float zf = gbf, zb = gbb, zf2 = 0.f, zb2 = 0.f;
#pragma unroll
            for (int i = 0; i < 4; i += 2)
#pragma unroll
                for (int e = 0; e < 4; ++e) { zf += L[tt & 1][i][e] * gwf[4 * i + e]; zf2 += L[tt & 1][i + 1][e] * gwf[4 * i + 4 + e]; zb += L[tt & 1][4 + i][e] * gwb[4 * i + e]; zb2 += L[tt & 1][5 + i][e] * gwb[4 * i + 4 + e]; }
            pf[tt] = logsigf(zf + zf2) * 0.0625f; sb[tt] = logsigf(zb + zb2) * 0.0625f; }
#pragma unroll
        for (int tt = 1; tt < 8; ++tt) pf[tt] += pf[tt - 1];
#pragma unroll
        for (int tt = 6; tt >= 0; --tt) sb[tt] += sb[tt + 1];
        seg[(0 * 8 + sg) * 64 + dk] = pf[7]; seg[(1 * 8 + sg) * 64 + dk] = sb[0];
        __syncthreads();
        float offf = 0.f, offb = 0.f;
#pragma unroll
        for (int q = 0; q < 8; ++q) { const float a = seg[q * 64 + dk], c = seg[(8 + q) * 64 + dk]; if (q < sg) offf += a; if (q > sg) offb += c; }
#pragma unroll
        for (int tt = 0; tt < 8; ++tt) { const int t = sg * 8 + tt; const float bf_ = offf + pf[tt], bb_ = offb + sb[tt];
            qf[t * 72 + dk] = (bf16)f2bf(qv[tt] * __expf(bf_)); kf[t * 72 + dk] = (bf16)f2bf(kv[tt] * __expf(-bf_));
            qb[t * 72 + dk] = (bf16)f2bf(qv[tt] * __expf(bb_)); kb[t * 72 + dk] = (bf16)f2bf(kv[tt] * __expf(-bb_)); }
        __syncthreads();
        { const int mt = wave >> 1;
#pragma unroll
          for (int n2 = 0; n2 < 2; ++n2) { const int nt = 2 * (wave & 1) + n2; f32x4 af = (f32x4){0.f, 0.f, 0.f, 0.f}, ab = (f32x4){0.f, 0.f, 0.f, 0.f};
#pragma unroll
              for (int ks = 0; ks < 2; ++ks) { af = MFMA(frag_rm(qf, 72, 16 * mt, 32 * ks, lane), frag_rm(kf, 72, 16 * nt, 32 * ks, lane), af);
                                               ab = MFMA(frag_rm(qb, 72, 16 * mt, 32 * ks, lane), frag_rm(kb, 72, 16 * nt, 32 * ks, lane), ab); }
#pragma unroll
              for (int r = 0; r < 4; ++r) { const int t = 16 * mt + 4 * fq + r, s = 16 * nt + fr;
                  Af[t * 72 + s] = (bf16)f2bf(s <= t ? af[r] : 0.f); Ab[t * 72 + s] = (bf16)f2bf(s >= t ? ab[r] : 0.f); } } }
        __syncthreads();
        f32x4 o[4];
#pragma unroll
        for (int mt = 0; mt < 4; ++mt) o[mt] = (f32x4){0.f, 0.f, 0.f, 0.f};
#pragma unroll
        for (int ks = 0; ks < 2; ++ks) { const bf16x8 bv = frag_tr(vs, 136, 32 * ks, 16 * wave, lane), bsf = frag_tr(Sf, 136, 32 * ks, 16 * wave, lane), bsb = frag_tr(Sb, 136, 32 * ks, 16 * wave, lane);
#pragma unroll
            for (int mt = 0; mt < 4; ++mt) { o[mt] = MFMA(frag_rm(Af, 72, 16 * mt, 32 * ks, lane), bv, o[mt]); o[mt] = MFMA(frag_rm(Ab, 72, 16 * mt, 32 * ks, lane), bv, o[mt]);
                o[mt] = MFMA(frag_rm(qf, 72, 16 * mt, 32 * ks, lane), bsf, o[mt]); o[mt] = MFMA(frag_rm(qb, 72, 16 * mt, 32 * ks, lane), bsb, o[mt]); } }
        scan_out_tail(lds, o, P, ldp, Z, row0, h, p->gla_norm_g + (size_t)li * 512);
    }
}
constexpr int MO_QS = 0, MO_KS = 9216, MO_QWF = 18432, MO_QWB = 27648;
__device__ __forceinline__ void phase_scan_out_mlstm(KP p, LAS unsigned char* lds, int l, bool need_ctx) {
    const int tid = otid(), lane = tid & 63, wave = tid >> 6, fq = lane >> 4, fr = lane & 15; const int li = l >> 1;
    const bf16* P = (const bf16*)(p->ws + WS_P); const int ldp = NP_ODD; const float* SM = (const float*)(p->ws + WS_SM); bf16* Z = (bf16*)(p->ws + WS_H);
    const bf16* S = (const bf16*)(p->ws + WS_S); const float* GAM = (const float*)(p->ws + WS_GAM); const float* SC = (const float*)(p->ws + WS_SC);
    LAS bf16* qs = (LAS bf16*)(lds + MO_QS); LAS bf16* ks_ = (LAS bf16*)(lds + MO_KS); LAS bf16* qwf = (LAS bf16*)(lds + MO_QWF); LAS bf16* qwb = (LAS bf16*)(lds + MO_QWB);
    LAS bf16* vs = (LAS bf16*)(lds + SO_VS); LAS bf16* Af = (LAS bf16*)(lds + SO_AF); LAS bf16* Ab = (LAS bf16*)(lds + SO_AB); LAS bf16* Cf = (LAS bf16*)(lds + SO_SF); LAS bf16* Cb = (LAS bf16*)(lds + SO_SB);
    LAS float* part = (LAS float*)(lds + SO_SEG);
    LAS float* misc = (LAS float*)(lds + SO_MISC);
    const float* mb = p->ml_gate_b + li * 16;
    for (int it = blockIdx.x; it < BATCH * 4 * NCHUNK; it += gridDim.x) {
        const int b = it / (4 * NCHUNK), h = (it / NCHUNK) & 3, cp = it % NCHUNK; if (cp < 4 && !need_ctx) continue;
        const int row0 = chunk_row0(b, cp); const int slf = ((b * 4 + h) * 2 + 0) * NCHUNK + cp, slb = slf + NCHUNK;
        __syncthreads();
#pragma unroll
        for (int c2 = 0; c2 < 2; ++c2) { const int idx = tid + NTHR * c2, t = idx >> 4, ch = idx & 15; *(LAS u32x4*)(vs + t * 136 + 8 * ch) = *(const u32x4*)(P + (size_t)(row0 + t) * ldp + 512 + h * 128 + 8 * ch); }
        stage_state(Cf, S + (size_t)slf * 8192); stage_state(Cb, S + (size_t)slb * 8192);
        { const int t = tid >> 3, ch = tid & 7; const size_t ro = (size_t)(row0 + t) * ldp + h * 64 + 8 * ch;
          *(LAS u32x4*)(qs + t * 72 + 8 * ch) = *(const u32x4*)(P + ro); *(LAS u32x4*)(ks_ + t * 72 + 8 * ch) = *(const u32x4*)(P + ro + 256); }
        float mprev_r = 0.f;
        if (tid < 128) { const int d = tid >> 6, t = tid & 63; const float* gp = SM + (size_t)(row0 + t) * 32 + d * 8;
            misc[d * 512 + t] = gp[h] + mb[d * 8 + h]; misc[d * 512 + 64 + t] = logsigf(gp[4 + h] + mb[d * 8 + 4 + h]);
            misc[1024 + d * 64 + t] = GAM[(size_t)(d ? slb : slf) * 64 + t]; mprev_r = SC[(size_t)(d ? slb : slf) * 4 + 2]; }
        __syncthreads();
        if (tid < 128) { const int d = tid >> 6, t = tid & 63; LAS float* md = misc + d * 512; const float run = wave_scan_sum(md[64 + t], t, d == 1); const float pm = wave_scan_max(md[t] - run, t, d == 1);
            const float mprev = mprev_r;
            const float mt_ = fmaxf(run + pm, run + mprev);
            md[128 + t] = run; md[192 + t] = mt_; md[256 + t] = __expf(run + mprev - mt_); }
        __syncthreads();
        { const int t = tid >> 3, ch = tid & 7; const u32x4 qv = *(const LAS u32x4*)(qs + t * 72 + 8 * ch); const float wf = misc[256 + t], wb = misc[512 + 256 + t];
          u32x4 a, c;
          a.x = pk2(bflo(qv.x) * wf, bfhi(qv.x) * wf); a.y = pk2(bflo(qv.y) * wf, bfhi(qv.y) * wf); a.z = pk2(bflo(qv.z) * wf, bfhi(qv.z) * wf); a.w = pk2(bflo(qv.w) * wf, bfhi(qv.w) * wf);
          c.x = pk2(bflo(qv.x) * wb, bfhi(qv.x) * wb); c.y = pk2(bflo(qv.y) * wb, bfhi(qv.y) * wb); c.z = pk2(bflo(qv.z) * wb, bfhi(qv.z) * wb); c.w = pk2(bflo(qv.w) * wb, bfhi(qv.w) * wb);
          *(LAS u32x4*)(qwf + t * 72 + 8 * ch) = a; *(LAS u32x4*)(qwb + t * 72 + 8 * ch) = c;
          const float q0 = bflo(qv.x), q1 = bfhi(qv.x), q2 = bflo(qv.y), q3 = bfhi(qv.y), q4 = bflo(qv.z), q5 = bfhi(qv.z), q6 = bflo(qv.w), q7 = bfhi(qv.w);
#pragma unroll
          for (int d = 0; d < 2; ++d) { const LAS float* nv = misc + 1024 + d * 64 + 8 * ch;
              part[(d * 8 + ch) * 64 + t] = q0 * nv[0] + q1 * nv[1] + q2 * nv[2] + q3 * nv[3] + q4 * nv[4] + q5 * nv[5] + q6 * nv[6] + q7 * nv[7]; } }
        { const int mt = wave >> 1; float rsf[4] = {0.f, 0.f, 0.f, 0.f}, rsb[4] = {0.f, 0.f, 0.f, 0.f};
#pragma unroll
          for (int n2 = 0; n2 < 2; ++n2) { const int nt = 2 * (wave & 1) + n2; f32x4 a = (f32x4){0.f, 0.f, 0.f, 0.f};
#pragma unroll
              for (int ks = 0; ks < 2; ++ks) a = MFMA(frag_rm(qs, 72, 16 * mt, 32 * ks, lane), frag_rm(ks_, 72, 16 * nt, 32 * ks, lane), a);
#pragma unroll
              for (int r = 0; r < 4; ++r) { const int t = 16 * mt + 4 * fq + r, s = 16 * nt + fr;
                  const float wf = s <= t ? __expf(misc[128 + t] - misc[128 + s] + misc[s] - misc[192 + t]) : 0.f;
                  const float wb = s >= t ? __expf(misc[512 + 128 + t] - misc[512 + 128 + s] + misc[512 + s] - misc[512 + 192 + t]) : 0.f;
                  const float vf = a[r] * wf, vb = a[r] * wb; rsf[r] += vf; rsb[r] += vb;
                  Af[t * 72 + s] = (bf16)f2bf(vf); Ab[t * 72 + s] = (bf16)f2bf(vb); } }
#pragma unroll
          for (int r = 0; r < 4; ++r) { const float a = red16_sum(rsf[r]), c = red16_sum(rsb[r]);
              if (fr == 0) { misc[1152 + (0 * 2 + (wave & 1)) * 64 + 16 * mt + 4 * fq + r] = a; misc[1152 + (1 * 2 + (wave & 1)) * 64 + 16 * mt + 4 * fq + r] = c; } } }
        __syncthreads();
        if (tid < 128) { const int d = tid >> 6, t = tid & 63; float qn = 0.f;
#pragma unroll
            for (int q = 0; q < 8; ++q) qn += part[(d * 8 + q) * 64 + t];
            const float den = misc[1152 + (d * 2 + 0) * 64 + t] + misc[1152 + (d * 2 + 1) * 64 + t] + misc[d * 512 + 256 + t] * qn;
            misc[d * 512 + 320 + t] = 1.f / fmaxf(fabsf(den), __expf(-misc[d * 512 + 192 + t])); }
        f32x4 of[4], ob[4];
#pragma unroll
        for (int mt = 0; mt < 4; ++mt) { of[mt] = (f32x4){0.f, 0.f, 0.f, 0.f}; ob[mt] = (f32x4){0.f, 0.f, 0.f, 0.f}; }
#pragma unroll
        for (int ks = 0; ks < 2; ++ks) { const bf16x8 bv = frag_tr(vs, 136, 32 * ks, 16 * wave, lane), bcf = frag_tr(Cf, 136, 32 * ks, 16 * wave, lane), bcb = frag_tr(Cb, 136, 32 * ks, 16 * wave, lane);
#pragma unroll
            for (int mt = 0; mt < 4; ++mt) { of[mt] = MFMA(frag_rm(Af, 72, 16 * mt, 32 * ks, lane), bv, of[mt]); of[mt] = MFMA(frag_rm(qwf, 72, 16 * mt, 32 * ks, lane), bcf, of[mt]);
                ob[mt] = MFMA(frag_rm(Ab, 72, 16 * mt, 32 * ks, lane), bv, ob[mt]); ob[mt] = MFMA(frag_rm(qwb, 72, 16 * mt, 32 * ks, lane), bcb, ob[mt]); } }
        __syncthreads();
        f32x4 o[4];
#pragma unroll
        for (int mt = 0; mt < 4; ++mt)
#pragma unroll
            for (int r = 0; r < 4; ++r) { const int t = 16 * mt + 4 * fq + r; o[mt][r] = of[mt][r] * misc[320 + t] + ob[mt][r] * misc[512 + 320 + t]; }
        scan_out_tail(lds, o, P, ldp, Z, row0, h, p->ml_norm_g + (size_t)li * 512);
    }
}
#define XB_TMO      128
#define XB_XCNT(j)  (256  + 64 * (j))
#define XB_XSUB(j)  (1280 + 64 * (j))
#define XB_XGEN(j)  (2304 + 64 * (j))
#define XB_TOP      3328
#define XB_TOPGEN   3392
#define XCD_BAR_WORDS 3456
#define XB_SPIN_CAP (1u << 18)

__device__ __forceinline__ unsigned xb_ld(unsigned* p)              { return __hip_atomic_load(p, __ATOMIC_RELAXED, __HIP_MEMORY_SCOPE_AGENT); }
__device__ __forceinline__ unsigned xb_add(unsigned* p, unsigned v) { return __hip_atomic_fetch_add(p, v, __ATOMIC_RELAXED, __HIP_MEMORY_SCOPE_AGENT); }
__device__ __forceinline__ unsigned xb_xcc_id() { return (unsigned)__builtin_amdgcn_s_getreg((3 << 11) | 20) & 0xFu; }
#define XB_SPIN(cond, bar) do { unsigned _sp = 0; while (cond) { __builtin_amdgcn_s_sleep(1); \
    if ((++_sp & 255u) == 0u) { if (xb_ld(&(bar)[XB_TMO])) break; if (_sp > XB_SPIN_CAP) { atomicAdd(&(bar)[XB_TMO], 1u); break; } } } } while (0)

struct XcdBarrier {
    unsigned* bar; unsigned x;
    volatile LAS unsigned* st;
};

__device__ __forceinline__ XcdBarrier xcd_barrier_post(unsigned* bar, volatile LAS unsigned* st) {
    XcdBarrier b; b.bar = bar; b.x = xb_xcc_id(); b.st = st;
    if (otid() == 0) (void)xb_add(&bar[XB_XCNT(b.x)], 1u);
    return b;
}
__device__ __forceinline__ void xcd_barrier_complete(unsigned* bar, unsigned x, unsigned& nloc, unsigned& nx) {
    const unsigned G = gridDim.x * gridDim.y * gridDim.z;
    unsigned sum, cnt, mine, sp = 0u;
    for (;;) {
        sum = 0u; cnt = 0u; mine = 0u;
#pragma unroll
        for (unsigned j = 0; j < 16; ++j) { const unsigned c = xb_ld(&bar[XB_XCNT(j)]); sum += c; cnt += (c > 0u) ? 1u : 0u; mine = (j == x) ? c : mine; }
        if (sum == G) break;
        __builtin_amdgcn_s_sleep(1);
        if ((++sp & 255u) == 0u) { if (xb_ld(&bar[XB_TMO])) break; if (sp > XB_SPIN_CAP) { atomicAdd(&bar[XB_TMO], 1u); break; } }
    }
    nloc = mine > 0u ? mine : 1u; nx = cnt > 0u ? cnt : 1u;
}

__device__ __forceinline__ void xcd_barrier(const XcdBarrier& b) {
    asm volatile("s_waitcnt vmcnt(0)" ::: "memory");
    __syncthreads();
    if (otid() == 0) {
        unsigned* bar = b.bar;
        __builtin_amdgcn_s_waitcnt(0);
        unsigned nloc = b.st[0], nx = b.st[1];
        if (nloc == 0u) { xcd_barrier_complete(bar, b.x, nloc, nx); b.st[0] = nloc; b.st[1] = nx; }
        const unsigned old = xb_add(&bar[XB_XSUB(b.x)], 1u);
        const unsigned gen = old / nloc;
        if (old + 1u == (gen + 1u) * nloc) {
            __builtin_amdgcn_fence(__ATOMIC_RELEASE, "agent");
            asm volatile("s_waitcnt vmcnt(0)" ::: "memory");
            const unsigned og = xb_add(&bar[XB_TOP], 1u);
            const unsigned tg = og / nx;
            if (og + 1u == (tg + 1u) * nx) xb_add(&bar[XB_TOPGEN], 1u);
            else XB_SPIN(xb_ld(&bar[XB_TOPGEN]) == tg, bar);
            __builtin_amdgcn_fence(__ATOMIC_ACQUIRE, "agent");
            xb_add(&bar[XB_XGEN(b.x)], 1u);
            asm volatile("s_waitcnt vmcnt(0)" ::: "memory");
        } else {
            XB_SPIN(xb_ld(&bar[XB_XGEN(b.x)]) == gen, bar);
            __builtin_amdgcn_fence(__ATOMIC_ACQUIRE, "agent");
            asm volatile("s_waitcnt vmcnt(0)" ::: "memory");
        }
    }
    __syncthreads();
}

#define REP_GEMM 1
#define REP_ATT 1
#define REP_LOC 1
#define REP_OUT 1
#define REP_PRO 1
#define REP_SEQ 1
#define REP_LN 1
#ifndef MK_N_LAUNCHES
#define MK_N_LAUNCHES 1
#endif
constexpr int N_PHASES = 2 + 6 * DEPTH;
__global__ void __launch_bounds__(NTHR, 2) fwd_megakernel(Params p_unused) {
    extern __shared__ __attribute__((aligned(16))) unsigned char lds_raw[];
    LAS unsigned char* lds = (LAS unsigned char*)lds_raw;
    cg::grid_group grid = cg::this_grid();
    const int lo = (int)kparams()->ph_lo, hi = (int)kparams()->ph_hi;
#define IN(k) (lo <= (k) && (k) < hi)
    volatile LAS unsigned* bst = (volatile LAS unsigned*)(lds + LDS_BYTES - 64);
    if (otid() < 16) bst[otid()] = 0u;
    __syncthreads();
    XcdBarrier bar = xcd_barrier_post((unsigned*)(kparams()->ws + WS_BAR), bst);
    if (kparams()->ph_hi < 0) grid.sync();
#define SEAM(k) do { if (IN(k) && IN((k) + 1)) xcd_barrier(bar); } while (0)
    if (IN(0)) { for (int rep = 0; rep < REP_PRO; ++rep) { phase_prologue(kparams(), lds); __syncthreads(); } } SEAM(0);
    if (IN(1)) { for (int rep = 0; rep < REP_PRO; ++rep) phase_h0(kparams()); } SEAM(1);
#pragma unroll 1
    for (int l = 0; l < DEPTH; ++l) {
        const int pb = 2 + 6 * l; const bool odd = l & 1; const int li = l >> 1; const bool need_ctx = l < DEPTH - 1;
        if (IN(pb + 0)) {
            const int npad = odd ? NPAD_ODD : NPAD_EVEN; unsigned char* ws = kparams()->ws;
            pg8::Gemm g{(const pg8::bf16_t*)(ws + WS_H), (const pg8::bf16_t*)(ws + (odd ? WS_WIO : WS_WIE)) + (size_t)li * npad * 1024, MTOT, npad, 1024};
            pg8::StaticOrder S; S.init(MTOT, npad, (int)gridDim.x, (int)blockIdx.x);
            pg8::EpiProj E{(pg8::bf16_t*)(ws + WS_P), odd ? NP_ODD : NP_EVEN, (float*)(ws + WS_SM), odd ? 16 : 32, npad / 256 - 1, odd ? 1 : 0, (const float*)(ws + WS_ROPE), (const float*)(ws + WS_ROPE) + 1024};
            for (int rep = 0; rep < REP_GEMM; ++rep) pg8::gemm_phase<pg8::EpiProj, pg8::StaticOrder, true, true>(lds, g, S, E);
        }
        SEAM(pb + 0);
        if (IN(pb + 1)) { for (int rep = 0; rep < REP_ATT; ++rep) phase_attn(kparams(), lds, l, need_ctx); for (int rep = 0; rep < REP_LOC; ++rep) phase_scan_local(kparams(), lds, l); }
        SEAM(pb + 1);
        if (IN(pb + 2)) { for (int rep = 1; rep < REP_SEQ; ++rep) { phase_scan_seq(kparams(), l, true); __syncthreads(); } phase_scan_seq(kparams(), l); }
        SEAM(pb + 2);
        if (IN(pb + 3)) { for (int rep = 0; rep < REP_OUT; ++rep) { if (odd) phase_scan_out_mlstm(kparams(), lds, l, need_ctx); else phase_scan_out_gla(kparams(), lds, l, need_ctx); } }
        SEAM(pb + 3);
        if (IN(pb + 4)) {
            const int mrows = need_ctx ? MTOT : MLAT; unsigned char* ws = kparams()->ws;
            pg8::Gemm g{(const pg8::bf16_t*)(ws + WS_H), (const pg8::bf16_t*)(ws + WS_WO) + (size_t)l * 1024 * 1024, mrows, 1024, 1024};
            pg8::StaticOrder S; S.init(mrows, 1024, (int)gridDim.x, (int)blockIdx.x);
            pg8::EpiProj E{(pg8::bf16_t*)(ws + WS_P), 1024, nullptr, 0, -1, 0, nullptr, nullptr};
            for (int rep = 0; rep < REP_GEMM; ++rep) pg8::gemm_phase<pg8::EpiProj, pg8::StaticOrder, true, true>(lds, g, S, E);
        }
        SEAM(pb + 4);
        if (IN(pb + 5)) { for (int rep = 1; rep < REP_LN; ++rep) { phase_ln(kparams(), l, true); } phase_ln(kparams(), l); }
        SEAM(pb + 5);
    }
}
extern "C" void kernel_launch(void* const* d_in, const int* in_sizes, int n_in, void* d_out, int out_size, void* d_ws, size_t ws_size, hipStream_t stream) {
    static int grid = 0;
    if (grid == 0) {
        if (n_in != 19 || ws_size < WS_END) { fprintf(stderr, "kernel_launch: need 19 inputs and %zu bytes of workspace; got %d, %zu\n", (size_t)WS_END, n_in, ws_size); grid = -1; return; }
        int dev = 0, cus = 0, per_cu = 0;
        if (hipGetDevice(&dev) != hipSuccess || hipDeviceGetAttribute(&cus, hipDeviceAttributeMultiprocessorCount, dev) != hipSuccess) { grid = -1; return; }
        if (hipFuncSetAttribute((const void*)fwd_megakernel, hipFuncAttributeMaxDynamicSharedMemorySize, LDS_BYTES) != hipSuccess) { fprintf(stderr, "kernel_launch: hipFuncSetAttribute failed\n"); grid = -1; return; }
        if (hipOccupancyMaxActiveBlocksPerMultiprocessor(&per_cu, (const void*)fwd_megakernel, NTHR, LDS_BYTES) != hipSuccess || per_cu < 1) per_cu = 1;
        grid = cus * per_cu;
    }
    if (grid < 0) return;
    Params p{};
    p.x = (const float*)d_in[0]; p.c = (const float*)d_in[1]; p.ctx = (const float*)d_in[2]; p.c_ctx = (const float*)d_in[3]; p.w_ada = (const float*)d_in[4]; p.b_ada = (const float*)d_in[5];
    p.ln_g = (const float*)d_in[6]; p.ln_b = (const float*)d_in[7]; p.w_in_even = (const float*)d_in[8]; p.w_out_even = (const float*)d_in[9]; p.gla_gate_w = (const float*)d_in[10]; p.gla_gate_b = (const float*)d_in[11];
    p.gla_norm_g = (const float*)d_in[12]; p.na_rpb = (const float*)d_in[13]; p.w_in_odd = (const float*)d_in[14]; p.w_out_odd = (const float*)d_in[15]; p.ml_gate_b = (const float*)d_in[16]; p.ml_norm_g = (const float*)d_in[17];
    p.sw_sink = (const float*)d_in[18]; p.out = (float*)d_out; p.ws = (unsigned char*)d_ws;
    if (hipMemsetAsync((char*)d_ws + WS_BAR, 0, XCD_BAR_WORDS * 4, stream) != hipSuccess) { fprintf(stderr, "kernel_launch: memset failed\n"); return; }
#if MK_N_LAUNCHES == 1
    p.ph_lo = 0; p.ph_hi = N_PHASES;
    void* args[] = {&p};
    hipError_t e = hipLaunchCooperativeKernel((const void*)fwd_megakernel, dim3(grid), dim3(NTHR), args, LDS_BYTES, stream);
    if (e != hipSuccess) fprintf(stderr, "kernel_launch: cooperative launch failed: %s (grid %d)\n", hipGetErrorString(e), grid);
#else
    for (int k = 0; k < N_PHASES; ++k) { p.ph_lo = k; p.ph_hi = k + 1; hipLaunchKernelGGL(fwd_megakernel, dim3(grid), dim3(NTHR), LDS_BYTES, stream, p); }
#endif
}
```

```cpp
#include <hip/hip_runtime.h>
#include <hip/hip_cooperative_groups.h>
#include <cstdio>
#include <cstdint>
namespace cg = cooperative_groups;
__device__ __forceinline__ int otid() { int t = threadIdx.x; asm volatile("" : "+v"(t)); return t; }
namespace pg8 {
#define PG8_LAS __attribute__((address_space(3)))
typedef unsigned short bf16_t;
typedef short bf16x8 __attribute__((ext_vector_type(8)));
typedef float f32x4 __attribute__((ext_vector_type(4)));
typedef unsigned u32x4 __attribute__((ext_vector_type(4)));
constexpr int BM = 256, BK = 64, HALF = 128, HTB = HALF * BK * 2  , STAGE_BYTES = 8 * HTB, NXCD = 8, WGM = 8;

__host__ __device__ __forceinline__ int lds_byte(int r, int c) { const int st = (r >> 4) * 2 + (c >> 5), rr = r & 15, cc = c & 31, ob = rr * 64 + cc * 2; return st * 1024 + (ob ^ (((ob >> 9) & 1) << 5)); }
__host__ __device__ __forceinline__ void stage_rc(int b, int& R, int& C) { const int st = b / 1024, sb = b % 1024, swz = sb ^ (((sb >> 9) & 1) << 5); R = (st >> 1) * 16 + swz / 64; C = (st & 1) * 32 + (swz % 64) / 2; }
__host__ __device__ __forceinline__ int perm32(int rho) { const int n = rho >> 4, i = rho & 15; return 8 * (i >> 2) + 4 * n + (i & 3); }

struct Unit { int pm, pn; };
struct Gemm { const bf16_t* A; const bf16_t* Bt; int M, N, K; };

struct StaticOrder {
    int nM, nN, nwg, G, c;
    __host__ __device__ void init(int M, int N, int G_, int c_) { nM = M / BM; nN = N / BM; nwg = nM * nN; G = G_; c = c_; }
    __host__ __device__ bool next(int i, Unit& u) const {
        const long L = (long)i * G + c; if (L >= nwg) return false;
        int wgid = (int)L; { const int q = nwg / NXCD, r = nwg % NXCD, xcd = wgid % NXCD, off = wgid / NXCD; wgid = (xcd < r ? xcd * (q + 1) : r * (q + 1) + (xcd - r) * q) + off; }
        const int nig = WGM * nN, gid = wgid / nig, fm = gid * WGM, gsz = (nM - fm) < WGM ? (nM - fm) : WGM;
        u.pm = fm + ((wgid % nig) % gsz); u.pn = (wgid % nig) / gsz; return true;
    }
    __device__ __forceinline__ void a_ready(const Unit&) const {}
    __device__ __forceinline__ void done(const Unit&) const {}
};

__device__ __forceinline__ unsigned cvt_pk_bf16(float lo, float hi) { unsigned r; asm volatile("v_cvt_pk_bf16_f32 %0, %1, %2" : "=v"(r) : "v"(lo), "v"(hi)); return r; }
struct EpiProj {
    static constexpr bool PERM = true, AFTER_DRAIN = false;
    bf16_t* P; int ldp; float* SM; int nsm; int last_pn; int rope; const float* cosT; const float* sinT;
    __device__ __forceinline__ void operator()(const f32x4 (&acc)[2][2][4][2], const Unit& u, int wr, int wc, int fr, int fq) const {
        const int row0 = u.pm * BM + wr * 64 + fr;
        if (u.pn == last_pn) {
            if (wc == 0) {
#pragma unroll
                for (int ai = 0; ai < 2; ++ai)
#pragma unroll
                    for (int m = 0; m < 4; ++m) { const int row = row0 + ai * HALF + m * 16;
#pragma unroll
                        for (int n = 0; n < 2; ++n) { const int col = 8 * fq + 4 * n; if (col < nsm) *(f32x4*)(SM + (size_t)row * 32 + col) = acc[ai][0][m][n]; } }
            }
            return;
        }
        const bool do_rope_tile = rope && (u.pn == 6 || u.pn == 7 || u.pn == 8) && (u.pm * BM < 32768);
#pragma unroll
        for (int ai = 0; ai < 2; ++ai)
#pragma unroll
            for (int m = 0; m < 4; ++m) { const int row = row0 + ai * HALF + m * 16; bf16_t* rowp = P + (size_t)row * ldp + u.pn * BM + wc * 32 + 8 * fq;
#pragma unroll
                for (int bj = 0; bj < 2; ++bj) { f32x4 v0 = acc[ai][bj][m][0], v1 = acc[ai][bj][m][1];
                    if (do_rope_tile && (u.pn != 8 || bj == 0)) {
                        const int t = row & 4095; const int pos = (wc & 1) ? (t & 63) : (t >> 6); const int i0 = pos * 16 + 8 * (fq & 1);
                        const f32x4 c0 = *(const f32x4*)(cosT + i0), c1 = *(const f32x4*)(cosT + i0 + 4), s0 = *(const f32x4*)(sinT + i0), s1 = *(const f32x4*)(sinT + i0 + 4);
                        f32x4 p0, p1;
#pragma unroll
                        for (int e = 0; e < 4; ++e) { p0[e] = __shfl_xor(v0[e], 32); p1[e] = __shfl_xor(v1[e], 32); }
                        if (fq < 2) { v0 = v0 * c0 - p0 * s0; v1 = v1 * c1 - p1 * s1; } else { v0 = p0 * s0 + v0 * c0; v1 = p1 * s1 + v1 * c1; }
                    }
                    u32x4 w; w.x = cvt_pk_bf16(v0[0], v0[1]); w.y = cvt_pk_bf16(v0[2], v0[3]); w.z = cvt_pk_bf16(v1[0], v1[1]); w.w = cvt_pk_bf16(v1[2], v1[3]);
                    *(u32x4*)(rowp + bj * HALF) = w; } }
    }
};
template <class Epi, class Sched, bool ALIGN_EPI = false, bool SP2 = false>
__device__ __forceinline__ void gemm_phase(PG8_LAS unsigned char* lds, const Gemm g, const Sched& S, const Epi& E) {
    const int tid = otid(), wid = __builtin_amdgcn_readfirstlane(tid >> 6), lane = tid & 63, wr = wid >> 2, wc = wid & 3, fr = lane & 15, fq = lane >> 4;
    const int K = g.K, nt = K / BK;
    unsigned voffA[2], voffB[2];
#pragma unroll
    for (int i = 0; i < 2; ++i) { int R, C; stage_rc(tid * 16 + i * 8192, R, C); const int Rb = Epi::PERM ? ((R & ~31) + perm32(R & 31)) : R;
        voffA[i] = (unsigned)(R * K + C) * 2u; voffB[i] = (unsigned)(Rb * K + C) * 2u; }
    const size_t kstep = (size_t)(BK * 2);
    const size_t hstep = (size_t)HALF * K * 2;
    const size_t tstep = 2 * hstep;
    const unsigned ldsw = (unsigned)wid * 1024u;
    const int aoff = lds_byte(wr * 64 + fr, fq * 8), boff = lds_byte(wc * 32 + fr, fq * 8);
#define PG8_SA(b, h) (((b) * 2 + (h)) * HTB)
#define PG8_SB(b, h) ((4 + (b) * 2 + (h)) * HTB)
#define PG8_STAGE(bufoff, gbase, voff) do { _Pragma("unroll") for (int _i = 0; _i < 2; ++_i) \
        __builtin_amdgcn_global_load_lds((const unsigned*)((const char*)(gbase) + (voff)[_i]), (PG8_LAS unsigned*)(lds + (bufoff) + ldsw + _i * 8192), 16, 0, 0); } while (0)
#define PG8_LDA(dst, b, h) do { _Pragma("unroll") for (int m = 0; m < 4; ++m) _Pragma("unroll") for (int k = 0; k < 2; ++k) dst[m][k] = *(const PG8_LAS bf16x8*)(lds + PG8_SA(b, h) + aoff + m * 2048 + k * 1024); } while (0)
#define PG8_LDB(dst, b, h) do { _Pragma("unroll") for (int n = 0; n < 2; ++n) _Pragma("unroll") for (int k = 0; k < 2; ++k) dst[n][k] = *(const PG8_LAS bf16x8*)(lds + PG8_SB(b, h) + boff + n * 2048 + k * 1024); } while (0)
#define PG8_MMA(ai, bj, At, Bt) do { __builtin_amdgcn_s_setprio(1); _Pragma("unroll") for (int m = 0; m < 4; ++m) _Pragma("unroll") for (int n = 0; n < 2; ++n) _Pragma("unroll") for (int k = 0; k < 2; ++k) \
        acc[ai][bj][m][n] = __builtin_amdgcn_mfma_f32_16x16x32_bf16(Bt[n][k], At[m][k], acc[ai][bj][m][n], 0, 0, 0); __builtin_amdgcn_s_setprio(0); } while (0)
#define PG8_WAIT_V(n) asm volatile("s_waitcnt vmcnt(" #n ")" ::: "memory")
#define PG8_WAIT_L(n) asm volatile("s_waitcnt lgkmcnt(" #n ")" ::: "memory")
#define PG8_BAR __builtin_amdgcn_s_barrier()
#define PG8_SCHED __builtin_amdgcn_sched_barrier(0)
    Unit cur, nxt; int ui = 0;
    if (!S.next(0, cur)) return;
    f32x4 acc[2][2][4][2];
#pragma unroll
    for (int a = 0; a < 2; ++a)
#pragma unroll
        for (int b = 0; b < 2; ++b)
#pragma unroll
            for (int m = 0; m < 4; ++m)
#pragma unroll
                for (int n = 0; n < 2; ++n) acc[a][b][m][n] = (f32x4){0.f, 0.f, 0.f, 0.f};
    bf16x8 At[4][2], B0[2][2], B1[2][2];
    const char* cA = (const char*)g.A + (size_t)cur.pm * tstep; const char* cB = (const char*)g.Bt + (size_t)cur.pn * tstep;
    S.a_ready(cur);
    if constexpr (SP2) {
        PG8_STAGE(PG8_SB(0, 0), cB, voffB); PG8_STAGE(PG8_SB(0, 1), cB + hstep, voffB); PG8_STAGE(PG8_SA(0, 0), cA, voffA); PG8_STAGE(PG8_SA(0, 1), cA + hstep, voffA);
        if (wr == 1) PG8_BAR;
        PG8_WAIT_V(2); PG8_BAR;
        PG8_STAGE(PG8_SB(1, 0), cB + kstep, voffB); PG8_STAGE(PG8_SA(1, 0), cA + kstep, voffA); PG8_STAGE(PG8_SB(1, 1), cB + hstep + kstep, voffB);
        PG8_WAIT_V(6); PG8_BAR;
    } else {
        PG8_STAGE(PG8_SB(0, 0), cB, voffB); PG8_STAGE(PG8_SA(0, 0), cA, voffA); PG8_STAGE(PG8_SB(0, 1), cB + hstep, voffB); PG8_STAGE(PG8_SA(0, 1), cA + hstep, voffA);
        if (wr == 1) PG8_BAR;
        PG8_WAIT_V(4); PG8_BAR;
        PG8_STAGE(PG8_SB(1, 0), cB + kstep, voffB); PG8_STAGE(PG8_SA(1, 0), cA + kstep, voffA); PG8_STAGE(PG8_SB(1, 1), cB + hstep + kstep, voffB);
        PG8_WAIT_V(6); PG8_BAR;
    }
    for (;;) {
        const bool has_next = S.next(ui + 1, nxt);
        const char* nA = has_next ? (const char*)g.A + (size_t)nxt.pm * tstep : cA; const char* nB = has_next ? (const char*)g.Bt + (size_t)nxt.pn * tstep : cB;
        for (int t = 0; t < nt; t += 2) {
            const bool last = (t == nt - 2);
            const char* a1 = cA + (size_t)(t + 1) * kstep;
            const char* a2 = last ? nA : cA + (size_t)(t + 2) * kstep; const char* b2 = last ? nB : cB + (size_t)(t + 2) * kstep;
            const char* a3 = a2 + kstep; const char* b3 = b2 + kstep;
            if (last && has_next) S.a_ready(nxt);
            if constexpr (SP2) {
            PG8_LDB(B0, 0, 0); PG8_LDB(B1, 0, 1); PG8_SCHED; PG8_LDA(At, 0, 0); PG8_STAGE(PG8_SA(1, 1), a1 + hstep, voffA);
            PG8_WAIT_V(8); PG8_WAIT_L(0); PG8_BAR; PG8_MMA(0, 0, At, B0); PG8_MMA(0, 1, At, B1); PG8_BAR; PG8_SCHED;
            PG8_LDA(At, 0, 1); PG8_STAGE(PG8_SB(0, 0), b2, voffB); PG8_STAGE(PG8_SB(0, 1), b2 + hstep, voffB); PG8_STAGE(PG8_SA(0, 0), a2, voffA);
            PG8_WAIT_V(8); PG8_WAIT_L(0); PG8_BAR; PG8_MMA(1, 0, At, B0); PG8_MMA(1, 1, At, B1); PG8_BAR; PG8_SCHED;
            PG8_LDB(B0, 1, 0); PG8_LDB(B1, 1, 1); PG8_SCHED; PG8_LDA(At, 1, 0); PG8_STAGE(PG8_SA(0, 1), a2 + hstep, voffA);
            PG8_WAIT_V(8); PG8_WAIT_L(0); PG8_BAR; PG8_MMA(0, 0, At, B0); PG8_MMA(0, 1, At, B1); PG8_BAR; PG8_SCHED;
            PG8_LDA(At, 1, 1); PG8_STAGE(PG8_SB(1, 0), b3, voffB); PG8_STAGE(PG8_SB(1, 1), b3 + hstep, voffB); PG8_STAGE(PG8_SA(1, 0), a3, voffA);
            PG8_WAIT_V(8); PG8_WAIT_L(0); PG8_BAR; PG8_MMA(1, 0, At, B0); PG8_MMA(1, 1, At, B1); PG8_BAR; PG8_SCHED;
            } else {
            PG8_LDB(B0, 0, 0); PG8_SCHED; PG8_LDA(At, 0, 0); PG8_STAGE(PG8_SA(1, 1), a1 + hstep, voffA);
            PG8_WAIT_L(8); PG8_BAR; PG8_WAIT_L(0); PG8_MMA(0, 0, At, B0); PG8_BAR; PG8_SCHED;
            PG8_LDB(B1, 0, 1); PG8_STAGE(PG8_SB(0, 0), b2, voffB);
            PG8_BAR; PG8_WAIT_L(0); PG8_MMA(0, 1, At, B1); PG8_BAR;
            PG8_LDA(At, 0, 1); PG8_STAGE(PG8_SA(0, 0), a2, voffA);
            PG8_BAR; PG8_WAIT_L(0); PG8_MMA(1, 0, At, B0); PG8_BAR; PG8_SCHED;
            PG8_STAGE(PG8_SB(0, 1), b2 + hstep, voffB);
            PG8_WAIT_V(6); PG8_BAR; PG8_MMA(1, 1, At, B1); PG8_BAR;
            PG8_LDB(B0, 1, 0); PG8_SCHED; PG8_LDA(At, 1, 0); PG8_STAGE(PG8_SA(0, 1), a2 + hstep, voffA);
            PG8_WAIT_L(8); PG8_BAR; PG8_WAIT_L(0); PG8_MMA(0, 0, At, B0); PG8_BAR; PG8_SCHED;
            PG8_LDB(B1, 1, 1); PG8_STAGE(PG8_SB(1, 0), b3, voffB);
            PG8_BAR; PG8_WAIT_L(0); PG8_MMA(0, 1, At, B1); PG8_BAR;
            PG8_LDA(At, 1, 1); PG8_STAGE(PG8_SA(1, 0), a3, voffA);
            PG8_BAR; PG8_WAIT_L(0); PG8_MMA(1, 0, At, B0); PG8_BAR; PG8_SCHED;
            PG8_STAGE(PG8_SB(1, 1), b3 + hstep, voffB);
            PG8_WAIT_V(6); PG8_BAR; PG8_MMA(1, 1, At, B1); PG8_BAR;
            }
        }
        if constexpr (ALIGN_EPI) { if (wr == 0) PG8_BAR; }
        if constexpr (!Epi::AFTER_DRAIN) { E(acc, cur, wr, wc, fr, fq); S.done(cur); }
        if (!has_next) break;
#pragma unroll
        for (int a = 0; a < 2; ++a)
#pragma unroll
            for (int b = 0; b < 2; ++b)
#pragma unroll
                for (int m = 0; m < 4; ++m)
#pragma unroll
                    for (int n = 0; n < 2; ++n) acc[a][b][m][n] = (f32x4){0.f, 0.f, 0.f, 0.f};
        cur = nxt; cA = nA; cB = nB; ++ui;
        if constexpr (ALIGN_EPI) { if (wr == 1) PG8_BAR; }
    }
    PG8_WAIT_V(0);
    if constexpr (!ALIGN_EPI) { if (wr == 0) PG8_BAR; }
    PG8_BAR;
    if constexpr (Epi::AFTER_DRAIN) { E.fused(acc, cur, wr, wc, fr, fq, lds, wid, lane); S.done(cur); }
#undef PG8_SA
#undef PG8_SB
#undef PG8_STAGE
#undef PG8_LDA
#undef PG8_LDB
#undef PG8_MMA
#undef PG8_WAIT_V
#undef PG8_WAIT_L
#undef PG8_BAR
#undef PG8_SCHED
}
}
constexpr int NWAVES = 8, NTHR = 512;
constexpr int BATCH = 8, SEQ = 4096, DM = 1024, CTXL = 256, DEPTH = 4;
constexpr int MLAT = BATCH * SEQ, MCTX = BATCH * CTXL, MTOT = MLAT + MCTX;
constexpr int NP_EVEN = 3584, NPAD_EVEN = 3840, NORIG_EVEN = 3616;
constexpr int NP_ODD = 2816, NPAD_ODD = 3072, NORIG_ODD = 2832;
constexpr int NCHUNK = 68;
constexpr int NSLOT = BATCH * 4 * 2 * NCHUNK;
constexpr float ALPHA_DN = 1.681792830507429f;
constexpr size_t MiB = 1u << 20;
constexpr size_t WS_MOD = 0;
constexpr size_t WS_BAR = 512 * 1024;
constexpr size_t WS_ROPE = 1 * MiB;
constexpr size_t WS_SC = WS_ROPE + 65536;
constexpr size_t WS_GAM = 2 * MiB;
constexpr size_t WS_SM = 4 * MiB;
constexpr size_t WS_WIE = 9 * MiB;
constexpr size_t WS_WIO = 24 * MiB;
constexpr size_t WS_WO = 36 * MiB;
constexpr size_t WS_XC = 44 * MiB;
constexpr size_t WS_H = 52 * MiB;
constexpr size_t WS_P = 120 * MiB;
constexpr size_t WS_S = 359 * MiB;
constexpr size_t WS_X16 = 427 * MiB;
constexpr size_t WS_END = WS_X16 + (size_t)MTOT * 1024 * 2;
static_assert(WS_S + (size_t)NSLOT * 8192 * 2 <= WS_X16, "ws map 4");
static_assert(WS_SC + (size_t)NSLOT * 16 <= WS_GAM && WS_GAM + (size_t)NSLOT * 256 <= WS_SM && WS_SM + (size_t)MTOT * 128 <= WS_WIE, "ws map 1");
static_assert(WS_WIE + (size_t)2 * NPAD_EVEN * 1024 * 2 <= WS_WIO && WS_WIO + (size_t)2 * NPAD_ODD * 1024 * 2 <= WS_WO && WS_WO + (size_t)4 * 1024 * 1024 * 2 <= WS_XC, "ws map 2");
static_assert(WS_XC + (size_t)MCTX * 1024 * 4 <= WS_H && WS_H + (size_t)MTOT * 1024 * 2 <= WS_P && WS_P + (size_t)MTOT * NP_EVEN * 2 <= WS_S && WS_END <= 512 * MiB, "ws map 3");
constexpr int LDS_BYTES = 147456;

#define LAS __attribute__((address_space(3)))
typedef unsigned short bf16;
typedef float f32x4 __attribute__((ext_vector_type(4)));
typedef short bf16x8 __attribute__((ext_vector_type(8)));
typedef short s16x4 __attribute__((ext_vector_type(4)));
typedef unsigned u32x4 __attribute__((ext_vector_type(4)));
typedef unsigned u32x2 __attribute__((ext_vector_type(2)));
#define LDS_WAIT() asm volatile("s_waitcnt lgkmcnt(0)" ::: "memory")

typedef __bf16 hbf2 __attribute__((ext_vector_type(2)));
typedef float f32x2_ __attribute__((ext_vector_type(2)));
__device__ __forceinline__ unsigned f2bf(float f) { const __bf16 b = (__bf16)f; return (unsigned)__builtin_bit_cast(unsigned short, b); }
__device__ __forceinline__ unsigned pk2(float lo, float hi) { const f32x2_ v = {lo, hi}; const hbf2 b = __builtin_convertvector(v, hbf2); return __builtin_bit_cast(unsigned, b); }
__device__ __forceinline__ float bf2f(unsigned short v) { return __builtin_bit_cast(float, (unsigned)v << 16); }
__device__ __forceinline__ float bflo(unsigned w) { return __builtin_bit_cast(float, w << 16); }
__device__ __forceinline__ float bfhi(unsigned w) { return __builtin_bit_cast(float, w & 0xffff0000u); }
__device__ __forceinline__ float siluf(float x) { return x * __builtin_amdgcn_rcpf(1.f + __expf(-x)); }
__device__ __forceinline__ float logsigf(float z) { return fminf(z, 0.f) - 0.69314718056f * __builtin_amdgcn_logf(1.f + __builtin_amdgcn_exp2f(-1.44269504089f * fabsf(z))); }
__device__ __forceinline__ float rdlane(float v, int l) { return __builtin_bit_cast(float, __builtin_amdgcn_readlane(__builtin_bit_cast(int, v), l)); }
template <int N> __device__ __forceinline__ float dpp_ror(float v) { return __builtin_bit_cast(float, __builtin_amdgcn_update_dpp(0, __builtin_bit_cast(int, v), 0x120 + N, 0xf, 0xf, false)); }
__device__ __forceinline__ float red16_max(float v) { v = fmaxf(v, dpp_ror<1>(v)); v = fmaxf(v, dpp_ror<2>(v)); v = fmaxf(v, dpp_ror<4>(v)); v = fmaxf(v, dpp_ror<8>(v)); return v; }
__device__ __forceinline__ float red16_sum(float v) { v += dpp_ror<1>(v); v += dpp_ror<2>(v); v += dpp_ror<4>(v); v += dpp_ror<8>(v); return v; }
__device__ __forceinline__ float wave_sum(float v) { v = red16_sum(v); return (rdlane(v, 0) + rdlane(v, 16)) + (rdlane(v, 32) + rdlane(v, 48)); }
__device__ __forceinline__ float wave_max(float v) { v = red16_max(v); return fmaxf(fmaxf(rdlane(v, 0), rdlane(v, 16)), fmaxf(rdlane(v, 32), rdlane(v, 48))); }
template <int N, bool REV> __device__ __forceinline__ float dpp_rshift(float v, float ident) {
    return __builtin_bit_cast(float, __builtin_amdgcn_update_dpp(__builtin_bit_cast(int, ident), __builtin_bit_cast(int, v), (REV ? 0x100 : 0x110) + N, 0xf, 0xf, false));
}
template <bool REV> __device__ __forceinline__ float wave_scan_sum_t(float v, int lane) {
    v += dpp_rshift<1, REV>(v, 0.f); v += dpp_rshift<2, REV>(v, 0.f); v += dpp_rshift<4, REV>(v, 0.f); v += dpp_rshift<8, REV>(v, 0.f);
    const int row = lane >> 4;
    if (!REV) { const float t0 = rdlane(v, 15), t1 = rdlane(v, 31), t2 = rdlane(v, 47);
        v += row == 1 ? t0 : row == 2 ? t0 + t1 : row == 3 ? t0 + t1 + t2 : 0.f; }
    else { const float t1 = rdlane(v, 16), t2 = rdlane(v, 32), t3 = rdlane(v, 48);
        v += row == 2 ? t3 : row == 1 ? t3 + t2 : row == 0 ? t3 + t2 + t1 : 0.f; }
    return v;
}
template <bool REV> __device__ __forceinline__ float wave_scan_max_t(float v, int lane) {
    v = fmaxf(v, dpp_rshift<1, REV>(v, -3e38f)); v = fmaxf(v, dpp_rshift<2, REV>(v, -3e38f)); v = fmaxf(v, dpp_rshift<4, REV>(v, -3e38f)); v = fmaxf(v, dpp_rshift<8, REV>(v, -3e38f));
    const int row = lane >> 4;
    if (!REV) { const float t0 = rdlane(v, 15), t1 = rdlane(v, 31), t2 = rdlane(v, 47);
        v = fmaxf(v, row == 1 ? t0 : row == 2 ? fmaxf(t0, t1) : row == 3 ? fmaxf(fmaxf(t0, t1), t2) : -3e38f); }
    else { const float t1 = rdlane(v, 16), t2 = rdlane(v, 32), t3 = rdlane(v, 48);
        v = fmaxf(v, row == 2 ? t3 : row == 1 ? fmaxf(t3, t2) : row == 0 ? fmaxf(fmaxf(t3, t2), t1) : -3e38f); }
    return v;
}
template <int N, bool REV> __device__ __forceinline__ float dpp_rshift0(float v) {
    return __builtin_bit_cast(float, __builtin_amdgcn_update_dpp(0, __builtin_bit_cast(int, v), (REV ? 0x100 : 0x110) + N, 0xf, 0xf, true));
}
template <int N, bool REV, bool MAX> __device__ __forceinline__ float scan_step(float v, int li) {
    const float t = dpp_rshift0<N, REV>(v); const bool ok = REV ? (li + N < 16) : (li >= N);
    return MAX ? (ok ? fmaxf(v, t) : v) : (ok ? v + t : v);
}
template <bool REV, bool MAX> __device__ __forceinline__ float wave_scan_t(float v, int lane) {
    const int li = lane & 15, row = lane >> 4;
    v = scan_step<1, REV, MAX>(v, li); v = scan_step<2, REV, MAX>(v, li); v = scan_step<4, REV, MAX>(v, li); v = scan_step<8, REV, MAX>(v, li);
    const float a0 = rdlane(v, REV ? 48 : 15), a1 = rdlane(v, REV ? 32 : 31), a2 = rdlane(v, REV ? 16 : 47);
    const int k = REV ? 3 - row : row;
    if (MAX) { float e = v; if (k >= 1) e = fmaxf(e, a0); if (k >= 2) e = fmaxf(e, a1); if (k >= 3) e = fmaxf(e, a2); return e; }
    float e = v; if (k >= 1) e += a0; if (k >= 2) e += a1; if (k >= 3) e += a2; return e;
}
__device__ __forceinline__ float wave_scan_sum(float v, int lane, bool rev) { return rev ? wave_scan_t<true, false>(v, lane) : wave_scan_t<false, false>(v, lane); }
__device__ __forceinline__ float wave_scan_max(float v, int lane, bool rev) { return rev ? wave_scan_t<true, true>(v, lane) : wave_scan_t<false, true>(v, lane); }
#define MFMA(a, b, c) __builtin_amdgcn_mfma_f32_16x16x32_bf16((a), (b), (c), 0, 0, 0)
__device__ __forceinline__ bf16x8 frag_rm(const LAS bf16* X, int ld, int row0, int k0, int lane) {
    return *(const LAS bf16x8*)(X + (row0 + (lane & 15)) * ld + k0 + 8 * (lane >> 4));
}
__device__ __forceinline__ bf16x8 frag_tr(const LAS bf16* X, int ld, int k0, int n0, int lane) {
    const int g = lane >> 4, m = lane & 15, q = m >> 2, p = m & 3;
    const LAS bf16* a0 = X + (k0 + 8 * g + q) * ld + n0 + 4 * p;
    const s16x4 lo = __builtin_amdgcn_ds_read_tr16_b64_v4i16((LAS s16x4*)a0);
    const s16x4 hi = __builtin_amdgcn_ds_read_tr16_b64_v4i16((LAS s16x4*)(a0 + 4 * ld));
    bf16x8 r; r[0] = lo[0]; r[1] = lo[1]; r[2] = lo[2]; r[3] = lo[3]; r[4] = hi[0]; r[5] = hi[1]; r[6] = hi[2]; r[7] = hi[3]; return r;
}

struct Params {
    const float *x, *c, *ctx, *c_ctx, *w_ada, *b_ada, *ln_g, *ln_b, *w_in_even, *w_out_even, *gla_gate_w, *gla_gate_b, *gla_norm_g, *na_rpb, *w_in_odd, *w_out_odd, *ml_gate_b, *ml_norm_g, *sw_sink;
    float* out; unsigned char* ws; long long ph_lo, ph_hi;
};
typedef const __attribute__((address_space(4))) Params* KP;
__device__ __forceinline__ KP kparams() { unsigned long long v = (unsigned long long)__builtin_amdgcn_kernarg_segment_ptr(); asm volatile("" : "+s"(v)); return (KP)v; }

__device__ __forceinline__ int orig_col(int type, int n) {
    if (type == 0) { if (n < 1536) return n; if (n < 3584) return n + 32; if (n < 3616) return n - 3584 + 1536; return -1; }
    if (type == 1) { if (n < 1536) return n; if (n < 2816) return n + 16; if (n < 2832) return n - 2816 + 1536; return -1; }
    return n;
}
__device__ __forceinline__ float col_scale(int type, int n) {
    if (type == 0) return (n < 256 || (n >= 1536 && n < 2048)) ? 0.125f : 1.f;
    if (type == 1) return ((n >= 256 && n < 512) || (n >= 1536 && n < 2048)) ? 0.125f : 1.f;
    return 1.f;
}
__device__ __forceinline__ void p0_transpose_item(const float* __restrict__ W, int K, int Norig, int type, bf16* __restrict__ WT, LAS float* scr, int nblk, int item, int lane) {
    const int kb = item / nblk, nb = item % nblk, k0 = 64 * kb, n0 = 32 * nb;
    const int oc = orig_col(type, n0 + (lane & 31)); const float sc = col_scale(type, n0 + (lane & 31));
#pragma unroll 8
    for (int i = 0; i < 32; ++i) { const int kk = 2 * i + (lane >> 5); scr[kk * 33 + (lane & 31)] = oc >= 0 ? W[(size_t)(k0 + kk) * Norig + oc] * sc : 0.f; }
    LDS_WAIT();
    const int c = lane & 7;
#pragma unroll
    for (int j = 0; j < 4; ++j) { const int n = (lane >> 3) + 8 * j; const LAS float* s = scr + (8 * c) * 33 + n;
        u32x4 o; o.x = pk2(s[0 * 33], s[1 * 33]); o.y = pk2(s[2 * 33], s[3 * 33]); o.z = pk2(s[4 * 33], s[5 * 33]); o.w = pk2(s[6 * 33], s[7 * 33]);
        *(u32x4*)(WT + (size_t)(n0 + n) * K + k0 + 8 * c) = o; }
    LDS_WAIT();
}
__device__ __forceinline__ void phase_prologue(KP p, LAS unsigned char* lds) {
    const int tid = otid(), lane = tid & 63, wave = tid >> 6;
    unsigned char* ws = p->ws;
    float* MOD = (float*)(ws + WS_MOD);
    if ((int)blockIdx.x < 192) {
        LAS float* cond = (LAS float*)lds;
        LAS float* red = (LAS float*)(lds + 36864);
        for (int e = tid; e < 9 * 1024; e += NTHR) { const int j = e >> 10, k = e & 1023; const float v = j < 8 ? p->c[j * 1024 + k] : p->c_ctx[k]; cond[e] = siluf(v); }
        __syncthreads();
        for (int it = blockIdx.x; it < 192; it += gridDim.x) {
            const int l = it / 48, n0 = (it % 48) * 64, cq = tid & 15, ks = tid >> 4;
            float acc[9][4];
#pragma unroll
            for (int j = 0; j < 9; ++j) { acc[j][0] = 0.f; acc[j][1] = 0.f; acc[j][2] = 0.f; acc[j][3] = 0.f; }
            const float* wp = p->w_ada + (size_t)l * 1024 * 3072 + (size_t)(ks * 32) * 3072 + n0 + 4 * cq;
#pragma unroll 4
            for (int kk = 0; kk < 32; ++kk) { const f32x4 w = *(const f32x4*)(wp + (size_t)kk * 3072);
#pragma unroll
                for (int j = 0; j < 9; ++j) { const float cv = cond[j * 1024 + ks * 32 + kk]; acc[j][0] += cv * w[0]; acc[j][1] += cv * w[1]; acc[j][2] += cv * w[2]; acc[j][3] += cv * w[3]; } }
#pragma unroll
            for (int j = 0; j < 9; ++j)
#pragma unroll
                for (int i = 0; i < 4; ++i) red[ks * 576 + j * 64 + 4 * cq + i] = acc[j][i];
            __syncthreads();
            for (int o = tid; o < 576; o += NTHR) { float s = 0.f; for (int q = 0; q < 32; ++q) s += red[q * 576 + o]; const int j = o >> 6, n = n0 + (o & 63);
                MOD[(size_t)(l * 9 + j) * 3072 + n] = s + p->b_ada[l * 3072 + n]; }
            __syncthreads();
        }
    }
    if (blockIdx.x == gridDim.x - 1) {
        float* cosT = (float*)(ws + WS_ROPE); float* sinT = cosT + 1024;
        for (int e = tid; e < 1024; e += NTHR) { const int pos = e >> 4, i = e & 15;
            double f = 1.0; for (int q = 0; q < i; ++q) f *= 0.5623413251903491;
            const double f2 = f * f; double sn = 1.0, cs = 1.0;
            for (int q = 12; q >= 1; --q) { sn = 1.0 - f2 / ((2.0 * q) * (2.0 * q + 1.0)) * sn; cs = 1.0 - f2 / ((2.0 * q - 1.0) * (2.0 * q)) * cs; }
            sn *= f;
            double c = 1.0, s = 0.0; for (int q = 0; q < pos; ++q) { const double c2 = c * cs - s * sn, s2 = s * cs + c * sn; c = c2; s = s2; }
            cosT[e] = (float)c; sinT[e] = (float)s; }
    }
    __syncthreads();
    {
        LAS float* scr = (LAS float*)(lds + wave * 16384);
        const int gw = blockIdx.x * NWAVES + wave, NGW = gridDim.x * NWAVES;
        constexpr int I_E = 16 * (NPAD_EVEN / 32), I_O = 16 * (NPAD_ODD / 32), I_W = 16 * 32;
        constexpr int NIT = 2 * I_E + 2 * I_O + 4 * I_W;
        for (int it = gw; it < NIT; it += NGW) {
            int r = it;
            if (r < 2 * I_E) { const int i = r / I_E; r -= i * I_E; p0_transpose_item(p->w_in_even + (size_t)i * 1024 * NORIG_EVEN, 1024, NORIG_EVEN, 0, (bf16*)(ws + WS_WIE) + (size_t)i * NPAD_EVEN * 1024, scr, NPAD_EVEN / 32, r, lane); continue; }
            r -= 2 * I_E;
            if (r < 2 * I_O) { const int i = r / I_O; r -= i * I_O; p0_transpose_item(p->w_in_odd + (size_t)i * 1024 * NORIG_ODD, 1024, NORIG_ODD, 1, (bf16*)(ws + WS_WIO) + (size_t)i * NPAD_ODD * 1024, scr, NPAD_ODD / 32, r, lane); continue; }
            r -= 2 * I_O;
            { const int l = r / I_W; r -= l * I_W; const float* W = (l & 1) ? p->w_out_odd + (size_t)(l >> 1) * 1024 * 1024 : p->w_out_even + (size_t)(l >> 1) * 1024 * 1024;
              p0_transpose_item(W, 1024, 1024, 2, (bf16*)(ws + WS_WO) + (size_t)l * 1024 * 1024, scr, 32, r, lane); }
        }
    }
}
typedef float f32x8h __attribute__((ext_vector_type(8)));
__device__ __forceinline__ void phase_h0(KP p) {
    const int lane = otid() & 63, gw = blockIdx.x * NWAVES + (otid() >> 6), NGW = gridDim.x * NWAVES;
    const float* MOD = (const float*)(p->ws + WS_MOD); bf16* H = (bf16*)(p->ws + WS_H);
    for (int m = gw; m < MTOT; m += NGW) {
        const int jb = m < MLAT ? (m >> 12) : 8;
        const float* src = m < MLAT ? p->x + (size_t)m * DM : p->ctx + (size_t)(m - MLAT) * DM;
        const float* md = MOD + (size_t)jb * 3072;
#pragma unroll
        for (int j = 0; j < 2; ++j) { const int k = 8 * lane + 512 * j; const f32x8h v = *(const f32x8h*)(src + k), sh = *(const f32x8h*)(md + k), sc = *(const f32x8h*)(md + 1024 + k);
            const f32x8h h = v * (sc + 1.0f) + sh; u32x4 o; o.x = pk2(h[0], h[1]); o.y = pk2(h[2], h[3]); o.z = pk2(h[4], h[5]); o.w = pk2(h[6], h[7]); *(u32x4*)(H + (size_t)m * DM + k) = o; }
    }
}
typedef _Float16 f16x8 __attribute__((ext_vector_type(8)));
typedef float f32x8 __attribute__((ext_vector_type(8)));
struct LnRaw { f32x8 xf[2][2]; f16x8 xh[2][2]; u32x4 y[2][2]; };
__device__ __forceinline__ void ln_load(LnRaw& R, int l, int m0, int lane, const float* xin, const float* cin, const _Float16* X16, const bf16* Y) {
#pragma unroll
    for (int j = 0; j < 2; ++j) { const int k = 8 * lane + 512 * j;
#pragma unroll
        for (int q = 0; q < 2; ++q) { const int m = m0 + q;
            if (l == 0) R.xf[q][j] = *(const f32x8*)((m < MLAT ? xin + (size_t)m * DM : cin + (size_t)(m - MLAT) * DM) + k);
            else R.xh[q][j] = *(const f16x8*)(X16 + (size_t)m * DM + k);
            R.y[q][j] = *(const u32x4*)(Y + (size_t)m * DM + k); } }
}
__device__ __forceinline__ float sum8(const f32x8 v) { return ((v[0] + v[1]) + (v[2] + v[3])) + ((v[4] + v[5]) + (v[6] + v[7])); }
__device__ __forceinline__ u32x4 pack8(const f32x8 h) { u32x4 w; w.x = pk2(h[0], h[1]); w.y = pk2(h[2], h[3]); w.z = pk2(h[4], h[5]); w.w = pk2(h[6], h[7]); return w; }
__device__ __forceinline__ void phase_ln(KP p, int l, bool dummy = false) {
    const int lane = otid() & 63, gw = blockIdx.x * NWAVES + (otid() >> 6), NGW = gridDim.x * NWAVES;
    const float* MOD = (const float*)(p->ws + WS_MOD); bf16* H = (bf16*)(p->ws + WS_H); const bf16* Y = (const bf16*)(p->ws + WS_P); _Float16* X16 = (_Float16*)(p->ws + WS_X16);
    const int mrows = l < DEPTH - 1 ? MTOT : MLAT;
    const float* lg = p->ln_g + l * DM; const float* lb = p->ln_b + l * DM;
    const float* xin = p->x; const float* cin = p->ctx; float* outp = p->out;
    LnRaw R;
    if (2 * gw < mrows) ln_load(R, l, 2 * gw, lane, xin, cin, X16, Y);
    for (int m0 = 2 * gw; m0 < mrows; m0 += 2 * NGW) {
        const int jb = m0 < MLAT ? (m0 >> 12) : 8;
        const float* md = MOD + (size_t)(l * 9 + jb) * 3072;
        f32x8 v[2][2], xs[2][2]; float s[2] = {0.f, 0.f};
#pragma unroll
        for (int j = 0; j < 2; ++j) { const int k = 8 * lane + 512 * j; const f32x8 g = *(const f32x8*)(md + 2048 + k);
#pragma unroll
            for (int q = 0; q < 2; ++q) { const f32x8 xv = l == 0 ? R.xf[q][j] : __builtin_convertvector(R.xh[q][j], f32x8); const u32x4 yw = R.y[q][j];
                f32x8 y; y[0] = bflo(yw.x); y[1] = bfhi(yw.x); y[2] = bflo(yw.y); y[3] = bfhi(yw.y); y[4] = bflo(yw.z); y[5] = bfhi(yw.z); y[6] = bflo(yw.w); y[7] = bfhi(yw.w);
                xs[q][j] = xv; v[q][j] = xv * ALPHA_DN + g * y; s[q] += sum8(v[q][j]); } }
        if (m0 + 2 * NGW < mrows) ln_load(R, l, m0 + 2 * NGW, lane, xin, cin, X16, Y);
        float rstd[2];
#pragma unroll
        for (int q = 0; q < 2; ++q) { const float mean = wave_sum(s[q]) * (1.f / DM); float s2 = 0.f;
#pragma unroll
            for (int j = 0; j < 2; ++j) { v[q][j] = v[q][j] - mean; s2 += sum8(v[q][j] * v[q][j]); }
            rstd[q] = 1.f / sqrtf(wave_sum(s2) * (1.f / DM) + 1e-5f); }
        const float* md2 = MOD + (size_t)((l + 1) * 9 + jb) * 3072;
#pragma unroll
        for (int j = 0; j < 2; ++j) { const int k = 8 * lane + 512 * j; const f32x8 gg = *(const f32x8*)(lg + k), bb = *(const f32x8*)(lb + k);
            f32x8 sh = gg * 0.f, sc = sh; if (l < DEPTH - 1) { sh = *(const f32x8*)(md2 + k); sc = *(const f32x8*)(md2 + 1024 + k); }
#pragma unroll
            for (int q = 0; q < 2; ++q) { const int m = m0 + q; const f32x8 o = v[q][j] * rstd[q] * gg + bb;
                if (l < DEPTH - 1) { *(f16x8*)(X16 + (size_t)m * DM + k) = __builtin_convertvector(dummy ? xs[q][j] : o, f16x8);
                    *(u32x4*)(H + (size_t)m * DM + k) = pack8(o * (sc + 1.0f) + sh); }
                else { if (!dummy) *(f32x8*)(outp + (size_t)m * DM + k) = o; } } }
    }
}
constexpr int AT_KS = 0, AT_VS = 9216, AT_BUF = 18432, AT_PS = 36864, AT_RPB = AT_PS + 8 * 2304;
__device__ __forceinline__ bf16x8 frag_tr_perm(const LAS bf16* X, int ld, int k0, int n0, int lane) {
    const int g = lane >> 4, m = lane & 15, q = m >> 2, p = m & 3;
    const LAS bf16* a0 = X + (k0 + 4 * g + q) * ld + n0 + 4 * p;
    const s16x4 lo = __builtin_amdgcn_ds_read_tr16_b64_v4i16((LAS s16x4*)a0);
    const s16x4 hi = __builtin_amdgcn_ds_read_tr16_b64_v4i16((LAS s16x4*)(a0 + 16 * ld));
    bf16x8 r; r[0] = lo[0]; r[1] = lo[1]; r[2] = lo[2]; r[3] = lo[3]; r[4] = hi[0]; r[5] = hi[1]; r[6] = hi[2]; r[7] = hi[3]; return r;
}
__device__ __forceinline__ void attn_tile(const LAS bf16* Ks, const LAS bf16* Vs, const LAS float* rpb, const bf16x8 (&qa)[2][2], float (&mrow)[2], float (&lsum)[2], f32x4 (&oacc)[2][4],
                                          int mode, int i, int nlat, int qa_, int qb_, int ka_, int lane) {
    const int fq = lane >> 4, fr = lane & 15;
    const bool islat = i < nlat;
    bool active = true; int kt0 = 0;
    if (islat) {
        if (mode == 0) { kt0 = ka_ + i; const int rs = min(max(qa_ - 4, 0), 56); active = (kt0 >= rs) && (kt0 < rs + 8); }
        else { kt0 = ka_ + 64 * i; active = !(kt0 > qa_ + 31 + 128 || kt0 + 63 < qa_ - 128); }
    }
    if (!active) return;
    const bool nar = islat && mode == 0;
    const int ct0 = qb_ >> 4;
    int ntlo[2], nthi[2];
#pragma unroll
    for (int nq = 0; nq < 2; ++nq) { const int ct = ct0 + nq; ntlo[nq] = nar ? (ct < 2 ? 0 : ct - 1) : 0; nthi[nq] = nar ? (ct > 1 ? 3 : ct + 1) : 3; }
    const int ulo = min(ntlo[0], ntlo[1]), uhi = max(nthi[0], nthi[1]);
    f32x4 s[2][4];
#pragma unroll
    for (int mt = 0; mt < 4; ++mt) { s[0][mt] = (f32x4){0.f, 0.f, 0.f, 0.f}; s[1][mt] = (f32x4){0.f, 0.f, 0.f, 0.f};
        if (mt >= ulo && mt <= uhi) {
#pragma unroll
            for (int ks = 0; ks < 2; ++ks) { const bf16x8 kf = frag_rm(Ks, 72, 16 * mt, 32 * ks, lane);
                if (mt >= ntlo[0] && mt <= nthi[0]) s[0][mt] = MFMA(kf, qa[0][ks], s[0][mt]);
                if (mt >= ntlo[1] && mt <= nthi[1]) s[1][mt] = MFMA(kf, qa[1][ks], s[1][mt]); } } }
    unsigned pw[2][8];
    const bool swa_mask = islat && mode == 1 && !((qa_ + 31 - kt0 <= 128) && (qa_ - kt0 - 63 >= -128));
    constexpr float L2E = 1.44269504089f;
#pragma unroll
    for (int nq = 0; nq < 2; ++nq) {
        float tmax = -3e38f;
        if (nar) {
            const int qc = qb_ + 16 * nq + fr, cs = min(max(qc - 8, 0), 48);
            const unsigned long long ml = (0xFFFFull << cs) >> (4 * fq);
            const unsigned mlo = (unsigned)ml, mhi = (unsigned)(ml >> 32);
            const LAS float* bp = rpb + (kt0 - qa_ + 7) * 31 + (4 * fq - qc + 15);
#pragma unroll
            for (int mt = 0; mt < 4; ++mt) { if (mt >= ntlo[nq] && mt <= nthi[nq]) {
#pragma unroll
                for (int r = 0; r < 4; ++r) { const int pbit = 16 * mt + r; const bool ok = ((pbit < 32 ? mlo >> pbit : mhi >> (pbit - 32)) & 1u) != 0u;
                    const float v = ok ? s[nq][mt][r] + bp[ok ? pbit : 0] : -3e38f; s[nq][mt][r] = v; tmax = fmaxf(tmax, v); } } }
        } else if (swa_mask) {
            const int d0 = (qa_ + 16 * nq + fr) - (kt0 + 4 * fq);
#pragma unroll
            for (int mt = 0; mt < 4; ++mt)
#pragma unroll
                for (int r = 0; r < 4; ++r) { const int d = d0 - (16 * mt + r); const float v = (d <= 128 && d >= -128) ? s[nq][mt][r] : -3e38f; s[nq][mt][r] = v; tmax = fmaxf(tmax, v); }
        } else {
#pragma unroll
            for (int mt = 0; mt < 4; ++mt)
#pragma unroll
                for (int r = 0; r < 4; ++r) tmax = fmaxf(tmax, s[nq][mt][r]);
        }
        tmax = fmaxf(tmax, __shfl_xor(tmax, 16)); tmax = fmaxf(tmax, __shfl_xor(tmax, 32));
        const float mnew = fmaxf(mrow[nq], tmax); const float alpha = __builtin_amdgcn_exp2f((mrow[nq] - mnew) * L2E); mrow[nq] = mnew;
        const float nm = -mnew * L2E;
        float ps = 0.f;
#pragma unroll
        for (int mt = 0; mt < 4; ++mt) { float p0 = 0.f, p1 = 0.f, p2 = 0.f, p3 = 0.f;
            if (mt >= ntlo[nq] && mt <= nthi[nq]) { p0 = __builtin_amdgcn_exp2f(__builtin_fmaf(s[nq][mt][0], L2E, nm)); p1 = __builtin_amdgcn_exp2f(__builtin_fmaf(s[nq][mt][1], L2E, nm));
                p2 = __builtin_amdgcn_exp2f(__builtin_fmaf(s[nq][mt][2], L2E, nm)); p3 = __builtin_amdgcn_exp2f(__builtin_fmaf(s[nq][mt][3], L2E, nm)); ps += (p0 + p1) + (p2 + p3); }
            pw[nq][2 * mt] = pk2(p0, p1); pw[nq][2 * mt + 1] = pk2(p2, p3); oacc[nq][mt] = oacc[nq][mt] * alpha; }
        lsum[nq] = lsum[nq] * alpha + ps;
    }
#pragma unroll
    for (int ks = 0; ks < 2; ++ks) { if (ks == 0 ? (ulo < 2) : (uhi > 1)) {
        const u32x4 pu0 = (u32x4){pw[0][4 * ks], pw[0][4 * ks + 1], pw[0][4 * ks + 2], pw[0][4 * ks + 3]}, pu1 = (u32x4){pw[1][4 * ks], pw[1][4 * ks + 1], pw[1][4 * ks + 2], pw[1][4 * ks + 3]};
        const bf16x8 pb0 = __builtin_bit_cast(bf16x8, pu0), pb1 = __builtin_bit_cast(bf16x8, pu1);
#pragma unroll
        for (int mt = 0; mt < 4; ++mt) { const bf16x8 vf = frag_tr_perm(Vs, 72, 32 * ks, 16 * mt, lane); oacc[0][mt] = MFMA(vf, pb0, oacc[0][mt]); oacc[1][mt] = MFMA(vf, pb1, oacc[1][mt]); } } }
}
constexpr int AT_PSW = 32 * 72 * 2;
constexpr int AT_RPB2 = AT_PS + 8 * AT_PSW;
__device__ __forceinline__ void attn_item(LAS unsigned char* lds, const bf16* __restrict__ P, int ldp, bf16* __restrict__ Z, int mode,
                                          int qrow0, int qcol, int kcol, int vcol, int gcol, int zcol,
                                          int nlat, int lat_row0, int ctx_row0, int qa_, int qb_, int ka_, const float* __restrict__ rpb_g, float sink) {
    const int tid = otid(), lane = tid & 63, wave = tid >> 6, fq = lane >> 4, fr = lane & 15;
    LAS bf16* Ks0 = (LAS bf16*)(lds + AT_KS); LAS bf16* Vs0 = (LAS bf16*)(lds + AT_VS); LAS bf16* Ks1 = (LAS bf16*)(lds + AT_KS + AT_BUF); LAS bf16* Vs1 = (LAS bf16*)(lds + AT_VS + AT_BUF);
    LAS bf16* Ps = (LAS bf16*)(lds + AT_PS + wave * AT_PSW); LAS float* rpb = (LAS float*)(lds + AT_RPB2);
    const int ntile = nlat + 4, srow = tid >> 3, sch = tid & 7, soff = srow * 72 + 8 * sch;
#define AT_ROWB(j) (((j) < nlat) ? lat_row0 + 64 * (j) : ctx_row0 + 64 * ((j) - nlat))
#define AT_LOAD(kr, vr, j) do { const size_t ro_ = (size_t)(AT_ROWB(j) + srow) * ldp + 8 * sch; kr = *(const u32x4*)(P + ro_ + kcol); vr = *(const u32x4*)(P + ro_ + vcol); } while (0)
    u32x4 k0, v0, k1, v1;
    AT_LOAD(k0, v0, 0);
    bf16x8 qa[2][2];
#pragma unroll
    for (int nq = 0; nq < 2; ++nq)
#pragma unroll
        for (int ks = 0; ks < 2; ++ks) qa[nq][ks] = *(const bf16x8*)(P + (size_t)(qrow0 + 16 * nq + fr) * ldp + qcol + 32 * ks + 8 * fq);
    __syncthreads();
    if (mode == 0) { for (int e = tid; e < 465; e += NTHR) rpb[e] = rpb_g[e]; }
    *(LAS u32x4*)(Ks0 + soff) = k0; *(LAS u32x4*)(Vs0 + soff) = v0;
    AT_LOAD(k0, v0, 1);
    AT_LOAD(k1, v1, 2);
    float mrow[2] = {-1e30f, -1e30f}, lsum[2] = {0.f, 0.f}; f32x4 oacc[2][4];
#pragma unroll
    for (int nq = 0; nq < 2; ++nq)
#pragma unroll
        for (int r = 0; r < 4; ++r) oacc[nq][r] = (f32x4){0.f, 0.f, 0.f, 0.f};
    __syncthreads();
    for (int i = 0; i < ntile; i += 2) {
        attn_tile(Ks0, Vs0, rpb, qa, mrow, lsum, oacc, mode, i, nlat, qa_, qb_, ka_, lane);
        if (i + 1 < ntile) { *(LAS u32x4*)(Ks1 + soff) = k0; *(LAS u32x4*)(Vs1 + soff) = v0; }
        if (i + 3 < ntile) AT_LOAD(k0, v0, i + 3);
        __syncthreads();
        if (i + 1 >= ntile) break;
        attn_tile(Ks1, Vs1, rpb, qa, mrow, lsum, oacc, mode, i + 1, nlat, qa_, qb_, ka_, lane);
        if (i + 2 < ntile) { *(LAS u32x4*)(Ks0 + soff) = k1; *(LAS u32x4*)(Vs0 + soff) = v1; }
        if (i + 4 < ntile) AT_LOAD(k1, v1, i + 4);
        __syncthreads();
    }
#undef AT_LOAD
#undef AT_ROWB
    u32x4 gvv[4];
#pragma unroll
    for (int c2 = 0; c2 < 4; ++c2) { const int idx = lane + 64 * c2, q = idx >> 3, ch = idx & 7; gvv[c2] = *(const u32x4*)(P + (size_t)(qrow0 + q) * ldp + gcol + 8 * ch); }
#pragma unroll
    for (int nq = 0; nq < 2; ++nq) { float lt = lsum[nq]; lt += __shfl_xor(lt, 16); lt += __shfl_xor(lt, 32); float sc;
      if (mode == 1 || mode == 3) { const float mf = fmaxf(mrow[nq], sink); const float al = __expf(mrow[nq] - mf); lt = lt * al + __expf(sink - mf); sc = al / lt; } else sc = 1.f / lt;
#pragma unroll
      for (int mt = 0; mt < 4; ++mt) { u32x2 w; w.x = pk2(oacc[nq][mt][0] * sc, oacc[nq][mt][1] * sc); w.y = pk2(oacc[nq][mt][2] * sc, oacc[nq][mt][3] * sc); *(LAS u32x2*)(Ps + (16 * nq + fr) * 72 + 16 * mt + 4 * fq) = w; } }
    LDS_WAIT();
#pragma unroll
    for (int c2 = 0; c2 < 4; ++c2) { const int idx = lane + 64 * c2, q = idx >> 3, ch = idx & 7;
        const u32x4 ov = *(const LAS u32x4*)(Ps + q * 72 + 8 * ch); const u32x4 gv = gvv[c2];
        u32x4 w;
        w.x = pk2(bflo(ov.x) * siluf(bflo(gv.x)), bfhi(ov.x) * siluf(bfhi(gv.x))); w.y = pk2(bflo(ov.y) * siluf(bflo(gv.y)), bfhi(ov.y) * siluf(bfhi(gv.y)));
        w.z = pk2(bflo(ov.z) * siluf(bflo(gv.z)), bfhi(ov.z) * siluf(bfhi(gv.z))); w.w = pk2(bflo(ov.w) * siluf(bflo(gv.w)), bfhi(ov.w) * siluf(bfhi(gv.w)));
        *(u32x4*)(Z + (size_t)(qrow0 + q) * DM + zcol + 8 * ch) = w; }
    LDS_WAIT();
}
__device__ __forceinline__ void phase_attn(KP p, LAS unsigned char* lds, int l, bool need_ctx) {
    const int wave = otid() >> 6; const bool odd = l & 1; const int li = l >> 1;
    const bf16* P = (const bf16*)(p->ws + WS_P); bf16* Z = (bf16*)(p->ws + WS_H); const int ldp = odd ? NP_ODD : NP_EVEN;
    const int nmain = BATCH * 8 * 16, nctx = need_ctx ? BATCH * 8 : 0;
    for (int it = blockIdx.x; it < nmain + nctx; it += gridDim.x) {
        if (it < nmain) {
            int itv = it;
            if (gridDim.x == 256) { const int rnd = it >> 8, bx = it & 255, xcd = bx & 7, slot = bx >> 3; itv = ((rnd * 16 + 2 * xcd + (slot >> 4)) << 4) + (slot & 15); }
            const int b = itv >> 7, h = (itv >> 4) & 7, qb = itv & 15;
            if (!odd) { const int r0 = 4 * qb, rw = r0 + (wave >> 1); const int rs0 = min(max(r0 - 4, 0), 56), rs3 = min(max(r0 + 3 - 4, 0), 56);
                attn_item(lds, P, ldp, Z, 0, b * SEQ + rw * 64 + 32 * (wave & 1), 1536 + h * 64, 2048 + h * 64, 2560 + h * 64, 3072 + h * 64, 512 + h * 64,
                          rs3 + 8 - rs0, b * SEQ + rs0 * 64, MLAT + b * CTXL, rw, 32 * (wave & 1), rs0, p->na_rpb + (size_t)(li * 8 + h) * 465, 0.f); }
            else {
                int itw = it; if (gridDim.x == 256) { const int rnd = it >> 8, bx = it & 255, xcd = bx & 7, slot = bx >> 3; itw = ((rnd * 8 + xcd) << 5) + slot; }
                const int bb = itw >> 7, kv = (itw >> 6) & 1, qb2 = itw & 63, hh = 4 * kv + (wave >> 1), w2 = wave & 1;
                const int t0 = 64 * qb2, lt0 = max(0, qb2 - 2), lt1 = min(63, qb2 + 2);
                attn_item(lds, P, ldp, Z, 1, bb * SEQ + t0 + 32 * w2, 1536 + hh * 64, 2048 + kv * 64, 2176 + kv * 64, 2304 + hh * 64, 512 + hh * 64,
                          lt1 - lt0 + 1, bb * SEQ + lt0 * 64, MLAT + bb * CTXL, t0 + 32 * w2, 0, lt0 * 64, nullptr, p->sw_sink[li * 8 + hh]); }
        } else {
            const int j = it - nmain, b = j >> 3, h = j & 7; const int q0 = MLAT + b * CTXL + 32 * wave;
            if (!odd) attn_item(lds, P, ldp, Z, 2, q0, 1536 + h * 64, 2048 + h * 64, 2560 + h * 64, 3072 + h * 64, 512 + h * 64, 0, 0, MLAT + b * CTXL, 0, 0, 0, nullptr, 0.f);
            else { const int kv = h >> 2; attn_item(lds, P, ldp, Z, 3, q0, 1536 + h * 64, 2048 + kv * 64, 2176 + kv * 64, 2304 + h * 64, 512 + h * 64, 0, 0, MLAT + b * CTXL, 0, 0, 0, nullptr, p->sw_sink[li * 8 + h]); }
        }
    }
}
__device__ __forceinline__ int chunk_row0(int b, int cp) { return cp < 4 ? MLAT + b * CTXL + cp * 64 : b * SEQ + (cp - 4) * 64; }
constexpr int SL_KDF = 0, SL_KDB = 9216, SL_VS = 18432, SL_SEG = 35840, SL_MISC = 39936;
__device__ __forceinline__ void phase_scan_local(KP p, LAS unsigned char* lds, int l) {
    const int tid = otid(), lane = tid & 63, wave = tid >> 6, fq = lane >> 4, fr = lane & 15; const bool odd = l & 1; const int li = l >> 1;
    const bf16* P = (const bf16*)(p->ws + WS_P); const int ldp = odd ? NP_ODD : NP_EVEN; const float* SM = (const float*)(p->ws + WS_SM);
    bf16* S = (bf16*)(p->ws + WS_S); float* GAM = (float*)(p->ws + WS_GAM); float* SC = (float*)(p->ws + WS_SC);
    LAS bf16* kdf = (LAS bf16*)(lds + SL_KDF); LAS bf16* kdb = (LAS bf16*)(lds + SL_KDB); LAS bf16* vs = (LAS bf16*)(lds + SL_VS);
    LAS float* seg = (LAS float*)(lds + SL_SEG); LAS float* misc = (LAS float*)(lds + SL_MISC);
    const int dk = tid & 63, sg = tid >> 6;
    for (int it = blockIdx.x; it < BATCH * 4 * NCHUNK; it += gridDim.x) {
        const int b = it / (4 * NCHUNK), h = (it / NCHUNK) & 3, cp = it % NCHUNK; const int row0 = chunk_row0(b, cp);
        const int slf = ((b * 4 + h) * 2 + 0) * NCHUNK + cp, slb = slf + NCHUNK;
        __syncthreads();
#pragma unroll
        for (int c2 = 0; c2 < 2; ++c2) { const int idx = tid + NTHR * c2, t = idx >> 4, ch = idx & 15; *(LAS u32x4*)(vs + t * 136 + 8 * ch) = *(const u32x4*)(P + (size_t)(row0 + t) * ldp + 512 + h * 128 + 8 * ch); }
        float kv[8];
#pragma unroll
        for (int tt = 0; tt < 8; ++tt) kv[tt] = bf2f(P[(size_t)(row0 + sg * 8 + tt) * ldp + 256 + h * 64 + dk]);
        if (!odd) {
            float gwf[16], gwb[16];
            const float* gw = p->gla_gate_w + (size_t)li * 2 * 16 * 256; const float* gb = p->gla_gate_b + (size_t)li * 2 * 256;
#pragma unroll
            for (int r = 0; r < 16; ++r) { gwf[r] = gw[r * 256 + h * 64 + dk]; gwb[r] = gw[(16 + r) * 256 + h * 64 + dk]; }
            const float gbf = gb[h * 64 + dk], gbb = gb[256 + h * 64 + dk];
            { const int t = tid >> 3, c4 = (tid & 7) * 4; *(LAS f32x4*)(misc + t * 32 + c4) = *(const f32x4*)(SM + (size_t)(row0 + t) * 32 + c4); }
            __syncthreads();
            float pf[8], sb[8];
            f32x4 L[2][8];
#pragma unroll
            for (int i = 0; i < 8; ++i) L[0][i] = *(const LAS f32x4*)(misc + (sg * 8) * 32 + 4 * i);
#pragma unroll
            for (int tt = 0; tt < 8; ++tt) {
                if (tt < 7) {
#pragma unroll
                    for (int i = 0; i < 8; ++i) L[(tt + 1) & 1][i] = *(const LAS f32x4*)(misc + (sg * 8 + tt + 1) * 32 + 4 * i); }
                float zf = gbf, zb = gbb, zf2 = 0.f, zb2 = 0.f;
#pragma unroll
                for (int i = 0; i < 4; i += 2)
#pragma unroll
                    for (int e = 0; e < 4; ++e) { zf += L[tt & 1][i][e] * gwf[4 * i + e]; zf2 += L[tt & 1][i + 1][e] * gwf[4 * i + 4 + e]; zb += L[tt & 1][4 + i][e] * gwb[4 * i + e]; zb2 += L[tt & 1][5 + i][e] * gwb[4 * i + 4 + e]; }
                pf[tt] = logsigf(zf + zf2) * 0.0625f; sb[tt] = logsigf(zb + zb2) * 0.0625f; }
#pragma unroll
            for (int tt = 1; tt < 8; ++tt) pf[tt] += pf[tt - 1];
#pragma unroll
            for (int tt = 6; tt >= 0; --tt) sb[tt] += sb[tt + 1];
            seg[(0 * 8 + sg) * 64 + dk] = pf[7]; seg[(1 * 8 + sg) * 64 + dk] = sb[0];
            __syncthreads();
            float offf = 0.f, totf = 0.f, offb = 0.f, totb = 0.f;
#pragma unroll
            for (int q = 0; q < 8; ++q) { const float a = seg[q * 64 + dk], c = seg[(8 + q) * 64 + dk]; totf += a; totb += c; if (q < sg) offf += a; if (q > sg) offb += c; }
#pragma unroll
            for (int tt = 0; tt < 8; ++tt) { const int t = sg * 8 + tt;
                kdf[t * 72 + dk] = (bf16)f2bf(kv[tt] * __expf(totf - (offf + pf[tt]))); kdb[t * 72 + dk] = (bf16)f2bf(kv[tt] * __expf(totb - (offb + sb[tt]))); }
            if (sg == 0) { GAM[(size_t)slf * 64 + dk] = __expf(totf); GAM[(size_t)slb * 64 + dk] = __expf(totb); }
        } else {
            const float* mb = p->ml_gate_b + li * 16;
            if (tid < 128) { const int d = tid >> 6, t = tid & 63; const float* gp = SM + (size_t)(row0 + t) * 32 + d * 8;
                misc[d * 128 + t] = gp[h] + mb[d * 8 + h]; misc[d * 128 + 64 + t] = logsigf(gp[4 + h] + mb[d * 8 + 4 + h]); }
            __syncthreads();
            if (tid < 128) { const int d = tid >> 6, t = tid & 63; const float run = wave_scan_sum(misc[d * 128 + 64 + t], t, d == 1);
                const float tot = d == 0 ? __shfl(run, 63) : __shfl(run, 0);
                const float wl = tot - run + misc[d * 128 + t]; const float ml = wave_max(wl);
                misc[256 + d * 64 + t] = __expf(wl - ml);
                if (t == 0) { const int sl = d == 0 ? slf : slb; SC[(size_t)sl * 4 + 0] = tot; SC[(size_t)sl * 4 + 1] = ml; } }
            __syncthreads();
            float nf = 0.f, nb = 0.f;
#pragma unroll
            for (int tt = 0; tt < 8; ++tt) { const int t = sg * 8 + tt; const float a = kv[tt] * misc[256 + t], c = kv[tt] * misc[256 + 64 + t]; nf += a; nb += c;
                kdf[t * 72 + dk] = (bf16)f2bf(a); kdb[t * 72 + dk] = (bf16)f2bf(c); }
            seg[(0 * 8 + sg) * 64 + dk] = nf; seg[(1 * 8 + sg) * 64 + dk] = nb;
            __syncthreads();
            if (sg < 2) { float s2 = 0.f;
#pragma unroll
                for (int q = 0; q < 8; ++q) s2 += seg[(sg * 8 + q) * 64 + dk];
                GAM[(size_t)(sg == 0 ? slf : slb) * 64 + dk] = s2; }
        }
        __syncthreads();
#pragma unroll
        for (int d = 0; d < 2; ++d) { const LAS bf16* kd = d ? kdb : kdf; f32x4 acc[4];
#pragma unroll
            for (int nt = 0; nt < 4; ++nt) acc[nt] = (f32x4){0.f, 0.f, 0.f, 0.f};
#pragma unroll
            for (int ks = 0; ks < 2; ++ks) { const bf16x8 av = frag_tr(vs, 136, 32 * ks, 16 * wave, lane);
#pragma unroll
                for (int nt = 0; nt < 4; ++nt) acc[nt] = MFMA(av, frag_tr(kd, 72, 32 * ks, 16 * nt, lane), acc[nt]); }
            bf16* dst = S + (size_t)(d ? slb : slf) * 8192;
#pragma unroll
            for (int nt = 0; nt < 4; ++nt) { u32x2 w; w.x = pk2(acc[nt][0], acc[nt][1]); w.y = pk2(acc[nt][2], acc[nt][3]); *(u32x2*)(dst + (16 * nt + fr) * 128 + 16 * wave + 4 * fq) = w; } }
    }
}
__device__ __forceinline__ void phase_scan_seq(KP p, int l, bool dummy = false) {
    const bool odd = l & 1;
    u32x2* S2 = (u32x2*)(p->ws + WS_S); float* GAM = (float*)(p->ws + WS_GAM); f32x4* GAM4 = (f32x4*)(p->ws + WS_GAM); float* SC = (float*)(p->ws + WS_SC);
    const int nthreads = gridDim.x * NTHR;
    for (int gid = blockIdx.x * NTHR + otid(); gid < 64 * 2048; gid += nthreads) {
        const int chain = gid >> 11, e4 = gid & 2047, dir = chain & 1, dkk = e4 >> 5; const int base = chain * NCHUNK;
        f32x4 st = (f32x4){0.f, 0.f, 0.f, 0.f}, nst = (f32x4){0.f, 0.f, 0.f, 0.f}; float m = 0.f; const bool hasn = odd && e4 < 16;
        for (int s0 = 0; s0 < NCHUNK; s0 += 4) {
            u32x2 dr[4]; f32x4 dn[4]; float g0[4], g1[4]; int idx[4];
#pragma unroll
            for (int u = 0; u < 4; ++u) { const int step = s0 + u; const int cp = dir == 0 ? step : (step < 4 ? 3 - step : 71 - step); idx[u] = base + cp;
                dr[u] = S2[(size_t)idx[u] * 2048 + e4];
                if (!odd) { g0[u] = GAM[(size_t)idx[u] * 64 + dkk]; g1[u] = 0.f; } else { g0[u] = SC[(size_t)idx[u] * 4 + 0]; g1[u] = SC[(size_t)idx[u] * 4 + 1]; if (hasn) dn[u] = GAM4[(size_t)idx[u] * 16 + e4]; } }
#pragma unroll
            for (int u = 0; u < 4; ++u) {
                const f32x4 d = (f32x4){bflo(dr[u].x), bfhi(dr[u].x), bflo(dr[u].y), bfhi(dr[u].y)};
                u32x2 w; w.x = pk2(st[0], st[1]); w.y = pk2(st[2], st[3]);
                S2[(size_t)idx[u] * 2048 + e4] = dummy ? dr[u] : w;
                if (!odd) { st = st * g0[u] + d; }
                else { if (hasn) GAM4[(size_t)idx[u] * 16 + e4] = dummy ? dn[u] : nst; if (e4 == 0 && !dummy) SC[(size_t)idx[u] * 4 + 2] = m;
                    const float mn = fmaxf(g0[u] + m, g1[u]); const float dec = __expf(g0[u] + m - mn), sc = __expf(g1[u] - mn);
                    st = st * dec + d * sc; if (hasn) nst = nst * dec + dn[u] * sc; m = mn; }
            }
        }
    }
}
constexpr int SO_QF = 0, SO_KF = 9216, SO_QB = 18432, SO_KB = 27648, SO_VS = 36864, SO_AF = 54272, SO_AB = 63488, SO_SF = 72704, SO_SB = 90112, SO_SEG = 107520, SO_SSQ = 111616, SO_MISC = 113664;
constexpr int SO_OST = 0;
__device__ __forceinline__ void scan_out_tail(LAS unsigned char* lds, f32x4 (&o)[4], const bf16* __restrict__ P, int ldp, bf16* __restrict__ Z, int row0, int h, const float* __restrict__ ng) {
    const int tid = otid(), lane = tid & 63, wave = tid >> 6, fq = lane >> 4, fr = lane & 15;
    LAS float* ost = (LAS float*)(lds + SO_OST);
    u32x4 gv[2]; f32x4 g0[2], g1[2];
#pragma unroll
    for (int c2 = 0; c2 < 2; ++c2) { const int idx = tid + NTHR * c2, t = idx >> 4, ch = idx & 15;
        gv[c2] = *(const u32x4*)(P + (size_t)(row0 + t) * ldp + 1024 + h * 128 + 8 * ch); g0[c2] = *(const f32x4*)(ng + h * 128 + 8 * ch); g1[c2] = *(const f32x4*)(ng + h * 128 + 8 * ch + 4); }
    __syncthreads();
#pragma unroll
    for (int mt = 0; mt < 4; ++mt)
#pragma unroll
        for (int r = 0; r < 4; ++r) ost[(16 * mt + 4 * fq + r) * 132 + 16 * wave + fr] = o[mt][r];
    __syncthreads();
#pragma unroll
    for (int c2 = 0; c2 < 2; ++c2) { const int idx = tid + NTHR * c2, t = idx >> 4, ch = idx & 15;
        f32x4 o0 = *(const LAS f32x4*)(ost + t * 132 + 8 * ch), o1 = *(const LAS f32x4*)(ost + t * 132 + 8 * ch + 4);
        const float q = red16_sum((o0[0] * o0[0] + o0[1] * o0[1]) + (o0[2] * o0[2] + o0[3] * o0[3]) + (o1[0] * o1[0] + o1[1] * o1[1]) + (o1[2] * o1[2] + o1[3] * o1[3]));
        const float rs = rsqrtf(q * (1.f / 128.f) + 1e-6f); o0 = o0 * rs * g0[c2]; o1 = o1 * rs * g1[c2];
        u32x4 w;
        w.x = pk2(o0[0] * siluf(bflo(gv[c2].x)), o0[1] * siluf(bfhi(gv[c2].x))); w.y = pk2(o0[2] * siluf(bflo(gv[c2].y)), o0[3] * siluf(bfhi(gv[c2].y)));
        w.z = pk2(o1[0] * siluf(bflo(gv[c2].z)), o1[1] * siluf(bfhi(gv[c2].z))); w.w = pk2(o1[2] * siluf(bflo(gv[c2].w)), o1[3] * siluf(bfhi(gv[c2].w)));
        *(u32x4*)(Z + (size_t)(row0 + t) * DM + h * 128 + 8 * ch) = w; }
}
__device__ __forceinline__ void stage_state(LAS bf16* dst, const bf16* __restrict__ src) {
    const int tid = otid();
#pragma unroll
    for (int c2 = 0; c2 < 2; ++c2) { const int idx = tid + NTHR * c2, r = idx >> 4, ch = idx & 15; *(LAS u32x4*)(dst + r * 136 + 8 * ch) = *(const u32x4*)(src + r * 128 + 8 * ch); }
}
__device__ __forceinline__ void phase_scan_out_gla(KP p, LAS unsigned char* lds, int l, bool need_ctx) {
    const int tid = otid(), lane = tid & 63, wave = tid >> 6, fq = lane >> 4, fr = lane & 15; const int li = l >> 1;
    const bf16* P = (const bf16*)(p->ws + WS_P); const int ldp = NP_EVEN; const float* SM = (const float*)(p->ws + WS_SM); bf16* Z = (bf16*)(p->ws + WS_H);
    const bf16* S = (const bf16*)(p->ws + WS_S);
    LAS bf16* qf = (LAS bf16*)(lds + SO_QF); LAS bf16* kf = (LAS bf16*)(lds + SO_KF); LAS bf16* qb = (LAS bf16*)(lds + SO_QB); LAS bf16* kb = (LAS bf16*)(lds + SO_KB);
    LAS bf16* vs = (LAS bf16*)(lds + SO_VS); LAS bf16* Af = (LAS bf16*)(lds + SO_AF); LAS bf16* Ab = (LAS bf16*)(lds + SO_AB); LAS bf16* Sf = (LAS bf16*)(lds + SO_SF); LAS bf16* Sb = (LAS bf16*)(lds + SO_SB);
    LAS float* seg = (LAS float*)(lds + SO_SEG); LAS float* lrs = (LAS float*)(lds + SO_MISC);
    const int dk = tid & 63, sg = tid >> 6;
    for (int it = blockIdx.x; it < BATCH * 4 * NCHUNK; it += gridDim.x) {
        const int b = it / (4 * NCHUNK), h = (it / NCHUNK) & 3, cp = it % NCHUNK; if (cp < 4 && !need_ctx) continue;
        const int row0 = chunk_row0(b, cp); const int slf = ((b * 4 + h) * 2 + 0) * NCHUNK + cp, slb = slf + NCHUNK;
        __syncthreads();
#pragma unroll
        for (int c2 = 0; c2 < 2; ++c2) { const int idx = tid + NTHR * c2, t = idx >> 4, ch = idx & 15; *(LAS u32x4*)(vs + t * 136 + 8 * ch) = *(const u32x4*)(P + (size_t)(row0 + t) * ldp + 512 + h * 128 + 8 * ch); }
        stage_state(Sf, S + (size_t)slf * 8192); stage_state(Sb, S + (size_t)slb * 8192);
        float qv[8], kv[8];
#pragma unroll
        for (int tt = 0; tt < 8; ++tt) { const size_t ro = (size_t)(row0 + sg * 8 + tt) * ldp + h * 64 + dk; qv[tt] = bf2f(P[ro]); kv[tt] = bf2f(P[ro + 256]); }
        float gwf[16], gwb[16];
        const float* gw = p->gla_gate_w + (size_t)li * 2 * 16 * 256; const float* gb = p->gla_gate_b + (size_t)li * 2 * 256;
#pragma unroll
        for (int r = 0; r < 16; ++r) { gwf[r] = gw[r * 256 + h * 64 + dk]; gwb[r] = gw[(16 + r) * 256 + h * 64 + dk]; }
        const float gbf = gb[h * 64 + dk], gbb = gb[256 + h * 64 + dk];
        { const int t = tid >> 3, c4 = (tid & 7) * 4; *(LAS f32x4*)(lrs + t * 32 + c4) = *(const f32x4*)(SM + (size_t)(row0 + t) * 32 + c4); }
        __syncthreads();
        float pf[8], sb[8];
        f32x4 L[2][8];
#pragma unroll
        for (int i = 0; i < 8; ++i) L[0][i] = *(const LAS f32x4*)(lrs + (sg * 8) * 32 + 4 * i);
#pragma unroll
        for (int tt = 0; tt < 8; ++tt) {
            if (tt < 7) {
#pragma unroll
                for (int i = 0; i < 8; ++i) L[(tt + 1) & 1][i] = *(const LAS f32x4*)(lrs + (sg * 8 + tt + 1) * 32 + 4 * i); }
            float zf = gbf, zb = gbb, zf2 = 0.f, zb2 = 0.f;
#pragma unroll
            for (int i = 0; i < 4; i += 2)
#pragma unroll
                for (int e = 0; e < 4; ++e) { zf += L[tt & 1][i][e] * gwf[4 * i + e]; zf2 += L[tt & 1][i + 1][e] * gwf[4 * i + 4 + e]; zb += L[tt & 1][4 + i][e] * gwb[4 * i + e]; zb2 += L[tt & 1][5 + i][e] * gwb[4 * i + 4 + e]; }
            pf[tt] = logsigf(zf + zf2) * 0.0625f; sb[tt] = logsigf(zb + zb2) * 0.0625f; }
#pragma unroll
        for (int tt = 1; tt < 8; ++tt) pf[tt] += pf[tt - 1];
#pragma unroll
        for (int tt = 6; tt >= 0; --tt) sb[tt] += sb[tt + 1];
        seg[(0 * 8 + sg) * 64 + dk] = pf[7]; seg[(1 * 8 + sg) * 64 + dk] = sb[0];
        __syncthreads();
        float offf = 0.f, offb = 0.f;
#pragma unroll
        for (int q = 0; q < 8; ++q) { const float a = seg[q * 64 + dk], c = seg[(8 + q) * 64 + dk]; if (q < sg) offf += a; if (q > sg) offb += c; }
#pragma unroll
        for (int tt = 0; tt < 8; ++tt) { const int t = sg * 8 + tt; const float bf_ = offf + pf[tt], bb_ = offb + sb[tt];
            qf[t * 72 + dk] = (bf16)f2bf(qv[tt] * __expf(bf_)); kf[t * 72 + dk] = (bf16)f2bf(kv[tt] * __expf(-bf_));
            qb[t * 72 + dk] = (bf16)f2bf(qv[tt] * __expf(bb_)); kb[t * 72 + dk] = (bf16)f2bf(kv[tt] * __expf(-bb_)); }
        __syncthreads();
        { const int mt = wave >> 1;
#pragma unroll
          for (int n2 = 0; n2 < 2; ++n2) { const int nt = 2 * (wave & 1) + n2; f32x4 af = (f32x4){0.f, 0.f, 0.f, 0.f}, ab = (f32x4){0.f, 0.f, 0.f, 0.f};
#pragma unroll
              for (int ks = 0; ks < 2; ++ks) { af = MFMA(frag_rm(qf, 72, 16 * mt, 32 * ks, lane), frag_rm(kf, 72, 16 * nt, 32 * ks, lane), af);
                                               ab = MFMA(frag_rm(qb, 72, 16 * mt, 32 * ks, lane), frag_rm(kb, 72, 16 * nt, 32 * ks, lane), ab); }
#pragma unroll
              for (int r = 0; r < 4; ++r) { const int t = 16 * mt + 4 * fq + r, s = 16 * nt + fr;
                  Af[t * 72 + s] = (bf16)f2bf(s <= t ? af[r] : 0.f); Ab[t * 72 + s] = (bf16)f2bf(s >= t ? ab[r] : 0.f); } } }
        __syncthreads();
        f32x4 o[4];
#pragma unroll
        for (int mt = 0; mt < 4; ++mt) o[mt] = (f32x4){0.f, 0.f, 0.f, 0.f};
#pragma unroll
        for (int ks = 0; ks < 2; ++ks) { const bf16x8 bv = frag_tr(vs, 136, 32 * ks, 16 * wave, lane), bsf = frag_tr(Sf, 136, 32 * ks, 16 * wave, lane), bsb = frag_tr(Sb, 136, 32 * ks, 16 * wave, lane);
#pragma unroll
            for (int mt = 0; mt < 4; ++mt) { o[mt] = MFMA(frag_rm(Af, 72, 16 * mt, 32 * ks, lane), bv, o[mt]); o[mt] = MFMA(frag_rm(Ab, 72, 16 * mt, 32 * ks, lane), bv, o[mt]);
                o[mt] = MFMA(frag_rm(qf, 72, 16 * mt, 32 * ks, lane), bsf, o[mt]); o[mt] = MFMA(frag_rm(qb, 72, 16 * mt, 32 * ks, lane), bsb, o[mt]); } }
        scan_out_tail(lds, o, P, ldp, Z, row0, h, p->gla_norm_g + (size_t)li * 512);
    }
}
constexpr int MO_QS = 0, MO_KS = 9216, MO_QWF = 18432, MO_QWB = 27648;
__device__ __forceinline__ void phase_scan_out_mlstm(KP p, LAS unsigned char* lds, int l, bool need_ctx) {
    const int tid = otid(), lane = tid & 63, wave = tid >> 6, fq = lane >> 4, fr = lane & 15; const int li = l >> 1;
    const bf16* P = (const bf16*)(p->ws + WS_P); const int ldp = NP_ODD; const float* SM = (const float*)(p->ws + WS_SM); bf16* Z = (bf16*)(p->ws + WS_H);
    const bf16* S = (const bf16*)(p->ws + WS_S); const float* GAM = (const float*)(p->ws + WS_GAM); const float* SC = (const float*)(p->ws + WS_SC);
    LAS bf16* qs = (LAS bf16*)(lds + MO_QS); LAS bf16* ks_ = (LAS bf16*)(lds + MO_KS); LAS bf16* qwf = (LAS bf16*)(lds + MO_QWF); LAS bf16* qwb = (LAS bf16*)(lds + MO_QWB);
    LAS bf16* vs = (LAS bf16*)(lds + SO_VS); LAS bf16* Af = (LAS bf16*)(lds + SO_AF); LAS bf16* Ab = (LAS bf16*)(lds + SO_AB); LAS bf16* Cf = (LAS bf16*)(lds + SO_SF); LAS bf16* Cb = (LAS bf16*)(lds + SO_SB);
    LAS float* part = (LAS float*)(lds + SO_SEG);
    LAS float* misc = (LAS float*)(lds + SO_MISC);
    const float* mb = p->ml_gate_b + li * 16;
    for (int it = blockIdx.x; it < BATCH * 4 * NCHUNK; it += gridDim.x) {
        const int b = it / (4 * NCHUNK), h = (it / NCHUNK) & 3, cp = it % NCHUNK; if (cp < 4 && !need_ctx) continue;
        const int row0 = chunk_row0(b, cp); const int slf = ((b * 4 + h) * 2 + 0) * NCHUNK + cp, slb = slf + NCHUNK;
        __syncthreads();
#pragma unroll
        for (int c2 = 0; c2 < 2; ++c2) { const int idx = tid + NTHR * c2, t = idx >> 4, ch = idx & 15; *(LAS u32x4*)(vs + t * 136 + 8 * ch) = *(const u32x4*)(P + (size_t)(row0 + t) * ldp + 512 + h * 128 + 8 * ch); }
        stage_state(Cf, S + (size_t)slf * 8192); stage_state(Cb, S + (size_t)slb * 8192);
        { const int t = tid >> 3, ch = tid & 7; const size_t ro = (size_t)(row0 + t) * ldp + h * 64 + 8 * ch;
          *(LAS u32x4*)(qs + t * 72 + 8 * ch) = *(const u32x4*)(P + ro); *(LAS u32x4*)(ks_ + t * 72 + 8 * ch) = *(const u32x4*)(P + ro + 256); }
        float mprev_r = 0.f;
        if (tid < 128) { const int d = tid >> 6, t = tid & 63; const float* gp = SM + (size_t)(row0 + t) * 32 + d * 8;
            misc[d * 512 + t] = gp[h] + mb[d * 8 + h]; misc[d * 512 + 64 + t] = logsigf(gp[4 + h] + mb[d * 8 + 4 + h]);
            misc[1024 + d * 64 + t] = GAM[(size_t)(d ? slb : slf) * 64 + t]; mprev_r = SC[(size_t)(d ? slb : slf) * 4 + 2]; }
        __syncthreads();
        if (tid < 128) { const int d = tid >> 6, t = tid & 63; LAS float* md = misc + d * 512; const float run = wave_scan_sum(md[64 + t], t, d == 1); const float pm = wave_scan_max(md[t] - run, t, d == 1);
            const float mprev = mprev_r;
            const float mt_ = fmaxf(run + pm, run + mprev);
            md[128 + t] = run; md[192 + t] = mt_; md[256 + t] = __expf(run + mprev - mt_); }
        __syncthreads();
        { const int t = tid >> 3, ch = tid & 7; const u32x4 qv = *(const LAS u32x4*)(qs + t * 72 + 8 * ch); const float wf = misc[256 + t], wb = misc[512 + 256 + t];
          u32x4 a, c;
          a.x = pk2(bflo(qv.x) * wf, bfhi(qv.x) * wf); a.y = pk2(bflo(qv.y) * wf, bfhi(qv.y) * wf); a.z = pk2(bflo(qv.z) * wf, bfhi(qv.z) * wf); a.w = pk2(bflo(qv.w) * wf, bfhi(qv.w) * wf);
          c.x = pk2(bflo(qv.x) * wb, bfhi(qv.x) * wb); c.y = pk2(bflo(qv.y) * wb, bfhi(qv.y) * wb); c.z = pk2(bflo(qv.z) * wb, bfhi(qv.z) * wb); c.w = pk2(bflo(qv.w) * wb, bfhi(qv.w) * wb);
          *(LAS u32x4*)(qwf + t * 72 + 8 * ch) = a; *(LAS u32x4*)(qwb + t * 72 + 8 * ch) = c;
          const float q0 = bflo(qv.x), q1 = bfhi(qv.x), q2 = bflo(qv.y), q3 = bfhi(qv.y), q4 = bflo(qv.z), q5 = bfhi(qv.z), q6 = bflo(qv.w), q7 = bfhi(qv.w);
#pragma unroll
          for (int d = 0; d < 2; ++d) { const LAS float* nv = misc + 1024 + d * 64 + 8 * ch;
              part[(d * 8 + ch) * 64 + t] = q0 * nv[0] + q1 * nv[1] + q2 * nv[2] + q3 * nv[3] + q4 * nv[4] + q5 * nv[5] + q6 * nv[6] + q7 * nv[7]; } }
        { const int mt = wave >> 1; float rsf[4] = {0.f, 0.f, 0.f, 0.f}, rsb[4] = {0.f, 0.f, 0.f, 0.f};
#pragma unroll
          for (int n2 = 0; n2 < 2; ++n2) { const int nt = 2 * (wave & 1) + n2; f32x4 a = (f32x4){0.f, 0.f, 0.f, 0.f};
#pragma unroll
              for (int ks = 0; ks < 2; ++ks) a = MFMA(frag_rm(qs, 72, 16 * mt, 32 * ks, lane), frag_rm(ks_, 72, 16 * nt, 32 * ks, lane), a);
#pragma unroll
              for (int r = 0; r < 4; ++r) { const int t = 16 * mt + 4 * fq + r, s = 16 * nt + fr;
                  const float wf = s <= t ? __expf(misc[128 + t] - misc[128 + s] + misc[s] - misc[192 + t]) : 0.f;
                  const float wb = s >= t ? __expf(misc[512 + 128 + t] - misc[512 + 128 + s] + misc[512 + s] - misc[512 + 192 + t]) : 0.f;
                  const float vf = a[r] * wf, vb = a[r] * wb; rsf[r] += vf; rsb[r] += vb;
                  Af[t * 72 + s] = (bf16)f2bf(vf); Ab[t * 72 + s] = (bf16)f2bf(vb); } }
#pragma unroll
          for (int r = 0; r < 4; ++r) { const float a = red16_sum(rsf[r]), c = red16_sum(rsb[r]);
              if (fr == 0) { misc[1152 + (0 * 2 + (wave & 1)) * 64 + 16 * mt + 4 * fq + r] = a; misc[1152 + (1 * 2 + (wave & 1)) * 64 + 16 * mt + 4 * fq + r] = c; } } }
        __syncthreads();
        if (tid < 128) { const int d = tid >> 6, t = tid & 63; float qn = 0.f;
#pragma unroll
            for (int q = 0; q < 8; ++q) qn += part[(d * 8 + q) * 64 + t];
            const float den = misc[1152 + (d * 2 + 0) * 64 + t] + misc[1152 + (d * 2 + 1) * 64 + t] + misc[d * 512 + 256 + t] * qn;
            misc[d * 512 + 320 + t] = 1.f / fmaxf(fabsf(den), __expf(-misc[d * 512 + 192 + t])); }
        f32x4 of[4], ob[4];
#pragma unroll
        for (int mt = 0; mt < 4; ++mt) { of[mt] = (f32x4){0.f, 0.f, 0.f, 0.f}; ob[mt] = (f32x4){0.f, 0.f, 0.f, 0.f}; }
#pragma unroll
        for (int ks = 0; ks < 2; ++ks) { const bf16x8 bv = frag_tr(vs, 136, 32 * ks, 16 * wave, lane), bcf = frag_tr(Cf, 136, 32 * ks, 16 * wave, lane), bcb = frag_tr(Cb, 136, 32 * ks, 16 * wave, lane);
#pragma unroll
            for (int mt = 0; mt < 4; ++mt) { of[mt] = MFMA(frag_rm(Af, 72, 16 * mt, 32 * ks, lane), bv, of[mt]); of[mt] = MFMA(frag_rm(qwf, 72, 16 * mt, 32 * ks, lane), bcf, of[mt]);
                ob[mt] = MFMA(frag_rm(Ab, 72, 16 * mt, 32 * ks, lane), bv, ob[mt]); ob[mt] = MFMA(frag_rm(qwb, 72, 16 * mt, 32 * ks, lane), bcb, ob[mt]); } }
        __syncthreads();
        f32x4 o[4];
#pragma unroll
        for (int mt = 0; mt < 4; ++mt)
#pragma unroll
            for (int r = 0; r < 4; ++r) { const int t = 16 * mt + 4 * fq + r; o[mt][r] = of[mt][r] * misc[320 + t] + ob[mt][r] * misc[512 + 320 + t]; }
        scan_out_tail(lds, o, P, ldp, Z, row0, h, p->ml_norm_g + (size_t)li * 512);
    }
}
#define XB_TMO      128
#define XB_XCNT(j)  (256  + 64 * (j))
#define XB_XSUB(j)  (1280 + 64 * (j))
#define XB_XGEN(j)  (2304 + 64 * (j))
#define XB_TOP      3328
#define XB_TOPGEN   3392
#define XCD_BAR_WORDS 3456
#define XB_SPIN_CAP (1u << 18)

__device__ __forceinline__ unsigned xb_ld(unsigned* p)              { return __hip_atomic_load(p, __ATOMIC_RELAXED, __HIP_MEMORY_SCOPE_AGENT); }
__device__ __forceinline__ unsigned xb_add(unsigned* p, unsigned v) { return __hip_atomic_fetch_add(p, v, __ATOMIC_RELAXED, __HIP_MEMORY_SCOPE_AGENT); }
__device__ __forceinline__ unsigned xb_xcc_id() { return (unsigned)__builtin_amdgcn_s_getreg((3 << 11) | 20) & 0xFu; }
#define XB_SPIN(cond, bar) do { unsigned _sp = 0; while (cond) { __builtin_amdgcn_s_sleep(1); \
    if ((++_sp & 255u) == 0u) { if (xb_ld(&(bar)[XB_TMO])) break; if (_sp > XB_SPIN_CAP) { atomicAdd(&(bar)[XB_TMO], 1u); break; } } } } while (0)

struct XcdBarrier {
    unsigned* bar; unsigned x;
    volatile LAS unsigned* st;
};

__device__ __forceinline__ XcdBarrier xcd_barrier_post(unsigned* bar, volatile LAS unsigned* st) {
    XcdBarrier b; b.bar = bar; b.x = xb_xcc_id(); b.st = st;
    if (otid() == 0) (void)xb_add(&bar[XB_XCNT(b.x)], 1u);
    return b;
}
__device__ __forceinline__ void xcd_barrier_complete(unsigned* bar, unsigned x, unsigned& nloc, unsigned& nx) {
    const unsigned G = gridDim.x * gridDim.y * gridDim.z;
    unsigned sum, cnt, mine, sp = 0u;
    for (;;) {
        sum = 0u; cnt = 0u; mine = 0u;
#pragma unroll
        for (unsigned j = 0; j < 16; ++j) { const unsigned c = xb_ld(&bar[XB_XCNT(j)]); sum += c; cnt += (c > 0u) ? 1u : 0u; mine = (j == x) ? c : mine; }
        if (sum == G) break;
        __builtin_amdgcn_s_sleep(1);
        if ((++sp & 255u) == 0u) { if (xb_ld(&bar[XB_TMO])) break; if (sp > XB_SPIN_CAP) { atomicAdd(&bar[XB_TMO], 1u); break; } }
    }
    nloc = mine > 0u ? mine : 1u; nx = cnt > 0u ? cnt : 1u;
}

__device__ __forceinline__ void xcd_barrier(const XcdBarrier& b) {
    asm volatile("s_waitcnt vmcnt(0)" ::: "memory");
    __syncthreads();
    if (otid() == 0) {
        unsigned* bar = b.bar;
        __builtin_amdgcn_s_waitcnt(0);
        unsigned nloc = b.st[0], nx = b.st[1];
        if (nloc == 0u) { xcd_barrier_complete(bar, b.x, nloc, nx); b.st[0] = nloc; b.st[1] = nx; }
        const unsigned old = xb_add(&bar[XB_XSUB(b.x)], 1u);
        const unsigned gen = old / nloc;
        if (old + 1u == (gen + 1u) * nloc) {
            __builtin_amdgcn_fence(__ATOMIC_RELEASE, "agent");
            asm volatile("s_waitcnt vmcnt(0)" ::: "memory");
            const unsigned og = xb_add(&bar[XB_TOP], 1u);
            const unsigned tg = og / nx;
            if (og + 1u == (tg + 1u) * nx) xb_add(&bar[XB_TOPGEN], 1u);
            else XB_SPIN(xb_ld(&bar[XB_TOPGEN]) == tg, bar);
            __builtin_amdgcn_fence(__ATOMIC_ACQUIRE, "agent");
            xb_add(&bar[XB_XGEN(b.x)], 1u);
            asm volatile("s_waitcnt vmcnt(0)" ::: "memory");
        } else {
            XB_SPIN(xb_ld(&bar[XB_XGEN(b.x)]) == gen, bar);
            __builtin_amdgcn_fence(__ATOMIC_ACQUIRE, "agent");
            asm volatile("s_waitcnt vmcnt(0)" ::: "memory");
        }
    }
    __syncthreads();
}

#define REP_GEMM 1
#define REP_ATT 1
#define REP_LOC 1
#define REP_OUT 1
#define REP_PRO 1
#define REP_SEQ 1
#define REP_LN 1
#ifndef MK_N_LAUNCHES
#define MK_N_LAUNCHES 1
#endif
constexpr int N_PHASES = 2 + 6 * DEPTH;
__global__ void __launch_bounds__(NTHR, 2) fwd_megakernel(Params p_unused) {
    extern __shared__ __attribute__((aligned(16))) unsigned char lds_raw[];
    LAS unsigned char* lds = (LAS unsigned char*)lds_raw;
    cg::grid_group grid = cg::this_grid();
    const int lo = (int)kparams()->ph_lo, hi = (int)kparams()->ph_hi;
#define IN(k) (lo <= (k) && (k) < hi)
    volatile LAS unsigned* bst = (volatile LAS unsigned*)(lds + LDS_BYTES - 64);
    if (otid() < 16) bst[otid()] = 0u;
    __syncthreads();
    XcdBarrier bar = xcd_barrier_post((unsigned*)(kparams()->ws + WS_BAR), bst);
    if (kparams()->ph_hi < 0) grid.sync();
#define SEAM(k) do { if (IN(k) && IN((k) + 1)) xcd_barrier(bar); } while (0)
    if (IN(0)) { for (int rep = 0; rep < REP_PRO; ++rep) { phase_prologue(kparams(), lds); __syncthreads(); } } SEAM(0);
    if (IN(1)) { for (int rep = 0; rep < REP_PRO; ++rep) phase_h0(kparams()); } SEAM(1);
#pragma unroll 1
    for (int l = 0; l < DEPTH; ++l) {
        const int pb = 2 + 6 * l; const bool odd = l & 1; const int li = l >> 1; const bool need_ctx = l < DEPTH - 1;
        if (IN(pb + 0)) {
            const int npad = odd ? NPAD_ODD : NPAD_EVEN; unsigned char* ws = kparams()->ws;
            pg8::Gemm g{(const pg8::bf16_t*)(ws + WS_H), (const pg8::bf16_t*)(ws + (odd ? WS_WIO : WS_WIE)) + (size_t)li * npad * 1024, MTOT, npad, 1024};
            pg8::StaticOrder S; S.init(MTOT, npad, (int)gridDim.x, (int)blockIdx.x);
            pg8::EpiProj E{(pg8::bf16_t*)(ws + WS_P), odd ? NP_ODD : NP_EVEN, (float*)(ws + WS_SM), odd ? 16 : 32, npad / 256 - 1, odd ? 1 : 0, (const float*)(ws + WS_ROPE), (const float*)(ws + WS_ROPE) + 1024};
            for (int rep = 0; rep < REP_GEMM; ++rep) pg8::gemm_phase<pg8::EpiProj, pg8::StaticOrder, true, true>(lds, g, S, E);
        }
        SEAM(pb + 0);
        if (IN(pb + 1)) { for (int rep = 0; rep < REP_ATT; ++rep) phase_attn(kparams(), lds, l, need_ctx); for (int rep = 0; rep < REP_LOC; ++rep) phase_scan_local(kparams(), lds, l); }
        SEAM(pb + 1);
        if (IN(pb + 2)) { for (int rep = 1; rep < REP_SEQ; ++rep) { phase_scan_seq(kparams(), l, true); __syncthreads(); } phase_scan_seq(kparams(), l); }
        SEAM(pb + 2);
        if (IN(pb + 3)) { for (int rep = 0; rep < REP_OUT; ++rep) { if (odd) phase_scan_out_mlstm(kparams(), lds, l, need_ctx); else phase_scan_out_gla(kparams(), lds, l, need_ctx); } }
        SEAM(pb + 3);
        if (IN(pb + 4)) {
            const int mrows = need_ctx ? MTOT : MLAT; unsigned char* ws = kparams()->ws;
            pg8::Gemm g{(const pg8::bf16_t*)(ws + WS_H), (const pg8::bf16_t*)(ws + WS_WO) + (size_t)l * 1024 * 1024, mrows, 1024, 1024};
            pg8::StaticOrder S; S.init(mrows, 1024, (int)gridDim.x, (int)blockIdx.x);
            pg8::EpiProj E{(pg8::bf16_t*)(ws + WS_P), 1024, nullptr, 0, -1, 0, nullptr, nullptr};
            for (int rep = 0; rep < REP_GEMM; ++rep) pg8::gemm_phase<pg8::EpiProj, pg8::StaticOrder, true, true>(lds, g, S, E);
        }
        SEAM(pb + 4);
        if (IN(pb + 5)) { for (int rep = 1; rep < REP_LN; ++rep) { phase_ln(kparams(), l, true); } phase_ln(kparams(), l); }
        SEAM(pb + 5);
    }
}
extern "C" void kernel_launch(void* const* d_in, const int* in_sizes, int n_in, void* d_out, int out_size, void* d_ws, size_t ws_size, hipStream_t stream) {
    static int grid = 0;
    if (grid == 0) {
        if (n_in != 19 || ws_size < WS_END) { fprintf(stderr, "kernel_launch: need 19 inputs and %zu bytes of workspace; got %d, %zu\n", (size_t)WS_END, n_in, ws_size); grid = -1; return; }
        int dev = 0, cus = 0, per_cu = 0;
        if (hipGetDevice(&dev) != hipSuccess || hipDeviceGetAttribute(&cus, hipDeviceAttributeMultiprocessorCount, dev) != hipSuccess) { grid = -1; return; }
        if (hipFuncSetAttribute((const void*)fwd_megakernel, hipFuncAttributeMaxDynamicSharedMemorySize, LDS_BYTES) != hipSuccess) { fprintf(stderr, "kernel_launch: hipFuncSetAttribute failed\n"); grid = -1; return; }
        if (hipOccupancyMaxActiveBlocksPerMultiprocessor(&per_cu, (const void*)fwd_megakernel, NTHR, LDS_BYTES) != hipSuccess || per_cu < 1) per_cu = 1;
        grid = cus * per_cu;
    }
    if (grid < 0) return;
    Params p{};
    p.x = (const float*)d_in[0]; p.c = (const float*)d_in[1]; p.ctx = (const float*)d_in[2]; p.c_ctx = (const float*)d_in[3]; p.w_ada = (const float*)d_in[4]; p.b_ada = (const float*)d_in[5];
    p.ln_g = (const float*)d_in[6]; p.ln_b = (const float*)d_in[7]; p.w_in_even = (const float*)d_in[8]; p.w_out_even = (const float*)d_in[9]; p.gla_gate_w = (const float*)d_in[10]; p.gla_gate_b = (const float*)d_in[11];
    p.gla_norm_g = (const float*)d_in[12]; p.na_rpb = (const float*)d_in[13]; p.w_in_odd = (const float*)d_in[14]; p.w_out_odd = (const float*)d_in[15]; p.ml_gate_b = (const float*)d_in[16]; p.ml_norm_g = (const float*)d_in[17];
    p.sw_sink = (const float*)d_in[18]; p.out = (float*)d_out; p.ws = (unsigned char*)d_ws;
    if (hipMemsetAsync((char*)d_ws + WS_BAR, 0, XCD_BAR_WORDS * 4, stream) != hipSuccess) { fprintf(stderr, "kernel_launch: memset failed\n"); return; }
#if MK_N_LAUNCHES == 1
    p.ph_lo = 0; p.ph_hi = N_PHASES;
    void* args[] = {&p};
    hipError_t e = hipLaunchCooperativeKernel((const void*)fwd_megakernel, dim3(grid), dim3(NTHR), args, LDS_BYTES, stream);
    if (e != hipSuccess) fprintf(stderr, "kernel_launch: cooperative launch failed: %s (grid %d)\n", hipGetErrorString(e), grid);
#else
    for (int k = 0; k < N_PHASES; ++k) { p.ph_lo = k; p.ph_hi = k + 1; hipLaunchKernelGGL(fwd_megakernel, dim3(grid), dim3(NTHR), LDS_BYTES, stream, p); }
#endif
}
```

```cpp
#include <hip/hip_runtime.h>
#include <hip/hip_cooperative_groups.h>
#include <cstdio>
#include <cstdint>
namespace cg = cooperative_groups;
__device__ __forceinline__ int otid() { int t = threadIdx.x; asm volatile("" : "+v"(t)); return t; }
namespace pg8 {
#define PG8_LAS __attribute__((address_space(3)))
typedef unsigned short bf16_t;
typedef short bf16x8 __attribute__((ext_vector_type(8)));
typedef float f32x4 __attribute__((ext_vector_type(4)));
typedef unsigned u32x4 __attribute__((ext_vector_type(4)));
constexpr int BM = 256, BK = 64, HALF = 128, HTB = HALF * BK * 2  , STAGE_BYTES = 8 * HTB, NXCD = 8, WGM = 8;

__host__ __device__ __forceinline__ int lds_byte(int r, int c) { const int st = (r >> 4) * 2 + (c >> 5), rr = r & 15, cc = c & 31, ob = rr * 64 + cc * 2; return st * 1024 + (ob ^ (((ob >> 9) & 1) << 5)); }
__host__ __device__ __forceinline__ void stage_rc(int b, int& R, int& C) { const int st = b / 1024, sb = b % 1024, swz = sb ^ (((sb >> 9) & 1) << 5); R = (st >> 1) * 16 + swz / 64; C = (st & 1) * 32 + (swz % 64) / 2; }
__host__ __device__ __forceinline__ int perm32(int rho) { const int n = rho >> 4, i = rho & 15; return 8 * (i >> 2) + 4 * n + (i & 3); }

struct Unit { int pm, pn; };
struct Gemm { const bf16_t* A; const bf16_t* Bt; int M, N, K; };

struct StaticOrder {
    int nM, nN, nwg, G, c;
    __host__ __device__ void init(int M, int N, int G_, int c_) { nM = M / BM; nN = N / BM; nwg = nM * nN; G = G_; c = c_; }
    __host__ __device__ bool next(int i, Unit& u) const {
        const long L = (long)i * G + c; if (L >= nwg) return false;
        int wgid = (int)L; { const int q = nwg / NXCD, r = nwg % NXCD, xcd = wgid % NXCD, off = wgid / NXCD; wgid = (xcd < r ? xcd * (q + 1) : r * (q + 1) + (xcd - r) * q) + off; }
        const int nig = WGM * nN, gid = wgid / nig, fm = gid * WGM, gsz = (nM - fm) < WGM ? (nM - fm) : WGM;
        u.pm = fm + ((wgid % nig) % gsz); u.pn = (wgid % nig) / gsz; return true;
    }
    __device__ __forceinline__ void a_ready(const Unit&) const {}
    __device__ __forceinline__ void done(const Unit&) const {}
};

__device__ __forceinline__ unsigned cvt_pk_bf16(float lo, float hi) { unsigned r; asm volatile("v_cvt_pk_bf16_f32 %0, %1, %2" : "=v"(r) : "v"(lo), "v"(hi)); return r; }
struct EpiProj {
    static constexpr bool PERM = true, AFTER_DRAIN = false;
    bf16_t* P; int ldp; float* SM; int nsm; int last_pn; int rope; const float* cosT; const float* sinT;
    __device__ __forceinline__ void operator()(const f32x4 (&acc)[2][2][4][2], const Unit& u, int wr, int wc, int fr, int fq) const {
        const int row0 = u.pm * BM + wr * 64 + fr;
        if (u.pn == last_pn) {
            if (wc == 0) {
#pragma unroll
                for (int ai = 0; ai < 2; ++ai)
#pragma unroll
                    for (int m = 0; m < 4; ++m) { const int row = row0 + ai * HALF + m * 16;
#pragma unroll
                        for (int n = 0; n < 2; ++n) { const int col = 8 * fq + 4 * n; if (col < nsm) *(f32x4*)(SM + (size_t)row * 32 + col) = acc[ai][0][m][n]; } }
            }
            return;
        }
        const bool do_rope_tile = rope && (u.pn == 6 || u.pn == 7 || u.pn == 8) && (u.pm * BM < 32768);
#pragma unroll
        for (int ai = 0; ai < 2; ++ai)
#pragma unroll
            for (int m = 0; m < 4; ++m) { const int row = row0 + ai * HALF + m * 16; bf16_t* rowp = P + (size_t)row * ldp + u.pn * BM + wc * 32 + 8 * fq;
#pragma unroll
                for (int bj = 0; bj < 2; ++bj) { f32x4 v0 = acc[ai][bj][m][0], v1 = acc[ai][bj][m][1];
                    if (do_rope_tile && (u.pn != 8 || bj == 0)) {
                        const int t = row & 4095; const int pos = (wc & 1) ? (t & 63) : (t >> 6); const int i0 = pos * 16 + 8 * (fq & 1);
                        const f32x4 c0 = *(const f32x4*)(cosT + i0), c1 = *(const f32x4*)(cosT + i0 + 4), s0 = *(const f32x4*)(sinT + i0), s1 = *(const f32x4*)(sinT + i0 + 4);
                        f32x4 p0, p1;
#pragma unroll
                        for (int e = 0; e < 4; ++e) { p0[e] = __shfl_xor(v0[e], 32); p1[e] = __shfl_xor(v1[e], 32); }
                        if (fq < 2) { v0 = v0 * c0 - p0 * s0; v1 = v1 * c1 - p1 * s1; } else { v0 = p0 * s0 + v0 * c0; v1 = p1 * s1 + v1 * c1; }
                    }
                    u32x4 w; w.x = cvt_pk_bf16(v0[0], v0[1]); w.y = cvt_pk_bf16(v0[2], v0[3]); w.z = cvt_pk_bf16(v1[0], v1[1]); w.w = cvt_pk_bf16(v1[2], v1[3]);
                    *(u32x4*)(rowp + bj * HALF) = w; } }
    }
};
template <class Epi, class Sched, bool ALIGN_EPI = false, bool SP2 = false>
__device__ __forceinline__ void gemm_phase(PG8_LAS unsigned char* lds, const Gemm g, const Sched& S, const Epi& E) {
    const int tid = otid(), wid = __builtin_amdgcn_readfirstlane(tid >> 6), lane = tid & 63, wr = wid >> 2, wc = wid & 3, fr = lane & 15, fq = lane >> 4;
    const int K = g.K, nt = K / BK;
    unsigned voffA[2], voffB[2];
#pragma unroll
    for (int i = 0; i < 2; ++i) { int R, C; stage_rc(tid * 16 + i * 8192, R, C); const int Rb = Epi::PERM ? ((R & ~31) + perm32(R & 31)) : R;
        voffA[i] = (unsigned)(R * K + C) * 2u; voffB[i] = (unsigned)(Rb * K + C) * 2u; }
    const size_t kstep = (size_t)(BK * 2);
    const size_t hstep = (size_t)HALF * K * 2;
    const size_t tstep = 2 * hstep;
    const unsigned ldsw = (unsigned)wid * 1024u;
    const int aoff = lds_byte(wr * 64 + fr, fq * 8), boff = lds_byte(wc * 32 + fr, fq * 8);
#define PG8_SA(b, h) (((b) * 2 + (h)) * HTB)
#define PG8_SB(b, h) ((4 + (b) * 2 + (h)) * HTB)
#define PG8_STAGE(bufoff, gbase, voff) do { _Pragma("unroll") for (int _i = 0; _i < 2; ++_i) \
        __builtin_amdgcn_global_load_lds((const unsigned*)((const char*)(gbase) + (voff)[_i]), (PG8_LAS unsigned*)(lds + (bufoff) + ldsw + _i * 8192), 16, 0, 0); } while (0)
#define PG8_LDA(dst, b, h) do { _Pragma("unroll") for (int m = 0; m < 4; ++m) _Pragma("unroll") for (int k = 0; k < 2; ++k) dst[m][k] = *(const PG8_LAS bf16x8*)(lds + PG8_SA(b, h) + aoff + m * 2048 + k * 1024); } while (0)
#define PG8_LDB(dst, b, h) do { _Pragma("unroll") for (int n = 0; n < 2; ++n) _Pragma("unroll") for (int k = 0; k < 2; ++k) dst[n][k] = *(const PG8_LAS bf16x8*)(lds + PG8_SB(b, h) + boff + n * 2048 + k * 1024); } while (0)
#define PG8_MMA(ai, bj, At, Bt) do { __builtin_amdgcn_s_setprio(1); _Pragma("unroll") for (int m = 0; m < 4; ++m) _Pragma("unroll") for (int n = 0; n < 2; ++n) _Pragma("unroll") for (int k = 0; k < 2; ++k) \
        acc[ai][bj][m][n] = __builtin_amdgcn_mfma_f32_16x16x32_bf16(Bt[n][k], At[m][k], acc[ai][bj][m][n], 0, 0, 0); __builtin_amdgcn_s_setprio(0); } while (0)
#define PG8_WAIT_V(n) asm volatile("s_waitcnt vmcnt(" #n ")" ::: "memory")
#define PG8_WAIT_L(n) asm volatile("s_waitcnt lgkmcnt(" #n ")" ::: "memory")
#define PG8_BAR __builtin_amdgcn_s_barrier()
#define PG8_SCHED __builtin_amdgcn_sched_barrier(0)
    Unit cur, nxt; int ui = 0;
    if (!S.next(0, cur)) return;
    f32x4 acc[2][2][4][2];
#pragma unroll
    for (int a = 0; a < 2; ++a)
#pragma unroll
        for (int b = 0; b < 2; ++b)
#pragma unroll
            for (int m = 0; m < 4; ++m)
#pragma unroll
                for (int n = 0; n < 2; ++n) acc[a][b][m][n] = (f32x4){0.f, 0.f, 0.f, 0.f};
    bf16x8 At[4][2], B0[2][2], B1[2][2];
    const char* cA = (const char*)g.A + (size_t)cur.pm * tstep; const char* cB = (const char*)g.Bt + (size_t)cur.pn * tstep;
    S.a_ready(cur);
    if constexpr (SP2) {
        PG8_STAGE(PG8_SB(0, 0), cB, voffB); PG8_STAGE(PG8_SB(0, 1), cB + hstep, voffB); PG8_STAGE(PG8_SA(0, 0), cA, voffA); PG8_STAGE(PG8_SA(0, 1), cA + hstep, voffA);
        if (wr == 1) PG8_BAR;
        PG8_WAIT_V(2); PG8_BAR;
        PG8_STAGE(PG8_SB(1, 0), cB + kstep, voffB); PG8_STAGE(PG8_SA(1, 0), cA + kstep, voffA); PG8_STAGE(PG8_SB(1, 1), cB + hstep + kstep, voffB);
        PG8_WAIT_V(6); PG8_BAR;
    } else {
        PG8_STAGE(PG8_SB(0, 0), cB, voffB); PG8_STAGE(PG8_SA(0, 0), cA, voffA); PG8_STAGE(PG8_SB(0, 1), cB + hstep, voffB); PG8_STAGE(PG8_SA(0, 1), cA + hstep, voffA);
        if (wr == 1) PG8_BAR;
        PG8_WAIT_V(4); PG8_BAR;
        PG8_STAGE(PG8_SB(1, 0), cB + kstep, voffB); PG8_STAGE(PG8_SA(1, 0), cA + kstep, voffA); PG8_STAGE(PG8_SB(1, 1), cB + hstep + kstep, voffB);
        PG8_WAIT_V(6); PG8_BAR;
    }
    for (;;) {
        const bool has_next = S.next(ui + 1, nxt);
        const char* nA = has_next ? (const char*)g.A + (size_t)nxt.pm * tstep : cA; const char* nB = has_next ? (const char*)g.Bt + (size_t)nxt.pn * tstep : cB;
        for (int t = 0; t < nt; t += 2) {
            const bool last = (t == nt - 2);
            const char* a1 = cA + (size_t)(t + 1) * kstep;
            const char* a2 = last ? nA : cA + (size_t)(t + 2) * kstep; const char* b2 = last ? nB : cB + (size_t)(t + 2) * kstep;
            const char* a3 = a2 + kstep; const char* b3 = b2 + kstep;
            if (last && has_next) S.a_ready(nxt);
            if constexpr (SP2) {
            PG8_LDB(B0, 0, 0); PG8_LDB(B1, 0, 1); PG8_SCHED; PG8_LDA(At, 0, 0); PG8_STAGE(PG8_SA(1, 1), a1 + hstep, voffA);
            PG8_WAIT_V(8); PG8_WAIT_L(0); PG8_BAR; PG8_MMA(0, 0, At, B0); PG8_MMA(0, 1, At, B1); PG8_BAR; PG8_SCHED;
            PG8_LDA(At, 0, 1); PG8_STAGE(PG8_SB(0, 0), b2, voffB); PG8_STAGE(PG8_SB(0, 1), b2 + hstep, voffB); PG8_STAGE(PG8_SA(0, 0), a2, voffA);
            PG8_WAIT_V(8); PG8_WAIT_L(0); PG8_BAR; PG8_MMA(1, 0, At, B0); PG8_MMA(1, 1, At, B1); PG8_BAR; PG8_SCHED;
            PG8_LDB(B0, 1, 0); PG8_LDB(B1, 1, 1); PG8_SCHED; PG8_LDA(At, 1, 0); PG8_STAGE(PG8_SA(0, 1), a2 + hstep, voffA);
            PG8_WAIT_V(8); PG8_WAIT_L(0); PG8_BAR; PG8_MMA(0, 0, At, B0); PG8_MMA(0, 1, At, B1); PG8_BAR; PG8_SCHED;
            PG8_LDA(At, 1, 1); PG8_STAGE(PG8_SB(1, 0), b3, voffB); PG8_STAGE(PG8_SB(1, 1), b3 + hstep, voffB); PG8_STAGE(PG8_SA(1, 0), a3, voffA);
            PG8_WAIT_V(8); PG8_WAIT_L(0); PG8_BAR; PG8_MMA(1, 0, At, B0); PG8_MMA(1, 1, At, B1); PG8_BAR; PG8_SCHED;
            } else {
            PG8_LDB(B0, 0, 0); PG8_SCHED; PG8_LDA(At, 0, 0); PG8_STAGE(PG8_SA(1, 1), a1 + hstep, voffA);
            PG8_WAIT_L(8); PG8_BAR; PG8_WAIT_L(0); PG8_MMA(0, 0, At, B0); PG8_BAR; PG8_SCHED;
            PG8_LDB(B1, 0, 1); PG8_STAGE(PG8_SB(0, 0), b2, voffB);
            PG8_BAR; PG8_WAIT_L(0); PG8_MMA(0, 1, At, B1); PG8_BAR;
            PG8_LDA(At, 0, 1); PG8_STAGE(PG8_SA(0, 0), a2, voffA);
            PG8_BAR; PG8_WAIT_L(0); PG8_MMA(1, 0, At, B0); PG8_BAR; PG8_SCHED;
            PG8_STAGE(PG8_SB(0, 1), b2 + hstep, voffB);
            PG8_WAIT_V(6); PG8_BAR; PG8_MMA(1, 1, At, B1); PG8_BAR;
            PG8_LDB(B0, 1, 0); PG8_SCHED; PG8_LDA(At, 1, 0); PG8_STAGE(PG8_SA(0, 1), a2 + hstep, voffA);
            PG8_WAIT_L(8); PG8_BAR; PG8_WAIT_L(0); PG8_MMA(0, 0, At, B0); PG8_BAR; PG8_SCHED;
            PG8_LDB(B1, 1, 1); PG8_STAGE(PG8_SB(1, 0), b3, voffB);
            PG8_BAR; PG8_WAIT_L(0); PG8_MMA(0, 1, At, B1); PG8_BAR;
            PG8_LDA(At, 1, 1); PG8_STAGE(PG8_SA(1, 0), a3, voffA);
            PG8_BAR; PG8_WAIT_L(0); PG8_MMA(1, 0, At, B0); PG8_BAR; PG8_SCHED;
            PG8_STAGE(PG8_SB(1, 1), b3 + hstep, voffB);
            PG8_WAIT_V(6); PG8_BAR; PG8_MMA(1, 1, At, B1); PG8_BAR;
            }
        }
        if constexpr (ALIGN_EPI) { if (wr == 0) PG8_BAR; }
        if constexpr (!Epi::AFTER_DRAIN) { E(acc, cur, wr, wc, fr, fq); S.done(cur); }
        if (!has_next) break;
#pragma unroll
        for (int a = 0; a < 2; ++a)
#pragma unroll
            for (int b = 0; b < 2; ++b)
#pragma unroll
                for (int m = 0; m < 4; ++m)
#pragma unroll
                    for (int n = 0; n < 2; ++n) acc[a][b][m][n] = (f32x4){0.f, 0.f, 0.f, 0.f};
        cur = nxt; cA = nA; cB = nB; ++ui;
        if constexpr (ALIGN_EPI) { if (wr == 1) PG8_BAR; }
    }
    PG8_WAIT_V(0);
    if constexpr (!ALIGN_EPI) { if (wr == 0) PG8_BAR; }
    PG8_BAR;
    if constexpr (Epi::AFTER_DRAIN) { E.fused(acc, cur, wr, wc, fr, fq, lds, wid, lane); S.done(cur); }
#undef PG8_SA
#undef PG8_SB
#undef PG8_STAGE
#undef PG8_LDA
#undef PG8_LDB
#undef PG8_MMA
#undef PG8_WAIT_V
#undef PG8_WAIT_L
#undef PG8_BAR
#undef PG8_SCHED
}
}
constexpr int NWAVES = 8, NTHR = 512;
constexpr int BATCH = 8, SEQ = 4096, DM = 1024, CTXL = 256, DEPTH = 4;
constexpr int MLAT = BATCH * SEQ, MCTX = BATCH * CTXL, MTOT = MLAT + MCTX;
constexpr int NP_EVEN = 3584, NPAD_EVEN = 3840, NORIG_EVEN = 3616;
constexpr int NP_ODD = 2816, NPAD_ODD = 3072, NORIG_ODD = 2832;
constexpr int NCHUNK = 68;
constexpr int NSLOT = BATCH * 4 * 2 * NCHUNK;
constexpr float ALPHA_DN = 1.681792830507429f;
constexpr size_t MiB = 1u << 20;
constexpr size_t WS_MOD = 0;
constexpr size_t WS_BAR = 512 * 1024;
constexpr size_t WS_ROPE = 1 * MiB;
constexpr size_t WS_SC = WS_ROPE + 65536;
constexpr size_t WS_GAM = 2 * MiB;
constexpr size_t WS_SM = 4 * MiB;
constexpr size_t WS_WIE = 9 * MiB;
constexpr size_t WS_WIO = 24 * MiB;
constexpr size_t WS_WO = 36 * MiB;
constexpr size_t WS_XC = 44 * MiB;
constexpr size_t WS_H = 52 * MiB;
constexpr size_t WS_P = 120 * MiB;
constexpr size_t WS_S = 359 * MiB;
constexpr size_t WS_X16 = 427 * MiB;
constexpr size_t WS_END = WS_X16 + (size_t)MTOT * 1024 * 2;
static_assert(WS_S + (size_t)NSLOT * 8192 * 2 <= WS_X16, "ws map 4");
static_assert(WS_SC + (size_t)NSLOT * 16 <= WS_GAM && WS_GAM + (size_t)NSLOT * 256 <= WS_SM && WS_SM + (size_t)MTOT * 128 <= WS_WIE, "ws map 1");
static_assert(WS_WIE + (size_t)2 * NPAD_EVEN * 1024 * 2 <= WS_WIO && WS_WIO + (size_t)2 * NPAD_ODD * 1024 * 2 <= WS_WO && WS_WO + (size_t)4 * 1024 * 1024 * 2 <= WS_XC, "ws map 2");
static_assert(WS_XC + (size_t)MCTX * 1024 * 4 <= WS_H && WS_H + (size_t)MTOT * 1024 * 2 <= WS_P && WS_P + (size_t)MTOT * NP_EVEN * 2 <= WS_S && WS_END <= 512 * MiB, "ws map 3");
constexpr int LDS_BYTES = 147456;

#define LAS __attribute__((address_space(3)))
typedef unsigned short bf16;
typedef float f32x4 __attribute__((ext_vector_type(4)));
typedef short bf16x8 __attribute__((ext_vector_type(8)));
typedef short s16x4 __attribute__((ext_vector_type(4)));
typedef unsigned u32x4 __attribute__((ext_vector_type(4)));
typedef unsigned u32x2 __attribute__((ext_vector_type(2)));
#define LDS_WAIT() asm volatile("s_waitcnt lgkmcnt(0)" ::: "memory")

typedef __bf16 hbf2 __attribute__((ext_vector_type(2)));
typedef float f32x2_ __attribute__((ext_vector_type(2)));
__device__ __forceinline__ unsigned f2bf(float f) { const __bf16 b = (__bf16)f; return (unsigned)__builtin_bit_cast(unsigned short, b); }
__device__ __forceinline__ unsigned pk2(float lo, float hi) { const f32x2_ v = {lo, hi}; const hbf2 b = __builtin_convertvector(v, hbf2); return __builtin_bit_cast(unsigned, b); }
__device__ __forceinline__ float bf2f(unsigned short v) { return __builtin_bit_cast(float, (unsigned)v << 16); }
__device__ __forceinline__ float bflo(unsigned w) { return __builtin_bit_cast(float, w << 16); }
__device__ __forceinline__ float bfhi(unsigned w) { return __builtin_bit_cast(float, w & 0xffff0000u); }
__device__ __forceinline__ float siluf(float x) { return x * __builtin_amdgcn_rcpf(1.f + __expf(-x)); }
__device__ __forceinline__ float logsigf(float z) { return fminf(z, 0.f) - 0.69314718056f * __builtin_amdgcn_logf(1.f + __builtin_amdgcn_exp2f(-1.44269504089f * fabsf(z))); }
__device__ __forceinline__ float rdlane(float v, int l) { return __builtin_bit_cast(float, __builtin_amdgcn_readlane(__builtin_bit_cast(int, v), l)); }
template <int N> __device__ __forceinline__ float dpp_ror(float v) { return __builtin_bit_cast(float, __builtin_amdgcn_update_dpp(0, __builtin_bit_cast(int, v), 0x120 + N, 0xf, 0xf, false)); }
__device__ __forceinline__ float red16_max(float v) { v = fmaxf(v, dpp_ror<1>(v)); v = fmaxf(v, dpp_ror<2>(v)); v = fmaxf(v, dpp_ror<4>(v)); v = fmaxf(v, dpp_ror<8>(v)); return v; }
__device__ __forceinline__ float red16_sum(float v) { v += dpp_ror<1>(v); v += dpp_ror<2>(v); v += dpp_ror<4>(v); v += dpp_ror<8>(v); return v; }
__device__ __forceinline__ float wave_sum(float v) { v = red16_sum(v); return (rdlane(v, 0) + rdlane(v, 16)) + (rdlane(v, 32) + rdlane(v, 48)); }
__device__ __forceinline__ float wave_max(float v) { v = red16_max(v); return fmaxf(fmaxf(rdlane(v, 0), rdlane(v, 16)), fmaxf(rdlane(v, 32), rdlane(v, 48))); }
template <int N, bool REV> __device__ __forceinline__ float dpp_rshift(float v, float ident) {
    return __builtin_bit_cast(float, __builtin_amdgcn_update_dpp(__builtin_bit_cast(int, ident), __builtin_bit_cast(int, v), (REV ? 0x100 : 0x110) + N, 0xf, 0xf, false));
}
template <bool REV> __device__ __forceinline__ float wave_scan_sum_t(float v, int lane) {
    v += dpp_rshift<1, REV>(v, 0.f); v += dpp_rshift<2, REV>(v, 0.f); v += dpp_rshift<4, REV>(v, 0.f); v += dpp_rshift<8, REV>(v, 0.f);
    const int row = lane >> 4;
    if (!REV) { const float t0 = rdlane(v, 15), t1 = rdlane(v, 31), t2 = rdlane(v, 47);
        v += row == 1 ? t0 : row == 2 ? t0 + t1 : row == 3 ? t0 + t1 + t2 : 0.f; }
    else { const float t1 = rdlane(v, 16), t2 = rdlane(v, 32), t3 = rdlane(v, 48);
        v += row == 2 ? t3 : row == 1 ? t3 + t2 : row == 0 ? t3 + t2 + t1 : 0.f; }
    return v;
}
template <bool REV> __device__ __forceinline__ float wave_scan_max_t(float v, int lane) {
    v = fmaxf(v, dpp_rshift<1, REV>(v, -3e38f)); v = fmaxf(v, dpp_rshift<2, REV>(v, -3e38f)); v = fmaxf(v, dpp_rshift<4, REV>(v, -3e38f)); v = fmaxf(v, dpp_rshift<8, REV>(v, -3e38f));
    const int row = lane >> 4;
    if (!REV) { const float t0 = rdlane(v, 15), t1 = rdlane(v, 31), t2 = rdlane(v, 47);
        v = fmaxf(v, row == 1 ? t0 : row == 2 ? fmaxf(t0, t1) : row == 3 ? fmaxf(fmaxf(t0, t1), t2) : -3e38f); }
    else { const float t1 = rdlane(v, 16), t2 = rdlane(v, 32), t3 = rdlane(v, 48);
        v = fmaxf(v, row == 2 ? t3 : row == 1 ? fmaxf(t3, t2) : row == 0 ? fmaxf(fmaxf(t3, t2), t1) : -3e38f); }
    return v;
}
template <int N, bool REV> __device__ __forceinline__ float dpp_rshift0(float v) {
    return __builtin_bit_cast(float, __builtin_amdgcn_update_dpp(0, __builtin_bit_cast(int, v), (REV ? 0x100 : 0x110) + N, 0xf, 0xf, true));
}
template <int N, bool REV, bool MAX> __device__ __forceinline__ float scan_step(float v, int li) {
    const float t = dpp_rshift0<N, REV>(v); const bool ok = REV ? (li + N < 16) : (li >= N);
    return MAX ? (ok ? fmaxf(v, t) : v) : (ok ? v + t : v);
}
template <bool REV, bool MAX> __device__ __forceinline__ float wave_scan_t(float v, int lane) {
    const int li = lane & 15, row = lane >> 4;
    v = scan_step<1, REV, MAX>(v, li); v = scan_step<2, REV, MAX>(v, li); v = scan_step<4, REV, MAX>(v, li); v = scan_step<8, REV, MAX>(v, li);
    const float a0 = rdlane(v, REV ? 48 : 15), a1 = rdlane(v, REV ? 32 : 31), a2 = rdlane(v, REV ? 16 : 47);
    const int k = REV ? 3 - row : row;
    if (MAX) { float e = v; if (k >= 1) e = fmaxf(e, a0); if (k >= 2) e = fmaxf(e, a1); if (k >= 3) e = fmaxf(e, a2); return e; }
    float e = v; if (k >= 1) e += a0; if (k >= 2) e += a1; if (k >= 3) e += a2; return e;
}
__device__ __forceinline__ float wave_scan_sum(float v, int lane, bool rev) { return rev ? wave_scan_t<true, false>(v, lane) : wave_scan_t<false, false>(v, lane); }
__device__ __forceinline__ float wave_scan_max(float v, int lane, bool rev) { return rev ? wave_scan_t<true, true>(v, lane) : wave_scan_t<false, true>(v, lane); }
#define MFMA(a, b, c) __builtin_amdgcn_mfma_f32_16x16x32_bf16((a), (b), (c), 0, 0, 0)
__device__ __forceinline__ bf16x8 frag_rm(const LAS bf16* X, int ld, int row0, int k0, int lane) {
    return *(const LAS bf16x8*)(X + (row0 + (lane & 15)) * ld + k0 + 8 * (lane >> 4));
}
__device__ __forceinline__ bf16x8 frag_tr(const LAS bf16* X, int ld, int k0, int n0, int lane) {
    const int g = lane >> 4, m = lane & 15, q = m >> 2, p = m & 3;
    const LAS bf16* a0 = X + (k0 + 8 * g + q) * ld + n0 + 4 * p;
    const s16x4 lo = __builtin_amdgcn_ds_read_tr16_b64_v4i16((LAS s16x4*)a0);
    const s16x4 hi = __builtin_amdgcn_ds_read_tr16_b64_v4i16((LAS s16x4*)(a0 + 4 * ld));
    bf16x8 r; r[0] = lo[0]; r[1] = lo[1]; r[2] = lo[2]; r[3] = lo[3]; r[4] = hi[0]; r[5] = hi[1]; r[6] = hi[2]; r[7] = hi[3]; return r;
}

struct Params {
    const float *x, *c, *ctx, *c_ctx, *w_ada, *b_ada, *ln_g, *ln_b, *w_in_even, *w_out_even, *gla_gate_w, *gla_gate_b, *gla_norm_g, *na_rpb, *w_in_odd, *w_out_odd, *ml_gate_b, *ml_norm_g, *sw_sink;
    float* out; unsigned char* ws; long long ph_lo, ph_hi;
};
typedef const __attribute__((address_space(4))) Params* KP;
__device__ __forceinline__ KP kparams() { unsigned long long v = (unsigned long long)__builtin_amdgcn_kernarg_segment_ptr(); asm volatile("" : "+s"(v)); return (KP)v; }

__device__ __forceinline__ int orig_col(int type, int n) {
    if (type == 0) { if (n < 1536) return n; if (n < 3584) return n + 32; if (n < 3616) return n - 3584 + 1536; return -1; }
    if (type == 1) { if (n < 1536) return n; if (n < 2816) return n + 16; if (n < 2832) return n - 2816 + 1536; return -1; }
    return n;
}
__device__ __forceinline__ float col_scale(int type, int n) {
    if (type == 0) return (n < 256 || (n >= 1536 && n < 2048)) ? 0.125f : 1.f;
    if (type == 1) return ((n >= 256 && n < 512) || (n >= 1536 && n < 2048)) ? 0.125f : 1.f;
    return 1.f;
}
__device__ __forceinline__ void p0_transpose_item(const float* __restrict__ W, int K, int Norig, int type, bf16* __restrict__ WT, LAS float* scr, int nblk, int item, int lane) {
    const int kb = item / nblk, nb = item % nblk, k0 = 64 * kb, n0 = 32 * nb;
    const int oc = orig_col(type, n0 + (lane & 31)); const float sc = col_scale(type, n0 + (lane & 31));
#pragma unroll 8
    for (int i = 0; i < 32; ++i) { const int kk = 2 * i + (lane >> 5); scr[kk * 33 + (lane & 31)] = oc >= 0 ? W[(size_t)(k0 + kk) * Norig + oc] * sc : 0.f; }
    LDS_WAIT();
    const int c = lane & 7;
#pragma unroll
    for (int j = 0; j < 4; ++j) { const int n = (lane >> 3) + 8 * j; const LAS float* s = scr + (8 * c) * 33 + n;
        u32x4 o; o.x = pk2(s[0 * 33], s[1 * 33]); o.y = pk2(s[2 * 33], s[3 * 33]); o.z = pk2(s[4 * 33], s[5 * 33]); o.w = pk2(s[6 * 33], s[7 * 33]);
        *(u32x4*)(WT + (size_t)(n0 + n) * K + k0 + 8 * c) = o; }
    LDS_WAIT();
}
__device__ __forceinline__ void phase_prologue(KP p, LAS unsigned char* lds) {
    const int tid = otid(), lane = tid & 63, wave = tid >> 6;
    unsigned char* ws = p->ws;
    float* MOD = (float*)(ws + WS_MOD);
    if ((int)blockIdx.x < 192) {
        LAS float* cond = (LAS float*)lds;
        LAS float* red = (LAS float*)(lds + 36864);
        for (int e = tid; e < 9 * 1024; e += NTHR) { const int j = e >> 10, k = e & 1023; const float v = j < 8 ? p->c[j * 1024 + k] : p->c_ctx[k]; cond[e] = siluf(v); }
        __syncthreads();
        for (int it = blockIdx.x; it < 192; it += gridDim.x) {
            const int l = it / 48, n0 = (it % 48) * 64, cq = tid & 15, ks = tid >> 4;
            float acc[9][4];
#pragma unroll
            for (int j = 0; j < 9; ++j) { acc[j][0] = 0.f; acc[j][1] = 0.f; acc[j][2] = 0.f; acc[j][3] = 0.f; }
            const float* wp = p->w_ada + (size_t)l * 1024 * 3072 + (size_t)(ks * 32) * 3072 + n0 + 4 * cq;
#pragma unroll 4
            for (int kk = 0; kk < 32; ++kk) { const f32x4 w = *(const f32x4*)(wp + (size_t)kk * 3072);
#pragma unroll
                for (int j = 0; j < 9; ++j) { const float cv = cond[j * 1024 + ks * 32 + kk]; acc[j][0] += cv * w[0]; acc[j][1] += cv * w[1]; acc[j][2] += cv * w[2]; acc[j][3] += cv * w[3]; } }
#pragma unroll
            for (int j = 0; j < 9; ++j)
#pragma unroll
                for (int i = 0; i < 4; ++i) red[ks * 576 + j * 64 + 4 * cq + i] = acc[j][i];
            __syncthreads();
            for (int o = tid; o < 576; o += NTHR) { float s = 0.f; for (int q = 0; q < 32; ++q) s += red[q * 576 + o]; const int j = o >> 6, n = n0 + (o & 63);
                MOD[(size_t)(l * 9 + j) * 3072 + n] = s + p->b_ada[l * 3072 + n]; }
            __syncthreads();
        }
    }
    if (blockIdx.x == gridDim.x - 1) {
        float* cosT = (float*)(ws + WS_ROPE); float* sinT = cosT + 1024;
        for (int e = tid; e < 1024; e += NTHR) { const int pos = e >> 4, i = e & 15;
            double f = 1.0; for (int q = 0; q < i; ++q) f *= 0.5623413251903491;
            const double f2 = f * f; double sn = 1.0, cs = 1.0;
            for (int q = 12; q >= 1; --q) { sn = 1.0 - f2 / ((2.0 * q) * (2.0 * q + 1.0)) * sn; cs = 1.0 - f2 / ((2.0 * q - 1.0) * (2.0 * q)) * cs; }
            sn *= f;
            double c = 1.0, s = 0.0; for (int q = 0; q < pos; ++q) { const double c2 = c * cs - s * sn, s2 = s * cs + c * sn; c = c2; s = s2; }
            cosT[e] = (float)c; sinT[e] = (float)s; }
    }
    __syncthreads();
    {
        LAS float* scr = (LAS float*)(lds + wave * 16384);
        const int gw = blockIdx.x * NWAVES + wave, NGW = gridDim.x * NWAVES;
        constexpr int I_E = 16 * (NPAD_EVEN / 32), I_O = 16 * (NPAD_ODD / 32), I_W = 16 * 32;
        constexpr int NIT = 2 * I_E + 2 * I_O + 4 * I_W;
        for (int it = gw; it < NIT; it += NGW) {
            int r = it;
            if (r < 2 * I_E) { const int i = r / I_E; r -= i * I_E; p0_transpose_item(p->w_in_even + (size_t)i * 1024 * NORIG_EVEN, 1024, NORIG_EVEN, 0, (bf16*)(ws + WS_WIE) + (size_t)i * NPAD_EVEN * 1024, scr, NPAD_EVEN / 32, r, lane); continue; }
            r -= 2 * I_E;
            if (r < 2 * I_O) { const int i = r / I_O; r -= i * I_O; p0_transpose_item(p->w_in_odd + (size_t)i * 1024 * NORIG_ODD, 1024, NORIG_ODD, 1, (bf16*)(ws + WS_WIO) + (size_t)i * NPAD_ODD * 1024, scr, NPAD_ODD / 32, r, lane); continue; }
            r -= 2 * I_O;
            { const int l = r / I_W; r -= l * I_W; const float* W = (l & 1) ? p->w_out_odd + (size_t)(l >> 1) * 1024 * 1024 : p->w_out_even + (size_t)(l >> 1) * 1024 * 1024;
              p0_transpose_item(W, 1024, 1024, 2, (bf16*)(ws + WS_WO) + (size_t)l * 1024 * 1024, scr, 32, r, lane); }
        }
    }
}
typedef float f32x8h __attribute__((ext_vector_type(8)));
__device__ __forceinline__ void phase_h0(KP p) {
    const int lane = otid() & 63, gw = blockIdx.x * NWAVES + (otid() >> 6), NGW = gridDim.x * NWAVES;
    const float* MOD = (const float*)(p->ws + WS_MOD); bf16* H = (bf16*)(p->ws + WS_H);
    for (int m = gw; m < MTOT; m += NGW) {
        const int jb = m < MLAT ? (m >> 12) : 8;
        const float* src = m < MLAT ? p->x + (size_t)m * DM : p->ctx + (size_t)(m - MLAT) * DM;
        const float* md = MOD + (size_t)jb * 3072;
#pragma unroll
        for (int j = 0; j < 2; ++j) { const int k = 8 * lane + 512 * j; const f32x8h v = *(const f32x8h*)(src + k), sh = *(const f32x8h*)(md + k), sc = *(const f32x8h*)(md + 1024 + k);
            const f32x8h h = v * (sc + 1.0f) + sh; u32x4 o; o.x = pk2(h[0], h[1]); o.y = pk2(h[2], h[3]); o.z = pk2(h[4], h[5]); o.w = pk2(h[6], h[7]); *(u32x4*)(H + (size_t)m * DM + k) = o; }
    }
}
typedef _Float16 f16x8 __attribute__((ext_vector_type(8)));
typedef float f32x8 __attribute__((ext_vector_type(8)));
struct LnRaw { f32x8 xf[2][2]; f16x8 xh[2][2]; u32x4 y[2][2]; };
__device__ __forceinline__ void ln_load(LnRaw& R, int l, int m0, int lane, const float* xin, const float* cin, const _Float16* X16, const bf16* Y) {
#pragma unroll
    for (int j = 0; j < 2; ++j) { const int k = 8 * lane + 512 * j;
#pragma unroll
        for (int q = 0; q < 2; ++q) { const int m = m0 + q;
            if (l == 0) R.xf[q][j] = *(const f32x8*)((m < MLAT ? xin + (size_t)m * DM : cin + (size_t)(m - MLAT) * DM) + k);
            else R.xh[q][j] = *(const f16x8*)(X16 + (size_t)m * DM + k);
            R.y[q][j] = *(const u32x4*)(Y + (size_t)m * DM + k); } }
}
__device__ __forceinline__ float sum8(const f32x8 v) { return ((v[0] + v[1]) + (v[2] + v[3])) + ((v[4] + v[5]) + (v[6] + v[7])); }
__device__ __forceinline__ u32x4 pack8(const f32x8 h) { u32x4 w; w.x = pk2(h[0], h[1]); w.y = pk2(h[2], h[3]); w.z = pk2(h[4], h[5]); w.w = pk2(h[6], h[7]); return w; }
__device__ __forceinline__ void phase_ln(KP p, int l, bool dummy = false) {
    const int lane = otid() & 63, gw = blockIdx.x * NWAVES + (otid() >> 6), NGW = gridDim.x * NWAVES;
    const float* MOD = (const float*)(p->ws + WS_MOD); bf16* H = (bf16*)(p->ws + WS_H); const bf16* Y = (const bf16*)(p->ws + WS_P); _Float16* X16 = (_Float16*)(p->ws + WS_X16);
    const int mrows = l < DEPTH - 1 ? MTOT : MLAT;
    const float* lg = p->ln_g + l * DM; const float* lb = p->ln_b + l * DM;
    const float* xin = p->x; const float* cin = p->ctx; float* outp = p->out;
    LnRaw R;
    if (2 * gw < mrows) ln_load(R, l, 2 * gw, lane, xin, cin, X16, Y);
    for (int m0 = 2 * gw; m0 < mrows; m0 += 2 * NGW) {
        const int jb = m0 < MLAT ? (m0 >> 12) : 8;
        const float* md = MOD + (size_t)(l * 9 + jb) * 3072;
        f32x8 v[2][2], xs[2][2]; float s[2] = {0.f, 0.f};
#pragma unroll
        for (int j = 0; j < 2; ++j) { const int k = 8 * lane + 512 * j; const f32x8 g = *(const f32x8*)(md + 2048 + k);
#pragma unroll
            for (int q = 0; q < 2; ++q) { const f32x8 xv = l == 0 ? R.xf[q][j] : __builtin_convertvector(R.xh[q][j], f32x8); const u32x4 yw = R.y[q][j];
                f32x8 y; y[0] = bflo(yw.x); y[1] = bfhi(yw.x); y[2] = bflo(yw.y); y[3] = bfhi(yw.y); y[4] = bflo(yw.z); y[5] = bfhi(yw.z); y[6] = bflo(yw.w); y[7] = bfhi(yw.w);
                xs[q][j] = xv; v[q][j] = xv * ALPHA_DN + g * y; s[q] += sum8(v[q][j]); } }
        if (m0 + 2 * NGW < mrows) ln_load(R, l, m0 + 2 * NGW, lane, xin, cin, X16, Y);
        float rstd[2];
#pragma unroll
        for (int q = 0; q < 2; ++q) { const float mean = wave_sum(s[q]) * (1.f / DM); float s2 = 0.f;
#pragma unroll
            for (int j = 0; j < 2; ++j) { v[q][j] = v[q][j] - mean; s2 += sum8(v[q][j] * v[q][j]); }
            rstd[q] = 1.f / sqrtf(wave_sum(s2) * (1.f / DM) + 1e-5f); }
        const float* md2 = MOD + (size_t)((l + 1) * 9 + jb) * 3072;
#pragma unroll
        for (int j = 0; j < 2; ++j) { const int k = 8 * lane + 512 * j; const f32x8 gg = *(const f32x8*)(lg + k), bb = *(const f32x8*)(lb + k);
            f32x8 sh = gg * 0.f, sc = sh; if (l < DEPTH - 1) { sh = *(const f32x8*)(md2 + k); sc = *(const f32x8*)(md2 + 1024 + k); }
#pragma unroll
            for (int q = 0; q < 2; ++q) { const int m = m0 + q; const f32x8 o = v[q][j] * rstd[q] * gg + bb;
                if (l < DEPTH - 1) { *(f16x8*)(X16 + (size_t)m * DM + k) = __builtin_convertvector(dummy ? xs[q][j] : o, f16x8);
                    *(u32x4*)(H + (size_t)m * DM + k) = pack8(o * (sc + 1.0f) + sh); }
                else { if (!dummy) *(f32x8*)(outp + (size_t)m * DM + k) = o; } } }
    }
}
constexpr int AT_KS = 0, AT_VS = 9216, AT_BUF = 18432, AT_PS = 36864, AT_RPB = AT_PS + 8 * 2304;
__device__ __forceinline__ bf16x8 frag_tr_perm(const LAS bf16* X, int ld, int k0, int n0, int lane) {
    const int g = lane >> 4, m = lane & 15, q = m >> 2, p = m & 3;
    const LAS bf16* a0 = X + (k0 + 4 * g + q) * ld + n0 + 4 * p;
    const s16x4 lo = __builtin_amdgcn_ds_read_tr16_b64_v4i16((LAS s16x4*)a0);
    const s16x4 hi = __builtin_amdgcn_ds_read_tr16_b64_v4i16((LAS s16x4*)(a0 + 16 * ld));
    bf16x8 r; r[0] = lo[0]; r[1] = lo[1]; r[2] = lo[2]; r[3] = lo[3]; r[4] = hi[0]; r[5] = hi[1]; r[6] = hi[2]; r[7] = hi[3]; return r;
}
__device__ __forceinline__ void attn_tile(const LAS bf16* Ks, const LAS bf16* Vs, const LAS float* rpb, const bf16x8 (&qa)[2][2], float (&mrow)[2], float (&lsum)[2], f32x4 (&oacc)[2][4],
                                          int mode, int i, int nlat, int qa_, int qb_, int ka_, int lane) {
    const int fq = lane >> 4, fr = lane & 15;
    const bool islat = i < nlat;
    bool active = true; int kt0 = 0;
    if (islat) {
        if (mode == 0) { kt0 = ka_ + i; const int rs = min(max(qa_ - 4, 0), 56); active = (kt0 >= rs) && (kt0 < rs + 8); }
        else { kt0 = ka_ + 64 * i; active = !(kt0 > qa_ + 31 + 128 || kt0 + 63 < qa_ - 128); }
    }
    if (!active) return;
    const bool nar = islat && mode == 0;
    const int ct0 = qb_ >> 4;
    int ntlo[2], nthi[2];
#pragma unroll
    for (int nq = 0; nq < 2; ++nq) { const int ct = ct0 + nq; ntlo[nq] = nar ? (ct < 2 ? 0 : ct - 1) : 0; nthi[nq] = nar ? (ct > 1 ? 3 : ct + 1) : 3; }
    const int ulo = min(ntlo[0], ntlo[1]), uhi = max(nthi[0], nthi[1]);
    f32x4 s[2][4];
#pragma unroll
    for (int mt = 0; mt < 4; ++mt) { s[0][mt] = (f32x4){0.f, 0.f, 0.f, 0.f}; s[1][mt] = (f32x4){0.f, 0.f, 0.f, 0.f};
        if (mt >= ulo && mt <= uhi) {
#pragma unroll
            for (int ks = 0; ks < 2; ++ks) { const bf16x8 kf = frag_rm(Ks, 72, 16 * mt, 32 * ks, lane);
                if (mt >= ntlo[0] && mt <= nthi[0]) s[0][mt] = MFMA(kf, qa[0][ks], s[0][mt]);
                if (mt >= ntlo[1] && mt <= nthi[1]) s[1][mt] = MFMA(kf, qa[1][ks], s[1][mt]); } } }
    unsigned pw[2][8];
    const bool swa_mask = islat && mode == 1 && !((qa_ + 31 - kt0 <= 128) && (qa_ - kt0 - 63 >= -128));
    constexpr float L2E = 1.44269504089f;
#pragma unroll
    for (int nq = 0; nq < 2; ++nq) {
        float tmax = -3e38f;
        if (nar) {
            const int qc = qb_ + 16 * nq + fr, cs = min(max(qc - 8, 0), 48);
            const unsigned long long ml = (0xFFFFull << cs) >> (4 * fq);
            const unsigned mlo = (unsigned)ml, mhi = (unsigned)(ml >> 32);
            const LAS float* bp = rpb + (kt0 - qa_ + 7) * 31 + (4 * fq - qc + 15);
#pragma unroll
            for (int mt = 0; mt < 4; ++mt) { if (mt >= ntlo[nq] && mt <= nthi[nq]) {
#pragma unroll
                for (int r = 0; r < 4; ++r) { const int pbit = 16 * mt + r; const bool ok = ((pbit < 32 ? mlo >> pbit : mhi >> (pbit - 32)) & 1u) != 0u;
                    const float v = ok ? s[nq][mt][r] + bp[ok ? pbit : 0] : -3e38f; s[nq][mt][r] = v; tmax = fmaxf(tmax, v); } } }
        } else if (swa_mask) {
            const int d0 = (qa_ + 16 * nq + fr) - (kt0 + 4 * fq);
#pragma unroll
            for (int mt = 0; mt < 4; ++mt)
#pragma unroll
                for (int r = 0; r < 4; ++r) { const int d = d0 - (16 * mt + r); const float v = (d <= 128 && d >= -128) ? s[nq][mt][r] : -3e38f; s[nq][mt][r] = v; tmax = fmaxf(tmax, v); }
        } else {
#pragma unroll
            for (int mt = 0; mt < 4; ++mt)
#pragma unroll
                for (int r = 0; r < 4; ++r) tmax = fmaxf(tmax, s[nq][mt][r]);
        }
        tmax = fmaxf(tmax, __shfl_xor(tmax, 16)); tmax = fmaxf(tmax, __shfl_xor(tmax, 32));
        const float mnew = fmaxf(mrow[nq], tmax); const float alpha = __builtin_amdgcn_exp2f((mrow[nq] - mnew) * L2E); mrow[nq] = mnew;
        const float nm = -mnew * L2E;
        float ps = 0.f;
#pragma unroll
        for (int mt = 0; mt < 4; ++mt) { float p0 = 0.f, p1 = 0.f, p2 = 0.f, p3 = 0.f;
            if (mt >= ntlo[nq] && mt <= nthi[nq]) { p0 = __builtin_amdgcn_exp2f(__builtin_fmaf(s[nq][mt][0], L2E, nm)); p1 = __builtin_amdgcn_exp2f(__builtin_fmaf(s[nq][mt][1], L2E, nm));
                p2 = __builtin_amdgcn_exp2f(__builtin_fmaf(s[nq][mt][2], L2E, nm)); p3 = __builtin_amdgcn_exp2f(__builtin_fmaf(s[nq][mt][3], L2E, nm)); ps += (p0 + p1) + (p2 + p3); }
            pw[nq][2 * mt] = pk2(p0, p1); pw[nq][2 * mt + 1] = pk2(p2, p3); oacc[nq][mt] = oacc[nq][mt] * alpha; }
        lsum[nq] = lsum[nq] * alpha + ps;
    }
#pragma unroll
    for (int ks = 0; ks < 2; ++ks) { if (ks == 0 ? (ulo < 2) : (uhi > 1)) {
        const u32x4 pu0 = (u32x4){pw[0][4 * ks], pw[0][4 * ks + 1], pw[0][4 * ks + 2], pw[0][4 * ks + 3]}, pu1 = (u32x4){pw[1][4 * ks], pw[1][4 * ks + 1], pw[1][4 * ks + 2], pw[1][4 * ks + 3]};
        const bf16x8 pb0 = __builtin_bit_cast(bf16x8, pu0), pb1 = __builtin_bit_cast(bf16x8, pu1);
#pragma unroll
        for (int mt = 0; mt < 4; ++mt) { const bf16x8 vf = frag_tr_perm(Vs, 72, 32 * ks, 16 * mt, lane); oacc[0][mt] = MFMA(vf, pb0, oacc[0][mt]); oacc[1][mt] = MFMA(vf, pb1, oacc[1][mt]); } } }
}
constexpr int AT_PSW = 32 * 72 * 2;
constexpr int AT_RPB2 = AT_PS + 8 * AT_PSW;
__device__ __forceinline__ void attn_item(LAS unsigned char* lds, const bf16* __restrict__ P, int ldp, bf16* __restrict__ Z, int mode,
                                          int qrow0, int qcol, int kcol, int vcol, int gcol, int zcol,
                                          int nlat, int lat_row0, int ctx_row0, int qa_, int qb_, int ka_, const float* __restrict__ rpb_g, float sink) {
    const int tid = otid(), lane = tid & 63, wave = tid >> 6, fq = lane >> 4, fr = lane & 15;
    LAS bf16* Ks0 = (LAS bf16*)(lds + AT_KS); LAS bf16* Vs0 = (LAS bf16*)(lds + AT_VS); LAS bf16* Ks1 = (LAS bf16*)(lds + AT_KS + AT_BUF); LAS bf16* Vs1 = (LAS bf16*)(lds + AT_VS + AT_BUF);
    LAS bf16* Ps = (LAS bf16*)(lds + AT_PS + wave * AT_PSW); LAS float* rpb = (LAS float*)(lds + AT_RPB2);
    const int ntile = nlat + 4, srow = tid >> 3, sch = tid & 7, soff = srow * 72 + 8 * sch;
#define AT_ROWB(j) (((j) < nlat) ? lat_row0 + 64 * (j) : ctx_row0 + 64 * ((j) - nlat))
#define AT_LOAD(kr, vr, j) do { const size_t ro_ = (size_t)(AT_ROWB(j) + srow) * ldp + 8 * sch; kr = *(const u32x4*)(P + ro_ + kcol); vr = *(const u32x4*)(P + ro_ + vcol); } while (0)
    u32x4 k0, v0, k1, v1;
    AT_LOAD(k0, v0, 0);
    bf16x8 qa[2][2];
#pragma unroll
    for (int nq = 0; nq < 2; ++nq)
#pragma unroll
        for (int ks = 0; ks < 2; ++ks) qa[nq][ks] = *(const bf16x8*)(P + (size_t)(qrow0 + 16 * nq + fr) * ldp + qcol + 32 * ks + 8 * fq);
    __syncthreads();
    if (mode == 0) { for (int e = tid; e < 465; e += NTHR) rpb[e] = rpb_g[e]; }
    *(LAS u32x4*)(Ks0 + soff) = k0; *(LAS u32x4*)(Vs0 + soff) = v0;
    AT_LOAD(k0, v0, 1);
    AT_LOAD(k1, v1, 2);
    float mrow[2] = {-1e30f, -1e30f}, lsum[2] = {0.f, 0.f}; f32x4 oacc[2][4];
#pragma unroll
    for (int nq = 0; nq < 2; ++nq)
#pragma unroll
        for (int r = 0; r < 4; ++r) oacc[nq][r] = (f32x4){0.f, 0.f, 0.f, 0.f};
    __syncthreads();
    for (int i = 0; i < ntile; i += 2) {
        attn_tile(Ks0, Vs0, rpb, qa, mrow, lsum, oacc, mode, i, nlat, qa_, qb_, ka_, lane);
        if (i + 1 < ntile) { *(LAS u32x4*)(Ks1 + soff) = k0; *(LAS u32x4*)(Vs1 + soff) = v0; }
        if (i + 3 < ntile) AT_LOAD(k0, v0, i + 3);
        __syncthreads();
        if (i + 1 >= ntile) break;
        attn_tile(Ks1, Vs1, rpb, qa, mrow, lsum, oacc, mode, i + 1, nlat, qa_, qb_, ka_, lane);
        if (i + 2 < ntile) { *(LAS u32x4*)(Ks0 + soff) = k1; *(LAS u32x4*)(Vs0 + soff) = v1; }
        if (i + 4 < ntile) AT_LOAD(k1, v1, i + 4);
        __syncthreads();
    }
#undef AT_LOAD
#undef AT_ROWB
    u32x4 gvv[4];
#pragma unroll
    for (int c2 = 0; c2 < 4; ++c2) { const int idx = lane + 64 * c2, q = idx >> 3, ch = idx & 7; gvv[c2] = *(const u32x4*)(P + (size_t)(qrow0 + q) * ldp + gcol + 8 * ch); }
#pragma unroll
    for (int nq = 0; nq < 2; ++nq) { float lt = lsum[nq]; lt += __shfl_xor(lt, 16); lt += __shfl_xor(lt, 32); float sc;
      if (mode == 1 || mode == 3) { const float mf = fmaxf(mrow[nq], sink); const float al = __expf(mrow[nq] - mf); lt = lt * al + __expf(sink - mf); sc = al / lt; } else sc = 1.f / lt;
#pragma unroll
      for (int mt = 0; mt < 4; ++mt) { u32x2 w; w.x = pk2(oacc[nq][mt][0] * sc, oacc[nq][mt][1] * sc); w.y = pk2(oacc[nq][mt][2] * sc, oacc[nq][mt][3] * sc); *(LAS u32x2*)(Ps + (16 * nq + fr) * 72 + 16 * mt + 4 * fq) = w; } }
    LDS_WAIT();
#pragma unroll
    for (int c2 = 0; c2 < 4; ++c2) { const int idx = lane + 64 * c2, q = idx >> 3, ch = idx & 7;
        const u32x4 ov = *(const LAS u32x4*)(Ps + q * 72 + 8 * ch); const u32x4 gv = gvv[c2];
        u32x4 w;
        w.x = pk2(bflo(ov.x) * siluf(bflo(gv.x)), bfhi(ov.x) * siluf(bfhi(gv.x))); w.y = pk2(bflo(ov.y) * siluf(bflo(gv.y)), bfhi(ov.y) * siluf(bfhi(gv.y)));
        w.z = pk2(bflo(ov.z) * siluf(bflo(gv.z)), bfhi(ov.z) * siluf(bfhi(gv.z))); w.w = pk2(bflo(ov.w) * siluf(bflo(gv.w)), bfhi(ov.w) * siluf(bfhi(gv.w)));
        *(u32x4*)(Z + (size_t)(qrow0 + q) * DM + zcol + 8 * ch) = w; }
    LDS_WAIT();
}
__device__ __forceinline__ void phase_attn(KP p, LAS unsigned char* lds, int l, bool need_ctx) {
    const int wave = otid() >> 6; const bool odd = l & 1; const int li = l >> 1;
    const bf16* P = (const bf16*)(p->ws + WS_P); bf16* Z = (bf16*)(p->ws + WS_H); const int ldp = odd ? NP_ODD : NP_EVEN;
    const int nmain = BATCH * 8 * 16, nctx = need_ctx ? BATCH * 8 : 0;
    for (int it = blockIdx.x; it < nmain + nctx; it += gridDim.x) {
        if (it < nmain) {
            int itv = it;
            if (gridDim.x == 256) { const int rnd = it >> 8, bx = it & 255, xcd = bx & 7, slot = bx >> 3; itv = ((rnd * 16 + 2 * xcd + (slot >> 4)) << 4) + (slot & 15); }
            const int b = itv >> 7, h = (itv >> 4) & 7, qb = itv & 15;
            if (!odd) { const int r0 = 4 * qb, rw = r0 + (wave >> 1); const int rs0 = min(max(r0 - 4, 0), 56), rs3 = min(max(r0 + 3 - 4, 0), 56);
                attn_item(lds, P, ldp, Z, 0, b * SEQ + rw * 64 + 32 * (wave & 1), 1536 + h * 64, 2048 + h * 64, 2560 + h * 64, 3072 + h * 64, 512 + h * 64,
                          rs3 + 8 - rs0, b * SEQ + rs0 * 64, MLAT + b * CTXL, rw, 32 * (wave & 1), rs0, p->na_rpb + (size_t)(li * 8 + h) * 465, 0.f); }
            else {
                int itw = it; if (gridDim.x == 256) { const int rnd = it >> 8, bx = it & 255, xcd = bx & 7, slot = bx >> 3; itw = ((rnd * 8 + xcd) << 5) + slot; }
                const int bb = itw >> 7, kv = (itw >> 6) & 1, qb2 = itw & 63, hh = 4 * kv + (wave >> 1), w2 = wave & 1;
                const int t0 = 64 * qb2, lt0 = max(0, qb2 - 2), lt1 = min(63, qb2 + 2);
                attn_item(lds, P, ldp, Z, 1, bb * SEQ + t0 + 32 * w2, 1536 + hh * 64, 2048 + kv * 64, 2176 + kv * 64, 2304 + hh * 64, 512 + hh * 64,
                          lt1 - lt0 + 1, bb * SEQ + lt0 * 64, MLAT + bb * CTXL, t0 + 32 * w2, 0, lt0 * 64, nullptr, p->sw_sink[li * 8 + hh]); }
        } else {
            const int j = it - nmain, b = j >> 3, h = j & 7; const int q0 = MLAT + b * CTXL + 32 * wave;
            if (!odd) attn_item(lds, P, ldp, Z, 2, q0, 1536 + h * 64, 2048 + h * 64, 2560 + h * 64, 3072 + h * 64, 512 + h * 64, 0, 0, MLAT + b * CTXL, 0, 0, 0, nullptr, 0.f);
            else { const int kv = h >> 2; attn_item(lds, P, ldp, Z, 3, q0, 1536 + h * 64, 2048 + kv * 64, 2176 + kv * 64, 2304 + h * 64, 512 + h * 64, 0, 0, MLAT + b * CTXL, 0, 0, 0, nullptr, p->sw_sink[li * 8 + h]); }
        }
    }
}
__device__ __forceinline__ int chunk_row0(int b, int cp) { return cp < 4 ? MLAT + b * CTXL + cp * 64 : b * SEQ + (cp - 4) * 64; }
constexpr int SL_KDF = 0, SL_KDB = 9216, SL_VS = 18432, SL_SEG = 35840, SL_MISC = 39936;
__device__ __forceinline__ void phase_scan_local(KP p, LAS unsigned char* lds, int l) {
    const int tid = otid(), lane = tid & 63, wave = tid >> 6, fq = lane >> 4, fr = lane & 15; const bool odd = l & 1; const int li = l >> 1;
    const bf16* P = (const bf16*)(p->ws + WS_P); const int ldp = odd ? NP_ODD : NP_EVEN; const float* SM = (const float*)(p->ws + WS_SM);
    bf16* S = (bf16*)(p->ws + WS_S); float* GAM = (float*)(p->ws + WS_GAM); float* SC = (float*)(p->ws + WS_SC);
    LAS bf16* kdf = (LAS bf16*)(lds + SL_KDF); LAS bf16* kdb = (LAS bf16*)(lds + SL_KDB); LAS bf16* vs = (LAS bf16*)(lds + SL_VS);
    LAS float* seg = (LAS float*)(lds + SL_SEG); LAS float* misc = (LAS float*)(lds + SL_MISC);
    const int dk = tid & 63, sg = tid >> 6;
    for (int it = blockIdx.x; it < BATCH * 4 * NCHUNK; it += gridDim.x) {
        const int b = it / (4 * NCHUNK), h = (it / NCHUNK) & 3, cp = it % NCHUNK; const int row0 = chunk_row0(b, cp);
        const int slf = ((b * 4 + h) * 2 + 0) * NCHUNK + cp, slb = slf + NCHUNK;
        __syncthreads();
#pragma unroll
        for (int c2 = 0; c2 < 2; ++c2) { const int idx = tid + NTHR * c2, t = idx >> 4, ch = idx & 15; *(LAS u32x4*)(vs + t * 136 + 8 * ch) = *(const u32x4*)(P + (size_t)(row0 + t) * ldp + 512 + h * 128 + 8 * ch); }
        float kv[8];
#pragma unroll
        for (int tt = 0; tt < 8; ++tt) kv[tt] = bf2f(P[(size_t)(row0 + sg * 8 + tt) * ldp + 256 + h * 64 + dk]);
        if (!odd) {
            float gwf[16], gwb[16];
            const float* gw = p->gla_gate_w + (size_t)li * 2 * 16 * 256; const float* gb = p->gla_gate_b + (size_t)li * 2 * 256;
#pragma unroll
            for (int r = 0; r < 16; ++r) { gwf[r] = gw[r * 256 + h * 64 + dk]; gwb[r] = gw[(16 + r) * 256 + h * 64 + dk]; }
            const float gbf = gb[h * 64 + dk], gbb = gb[256 + h * 64 + dk];
            { const int t = tid >> 3, c4 = (tid & 7) * 4; *(LAS f32x4*)(misc + t * 32 + c4) = *(const f32x4*)(SM + (size_t)(row0 + t) * 32 + c4); }
            __syncthreads();
            float pf[8], sb[8];
            f32x4 L[2][8];
#pragma unroll
            for (int i = 0; i < 8; ++i) L[0][i] = *(const LAS f32x4*)(misc + (sg * 8) * 32 + 4 * i);
#pragma unroll
            for (int tt = 0; tt < 8; ++tt) {
                if (tt < 7) {
#pragma unroll
                    for (int i = 0; i < 8; ++i) L[(tt + 1) & 1][i] = *(const LAS f32x4*)(misc + (sg * 8 + tt + 1) * 32 + 4 * i); }
                float zf = gbf, zb = gbb, zf2 = 0.f, zb2 = 0.f;
#pragma unroll
                for (int i = 0; i < 4; i += 2)
#pragma unroll
                    for (int e = 0; e < 4; ++e) { zf += L[tt & 1][i][e] * gwf[4 * i + e]; zf2 += L[tt & 1][i + 1][e] * gwf[4 * i + 4 + e]; zb += L[tt & 1][4 + i][e] * gwb[4 * i + e]; zb2 += L[tt & 1][5 + i][e] * gwb[4 * i + 4 + e]; }
                pf[tt] = logsigf(zf + zf2) * 0.0625f; sb[tt] = logsigf(zb + zb2) * 0.0625f; }
#pragma unroll
            for (int tt = 1; tt < 8; ++tt) pf[tt] += pf[tt - 1];
#pragma unroll
            for (int tt = 6; tt >= 0; --tt) sb[tt] += sb[tt + 1];
            seg[(0 * 8 + sg) * 64 + dk] = pf[7]; seg[(1 * 8 + sg) * 64 + dk] = sb[0];
            __syncthreads();
            float offf = 0.f, totf = 0.f, offb = 0.f, totb = 0.f;
#pragma unroll
            for (int q = 0; q < 8; ++q) { const float a = seg[q * 64 + dk], c = seg[(8 + q) * 64 + dk]; totf += a; totb += c; if (q < sg) offf += a; if (q > sg) offb += c; }
#pragma unroll
            for (int tt = 0; tt < 8; ++tt) { const int t = sg * 8 + tt;
                kdf[t * 72 + dk] = (bf16)f2bf(kv[tt] * __expf(totf - (offf + pf[tt]))); kdb[t * 72 + dk] = (bf16)f2bf(kv[tt] * __expf(totb - (offb + sb[tt]))); }
            if (sg == 0) { GAM[(size_t)slf * 64 + dk] = __expf(totf); GAM[(size_t)slb * 64 + dk] = __expf(totb); }
        } else {
            const float* mb = p->ml_gate_b + li * 16;
            if (tid < 128) { const int d = tid >> 6, t = tid & 63; const float* gp = SM + (size_t)(row0 + t) * 32 + d * 8;
                const float ig = gp[h] + mb[d * 8 + h], lf = logsigf(gp[4 + h] + mb[d * 8 + 4 + h]);
                const float run = wave_scan_sum(lf, t, d == 1);
                const float tot = rdlane(run, d == 0 ? 63 : 0);
                const float wl = tot - run + ig; const float ml = wave_max(wl);
                misc[256 + d * 64 + t] = __expf(wl - ml);
                if (t == 0) { const int sl = d == 0 ? slf : slb; SC[(size_t)sl * 4 + 0] = tot; SC[(size_t)sl * 4 + 1] = ml; } }
            __syncthreads();
            float nf = 0.f, nb = 0.f;
#pragma unroll
            for (int tt = 0; tt < 8; ++tt) { const int t = sg * 8 + tt; const float a = kv[tt] * misc[256 + t], c = kv[tt] * misc[256 + 64 + t]; nf += a; nb += c;
                kdf[t * 72 + dk] = (bf16)f2bf(a); kdb[t * 72 + dk] = (bf16)f2bf(c); }
            seg[(0 * 8 + sg) * 64 + dk] = nf; seg[(1 * 8 + sg) * 64 + dk] = nb;
            __syncthreads();
            if (sg < 2) { float s2 = 0.f;
#pragma unroll
                for (int q = 0; q < 8; ++q) s2 += seg[(sg * 8 + q) * 64 + dk];
                GAM[(size_t)(sg == 0 ? slf : slb) * 64 + dk] = s2; }
        }
        __syncthreads();
#pragma unroll
        for (int d = 0; d < 2; ++d) { const LAS bf16* kd = d ? kdb : kdf; f32x4 acc[4];
#pragma unroll
            for (int nt = 0; nt < 4; ++nt) acc[nt] = (f32x4){0.f, 0.f, 0.f, 0.f};
#pragma unroll
            for (int ks = 0; ks < 2; ++ks) { const bf16x8 av = frag_tr(vs, 136, 32 * ks, 16 * wave, lane);
#pragma unroll
                for (int nt = 0; nt < 4; ++nt) acc[nt] = MFMA(av, frag_tr(kd, 72, 32 * ks, 16 * nt, lane), acc[nt]); }
            bf16* dst = S + (size_t)(d ? slb : slf) * 8192;
#pragma unroll
            for (int nt = 0; nt < 4; ++nt) { u32x2 w; w.x = pk2(acc[nt][0], acc[nt][1]); w.y = pk2(acc[nt][2], acc[nt][3]); *(u32x2*)(dst + (16 * nt + fr) * 128 + 16 * wave + 4 * fq) = w; } }
    }
}
__device__ __forceinline__ void phase_scan_seq(KP p, int l, bool dummy = false) {
    const bool odd = l & 1;
    u32x2* S2 = (u32x2*)(p->ws + WS_S); float* GAM = (float*)(p->ws + WS_GAM); f32x4* GAM4 = (f32x4*)(p->ws + WS_GAM); float* SC = (float*)(p->ws + WS_SC);
    const int nthreads = gridDim.x * NTHR;
    for (int gid = blockIdx.x * NTHR + otid(); gid < 64 * 2048; gid += nthreads) {
        const int chain = gid >> 11, e4 = gid & 2047, dir = chain & 1, dkk = e4 >> 5; const int base = chain * NCHUNK;
        f32x4 st = (f32x4){0.f, 0.f, 0.f, 0.f}, nst = (f32x4){0.f, 0.f, 0.f, 0.f}; float m = 0.f; const bool hasn = odd && e4 < 16;
        for (int s0 = 0; s0 < NCHUNK; s0 += 4) {
            u32x2 dr[4]; f32x4 dn[4]; float g0[4], g1[4]; int idx[4];
#pragma unroll
            for (int u = 0; u < 4; ++u) { const int step = s0 + u; const int cp = dir == 0 ? step : (step < 4 ? 3 - step : 71 - step); idx[u] = base + cp;
                dr[u] = S2[(size_t)idx[u] * 2048 + e4];
                if (!odd) { g0[u] = GAM[(size_t)idx[u] * 64 + dkk]; g1[u] = 0.f; } else { g0[u] = SC[(size_t)idx[u] * 4 + 0]; g1[u] = SC[(size_t)idx[u] * 4 + 1]; if (hasn) dn[u] = GAM4[(size_t)idx[u] * 16 + e4]; } }
#pragma unroll
            for (int u = 0; u < 4; ++u) {
                const f32x4 d = (f32x4){bflo(dr[u].x), bfhi(dr[u].x), bflo(dr[u].y), bfhi(dr[u].y)};
                u32x2 w; w.x = pk2(st[0], st[1]); w.y = pk2(st[2], st[3]);
                S2[(size_t)idx[u] * 2048 + e4] = dummy ? dr[u] : w;
                if (!odd) { st = st * g0[u] + d; }
                else { if (hasn) GAM4[(size_t)idx[u] * 16 + e4] = dummy ? dn[u] : nst; if (e4 == 0 && !dummy) SC[(size_t)idx[u] * 4 + 2] = m;
                    const float mn = fmaxf(g0[u] + m, g1[u]); const float dec = __expf(g0[u] + m - mn), sc = __expf(g1[u] - mn);
                    st = st * dec + d * sc; if (hasn) nst = nst * dec + dn[u] * sc; m = mn; }
            }
        }
    }
}
constexpr int SO_QF = 0, SO_KF = 9216, SO_QB = 18432, SO_KB = 27648, SO_VS = 36864, SO_AF = 54272, SO_AB = 63488, SO_SF = 72704, SO_SB = 90112, SO_SEG = 107520, SO_SSQ = 111616, SO_MISC = 113664;
constexpr int SO_OST = 0;
__device__ __forceinline__ void scan_out_tail(LAS unsigned char* lds, f32x4 (&o)[4], const bf16* __restrict__ P, int ldp, bf16* __restrict__ Z, int row0, int h, const float* __restrict__ ng) {
    const int tid = otid(), lane = tid & 63, wave = tid >> 6, fq = lane >> 4, fr = lane & 15;
    LAS float* ost = (LAS float*)(lds + SO_OST);
    u32x4 gv[2]; f32x4 g0[2], g1[2];
#pragma unroll
    for (int c2 = 0; c2 < 2; ++c2) { const int idx = tid + NTHR * c2, t = idx >> 4, ch = idx & 15;
        gv[c2] = *(const u32x4*)(P + (size_t)(row0 + t) * ldp + 1024 + h * 128 + 8 * ch); g0[c2] = *(const f32x4*)(ng + h * 128 + 8 * ch); g1[c2] = *(const f32x4*)(ng + h * 128 + 8 * ch + 4); }
    __syncthreads();
#pragma unroll
    for (int mt = 0; mt < 4; ++mt)
#pragma unroll
        for (int r = 0; r < 4; ++r) ost[(16 * mt + 4 * fq + r) * 132 + 16 * wave + fr] = o[mt][r];
    __syncthreads();
#pragma unroll
    for (int c2 = 0; c2 < 2; ++c2) { const int idx = tid + NTHR * c2, t = idx >> 4, ch = idx & 15;
        f32x4 o0 = *(const LAS f32x4*)(ost + t * 132 + 8 * ch), o1 = *(const LAS f32x4*)(ost + t * 132 + 8 * ch + 4);
        const float q = red16_sum((o0[0] * o0[0] + o0[1] * o0[1]) + (o0[2] * o0[2] + o0[3] * o0[3]) + (o1[0] * o1[0] + o1[1] * o1[1]) + (o1[2] * o1[2] + o1[3] * o1[3]));
        const float rs = rsqrtf(q * (1.f / 128.f) + 1e-6f); o0 = o0 * rs * g0[c2]; o1 = o1 * rs * g1[c2];
        u32x4 w;
        w.x = pk2(o0[0] * siluf(bflo(gv[c2].x)), o0[1] * siluf(bfhi(gv[c2].x))); w.y = pk2(o0[2] * siluf(bflo(gv[c2].y)), o0[3] * siluf(bfhi(gv[c2].y)));
        w.z = pk2(o1[0] * siluf(bflo(gv[c2].z)), o1[1] * siluf(bfhi(gv[c2].z))); w.w = pk2(o1[2] * siluf(bflo(gv[c2].w)), o1[3] * siluf(bfhi(gv[c2].w)));
        *(u32x4*)(Z + (size_t)(row0 + t) * DM + h * 128 + 8 * ch) = w; }
}
__device__ __forceinline__ void stage_state(LAS bf16* dst, const bf16* __restrict__ src) {
    const int tid = otid();
#pragma unroll
    for (int c2 = 0; c2 < 2; ++c2) { const int idx = tid + NTHR * c2, r = idx >> 4, ch = idx & 15; *(LAS u32x4*)(dst + r * 136 + 8 * ch) = *(const u32x4*)(src + r * 128 + 8 * ch); }
}
__device__ __forceinline__ void phase_scan_out_gla(KP p, LAS unsigned char* lds, int l, bool need_ctx) {
    const int tid = otid(), lane = tid & 63, wave = tid >> 6, fq = lane >> 4, fr = lane & 15; const int li = l >> 1;
    const bf16* P = (const bf16*)(p->ws + WS_P); const int ldp = NP_EVEN; const float* SM = (const float*)(p->ws + WS_SM); bf16* Z = (bf16*)(p->ws + WS_H);
    const bf16* S = (const bf16*)(p->ws + WS_S);
    LAS bf16* qf = (LAS bf16*)(lds + SO_QF); LAS bf16* kf = (LAS bf16*)(lds + SO_KF); LAS bf16* qb = (LAS bf16*)(lds + SO_QB); LAS bf16* kb = (LAS bf16*)(lds + SO_KB);
    LAS bf16* vs = (LAS bf16*)(lds + SO_VS); LAS bf16* Af = (LAS bf16*)(lds + SO_AF); LAS bf16* Ab = (LAS bf16*)(lds + SO_AB); LAS bf16* Sf = (LAS bf16*)(lds + SO_SF); LAS bf16* Sb = (LAS bf16*)(lds + SO_SB);
    LAS float* seg = (LAS float*)(lds + SO_SEG); LAS float* lrs = (LAS float*)(lds + SO_MISC);
    const int dk = tid & 63, sg = tid >> 6;
    for (int it = blockIdx.x; it < BATCH * 4 * NCHUNK; it += gridDim.x) {
        const int b = it / (4 * NCHUNK), h = (it / NCHUNK) & 3, cp = it % NCHUNK; if (cp < 4 && !need_ctx) continue;
        const int row0 = chunk_row0(b, cp); const int slf = ((b * 4 + h) * 2 + 0) * NCHUNK + cp, slb = slf + NCHUNK;
        __syncthreads();
#pragma unroll
        for (int c2 = 0; c2 < 2; ++c2) { const int idx = tid + NTHR * c2, t = idx >> 4, ch = idx & 15; *(LAS u32x4*)(vs + t * 136 + 8 * ch) = *(const u32x4*)(P + (size_t)(row0 + t) * ldp + 512 + h * 128 + 8 * ch); }
        stage_state(Sf, S + (size_t)slf * 8192); stage_state(Sb, S + (size_t)slb * 8192);
        float qv[8], kv[8];
#pragma unroll
        for (int tt = 0; tt < 8; ++tt) { const size_t ro = (size_t)(row0 + sg * 8 + tt) * ldp + h * 64 + dk; qv[tt] = bf2f(P[ro]); kv[tt] = bf2f(P[ro + 256]); }
        float gwf[16], gwb[16];
        const float* gw = p->gla_gate_w + (size_t)li * 2 * 16 * 256; const float* gb = p->gla_gate_b + (size_t)li * 2 * 256;
#pragma unroll
        for (int r = 0; r < 16; ++r) { gwf[r] = gw[r * 256 + h * 64 + dk]; gwb[r] = gw[(16 + r) * 256 + h * 64 + dk]; }
        const float gbf = gb[h * 64 + dk], gbb = gb[256 + h * 64 + dk];
        { const int t = tid >> 3, c4 = (tid & 7) * 4; *(LAS f32x4*)(lrs + t * 32 + c4) = *(const f32x4*)(SM + (size_t)(row0 + t) * 32 + c4); }
        __syncthreads();
        float pf[8], sb[8];
        f32x4 L[2][8];
#pragma unroll
        for (int i = 0; i < 8; ++i) L[0][i] = *(const LAS f32x4*)(lrs + (sg * 8) * 32 + 4 * i);
#pragma unroll
        for (int tt = 0; tt < 8; ++tt) {
            if (tt < 7) {
#pragma unroll
                for (int i = 0; i < 8; ++i) L[(tt + 1) & 1][i] = *(const LAS f32x4*)(lrs + (sg * 8 + tt + 1) * 32 + 4 * i); }
            float zf = gbf, zb = gbb, zf2 = 0.f, zb2 = 0.f;
#pragma unroll
            for (int i = 0; i < 4; i += 2)
#pragma unroll
                for (int e = 0; e < 4; ++e) { zf += L[tt & 1][i][e] * gwf[4 * i + e]; zf2 += L[tt & 1][i + 1][e] * gwf[4 * i + 4 + e]; zb += L[tt & 1][4 + i][e] * gwb[4 * i + e]; zb2 += L[tt & 1][5 + i][e] * gwb[4 * i + 4 + e]; }
            pf[tt] = logsigf(zf + zf2) * 0.0625f; sb[tt] = logsigf(zb + zb2) * 0.0625f; }
#pragma unroll
        for (int tt = 1; tt < 8; ++tt) pf[tt] += pf[tt - 1];
#pragma unroll
        for (int tt = 6; tt >= 0; --tt) sb[tt] += sb[tt + 1];
        seg[(0 * 8 + sg) * 64 + dk] = pf[7]; seg[(1 * 8 + sg) * 64 + dk] = sb[0];
        __syncthreads();
        float offf = 0.f, offb = 0.f;
#pragma unroll
        for (int q = 0; q < 8; ++q) { const float a = seg[q * 64 + dk], c = seg[(8 + q) * 64 + dk]; if (q < sg) offf += a; if (q > sg) offb += c; }
#pragma unroll
        for (int tt = 0; tt < 8; ++tt) { const int t = sg * 8 + tt; const float bf_ = offf + pf[tt], bb_ = offb + sb[tt];
            qf[t * 72 + dk] = (bf16)f2bf(qv[tt] * __expf(bf_)); kf[t * 72 + dk] = (bf16)f2bf(kv[tt] * __expf(-bf_));
            qb[t * 72 + dk] = (bf16)f2bf(qv[tt] * __expf(bb_)); kb[t * 72 + dk] = (bf16)f2bf(kv[tt] * __expf(-bb_)); }
        __syncthreads();
        { const int mt = wave >> 1;
#pragma unroll
          for (int n2 = 0; n2 < 2; ++n2) { const int nt = 2 * (wave & 1) + n2; f32x4 af = (f32x4){0.f, 0.f, 0.f, 0.f}, ab = (f32x4){0.f, 0.f, 0.f, 0.f};
#pragma unroll
              for (int ks = 0; ks < 2; ++ks) { af = MFMA(frag_rm(qf, 72, 16 * mt, 32 * ks, lane), frag_rm(kf, 72, 16 * nt, 32 * ks, lane), af);
                                               ab = MFMA(frag_rm(qb, 72, 16 * mt, 32 * ks, lane), frag_rm(kb, 72, 16 * nt, 32 * ks, lane), ab); }
#pragma unroll
              for (int r = 0; r < 4; ++r) { const int t = 16 * mt + 4 * fq + r, s = 16 * nt + fr;
                  Af[t * 72 + s] = (bf16)f2bf(s <= t ? af[r] : 0.f); Ab[t * 72 + s] = (bf16)f2bf(s >= t ? ab[r] : 0.f); } } }
        __syncthreads();
        f32x4 o[4];
#pragma unroll
        for (int mt = 0; mt < 4; ++mt) o[mt] = (f32x4){0.f, 0.f, 0.f, 0.f};
#pragma unroll
        for (int ks = 0; ks < 2; ++ks) { const bf16x8 bv = frag_tr(vs, 136, 32 * ks, 16 * wave, lane), bsf = frag_tr(Sf, 136, 32 * ks, 16 * wave, lane), bsb = frag_tr(Sb, 136, 32 * ks, 16 * wave, lane);
#pragma unroll
            for (int mt = 0; mt < 4; ++mt) { o[mt] = MFMA(frag_rm(Af, 72, 16 * mt, 32 * ks, lane), bv, o[mt]); o[mt] = MFMA(frag_rm(Ab, 72, 16 * mt, 32 * ks, lane), bv, o[mt]);
                o[mt] = MFMA(frag_rm(qf, 72, 16 * mt, 32 * ks, lane), bsf, o[mt]); o[mt] = MFMA(frag_rm(qb, 72, 16 * mt, 32 * ks, lane), bsb, o[mt]); } }
        scan_out_tail(lds, o, P, ldp, Z, row0, h, p->gla_norm_g + (size_t)li * 512);
    }
}
constexpr int MO_QS = 0, MO_KS = 9216, MO_QWF = 18432, MO_QWB = 27648;
__device__ __forceinline__ void phase_scan_out_mlstm(KP p, LAS unsigned char* lds, int l, bool need_ctx) {
    const int tid = otid(), lane = tid & 63, wave = tid >> 6, fq = lane >> 4, fr = lane & 15; const int li = l >> 1;
    const bf16* P = (const bf16*)(p->ws + WS_P); const int ldp = NP_ODD; const float* SM = (const float*)(p->ws + WS_SM); bf16* Z = (bf16*)(p->ws + WS_H);
    const bf16* S = (const bf16*)(p->ws + WS_S); const float* GAM = (const float*)(p->ws + WS_GAM); const float* SC = (const float*)(p->ws + WS_SC);
    LAS bf16* qs = (LAS bf16*)(lds + MO_QS); LAS bf16* ks_ = (LAS bf16*)(lds + MO_KS); LAS bf16* qwf = (LAS bf16*)(lds + MO_QWF); LAS bf16* qwb = (LAS bf16*)(lds + MO_QWB);
    LAS bf16* vs = (LAS bf16*)(lds + SO_VS); LAS bf16* Af = (LAS bf16*)(lds + SO_AF); LAS bf16* Ab = (LAS bf16*)(lds + SO_AB); LAS bf16* Cf = (LAS bf16*)(lds + SO_SF); LAS bf16* Cb = (LAS bf16*)(lds + SO_SB);
    LAS float* part = (LAS float*)(lds + SO_SEG);
    LAS float* misc = (LAS float*)(lds + SO_MISC);
    const float* mb = p->ml_gate_b + li * 16;
    for (int it = blockIdx.x; it < BATCH * 4 * NCHUNK; it += gridDim.x) {
        const int b = it / (4 * NCHUNK), h = (it / NCHUNK) & 3, cp = it % NCHUNK; if (cp < 4 && !need_ctx) continue;
        const int row0 = chunk_row0(b, cp); const int slf = ((b * 4 + h) * 2 + 0) * NCHUNK + cp, slb = slf + NCHUNK;
        __syncthreads();
#pragma unroll
        for (int c2 = 0; c2 < 2; ++c2) { const int idx = tid + NTHR * c2, t = idx >> 4, ch = idx & 15; *(LAS u32x4*)(vs + t * 136 + 8 * ch) = *(const u32x4*)(P + (size_t)(row0 + t) * ldp + 512 + h * 128 + 8 * ch); }
        stage_state(Cf, S + (size_t)slf * 8192); stage_state(Cb, S + (size_t)slb * 8192);
        { const int t = tid >> 3, ch = tid & 7; const size_t ro = (size_t)(row0 + t) * ldp + h * 64 + 8 * ch;
          *(LAS u32x4*)(qs + t * 72 + 8 * ch) = *(const u32x4*)(P + ro); *(LAS u32x4*)(ks_ + t * 72 + 8 * ch) = *(const u32x4*)(P + ro + 256); }
        float mprev_r = 0.f;
        if (tid < 128) { const int d = tid >> 6, t = tid & 63; const float* gp = SM + (size_t)(row0 + t) * 32 + d * 8; LAS float* md = misc + d * 512;
            const float ig = gp[h] + mb[d * 8 + h], lf = logsigf(gp[4 + h] + mb[d * 8 + 4 + h]);
            md[t] = ig; misc[1024 + d * 64 + t] = GAM[(size_t)(d ? slb : slf) * 64 + t]; mprev_r = SC[(size_t)(d ? slb : slf) * 4 + 2];
            const float run = wave_scan_sum(lf, t, d == 1); const float pm = wave_scan_max(ig - run, t, d == 1);
            const float mprev = mprev_r;
            const float mt_ = fmaxf(run + pm, run + mprev);
            md[128 + t] = run; md[192 + t] = mt_; md[256 + t] = __expf(run + mprev - mt_); }
        __syncthreads();
        { const int t = tid >> 3, ch = tid & 7; const u32x4 qv = *(const LAS u32x4*)(qs + t * 72 + 8 * ch); const float wf = misc[256 + t], wb = misc[512 + 256 + t];
          u32x4 a, c;
          a.x = pk2(bflo(qv.x) * wf, bfhi(qv.x) * wf); a.y = pk2(bflo(qv.y) * wf, bfhi(qv.y) * wf); a.z = pk2(bflo(qv.z) * wf, bfhi(qv.z) * wf); a.w = pk2(bflo(qv.w) * wf, bfhi(qv.w) * wf);
          c.x = pk2(bflo(qv.x) * wb, bfhi(qv.x) * wb); c.y = pk2(bflo(qv.y) * wb, bfhi(qv.y) * wb); c.z = pk2(bflo(qv.z) * wb, bfhi(qv.z) * wb); c.w = pk2(bflo(qv.w) * wb, bfhi(qv.w) * wb);
          *(LAS u32x4*)(qwf + t * 72 + 8 * ch) = a; *(LAS u32x4*)(qwb + t * 72 + 8 * ch) = c;
          const float q0 = bflo(qv.x), q1 = bfhi(qv.x), q2 = bflo(qv.y), q3 = bfhi(qv.y), q4 = bflo(qv.z), q5 = bfhi(qv.z), q6 = bflo(qv.w), q7 = bfhi(qv.w);
#pragma unroll
          for (int d = 0; d < 2; ++d) { const LAS float* nv = misc + 1024 + d * 64 + 8 * ch;
              part[(d * 8 + ch) * 64 + t] = q0 * nv[0] + q1 * nv[1] + q2 * nv[2] + q3 * nv[3] + q4 * nv[4] + q5 * nv[5] + q6 * nv[6] + q7 * nv[7]; } }
        { const int mt = wave >> 1; float rsf[4] = {0.f, 0.f, 0.f, 0.f}, rsb[4] = {0.f, 0.f, 0.f, 0.f};
#pragma unroll
          for (int n2 = 0; n2 < 2; ++n2) { const int nt = 2 * (wave & 1) + n2; f32x4 a = (f32x4){0.f, 0.f, 0.f, 0.f};
#pragma unroll
              for (int ks = 0; ks < 2; ++ks) a = MFMA(frag_rm(qs, 72, 16 * mt, 32 * ks, lane), frag_rm(ks_, 72, 16 * nt, 32 * ks, lane), a);
#pragma unroll
              for (int r = 0; r < 4; ++r) { const int t = 16 * mt + 4 * fq + r, s = 16 * nt + fr;
                  const float wf = s <= t ? __expf(misc[128 + t] - misc[128 + s] + misc[s] - misc[192 + t]) : 0.f;
                  const float wb = s >= t ? __expf(misc[512 + 128 + t] - misc[512 + 128 + s] + misc[512 + s] - misc[512 + 192 + t]) : 0.f;
                  const float vf = a[r] * wf, vb = a[r] * wb; rsf[r] += vf; rsb[r] += vb;
                  Af[t * 72 + s] = (bf16)f2bf(vf); Ab[t * 72 + s] = (bf16)f2bf(vb); } }
#pragma unroll
          for (int r = 0; r < 4; ++r) { const float a = red16_sum(rsf[r]), c = red16_sum(rsb[r]);
              if (fr == 0) { misc[1152 + (0 * 2 + (wave & 1)) * 64 + 16 * mt + 4 * fq + r] = a; misc[1152 + (1 * 2 + (wave & 1)) * 64 + 16 * mt + 4 * fq + r] = c; } } }
        __syncthreads();
        if (tid < 128) { const int d = tid >> 6, t = tid & 63; float qn = 0.f;
#pragma unroll
            for (int q = 0; q < 8; ++q) qn += part[(d * 8 + q) * 64 + t];
            const float den = misc[1152 + (d * 2 + 0) * 64 + t] + misc[1152 + (d * 2 + 1) * 64 + t] + misc[d * 512 + 256 + t] * qn;
            misc[d * 512 + 320 + t] = 1.f / fmaxf(fabsf(den), __expf(-misc[d * 512 + 192 + t])); }
        f32x4 of[4], ob[4];
#pragma unroll
        for (int mt = 0; mt < 4; ++mt) { of[mt] = (f32x4){0.f, 0.f, 0.f, 0.f}; ob[mt] = (f32x4){0.f, 0.f, 0.f, 0.f}; }
#pragma unroll
        for (int ks = 0; ks < 2; ++ks) { const bf16x8 bv = frag_tr(vs, 136, 32 * ks, 16 * wave, lane), bcf = frag_tr(Cf, 136, 32 * ks, 16 * wave, lane), bcb = frag_tr(Cb, 136, 32 * ks, 16 * wave, lane);
#pragma unroll
            for (int mt = 0; mt < 4; ++mt) { of[mt] = MFMA(frag_rm(Af, 72, 16 * mt, 32 * ks, lane), bv, of[mt]); of[mt] = MFMA(frag_rm(qwf, 72, 16 * mt, 32 * ks, lane), bcf, of[mt]);
                ob[mt] = MFMA(frag_rm(Ab, 72, 16 * mt, 32 * ks, lane), bv, ob[mt]); ob[mt] = MFMA(frag_rm(qwb, 72, 16 * mt, 32 * ks, lane), bcb, ob[mt]); } }
        __syncthreads();
        f32x4 o[4];
#pragma unroll
        for (int mt = 0; mt < 4; ++mt)
#pragma unroll
            for (int r = 0; r < 4; ++r) { const int t = 16 * mt + 4 * fq + r; o[mt][r] = of[mt][r] * misc[320 + t] + ob[mt][r] * misc[512 + 320 + t]; }
        scan_out_tail(lds, o, P, ldp, Z, row0, h, p->ml_norm_g + (size_t)li * 512);
    }
}
#define XB_TMO      128
#define XB_XCNT(j)  (256  + 64 * (j))
#define XB_XSUB(j)  (1280 + 64 * (j))
#define XB_XGEN(j)  (2304 + 64 * (j))
#define XB_TOP      3328
#define XB_TOPGEN   3392
#define XCD_BAR_WORDS 3456
#define XB_SPIN_CAP (1u << 18)

__device__ __forceinline__ unsigned xb_ld(unsigned* p)              { return __hip_atomic_load(p, __ATOMIC_RELAXED, __HIP_MEMORY_SCOPE_AGENT); }
__device__ __forceinline__ unsigned xb_add(unsigned* p, unsigned v) { return __hip_atomic_fetch_add(p, v, __ATOMIC_RELAXED, __HIP_MEMORY_SCOPE_AGENT); }
__device__ __forceinline__ unsigned xb_xcc_id() { return (unsigned)__builtin_amdgcn_s_getreg((3 << 11) | 20) & 0xFu; }
#define XB_SPIN(cond, bar) do { unsigned _sp = 0; while (cond) { __builtin_amdgcn_s_sleep(1); \
    if ((++_sp & 255u) == 0u) { if (xb_ld(&(bar)[XB_TMO])) break; if (_sp > XB_SPIN_CAP) { atomicAdd(&(bar)[XB_TMO], 1u); break; } } } } while (0)

struct XcdBarrier {
    unsigned* bar; unsigned x;
    volatile LAS unsigned* st;
};

__device__ __forceinline__ XcdBarrier xcd_barrier_post(unsigned* bar, volatile LAS unsigned* st) {
    XcdBarrier b; b.bar = bar; b.x = xb_xcc_id(); b.st = st;
    if (otid() == 0) (void)xb_add(&bar[XB_XCNT(b.x)], 1u);
    return b;
}
__device__ __forceinline__ void xcd_barrier_complete(unsigned* bar, unsigned x, unsigned& nloc, unsigned& nx) {
    const unsigned G = gridDim.x * gridDim.y * gridDim.z;
    unsigned sum, cnt, mine, sp = 0u;
    for (;;) {
        sum = 0u; cnt = 0u; mine = 0u;
#pragma unroll
        for (unsigned j = 0; j < 16; ++j) { const unsigned c = xb_ld(&bar[XB_XCNT(j)]); sum += c; cnt += (c > 0u) ? 1u : 0u; mine = (j == x) ? c : mine; }
        if (sum == G) break;
        __builtin_amdgcn_s_sleep(1);
        if ((++sp & 255u) == 0u) { if (xb_ld(&bar[XB_TMO])) break; if (sp > XB_SPIN_CAP) { atomicAdd(&bar[XB_TMO], 1u); break; } }
    }
    nloc = mine > 0u ? mine : 1u; nx = cnt > 0u ? cnt : 1u;
}

__device__ __forceinline__ void xcd_barrier(const XcdBarrier& b) {
    asm volatile("s_waitcnt vmcnt(0)" ::: "memory");
    __syncthreads();
    if (otid() == 0) {
        unsigned* bar = b.bar;
        __builtin_amdgcn_s_waitcnt(0);
        unsigned nloc = b.st[0], nx = b.st[1];
        if (nloc == 0u) { xcd_barrier_complete(bar, b.x, nloc, nx); b.st[0] = nloc; b.st[1] = nx; }
        const unsigned old = xb_add(&bar[XB_XSUB(b.x)], 1u);
        const unsigned gen = old / nloc;
        if (old + 1u == (gen + 1u) * nloc) {
            __builtin_amdgcn_fence(__ATOMIC_RELEASE, "agent");
            asm volatile("s_waitcnt vmcnt(0)" ::: "memory");
            const unsigned og = xb_add(&bar[XB_TOP], 1u);
            const unsigned tg = og / nx;
            if (og + 1u == (tg + 1u) * nx) xb_add(&bar[XB_TOPGEN], 1u);
            else XB_SPIN(xb_ld(&bar[XB_TOPGEN]) == tg, bar);
            __builtin_amdgcn_fence(__ATOMIC_ACQUIRE, "agent");
            xb_add(&bar[XB_XGEN(b.x)], 1u);
            asm volatile("s_waitcnt vmcnt(0)" ::: "memory");
        } else {
            XB_SPIN(xb_ld(&bar[XB_XGEN(b.x)]) == gen, bar);
            __builtin_amdgcn_fence(__ATOMIC_ACQUIRE, "agent");
            asm volatile("s_waitcnt vmcnt(0)" ::: "memory");
        }
    }
    __syncthreads();
}

#define REP_GEMM 1
#define REP_ATT 1
#define REP_LOC 1
#define REP_OUT 1
#define REP_PRO 1
#define REP_SEQ 1
#define REP_LN 1
#ifndef MK_N_LAUNCHES
#define MK_N_LAUNCHES 1
#endif
constexpr int N_PHASES = 2 + 6 * DEPTH;
__global__ void __launch_bounds__(NTHR, 2) fwd_megakernel(Params p_unused) {
    extern __shared__ __attribute__((aligned(16))) unsigned char lds_raw[];
    LAS unsigned char* lds = (LAS unsigned char*)lds_raw;
    cg::grid_group grid = cg::this_grid();
    const int lo = (int)kparams()->ph_lo, hi = (int)kparams()->ph_hi;
#define IN(k) (lo <= (k) && (k) < hi)
    volatile LAS unsigned* bst = (volatile LAS unsigned*)(lds + LDS_BYTES - 64);
    if (otid() < 16) bst[otid()] = 0u;
    __syncthreads();
    XcdBarrier bar = xcd_barrier_post((unsigned*)(kparams()->ws + WS_BAR), bst);
    if (kparams()->ph_hi < 0) grid.sync();
#define SEAM(k) do { if (IN(k) && IN((k) + 1)) xcd_barrier(bar); } while (0)
    if (IN(0)) { for (int rep = 0; rep < REP_PRO; ++rep) { phase_prologue(kparams(), lds); __syncthreads(); } } SEAM(0);
    if (IN(1)) { for (int rep = 0; rep < REP_PRO; ++rep) phase_h0(kparams()); } SEAM(1);
#pragma unroll 1
    for (int l = 0; l < DEPTH; ++l) {
        const int pb = 2 + 6 * l; const bool odd = l & 1; const int li = l >> 1; const bool need_ctx = l < DEPTH - 1;
        if (IN(pb + 0)) {
            const int npad = odd ? NPAD_ODD : NPAD_EVEN; unsigned char* ws = kparams()->ws;
            pg8::Gemm g{(const pg8::bf16_t*)(ws + WS_H), (const pg8::bf16_t*)(ws + (odd ? WS_WIO : WS_WIE)) + (size_t)li * npad * 1024, MTOT, npad, 1024};
            pg8::StaticOrder S; S.init(MTOT, npad, (int)gridDim.x, (int)blockIdx.x);
            pg8::EpiProj E{(pg8::bf16_t*)(ws + WS_P), odd ? NP_ODD : NP_EVEN, (float*)(ws + WS_SM), odd ? 16 : 32, npad / 256 - 1, odd ? 1 : 0, (const float*)(ws + WS_ROPE), (const float*)(ws + WS_ROPE) + 1024};
            for (int rep = 0; rep < REP_GEMM; ++rep) pg8::gemm_phase<pg8::EpiProj, pg8::StaticOrder, true, true>(lds, g, S, E);
        }
        SEAM(pb + 0);
        if (IN(pb + 1)) { for (int rep = 0; rep < REP_ATT; ++rep) phase_attn(kparams(), lds, l, need_ctx); for (int rep = 0; rep < REP_LOC; ++rep) phase_scan_local(kparams(), lds, l); }
        SEAM(pb + 1);
        if (IN(pb + 2)) { for (int rep = 1; rep < REP_SEQ; ++rep) { phase_scan_seq(kparams(), l, true); __syncthreads(); } phase_scan_seq(kparams(), l); }
        SEAM(pb + 2);
        if (IN(pb + 3)) { for (int rep = 0; rep < REP_OUT; ++rep) { if (odd) phase_scan_out_mlstm(kparams(), lds, l, need_ctx); else phase_scan_out_gla(kparams(), lds, l, need_ctx); } }
        SEAM(pb + 3);
        if (IN(pb + 4)) {
            const int mrows = need_ctx ? MTOT : MLAT; unsigned char* ws = kparams()->ws;
            pg8::Gemm g{(const pg8::bf16_t*)(ws + WS_H), (const pg8::bf16_t*)(ws + WS_WO) + (size_t)l * 1024 * 1024, mrows, 1024, 1024};
            pg8::StaticOrder S; S.init(mrows, 1024, (int)gridDim.x, (int)blockIdx.x);
            pg8::EpiProj E{(pg8::bf16_t*)(ws + WS_P), 1024, nullptr, 0, -1, 0, nullptr, nullptr};
            for (int rep = 0; rep < REP_GEMM; ++rep) pg8::gemm_phase<pg8::EpiProj, pg8::StaticOrder, true, true>(lds, g, S, E);
        }
        SEAM(pb + 4);
        if (IN(pb + 5)) { for (int rep = 1; rep < REP_LN; ++rep) { phase_ln(kparams(), l, true); } phase_ln(kparams(), l); }
        SEAM(pb + 5);
    }
}
extern "C" void kernel_launch(void* const* d_in, const int* in_sizes, int n_in, void* d_out, int out_size, void* d_ws, size_t ws_size, hipStream_t stream) {
    static int grid = 0;
    if (grid == 0) {
        if (n_in != 19 || ws_size < WS_END) { fprintf(stderr, "kernel_launch: need 19 inputs and %zu bytes of workspace; got %d, %zu\n", (size_t)WS_END, n_in, ws_size); grid = -1; return; }
        int dev = 0, cus = 0, per_cu = 0;
        if (hipGetDevice(&dev) != hipSuccess || hipDeviceGetAttribute(&cus, hipDeviceAttributeMultiprocessorCount, dev) != hipSuccess) { grid = -1; return; }
        if (hipFuncSetAttribute((const void*)fwd_megakernel, hipFuncAttributeMaxDynamicSharedMemorySize, LDS_BYTES) != hipSuccess) { fprintf(stderr, "kernel_launch: hipFuncSetAttribute failed\n"); grid = -1; return; }
        if (hipOccupancyMaxActiveBlocksPerMultiprocessor(&per_cu, (const void*)fwd_megakernel, NTHR, LDS_BYTES) != hipSuccess || per_cu < 1) per_cu = 1;
        grid = cus * per_cu;
    }
    if (grid < 0) return;
    Params p{};
    p.x = (const float*)d_in[0]; p.c = (const float*)d_in[1]; p.ctx = (const float*)d_in[2]; p.c_ctx = (const float*)d_in[3]; p.w_ada = (const float*)d_in[4]; p.b_ada = (const float*)d_in[5];
    p.ln_g = (const float*)d_in[6]; p.ln_b = (const float*)d_in[7]; p.w_in_even = (const float*)d_in[8]; p.w_out_even = (const float*)d_in[9]; p.gla_gate_w = (const float*)d_in[10]; p.gla_gate_b = (const float*)d_in[11];
    p.gla_norm_g = (const float*)d_in[12]; p.na_rpb = (const float*)d_in[13]; p.w_in_odd = (const float*)d_in[14]; p.w_out_odd = (const float*)d_in[15]; p.ml_gate_b = (const float*)d_in[16]; p.ml_norm_g = (const float*)d_in[17];
    p.sw_sink = (const float*)d_in[18]; p.out = (float*)d_out; p.ws = (unsigned char*)d_ws;
    if (hipMemsetAsync((char*)d_ws + WS_BAR, 0, XCD_BAR_WORDS * 4, stream) != hipSuccess) { fprintf(stderr, "kernel_launch: memset failed\n"); return; }
#if MK_N_LAUNCHES == 1
    p.ph_lo = 0; p.ph_hi = N_PHASES;
    void* args[] = {&p};
    hipError_t e = hipLaunchCooperativeKernel((const void*)fwd_megakernel, dim3(grid), dim3(NTHR), args, LDS_BYTES, stream);
    if (e != hipSuccess) fprintf(stderr, "kernel_launch: cooperative launch failed: %s (grid %d)\n", hipGetErrorString(e), grid);
#else
    for (int k = 0; k < N_PHASES; ++k) { p.ph_lo = k; p.ph_hi = k + 1; hipLaunchKernelGGL(fwd_megakernel, dim3(grid), dim3(NTHR), LDS_BYTES, stream, p); }
#endif
}
```

```cpp
#include <hip/hip_runtime.h>
#include <hip/hip_cooperative_groups.h>
#include <cstdio>
#include <cstdint>
namespace cg = cooperative_groups;
__device__ __forceinline__ int otid() { int t = threadIdx.x; asm volatile("" : "+v"(t)); return t; }
namespace pg8 {
#define PG8_LAS __attribute__((address_space(3)))
typedef unsigned short bf16_t;
typedef short bf16x8 __attribute__((ext_vector_type(8)));
typedef float f32x4 __attribute__((ext_vector_type(4)));
typedef unsigned u32x4 __attribute__((ext_vector_type(4)));
constexpr int BM = 256, BK = 64, HALF = 128, HTB = HALF * BK * 2  , STAGE_BYTES = 8 * HTB, NXCD = 8, WGM = 8;

__host__ __device__ __forceinline__ int lds_byte(int r, int c) { const int st = (r >> 4) * 2 + (c >> 5), rr = r & 15, cc = c & 31, ob = rr * 64 + cc * 2; return st * 1024 + (ob ^ (((ob >> 9) & 1) << 5)); }
__host__ __device__ __forceinline__ void stage_rc(int b, int& R, int& C) { const int st = b / 1024, sb = b % 1024, swz = sb ^ (((sb >> 9) & 1) << 5); R = (st >> 1) * 16 + swz / 64; C = (st & 1) * 32 + (swz % 64) / 2; }
__host__ __device__ __forceinline__ int perm32(int rho) { const int n = rho >> 4, i = rho & 15; return 8 * (i >> 2) + 4 * n + (i & 3); }

struct Unit { int pm, pn; };
struct Gemm { const bf16_t* A; const bf16_t* Bt; int M, N, K; };

struct StaticOrder {
    int nM, nN, nwg, G, c;
    __host__ __device__ void init(int M, int N, int G_, int c_) { nM = M / BM; nN = N / BM; nwg = nM * nN; G = G_; c = c_; }
    __host__ __device__ bool next(int i, Unit& u) const {
        const long L = (long)i * G + c; if (L >= nwg) return false;
        int wgid = (int)L; { const int q = nwg / NXCD, r = nwg % NXCD, xcd = wgid % NXCD, off = wgid / NXCD; wgid = (xcd < r ? xcd * (q + 1) : r * (q + 1) + (xcd - r) * q) + off; }
        const int nig = WGM * nN, gid = wgid / nig, fm = gid * WGM, gsz = (nM - fm) < WGM ? (nM - fm) : WGM;
        u.pm = fm + ((wgid % nig) % gsz); u.pn = (wgid % nig) / gsz; return true;
    }
    __device__ __forceinline__ void a_ready(const Unit&) const {}
    __device__ __forceinline__ void done(const Unit&) const {}
};

__device__ __forceinline__ unsigned cvt_pk_bf16(float lo, float hi) { unsigned r; asm volatile("v_cvt_pk_bf16_f32 %0, %1, %2" : "=v"(r) : "v"(lo), "v"(hi)); return r; }
struct EpiProj {
    static constexpr bool PERM = true, AFTER_DRAIN = false;
    bf16_t* P; int ldp; float* SM; int nsm; int last_pn; int rope; const float* cosT; const float* sinT;
    __device__ __forceinline__ void operator()(const f32x4 (&acc)[2][2][4][2], const Unit& u, int wr, int wc, int fr, int fq) const {
        const int row0 = u.pm * BM + wr * 64 + fr;
        if (u.pn == last_pn) {
            if (wc == 0) {
#pragma unroll
                for (int ai = 0; ai < 2; ++ai)
#pragma unroll
                    for (int m = 0; m < 4; ++m) { const int row = row0 + ai * HALF + m * 16;
#pragma unroll
                        for (int n = 0; n < 2; ++n) { const int col = 8 * fq + 4 * n; if (col < nsm) *(f32x4*)(SM + (size_t)row * 32 + col) = acc[ai][0][m][n]; } }
            }
            return;
        }
        const bool do_rope_tile = rope && (u.pn == 6 || u.pn == 7 || u.pn == 8) && (u.pm * BM < 32768);
#pragma unroll
        for (int ai = 0; ai < 2; ++ai)
#pragma unroll
            for (int m = 0; m < 4; ++m) { const int row = row0 + ai * HALF + m * 16; bf16_t* rowp = P + (size_t)row * ldp + u.pn * BM + wc * 32 + 8 * fq;
#pragma unroll
                for (int bj = 0; bj < 2; ++bj) { f32x4 v0 = acc[ai][bj][m][0], v1 = acc[ai][bj][m][1];
                    if (do_rope_tile && (u.pn != 8 || bj == 0)) {
                        const int t = row & 4095; const int pos = (wc & 1) ? (t & 63) : (t >> 6); const int i0 = pos * 16 + 8 * (fq & 1);
                        const f32x4 c0 = *(const f32x4*)(cosT + i0), c1 = *(const f32x4*)(cosT + i0 + 4), s0 = *(const f32x4*)(sinT + i0), s1 = *(const f32x4*)(sinT + i0 + 4);
                        f32x4 p0, p1;
#pragma unroll
                        for (int e = 0; e < 4; ++e) { p0[e] = __shfl_xor(v0[e], 32); p1[e] = __shfl_xor(v1[e], 32); }
                        if (fq < 2) { v0 = v0 * c0 - p0 * s0; v1 = v1 * c1 - p1 * s1; } else { v0 = p0 * s0 + v0 * c0; v1 = p1 * s1 + v1 * c1; }
                    }
                    u32x4 w; w.x = cvt_pk_bf16(v0[0], v0[1]); w.y = cvt_pk_bf16(v0[2], v0[3]); w.z = cvt_pk_bf16(v1[0], v1[1]); w.w = cvt_pk_bf16(v1[2], v1[3]);
                    *(u32x4*)(rowp + bj * HALF) = w; } }
    }
};
template <class Epi, class Sched, bool ALIGN_EPI = false, bool SP2 = false>
__device__ __forceinline__ void gemm_phase(PG8_LAS unsigned char* lds, const Gemm g, const Sched& S, const Epi& E) {
    const int tid = otid(), wid = __builtin_amdgcn_readfirstlane(tid >> 6), lane = tid & 63, wr = wid >> 2, wc = wid & 3, fr = lane & 15, fq = lane >> 4;
    const int K = g.K, nt = K / BK;
    unsigned voffA[2], voffB[2];
#pragma unroll
    for (int i = 0; i < 2; ++i) { int R, C; stage_rc(tid * 16 + i * 8192, R, C); const int Rb = Epi::PERM ? ((R & ~31) + perm32(R & 31)) : R;
        voffA[i] = (unsigned)(R * K + C) * 2u; voffB[i] = (unsigned)(Rb * K + C) * 2u; }
    const size_t kstep = (size_t)(BK * 2);
    const size_t hstep = (size_t)HALF * K * 2;
    const size_t tstep = 2 * hstep;
    const unsigned ldsw = (unsigned)wid * 1024u;
    const int aoff = lds_byte(wr * 64 + fr, fq * 8), boff = lds_byte(wc * 32 + fr, fq * 8);
#define PG8_SA(b, h) (((b) * 2 + (h)) * HTB)
#define PG8_SB(b, h) ((4 + (b) * 2 + (h)) * HTB)
#define PG8_STAGE(bufoff, gbase, voff) do { _Pragma("unroll") for (int _i = 0; _i < 2; ++_i) \
        __builtin_amdgcn_global_load_lds((const unsigned*)((const char*)(gbase) + (voff)[_i]), (PG8_LAS unsigned*)(lds + (bufoff) + ldsw + _i * 8192), 16, 0, 0); } while (0)
#define PG8_LDA(dst, b, h) do { _Pragma("unroll") for (int m = 0; m < 4; ++m) _Pragma("unroll") for (int k = 0; k < 2; ++k) dst[m][k] = *(const PG8_LAS bf16x8*)(lds + PG8_SA(b, h) + aoff + m * 2048 + k * 1024); } while (0)
#define PG8_LDB(dst, b, h) do { _Pragma("unroll") for (int n = 0; n < 2; ++n) _Pragma("unroll") for (int k = 0; k < 2; ++k) dst[n][k] = *(const PG8_LAS bf16x8*)(lds + PG8_SB(b, h) + boff + n * 2048 + k * 1024); } while (0)
#define PG8_MMA(ai, bj, At, Bt) do { __builtin_amdgcn_s_setprio(1); _Pragma("unroll") for (int m = 0; m < 4; ++m) _Pragma("unroll") for (int n = 0; n < 2; ++n) _Pragma("unroll") for (int k = 0; k < 2; ++k) \
        acc[ai][bj][m][n] = __builtin_amdgcn_mfma_f32_16x16x32_bf16(Bt[n][k], At[m][k], acc[ai][bj][m][n], 0, 0, 0); __builtin_amdgcn_s_setprio(0); } while (0)
#define PG8_WAIT_V(n) asm volatile("s_waitcnt vmcnt(" #n ")" ::: "memory")
#define PG8_WAIT_L(n) asm volatile("s_waitcnt lgkmcnt(" #n ")" ::: "memory")
#define PG8_BAR __builtin_amdgcn_s_barrier()
#define PG8_SCHED __builtin_amdgcn_sched_barrier(0)
    Unit cur, nxt; int ui = 0;
    if (!S.next(0, cur)) return;
    f32x4 acc[2][2][4][2];
#pragma unroll
    for (int a = 0; a < 2; ++a)
#pragma unroll
        for (int b = 0; b < 2; ++b)
#pragma unroll
            for (int m = 0; m < 4; ++m)
#pragma unroll
                for (int n = 0; n < 2; ++n) acc[a][b][m][n] = (f32x4){0.f, 0.f, 0.f, 0.f};
    bf16x8 At[4][2], B0[2][2], B1[2][2];
    const char* cA = (const char*)g.A + (size_t)cur.pm * tstep; const char* cB = (const char*)g.Bt + (size_t)cur.pn * tstep;
    S.a_ready(cur);
    if constexpr (SP2) {
        PG8_STAGE(PG8_SB(0, 0), cB, voffB); PG8_STAGE(PG8_SB(0, 1), cB + hstep, voffB); PG8_STAGE(PG8_SA(0, 0), cA, voffA); PG8_STAGE(PG8_SA(0, 1), cA + hstep, voffA);
        if (wr == 1) PG8_BAR;
        PG8_WAIT_V(2); PG8_BAR;
        PG8_STAGE(PG8_SB(1, 0), cB + kstep, voffB); PG8_STAGE(PG8_SA(1, 0), cA + kstep, voffA); PG8_STAGE(PG8_SB(1, 1), cB + hstep + kstep, voffB);
        PG8_WAIT_V(6); PG8_BAR;
    } else {
        PG8_STAGE(PG8_SB(0, 0), cB, voffB); PG8_STAGE(PG8_SA(0, 0), cA, voffA); PG8_STAGE(PG8_SB(0, 1), cB + hstep, voffB); PG8_STAGE(PG8_SA(0, 1), cA + hstep, voffA);
        if (wr == 1) PG8_BAR;
        PG8_WAIT_V(4); PG8_BAR;
        PG8_STAGE(PG8_SB(1, 0), cB + kstep, voffB); PG8_STAGE(PG8_SA(1, 0), cA + kstep, voffA); PG8_STAGE(PG8_SB(1, 1), cB + hstep + kstep, voffB);
        PG8_WAIT_V(6); PG8_BAR;
    }
    for (;;) {
        const bool has_next = S.next(ui + 1, nxt);
        const char* nA = has_next ? (const char*)g.A + (size_t)nxt.pm * tstep : cA; const char* nB = has_next ? (const char*)g.Bt + (size_t)nxt.pn * tstep : cB;
        for (int t = 0; t < nt; t += 2) {
            const bool last = (t == nt - 2);
            const char* a1 = cA + (size_t)(t + 1) * kstep;
            const char* a2 = last ? nA : cA + (size_t)(t + 2) * kstep; const char* b2 = last ? nB : cB + (size_t)(t + 2) * kstep;
            const char* a3 = a2 + kstep; const char* b3 = b2 + kstep;
            if (last && has_next) S.a_ready(nxt);
            if constexpr (SP2) {
            PG8_LDB(B0, 0, 0); PG8_LDB(B1, 0, 1); PG8_SCHED; PG8_LDA(At, 0, 0); PG8_STAGE(PG8_SA(1, 1), a1 + hstep, voffA);
            PG8_WAIT_V(8); PG8_WAIT_L(0); PG8_BAR; PG8_MMA(0, 0, At, B0); PG8_MMA(0, 1, At, B1); PG8_BAR; PG8_SCHED;
            PG8_LDA(At, 0, 1); PG8_STAGE(PG8_SB(0, 0), b2, voffB); PG8_STAGE(PG8_SB(0, 1), b2 + hstep, voffB); PG8_STAGE(PG8_SA(0, 0), a2, voffA);
            PG8_WAIT_V(8); PG8_WAIT_L(0); PG8_BAR; PG8_MMA(1, 0, At, B0); PG8_MMA(1, 1, At, B1); PG8_BAR; PG8_SCHED;
            PG8_LDB(B0, 1, 0); PG8_LDB(B1, 1, 1); PG8_SCHED; PG8_LDA(At, 1, 0); PG8_STAGE(PG8_SA(0, 1), a2 + hstep, voffA);
            PG8_WAIT_V(8); PG8_WAIT_L(0); PG8_BAR; PG8_MMA(0, 0, At, B0); PG8_MMA(0, 1, At, B1); PG8_BAR; PG8_SCHED;
            PG8_LDA(At, 1, 1); PG8_STAGE(PG8_SB(1, 0), b3, voffB); PG8_STAGE(PG8_SB(1, 1), b3 + hstep, voffB); PG8_STAGE(PG8_SA(1, 0), a3, voffA);
            PG8_WAIT_V(8); PG8_WAIT_L(0); PG8_BAR; PG8_MMA(1, 0, At, B0); PG8_MMA(1, 1, At, B1); PG8_BAR; PG8_SCHED;
            } else {
            PG8_LDB(B0, 0, 0); PG8_SCHED; PG8_LDA(At, 0, 0); PG8_STAGE(PG8_SA(1, 1), a1 + hstep, voffA);
            PG8_WAIT_L(8); PG8_BAR; PG8_WAIT_L(0); PG8_MMA(0, 0, At, B0); PG8_BAR; PG8_SCHED;
            PG8_LDB(B1, 0, 1); PG8_STAGE(PG8_SB(0, 0), b2, voffB);
            PG8_BAR; PG8_WAIT_L(0); PG8_MMA(0, 1, At, B1); PG8_BAR;
            PG8_LDA(At, 0, 1); PG8_STAGE(PG8_SA(0, 0), a2, voffA);
            PG8_BAR; PG8_WAIT_L(0); PG8_MMA(1, 0, At, B0); PG8_BAR; PG8_SCHED;
            PG8_STAGE(PG8_SB(0, 1), b2 + hstep, voffB);
            PG8_WAIT_V(6); PG8_BAR; PG8_MMA(1, 1, At, B1); PG8_BAR;
            PG8_LDB(B0, 1, 0); PG8_SCHED; PG8_LDA(At, 1, 0); PG8_STAGE(PG8_SA(0, 1), a2 + hstep, voffA);
            PG8_WAIT_L(8); PG8_BAR; PG8_WAIT_L(0); PG8_MMA(0, 0, At, B0); PG8_BAR; PG8_SCHED;
            PG8_LDB(B1, 1, 1); PG8_STAGE(PG8_SB(1, 0), b3, voffB);
            PG8_BAR; PG8_WAIT_L(0); PG8_MMA(0, 1, At, B1); PG8_BAR;
            PG8_LDA(At, 1, 1); PG8_STAGE(PG8_SA(1, 0), a3, voffA);
            PG8_BAR; PG8_WAIT_L(0); PG8_MMA(1, 0, At, B0); PG8_BAR; PG8_SCHED;
            PG8_STAGE(PG8_SB(1, 1), b3 + hstep, voffB);
            PG8_WAIT_V(6); PG8_BAR; PG8_MMA(1, 1, At, B1); PG8_BAR;
            }
        }
        if constexpr (ALIGN_EPI) { if (wr == 0) PG8_BAR; }
        if constexpr (!Epi::AFTER_DRAIN) { E(acc, cur, wr, wc, fr, fq); S.done(cur); }
        if (!has_next) break;
#pragma unroll
        for (int a = 0; a < 2; ++a)
#pragma unroll
            for (int b = 0; b < 2; ++b)
#pragma unroll
                for (int m = 0; m < 4; ++m)
#pragma unroll
                    for (int n = 0; n < 2; ++n) acc[a][b][m][n] = (f32x4){0.f, 0.f, 0.f, 0.f};
        cur = nxt; cA = nA; cB = nB; ++ui;
        if constexpr (ALIGN_EPI) { if (wr == 1) PG8_BAR; }
    }
    PG8_WAIT_V(0);
    if constexpr (!ALIGN_EPI) { if (wr == 0) PG8_BAR; }
    PG8_BAR;
    if constexpr (Epi::AFTER_DRAIN) { E.fused(acc, cur, wr, wc, fr, fq, lds, wid, lane); S.done(cur); }
#undef PG8_SA
#undef PG8_SB
#undef PG8_STAGE
#undef PG8_LDA
#undef PG8_LDB
#undef PG8_MMA
#undef PG8_WAIT_V
#undef PG8_WAIT_L
#undef PG8_BAR
#undef PG8_SCHED
}
}
constexpr int NWAVES = 8, NTHR = 512;
constexpr int BATCH = 8, SEQ = 4096, DM = 1024, CTXL = 256, DEPTH = 4;
constexpr int MLAT = BATCH * SEQ, MCTX = BATCH * CTXL, MTOT = MLAT + MCTX;
constexpr int NP_EVEN = 3584, NPAD_EVEN = 3840, NORIG_EVEN = 3616;
constexpr int NP_ODD = 2816, NPAD_ODD = 3072, NORIG_ODD = 2832;
constexpr int NCHUNK = 68;
constexpr int NSLOT = BATCH * 4 * 2 * NCHUNK;
constexpr float ALPHA_DN = 1.681792830507429f;
constexpr size_t MiB = 1u << 20;
constexpr size_t WS_MOD = 0;
constexpr size_t WS_BAR = 512 * 1024;
constexpr size_t WS_ROPE = 1 * MiB;
constexpr size_t WS_SC = WS_ROPE + 65536;
constexpr size_t WS_GAM = 2 * MiB;
constexpr size_t WS_SM = 4 * MiB;
constexpr size_t WS_WIE = 9 * MiB;
constexpr size_t WS_WIO = 24 * MiB;
constexpr size_t WS_WO = 36 * MiB;
constexpr size_t WS_XC = 44 * MiB;
constexpr size_t WS_H = 52 * MiB;
constexpr size_t WS_P = 120 * MiB;
constexpr size_t WS_S = 359 * MiB;
constexpr size_t WS_X16 = 427 * MiB;
constexpr size_t WS_END = WS_X16 + (size_t)MTOT * 1024 * 2;
static_assert(WS_S + (size_t)NSLOT * 8192 * 2 <= WS_X16, "ws map 4");
static_assert(WS_SC + (size_t)NSLOT * 16 <= WS_GAM && WS_GAM + (size_t)NSLOT * 256 <= WS_SM && WS_SM + (size_t)MTOT * 128 <= WS_WIE, "ws map 1");
static_assert(WS_WIE + (size_t)2 * NPAD_EVEN * 1024 * 2 <= WS_WIO && WS_WIO + (size_t)2 * NPAD_ODD * 1024 * 2 <= WS_WO && WS_WO + (size_t)4 * 1024 * 1024 * 2 <= WS_XC, "ws map 2");
static_assert(WS_XC + (size_t)MCTX * 1024 * 4 <= WS_H && WS_H + (size_t)MTOT * 1024 * 2 <= WS_P && WS_P + (size_t)MTOT * NP_EVEN * 2 <= WS_S && WS_END <= 512 * MiB, "ws map 3");
constexpr int LDS_BYTES = 147456;

#define LAS __attribute__((address_space(3)))
typedef unsigned short bf16;
typedef float f32x4 __attribute__((ext_vector_type(4)));
typedef short bf16x8 __attribute__((ext_vector_type(8)));
typedef short s16x4 __attribute__((ext_vector_type(4)));
typedef unsigned u32x4 __attribute__((ext_vector_type(4)));
typedef unsigned u32x2 __attribute__((ext_vector_type(2)));
#define LDS_WAIT() asm volatile("s_waitcnt lgkmcnt(0)" ::: "memory")

typedef __bf16 hbf2 __attribute__((ext_vector_type(2)));
typedef float f32x2_ __attribute__((ext_vector_type(2)));
__device__ __forceinline__ unsigned f2bf(float f) { const __bf16 b = (__bf16)f; return (unsigned)__builtin_bit_cast(unsigned short, b); }
__device__ __forceinline__ unsigned pk2(float lo, float hi) { const f32x2_ v = {lo, hi}; const hbf2 b = __builtin_convertvector(v, hbf2); return __builtin_bit_cast(unsigned, b); }
__device__ __forceinline__ float bf2f(unsigned short v) { return __builtin_bit_cast(float, (unsigned)v << 16); }
__device__ __forceinline__ float bflo(unsigned w) { return __builtin_bit_cast(float, w << 16); }
__device__ __forceinline__ float bfhi(unsigned w) { return __builtin_bit_cast(float, w & 0xffff0000u); }
__device__ __forceinline__ float siluf(float x) { return x * __builtin_amdgcn_rcpf(1.f + __expf(-x)); }
__device__ __forceinline__ float logsigf(float z) { return fminf(z, 0.f) - 0.69314718056f * __builtin_amdgcn_logf(1.f + __builtin_amdgcn_exp2f(-1.44269504089f * fabsf(z))); }
__device__ __forceinline__ float rdlane(float v, int l) { return __builtin_bit_cast(float, __builtin_amdgcn_readlane(__builtin_bit_cast(int, v), l)); }
template <int N> __device__ __forceinline__ float dpp_ror(float v) { return __builtin_bit_cast(float, __builtin_amdgcn_update_dpp(0, __builtin_bit_cast(int, v), 0x120 + N, 0xf, 0xf, false)); }
__device__ __forceinline__ float red16_max(float v) { v = fmaxf(v, dpp_ror<1>(v)); v = fmaxf(v, dpp_ror<2>(v)); v = fmaxf(v, dpp_ror<4>(v)); v = fmaxf(v, dpp_ror<8>(v)); return v; }
__device__ __forceinline__ float red16_sum(float v) { v += dpp_ror<1>(v); v += dpp_ror<2>(v); v += dpp_ror<4>(v); v += dpp_ror<8>(v); return v; }
__device__ __forceinline__ float wave_sum(float v) { v = red16_sum(v); return (rdlane(v, 0) + rdlane(v, 16)) + (rdlane(v, 32) + rdlane(v, 48)); }
__device__ __forceinline__ float wave_max(float v) { v = red16_max(v); return fmaxf(fmaxf(rdlane(v, 0), rdlane(v, 16)), fmaxf(rdlane(v, 32), rdlane(v, 48))); }
template <int N, bool REV> __device__ __forceinline__ float dpp_rshift(float v, float ident) {
    return __builtin_bit_cast(float, __builtin_amdgcn_update_dpp(__builtin_bit_cast(int, ident), __builtin_bit_cast(int, v), (REV ? 0x100 : 0x110) + N, 0xf, 0xf, false));
}
template <bool REV> __device__ __forceinline__ float wave_scan_sum_t(float v, int lane) {
    v += dpp_rshift<1, REV>(v, 0.f); v += dpp_rshift<2, REV>(v, 0.f); v += dpp_rshift<4, REV>(v, 0.f); v += dpp_rshift<8, REV>(v, 0.f);
    const int row = lane >> 4;
    if (!REV) { const float t0 = rdlane(v, 15), t1 = rdlane(v, 31), t2 = rdlane(v, 47);
        v += row == 1 ? t0 : row == 2 ? t0 + t1 : row == 3 ? t0 + t1 + t2 : 0.f; }
    else { const float t1 = rdlane(v, 16), t2 = rdlane(v, 32), t3 = rdlane(v, 48);
        v += row == 2 ? t3 : row == 1 ? t3 + t2 : row == 0 ? t3 + t2 + t1 : 0.f; }
    return v;
}
template <bool REV> __device__ __forceinline__ float wave_scan_max_t(float v, int lane) {
    v = fmaxf(v, dpp_rshift<1, REV>(v, -3e38f)); v = fmaxf(v, dpp_rshift<2, REV>(v, -3e38f)); v = fmaxf(v, dpp_rshift<4, REV>(v, -3e38f)); v = fmaxf(v, dpp_rshift<8, REV>(v, -3e38f));
    const int row = lane >> 4;
    if (!REV) { const float t0 = rdlane(v, 15), t1 = rdlane(v, 31), t2 = rdlane(v, 47);
        v = fmaxf(v, row == 1 ? t0 : row == 2 ? fmaxf(t0, t1) : row == 3 ? fmaxf(fmaxf(t0, t1), t2) : -3e38f); }
    else { const float t1 = rdlane(v, 16), t2 = rdlane(v, 32), t3 = rdlane(v, 48);
        v = fmaxf(v, row == 2 ? t3 : row == 1 ? fmaxf(t3, t2) : row == 0 ? fmaxf(fmaxf(t3, t2), t1) : -3e38f); }
    return v;
}
template <int N, bool REV> __device__ __forceinline__ float dpp_rshift0(float v) {
    return __builtin_bit_cast(float, __builtin_amdgcn_update_dpp(0, __builtin_bit_cast(int, v), (REV ? 0x100 : 0x110) + N, 0xf, 0xf, true));
}
template <int N, bool REV, bool MAX> __device__ __forceinline__ float scan_step(float v, int li) {
    const float t = dpp_rshift0<N, REV>(v); const bool ok = REV ? (li + N < 16) : (li >= N);
    return MAX ? (ok ? fmaxf(v, t) : v) : (ok ? v + t : v);
}
template <bool REV, bool MAX> __device__ __forceinline__ float wave_scan_t(float v, int lane) {
    const int li = lane & 15, row = lane >> 4;
    v = scan_step<1, REV, MAX>(v, li); v = scan_step<2, REV, MAX>(v, li); v = scan_step<4, REV, MAX>(v, li); v = scan_step<8, REV, MAX>(v, li);
    const float a0 = rdlane(v, REV ? 48 : 15), a1 = rdlane(v, REV ? 32 : 31), a2 = rdlane(v, REV ? 16 : 47);
    const int k = REV ? 3 - row : row;
    if (MAX) { float e = v; if (k >= 1) e = fmaxf(e, a0); if (k >= 2) e = fmaxf(e, a1); if (k >= 3) e = fmaxf(e, a2); return e; }
    float e = v; if (k >= 1) e += a0; if (k >= 2) e += a1; if (k >= 3) e += a2; return e;
}
__device__ __forceinline__ float wave_scan_sum(float v, int lane, bool rev) { return rev ? wave_scan_t<true, false>(v, lane) : wave_scan_t<false, false>(v, lane); }
__device__ __forceinline__ float wave_scan_max(float v, int lane, bool rev) { return rev ? wave_scan_t<true, true>(v, lane) : wave_scan_t<false, true>(v, lane); }
#define MFMA(a, b, c) __builtin_amdgcn_mfma_f32_16x16x32_bf16((a), (b), (c), 0, 0, 0)
__device__ __forceinline__ bf16x8 frag_rm(const LAS bf16* X, int ld, int row0, int k0, int lane) {
    return *(const LAS bf16x8*)(X + (row0 + (lane & 15)) * ld + k0 + 8 * (lane >> 4));
}
__device__ __forceinline__ bf16x8 frag_tr(const LAS bf16* X, int ld, int k0, int n0, int lane) {
    const int g = lane >> 4, m = lane & 15, q = m >> 2, p = m & 3;
    const LAS bf16* a0 = X + (k0 + 8 * g + q) * ld + n0 + 4 * p;
    const s16x4 lo = __builtin_amdgcn_ds_read_tr16_b64_v4i16((LAS s16x4*)a0);
    const s16x4 hi = __builtin_amdgcn_ds_read_tr16_b64_v4i16((LAS s16x4*)(a0 + 4 * ld));
    bf16x8 r; r[0] = lo[0]; r[1] = lo[1]; r[2] = lo[2]; r[3] = lo[3]; r[4] = hi[0]; r[5] = hi[1]; r[6] = hi[2]; r[7] = hi[3]; return r;
}

struct Params {
    const float *x, *c, *ctx, *c_ctx, *w_ada, *b_ada, *ln_g, *ln_b, *w_in_even, *w_out_even, *gla_gate_w, *gla_gate_b, *gla_norm_g, *na_rpb, *w_in_odd, *w_out_odd, *ml_gate_b, *ml_norm_g, *sw_sink;
    float* out; unsigned char* ws; long long ph_lo, ph_hi;
};
typedef const __attribute__((address_space(4))) Params* KP;
__device__ __forceinline__ KP kparams() { unsigned long long v = (unsigned long long)__builtin_amdgcn_kernarg_segment_ptr(); asm volatile("" : "+s"(v)); return (KP)v; }

__device__ __forceinline__ int orig_col(int type, int n) {
    if (type == 0) { if (n < 1536) return n; if (n < 3584) return n + 32; if (n < 3616) return n - 3584 + 1536; return -1; }
    if (type == 1) { if (n < 1536) return n; if (n < 2816) return n + 16; if (n < 2832) return n - 2816 + 1536; return -1; }
    return n;
}
__device__ __forceinline__ float col_scale(int type, int n) {
    if (type == 0) return (n < 256 || (n >= 1536 && n < 2048)) ? 0.125f : 1.f;
    if (type == 1) return ((n >= 256 && n < 512) || (n >= 1536 && n < 2048)) ? 0.125f : 1.f;
    return 1.f;
}
__device__ __forceinline__ void p0_transpose_item(const float* __restrict__ W, int K, int Norig, int type, bf16* __restrict__ WT, LAS float* scr, int nblk, int item, int lane) {
    const int kb = item / nblk, nb = item % nblk, k0 = 64 * kb, n0 = 32 * nb;
    const int oc = orig_col(type, n0 + (lane & 31)); const float sc = col_scale(type, n0 + (lane & 31));
#pragma unroll 8
    for (int i = 0; i < 32; ++i) { const int kk = 2 * i + (lane >> 5); scr[kk * 33 + (lane & 31)] = oc >= 0 ? W[(size_t)(k0 + kk) * Norig + oc] * sc : 0.f; }
    LDS_WAIT();
    const int c = lane & 7;
#pragma unroll
    for (int j = 0; j < 4; ++j) { const int n = (lane >> 3) + 8 * j; const LAS float* s = scr + (8 * c) * 33 + n;
        u32x4 o; o.x = pk2(s[0 * 33], s[1 * 33]); o.y = pk2(s[2 * 33], s[3 * 33]); o.z = pk2(s[4 * 33], s[5 * 33]); o.w = pk2(s[6 * 33], s[7 * 33]);
        *(u32x4*)(WT + (size_t)(n0 + n) * K + k0 + 8 * c) = o; }
    LDS_WAIT();
}
__device__ __forceinline__ void phase_prologue(KP p, LAS unsigned char* lds) {
    const int tid = otid(), lane = tid & 63, wave = tid >> 6;
    unsigned char* ws = p->ws;
    float* MOD = (float*)(ws + WS_MOD);
    if ((int)blockIdx.x < 192) {
        LAS float* cond = (LAS float*)lds;
        LAS float* red = (LAS float*)(lds + 36864);
        for (int e = tid; e < 9 * 1024; e += NTHR) { const int j = e >> 10, k = e & 1023; const float v = j < 8 ? p->c[j * 1024 + k] : p->c_ctx[k]; cond[e] = siluf(v); }
        __syncthreads();
        for (int it = blockIdx.x; it < 192; it += gridDim.x) {
            const int l = it / 48, n0 = (it % 48) * 64, cq = tid & 15, ks = tid >> 4;
            float acc[9][4];
#pragma unroll
            for (int j = 0; j < 9; ++j) { acc[j][0] = 0.f; acc[j][1] = 0.f; acc[j][2] = 0.f; acc[j][3] = 0.f; }
            const float* wp = p->w_ada + (size_t)l * 1024 * 3072 + (size_t)(ks * 32) * 3072 + n0 + 4 * cq;
#pragma unroll 4
            for (int kk = 0; kk < 32; ++kk) { const f32x4 w = *(const f32x4*)(wp + (size_t)kk * 3072);
#pragma unroll
                for (int j = 0; j < 9; ++j) { const float cv = cond[j * 1024 + ks * 32 + kk]; acc[j][0] += cv * w[0]; acc[j][1] += cv * w[1]; acc[j][2] += cv * w[2]; acc[j][3] += cv * w[3]; } }
#pragma unroll
            for (int j = 0; j < 9; ++j)
#pragma unroll
                for (int i = 0; i < 4; ++i) red[ks * 576 + j * 64 + 4 * cq + i] = acc[j][i];
            __syncthreads();
            for (int o = tid; o < 576; o += NTHR) { float s = 0.f; for (int q = 0; q < 32; ++q) s += red[q * 576 + o]; const int j = o >> 6, n = n0 + (o & 63);
                MOD[(size_t)(l * 9 + j) * 3072 + n] = s + p->b_ada[l * 3072 + n]; }
            __syncthreads();
        }
    }
    if (blockIdx.x == gridDim.x - 1) {
        float* cosT = (float*)(ws + WS_ROPE); float* sinT = cosT + 1024;
        for (int e = tid; e < 1024; e += NTHR) { const int pos = e >> 4, i = e & 15;
            double f = 1.0; for (int q = 0; q < i; ++q) f *= 0.5623413251903491;
            const double f2 = f * f; double sn = 1.0, cs = 1.0;
            for (int q = 12; q >= 1; --q) { sn = 1.0 - f2 / ((2.0 * q) * (2.0 * q + 1.0)) * sn; cs = 1.0 - f2 / ((2.0 * q - 1.0) * (2.0 * q)) * cs; }
            sn *= f;
            double c = 1.0, s = 0.0; for (int q = 0; q < pos; ++q) { const double c2 = c * cs - s * sn, s2 = s * cs + c * sn; c = c2; s = s2; }
            cosT[e] = (float)c; sinT[e] = (float)s; }
    }
    __syncthreads();
    {
        LAS float* scr = (LAS float*)(lds + wave * 16384);
        const int gw = blockIdx.x * NWAVES + wave, NGW = gridDim.x * NWAVES;
        constexpr int I_E = 16 * (NPAD_EVEN / 32), I_O = 16 * (NPAD_ODD / 32), I_W = 16 * 32;
        constexpr int NIT = 2 * I_E + 2 * I_O + 4 * I_W;
        for (int it = gw; it < NIT; it += NGW) {
            int r = it;
            if (r < 2 * I_E) { const int i = r / I_E; r -= i * I_E; p0_transpose_item(p->w_in_even + (size_t)i * 1024 * NORIG_EVEN, 1024, NORIG_EVEN, 0, (bf16*)(ws + WS_WIE) + (size_t)i * NPAD_EVEN * 1024, scr, NPAD_EVEN / 32, r, lane); continue; }
            r -= 2 * I_E;
            if (r < 2 * I_O) { const int i = r / I_O; r -= i * I_O; p0_transpose_item(p->w_in_odd + (size_t)i * 1024 * NORIG_ODD, 1024, NORIG_ODD, 1, (bf16*)(ws + WS_WIO) + (size_t)i * NPAD_ODD * 1024, scr, NPAD_ODD / 32, r, lane); continue; }
            r -= 2 * I_O;
            { const int l = r / I_W; r -= l * I_W; const float* W = (l & 1) ? p->w_out_odd + (size_t)(l >> 1) * 1024 * 1024 : p->w_out_even + (size_t)(l >> 1) * 1024 * 1024;
              p0_transpose_item(W, 1024, 1024, 2, (bf16*)(ws + WS_WO) + (size_t)l * 1024 * 1024, scr, 32, r, lane); }
        }
    }
}
typedef float f32x8h __attribute__((ext_vector_type(8)));
__device__ __forceinline__ void phase_h0(KP p) {
    const int lane = otid() & 63, gw = blockIdx.x * NWAVES + (otid() >> 6), NGW = gridDim.x * NWAVES;
    const float* MOD = (const float*)(p->ws + WS_MOD); bf16* H = (bf16*)(p->ws + WS_H);
    for (int m = gw; m < MTOT; m += NGW) {
        const int jb = m < MLAT ? (m >> 12) : 8;
        const float* src = m < MLAT ? p->x + (size_t)m * DM : p->ctx + (size_t)(m - MLAT) * DM;
        const float* md = MOD + (size_t)jb * 3072;
#pragma unroll
        for (int j = 0; j < 2; ++j) { const int k = 8 * lane + 512 * j; const f32x8h v = *(const f32x8h*)(src + k), sh = *(const f32x8h*)(md + k), sc = *(const f32x8h*)(md + 1024 + k);
            const f32x8h h = v * (sc + 1.0f) + sh; u32x4 o; o.x = pk2(h[0], h[1]); o.y = pk2(h[2], h[3]); o.z = pk2(h[4], h[5]); o.w = pk2(h[6], h[7]); *(u32x4*)(H + (size_t)m * DM + k) = o; }
    }
}
typedef _Float16 f16x8 __attribute__((ext_vector_type(8)));
typedef float f32x8 __attribute__((ext_vector_type(8)));
struct LnRaw { f32x8 xf[2][2]; f16x8 xh[2][2]; u32x4 y[2][2]; };
__device__ __forceinline__ void ln_load(LnRaw& R, int l, int m0, int lane, const float* xin, const float* cin, const _Float16* X16, const bf16* Y) {
#pragma unroll
    for (int j = 0; j < 2; ++j) { const int k = 8 * lane + 512 * j;
#pragma unroll
        for (int q = 0; q < 2; ++q) { const int m = m0 + q;
            if (l == 0) R.xf[q][j] = *(const f32x8*)((m < MLAT ? xin + (size_t)m * DM : cin + (size_t)(m - MLAT) * DM) + k);
            else R.xh[q][j] = *(const f16x8*)(X16 + (size_t)m * DM + k);
            R.y[q][j] = *(const u32x4*)(Y + (size_t)m * DM + k); } }
}
__device__ __forceinline__ float sum8(const f32x8 v) { return ((v[0] + v[1]) + (v[2] + v[3])) + ((v[4] + v[5]) + (v[6] + v[7])); }
__device__ __forceinline__ u32x4 pack8(const f32x8 h) { u32x4 w; w.x = pk2(h[0], h[1]); w.y = pk2(h[2], h[3]); w.z = pk2(h[4], h[5]); w.w = pk2(h[6], h[7]); return w; }
__device__ __forceinline__ void phase_ln(KP p, int l, bool dummy = false) {
    const int lane = otid() & 63, gw = blockIdx.x * NWAVES + (otid() >> 6), NGW = gridDim.x * NWAVES;
    const float* MOD = (const float*)(p->ws + WS_MOD); bf16* H = (bf16*)(p->ws + WS_H); const bf16* Y = (const bf16*)(p->ws + WS_P); _Float16* X16 = (_Float16*)(p->ws + WS_X16);
    const int mrows = l < DEPTH - 1 ? MTOT : MLAT;
    const float* lg = p->ln_g + l * DM; const float* lb = p->ln_b + l * DM;
    const float* xin = p->x; const float* cin = p->ctx; float* outp = p->out;
    LnRaw R;
    if (2 * gw < mrows) ln_load(R, l, 2 * gw, lane, xin, cin, X16, Y);
    for (int m0 = 2 * gw; m0 < mrows; m0 += 2 * NGW) {
        const int jb = m0 < MLAT ? (m0 >> 12) : 8;
        const float* md = MOD + (size_t)(l * 9 + jb) * 3072;
        f32x8 v[2][2], xs[2][2]; float s[2] = {0.f, 0.f};
#pragma unroll
        for (int j = 0; j < 2; ++j) { const int k = 8 * lane + 512 * j; const f32x8 g = *(const f32x8*)(md + 2048 + k);
#pragma unroll
            for (int q = 0; q < 2; ++q) { const f32x8 xv = l == 0 ? R.xf[q][j] : __builtin_convertvector(R.xh[q][j], f32x8); const u32x4 yw = R.y[q][j];
                f32x8 y; y[0] = bflo(yw.x); y[1] = bfhi(yw.x); y[2] = bflo(yw.y); y[3] = bfhi(yw.y); y[4] = bflo(yw.z); y[5] = bfhi(yw.z); y[6] = bflo(yw.w); y[7] = bfhi(yw.w);
                xs[q][j] = xv; v[q][j] = xv * ALPHA_DN + g * y; s[q] += sum8(v[q][j]); } }
        if (m0 + 2 * NGW < mrows) ln_load(R, l, m0 + 2 * NGW, lane, xin, cin, X16, Y);
        float rstd[2];
#pragma unroll
        for (int q = 0; q < 2; ++q) { const float mean = wave_sum(s[q]) * (1.f / DM); float s2 = 0.f;
#pragma unroll
            for (int j = 0; j < 2; ++j) { v[q][j] = v[q][j] - mean; s2 += sum8(v[q][j] * v[q][j]); }
            rstd[q] = 1.f / sqrtf(wave_sum(s2) * (1.f / DM) + 1e-5f); }
        const float* md2 = MOD + (size_t)((l + 1) * 9 + jb) * 3072;
#pragma unroll
        for (int j = 0; j < 2; ++j) { const int k = 8 * lane + 512 * j; const f32x8 gg = *(const f32x8*)(lg + k), bb = *(const f32x8*)(lb + k);
            f32x8 sh = gg * 0.f, sc = sh; if (l < DEPTH - 1) { sh = *(const f32x8*)(md2 + k); sc = *(const f32x8*)(md2 + 1024 + k); }
#pragma unroll
            for (int q = 0; q < 2; ++q) { const int m = m0 + q; const f32x8 o = v[q][j] * rstd[q] * gg + bb;
                if (l < DEPTH - 1) { *(f16x8*)(X16 + (size_t)m * DM + k) = __builtin_convertvector(dummy ? xs[q][j] : o, f16x8);
                    *(u32x4*)(H + (size_t)m * DM + k) = pack8(o * (sc + 1.0f) + sh); }
                else { if (!dummy) *(f32x8*)(outp + (size_t)m * DM + k) = o; } } }
    }
}
constexpr int AT_KS = 0, AT_VS = 9216, AT_BUF = 18432, AT_PS = 36864, AT_RPB = AT_PS + 8 * 2304;
__device__ __forceinline__ bf16x8 frag_tr_perm(const LAS bf16* X, int ld, int k0, int n0, int lane) {
    const int g = lane >> 4, m = lane & 15, q = m >> 2, p = m & 3;
    const LAS bf16* a0 = X + (k0 + 4 * g + q) * ld + n0 + 4 * p;
    const s16x4 lo = __builtin_amdgcn_ds_read_tr16_b64_v4i16((LAS s16x4*)a0);
    const s16x4 hi = __builtin_amdgcn_ds_read_tr16_b64_v4i16((LAS s16x4*)(a0 + 16 * ld));
    bf16x8 r; r[0] = lo[0]; r[1] = lo[1]; r[2] = lo[2]; r[3] = lo[3]; r[4] = hi[0]; r[5] = hi[1]; r[6] = hi[2]; r[7] = hi[3]; return r;
}
__device__ __forceinline__ void attn_tile(const LAS bf16* Ks, const LAS bf16* Vs, const LAS float* rpb, const bf16x8 (&qa)[2][2], float (&mrow)[2], float (&lsum)[2], f32x4 (&oacc)[2][4],
                                          int mode, int i, int nlat, int qa_, int qb_, int ka_, int lane) {
    const int fq = lane >> 4, fr = lane & 15;
    const bool islat = i < nlat;
    bool active = true; int kt0 = 0;
    if (islat) {
        if (mode == 0) { kt0 = ka_ + i; const int rs = min(max(qa_ - 4, 0), 56); active = (kt0 >= rs) && (kt0 < rs + 8); }
        else { kt0 = ka_ + 64 * i; active = !(kt0 > qa_ + 31 + 128 || kt0 + 63 < qa_ - 128); }
    }
    if (!active) return;
    const bool nar = islat && mode == 0;
    const int ct0 = qb_ >> 4;
    int ntlo[2], nthi[2];
#pragma unroll
    for (int nq = 0; nq < 2; ++nq) { const int ct = ct0 + nq; ntlo[nq] = nar ? (ct < 2 ? 0 : ct - 1) : 0; nthi[nq] = nar ? (ct > 1 ? 3 : ct + 1) : 3; }
    const int ulo = min(ntlo[0], ntlo[1]), uhi = max(nthi[0], nthi[1]);
    f32x4 s[2][4];
#pragma unroll
    for (int mt = 0; mt < 4; ++mt) { s[0][mt] = (f32x4){0.f, 0.f, 0.f, 0.f}; s[1][mt] = (f32x4){0.f, 0.f, 0.f, 0.f};
        if (mt >= ulo && mt <= uhi) {
#pragma unroll
            for (int ks = 0; ks < 2; ++ks) { const bf16x8 kf = frag_rm(Ks, 72, 16 * mt, 32 * ks, lane);
                if (mt >= ntlo[0] && mt <= nthi[0]) s[0][mt] = MFMA(kf, qa[0][ks], s[0][mt]);
                if (mt >= ntlo[1] && mt <= nthi[1]) s[1][mt] = MFMA(kf, qa[1][ks], s[1][mt]); } } }
    unsigned pw[2][8];
    const bool swa_mask = islat && mode == 1 && !((qa_ + 31 - kt0 <= 128) && (qa_ - kt0 - 63 >= -128));
    constexpr float L2E = 1.44269504089f;
#pragma unroll
    for (int nq = 0; nq < 2; ++nq) {
        float tmax = -3e38f;
        if (nar) {
            const int qc = qb_ + 16 * nq + fr, cs = min(max(qc - 8, 0), 48);
            const unsigned long long ml = (0xFFFFull << cs) >> (4 * fq);
            const unsigned mlo = (unsigned)ml, mhi = (unsigned)(ml >> 32);
            const LAS float* bp = rpb + (kt0 - qa_ + 7) * 31 + (4 * fq - qc + 15);
#pragma unroll
            for (int mt = 0; mt < 4; ++mt) { if (mt >= ntlo[nq] && mt <= nthi[nq]) {
#pragma unroll
                for (int r = 0; r < 4; ++r) { const int pbit = 16 * mt + r; const bool ok = ((pbit < 32 ? mlo >> pbit : mhi >> (pbit - 32)) & 1u) != 0u;
                    const float v = ok ? s[nq][mt][r] + bp[ok ? pbit : 0] : -3e38f; s[nq][mt][r] = v; tmax = fmaxf(tmax, v); } } }
        } else if (swa_mask) {
            const int d0 = (qa_ + 16 * nq + fr) - (kt0 + 4 * fq);
#pragma unroll
            for (int mt = 0; mt < 4; ++mt)
#pragma unroll
                for (int r = 0; r < 4; ++r) { const int d = d0 - (16 * mt + r); const float v = (d <= 128 && d >= -128) ? s[nq][mt][r] : -3e38f; s[nq][mt][r] = v; tmax = fmaxf(tmax, v); }
        } else {
#pragma unroll
            for (int mt = 0; mt < 4; ++mt)
#pragma unroll
                for (int r = 0; r < 4; ++r) tmax = fmaxf(tmax, s[nq][mt][r]);
        }
        tmax = fmaxf(tmax, __shfl_xor(tmax, 16)); tmax = fmaxf(tmax, __shfl_xor(tmax, 32));
        const float mnew = fmaxf(mrow[nq], tmax); const float alpha = __builtin_amdgcn_exp2f((mrow[nq] - mnew) * L2E); mrow[nq] = mnew;
        const float nm = -mnew * L2E;
        float ps = 0.f;
#pragma unroll
        for (int mt = 0; mt < 4; ++mt) { float p0 = 0.f, p1 = 0.f, p2 = 0.f, p3 = 0.f;
            if (mt >= ntlo[nq] && mt <= nthi[nq]) { p0 = __builtin_amdgcn_exp2f(__builtin_fmaf(s[nq][mt][0], L2E, nm)); p1 = __builtin_amdgcn_exp2f(__builtin_fmaf(s[nq][mt][1], L2E, nm));
                p2 = __builtin_amdgcn_exp2f(__builtin_fmaf(s[nq][mt][2], L2E, nm)); p3 = __builtin_amdgcn_exp2f(__builtin_fmaf(s[nq][mt][3], L2E, nm)); ps += (p0 + p1) + (p2 + p3); }
            pw[nq][2 * mt] = pk2(p0, p1); pw[nq][2 * mt + 1] = pk2(p2, p3); oacc[nq][mt] = oacc[nq][mt] * alpha; }
        lsum[nq] = lsum[nq] * alpha + ps;
    }
#pragma unroll
    for (int ks = 0; ks < 2; ++ks) { if (ks == 0 ? (ulo < 2) : (uhi > 1)) {
        const u32x4 pu0 = (u32x4){pw[0][4 * ks], pw[0][4 * ks + 1], pw[0][4 * ks + 2], pw[0][4 * ks + 3]}, pu1 = (u32x4){pw[1][4 * ks], pw[1][4 * ks + 1], pw[1][4 * ks + 2], pw[1][4 * ks + 3]};
        const bf16x8 pb0 = __builtin_bit_cast(bf16x8, pu0), pb1 = __builtin_bit_cast(bf16x8, pu1);
#pragma unroll
        for (int mt = 0; mt < 4; ++mt) { const bf16x8 vf = frag_tr_perm(Vs, 72, 32 * ks, 16 * mt, lane); oacc[0][mt] = MFMA(vf, pb0, oacc[0][mt]); oacc[1][mt] = MFMA(vf, pb1, oacc[1][mt]); } } }
}
constexpr int AT_PSW = 32 * 72 * 2;
constexpr int AT_RPB2 = AT_PS + 8 * AT_PSW;
__device__ __forceinline__ void attn_item(LAS unsigned char* lds, const bf16* __restrict__ P, int ldp, bf16* __restrict__ Z, int mode,
                                          int qrow0, int qcol, int kcol, int vcol, int gcol, int zcol,
                                          int nlat, int lat_row0, int ctx_row0, int qa_, int qb_, int ka_, const float* __restrict__ rpb_g, float sink) {
    const int tid = otid(), lane = tid & 63, wave = tid >> 6, fq = lane >> 4, fr = lane & 15;
    LAS bf16* Ks0 = (LAS bf16*)(lds + AT_KS); LAS bf16* Vs0 = (LAS bf16*)(lds + AT_VS); LAS bf16* Ks1 = (LAS bf16*)(lds + AT_KS + AT_BUF); LAS bf16* Vs1 = (LAS bf16*)(lds + AT_VS + AT_BUF);
    LAS bf16* Ps = (LAS bf16*)(lds + AT_PS + wave * AT_PSW); LAS float* rpb = (LAS float*)(lds + AT_RPB2);
    const int ntile = nlat + 4, srow = tid >> 3, sch = tid & 7, soff = srow * 72 + 8 * sch;
#define AT_ROWB(j) (((j) < nlat) ? lat_row0 + 64 * (j) : ctx_row0 + 64 * ((j) - nlat))
#define AT_LOAD(kr, vr, j) do { const size_t ro_ = (size_t)(AT_ROWB(j) + srow) * ldp + 8 * sch; kr = *(const u32x4*)(P + ro_ + kcol); vr = *(const u32x4*)(P + ro_ + vcol); } while (0)
    u32x4 k0, v0, k1, v1;
    AT_LOAD(k0, v0, 0);
    bf16x8 qa[2][2];
#pragma unroll
    for (int nq = 0; nq < 2; ++nq)
#pragma unroll
        for (int ks = 0; ks < 2; ++ks) qa[nq][ks] = *(const bf16x8*)(P + (size_t)(qrow0 + 16 * nq + fr) * ldp + qcol + 32 * ks + 8 * fq);
    __syncthreads();
    if (mode == 0) { for (int e = tid; e < 465; e += NTHR) rpb[e] = rpb_g[e]; }
    *(LAS u32x4*)(Ks0 + soff) = k0; *(LAS u32x4*)(Vs0 + soff) = v0;
    AT_LOAD(k0, v0, 1);
    AT_LOAD(k1, v1, 2);
    float mrow[2] = {-1e30f, -1e30f}, lsum[2] = {0.f, 0.f}; f32x4 oacc[2][4];
#pragma unroll
    for (int nq = 0; nq < 2; ++nq)
#pragma unroll
        for (int r = 0; r < 4; ++r) oacc[nq][r] = (f32x4){0.f, 0.f, 0.f, 0.f};
    __syncthreads();
    for (int i = 0; i < ntile; i += 2) {
        attn_tile(Ks0, Vs0, rpb, qa, mrow, lsum, oacc, mode, i, nlat, qa_, qb_, ka_, lane);
        if (i + 1 < ntile) { *(LAS u32x4*)(Ks1 + soff) = k0; *(LAS u32x4*)(Vs1 + soff) = v0; }
        if (i + 3 < ntile) AT_LOAD(k0, v0, i + 3);
        __syncthreads();
        if (i + 1 >= ntile) break;
        attn_tile(Ks1, Vs1, rpb, qa, mrow, lsum, oacc, mode, i + 1, nlat, qa_, qb_, ka_, lane);
        if (i + 2 < ntile) { *(LAS u32x4*)(Ks0 + soff) = k1; *(LAS u32x4*)(Vs0 + soff) = v1; }
        if (i + 4 < ntile) AT_LOAD(k1, v1, i + 4);
        __syncthreads();
    }
#undef AT_LOAD
#undef AT_ROWB
    u32x4 gvv[4];
#pragma unroll
    for (int c2 = 0; c2 < 4; ++c2) { const int idx = lane + 64 * c2, q = idx >> 3, ch = idx & 7; gvv[c2] = *(const u32x4*)(P + (size_t)(qrow0 + q) * ldp + gcol + 8 * ch); }
#pragma unroll
    for (int nq = 0; nq < 2; ++nq) { float lt = lsum[nq]; lt += __shfl_xor(lt, 16); lt += __shfl_xor(lt, 32); float sc;
      if (mode == 1 || mode == 3) { const float mf = fmaxf(mrow[nq], sink); const float al = __expf(mrow[nq] - mf); lt = lt * al + __expf(sink - mf); sc = al / lt; } else sc = 1.f / lt;
#pragma unroll
      for (int mt = 0; mt < 4; ++mt) { u32x2 w; w.x = pk2(oacc[nq][mt][0] * sc, oacc[nq][mt][1] * sc); w.y = pk2(oacc[nq][mt][2] * sc, oacc[nq][mt][3] * sc); *(LAS u32x2*)(Ps + (16 * nq + fr) * 72 + 16 * mt + 4 * fq) = w; } }
    LDS_WAIT();
#pragma unroll
    for (int c2 = 0; c2 < 4; ++c2) { const int idx = lane + 64 * c2, q = idx >> 3, ch = idx & 7;
        const u32x4 ov = *(const LAS u32x4*)(Ps + q * 72 + 8 * ch); const u32x4 gv = gvv[c2];
        u32x4 w;
        w.x = pk2(bflo(ov.x) * siluf(bflo(gv.x)), bfhi(ov.x) * siluf(bfhi(gv.x))); w.y = pk2(bflo(ov.y) * siluf(bflo(gv.y)), bfhi(ov.y) * siluf(bfhi(gv.y)));
        w.z = pk2(bflo(ov.z) * siluf(bflo(gv.z)), bfhi(ov.z) * siluf(bfhi(gv.z))); w.w = pk2(bflo(ov.w) * siluf(bflo(gv.w)), bfhi(ov.w) * siluf(bfhi(gv.w)));
        *(u32x4*)(Z + (size_t)(qrow0 + q) * DM + zcol + 8 * ch) = w; }
    LDS_WAIT();
}
__device__ __forceinline__ void phase_attn(KP p, LAS unsigned char* lds, int l, bool need_ctx) {
    const int wave = otid() >> 6; const bool odd = l & 1; const int li = l >> 1;
    const bf16* P = (const bf16*)(p->ws + WS_P); bf16* Z = (bf16*)(p->ws + WS_H); const int ldp = odd ? NP_ODD : NP_EVEN;
    const int nmain = BATCH * 8 * 16, nctx = need_ctx ? BATCH * 8 : 0;
    for (int it = blockIdx.x; it < nmain + nctx; it += gridDim.x) {
        if (it < nmain) {
            int itv = it;
            if (gridDim.x == 256) { const int rnd = it >> 8, bx = it & 255, xcd = bx & 7, slot = bx >> 3; itv = ((rnd * 16 + 2 * xcd + (slot >> 4)) << 4) + (slot & 15); }
            const int b = itv >> 7, h = (itv >> 4) & 7, qb = itv & 15;
            if (!odd) { const int r0 = 4 * qb, rw = r0 + (wave >> 1); const int rs0 = min(max(r0 - 4, 0), 56), rs3 = min(max(r0 + 3 - 4, 0), 56);
                attn_item(lds, P, ldp, Z, 0, b * SEQ + rw * 64 + 32 * (wave & 1), 1536 + h * 64, 2048 + h * 64, 2560 + h * 64, 3072 + h * 64, 512 + h * 64,
                          rs3 + 8 - rs0, b * SEQ + rs0 * 64, MLAT + b * CTXL, rw, 32 * (wave & 1), rs0, p->na_rpb + (size_t)(li * 8 + h) * 465, 0.f); }
            else {
                int itw = it; if (gridDim.x == 256) { const int rnd = it >> 8, bx = it & 255, xcd = bx & 7, slot = bx >> 3; itw = ((rnd * 8 + xcd) << 5) + slot; }
                const int bb = itw >> 7, kv = (itw >> 6) & 1, qb2 = itw & 63, hh = 4 * kv + (wave >> 1), w2 = wave & 1;
                const int t0 = 64 * qb2, lt0 = max(0, qb2 - 2), lt1 = min(63, qb2 + 2);
                attn_item(lds, P, ldp, Z, 1, bb * SEQ + t0 + 32 * w2, 1536 + hh * 64, 2048 + kv * 64, 2176 + kv * 64, 2304 + hh * 64, 512 + hh * 64,
                          lt1 - lt0 + 1, bb * SEQ + lt0 * 64, MLAT + bb * CTXL, t0 + 32 * w2, 0, lt0 * 64, nullptr, p->sw_sink[li * 8 + hh]); }
        } else {
            const int j = it - nmain, b = j >> 3, h = j & 7; const int q0 = MLAT + b * CTXL + 32 * wave;
            if (!odd) attn_item(lds, P, ldp, Z, 2, q0, 1536 + h * 64, 2048 + h * 64, 2560 + h * 64, 3072 + h * 64, 512 + h * 64, 0, 0, MLAT + b * CTXL, 0, 0, 0, nullptr, 0.f);
            else { const int kv = h >> 2; attn_item(lds, P, ldp, Z, 3, q0, 1536 + h * 64, 2048 + kv * 64, 2176 + kv * 64, 2304 + h * 64, 512 + h * 64, 0, 0, MLAT + b * CTXL, 0, 0, 0, nullptr, p->sw_sink[li * 8 + h]); }
        }
    }
}
__device__ __forceinline__ int chunk_row0(int b, int cp) { return cp < 4 ? MLAT + b * CTXL + cp * 64 : b * SEQ + (cp - 4) * 64; }
constexpr int SL_KDF = 0, SL_KDB = 9216, SL_VS = 18432, SL_SEG = 35840, SL_MISC = 39936;
__device__ __forceinline__ void phase_scan_local(KP p, LAS unsigned char* lds, int l) {
    const int tid = otid(), lane = tid & 63, wave = tid >> 6, fq = lane >> 4, fr = lane & 15; const bool odd = l & 1; const int li = l >> 1;
    const bf16* P = (const bf16*)(p->ws + WS_P); const int ldp = odd ? NP_ODD : NP_EVEN; const float* SM = (const float*)(p->ws + WS_SM);
    bf16* S = (bf16*)(p->ws + WS_S); float* GAM = (float*)(p->ws + WS_GAM); float* SC = (float*)(p->ws + WS_SC);
    LAS bf16* kdf = (LAS bf16*)(lds + SL_KDF); LAS bf16* kdb = (LAS bf16*)(lds + SL_KDB); LAS bf16* vs = (LAS bf16*)(lds + SL_VS);
    LAS float* seg = (LAS float*)(lds + SL_SEG); LAS float* misc = (LAS float*)(lds + SL_MISC);
    const int dk = tid & 63, sg = tid >> 6;
    for (int it = blockIdx.x; it < BATCH * 4 * NCHUNK; it += gridDim.x) {
        const int b = it / (4 * NCHUNK), h = (it / NCHUNK) & 3, cp = it % NCHUNK; const int row0 = chunk_row0(b, cp);
        const int slf = ((b * 4 + h) * 2 + 0) * NCHUNK + cp, slb = slf + NCHUNK;
        __syncthreads();
#pragma unroll
        for (int c2 = 0; c2 < 2; ++c2) { const int idx = tid + NTHR * c2, t = idx >> 4, ch = idx & 15; *(LAS u32x4*)(vs + t * 136 + 8 * ch) = *(const u32x4*)(P + (size_t)(row0 + t) * ldp + 512 + h * 128 + 8 * ch); }
        float kv[8];
#pragma unroll
        for (int tt = 0; tt < 8; ++tt) kv[tt] = bf2f(P[(size_t)(row0 + sg * 8 + tt) * ldp + 256 + h * 64 + dk]);
        if (!odd) {
            float gwf[16], gwb[16];
            const float* gw = p->gla_gate_w + (size_t)li * 2 * 16 * 256; const float* gb = p->gla_gate_b + (size_t)li * 2 * 256;
#pragma unroll
            for (int r = 0; r < 16; ++r) { gwf[r] = gw[r * 256 + h * 64 + dk]; gwb[r] = gw[(16 + r) * 256 + h * 64 + dk]; }
            const float gbf = gb[h * 64 + dk], gbb = gb[256 + h * 64 + dk];
            { const int t = tid >> 3, c4 = (tid & 7) * 4; *(LAS f32x4*)(misc + t * 32 + c4) = *(const f32x4*)(SM + (size_t)(row0 + t) * 32 + c4); }
            __syncthreads();
            float pf[8], sb[8];
            f32x4 L[2][8];
#pragma unroll
            for (int i = 0; i < 8; ++i) L[0][i] = *(const LAS f32x4*)(misc + (sg * 8) * 32 + 4 * i);
#pragma unroll
            for (int tt = 0; tt < 8; ++tt) {
                if (tt < 7) {
#pragma unroll
                    for (int i = 0; i < 8; ++i) L[(tt + 1) & 1][i] = *(const LAS f32x4*)(misc + (sg * 8 + tt + 1) * 32 + 4 * i); }
                f32x2_ af = {gbf, 0.f}, ab = {gbb, 0.f};
#pragma unroll
                for (int i = 0; i < 4; ++i)
#pragma unroll
                    for (int e = 0; e < 4; e += 2) { af += (f32x2_){L[tt & 1][i][e], L[tt & 1][i][e + 1]} * (f32x2_){gwf[4 * i + e], gwf[4 * i + e + 1]};
                                                     ab += (f32x2_){L[tt & 1][4 + i][e], L[tt & 1][4 + i][e + 1]} * (f32x2_){gwb[4 * i + e], gwb[4 * i + e + 1]}; }
                pf[tt] = logsigf(af[0] + af[1]) * 0.0625f; sb[tt] = logsigf(ab[0] + ab[1]) * 0.0625f; }
#pragma unroll
            for (int tt = 1; tt < 8; ++tt) pf[tt] += pf[tt - 1];
#pragma unroll
            for (int tt = 6; tt >= 0; --tt) sb[tt] += sb[tt + 1];
            seg[(0 * 8 + sg) * 64 + dk] = pf[7]; seg[(1 * 8 + sg) * 64 + dk] = sb[0];
            __syncthreads();
            float offf = 0.f, totf = 0.f, offb = 0.f, totb = 0.f;
#pragma unroll
            for (int q = 0; q < 8; ++q) { const float a = seg[q * 64 + dk], c = seg[(8 + q) * 64 + dk]; totf += a; totb += c; if (q < sg) offf += a; if (q > sg) offb += c; }
#pragma unroll
            for (int tt = 0; tt < 8; ++tt) { const int t = sg * 8 + tt;
                kdf[t * 72 + dk] = (bf16)f2bf(kv[tt] * __expf(totf - (offf + pf[tt]))); kdb[t * 72 + dk] = (bf16)f2bf(kv[tt] * __expf(totb - (offb + sb[tt]))); }
            if (sg == 0) { GAM[(size_t)slf * 64 + dk] = __expf(totf); GAM[(size_t)slb * 64 + dk] = __expf(totb); }
        } else {
            const float* mb = p->ml_gate_b + li * 16;
            if (tid < 128) { const int d = tid >> 6, t = tid & 63; const float* gp = SM + (size_t)(row0 + t) * 32 + d * 8;
                const float ig = gp[h] + mb[d * 8 + h], lf = logsigf(gp[4 + h] + mb[d * 8 + 4 + h]);
                const float run = wave_scan_sum(lf, t, d == 1);
                const float tot = rdlane(run, d == 0 ? 63 : 0);
                const float wl = tot - run + ig; const float ml = wave_max(wl);
                misc[256 + d * 64 + t] = __expf(wl - ml);
                if (t == 0) { const int sl = d == 0 ? slf : slb; SC[(size_t)sl * 4 + 0] = tot; SC[(size_t)sl * 4 + 1] = ml; } }
            __syncthreads();
            float nf = 0.f, nb = 0.f;
#pragma unroll
            for (int tt = 0; tt < 8; ++tt) { const int t = sg * 8 + tt; const float a = kv[tt] * misc[256 + t], c = kv[tt] * misc[256 + 64 + t]; nf += a; nb += c;
                kdf[t * 72 + dk] = (bf16)f2bf(a); kdb[t * 72 + dk] = (bf16)f2bf(c); }
            seg[(0 * 8 + sg) * 64 + dk] = nf; seg[(1 * 8 + sg) * 64 + dk] = nb;
            __syncthreads();
            if (sg < 2) { float s2 = 0.f;
#pragma unroll
                for (int q = 0; q < 8; ++q) s2 += seg[(sg * 8 + q) * 64 + dk];
                GAM[(size_t)(sg == 0 ? slf : slb) * 64 + dk] = s2; }
        }
        __syncthreads();
#pragma unroll
        for (int d = 0; d < 2; ++d) { const LAS bf16* kd = d ? kdb : kdf; f32x4 acc[4];
#pragma unroll
            for (int nt = 0; nt < 4; ++nt) acc[nt] = (f32x4){0.f, 0.f, 0.f, 0.f};
#pragma unroll
            for (int ks = 0; ks < 2; ++ks) { const bf16x8 av = frag_tr(vs, 136, 32 * ks, 16 * wave, lane);
#pragma unroll
                for (int nt = 0; nt < 4; ++nt) acc[nt] = MFMA(av, frag_tr(kd, 72, 32 * ks, 16 * nt, lane), acc[nt]); }
            bf16* dst = S + (size_t)(d ? slb : slf) * 8192;
#pragma unroll
            for (int nt = 0; nt < 4; ++nt) { u32x2 w; w.x = pk2(acc[nt][0], acc[nt][1]); w.y = pk2(acc[nt][2], acc[nt][3]); *(u32x2*)(dst + (16 * nt + fr) * 128 + 16 * wave + 4 * fq) = w; } }
    }
}
__device__ __forceinline__ void phase_scan_seq(KP p, int l, bool dummy = false) {
    const bool odd = l & 1;
    u32x2* S2 = (u32x2*)(p->ws + WS_S); float* GAM = (float*)(p->ws + WS_GAM); f32x4* GAM4 = (f32x4*)(p->ws + WS_GAM); float* SC = (float*)(p->ws + WS_SC);
    const int nthreads = gridDim.x * NTHR;
    for (int gid = blockIdx.x * NTHR + otid(); gid < 64 * 2048; gid += nthreads) {
        const int chain = gid >> 11, e4 = gid & 2047, dir = chain & 1, dkk = e4 >> 5; const int base = chain * NCHUNK;
        f32x4 st = (f32x4){0.f, 0.f, 0.f, 0.f}, nst = (f32x4){0.f, 0.f, 0.f, 0.f}; float m = 0.f; const bool hasn = odd && e4 < 16;
        for (int s0 = 0; s0 < NCHUNK; s0 += 4) {
            u32x2 dr[4]; f32x4 dn[4]; float g0[4], g1[4]; int idx[4];
#pragma unroll
            for (int u = 0; u < 4; ++u) { const int step = s0 + u; const int cp = dir == 0 ? step : (step < 4 ? 3 - step : 71 - step); idx[u] = base + cp;
                dr[u] = S2[(size_t)idx[u] * 2048 + e4];
                if (!odd) { g0[u] = GAM[(size_t)idx[u] * 64 + dkk]; g1[u] = 0.f; } else { g0[u] = SC[(size_t)idx[u] * 4 + 0]; g1[u] = SC[(size_t)idx[u] * 4 + 1]; if (hasn) dn[u] = GAM4[(size_t)idx[u] * 16 + e4]; } }
#pragma unroll
            for (int u = 0; u < 4; ++u) {
                const f32x4 d = (f32x4){bflo(dr[u].x), bfhi(dr[u].x), bflo(dr[u].y), bfhi(dr[u].y)};
                u32x2 w; w.x = pk2(st[0], st[1]); w.y = pk2(st[2], st[3]);
                S2[(size_t)idx[u] * 2048 + e4] = dummy ? dr[u] : w;
                if (!odd) { st = st * g0[u] + d; }
                else { if (hasn) GAM4[(size_t)idx[u] * 16 + e4] = dummy ? dn[u] : nst; if (e4 == 0 && !dummy) SC[(size_t)idx[u] * 4 + 2] = m;
                    const float mn = fmaxf(g0[u] + m, g1[u]); const float dec = __expf(g0[u] + m - mn), sc = __expf(g1[u] - mn);
                    st = st * dec + d * sc; if (hasn) nst = nst * dec + dn[u] * sc; m = mn; }
            }
        }
    }
}
constexpr int SO_QF = 0, SO_KF = 9216, SO_QB = 18432, SO_KB = 27648, SO_VS = 36864, SO_AF = 54272, SO_AB = 63488, SO_SF = 72704, SO_SB = 90112, SO_SEG = 107520, SO_SSQ = 111616, SO_MISC = 113664;
constexpr int SO_OST = 0;
__device__ __forceinline__ void scan_out_tail(LAS unsigned char* lds, f32x4 (&o)[4], const bf16* __restrict__ P, int ldp, bf16* __restrict__ Z, int row0, int h, const float* __restrict__ ng) {
    const int tid = otid(), lane = tid & 63, wave = tid >> 6, fq = lane >> 4, fr = lane & 15;
    LAS float* ost = (LAS float*)(lds + SO_OST);
    u32x4 gv[2]; f32x4 g0[2], g1[2];
#pragma unroll
    for (int c2 = 0; c2 < 2; ++c2) { const int idx = tid + NTHR * c2, t = idx >> 4, ch = idx & 15;
        gv[c2] = *(const u32x4*)(P + (size_t)(row0 + t) * ldp + 1024 + h * 128 + 8 * ch); g0[c2] = *(const f32x4*)(ng + h * 128 + 8 * ch); g1[c2] = *(const f32x4*)(ng + h * 128 + 8 * ch + 4); }
    __syncthreads();
#pragma unroll
    for (int mt = 0; mt < 4; ++mt)
#pragma unroll
        for (int r = 0; r < 4; ++r) ost[(16 * mt + 4 * fq + r) * 132 + 16 * wave + fr] = o[mt][r];
    __syncthreads();
#pragma unroll
    for (int c2 = 0; c2 < 2; ++c2) { const int idx = tid + NTHR * c2, t = idx >> 4, ch = idx & 15;
        f32x4 o0 = *(const LAS f32x4*)(ost + t * 132 + 8 * ch), o1 = *(const LAS f32x4*)(ost + t * 132 + 8 * ch + 4);
        const float q = red16_sum((o0[0] * o0[0] + o0[1] * o0[1]) + (o0[2] * o0[2] + o0[3] * o0[3]) + (o1[0] * o1[0] + o1[1] * o1[1]) + (o1[2] * o1[2] + o1[3] * o1[3]));
        const float rs = rsqrtf(q * (1.f / 128.f) + 1e-6f); o0 = o0 * rs * g0[c2]; o1 = o1 * rs * g1[c2];
        u32x4 w;
        w.x = pk2(o0[0] * siluf(bflo(gv[c2].x)), o0[1] * siluf(bfhi(gv[c2].x))); w.y = pk2(o0[2] * siluf(bflo(gv[c2].y)), o0[3] * siluf(bfhi(gv[c2].y)));
        w.z = pk2(o1[0] * siluf(bflo(gv[c2].z)), o1[1] * siluf(bfhi(gv[c2].z))); w.w = pk2(o1[2] * siluf(bflo(gv[c2].w)), o1[3] * siluf(bfhi(gv[c2].w)));
        *(u32x4*)(Z + (size_t)(row0 + t) * DM + h * 128 + 8 * ch) = w; }
}
__device__ __forceinline__ void stage_state(LAS bf16* dst, const bf16* __restrict__ src) {
    const int tid = otid();
#pragma unroll
    for (int c2 = 0; c2 < 2; ++c2) { const int idx = tid + NTHR * c2, r = idx >> 4, ch = idx & 15; *(LAS u32x4*)(dst + r * 136 + 8 * ch) = *(const u32x4*)(src + r * 128 + 8 * ch); }
}
__device__ __forceinline__ void phase_scan_out_gla(KP p, LAS unsigned char* lds, int l, bool need_ctx) {
    const int tid = otid(), lane = tid & 63, wave = tid >> 6, fq = lane >> 4, fr = lane & 15; const int li = l >> 1;
    const bf16* P = (const bf16*)(p->ws + WS_P); const int ldp = NP_EVEN; const float* SM = (const float*)(p->ws + WS_SM); bf16* Z = (bf16*)(p->ws + WS_H);
    const bf16* S = (const bf16*)(p->ws + WS_S);
    LAS bf16* qf = (LAS bf16*)(lds + SO_QF); LAS bf16* kf = (LAS bf16*)(lds + SO_KF); LAS bf16* qb = (LAS bf16*)(lds + SO_QB); LAS bf16* kb = (LAS bf16*)(lds + SO_KB);
    LAS bf16* vs = (LAS bf16*)(lds + SO_VS); LAS bf16* Af = (LAS bf16*)(lds + SO_AF); LAS bf16* Ab = (LAS bf16*)(lds + SO_AB); LAS bf16* Sf = (LAS bf16*)(lds + SO_SF); LAS bf16* Sb = (LAS bf16*)(lds + SO_SB);
    LAS float* seg = (LAS float*)(lds + SO_SEG); LAS float* lrs = (LAS float*)(lds + SO_MISC);
    const int dk = tid & 63, sg = tid >> 6;
    for (int it = blockIdx.x; it < BATCH * 4 * NCHUNK; it += gridDim.x) {
        const int b = it / (4 * NCHUNK), h = (it / NCHUNK) & 3, cp = it % NCHUNK; if (cp < 4 && !need_ctx) continue;
        const int row0 = chunk_row0(b, cp); const int slf = ((b * 4 + h) * 2 + 0) * NCHUNK + cp, slb = slf + NCHUNK;
        __syncthreads();
#pragma unroll
        for (int c2 = 0; c2 < 2; ++c2) { const int idx = tid + NTHR * c2, t = idx >> 4, ch = idx & 15; *(LAS u32x4*)(vs + t * 136 + 8 * ch) = *(const u32x4*)(P + (size_t)(row0 + t) * ldp + 512 + h * 128 + 8 * ch); }
        stage_state(Sf, S + (size_t)slf * 8192); stage_state(Sb, S + (size_t)slb * 8192);
        float qv[8], kv[8];
#pragma unroll
        for (int tt = 0; tt < 8; ++tt) { const size_t ro = (size_t)(row0 + sg * 8 + tt) * ldp + h * 64 + dk; qv[tt] = bf2f(P[ro]); kv[tt] = bf2f(P[ro + 256]); }
        float gwf[16], gwb[16];
        const float* gw = p->gla_gate_w + (size_t)li * 2 * 16 * 256; const float* gb = p->gla_gate_b + (size_t)li * 2 * 256;
#pragma unroll
        for (int r = 0; r < 16; ++r) { gwf[r] = gw[r * 256 + h * 64 + dk]; gwb[r] = gw[(16 + r) * 256 + h * 64 + dk]; }
        const float gbf = gb[h * 64 + dk], gbb = gb[256 + h * 64 + dk];
        { const int t = tid >> 3, c4 = (tid & 7) * 4; *(LAS f32x4*)(lrs + t * 32 + c4) = *(const f32x4*)(SM + (size_t)(row0 + t) * 32 + c4); }
        __syncthreads();
        float pf[8], sb[8];
        f32x4 L[2][8];
#pragma unroll
        for (int i = 0; i < 8; ++i) L[0][i] = *(const LAS f32x4*)(lrs + (sg * 8) * 32 + 4 * i);
#pragma unroll
        for (int tt = 0; tt < 8; ++tt) {
            if (tt < 7) {
#pragma unroll
                for (int i = 0; i < 8; ++i) L[(tt + 1) & 1][i] = *(const LAS f32x4*)(lrs + (sg * 8 + tt + 1) * 32 + 4 * i); }
            f32x2_ af = {gbf, 0.f}, ab = {gbb, 0.f};
#pragma unroll
            for (int i = 0; i < 4; ++i)
#pragma unroll
                for (int e = 0; e < 4; e += 2) { af += (f32x2_){L[tt & 1][i][e], L[tt & 1][i][e + 1]} * (f32x2_){gwf[4 * i + e], gwf[4 * i + e + 1]};
                                                 ab += (f32x2_){L[tt & 1][4 + i][e], L[tt & 1][4 + i][e + 1]} * (f32x2_){gwb[4 * i + e], gwb[4 * i + e + 1]}; }
            pf[tt] = logsigf(af[0] + af[1]) * 0.0625f; sb[tt] = logsigf(ab[0] + ab[1]) * 0.0625f; }
#pragma unroll
        for (int tt = 1; tt < 8; ++tt) pf[tt] += pf[tt - 1];
#pragma unroll
        for (int tt = 6; tt >= 0; --tt) sb[tt] += sb[tt + 1];
        seg[(0 * 8 + sg) * 64 + dk] = pf[7]; seg[(1 * 8 + sg) * 64 + dk] = sb[0];
        __syncthreads();
        float offf = 0.f, offb = 0.f;
#pragma unroll
        for (int q = 0; q < 8; ++q) { const float a = seg[q * 64 + dk], c = seg[(8 + q) * 64 + dk]; if (q < sg) offf += a; if (q > sg) offb += c; }
#pragma unroll
        for (int tt = 0; tt < 8; ++tt) { const int t = sg * 8 + tt; const float bf_ = offf + pf[tt], bb_ = offb + sb[tt];
            qf[t * 72 + dk] = (bf16)f2bf(qv[tt] * __expf(bf_)); kf[t * 72 + dk] = (bf16)f2bf(kv[tt] * __expf(-bf_));
            qb[t * 72 + dk] = (bf16)f2bf(qv[tt] * __expf(bb_)); kb[t * 72 + dk] = (bf16)f2bf(kv[tt] * __expf(-bb_)); }
        __syncthreads();
        { const int mt = wave >> 1;
#pragma unroll
          for (int n2 = 0; n2 < 2; ++n2) { const int nt = 2 * (wave & 1) + n2; f32x4 af = (f32x4){0.f, 0.f, 0.f, 0.f}, ab = (f32x4){0.f, 0.f, 0.f, 0.f};
#pragma unroll
              for (int ks = 0; ks < 2; ++ks) { af = MFMA(frag_rm(qf, 72, 16 * mt, 32 * ks, lane), frag_rm(kf, 72, 16 * nt, 32 * ks, lane), af);
                                               ab = MFMA(frag_rm(qb, 72, 16 * mt, 32 * ks, lane), frag_rm(kb, 72, 16 * nt, 32 * ks, lane), ab); }
#pragma unroll
              for (int r = 0; r < 4; ++r) { const int t = 16 * mt + 4 * fq + r, s = 16 * nt + fr;
                  Af[t * 72 + s] = (bf16)f2bf(s <= t ? af[r] : 0.f); Ab[t * 72 + s] = (bf16)f2bf(s >= t ? ab[r] : 0.f); } } }
        __syncthreads();
        f32x4 o[4];
#pragma unroll
        for (int mt = 0; mt < 4; ++mt) o[mt] = (f32x4){0.f, 0.f, 0.f, 0.f};
#pragma unroll
        for (int ks = 0; ks < 2; ++ks) { const bf16x8 bv = frag_tr(vs, 136, 32 * ks, 16 * wave, lane), bsf = frag_tr(Sf, 136, 32 * ks, 16 * wave, lane), bsb = frag_tr(Sb, 136, 32 * ks, 16 * wave, lane);
#pragma unroll
            for (int mt = 0; mt < 4; ++mt) { o[mt] = MFMA(frag_rm(Af, 72, 16 * mt, 32 * ks, lane), bv, o[mt]); o[mt] = MFMA(frag_rm(Ab, 72, 16 * mt, 32 * ks, lane), bv, o[mt]);
                o[mt] = MFMA(frag_rm(qf, 72, 16 * mt, 32 * ks, lane), bsf, o[mt]); o[mt] = MFMA(frag_rm(qb, 72, 16 * mt, 32 * ks, lane), bsb, o[mt]); } }
        scan_out_tail(lds, o, P, ldp, Z, row0, h, p->gla_norm_g + (size_t)li * 512);
    }
}
constexpr int MO_QS = 0, MO_KS = 9216, MO_QWF = 18432, MO_QWB = 27648;
__device__ __forceinline__ void phase_scan_out_mlstm(KP p, LAS unsigned char* lds, int l, bool need_ctx) {
    const int tid = otid(), lane = tid & 63, wave = tid >> 6, fq = lane >> 4, fr = lane & 15; const int li = l >> 1;
    const bf16* P = (const bf16*)(p->ws + WS_P); const int ldp = NP_ODD; const float* SM = (const float*)(p->ws + WS_SM); bf16* Z = (bf16*)(p->ws + WS_H);
    const bf16* S = (const bf16*)(p->ws + WS_S); const float* GAM = (const float*)(p->ws + WS_GAM); const float* SC = (const float*)(p->ws + WS_SC);
    LAS bf16* qs = (LAS bf16*)(lds + MO_QS); LAS bf16* ks_ = (LAS bf16*)(lds + MO_KS); LAS bf16* qwf = (LAS bf16*)(lds + MO_QWF); LAS bf16* qwb = (LAS bf16*)(lds + MO_QWB);
    LAS bf16* vs = (LAS bf16*)(lds + SO_VS); LAS bf16* Af = (LAS bf16*)(lds + SO_AF); LAS bf16* Ab = (LAS bf16*)(lds + SO_AB); LAS bf16* Cf = (LAS bf16*)(lds + SO_SF); LAS bf16* Cb = (LAS bf16*)(lds + SO_SB);
    LAS float* part = (LAS float*)(lds + SO_SEG);
    LAS float* misc = (LAS float*)(lds + SO_MISC);
    const float* mb = p->ml_gate_b + li * 16;
    for (int it = blockIdx.x; it < BATCH * 4 * NCHUNK; it += gridDim.x) {
        const int b = it / (4 * NCHUNK), h = (it / NCHUNK) & 3, cp = it % NCHUNK; if (cp < 4 && !need_ctx) continue;
        const int row0 = chunk_row0(b, cp); const int slf = ((b * 4 + h) * 2 + 0) * NCHUNK + cp, slb = slf + NCHUNK;
        __syncthreads();
#pragma unroll
        for (int c2 = 0; c2 < 2; ++c2) { const int idx = tid + NTHR * c2, t = idx >> 4, ch = idx & 15; *(LAS u32x4*)(vs + t * 136 + 8 * ch) = *(const u32x4*)(P + (size_t)(row0 + t) * ldp + 512 + h * 128 + 8 * ch); }
        stage_state(Cf, S + (size_t)slf * 8192); stage_state(Cb, S + (size_t)slb * 8192);
        { const int t = tid >> 3, ch = tid & 7; const size_t ro = (size_t)(row0 + t) * ldp + h * 64 + 8 * ch;
          *(LAS u32x4*)(qs + t * 72 + 8 * ch) = *(const u32x4*)(P + ro); *(LAS u32x4*)(ks_ + t * 72 + 8 * ch) = *(const u32x4*)(P + ro + 256); }
        float mprev_r = 0.f;
        if (tid < 128) { const int d = tid >> 6, t = tid & 63; const float* gp = SM + (size_t)(row0 + t) * 32 + d * 8; LAS float* md = misc + d * 512;
            const float ig = gp[h] + mb[d * 8 + h], lf = logsigf(gp[4 + h] + mb[d * 8 + 4 + h]);
            md[t] = ig; misc[1024 + d * 64 + t] = GAM[(size_t)(d ? slb : slf) * 64 + t]; mprev_r = SC[(size_t)(d ? slb : slf) * 4 + 2];
            const float run = wave_scan_sum(lf, t, d == 1); const float pm = wave_scan_max(ig - run, t, d == 1);
            const float mprev = mprev_r;
            const float mt_ = fmaxf(run + pm, run + mprev);
            md[128 + t] = run; md[192 + t] = mt_; md[256 + t] = __expf(run + mprev - mt_); }
        __syncthreads();
        { const int t = tid >> 3, ch = tid & 7; const u32x4 qv = *(const LAS u32x4*)(qs + t * 72 + 8 * ch); const float wf = misc[256 + t], wb = misc[512 + 256 + t];
          u32x4 a, c;
          a.x = pk2(bflo(qv.x) * wf, bfhi(qv.x) * wf); a.y = pk2(bflo(qv.y) * wf, bfhi(qv.y) * wf); a.z = pk2(bflo(qv.z) * wf, bfhi(qv.z) * wf); a.w = pk2(bflo(qv.w) * wf, bfhi(qv.w) * wf);
          c.x = pk2(bflo(qv.x) * wb, bfhi(qv.x) * wb); c.y = pk2(bflo(qv.y) * wb, bfhi(qv.y) * wb); c.z = pk2(bflo(qv.z) * wb, bfhi(qv.z) * wb); c.w = pk2(bflo(qv.w) * wb, bfhi(qv.w) * wb);
          *(LAS u32x4*)(qwf + t * 72 + 8 * ch) = a; *(LAS u32x4*)(qwb + t * 72 + 8 * ch) = c;
          const float q0 = bflo(qv.x), q1 = bfhi(qv.x), q2 = bflo(qv.y), q3 = bfhi(qv.y), q4 = bflo(qv.z), q5 = bfhi(qv.z), q6 = bflo(qv.w), q7 = bfhi(qv.w);
#pragma unroll
          for (int d = 0; d < 2; ++d) { const LAS float* nv = misc + 1024 + d * 64 + 8 * ch;
              part[(d * 8 + ch) * 64 + t] = q0 * nv[0] + q1 * nv[1] + q2 * nv[2] + q3 * nv[3] + q4 * nv[4] + q5 * nv[5] + q6 * nv[6] + q7 * nv[7]; } }
        { const int mt = wave >> 1; float rsf[4] = {0.f, 0.f, 0.f, 0.f}, rsb[4] = {0.f, 0.f, 0.f, 0.f};
#pragma unroll
          for (int n2 = 0; n2 < 2; ++n2) { const int nt = 2 * (wave & 1) + n2; f32x4 a = (f32x4){0.f, 0.f, 0.f, 0.f};
#pragma unroll
              for (int ks = 0; ks < 2; ++ks) a = MFMA(frag_rm(qs, 72, 16 * mt, 32 * ks, lane), frag_rm(ks_, 72, 16 * nt, 32 * ks, lane), a);
#pragma unroll
              for (int r = 0; r < 4; ++r) { const int t = 16 * mt + 4 * fq + r, s = 16 * nt + fr;
                  const float wf = s <= t ? __expf(misc[128 + t] - misc[128 + s] + misc[s] - misc[192 + t]) : 0.f;
                  const float wb = s >= t ? __expf(misc[512 + 128 + t] - misc[512 + 128 + s] + misc[512 + s] - misc[512 + 192 + t]) : 0.f;
                  const float vf = a[r] * wf, vb = a[r] * wb; rsf[r] += vf; rsb[r] += vb;
                  Af[t * 72 + s] = (bf16)f2bf(vf); Ab[t * 72 + s] = (bf16)f2bf(vb); } }
#pragma unroll
          for (int r = 0; r < 4; ++r) { const float a = red16_sum(rsf[r]), c = red16_sum(rsb[r]);
              if (fr == 0) { misc[1152 + (0 * 2 + (wave & 1)) * 64 + 16 * mt + 4 * fq + r] = a; misc[1152 + (1 * 2 + (wave & 1)) * 64 + 16 * mt + 4 * fq + r] = c; } } }
        __syncthreads();
        if (tid < 128) { const int d = tid >> 6, t = tid & 63; float qn = 0.f;
#pragma unroll
            for (int q = 0; q < 8; ++q) qn += part[(d * 8 + q) * 64 + t];
            const float den = misc[1152 + (d * 2 + 0) * 64 + t] + misc[1152 + (d * 2 + 1) * 64 + t] + misc[d * 512 + 256 + t] * qn;
            misc[d * 512 + 320 + t] = 1.f / fmaxf(fabsf(den), __expf(-misc[d * 512 + 192 + t])); }
        f32x4 of[4], ob[4];
#pragma unroll
        for (int mt = 0; mt < 4; ++mt) { of[mt] = (f32x4){0.f, 0.f, 0.f, 0.f}; ob[mt] = (f32x4){0.f, 0.f, 0.f, 0.f}; }
#pragma unroll
        for (int ks = 0; ks < 2; ++ks) { const bf16x8 bv = frag_tr(vs, 136, 32 * ks, 16 * wave, lane), bcf = frag_tr(Cf, 136, 32 * ks, 16 * wave, lane), bcb = frag_tr(Cb, 136, 32 * ks, 16 * wave, lane);
#pragma unroll
            for (int mt = 0; mt < 4; ++mt) { of[mt] = MFMA(frag_rm(Af, 72, 16 * mt, 32 * ks, lane), bv, of[mt]); of[mt] = MFMA(frag_rm(qwf, 72, 16 * mt, 32 * ks, lane), bcf, of[mt]);
                ob[mt] = MFMA(frag_rm(Ab, 72, 16 * mt, 32 * ks, lane), bv, ob[mt]); ob[mt] = MFMA(frag_rm(qwb, 72, 16 * mt, 32 * ks, lane), bcb, ob[mt]); } }
        __syncthreads();
        f32x4 o[4];
#pragma unroll
        for (int mt = 0; mt < 4; ++mt)
#pragma unroll
            for (int r = 0; r < 4; ++r) { const int t = 16 * mt + 4 * fq + r; o[mt][r] = of[mt][r] * misc[320 + t] + ob[mt][r] * misc[512 + 320 + t]; }
        scan_out_tail(lds, o, P, ldp, Z, row0, h, p->ml_norm_g + (size_t)li * 512);
    }
}
#define XB_TMO      128
#define XB_XCNT(j)  (256  + 64 * (j))
#define XB_XSUB(j)  (1280 + 64 * (j))
#define XB_XGEN(j)  (2304 + 64 * (j))
#define XB_TOP      3328
#define XB_TOPGEN   3392
#define XCD_BAR_WORDS 3456
#define XB_SPIN_CAP (1u << 18)

__device__ __forceinline__ unsigned xb_ld(unsigned* p)              { return __hip_atomic_load(p, __ATOMIC_RELAXED, __HIP_MEMORY_SCOPE_AGENT); }
__device__ __forceinline__ unsigned xb_add(unsigned* p, unsigned v) { return __hip_atomic_fetch_add(p, v, __ATOMIC_RELAXED, __HIP_MEMORY_SCOPE_AGENT); }
__device__ __forceinline__ unsigned xb_xcc_id() { return (unsigned)__builtin_amdgcn_s_getreg((3 << 11) | 20) & 0xFu; }
#define XB_SPIN(cond, bar) do { unsigned _sp = 0; while (cond) { __builtin_amdgcn_s_sleep(1); \
    if ((++_sp & 255u) == 0u) { if (xb_ld(&(bar)[XB_TMO])) break; if (_sp > XB_SPIN_CAP) { atomicAdd(&(bar)[XB_TMO], 1u); break; } } } } while (0)

struct XcdBarrier {
    unsigned* bar; unsigned x;
    volatile LAS unsigned* st;
};

__device__ __forceinline__ XcdBarrier xcd_barrier_post(unsigned* bar, volatile LAS unsigned* st) {
    XcdBarrier b; b.bar = bar; b.x = xb_xcc_id(); b.st = st;
    if (otid() == 0) (void)xb_add(&bar[XB_XCNT(b.x)], 1u);
    return b;
}
__device__ __forceinline__ void xcd_barrier_complete(unsigned* bar, unsigned x, unsigned& nloc, unsigned& nx) {
    const unsigned G = gridDim.x * gridDim.y * gridDim.z;
    unsigned sum, cnt, mine, sp = 0u;
    for (;;) {
        sum = 0u; cnt = 0u; mine = 0u;
#pragma unroll
        for (unsigned j = 0; j < 16; ++j) { const unsigned c = xb_ld(&bar[XB_XCNT(j)]); sum += c; cnt += (c > 0u) ? 1u : 0u; mine = (j == x) ? c : mine; }
        if (sum == G) break;
        __builtin_amdgcn_s_sleep(1);
        if ((++sp & 255u) == 0u) { if (xb_ld(&bar[XB_TMO])) break; if (sp > XB_SPIN_CAP) { atomicAdd(&bar[XB_TMO], 1u); break; } }
    }
    nloc = mine > 0u ? mine : 1u; nx = cnt > 0u ? cnt : 1u;
}

__device__ __forceinline__ void xcd_barrier(const XcdBarrier& b) {
    asm volatile("s_waitcnt vmcnt(0)" ::: "memory");
    __syncthreads();
    if (otid() == 0) {
        unsigned* bar = b.bar;
        __builtin_amdgcn_s_waitcnt(0);
        unsigned nloc = b.st[0], nx = b.st[1];
        if (nloc == 0u) { xcd_barrier_complete(bar, b.x, nloc, nx); b.st[0] = nloc; b.st[1] = nx; }
        const unsigned old = xb_add(&bar[XB_XSUB(b.x)], 1u);
        const unsigned gen = old / nloc;
        if (old + 1u == (gen + 1u) * nloc) {
            __builtin_amdgcn_fence(__ATOMIC_RELEASE, "agent");
            asm volatile("s_waitcnt vmcnt(0)" ::: "memory");
            const unsigned og = xb_add(&bar[XB_TOP], 1u);
            const unsigned tg = og / nx;
            if (og + 1u == (tg + 1u) * nx) xb_add(&bar[XB_TOPGEN], 1u);
            else XB_SPIN(xb_ld(&bar[XB_TOPGEN]) == tg, bar);
            __builtin_amdgcn_fence(__ATOMIC_ACQUIRE, "agent");
            xb_add(&bar[XB_XGEN(b.x)], 1u);
            asm volatile("s_waitcnt vmcnt(0)" ::: "memory");
        } else {
            XB_SPIN(xb_ld(&bar[XB_XGEN(b.x)]) == gen, bar);
            __builtin_amdgcn_fence(__ATOMIC_ACQUIRE, "agent");
            asm volatile("s_waitcnt vmcnt(0)" ::: "memory");
        }
    }
    __syncthreads();
}

#define REP_GEMM 1
#define REP_ATT 1
#define REP_LOC 1
#define REP_OUT 1
#define REP_PRO 1
#define REP_SEQ 1
#define REP_LN 1
#ifndef MK_N_LAUNCHES
#define MK_N_LAUNCHES 1
#endif
constexpr int N_PHASES = 2 + 6 * DEPTH;
__global__ void __launch_bounds__(NTHR, 2) fwd_megakernel(Params p_unused) {
    extern __shared__ __attribute__((aligned(16))) unsigned char lds_raw[];
    LAS unsigned char* lds = (LAS unsigned char*)lds_raw;
    cg::grid_group grid = cg::this_grid();
    const int lo = (int)kparams()->ph_lo, hi = (int)kparams()->ph_hi;
#define IN(k) (lo <= (k) && (k) < hi)
    volatile LAS unsigned* bst = (volatile LAS unsigned*)(lds + LDS_BYTES - 64);
    if (otid() < 16) bst[otid()] = 0u;
    __syncthreads();
    XcdBarrier bar = xcd_barrier_post((unsigned*)(kparams()->ws + WS_BAR), bst);
    if (kparams()->ph_hi < 0) grid.sync();
#define SEAM(k) do { if (IN(k) && IN((k) + 1)) xcd_barrier(bar); } while (0)
    if (IN(0)) { for (int rep = 0; rep < REP_PRO; ++rep) { phase_prologue(kparams(), lds); __syncthreads(); } } SEAM(0);
    if (IN(1)) { for (int rep = 0; rep < REP_PRO; ++rep) phase_h0(kparams()); } SEAM(1);
#pragma unroll 1
    for (int l = 0; l < DEPTH; ++l) {
        const int pb = 2 + 6 * l; const bool odd = l & 1; const int li = l >> 1; const bool need_ctx = l < DEPTH - 1;
        if (IN(pb + 0)) {
            const int npad = odd ? NPAD_ODD : NPAD_EVEN; unsigned char* ws = kparams()->ws;
            pg8::Gemm g{(const pg8::bf16_t*)(ws + WS_H), (const pg8::bf16_t*)(ws + (odd ? WS_WIO : WS_WIE)) + (size_t)li * npad * 1024, MTOT, npad, 1024};
            pg8::StaticOrder S; S.init(MTOT, npad, (int)gridDim.x, (int)blockIdx.x);
            pg8::EpiProj E{(pg8::bf16_t*)(ws + WS_P), odd ? NP_ODD : NP_EVEN, (float*)(ws + WS_SM), odd ? 16 : 32, npad / 256 - 1, odd ? 1 : 0, (const float*)(ws + WS_ROPE), (const float*)(ws + WS_ROPE) + 1024};
            for (int rep = 0; rep < REP_GEMM; ++rep) pg8::gemm_phase<pg8::EpiProj, pg8::StaticOrder, true, true>(lds, g, S, E);
        }
        SEAM(pb + 0);
        if (IN(pb + 1)) { for (int rep = 0; rep < REP_ATT; ++rep) phase_attn(kparams(), lds, l, need_ctx); for (int rep = 0; rep < REP_LOC; ++rep) phase_scan_local(kparams(), lds, l); }
        SEAM(pb + 1);
        if (IN(pb + 2)) { for (int rep = 1; rep < REP_SEQ; ++rep) { phase_scan_seq(kparams(), l, true); __syncthreads(); } phase_scan_seq(kparams(), l); }
        SEAM(pb + 2);
        if (IN(pb + 3)) { for (int rep = 0; rep < REP_OUT; ++rep) { if (odd) phase_scan_out_mlstm(kparams(), lds, l, need_ctx); else phase_scan_out_gla(kparams(), lds, l, need_ctx); } }
        SEAM(pb + 3);
        if (IN(pb + 4)) {
            const int mrows = need_ctx ? MTOT : MLAT; unsigned char* ws = kparams()->ws;
            pg8::Gemm g{(const pg8::bf16_t*)(ws + WS_H), (const pg8::bf16_t*)(ws + WS_WO) + (size_t)l * 1024 * 1024, mrows, 1024, 1024};
            pg8::StaticOrder S; S.init(mrows, 1024, (int)gridDim.x, (int)blockIdx.x);
            pg8::EpiProj E{(pg8::bf16_t*)(ws + WS_P), 1024, nullptr, 0, -1, 0, nullptr, nullptr};
            for (int rep = 0; rep < REP_GEMM; ++rep) pg8::gemm_phase<pg8::EpiProj, pg8::StaticOrder, true, true>(lds, g, S, E);
        }
        SEAM(pb + 4);
        if (IN(pb + 5)) { for (int rep = 1; rep < REP_LN; ++rep) { phase_ln(kparams(), l, true); } phase_ln(kparams(), l); }
        SEAM(pb + 5);
    }
}
extern "C" void kernel_launch(void* const* d_in, const int* in_sizes, int n_in, void* d_out, int out_size, void* d_ws, size_t ws_size, hipStream_t stream) {
    static int grid = 0;
    if (grid == 0) {
        if (n_in != 19 || ws_size < WS_END) { fprintf(stderr, "kernel_launch: need 19 inputs and %zu bytes of workspace; got %d, %zu\n", (size_t)WS_END, n_in, ws_size); grid = -1; return; }
        int dev = 0, cus = 0, per_cu = 0;
        if (hipGetDevice(&dev) != hipSuccess || hipDeviceGetAttribute(&cus, hipDeviceAttributeMultiprocessorCount, dev) != hipSuccess) { grid = -1; return; }
        if (hipFuncSetAttribute((const void*)fwd_megakernel, hipFuncAttributeMaxDynamicSharedMemorySize, LDS_BYTES) != hipSuccess) { fprintf(stderr, "kernel_launch: hipFuncSetAttribute failed\n"); grid = -1; return; }
        if (hipOccupancyMaxActiveBlocksPerMultiprocessor(&per_cu, (const void*)fwd_megakernel, NTHR, LDS_BYTES) != hipSuccess || per_cu < 1) per_cu = 1;
        grid = cus * per_cu;
    }
    if (grid < 0) return;
    Params p{};
    p.x = (const float*)d_in[0]; p.c = (const float*)d_in[1]; p.ctx = (const float*)d_in[2]; p.c_ctx = (const float*)d_in[3]; p.w_ada = (const float*)d_in[4]; p.b_ada = (const float*)d_in[5];
    p.ln_g = (const float*)d_in[6]; p.ln_b = (const float*)d_in[7]; p.w_in_even = (const float*)d_in[8]; p.w_out_even = (const float*)d_in[9]; p.gla_gate_w = (const float*)d_in[10]; p.gla_gate_b = (const float*)d_in[11];
    p.gla_norm_g = (const float*)d_in[12]; p.na_rpb = (const float*)d_in[13]; p.w_in_odd = (const float*)d_in[14]; p.w_out_odd = (const float*)d_in[15]; p.ml_gate_b = (const float*)d_in[16]; p.ml_norm_g = (const float*)d_in[17];
    p.sw_sink = (const float*)d_in[18]; p.out = (float*)d_out; p.ws = (unsigned char*)d_ws;
    if (hipMemsetAsync((char*)d_ws + WS_BAR, 0, XCD_BAR_WORDS * 4, stream) != hipSuccess) { fprintf(stderr, "kernel_launch: memset failed\n"); return; }
#if MK_N_LAUNCHES == 1
    p.ph_lo = 0; p.ph_hi = N_PHASES;
    void* args[] = {&p};
    hipError_t e = hipLaunchCooperativeKernel((const void*)fwd_megakernel, dim3(grid), dim3(NTHR), args, LDS_BYTES, stream);
    if (e != hipSuccess) fprintf(stderr, "kernel_launch: cooperative launch failed: %s (grid %d)\n", hipGetErrorString(e), grid);
#else
    for (int k = 0; k < N_PHASES; ++k) { p.ph_lo = k; p.ph_hi = k + 1; hipLaunchKernelGGL(fwd_megakernel, dim3(grid), dim3(NTHR), LDS_BYTES, stream, p); }
#endif
}
```
